# Optimizing an MI355X kernel written in HIP

```python
import jax, jax.numpy as jnp
from jax import lax
import numpy as np

D_MODEL = 1024
BATCH = 8
SEQ = 2048
DEPTH = 1
DEC_BATCH = 16
DEC_SEQ = 32
PAST_LEN = 1024

CHUNK = 64
POOL_WIDTH = 512
POOL_GROUPS = 4
POOL_GROUP_DIM = POOL_WIDTH // POOL_GROUPS
POOL_WINDOWS = (2, 4, 8, 16)
POOL_STATE = max(POOL_WINDOWS) - 1
SB_HEADS = 8
SB_HEAD_DIM = 64
SB_WIDTH = SB_HEADS * SB_HEAD_DIM
Q_BLOCK = 128
D_FF = 4 * D_MODEL
PLE_DIM = 256
IN_WIDTH = POOL_WIDTH + 3 * SB_WIDTH + 2 * D_MODEL
EPS = 1e-6

kernel_name = "stickbreak_pool_hybrid_step"


def rms_norm(x, g):
    xf = x.astype(jnp.float32)
    y = xf * lax.rsqrt(jnp.mean(xf * xf, axis=-1, keepdims=True) + EPS)
    return (y * g.astype(jnp.float32)).astype(x.dtype)


def multiscale_pool(u_hist, u, w_grp, scale):
    B, P, _ = u_hist.shape
    T = u.shape[1]
    full = jnp.concatenate([u_hist, u], axis=1)
    cs = jnp.cumsum(full.astype(jnp.float32), axis=1)
    cs = jnp.pad(cs, ((0, 0), (1, 0), (0, 0)))
    cs = cs.reshape(B, P + T + 1, POOL_GROUPS, POOL_GROUP_DIM)
    windows = jnp.array(POOL_WINDOWS, dtype=jnp.int32)
    end = P + 1 + jnp.arange(T, dtype=jnp.int32)
    start = jnp.maximum(end[:, None] - windows[None, :], 0)
    count = (end[:, None] - start).astype(jnp.float32)
    g_idx = jnp.arange(POOL_GROUPS, dtype=jnp.int32)
    cs_end = cs[:, end]
    cs_start = cs[:, start, g_idx[None, :]]
    mean = (cs_end - cs_start) / count[None, :, :, None]
    u4 = u.reshape(B, T, POOL_GROUPS, POOL_GROUP_DIM)
    y = (mean - u4.astype(jnp.float32)).astype(u.dtype)
    y = jnp.einsum('btgc,gcd->btgd', y, w_grp).reshape(B, T, POOL_WIDTH) * scale
    new_state = full[:, -POOL_STATE:]
    return y, new_state


def stick_breaking_block(q, k, v, q_pos, k_pos):
    z = jnp.einsum('bqhd,bkhd->bhqk', q.astype(jnp.float32), k.astype(jnp.float32)) * (SB_HEAD_DIM ** -0.5)
    causal = k_pos[None, :] < q_pos[:, None]
    log_not = jnp.where(causal, jax.nn.log_sigmoid(-z), 0.0)
    suffix = lax.cumsum(log_not, axis=3, reverse=True) - log_not
    a = jnp.where(causal, jnp.exp(jax.nn.log_sigmoid(z) + suffix), 0.0)
    o = jnp.einsum('bhqk,bkhd->bqhd', a, v.astype(jnp.float32))
    return o.astype(v.dtype)


def stick_breaking_prompt(q, k, v):
    B, T, H, Dh = q.shape
    nb = T // Q_BLOCK
    k_pos = jnp.arange(T, dtype=jnp.int32)
    qb = q.reshape(B, nb, Q_BLOCK, H, Dh).transpose(1, 0, 2, 3, 4)
    pos_b = k_pos.reshape(nb, Q_BLOCK)
    ob = lax.map(lambda args: stick_breaking_block(args[0], k, v, args[1], k_pos), (qb, pos_b))
    return ob.transpose(1, 0, 2, 3, 4).reshape(B, T, H, Dh)


def layer(x, p, pool_hist, k_hist, v_hist, is_prompt,
          g_mix, w_in, b_gate, w_pool_grp, pool_scale, w_pool_up, w_sb_up, w_out,
          g_mlp, w_up, w_down, g_ple, w_ple_gate, w_ple_proj):
    B, T, _ = x.shape
    P = k_hist.shape[1]
    xn = rms_norm(x, g_mix)
    h = xn @ w_in
    u, q, k, v, gates = jnp.split(
        h, [POOL_WIDTH, POOL_WIDTH + SB_WIDTH, POOL_WIDTH + 2 * SB_WIDTH, POOL_WIDTH + 3 * SB_WIDTH], axis=-1)
    gates = jax.nn.sigmoid((gates + b_gate).astype(jnp.float32)).astype(x.dtype)
    gate_a, gate_b = jnp.split(gates, 2, axis=-1)
    y_pool, pool_new = multiscale_pool(pool_hist, u, w_pool_grp, pool_scale)
    q = q.reshape(B, T, SB_HEADS, SB_HEAD_DIM)
    k = k.reshape(B, T, SB_HEADS, SB_HEAD_DIM)
    v = v.reshape(B, T, SB_HEADS, SB_HEAD_DIM)
    if is_prompt:
        o = stick_breaking_prompt(q, k, v)
    else:
        k_all = jnp.concatenate([k_hist, k], axis=1)
        v_all = jnp.concatenate([v_hist, v], axis=1)
        k_pos = jnp.arange(P + T, dtype=jnp.int32)
        q_pos = P + jnp.arange(T, dtype=jnp.int32)
        o = stick_breaking_block(q, k_all, v_all, q_pos, k_pos)
    y_sb = o.reshape(B, T, SB_WIDTH)
    merged = gate_a * (y_pool @ w_pool_up) + gate_b * (y_sb @ w_sb_up)
    x = x + merged @ w_out
    x = x + jnp.square(jax.nn.relu(rms_norm(x, g_mlp) @ w_up)) @ w_down
    x = x + jax.nn.sigmoid(rms_norm(x, g_ple) @ w_ple_gate) * (p @ w_ple_proj)
    return x, k, v, pool_new


def setup_inputs(seed: int = 0) -> dict:
    key = jax.random.key(seed)
    ks = jax.random.split(key, 24)
    f32 = jnp.float32

    def nrm(k, shape, scale):
        return jax.random.normal(k, shape, f32) * scale

    return {
        "x_prompt": nrm(ks[0], (BATCH, SEQ, D_MODEL), 1.0),
        "x_sample": nrm(ks[1], (DEC_BATCH, DEC_SEQ, D_MODEL), 1.0),
        "cache_k": nrm(ks[2], (DEPTH, DEC_BATCH, PAST_LEN, SB_HEADS, SB_HEAD_DIM), 1.0),
        "cache_v": nrm(ks[3], (DEPTH, DEC_BATCH, PAST_LEN, SB_HEADS, SB_HEAD_DIM), 1.0),
        "state_pool": nrm(ks[4], (DEPTH, DEC_BATCH, POOL_STATE, POOL_WIDTH), 1.0),
        "p_prompt": nrm(ks[5], (DEPTH, BATCH, SEQ, PLE_DIM), 1.0),
        "p_sample": nrm(ks[6], (DEPTH, DEC_BATCH, DEC_SEQ, PLE_DIM), 1.0),
        "g_mix": 1.0 + nrm(ks[7], (DEPTH, D_MODEL), 0.05),
        "w_in": nrm(ks[8], (DEPTH, D_MODEL, IN_WIDTH), D_MODEL ** -0.5),
        "b_gate": nrm(ks[9], (DEPTH, 2 * D_MODEL), 0.1),
        "w_pool_grp": nrm(ks[10], (DEPTH, POOL_GROUPS, POOL_GROUP_DIM, POOL_GROUP_DIM), POOL_GROUP_DIM ** -0.5),
        "pool_scale": 1.0 + nrm(ks[11], (DEPTH, POOL_WIDTH), 0.1),
        "w_pool_up": nrm(ks[12], (DEPTH, POOL_WIDTH, D_MODEL), POOL_WIDTH ** -0.5),
        "w_sb_up": nrm(ks[13], (DEPTH, SB_WIDTH, D_MODEL), SB_WIDTH ** -0.5),
        "w_out": nrm(ks[14], (DEPTH, D_MODEL, D_MODEL), D_MODEL ** -0.5),
        "g_mlp": 1.0 + nrm(ks[15], (DEPTH, D_MODEL), 0.05),
        "w_up": nrm(ks[16], (DEPTH, D_MODEL, D_FF), D_MODEL ** -0.5),
        "w_down": nrm(ks[17], (DEPTH, D_FF, D_MODEL), D_FF ** -0.5),
        "g_ple": 1.0 + nrm(ks[18], (DEPTH, D_MODEL), 0.05),
        "w_ple_gate": nrm(ks[19], (DEPTH, D_MODEL, D_MODEL), D_MODEL ** -0.5),
        "w_ple_proj": nrm(ks[20], (DEPTH, PLE_DIM, D_MODEL), PLE_DIM ** -0.5),
        "g_final": 1.0 + nrm(ks[21], (D_MODEL,), 0.05),
    }


def reference(x_prompt, x_sample, cache_k, cache_v, state_pool, p_prompt, p_sample,
              g_mix, w_in, b_gate, w_pool_grp, pool_scale, w_pool_up, w_sb_up, w_out,
              g_mlp, w_up, w_down, g_ple, w_ple_gate, w_ple_proj, g_final):
    xp, xs = x_prompt, x_sample
    empty_pool = jnp.zeros((xp.shape[0], 0, POOL_WIDTH), xp.dtype)
    empty_kv = jnp.zeros((xp.shape[0], 0, SB_HEADS, SB_HEAD_DIM), xp.dtype)
    kp_l, vp_l, pp_l, ks_l, vs_l, ps_l = [], [], [], [], [], []
    for d in range(DEPTH):
        weights = (g_mix[d], w_in[d], b_gate[d], w_pool_grp[d], pool_scale[d], w_pool_up[d], w_sb_up[d],
                   w_out[d], g_mlp[d], w_up[d], w_down[d], g_ple[d], w_ple_gate[d], w_ple_proj[d])
        xp, kp, vp, pp = layer(xp, p_prompt[d], empty_pool, empty_kv, empty_kv, True, *weights)
        xs, ksm, vsm, psm = layer(xs, p_sample[d], state_pool[d], cache_k[d], cache_v[d], False, *weights)
        kp_l.append(kp); vp_l.append(vp); pp_l.append(pp)
        ks_l.append(ksm); vs_l.append(vsm); ps_l.append(psm)
    y_prompt = rms_norm(xp, g_final)
    y_sample = rms_norm(xs, g_final)
    k_prompt = jnp.stack(kp_l); v_prompt = jnp.stack(vp_l); pool_prompt = jnp.stack(pp_l)
    k_sample = jnp.stack(ks_l); v_sample = jnp.stack(vs_l); pool_sample = jnp.stack(ps_l)
    return (y_prompt, y_sample, k_prompt, v_prompt, pool_prompt, k_sample, v_sample, pool_sample)
```

```cpp
#include <hip/hip_runtime.h>
#include <cstdio>
#include <cstdint>

namespace nv {
constexpr int DM = 1024, NB = 8, SEQ = 2048, DB = 16, DS = 32, PAST = 1024, PW = 512, SBW = 512, HD = 64, NH = 8, DFF = 4096, PLE = 256, INW = 4096;
constexpr int MP = NB * SEQ, MS = DB * DS, MT = MP + MS;
constexpr float EPS = 1e-6f;

template <int EPI>
__global__ void __launch_bounds__(256) gemm_f32(const float* __restrict__ A, int lda, const float* __restrict__ B, int ldb, float* C, int ldc, int K,
                                                const float* bias, const float* aux, int ldaux, const float* resid, int ldr, int accum) {
    __shared__ float As[16][65];
    __shared__ float Bs[16][64];
    const int tid = threadIdx.x, tx = tid & 15, ty = tid >> 4;
    const int m0 = blockIdx.y * 64, n0 = blockIdx.x * 64;
    float acc[4][4];
#pragma unroll
    for (int i = 0; i < 4; ++i)
#pragma unroll
        for (int j = 0; j < 4; ++j) acc[i][j] = 0.f;
    for (int k0 = 0; k0 < K; k0 += 16) {
#pragma unroll
        for (int i = 0; i < 4; ++i) { const int e = tid + i * 256, r = e >> 4, c = e & 15; As[c][r] = A[(size_t)(m0 + r) * lda + k0 + c]; }
#pragma unroll
        for (int i = 0; i < 4; ++i) { const int e = tid + i * 256, r = e >> 6, c = e & 63; Bs[r][c] = B[(size_t)(k0 + r) * ldb + n0 + c]; }
        __syncthreads();
#pragma unroll
        for (int k = 0; k < 16; ++k) {
            float a[4], b[4];
#pragma unroll
            for (int i = 0; i < 4; ++i) a[i] = As[k][ty * 4 + i];
#pragma unroll
            for (int j = 0; j < 4; ++j) b[j] = Bs[k][tx * 4 + j];
#pragma unroll
            for (int i = 0; i < 4; ++i)
#pragma unroll
                for (int j = 0; j < 4; ++j) acc[i][j] = fmaf(a[i], b[j], acc[i][j]);
        }
        __syncthreads();
    }
#pragma unroll
    for (int i = 0; i < 4; ++i)
#pragma unroll
        for (int j = 0; j < 4; ++j) {
            const int m = m0 + ty * 4 + i, n = n0 + tx * 4 + j; const size_t ci = (size_t)m * ldc + n; const float v = acc[i][j]; float o;
            if (EPI == 0) o = v;
            else if (EPI == 1) { o = (1.f / (1.f + expf(-(v + bias[n])))) * aux[(size_t)m * ldaux + n]; if (accum) o += C[ci]; }
            else if (EPI == 2) o = resid[(size_t)m * ldr + n] + v;
            else if (EPI == 3) { const float r = v > 0.f ? v : 0.f; o = r * r; }
            else if (EPI == 4) o = resid[(size_t)m * ldr + n] + (1.f / (1.f + expf(-v))) * C[ci];
            else o = v * bias[n];
            C[ci] = o;
        }
}

__global__ void __launch_bounds__(256) rmsnorm_rows(const float* x, const float* __restrict__ g, float* y, int rows) {
    const int row = blockIdx.x * 4 + (threadIdx.x >> 6), lane = threadIdx.x & 63; if (row >= rows) return;
    const float* xr = x + (size_t)row * DM; float v[16]; float s = 0.f;
#pragma unroll
    for (int i = 0; i < 16; ++i) { v[i] = xr[lane + 64 * i]; s += v[i] * v[i]; }
#pragma unroll
    for (int o = 1; o < 64; o <<= 1) s += __shfl_xor(s, o);
    const float r = 1.0f / sqrtf(s * (1.f / DM) + EPS);
#pragma unroll
    for (int i = 0; i < 16; ++i) y[(size_t)row * DM + lane + 64 * i] = v[i] * r * g[lane + 64 * i];
}

__global__ void copy_cols(const float* __restrict__ src, int lds_, float* __restrict__ dst, int ldd, int cols, int rows) {
    const size_t i = (size_t)blockIdx.x * blockDim.x + threadIdx.x; if (i >= (size_t)rows * cols) return;
    const int m = (int)(i / cols), c = (int)(i % cols); dst[(size_t)m * ldd + c] = src[(size_t)m * lds_ + c];
}

__global__ void pool_pre(const float* __restrict__ u, const float* __restrict__ state_pool, float* ypre, float* pool_p, float* pool_s) {
    const size_t i = (size_t)blockIdx.x * blockDim.x + threadIdx.x; if (i >= (size_t)MT * PW) return;
    const int m = (int)(i / PW), c = (int)(i % PW), g = c / 128, w = 2 << g;
    float s = 0.f; float cnt;
    if (m < MP) { const int t = m % SEQ; const int n = (t + 1 < w) ? t + 1 : w; for (int j = 0; j < n; ++j) s += u[(size_t)(m - j) * PW + c]; cnt = (float)n;
        if (t >= SEQ - 15) pool_p[((size_t)(m / SEQ) * 15 + (t - (SEQ - 15))) * PW + c] = u[i]; }
    else { const int ms = m - MP, b = ms / DS, t = ms % DS; for (int j = 0; j < w; ++j) { const int r = 15 + t - j; s += (r >= 15) ? u[(size_t)(m - j) * PW + c] : state_pool[((size_t)b * 15 + r) * PW + c]; } cnt = (float)w;
        if (t >= DS - 15) pool_s[((size_t)b * 15 + (t - (DS - 15))) * PW + c] = u[i]; }
    ypre[i] = s / cnt - u[i];
}

__device__ __forceinline__ float softplusf(float z) { return fmaxf(z, 0.f) + log1pf(expf(-fabsf(z))); }
__global__ void __launch_bounds__(64) sb_attn(const float* __restrict__ q, const float* __restrict__ kp, const float* __restrict__ vp, const float* __restrict__ ks, const float* __restrict__ vs,
                                              const float* __restrict__ ck, const float* __restrict__ cv, float* ysb) {
    const int idx = blockIdx.x * 64 + threadIdx.x; if (idx >= MT * NH) return;
    const int h = idx / MT, m = idx % MT;
    float qr[HD], o[HD];
#pragma unroll
    for (int d = 0; d < HD; ++d) { qr[d] = q[(size_t)m * SBW + h * HD + d] * 0.125f; o[d] = 0.f; }
    float S = 0.f; bool done = false;
    const float* kb; const float* vb; int nk;
    if (m < MP) { const int b = m / SEQ, t = m % SEQ; kb = kp + (size_t)b * SEQ * SBW + h * HD; vb = vp + (size_t)b * SEQ * SBW + h * HD; nk = t; }
    else { const int ms = m - MP, b = ms / DS, t = ms % DS; kb = ks + (size_t)b * DS * SBW + h * HD; vb = vs + (size_t)b * DS * SBW + h * HD; nk = t; }
    for (int s = nk - 1; s >= 0 && !done; --s) {
        const float* kr = kb + (size_t)s * SBW; const float* vr = vb + (size_t)s * SBW; float z = 0.f;
#pragma unroll
        for (int d = 0; d < HD; ++d) z = fmaf(qr[d], kr[d], z);
        const float sp = softplusf(z), a = expf(z - sp - S);
#pragma unroll
        for (int d = 0; d < HD; ++d) o[d] = fmaf(a, vr[d], o[d]);
        S += sp; if (S > 110.f) done = true;
    }
    if (m >= MP) { const int b = (m - MP) / DS; const float* kc = ck + (size_t)b * PAST * SBW + h * HD; const float* vc = cv + (size_t)b * PAST * SBW + h * HD;
        for (int s = PAST - 1; s >= 0 && !done; --s) {
            const float* kr = kc + (size_t)s * SBW; const float* vr = vc + (size_t)s * SBW; float z = 0.f;
#pragma unroll
            for (int d = 0; d < HD; ++d) z = fmaf(qr[d], kr[d], z);
            const float sp = softplusf(z), a = expf(z - sp - S);
#pragma unroll
            for (int d = 0; d < HD; ++d) o[d] = fmaf(a, vr[d], o[d]);
            S += sp; if (S > 110.f) done = true;
        } }
#pragma unroll
    for (int d = 0; d < HD; ++d) ysb[(size_t)m * SBW + h * HD + d] = o[d];
}
}

extern "C" void kernel_launch(void* const* d_in, const int* in_sizes, int n_in, void* d_out, int out_size, void* d_ws, size_t ws_size, hipStream_t stream) {
    using namespace nv;
    const float* x_p = (const float*)d_in[0]; const float* x_s = (const float*)d_in[1]; const float* cache_k = (const float*)d_in[2]; const float* cache_v = (const float*)d_in[3];
    const float* state_pool = (const float*)d_in[4]; const float* p_p = (const float*)d_in[5]; const float* p_s = (const float*)d_in[6];
    const float* g_mix = (const float*)d_in[7]; const float* w_in = (const float*)d_in[8]; const float* b_gate = (const float*)d_in[9]; const float* w_grp = (const float*)d_in[10];
    const float* pool_scale = (const float*)d_in[11]; const float* w_pool_up = (const float*)d_in[12]; const float* w_sb_up = (const float*)d_in[13]; const float* w_out = (const float*)d_in[14];
    const float* g_mlp = (const float*)d_in[15]; const float* w_up = (const float*)d_in[16]; const float* w_down = (const float*)d_in[17]; const float* g_ple = (const float*)d_in[18];
    const float* w_ple_gate = (const float*)d_in[19]; const float* w_ple_proj = (const float*)d_in[20]; const float* g_final = (const float*)d_in[21];
    float* out = (float*)d_out;
    float* y = out;
    float* k_p = out + 17301504; float* v_p = out + 25690112; float* pool_p = out + 34078720; float* k_s = out + 34140160; float* v_s = out + 34402304; float* pool_s = out + 34664448;
    float* ws = (float*)d_ws;
    float* RA = ws;
    float* RB = RA + (size_t)MT * DM;
    float* RC = RB + (size_t)MT * DM;
    float* xn = RA; float* u = RB; float* q = RB + (size_t)MT * 512; float* ysb = RC; float* ypre = RC + (size_t)MT * 512;
    rmsnorm_rows<<<MP / 4, 256, 0, stream>>>(x_p, g_mix, xn, MP);
    rmsnorm_rows<<<MS / 4, 256, 0, stream>>>(x_s, g_mix, xn + (size_t)MP * DM, MS);
    {
        gemm_f32<0><<<dim3(1024 / 64, MT / 64), 256, 0, stream>>>(xn, DM, w_in, INW, RC, 1024, DM, nullptr, nullptr, 0, nullptr, 0, 0);
    }
    copy_cols<<<(int)(((size_t)MT * 512 + 255) / 256), 256, 0, stream>>>(RC, 1024, u, 512, 512, MT);
    copy_cols<<<(int)(((size_t)MT * 512 + 255) / 256), 256, 0, stream>>>(RC + 512, 1024, q, 512, 512, MT);
    gemm_f32<0><<<dim3(512 / 64, MP / 64), 256, 0, stream>>>(xn, DM, w_in + 1024, INW, k_p, 512, DM, nullptr, nullptr, 0, nullptr, 0, 0);
    gemm_f32<0><<<dim3(512 / 64, MP / 64), 256, 0, stream>>>(xn, DM, w_in + 1536, INW, v_p, 512, DM, nullptr, nullptr, 0, nullptr, 0, 0);
    gemm_f32<0><<<dim3(512 / 64, MS / 64), 256, 0, stream>>>(xn + (size_t)MP * DM, DM, w_in + 1024, INW, k_s, 512, DM, nullptr, nullptr, 0, nullptr, 0, 0);
    gemm_f32<0><<<dim3(512 / 64, MS / 64), 256, 0, stream>>>(xn + (size_t)MP * DM, DM, w_in + 1536, INW, v_s, 512, DM, nullptr, nullptr, 0, nullptr, 0, 0);
    sb_attn<<<(MT * NH + 63) / 64, 64, 0, stream>>>(q, k_p, v_p, k_s, v_s, cache_k, cache_v, ysb);
    pool_pre<<<(int)(((size_t)MT * PW + 255) / 256), 256, 0, stream>>>(u, state_pool, ypre, pool_p, pool_s);
    float* ypool = q;
    for (int g = 0; g < 4; ++g)
        gemm_f32<5><<<dim3(128 / 64, MT / 64), 256, 0, stream>>>(ypre + g * 128, 512, w_grp + (size_t)g * 128 * 128, 128, ypool + g * 128, 512, 128, pool_scale + g * 128, nullptr, 0, nullptr, 0, 0);
    float* PX = y;
    gemm_f32<0><<<dim3(DM / 64, MT / 64), 256, 0, stream>>>(ypool, 512, w_pool_up, DM, PX, DM, 512, nullptr, nullptr, 0, nullptr, 0, 0);
    gemm_f32<1><<<dim3(DM / 64, MT / 64), 256, 0, stream>>>(xn, DM, w_in + 2048, INW, PX, DM, DM, b_gate, PX, DM, nullptr, 0, 0);
    float* PB = RB;
    gemm_f32<0><<<dim3(DM / 64, MT / 64), 256, 0, stream>>>(ysb, 512, w_sb_up, DM, PB, DM, 512, nullptr, nullptr, 0, nullptr, 0, 0);
    gemm_f32<1><<<dim3(DM / 64, MT / 64), 256, 0, stream>>>(xn, DM, w_in + 3072, INW, PX, DM, DM, b_gate + 1024, PB, DM, nullptr, 0, 1);
    float* merged = PX;
    float* x1 = RB;
    gemm_f32<2><<<dim3(DM / 64, MP / 64), 256, 0, stream>>>(merged, DM, w_out, DM, x1, DM, DM, nullptr, nullptr, 0, x_p, DM, 0);
    gemm_f32<2><<<dim3(DM / 64, MS / 64), 256, 0, stream>>>(merged + (size_t)MP * DM, DM, w_out, DM, x1 + (size_t)MP * DM, DM, DM, nullptr, nullptr, 0, x_s, DM, 0);
    rmsnorm_rows<<<MT / 4, 256, 0, stream>>>(x1, g_mlp, RA, MT);
    for (int c = 0; c < 4; ++c) { const int r0 = c * (MT / 4), nr = MT / 4;
        gemm_f32<3><<<dim3(DFF / 64, nr / 64), 256, 0, stream>>>(RA + (size_t)r0 * DM, DM, w_up, DFF, RC, DFF, DM, nullptr, nullptr, 0, nullptr, 0, 0);
        gemm_f32<2><<<dim3(DM / 64, nr / 64), 256, 0, stream>>>(RC, DFF, w_down, DM, x1 + (size_t)r0 * DM, DM, DFF, nullptr, nullptr, 0, x1 + (size_t)r0 * DM, DM, 0); }
    float* x2 = x1;
    rmsnorm_rows<<<MT / 4, 256, 0, stream>>>(x2, g_ple, RA, MT);
    gemm_f32<0><<<dim3(DM / 64, MP / 64), 256, 0, stream>>>(p_p, PLE, w_ple_proj, DM, y, DM, PLE, nullptr, nullptr, 0, nullptr, 0, 0);
    gemm_f32<0><<<dim3(DM / 64, MS / 64), 256, 0, stream>>>(p_s, PLE, w_ple_proj, DM, y + (size_t)MP * DM, DM, PLE, nullptr, nullptr, 0, nullptr, 0, 0);
    gemm_f32<4><<<dim3(DM / 64, MT / 64), 256, 0, stream>>>(RA, DM, w_ple_gate, DM, y, DM, DM, nullptr, nullptr, 0, x2, DM, 0);
    rmsnorm_rows<<<MT / 4, 256, 0, stream>>>(y, g_final, y, MT);
}
```

```cpp
#include <hip/hip_runtime.h>
#include <hip/hip_bf16.h>
#include <cstdio>
#include <cstdint>
#include <cmath>
namespace cfg {
constexpr int DM = 1024, NB = 8, SEQ = 2048, DB = 16, DS = 32, PAST = 1024, PW = 512, SBW = 512, HD = 64, NH = 8, DFF = 4096, PLE = 256, INW = 4096;
constexpr int MP = NB * SEQ, MS = DB * DS, MT = MP + MS;
constexpr float EPS = 1e-6f;
constexpr float QSCALE = 0.125f * 1.4426950408889634f;
}
namespace pg8 {
#define PG8_LAS __attribute__((address_space(3)))
typedef unsigned short bf16_t;
typedef short bf16x8 __attribute__((ext_vector_type(8)));
typedef float f32x4 __attribute__((ext_vector_type(4)));
typedef unsigned u32x4 __attribute__((ext_vector_type(4)));
constexpr int BM = 256, BK = 64, HALF = 128, HTB = HALF * BK * 2  , STAGE_BYTES = 8 * HTB, NXCD = 8, WGM = 8;

__host__ __device__ __forceinline__ int lds_byte(int r, int c) { const int st = (r >> 4) * 2 + (c >> 5), rr = r & 15, cc = c & 31, ob = rr * 64 + cc * 2; return st * 1024 + (ob ^ (((ob >> 9) & 1) << 5)); }
__host__ __device__ __forceinline__ void stage_rc(int b, int& R, int& C) { const int st = b / 1024, sb = b % 1024, swz = sb ^ (((sb >> 9) & 1) << 5); R = (st >> 1) * 16 + swz / 64; C = (st & 1) * 32 + (swz % 64) / 2; }
__host__ __device__ __forceinline__ int perm32(int rho) { const int n = rho >> 4, i = rho & 15; return 8 * (i >> 2) + 4 * n + (i & 3); }

struct Unit { int pm, pn; };
struct Gemm { const bf16_t* A; const bf16_t* Bt; int M, N, K; };

struct StaticOrder {
    int nM, nN, nwg, G, c;
    __host__ __device__ void init(int M, int N, int G_, int c_) { nM = M / BM; nN = N / BM; nwg = nM * nN; G = G_; c = c_; }
    __host__ __device__ bool next(int i, Unit& u) const {
        const long L = (long)i * G + c; if (L >= nwg) return false;
        int wgid = (int)L; { const int q = nwg / NXCD, r = nwg % NXCD, xcd = wgid % NXCD, off = wgid / NXCD; wgid = (xcd < r ? xcd * (q + 1) : r * (q + 1) + (xcd - r) * q) + off; }
        const int nig = WGM * nN, gid = wgid / nig, fm = gid * WGM, gsz = (nM - fm) < WGM ? (nM - fm) : WGM;
        u.pm = fm + ((wgid % nig) % gsz); u.pn = (wgid % nig) / gsz; return true;
    }
    __device__ __forceinline__ void a_ready(const Unit&) const {}
    __device__ __forceinline__ void done(const Unit&) const {}
};
struct RotOrder : StaticOrder {
    int rot, cnt;
    __host__ __device__ void init(int M, int N, int G_, int c_, int rot_) { StaticOrder::init(M, N, G_, c_); cnt = (nwg % G_ == 0) ? nwg / G_ : 0; rot = rot_; }
    __host__ __device__ bool next(int i, Unit& u) const { if (cnt == 0) return StaticOrder::next(i, u); if (i >= cnt) return false; return StaticOrder::next((i + rot) % cnt, u); }
};
typedef float f32x2v_t __attribute__((ext_vector_type(2))); typedef __bf16 bf16x2v_t __attribute__((ext_vector_type(2)));
__device__ __forceinline__ unsigned cvt_pk_bf16(float lo, float hi) { f32x2v_t v = {lo, hi}; bf16x2v_t b = __builtin_convertvector(v, bf16x2v_t); return __builtin_bit_cast(unsigned, b); }
typedef float f32x2 __attribute__((ext_vector_type(2)));
__device__ __forceinline__ float bf_lo(unsigned w) { return __uint_as_float(w << 16); }
__device__ __forceinline__ float bf_hi(unsigned w) { return __uint_as_float(w & 0xffff0000u); }
__device__ __forceinline__ u32x4 pack8(f32x4 a, f32x4 b) { u32x4 w; w.x = cvt_pk_bf16(a[0], a[1]); w.y = cvt_pk_bf16(a[2], a[3]); w.z = cvt_pk_bf16(b[0], b[1]); w.w = cvt_pk_bf16(b[2], b[3]); return w; }
__device__ __forceinline__ void unpack8(u32x4 w, f32x4& a, f32x4& b) { a = (f32x4){bf_lo(w.x), bf_hi(w.x), bf_lo(w.y), bf_hi(w.y)}; b = (f32x4){bf_lo(w.z), bf_hi(w.z), bf_lo(w.w), bf_hi(w.w)}; }
__device__ __forceinline__ float sigm(float x) { return __builtin_amdgcn_rcpf(1.f + __builtin_amdgcn_exp2f(-1.4426950408889634f * x)); }
__device__ __forceinline__ f32x4 sigm4(f32x4 x) { return (f32x4){sigm(x[0]), sigm(x[1]), sigm(x[2]), sigm(x[3])}; }
__device__ __forceinline__ float dot4(f32x4 a) { return (a[0] * a[0] + a[1] * a[1]) + (a[2] * a[2] + a[3] * a[3]); }
#ifndef DBG_LDAUX
#define DBG_LDAUX 16
#endif
__device__ __forceinline__ u32x4 ld16_sc1(const void* base, size_t byte_off) {
    const __amdgpu_buffer_rsrc_t rs = __builtin_amdgcn_make_buffer_rsrc((void*)base, (short)0, 0x7fffffff, 0x00020000);
    return __builtin_bit_cast(u32x4, __builtin_amdgcn_raw_buffer_load_b128(rs, (unsigned)byte_off, 0, DBG_LDAUX));
}
__device__ __forceinline__ float row_rstd(const float* SSQ, int r, int fq) {
    const f32x4 p = *(const f32x4*)(SSQ + (size_t)r * 16 + 4 * fq); float s = (p[0] + p[1]) + (p[2] + p[3]);
    s += __shfl_xor(s, 16); s += __shfl_xor(s, 32);
    return __builtin_amdgcn_rsqf(s * (1.0f / 1024.0f) + cfg::EPS);
}
#define PG8_ROWS(...) _Pragma("unroll") for (int ai = 0; ai < 2; ++ai) _Pragma("unroll") for (int m = 0; m < 4; ++m) { const int r = u.pm * BM + ai * HALF + wr * 64 + m * 16 + fr; __VA_ARGS__; if (m == 3) asm volatile("" ::: "memory"); }
#define PG8_COLS(...) _Pragma("unroll") for (int bj = 0; bj < 2; ++bj) { const int c = ct + bj * HALF + wc * 32 + 8 * fq; const f32x4 v0 = acc[ai][bj][m][0], v1 = acc[ai][bj][m][1]; __VA_ARGS__; }

struct EpiIn {
    static constexpr bool PERM = true, AFTER_DRAIN = false;
    bf16_t *U, *Q, *K, *V, *G; const float* b_gate; float *k_p, *v_p, *k_s, *v_s, *pool_p, *pool_s;
    __device__ __forceinline__ void operator()(const f32x4 (&acc)[2][2][4][2], const Unit& u, int wr, int wc, int fr, int fq) const {
        const int pn = u.pn;
        if (pn >= 8) {
            const int ct = (pn - 8) * BM; f32x4 bv[2][2];
#pragma unroll
            for (int bj = 0; bj < 2; ++bj) { const int c = ct + bj * HALF + wc * 32 + 8 * fq; bv[bj][0] = *(const f32x4*)(b_gate + c); bv[bj][1] = *(const f32x4*)(b_gate + c + 4); }
            PG8_ROWS(PG8_COLS(*(u32x4*)(G + (size_t)r * 2048 + c) = pack8(sigm4(v0 + bv[bj][0]), sigm4(v1 + bv[bj][1]))))
        } else if (pn >= 4) {
            const bool isv = pn >= 6; const int ct = (pn - (isv ? 6 : 4)) * BM; bf16_t* B = isv ? V : K; float* op = isv ? v_p : k_p; float* os = isv ? v_s : k_s;
            PG8_ROWS(float* orow = r < cfg::MP ? op + (size_t)r * 512 : os + (size_t)(r - cfg::MP) * 512;
                     PG8_COLS(*(u32x4*)(B + (size_t)r * 512 + c) = pack8(v0, v1); *(f32x4*)(orow + c) = v0; *(f32x4*)(orow + c + 4) = v1))
        } else if (pn >= 2) {
            const int ct = (pn - 2) * BM;
            PG8_ROWS(PG8_COLS(*(u32x4*)(Q + (size_t)r * 512 + c) = pack8(v0 * cfg::QSCALE, v1 * cfg::QSCALE)))
        } else {
            const int ct = pn * BM;
            PG8_ROWS(float* prow = nullptr;
                     if (r < cfg::MP) { const int t = r & (cfg::SEQ - 1); if (t >= cfg::SEQ - 15) prow = pool_p + ((size_t)(r >> 11) * 15 + (t - (cfg::SEQ - 15))) * 512; }
                     else { const int i = (r - cfg::MP) & 31; if (i >= 17) prow = pool_s + ((size_t)((r - cfg::MP) >> 5) * 15 + (i - 17)) * 512; }
                     PG8_COLS(*(u32x4*)(U + (size_t)r * 512 + c) = pack8(v0, v1); if (prow) { *(f32x4*)(prow + c) = v0; *(f32x4*)(prow + c + 4) = v1; }))
        }
    }
};
#if defined(DBG_ONLYG)
#define DBG_NOG_STMT *(u32x4*)(MG + (size_t)r * 1024 + c) = gw; continue;
#elif defined(DBG_NOG)
#define DBG_NOG_STMT g0 = (f32x4){0.5f, 0.5f, 0.5f, 0.5f}; g1 = g0;
#else
#define DBG_NOG_STMT
#endif
struct EpiMerge0 {
    static constexpr bool PERM = true, AFTER_DRAIN = false;
    const bf16_t* G; bf16_t* MG;
    __device__ __forceinline__ void operator()(const f32x4 (&acc)[2][2][4][2], const Unit& u, int wr, int wc, int fr, int fq) const {
        const int ct = u.pn * BM;
        PG8_ROWS(PG8_COLS(const u32x4 gw = ld16_sc1(G, ((size_t)r * 2048 + c) * 2); f32x4 g0; f32x4 g1; unpack8(gw, g0, g1); DBG_NOG_STMT *(u32x4*)(MG + (size_t)r * 1024 + c) = pack8(v0 * g0, v1 * g1)))
    }
};
#ifdef DBG_NORAW
#define DBG_NORAW_STMT m0 = (f32x4){0.f, 0.f, 0.f, 0.f}; m1 = m0;
#else
#define DBG_NORAW_STMT
#endif
struct EpiMerge1 {
    static constexpr bool PERM = true, AFTER_DRAIN = false;
    const bf16_t* G; bf16_t* MG;
    __device__ __forceinline__ void operator()(const f32x4 (&acc)[2][2][4][2], const Unit& u, int wr, int wc, int fr, int fq) const {
        const int ct = u.pn * BM;
        PG8_ROWS(PG8_COLS(const u32x4 gw = *(const u32x4*)(G + (size_t)r * 2048 + 1024 + c); const u32x4 mw = *(const u32x4*)(MG + (size_t)r * 1024 + c);
                          f32x4 g0; f32x4 g1; f32x4 m0; f32x4 m1; unpack8(gw, g0, g1); unpack8(mw, m0, m1); DBG_NORAW_STMT *(u32x4*)(MG + (size_t)r * 1024 + c) = pack8(m0 + v0 * g0, m1 + v1 * g1)))
    }
};
template <bool F32RES>
struct EpiResid {
    static constexpr bool PERM = true, AFTER_DRAIN = false;
    const float* res_p; bf16_t* X; bf16_t* XG; const float* gvec; float* SSQ;
    __device__ __forceinline__ void operator()(const f32x4 (&acc)[2][2][4][2], const Unit& u, int wr, int wc, int fr, int fq) const {
        const int ct = u.pn * BM; f32x4 gv[2][2];
#pragma unroll
        for (int bj = 0; bj < 2; ++bj) { const int c = ct + bj * HALF + wc * 32 + 8 * fq; gv[bj][0] = *(const f32x4*)(gvec + c); gv[bj][1] = *(const f32x4*)(gvec + c + 4); }
        PG8_ROWS(float s = 0.f;
                 PG8_COLS(f32x4 a; f32x4 b;
                          if (F32RES) { a = *(const f32x4*)(res_p + (size_t)r * 1024 + c); b = *(const f32x4*)(res_p + (size_t)r * 1024 + c + 4); }
                          else { const u32x4 xw = *(const u32x4*)(X + (size_t)r * 1024 + c); unpack8(xw, a, b); }
                          a += v0; b += v1; *(u32x4*)(X + (size_t)r * 1024 + c) = pack8(a, b); s += dot4(a) + dot4(b);
                          *(u32x4*)(XG + (size_t)r * 1024 + c) = pack8(a * gv[bj][0], b * gv[bj][1]))
                 s += __shfl_xor(s, 16); s += __shfl_xor(s, 32); if (fq == 0) SSQ[(size_t)r * 16 + u.pn * 4 + wc] = s)
    }
};
struct EpiUp {
    static constexpr bool PERM = true, AFTER_DRAIN = false;
    const float* SSQ; bf16_t* H;
    __device__ __forceinline__ void operator()(const f32x4 (&acc)[2][2][4][2], const Unit& u, int wr, int wc, int fr, int fq) const {
        const int ct = u.pn * BM; float rsv[2][4];
#pragma unroll
        for (int ai = 0; ai < 2; ++ai)
#pragma unroll
            for (int m = 0; m < 4; ++m) rsv[ai][m] = row_rstd(SSQ, u.pm * BM + ai * HALF + wr * 64 + m * 16 + fr, fq);
        PG8_ROWS(const float rs = rsv[ai][m];
                 PG8_COLS(f32x4 a = v0 * rs; f32x4 b = v1 * rs; a = __builtin_elementwise_max(a, (f32x4){0.f, 0.f, 0.f, 0.f}); b = __builtin_elementwise_max(b, (f32x4){0.f, 0.f, 0.f, 0.f});
                          *(u32x4*)(H + (size_t)r * 4096 + c) = pack8(a * a, b * b)))
    }
};
struct EpiNull {
    static constexpr bool PERM = true, AFTER_DRAIN = false;
    float* sink;
    __device__ __forceinline__ void operator()(const f32x4 (&acc)[2][2][4][2], const Unit& u, int wr, int wc, int fr, int fq) const {
        float s = 0.f;
#pragma unroll
        for (int ai = 0; ai < 2; ++ai)
#pragma unroll
            for (int bj = 0; bj < 2; ++bj)
#pragma unroll
                for (int m = 0; m < 4; ++m)
#pragma unroll
                    for (int n = 0; n < 2; ++n) s += acc[ai][bj][m][n][0] + acc[ai][bj][m][n][3];
        if (s == 1.2345e33f) sink[0] = s;
    }
};
struct EpiPP {
    static constexpr bool PERM = true, AFTER_DRAIN = false;
    bf16_t* PP;
    __device__ __forceinline__ void operator()(const f32x4 (&acc)[2][2][4][2], const Unit& u, int wr, int wc, int fr, int fq) const {
        const int ct = u.pn * BM;
        PG8_ROWS(PG8_COLS(*(u32x4*)(PP + (size_t)r * 1024 + c) = pack8(v0, v1)))
    }
};
struct EpiPleFinal {
    static constexpr bool PERM = true, AFTER_DRAIN = false;
    const float* SSQ; const bf16_t* PP; const bf16_t* X; float* Y; float* SSQo; const float* gfin; unsigned* cnt;
    __device__ __forceinline__ void operator()(f32x4 (&acc)[2][2][4][2], const Unit& u, int wr, int wc, int fr, int fq) const {
        const int ct = u.pn * BM; float rsv[2][4];
#pragma unroll
        for (int ai = 0; ai < 2; ++ai)
#pragma unroll
            for (int m = 0; m < 4; ++m) rsv[ai][m] = row_rstd(SSQ, u.pm * BM + ai * HALF + wr * 64 + m * 16 + fr, fq);
        PG8_ROWS(const float rs = rsv[ai][m]; float s = 0.f;
                 PG8_COLS(const u32x4 pw = *(const u32x4*)(PP + (size_t)r * 1024 + c); f32x4 p0; f32x4 p1; unpack8(pw, p0, p1);
                          const u32x4 xw = *(const u32x4*)(X + (size_t)r * 1024 + c); f32x4 a; f32x4 b; unpack8(xw, a, b); a += sigm4(v0 * rs) * p0; b += sigm4(v1 * rs) * p1;
                          acc[ai][bj][m][0] = a; acc[ai][bj][m][1] = b; s += dot4(a) + dot4(b))
                 s += __shfl_xor(s, 16); s += __shfl_xor(s, 32);
                 if (fq == 0) __hip_atomic_store(SSQo + (size_t)r * 16 + u.pn * 4 + wc, s, __ATOMIC_RELAXED, __HIP_MEMORY_SCOPE_AGENT))
        asm volatile("s_waitcnt vmcnt(0)" ::: "memory");
        unsigned* cw = cnt + 64 * u.pm;
        if (fr == 0 && fq == 0) __hip_atomic_fetch_add(cw, 1u, __ATOMIC_RELAXED, __HIP_MEMORY_SCOPE_AGENT);
        { unsigned spins = 0;
          while ((unsigned)__builtin_amdgcn_readfirstlane(__hip_atomic_load(cw, __ATOMIC_RELAXED, __HIP_MEMORY_SCOPE_AGENT)) < 32u) { __builtin_amdgcn_s_sleep(2); if (++spins > (1u << 22)) break; } }
        f32x4 gv[2][2];
#pragma unroll
        for (int bj = 0; bj < 2; ++bj) { const int c = ct + bj * HALF + wc * 32 + 8 * fq; gv[bj][0] = *(const f32x4*)(gfin + c); gv[bj][1] = *(const f32x4*)(gfin + c + 4); }
        PG8_ROWS(const f32x4 pq = __builtin_bit_cast(f32x4, ld16_sc1(SSQo, ((size_t)r * 16 + 4 * fq) * 4)); float t = (pq[0] + pq[1]) + (pq[2] + pq[3]); t += __shfl_xor(t, 16); t += __shfl_xor(t, 32);
                 const float r3 = __builtin_amdgcn_rsqf(t * (1.0f / 1024.0f) + cfg::EPS);
                 PG8_COLS(*(f32x4*)(Y + (size_t)r * 1024 + c) = v0 * r3 * gv[bj][0]; *(f32x4*)(Y + (size_t)r * 1024 + c + 4) = v1 * r3 * gv[bj][1]))
    }
};
template <class Epi, class Sched, bool ALIGN_EPI = false, bool SP2 = false>
__device__ __forceinline__ void gemm_phase(PG8_LAS unsigned char* lds, const Gemm g, const Sched& S, const Epi& E) {
    int tid = threadIdx.x; asm volatile("" : "+v"(tid));
    const int wid = __builtin_amdgcn_readfirstlane(tid >> 6), lane = tid & 63, wr = wid >> 2, wc = wid & 3, fr = lane & 15, fq = lane >> 4;
    int K = g.K; asm volatile("" : "+s"(K)); const int nt = K / BK;
    unsigned voffA[2], voffB[2];
#pragma unroll
    for (int i = 0; i < 2; ++i) { int R, C; stage_rc(tid * 16 + i * 8192, R, C); const int Rb = Epi::PERM ? ((R & ~31) + perm32(R & 31)) : R;
        voffA[i] = (unsigned)(R * K + C) * 2u; voffB[i] = (unsigned)(Rb * K + C) * 2u; }
    const size_t kstep = (size_t)(BK * 2);
    const size_t hstep = (size_t)HALF * K * 2;
    const size_t tstep = 2 * hstep;
    const size_t bhs = hstep;
    const unsigned ldsw = (unsigned)wid * 1024u;
    const int aoff = lds_byte(wr * 64 + fr, fq * 8), boff = lds_byte(wc * 32 + fr, fq * 8);
#define PG8_SA(b, h) (((b) * 2 + (h)) * HTB)
#define PG8_SB(b, h) ((4 + (b) * 2 + (h)) * HTB)
#define PG8_STAGE(bufoff, gbase, voff) do { _Pragma("unroll") for (int _i = 0; _i < 2; ++_i) \
        __builtin_amdgcn_global_load_lds((const unsigned*)((const char*)(gbase) + (voff)[_i]), (PG8_LAS unsigned*)(lds + (bufoff) + ldsw + _i * 8192), 16, 0, 0); } while (0)
#define PG8_LDA(dst, b, h) do { _Pragma("unroll") for (int m = 0; m < 4; ++m) _Pragma("unroll") for (int k = 0; k < 2; ++k) dst[m][k] = *(const PG8_LAS bf16x8*)(lds + PG8_SA(b, h) + aoff + m * 2048 + k * 1024); } while (0)
#define PG8_LDB(dst, b, h) do { _Pragma("unroll") for (int n = 0; n < 2; ++n) _Pragma("unroll") for (int k = 0; k < 2; ++k) dst[n][k] = *(const PG8_LAS bf16x8*)(lds + PG8_SB(b, h) + boff + n * 2048 + k * 1024); } while (0)
#define PG8_MMA(ai, bj, At, Bt) do { __builtin_amdgcn_s_setprio(1); _Pragma("unroll") for (int m = 0; m < 4; ++m) _Pragma("unroll") for (int n = 0; n < 2; ++n) _Pragma("unroll") for (int k = 0; k < 2; ++k) \
        acc[ai][bj][m][n] = __builtin_amdgcn_mfma_f32_16x16x32_bf16(Bt[n][k], At[m][k], acc[ai][bj][m][n], 0, 0, 0); __builtin_amdgcn_s_setprio(0); } while (0)
#ifdef DRAIN_ALL
#define PG8_WAIT_V(n) asm volatile("s_waitcnt vmcnt(0)" ::: "memory")
#else
#define PG8_WAIT_V(n) asm volatile("s_waitcnt vmcnt(" #n ")" ::: "memory")
#endif
#define PG8_WAIT_L(n) asm volatile("s_waitcnt lgkmcnt(" #n ")" ::: "memory")
#define PG8_BAR __builtin_amdgcn_s_barrier()
#define PG8_SCHED __builtin_amdgcn_sched_barrier(0)
    Unit cur, nxt; int ui = 0;
    if (!S.next(0, cur)) return;
    f32x4 acc[2][2][4][2];
#pragma unroll
    for (int a = 0; a < 2; ++a)
#pragma unroll
        for (int b = 0; b < 2; ++b)
#pragma unroll
            for (int m = 0; m < 4; ++m)
#pragma unroll
                for (int n = 0; n < 2; ++n) acc[a][b][m][n] = (f32x4){0.f, 0.f, 0.f, 0.f};
    bf16x8 At[4][2], B0[2][2], B1[2][2];
    const char* cA = (const char*)g.A + (size_t)cur.pm * tstep; const char* cB = (const char*)g.Bt + (size_t)cur.pn * tstep;
    S.a_ready(cur);
    if constexpr (SP2) {
        PG8_STAGE(PG8_SB(0, 0), cB, voffB); PG8_STAGE(PG8_SB(0, 1), cB + bhs, voffB); PG8_STAGE(PG8_SA(0, 0), cA, voffA); PG8_STAGE(PG8_SA(0, 1), cA + hstep, voffA);
        if (wr == 1) PG8_BAR;
        PG8_WAIT_V(2); PG8_BAR;
        PG8_STAGE(PG8_SB(1, 0), cB + kstep, voffB); PG8_STAGE(PG8_SA(1, 0), cA + kstep, voffA); PG8_STAGE(PG8_SB(1, 1), cB + bhs + kstep, voffB);
        PG8_WAIT_V(6); PG8_BAR;
    } else {
        PG8_STAGE(PG8_SB(0, 0), cB, voffB); PG8_STAGE(PG8_SA(0, 0), cA, voffA); PG8_STAGE(PG8_SB(0, 1), cB + bhs, voffB); PG8_STAGE(PG8_SA(0, 1), cA + hstep, voffA);
        if (wr == 1) PG8_BAR;
        PG8_WAIT_V(4); PG8_BAR;
        PG8_STAGE(PG8_SB(1, 0), cB + kstep, voffB); PG8_STAGE(PG8_SA(1, 0), cA + kstep, voffA); PG8_STAGE(PG8_SB(1, 1), cB + bhs + kstep, voffB);
        PG8_WAIT_V(6); PG8_BAR;
    }
    for (;;) {
        const bool has_next = S.next(ui + 1, nxt);
        const char* nA = has_next ? (const char*)g.A + (size_t)nxt.pm * tstep : cA; const char* nB = has_next ? (const char*)g.Bt + (size_t)nxt.pn * tstep : cB;
        for (int t = 0; t < nt; t += 2) {
            const bool last = (t == nt - 2);
            const char* a1 = cA + (size_t)(t + 1) * kstep;
            const char* a2 = last ? nA : cA + (size_t)(t + 2) * kstep; const char* b2 = last ? nB : cB + (size_t)(t + 2) * kstep;
            const char* a3 = a2 + kstep; const char* b3 = b2 + kstep;
            if (last && has_next) S.a_ready(nxt);
            if constexpr (SP2) {
            PG8_LDB(B0, 0, 0); PG8_LDB(B1, 0, 1); PG8_SCHED; PG8_LDA(At, 0, 0); PG8_STAGE(PG8_SA(1, 1), a1 + hstep, voffA);
            PG8_WAIT_V(8); PG8_WAIT_L(0); PG8_BAR; PG8_MMA(0, 0, At, B0); PG8_MMA(0, 1, At, B1); PG8_BAR; PG8_SCHED;
            PG8_LDA(At, 0, 1); PG8_STAGE(PG8_SB(0, 0), b2, voffB); PG8_STAGE(PG8_SB(0, 1), b2 + bhs, voffB); PG8_STAGE(PG8_SA(0, 0), a2, voffA);
            PG8_WAIT_V(8); PG8_WAIT_L(0); PG8_BAR; PG8_MMA(1, 0, At, B0); PG8_MMA(1, 1, At, B1); PG8_BAR; PG8_SCHED;
            PG8_LDB(B0, 1, 0); PG8_LDB(B1, 1, 1); PG8_SCHED; PG8_LDA(At, 1, 0); PG8_STAGE(PG8_SA(0, 1), a2 + hstep, voffA);
            PG8_WAIT_V(8); PG8_WAIT_L(0); PG8_BAR; PG8_MMA(0, 0, At, B0); PG8_MMA(0, 1, At, B1); PG8_BAR; PG8_SCHED;
            PG8_LDA(At, 1, 1); PG8_STAGE(PG8_SB(1, 0), b3, voffB); PG8_STAGE(PG8_SB(1, 1), b3 + bhs, voffB); PG8_STAGE(PG8_SA(1, 0), a3, voffA);
            PG8_WAIT_V(8); PG8_WAIT_L(0); PG8_BAR; PG8_MMA(1, 0, At, B0); PG8_MMA(1, 1, At, B1); PG8_BAR; PG8_SCHED;
            } else {
            PG8_LDB(B0, 0, 0); PG8_SCHED; PG8_LDA(At, 0, 0); PG8_STAGE(PG8_SA(1, 1), a1 + hstep, voffA);
            PG8_WAIT_L(8); PG8_BAR; PG8_WAIT_L(0); PG8_MMA(0, 0, At, B0); PG8_BAR; PG8_SCHED;
            PG8_LDB(B1, 0, 1); PG8_STAGE(PG8_SB(0, 0), b2, voffB);
            PG8_BAR; PG8_WAIT_L(0); PG8_MMA(0, 1, At, B1); PG8_BAR;
            PG8_LDA(At, 0, 1); PG8_STAGE(PG8_SA(0, 0), a2, voffA);
            PG8_BAR; PG8_WAIT_L(0); PG8_MMA(1, 0, At, B0); PG8_BAR; PG8_SCHED;
            PG8_STAGE(PG8_SB(0, 1), b2 + bhs, voffB);
            PG8_WAIT_V(6); PG8_BAR; PG8_MMA(1, 1, At, B1); PG8_BAR;
            PG8_LDB(B0, 1, 0); PG8_SCHED; PG8_LDA(At, 1, 0); PG8_STAGE(PG8_SA(0, 1), a2 + hstep, voffA);
            PG8_WAIT_L(8); PG8_BAR; PG8_WAIT_L(0); PG8_MMA(0, 0, At, B0); PG8_BAR; PG8_SCHED;
            PG8_LDB(B1, 1, 1); PG8_STAGE(PG8_SB(1, 0), b3, voffB);
            PG8_BAR; PG8_WAIT_L(0); PG8_MMA(0, 1, At, B1); PG8_BAR;
            PG8_LDA(At, 1, 1); PG8_STAGE(PG8_SA(1, 0), a3, voffA);
            PG8_BAR; PG8_WAIT_L(0); PG8_MMA(1, 0, At, B0); PG8_BAR; PG8_SCHED;
            PG8_STAGE(PG8_SB(1, 1), b3 + bhs, voffB);
            PG8_WAIT_V(6); PG8_BAR; PG8_MMA(1, 1, At, B1); PG8_BAR;
            }
        }
        if constexpr (ALIGN_EPI) { if (wr == 0) PG8_BAR; }
        if constexpr (!Epi::AFTER_DRAIN) { int t_ = threadIdx.x; asm volatile("" : "+v"(t_)); const int l_ = t_ & 63; E(acc, cur, wr, wc, l_ & 15, l_ >> 4); S.done(cur); }
        if (!has_next) break;
#pragma unroll
        for (int a = 0; a < 2; ++a)
#pragma unroll
            for (int b = 0; b < 2; ++b)
#pragma unroll
                for (int m = 0; m < 4; ++m)
#pragma unroll
                    for (int n = 0; n < 2; ++n) acc[a][b][m][n] = (f32x4){0.f, 0.f, 0.f, 0.f};
        cur = nxt; cA = nA; cB = nB; ++ui;
        if constexpr (ALIGN_EPI) { if (wr == 1) PG8_BAR; }
    }
    PG8_WAIT_V(0);
    if constexpr (!ALIGN_EPI) { if (wr == 0) PG8_BAR; }
    PG8_BAR;
    if constexpr (Epi::AFTER_DRAIN) { E.fused(acc, cur, wr, wc, fr, fq, lds, wid, lane); S.done(cur); }
#undef PG8_SA
#undef PG8_SB
#undef PG8_STAGE
#undef PG8_LDA
#undef PG8_LDB
#undef PG8_MMA
#undef PG8_WAIT_V
#undef PG8_WAIT_L
#undef PG8_BAR
#undef PG8_SCHED
}
}
namespace sba {
typedef short bf16x8 __attribute__((ext_vector_type(8)));
typedef short s16x4 __attribute__((ext_vector_type(4)));
typedef float f32x16 __attribute__((ext_vector_type(16)));
typedef float f32x4 __attribute__((ext_vector_type(4)));
typedef unsigned u32x4 __attribute__((ext_vector_type(4)));
typedef unsigned short bf16_t;
#define SB_LAS __attribute__((address_space(3)))
constexpr int PITCH = 512, SLOTB = 16384  , OFF_FLAGS = 2 * SLOTB, OFF_OST = OFF_FLAGS + 256, LDS_BYTES = OFF_OST + 8 * 4096;
constexpr float THR2 = 48.0f, NEGBIG = -1.0e30f;
typedef float f32x2_t __attribute__((ext_vector_type(2))); typedef __bf16 bf16x2_t __attribute__((ext_vector_type(2)));
__device__ __forceinline__ unsigned cvtpk(float lo, float hi) { f32x2_t v = {lo, hi}; bf16x2_t b = __builtin_convertvector(v, bf16x2_t); return __builtin_bit_cast(unsigned, b); }
__device__ __forceinline__ bf16x8 pack8f(float a0, float a1, float a2, float a3, float a4, float a5, float a6, float a7) {
    u32x4 w; w.x = cvtpk(a0, a1); w.y = cvtpk(a2, a3); w.z = cvtpk(a4, a5); w.w = cvtpk(a6, a7); return __builtin_bit_cast(bf16x8, w); }
typedef short v4i16_t __attribute__((ext_vector_type(4)));
__device__ __forceinline__ s16x4 vtr(const SB_LAS char* p) { return __builtin_bit_cast(s16x4, __builtin_amdgcn_ds_read_tr16_b64_v4i16((SB_LAS v4i16_t*)p)); }
__device__ __forceinline__ int crow(int r, int hi) { return (r & 3) + 8 * (r >> 2) + 4 * hi; }

template <int SUB>
__device__ __forceinline__ void sub_front(const SB_LAS char* Kslot, bool mask, int kq, const bf16x8 (&qr)[4], f32x16& w, bf16x8 (&spb)[2], int r32, int hi) {
    const SB_LAS char* kb = Kslot + hi * 1024 + r32 * 16 + SUB * 512;
    f32x16 p = {};
#pragma unroll
    for (int d0 = 0; d0 < 4; ++d0) { const bf16x8 kf = *(const SB_LAS bf16x8*)(kb + d0 * 2048); p = __builtin_amdgcn_mfma_f32_32x32x16_bf16(kf, qr[d0], p, 0, 0, 0); }
    float sp[16];
#pragma unroll
    for (int r = 0; r < 16; ++r) {
        float x = p[r];
        if (mask && (kq + 32 * SUB + (r & 3) + 8 * (r >> 2) >= 0)) x = NEGBIG;
        const float t = __builtin_amdgcn_exp2f(-__builtin_fabsf(x));
        const float l = __builtin_amdgcn_logf(1.0f + t);
        sp[r] = __builtin_fmaxf(x, 0.f) + l; w[r] = __builtin_fminf(x, 0.f) - l;
    }
    spb[0] = pack8f(sp[0], sp[1], sp[2], sp[3], sp[4], sp[5], sp[6], sp[7]);
    spb[1] = pack8f(sp[8], sp[9], sp[10], sp[11], sp[12], sp[13], sp[14], sp[15]);
}
template <int SUB>
__device__ __forceinline__ void sub_back(const SB_LAS char* vp, const f32x16& w, const f32x16& sx, f32x16 (&o)[2]) {
    float pr[16];
#pragma unroll
    for (int r = 0; r < 16; ++r) pr[r] = __builtin_amdgcn_exp2f(w[r] - sx[r]);
    bf16x8 pa[2];
    pa[0] = pack8f(pr[0], pr[1], pr[2], pr[3], pr[4], pr[5], pr[6], pr[7]);
    pa[1] = pack8f(pr[8], pr[9], pr[10], pr[11], pr[12], pr[13], pr[14], pr[15]);
#pragma unroll
    for (int d0 = 0; d0 < 2; ++d0)
#pragma unroll
        for (int s = 0; s < 2; ++s) { const int ks = 2 * SUB + s;
            const s16x4 lo = vtr(vp + d0 * 4096 + ks * 1024), hi4 = vtr(vp + d0 * 4096 + ks * 1024 + 512);
            const bf16x8 vf = (bf16x8){lo[0], lo[1], lo[2], lo[3], hi4[0], hi4[1], hi4[2], hi4[3]};
            o[d0] = __builtin_amdgcn_mfma_f32_32x32x16_bf16(pa[s], vf, o[d0], 0, 0, 0); }
}
__device__ __forceinline__ void sb_tile(const SB_LAS char* slot, bool mask, bool skip1, int kq, const bf16x8 (&qr)[4], f32x16& Rb, f32x16 (&o)[2], const bf16x8 (&Um)[2], const bf16x8 Jm, int r32, int hi, int lane) {
    const SB_LAS char* vp = slot + 8192 + ((lane >> 4) & 1) * 32 + (lane & 3) * 8 + (4 * hi + ((lane & 15) >> 2)) * 64;
    f32x16 w1, w0; bf16x8 sb1[2], sb0[2];
    f32x16 t1 = Rb;
    if (!skip1) {
    sub_front<1>(slot, mask, kq, qr, w1, sb1, r32, hi);
    f32x16 a1 = __builtin_amdgcn_mfma_f32_32x32x16_bf16(Um[0], sb1[0], Rb, 0, 0, 0); a1 = __builtin_amdgcn_mfma_f32_32x32x16_bf16(Um[1], sb1[1], a1, 0, 0, 0);
    t1 = __builtin_amdgcn_mfma_f32_32x32x16_bf16(Jm, sb1[0], Rb, 0, 0, 0); t1 = __builtin_amdgcn_mfma_f32_32x32x16_bf16(Jm, sb1[1], t1, 0, 0, 0);
    sub_back<1>(vp, w1, a1, o);
    }
    sub_front<0>(slot, mask, kq, qr, w0, sb0, r32, hi);
    f32x16 a0 = __builtin_amdgcn_mfma_f32_32x32x16_bf16(Um[0], sb0[0], t1, 0, 0, 0); a0 = __builtin_amdgcn_mfma_f32_32x32x16_bf16(Um[1], sb0[1], a0, 0, 0, 0);
    f32x16 rn = __builtin_amdgcn_mfma_f32_32x32x16_bf16(Jm, sb0[0], t1, 0, 0, 0); rn = __builtin_amdgcn_mfma_f32_32x32x16_bf16(Jm, sb0[1], rn, 0, 0, 0);
    sub_back<0>(vp, w0, a0, o);
    Rb = rn;
}
struct Tensors { const bf16_t* Q; const bf16_t* K; const bf16_t* V; bf16_t* O; const float* ck; const float* cv; };

template <bool SAMPLE>
__device__ __forceinline__ void sb_unit(int b, int h, int qb, const Tensors& T, SB_LAS char* lds) {
    int tid = threadIdx.x; asm volatile("" : "+v"(tid)); const int lane = tid & 63, r32 = lane & 31, hi = lane >> 5; const int wid = __builtin_amdgcn_readfirstlane(tid >> 6);
    const size_t rowbase = SAMPLE ? (size_t)cfg::MP + (size_t)b * 32 : (size_t)b * cfg::SEQ; const int q0 = SAMPLE ? 0 : qb * 256;
    const int jd = SAMPLE ? 16 : (q0 >> 6) + (wid >> 1), jtop = SAMPLE ? 16 : (q0 >> 6) + 3;
    const bool worker = SAMPLE ? (wid == 0) : true;
    const int wq = SAMPLE ? 0 : wid;
    const int qpos = (SAMPLE ? cfg::PAST : q0 + 32 * wq) + r32;
    volatile SB_LAS unsigned* flags = (volatile SB_LAS unsigned*)(lds + OFF_FLAGS);
    bf16x8 Um[2], Jm;
#pragma unroll
    for (int s = 0; s < 2; ++s)
#pragma unroll
        for (int jj = 0; jj < 8; ++jj) Um[s][jj] = (16 * s + 8 * (jj >> 2) + 4 * hi + (jj & 3) > r32) ? (short)0x3F80 : (short)0;
#pragma unroll
    for (int jj = 0; jj < 8; ++jj) Jm[jj] = (short)0x3F80;
    bf16x8 qr[4];
    { const bf16_t* Qw = T.Q + (rowbase + q0 + 32 * wq + r32) * PITCH + h * 64 + hi * 8;
#pragma unroll
      for (int d0 = 0; d0 < 4; ++d0) qr[d0] = *(const bf16x8*)(Qw + d0 * 16); }
    f32x16 Rb = {}, o[2]; o[0] = f32x16{}; o[1] = f32x16{};
    bool done = false;
    u32x4 kreg, vreg;
    const int vkey = 16 * (wid & 3) + (lane >> 2), vcol = (wid >> 2) * 32 + (lane & 3) * 8;
#define SB_LOAD(j) do { \
        if (!SAMPLE) { kreg = *(const u32x4*)(T.K + (rowbase + (size_t)(64 * (j) + lane)) * PITCH + h * 64 + wid * 8); vreg = *(const u32x4*)(T.V + (rowbase + (size_t)(64 * (j) + vkey)) * PITCH + h * 64 + vcol); } \
        else if ((j) == 16) { const int kr_ = lane < 31 ? lane : 31, vr_ = vkey < 31 ? vkey : 31; \
            kreg = *(const u32x4*)(T.K + (rowbase + kr_) * PITCH + h * 64 + wid * 8); vreg = *(const u32x4*)(T.V + (rowbase + vr_) * PITCH + h * 64 + vcol); } \
        else { const float* kp_ = T.ck + ((size_t)b * cfg::PAST + 64 * (j) + lane) * PITCH + h * 64 + wid * 8; const float* vp_ = T.cv + ((size_t)b * cfg::PAST + 64 * (j) + vkey) * PITCH + h * 64 + vcol; \
            const f32x4 k0_ = *(const f32x4*)kp_, k1_ = *(const f32x4*)(kp_ + 4), v0_ = *(const f32x4*)vp_, v1_ = *(const f32x4*)(vp_ + 4); \
            kreg = (u32x4){cvtpk(k0_[0], k0_[1]), cvtpk(k0_[2], k0_[3]), cvtpk(k1_[0], k1_[1]), cvtpk(k1_[2], k1_[3])}; vreg = (u32x4){cvtpk(v0_[0], v0_[1]), cvtpk(v0_[2], v0_[3]), cvtpk(v1_[0], v1_[1]), cvtpk(v1_[2], v1_[3])}; } } while (0)
    SB_LOAD(jtop);
    for (int j = jtop; j >= 0; --j) {
        SB_LAS char* slot = lds + (j & 1) * SLOTB;
        *(SB_LAS u32x4*)(slot + wid * 1024 + lane * 16) = kreg; *(SB_LAS u32x4*)(slot + 8192 + wid * 1024 + lane * 16) = vreg;
        __syncthreads();
        if (j != jtop) { const volatile SB_LAS unsigned* f = flags + ((j + 1) & 1) * 8; unsigned all = 1u;
#pragma unroll
            for (int w8 = 0; w8 < 8; ++w8) all &= f[w8];
            if (all) break; }
        if (j > 0) SB_LOAD(j - 1);
        if (worker && !done && j <= jd) {
            const int key0 = (SAMPLE && j == 16) ? cfg::PAST : 64 * j;
            sb_tile(slot, j == jd, (j == jd) && (SAMPLE || (wid & 1) == 0), key0 + 4 * hi - qpos, qr, Rb, o, Um, Jm, r32, hi, lane);
            done = __all(Rb[0] > THR2) != 0;
        }
        if (lane == 0) flags[(j & 1) * 8 + wid] = (done || !worker) ? 1u : 0u;
    }
#undef SB_LOAD
    if (worker) {
        SB_LAS bf16_t* stg = (SB_LAS bf16_t*)(lds + OFF_OST) + wid * 2048;
#pragma unroll
        for (int r = 0; r < 16; ++r) { const int orow = crow(r, hi);
#pragma unroll
            for (int d0 = 0; d0 < 2; ++d0) stg[orow * 64 + d0 * 32 + r32] = (bf16_t)(cvtpk(o[d0][r], 0.f) & 0xffffu); }
        asm volatile("s_waitcnt lgkmcnt(0)" ::: "memory");
        bf16_t* Ow = T.O + (rowbase + q0 + 32 * wq) * PITCH + h * 64;
#pragma unroll
        for (int i = 0; i < 4; ++i) { const int row = i * 8 + (lane >> 3), ch = lane & 7; const u32x4 v = *(const SB_LAS u32x4*)(stg + row * 64 + ch * 8); *(u32x4*)(Ow + (size_t)row * PITCH + ch * 8) = v; }
    }
    __syncthreads();
}
}
namespace sk {
typedef short bf16x8 __attribute__((ext_vector_type(8)));
typedef float f32x16 __attribute__((ext_vector_type(16)));
typedef float f32x4 __attribute__((ext_vector_type(4)));
typedef unsigned short bf16_t;
#define SK_LAS __attribute__((address_space(3)))
constexpr int PLD = 36;
constexpr int LDS_BYTES = 8 * 2 * 32 * PLD * 4;
__device__ __forceinline__ f32x4 tile(const bf16_t* A, const bf16_t* Bt, int K, size_t arow0, int col0, SK_LAS char* lds) {
    int tid = threadIdx.x; asm volatile("" : "+v"(tid)); const int lane = tid & 63, r32 = lane & 31, hi = lane >> 5; const int wid = __builtin_amdgcn_readfirstlane(tid >> 6);
    const int nsplit = (K >= 512) ? 8 : (K >> 6), ks = K / nsplit;
    const bf16_t* ap = A + (arow0 + r32) * K + wid * ks + hi * 32;
    const bf16_t* bp0 = Bt + (size_t)(col0 + r32) * K + wid * ks + hi * 32; const bf16_t* bp1 = bp0 + (size_t)32 * K;
    f32x16 acc0 = {}, acc1 = {};
#pragma unroll 2
    for (int s = 0; s < ((wid < nsplit) ? ks : 0); s += 64) {
        bf16x8 a[4], b0[4], b1[4];
#pragma unroll
        for (int j = 0; j < 4; ++j) { a[j] = *(const bf16x8*)(ap + s + 8 * j); b0[j] = *(const bf16x8*)(bp0 + s + 8 * j); b1[j] = *(const bf16x8*)(bp1 + s + 8 * j); }
#pragma unroll
        for (int j = 0; j < 4; ++j) {
            acc0 = __builtin_amdgcn_mfma_f32_32x32x16_bf16(b0[j], a[j], acc0, 0, 0, 0);
            acc1 = __builtin_amdgcn_mfma_f32_32x32x16_bf16(b1[j], a[j], acc1, 0, 0, 0); }
    }
    SK_LAS float* P0 = (SK_LAS float*)lds + ((wid * 2 + 0) * 32 + r32) * PLD + 4 * hi; SK_LAS float* P1 = P0 + 32 * PLD;
#pragma unroll
    for (int g = 0; g < 4; ++g) { *(SK_LAS f32x4*)(P0 + 8 * g) = (f32x4){acc0[4 * g], acc0[4 * g + 1], acc0[4 * g + 2], acc0[4 * g + 3]};
                                  *(SK_LAS f32x4*)(P1 + 8 * g) = (f32x4){acc1[4 * g], acc1[4 * g + 1], acc1[4 * g + 2], acc1[4 * g + 3]}; }
    __syncthreads();
    const int row = tid >> 4, c = (tid & 15) * 4, cb = c >> 5, cc = c & 31;
    f32x4 s = {0.f, 0.f, 0.f, 0.f};
#pragma unroll
    for (int w = 0; w < 8; ++w) s += *(const SK_LAS f32x4*)((SK_LAS float*)lds + ((w * 2 + cb) * 32 + row) * PLD + cc);
    __syncthreads();
    return s;
}
__device__ __forceinline__ void tile4(const bf16_t* A, const bf16_t* Bt, int K, size_t arow0, int col0, SK_LAS char* lds, f32x4 (&out)[2][2]) {
    int tid = threadIdx.x; asm volatile("" : "+v"(tid)); const int lane = tid & 63, r32 = lane & 31, hi = lane >> 5; const int wid = __builtin_amdgcn_readfirstlane(tid >> 6);
    const int half = wid >> 2, kq = wid & 3, ks = K >> 2;
    const bf16_t* ap = A + (arow0 + r32) * K + kq * ks + hi * 32;
    const bf16_t* bp = Bt + (size_t)(col0 + half * 128 + r32) * K + kq * ks + hi * 32;
    f32x16 acc[4]; acc[0] = f32x16{}; acc[1] = f32x16{}; acc[2] = f32x16{}; acc[3] = f32x16{};
#pragma unroll 1
    for (int s = 0; s < ks; s += 64) {
        bf16x8 a[4], b[4][4];
#pragma unroll
        for (int e = 0; e < 4; ++e) { a[e] = *(const bf16x8*)(ap + s + 8 * e);
#pragma unroll
            for (int j = 0; j < 4; ++j) b[j][e] = *(const bf16x8*)(bp + (size_t)(32 * j) * K + s + 8 * e); }
#pragma unroll
        for (int e = 0; e < 4; ++e)
#pragma unroll
            for (int j = 0; j < 4; ++j) acc[j] = __builtin_amdgcn_mfma_f32_32x32x16_bf16(b[j][e], a[e], acc[j], 0, 0, 0);
    }
    const int row = tid >> 4, cc = (tid & 15) * 4;
#pragma unroll
    for (int q = 0; q < 2; ++q) {
        SK_LAS float* P0 = (SK_LAS float*)lds + ((wid * 2 + 0) * 32 + r32) * PLD + 4 * hi; SK_LAS float* P1 = P0 + 32 * PLD;
#pragma unroll
        for (int g = 0; g < 4; ++g) { *(SK_LAS f32x4*)(P0 + 8 * g) = (f32x4){acc[2 * q][4 * g], acc[2 * q][4 * g + 1], acc[2 * q][4 * g + 2], acc[2 * q][4 * g + 3]};
                                      *(SK_LAS f32x4*)(P1 + 8 * g) = (f32x4){acc[2 * q + 1][4 * g], acc[2 * q + 1][4 * g + 1], acc[2 * q + 1][4 * g + 2], acc[2 * q + 1][4 * g + 3]}; }
        __syncthreads();
#pragma unroll
        for (int h = 0; h < 2; ++h) { f32x4 sum = {0.f, 0.f, 0.f, 0.f};
#pragma unroll
            for (int w = 0; w < 4; ++w) sum += *(const SK_LAS f32x4*)((SK_LAS float*)lds + (((h * 4 + w) * 2 + (cc >> 5)) * 32 + row) * PLD + (cc & 31));
            out[h][q] = sum; }
        __syncthreads();
    }
}
__device__ __forceinline__ float sum16(float v) { v += __shfl_xor(v, 1); v += __shfl_xor(v, 2); v += __shfl_xor(v, 4); v += __shfl_xor(v, 8); return v; }
__device__ __forceinline__ float rstd16(const float* SSQ, int r, int t) { return __builtin_amdgcn_rsqf(sum16(SSQ[(size_t)r * 16 + (t & 15)]) * (1.0f / 1024.0f) + cfg::EPS); }
__device__ __forceinline__ unsigned long long pk4(f32x4 v) { return (unsigned long long)pg8::cvt_pk_bf16(v[0], v[1]) | ((unsigned long long)pg8::cvt_pk_bf16(v[2], v[3]) << 32); }
__device__ __forceinline__ f32x4 up4(unsigned long long w) { const unsigned lo = (unsigned)w, hi = (unsigned)(w >> 32); return (f32x4){pg8::bf_lo(lo), pg8::bf_hi(lo), pg8::bf_lo(hi), pg8::bf_hi(hi)}; }
}
#define GAS __attribute__((address_space(1)))
#define LAS __attribute__((address_space(3)))
typedef unsigned short bf16;
typedef unsigned v4u __attribute__((ext_vector_type(4)));
typedef float f32x4 __attribute__((ext_vector_type(4)));
typedef short bf16x8 __attribute__((ext_vector_type(8)));
typedef GAS unsigned gu32;
typedef GAS unsigned long long gu64;
#define RLX_AGENT __ATOMIC_RELAXED, __HIP_MEMORY_SCOPE_AGENT
#define LDS_WAIT() asm volatile("s_waitcnt lgkmcnt(0)" ::: "memory")
#define VM_WAIT() asm volatile("s_waitcnt vmcnt(0)" ::: "memory")
__device__ __forceinline__ unsigned long long rt() { return __builtin_amdgcn_s_memrealtime(); }
__device__ __forceinline__ unsigned f2bf(float f) { unsigned u = __builtin_bit_cast(unsigned, f); return (u + 0x7fffu + ((u >> 16) & 1u)) >> 16; }
__device__ __forceinline__ unsigned pk2(float lo, float hi) { return f2bf(lo) | (f2bf(hi) << 16); }
#define XB_TMO      128
#define XB_XCNT(j)  (256  + 64 * (j))
#define XB_XSUB(j)  (1280 + 64 * (j))
#define XB_XGEN(j)  (2304 + 64 * (j))
#define XB_TOP      3328
#define XB_TOPGEN   3392
#define XCD_BAR_WORDS 3456
#define XB_SPIN_CAP (1u << 18)

__device__ __forceinline__ unsigned xb_ld(unsigned* p)              { return __hip_atomic_load(p, __ATOMIC_RELAXED, __HIP_MEMORY_SCOPE_AGENT); }
__device__ __forceinline__ unsigned xb_add(unsigned* p, unsigned v) { return __hip_atomic_fetch_add(p, v, __ATOMIC_RELAXED, __HIP_MEMORY_SCOPE_AGENT); }
__device__ __forceinline__ unsigned xb_xcc_id() { return (unsigned)__builtin_amdgcn_s_getreg((3 << 11) | 20) & 0xFu; }
#define XB_SPIN(cond, bar) do { unsigned _sp = 0; while (cond) { __builtin_amdgcn_s_sleep(1); \
    if ((++_sp & 255u) == 0u) { if (xb_ld(&(bar)[XB_TMO])) break; if (_sp > XB_SPIN_CAP) { atomicAdd(&(bar)[XB_TMO], 1u); break; } } } } while (0)

struct XcdBarrier {
    unsigned* bar; unsigned x;
    volatile LAS unsigned* st;
};

__device__ __forceinline__ XcdBarrier xcd_barrier_post(unsigned* bar, volatile LAS unsigned* st) {
    XcdBarrier b; b.bar = bar; b.x = xb_xcc_id(); b.st = st;
    if (threadIdx.x == 0) (void)xb_add(&bar[XB_XCNT(b.x)], 1u);
    return b;
}
__device__ __forceinline__ void xcd_barrier_complete(unsigned* bar, unsigned x, unsigned& nloc, unsigned& nx) {
    const unsigned G = gridDim.x * gridDim.y * gridDim.z;
    unsigned sum, cnt, mine, sp = 0u;
    for (;;) {
        sum = 0u; cnt = 0u; mine = 0u;
#pragma unroll
        for (unsigned j = 0; j < 16; ++j) { const unsigned c = xb_ld(&bar[XB_XCNT(j)]); sum += c; cnt += (c > 0u) ? 1u : 0u; mine = (j == x) ? c : mine; }
        if (sum == G) break;
        __builtin_amdgcn_s_sleep(1);
        if ((++sp & 255u) == 0u) { if (xb_ld(&bar[XB_TMO])) break; if (sp > XB_SPIN_CAP) { atomicAdd(&bar[XB_TMO], 1u); break; } }
    }
    nloc = mine > 0u ? mine : 1u; nx = cnt > 0u ? cnt : 1u;
}

__device__ __forceinline__ void xcd_barrier(const XcdBarrier& b) {
    asm volatile("s_waitcnt vmcnt(0)" ::: "memory");
    __syncthreads();
    if (threadIdx.x == 0) {
        unsigned* bar = b.bar;
        __builtin_amdgcn_s_waitcnt(0);
        unsigned nloc = b.st[0], nx = b.st[1];
        if (nloc == 0u) { xcd_barrier_complete(bar, b.x, nloc, nx); b.st[0] = nloc; b.st[1] = nx; }
        const unsigned old = xb_add(&bar[XB_XSUB(b.x)], 1u);
        const unsigned gen = old / nloc;
        if (old + 1u == (gen + 1u) * nloc) {
            __builtin_amdgcn_fence(__ATOMIC_RELEASE, "agent");
            asm volatile("s_waitcnt vmcnt(0)" ::: "memory");
            const unsigned og = xb_add(&bar[XB_TOP], 1u);
            const unsigned tg = og / nx;
            if (og + 1u == (tg + 1u) * nx) xb_add(&bar[XB_TOPGEN], 1u);
            else XB_SPIN(xb_ld(&bar[XB_TOPGEN]) == tg, bar);
            __builtin_amdgcn_fence(__ATOMIC_ACQUIRE, "agent");
            xb_add(&bar[XB_XGEN(b.x)], 1u);
            asm volatile("s_waitcnt vmcnt(0)" ::: "memory");
        } else {
            XB_SPIN(xb_ld(&bar[XB_XGEN(b.x)]) == gen, bar);
            __builtin_amdgcn_fence(__ATOMIC_ACQUIRE, "agent");
            asm volatile("s_waitcnt vmcnt(0)" ::: "memory");
        }
    }
    __syncthreads();
}
__device__ __forceinline__ float wave_sum(float v) {
#pragma unroll
    for (int o = 1; o < 64; o <<= 1) v += __shfl_xor(v, o);
    return v;
}
__device__ __forceinline__ void p0_transpose_item(const float* W, int K, int N, bf16* WT, int row_off, LAS float* scr, int item, int lane) {
    const int nblk = N / 32, kb = item / nblk, nb = item % nblk, k0 = 64 * kb, n0 = 32 * nb;
    float tv[32];
#pragma unroll
    for (int i = 0; i < 32; ++i) { const int kk = 2 * i + (lane >> 5); tv[i] = W[(size_t)(k0 + kk) * N + n0 + (lane & 31)]; }
#pragma unroll
    for (int i = 0; i < 32; ++i) { const int kk = 2 * i + (lane >> 5); scr[kk * 33 + (lane & 31)] = tv[i]; }
    LDS_WAIT(); asm volatile("" ::: "memory");
    const int c = lane & 7;
#pragma unroll
    for (int j = 0; j < 4; ++j) { const int n = (lane >> 3) + 8 * j; const LAS float* s = scr + (8 * c) * 33 + n;
        v4u o; o.x = pk2(s[0 * 33], s[1 * 33]); o.y = pk2(s[2 * 33], s[3 * 33]); o.z = pk2(s[4 * 33], s[5 * 33]); o.w = pk2(s[6 * 33], s[7 * 33]);
        *(GAS v4u*)(WT + (size_t)(row_off + n0 + n) * K + k0 + 8 * c) = o; }
    LDS_WAIT(); asm volatile("" ::: "memory");
}
constexpr int NWAVES = 8;
#ifndef MK_N_LAUNCHES
#define MK_N_LAUNCHES 1
#endif
constexpr int N_PHASES = 8;
#ifndef DBG_ROT
#define DBG_ROT 0
#endif
#ifndef DBG_REPEAT
#define DBG_REPEAT -1
#endif
#ifndef DBG_P2PART
#define DBG_P2PART 0
#endif
#ifndef DBG_ALIGN
#define DBG_ALIGN false
#endif
#ifndef DBG_SP2
#define DBG_SP2 true
#endif
using namespace cfg;
constexpr size_t MiB = 1u << 20;
constexpr size_t WS_CTL = 0, CTL_ZERO_BYTES = 1 * MiB;
constexpr size_t WS_WIN = 2 * MiB, WS_WEFF = 10 * MiB, WS_WSB = 11 * MiB, WS_WOUT = 12 * MiB, WS_WUP = 14 * MiB, WS_WDOWN = 22 * MiB, WS_WPG = 30 * MiB, WS_WPP = 32 * MiB;
constexpr size_t WS_SSQ1 = 33 * MiB, WS_SSQ2 = 35 * MiB, WS_SSQ3 = 37 * MiB;
constexpr size_t WS_PB = 40 * MiB;
constexpr size_t WS_XN = 49 * MiB;
constexpr size_t WS_BIG = 82 * MiB;
constexpr size_t WS_U = WS_BIG, WS_Q = WS_BIG + 16 * MiB + MiB / 2, WS_K = WS_BIG + 33 * MiB, WS_V = WS_BIG + 49 * MiB + MiB / 2;
constexpr size_t WS_G = WS_BIG + 66 * MiB;
constexpr size_t WS_Y = WS_BIG + 132 * MiB, WS_YSB = WS_Y + 16 * MiB + MiB / 2;
constexpr size_t WS_MG = WS_BIG;
constexpr size_t WS_H = WS_BIG;
constexpr size_t WS_PP = WS_BIG;
constexpr size_t WS_X = WS_Y;
constexpr size_t WS_END = WS_BIG + 165 * MiB;
static_assert((size_t)MT * 512 * 2 == 16 * MiB + MiB / 2 && (size_t)MT * 1024 * 2 == 33 * MiB && (size_t)MT * 16 * 4 <= 2 * MiB && (size_t)MT * 256 * 2 <= 9 * MiB && WS_END <= 256 * MiB, "d_ws map");
constexpr int CW_BAR = 4096, CW_FIN = 8192  , CW_FINS = 16384  ;
constexpr size_t O_Y = 0, O_KP = 17301504, O_VP = 25690112, O_POOLP = 34078720, O_KS = 34140160, O_VS = 34402304, O_POOLS = 34664448, O_END = 34787328;
constexpr int RING_OFF = 0, RING_BYTES = 131072, LDSCTL_OFF = RING_BYTES, MISC_OFF = LDSCTL_OFF + 320, LDS_BYTES = 147456;
static_assert(sk::LDS_BYTES <= RING_BYTES && sba::LDS_BYTES <= RING_BYTES, "attention scratch fits the ring region");

struct Args { const float* in[22]; float* out; unsigned char* ws; int ph_lo, ph_hi, li, pad; };

__device__ __forceinline__ void rms_rows_to_bf16(const float* xrow0, const float* xrow1, const float* g, bf16* orow0, bf16* orow1, int lane) {
    const GAS f32x4* xr0 = (const GAS f32x4*)xrow0 + lane; const GAS f32x4* xr1 = (const GAS f32x4*)(xrow1 ? xrow1 : xrow0) + lane; const GAS f32x4* gr = (const GAS f32x4*)g + lane;
    f32x4 v[4], w[4], gg[4]; float s = 0.f, t = 0.f;
#pragma unroll
    for (int j = 0; j < 4; ++j) { v[j] = xr0[64 * j]; w[j] = xr1[64 * j]; gg[j] = gr[64 * j]; }
#pragma unroll
    for (int j = 0; j < 4; ++j) { s += (v[j].x * v[j].x + v[j].y * v[j].y) + (v[j].z * v[j].z + v[j].w * v[j].w); t += (w[j].x * w[j].x + w[j].y * w[j].y) + (w[j].z * w[j].z + w[j].w * w[j].w); }
#pragma unroll
    for (int o = 1; o < 64; o <<= 1) { s += __shfl_xor(s, o); t += __shfl_xor(t, o); }
    const float rs = 1.f / sqrtf(s * (1.f / DM) + EPS), rt = 1.f / sqrtf(t * (1.f / DM) + EPS);
    GAS unsigned long long* o0 = (GAS unsigned long long*)orow0 + lane; GAS unsigned long long* o1 = (GAS unsigned long long*)orow1 + lane;
#pragma unroll
    for (int j = 0; j < 4; ++j) { o0[64 * j] = (unsigned long long)pk2(v[j].x * rs * gg[j].x, v[j].y * rs * gg[j].y) | ((unsigned long long)pk2(v[j].z * rs * gg[j].z, v[j].w * rs * gg[j].w) << 32);
        if (xrow1) o1[64 * j] = (unsigned long long)pk2(w[j].x * rt * gg[j].x, w[j].y * rt * gg[j].y) | ((unsigned long long)pk2(w[j].z * rt * gg[j].z, w[j].w * rt * gg[j].w) << 32); }
}
__device__ __forceinline__ void weff_item(const float* wgrp, const float* scale, const float* wpu, bf16* WT, int item, int lane) {
    const int nb = item & 15, cb = (item >> 4) & 15, g = item >> 8, n = nb * 64 + lane;
    float wg[8][2];
#pragma unroll
    for (int cc = 0; cc < 8; ++cc)
#pragma unroll
        for (int hh = 0; hh < 2; ++hh) wg[cc][hh] = wgrp[((size_t)(g * 128 + cb * 8 + cc)) * 128 + lane + 64 * hh] * scale[g * 128 + lane + 64 * hh];
    float acc[8];
#pragma unroll
    for (int cc = 0; cc < 8; ++cc) acc[cc] = 0.f;
#pragma unroll
    for (int hh = 0; hh < 2; ++hh)
#pragma unroll 16
        for (int d2 = 0; d2 < 64; ++d2) { const float wv = wpu[(size_t)(g * 128 + hh * 64 + d2) * 1024 + n];
#pragma unroll
            for (int cc = 0; cc < 8; ++cc) acc[cc] = fmaf(__builtin_bit_cast(float, __builtin_amdgcn_readlane(__builtin_bit_cast(int, wg[cc][hh]), d2)), wv, acc[cc]); }
    v4u o; o.x = pk2(acc[0], acc[1]); o.y = pk2(acc[2], acc[3]); o.z = pk2(acc[4], acc[5]); o.w = pk2(acc[6], acc[7]);
    *(GAS v4u*)(WT + (size_t)n * 512 + g * 128 + cb * 8) = o;
}

template <int W, int R>
__device__ __forceinline__ void pool_run(const bf16* Ub, const float* state_pool, bf16* Yb, int run, int c) {
    const int r0 = run * R; const bool sample = r0 >= MP; const int t0 = sample ? ((r0 - MP) & 31) : (r0 & (SEQ - 1)); const int b_ = sample ? ((r0 - MP) >> 5) : 0;
    v4u rw[R - 1 + W];
#pragma unroll
    for (int k = 0; k < W - 1; ++k) { const int pos = t0 + k - (W - 1);
        if (pos >= 0) rw[k] = *(const GAS v4u*)(Ub + (size_t)(r0 - (W - 1) + k) * 512 + c);
        else if (sample) { const float* sp = state_pool + ((size_t)b_ * 15 + 15 + pos) * 512 + c; const f32x4 a = *(const GAS f32x4*)sp, b = *(const GAS f32x4*)(sp + 4); rw[k] = pg8::pack8(a, b); }
        else rw[k] = (v4u){0u, 0u, 0u, 0u}; }
#pragma unroll
    for (int k = W - 1; k < R - 1 + W; ++k) rw[k] = *(const GAS v4u*)(Ub + (size_t)(r0 - (W - 1) + k) * 512 + c);
    f32x4 s0 = {0.f, 0.f, 0.f, 0.f}, s1 = {0.f, 0.f, 0.f, 0.f};
#pragma unroll
    for (int k = 0; k < W - 1; ++k) { f32x4 a, b; pg8::unpack8(rw[k], a, b); s0 += a; s1 += b; }
#pragma unroll
    for (int i = 0; i < R; ++i) { f32x4 a, b, u0, u1; pg8::unpack8(rw[W - 1 + i], u0, u1); s0 += u0; s1 += u1;
        const int cnt = sample ? W : ((t0 + i + 1 < W) ? t0 + i + 1 : W); const float ic = 1.0f / (float)cnt;
        *(GAS v4u*)(Yb + (size_t)(r0 + i) * 512 + c) = pg8::pack8(s0 * ic - u0, s1 * ic - u1);
        pg8::unpack8(rw[i], a, b); s0 -= a; s1 -= b; }
}
#if defined(HYB_ATTN) || defined(HYB_POOL)
__device__ __forceinline__ float hb2f(unsigned short v) { return __uint_as_float((unsigned)v << 16); }
__global__ void __launch_bounds__(64) hyb_attn(const unsigned short* Qb, const unsigned short* Kb, const unsigned short* Vb, const float* ck, const float* cv, unsigned short* YSB) {
    const int idx = blockIdx.x * 64 + threadIdx.x; if (idx >= MT * NH) return;
    const int h = idx / MT, m = idx % MT;
    float qr[HD], o[HD];
#pragma unroll
    for (int d = 0; d < HD; ++d) { qr[d] = hb2f(Qb[(size_t)m * 512 + h * HD + d]) * 0.6931471805599453f; o[d] = 0.f; }
    float S = 0.f; bool done = false; size_t kb; int nk;
    if (m < MP) { kb = (size_t)(m / SEQ) * SEQ; nk = m % SEQ; } else { const int ms = m - MP; kb = (size_t)MP + (size_t)(ms / DS) * DS; nk = ms % DS; }
    for (int s = nk - 1; s >= 0 && !done; --s) {
        const unsigned short* kr = Kb + (kb + s) * 512 + h * HD; const unsigned short* vr = Vb + (kb + s) * 512 + h * HD; float z = 0.f;
#pragma unroll
        for (int d = 0; d < HD; ++d) z = fmaf(qr[d], hb2f(kr[d]), z);
        const float sp = fmaxf(z, 0.f) + log1pf(expf(-fabsf(z))), a = expf(z - sp - S);
#pragma unroll
        for (int d = 0; d < HD; ++d) o[d] = fmaf(a, hb2f(vr[d]), o[d]);
        S += sp; if (S > 110.f) done = true;
    }
    if (m >= MP) { const int b = (m - MP) / DS; const float* kc = ck + (size_t)b * PAST * 512 + h * HD; const float* vc = cv + (size_t)b * PAST * 512 + h * HD;
        for (int s = PAST - 1; s >= 0 && !done; --s) {
            const float* kr = kc + (size_t)s * 512; const float* vr = vc + (size_t)s * 512; float z = 0.f;
#pragma unroll
            for (int d = 0; d < HD; ++d) z = fmaf(qr[d], kr[d], z);
            const float sp = fmaxf(z, 0.f) + log1pf(expf(-fabsf(z))), a = expf(z - sp - S);
#pragma unroll
            for (int d = 0; d < HD; ++d) o[d] = fmaf(a, vr[d], o[d]);
            S += sp; if (S > 110.f) done = true;
        } }
#pragma unroll
    for (int d = 0; d < HD; ++d) YSB[(size_t)m * 512 + h * HD + d] = (unsigned short)f2bf(o[d]);
}
__global__ void hyb_pool(const unsigned short* Ub, const float* state_pool, unsigned short* Yb) {
    const size_t i = (size_t)blockIdx.x * blockDim.x + threadIdx.x; if (i >= (size_t)MT * PW) return;
    const int m = (int)(i / PW), c = (int)(i % PW), g = c / 128, w = 2 << g;
    float s = 0.f; float cnt;
    if (m < MP) { const int t = m % SEQ; const int n = (t + 1 < w) ? t + 1 : w; for (int j = 0; j < n; ++j) s += hb2f(Ub[(size_t)(m - j) * PW + c]); cnt = (float)n; }
    else { const int ms = m - MP, b = ms / DS, t = ms % DS; for (int j = 0; j < w; ++j) { const int r = 15 + t - j; s += (r >= 15) ? hb2f(Ub[(size_t)(m - j) * PW + c]) : state_pool[((size_t)b * 15 + r) * PW + c]; } cnt = (float)w; }
    Yb[i] = (unsigned short)f2bf(s / cnt - hb2f(Ub[i]));
}
#endif

__global__ void __launch_bounds__(NWAVES * 64, 2) mega_fwd(Args args) {
    extern __shared__ __attribute__((aligned(16))) unsigned char lds[];
    LAS unsigned char* L = (LAS unsigned char*)lds;
    volatile LAS unsigned* MISC = (volatile LAS unsigned*)(L + MISC_OFF);
    const int wave = __builtin_amdgcn_readfirstlane(threadIdx.x >> 6);
#define FRESH_TID() int tid = threadIdx.x; asm volatile("" : "+v"(tid)); const int lane = tid & 63; (void)lane
    const int G = gridDim.x, bx = blockIdx.x, vcu = (G % 8 == 0) ? (bx % 8) * (G / 8) + bx / 8 : bx;
    unsigned char* ws = args.ws;
    gu32* ctl = (gu32*)(ws + WS_CTL);
    const float* x_p = args.in[0]; const float* x_s = args.in[1]; const float* cache_k = args.in[2]; const float* cache_v = args.in[3]; const float* state_pool = args.in[4];
    const float* p_p = args.in[5]; const float* p_s = args.in[6]; const float* g_mix = args.in[7]; const float* w_in = args.in[8]; const float* b_gate = args.in[9]; const float* w_grp = args.in[10];
    const float* pool_scale = args.in[11]; const float* w_pool_up = args.in[12]; const float* w_sb_up = args.in[13]; const float* w_out = args.in[14]; const float* g_mlp = args.in[15];
    const float* w_up = args.in[16]; const float* w_down = args.in[17]; const float* g_ple = args.in[18]; const float* w_ple_gate = args.in[19]; const float* w_ple_proj = args.in[20]; const float* g_final = args.in[21];
    float* out = args.out; float* Yo = out + O_Y;
    bf16 *WIN = (bf16*)(ws + WS_WIN), *WEFF = (bf16*)(ws + WS_WEFF), *WSB = (bf16*)(ws + WS_WSB), *WOUT = (bf16*)(ws + WS_WOUT), *WUP = (bf16*)(ws + WS_WUP), *WDOWN = (bf16*)(ws + WS_WDOWN), *WPG = (bf16*)(ws + WS_WPG), *WPP = (bf16*)(ws + WS_WPP);
    float *SSQ1 = (float*)(ws + WS_SSQ1), *SSQ2 = (float*)(ws + WS_SSQ2), *SSQ3 = (float*)(ws + WS_SSQ3);
    bf16 *PB = (bf16*)(ws + WS_PB), *XN = (bf16*)(ws + WS_XN), *Ub = (bf16*)(ws + WS_U), *Qb = (bf16*)(ws + WS_Q), *Kb = (bf16*)(ws + WS_K), *Vb = (bf16*)(ws + WS_V), *Gb = (bf16*)(ws + WS_G);
    bf16 *Yb = (bf16*)(ws + WS_Y), *YSB = (bf16*)(ws + WS_YSB), *MG = (bf16*)(ws + WS_MG), *Hb = (bf16*)(ws + WS_H), *PPb = (bf16*)(ws + WS_PP), *Xb = (bf16*)(ws + WS_X);

    for (int i = threadIdx.x; i < (LDS_BYTES - LDSCTL_OFF) / 4; i += NWAVES * 64) ((LAS unsigned*)(L + LDSCTL_OFF))[i] = 0u;
    __syncthreads();
    XcdBarrier bar; bar.bar = (unsigned*)(ctl + CW_BAR); bar.x = 0; bar.st = nullptr;
    if (MK_N_LAUNCHES == 1) bar = xcd_barrier_post((unsigned*)(ctl + CW_BAR), MISC + 8);
    const int lo = args.ph_lo, hi = args.ph_hi;
#define IN(k) (lo <= (k) && (k) < hi)
#ifdef DBG_BARCHK
#define SEAM(k) do { if (IN(k) && IN((k) + 1)) { if (threadIdx.x == 0) __hip_atomic_fetch_add((unsigned*)(ctl + 65536 + 64 * (k)), 1u, __ATOMIC_RELAXED, __HIP_MEMORY_SCOPE_AGENT); xcd_barrier(bar); \
    if (threadIdx.x == 0) { const unsigned v_ = __hip_atomic_load((unsigned*)(ctl + 65536 + 64 * (k)), __ATOMIC_RELAXED, __HIP_MEMORY_SCOPE_AGENT); if (v_ != (unsigned)G) { __hip_atomic_store((unsigned*)(ctl + 65536 + 64 * 32), 1u, __ATOMIC_RELAXED, __HIP_MEMORY_SCOPE_AGENT); out[O_KP + (k)] = __builtin_nanf(""); } } } } while (0)
#else
#define SEAM(k) do { if (IN(k) && IN((k) + 1)) xcd_barrier(bar); } while (0)
#endif
    const int gw = vcu * NWAVES + wave, NGW = G * NWAVES;
    const bool late_ = (vcu & 1) != 0;

#pragma unroll 1
    for (int rep_ = 0; rep_ < ((IN(0)) ? ((DBG_REPEAT == 0) ? 2 : 1) : 0); ++rep_) {
        if (rep_ > 0) xcd_barrier(bar);
        FRESH_TID();
        LAS float* scr = (LAS float*)(L + RING_OFF + wave * 16384);
        constexpr int I_IN = (DM / 64) * (INW / 32), I_SB = (SBW / 64) * (DM / 32), I_OUT = (DM / 64) * (DM / 32), I_UP = (DM / 64) * (DFF / 32), I_DOWN = (DFF / 64) * (DM / 32), I_PG = I_OUT, I_PP = (PLE / 64) * (DM / 32), I_EFF = 4 * 16 * 16;
        constexpr int NITEMS = I_IN + I_SB + I_OUT + I_UP + I_DOWN + I_PG + I_PP + I_EFF;
        for (int it = gw; it < NITEMS; it += NGW) {
            int r = it;
            if (r < I_EFF) { weff_item(w_grp, pool_scale, w_pool_up, WEFF, r, lane); continue; } r -= I_EFF;
            if (r < I_IN) { p0_transpose_item(w_in, DM, INW, WIN, 0, scr, r, lane); continue; } r -= I_IN;
            if (r < I_SB) { p0_transpose_item(w_sb_up, SBW, DM, WSB, 0, scr, r, lane); continue; } r -= I_SB;
            if (r < I_OUT) { p0_transpose_item(w_out, DM, DM, WOUT, 0, scr, r, lane); continue; } r -= I_OUT;
            if (r < I_UP) { p0_transpose_item(w_up, DM, DFF, WUP, 0, scr, r, lane); continue; } r -= I_UP;
            if (r < I_DOWN) { p0_transpose_item(w_down, DFF, DM, WDOWN, 0, scr, r, lane); continue; } r -= I_DOWN;
            if (r < I_PG) { p0_transpose_item(w_ple_gate, DM, DM, WPG, 0, scr, r, lane); continue; } r -= I_PG;
            p0_transpose_item(w_ple_proj, PLE, DM, WPP, 0, scr, r, lane);
        }
        for (int m = gw; m < MT; m += 2 * NGW) { const int m1 = m + NGW; const bool two = m1 < MT;
            const float* xr0 = m < MP ? x_p + (size_t)m * DM : x_s + (size_t)(m - MP) * DM;
            const float* xr1 = !two ? nullptr : (m1 < MP ? x_p + (size_t)m1 * DM : x_s + (size_t)(m1 - MP) * DM);
            const float* pr0 = m < MP ? p_p + (size_t)m * PLE : p_s + (size_t)(m - MP) * PLE;
            const float* pr1 = !two ? pr0 : (m1 < MP ? p_p + (size_t)m1 * PLE : p_s + (size_t)(m1 - MP) * PLE);
            const f32x4 pv0 = *((const GAS f32x4*)pr0 + lane), pv1 = *((const GAS f32x4*)pr1 + lane);
            rms_rows_to_bf16(xr0, xr1, g_mix, XN + (size_t)m * DM, XN + (size_t)(two ? m1 : m) * DM, lane);
            *((GAS unsigned long long*)(PB + (size_t)m * PLE) + lane) = (unsigned long long)pk2(pv0.x, pv0.y) | ((unsigned long long)pk2(pv0.z, pv0.w) << 32);
            if (two) *((GAS unsigned long long*)(PB + (size_t)m1 * PLE) + lane) = (unsigned long long)pk2(pv1.x, pv1.y) | ((unsigned long long)pk2(pv1.z, pv1.w) << 32);
        }
    }
    SEAM(0);
#pragma unroll 1
    for (int rep_ = 0; rep_ < ((IN(1)) ? ((DBG_REPEAT == 1) ? 2 : 1) : 0); ++rep_) {
        if (rep_ > 0) xcd_barrier(bar);
#pragma unroll 1
        for (int pass_ = 0; pass_ < 2; ++pass_) if ((pass_ == 1) == late_) {
        for (int task = vcu; task < 16 * (INW / 256); task += G) { const int rb = task & 15, col0 = (task >> 4) * 256; f32x4 vv[2][2];
            sk::tile4(XN, WIN, DM, (size_t)MP + rb * 32, col0, (SK_LAS char*)(L + RING_OFF), vv);
            const int t = threadIdx.x, rs = rb * 32 + (t >> 4), r = MP + rs;
#pragma unroll
            for (int h = 0; h < 2; ++h)
#pragma unroll
                for (int q = 0; q < 2; ++q) { const f32x4 v = vv[h][q]; const int c = col0 + 128 * h + 64 * q + (t & 15) * 4;
            if (c < 512) { *(GAS unsigned long long*)(Ub + (size_t)r * 512 + c) = sk::pk4(v); const int i = rs & 31; if (i >= 17) *(GAS f32x4*)(out + O_POOLS + ((size_t)(rs >> 5) * 15 + (i - 17)) * 512 + c) = v; }
            else if (c < 1024) *(GAS unsigned long long*)(Qb + (size_t)r * 512 + c - 512) = sk::pk4(v * QSCALE);
            else if (c < 1536) { *(GAS unsigned long long*)(Kb + (size_t)r * 512 + c - 1024) = sk::pk4(v); *(GAS f32x4*)(out + O_KS + (size_t)rs * 512 + c - 1024) = v; }
            else if (c < 2048) { *(GAS unsigned long long*)(Vb + (size_t)r * 512 + c - 1536) = sk::pk4(v); *(GAS f32x4*)(out + O_VS + (size_t)rs * 512 + c - 1536) = v; }
            else { const f32x4 bg = *(const GAS f32x4*)(b_gate + c - 2048); *(GAS unsigned long long*)(Gb + (size_t)r * 2048 + c - 2048) = sk::pk4(pg8::sigm4(v + bg)); } }
        }
        } else {
        pg8::Gemm g{XN, WIN, MP, INW, DM}; pg8::RotOrder S; S.init(MP, INW, G, bx, DBG_ROT);
        pg8::EpiIn E{Ub, Qb, Kb, Vb, Gb, b_gate, out + O_KP, out + O_VP, out + O_KS, out + O_VS, out + O_POOLP, out + O_POOLS};
        pg8::gemm_phase<pg8::EpiIn, pg8::RotOrder, DBG_ALIGN, DBG_SP2>(L + RING_OFF, g, S, E);
        }
#ifdef DBG_PREDELAY
        { const unsigned long long t0_ = __builtin_amdgcn_s_memrealtime(); while (__builtin_amdgcn_s_memrealtime() - t0_ < DBG_PREDELAY) __builtin_amdgcn_s_sleep(16); __syncthreads(); }
#endif
#ifdef DBG_PREFENCE
        __threadfence(); __syncthreads();
#endif
    }
    SEAM(1);
#ifdef DBG_GDUMP
#ifndef DBG_DUMPBUF
#define DBG_DUMPBUF WS_G
#define DBG_DUMPLD 2048
#endif
    for (int it = (vcu * NWAVES * 64 + (int)threadIdx.x); it < MT * 128; it += G * NWAVES * 64) {
        const int m = it >> 7, c = (it & 127) * 8; const v4u w = *(const GAS v4u*)((const bf16*)(ws + DBG_DUMPBUF) + (size_t)m * DBG_DUMPLD + ((DBG_GDUMP + c) % DBG_DUMPLD)); f32x4 a, b; pg8::unpack8(w, a, b);
        *(GAS f32x4*)(Yo + (size_t)m * 1024 + c) = a; *(GAS f32x4*)(Yo + (size_t)m * 1024 + c + 4) = b; }
#endif
#ifdef DBG_DELAY
    { const unsigned long long t0_ = __builtin_amdgcn_s_memrealtime(); while (__builtin_amdgcn_s_memrealtime() - t0_ < DBG_DELAY) __builtin_amdgcn_s_sleep(16); __syncthreads(); }
#endif
#ifndef DBG_SKIP_P2
#define DBG_SKIP_P2 0
#endif
    if (IN(2) && (DBG_SKIP_P2 & 8)) {
        for (int it = (vcu * NWAVES * 64 + (int)threadIdx.x); it < MT * 64; it += G * NWAVES * 64) {
            const int m = it >> 6, c = (it & 63) * 8; f32x4 a, b;
            for (int e = 0; e < 4; ++e) { a[e] = (float)(((m * 31 + (c + e) * 17) & 255) - 128) * (1.0f / 128.0f); b[e] = (float)(((m * 13 + (c + 4 + e) * 29) & 255) - 128) * (1.0f / 128.0f); }
            *(GAS v4u*)(Yb + (size_t)m * 512 + c) = pg8::pack8(a, b); *(GAS v4u*)(YSB + (size_t)m * 512 + c) = pg8::pack8(b, a);
            if (DBG_SKIP_P2 & 16) { *(GAS v4u*)(MG + (size_t)m * 1024 + c) = pg8::pack8(a, b); *(GAS v4u*)(MG + (size_t)m * 1024 + 512 + c) = pg8::pack8(b, a); }
        }
    }
#pragma unroll 1
    for (int rep_ = 0; rep_ < ((IN(2) && !(DBG_SKIP_P2 & 12)) ? ((DBG_REPEAT == 2) ? 2 : 1) : 0); ++rep_) {
        if (rep_ > 0) xcd_barrier(bar);
        FRESH_TID();
        const bool do_pool_ = (rep_ == 0) || DBG_P2PART == 0 || DBG_P2PART == 1, do_att_ = (rep_ == 0) || DBG_P2PART == 0 || DBG_P2PART == 2, do_sam_ = (rep_ == 0) || DBG_P2PART == 0 || DBG_P2PART == 3;
        if (do_pool_)
        for (int wi = wave * G + vcu; wi < 4 * (MT / 64); wi += NGW) { const int g = wi & 3, run = (wi >> 2) * 4 + (lane >> 4), c = g * 128 + (lane & 15) * 8;
            if (g == 0) pool_run<2, 16>(Ub, state_pool, Yb, run, c); else if (g == 1) pool_run<4, 16>(Ub, state_pool, Yb, run, c); else if (g == 2) pool_run<8, 16>(Ub, state_pool, Yb, run, c);
            else { pool_run<16, 8>(Ub, state_pool, Yb, 2 * run, c); asm volatile("" ::: "memory"); pool_run<16, 8>(Ub, state_pool, Yb, 2 * run + 1, c); } }
        const sba::Tensors T{Qb, Kb, Vb, YSB, cache_k, cache_v};
        if (do_att_) {
#pragma unroll 1
        for (int i2 = 2 * vcu; i2 < 512; i2 += ((i2 & 1) ? 2 * G - 1 : 1)) { const int i = i2 >> 1, bh = i >> 2, s = i & 3;
            sba::sb_unit<false>(bh >> 3, bh & 7, (i2 & 1) ? 7 - s : s, T, (SB_LAS char*)(L + RING_OFF)); }
        }
        if (do_sam_) {
        for (int i = G - 1 - vcu; i < 128; i += G) sba::sb_unit<true>(i >> 3, i & 7, 0, T, (SB_LAS char*)(L + RING_OFF));
        }
    }
    SEAM(2);
#pragma unroll 1
    for (int rep_ = 0; rep_ < ((IN(3) && !(DBG_SKIP_P2 & 16)) ? ((DBG_REPEAT == 3) ? 2 : 1) : 0); ++rep_) {
        if (rep_ > 0) xcd_barrier(bar);
#pragma unroll 1
        for (int pass_ = 0; pass_ < 2; ++pass_) if ((pass_ == 1) == late_) {
        for (int task = vcu; task < 16 * (DM / 64); task += G) { const int rb = task & 15, col0 = (task >> 4) * 64;
            const f32x4 va = sk::tile(Yb, WEFF, PW, (size_t)MP + rb * 32, col0, (SK_LAS char*)(L + RING_OFF));
            const f32x4 vb = sk::tile(YSB, WSB, SBW, (size_t)MP + rb * 32, col0, (SK_LAS char*)(L + RING_OFF));
            const int t = threadIdx.x, r = MP + rb * 32 + (t >> 4), c = col0 + (t & 15) * 4;
            const f32x4 ga = sk::up4(*(const GAS unsigned long long*)(Gb + (size_t)r * 2048 + c)), gb = sk::up4(*(const GAS unsigned long long*)(Gb + (size_t)r * 2048 + 1024 + c));
            *(GAS unsigned long long*)(MG + (size_t)r * 1024 + c) = sk::pk4(ga * va + gb * vb);
        }
        } else {
        { pg8::Gemm g{Yb, WEFF, MP, DM, PW}; pg8::StaticOrder S; S.init(MP, DM, G, bx); pg8::EpiMerge0 E{Gb, MG};
          pg8::gemm_phase<pg8::EpiMerge0, pg8::StaticOrder, DBG_ALIGN, DBG_SP2>(L + RING_OFF, g, S, E); }
        { pg8::Gemm g{YSB, WSB, MP, DM, SBW}; pg8::StaticOrder S; S.init(MP, DM, G, bx); pg8::EpiMerge1 E{Gb, MG};
          pg8::gemm_phase<pg8::EpiMerge1, pg8::StaticOrder, DBG_ALIGN, DBG_SP2>(L + RING_OFF, g, S, E); }
        }
    }
    SEAM(3);
#pragma unroll 1
    for (int rep_ = 0; rep_ < ((IN(4)) ? ((DBG_REPEAT == 4) ? 2 : 1) : 0); ++rep_) {
        if (rep_ > 0) xcd_barrier(bar);
#pragma unroll 1
        for (int pass_ = 0; pass_ < 2; ++pass_) if ((pass_ == 1) == late_) {
        for (int task = vcu; task < 16 * (DM / 64); task += G) { const int rb = task & 15, col0 = (task >> 4) * 64;
            const f32x4 v = sk::tile(MG, WOUT, DM, (size_t)MP + rb * 32, col0, (SK_LAS char*)(L + RING_OFF));
            const int t = threadIdx.x, rs = rb * 32 + (t >> 4), r = MP + rs, c = col0 + (t & 15) * 4;
            const f32x4 x1 = *(const GAS f32x4*)(x_s + (size_t)rs * DM + c) + v; *(GAS unsigned long long*)(Xb + (size_t)r * DM + c) = sk::pk4(x1);
            *(GAS unsigned long long*)(XN + (size_t)r * DM + c) = sk::pk4(x1 * *(const GAS f32x4*)(g_mlp + c));
            const float ss = sk::sum16(pg8::dot4(x1)); if ((t & 15) == 0) SSQ1[(size_t)r * 16 + (col0 >> 6)] = ss;
        }
        } else {
        pg8::Gemm g{MG, WOUT, MP, DM, DM}; pg8::StaticOrder S; S.init(MP, DM, G, bx); pg8::EpiResid<true> E{x_p, Xb, XN, g_mlp, SSQ1};
        pg8::gemm_phase<pg8::EpiResid<true>, pg8::StaticOrder, DBG_ALIGN, DBG_SP2>(L + RING_OFF, g, S, E);
        }
    }
    SEAM(4);
#pragma unroll 1
    for (int rep_ = 0; rep_ < ((IN(5)) ? ((DBG_REPEAT == 5) ? 2 : 1) : 0); ++rep_) {
        if (rep_ > 0) xcd_barrier(bar);
#pragma unroll 1
        for (int pass_ = 0; pass_ < 2; ++pass_) if ((pass_ == 1) == late_) {
        for (int task = vcu; task < 16 * (DFF / 256); task += G) { const int rb = task & 15, col0 = (task >> 4) * 256; f32x4 vv[2][2];
            sk::tile4(XN, WUP, DM, (size_t)MP + rb * 32, col0, (SK_LAS char*)(L + RING_OFF), vv);
            const int t = threadIdx.x, r = MP + rb * 32 + (t >> 4); const float rs_ = sk::rstd16(SSQ1, r, t);
#pragma unroll
            for (int h = 0; h < 2; ++h)
#pragma unroll
                for (int q = 0; q < 2; ++q) { const int c = col0 + 128 * h + 64 * q + (t & 15) * 4; const f32x4 a = __builtin_elementwise_max(vv[h][q] * rs_, (f32x4){0.f, 0.f, 0.f, 0.f});
                    *(GAS unsigned long long*)(Hb + (size_t)r * DFF + c) = sk::pk4(a * a); }
        }
        } else {
        pg8::Gemm g{XN, WUP, MP, DFF, DM}; pg8::StaticOrder S; S.init(MP, DFF, G, bx); pg8::EpiUp E{SSQ1, Hb};
        pg8::gemm_phase<pg8::EpiUp, pg8::StaticOrder, DBG_ALIGN, DBG_SP2>(L + RING_OFF, g, S, E);
        }
    }
    SEAM(5);
    if (IN(5) && DBG_REPEAT == 15) {
        { pg8::Gemm g{XN, WUP, MP, DFF, DM}; pg8::StaticOrder S; S.init(MP, DFF, G, bx); pg8::EpiNull E{SSQ3};
          pg8::gemm_phase<pg8::EpiNull, pg8::StaticOrder, DBG_ALIGN, DBG_SP2>(L + RING_OFF, g, S, E); }
        xcd_barrier(bar);
    }
    if (IN(5) && DBG_REPEAT == 25) {
        for (int task = vcu; task < 16 * (DFF / 256); task += G) { const int rb = task & 15, col0 = (task >> 4) * 256; f32x4 vv[2][2];
            sk::tile4(XN, WUP, DM, (size_t)MP + rb * 32, col0, (SK_LAS char*)(L + RING_OFF), vv); if (vv[0][0][0] + vv[1][1][0] + vv[0][1][0] + vv[1][0][0] == 1.2345e33f) SSQ3[0] = vv[0][0][1]; }
        xcd_barrier(bar);
    }
    if (IN(6) && DBG_REPEAT == 6) {
        { pg8::Gemm g{Hb, WDOWN, MP, DM, DFF}; pg8::StaticOrder S; S.init(MP, DM, G, bx); pg8::EpiNull E{SSQ3};
          pg8::gemm_phase<pg8::EpiNull, pg8::StaticOrder, DBG_ALIGN, DBG_SP2>(L + RING_OFF, g, S, E); }
        xcd_barrier(bar);
    }
    if (IN(6) && DBG_REPEAT == 16) {
        for (int task = vcu; task < 16 * (DM / 64); task += G) { const int rb = task & 15, col0 = (task >> 4) * 64;
            const f32x4 v = sk::tile(Hb, WDOWN, DFF, (size_t)MP + rb * 32, col0, (SK_LAS char*)(L + RING_OFF)); if (v[0] == 1.2345e33f) SSQ3[0] = v[1]; }
        xcd_barrier(bar);
    }
    if (IN(6)) {
#pragma unroll 1
        for (int pass_ = 0; pass_ < 2; ++pass_) if ((pass_ == 1) == late_) {
        for (int task = vcu; task < 16 * (DM / 64); task += G) { const int rb = task & 15, col0 = (task >> 4) * 64;
            const f32x4 v = sk::tile(Hb, WDOWN, DFF, (size_t)MP + rb * 32, col0, (SK_LAS char*)(L + RING_OFF));
            const int t = threadIdx.x, r = MP + rb * 32 + (t >> 4), c = col0 + (t & 15) * 4;
            const f32x4 x2 = sk::up4(*(const GAS unsigned long long*)(Xb + (size_t)r * DM + c)) + v; *(GAS unsigned long long*)(Xb + (size_t)r * DM + c) = sk::pk4(x2);
            *(GAS unsigned long long*)(XN + (size_t)r * DM + c) = sk::pk4(x2 * *(const GAS f32x4*)(g_ple + c));
            const float ss = sk::sum16(pg8::dot4(x2)); if ((t & 15) == 0) SSQ2[(size_t)r * 16 + (col0 >> 6)] = ss;
        }
        } else {
        { pg8::Gemm g{Hb, WDOWN, MP, DM, DFF}; pg8::StaticOrder S; S.init(MP, DM, G, bx); pg8::EpiResid<false> E{nullptr, Xb, XN, g_ple, SSQ2};
          pg8::gemm_phase<pg8::EpiResid<false>, pg8::StaticOrder, DBG_ALIGN, DBG_SP2>(L + RING_OFF, g, S, E); }
        }
    }
    SEAM(6);
    if (IN(7) && DBG_REPEAT == 7) {
        { pg8::Gemm g{PB, WPP, MP, DM, PLE}; pg8::StaticOrder S; S.init(MP, DM, G, bx); pg8::EpiNull E{SSQ3};
          pg8::gemm_phase<pg8::EpiNull, pg8::StaticOrder, DBG_ALIGN, DBG_SP2>(L + RING_OFF, g, S, E); }
        { pg8::Gemm g{XN, WPG, MP, DM, DM}; pg8::StaticOrder S; S.init(MP, DM, G, bx); pg8::EpiNull E{SSQ3};
          pg8::gemm_phase<pg8::EpiNull, pg8::StaticOrder, DBG_ALIGN, DBG_SP2>(L + RING_OFF, g, S, E); }
        xcd_barrier(bar);
    }
    if (IN(7) && DBG_REPEAT == 17) {
        for (int task = vcu; task < 16 * (DM / 64); task += G) { const int rb = task & 15, col0 = (task >> 4) * 64;
            const f32x4 vp = sk::tile(PB, WPP, PLE, (size_t)MP + rb * 32, col0, (SK_LAS char*)(L + RING_OFF));
            const f32x4 vg = sk::tile(XN, WPG, DM, (size_t)MP + rb * 32, col0, (SK_LAS char*)(L + RING_OFF)); if (vp[0] + vg[0] == 1.2345e33f) SSQ3[0] = vp[1]; }
        xcd_barrier(bar);
    }
    if (IN(7) && DBG_REPEAT == 27) {
        { pg8::Gemm g{PB, WPP, MP, DM, PLE}; pg8::StaticOrder S; S.init(MP, DM, G, bx); pg8::EpiPP E{PPb};
          pg8::gemm_phase<pg8::EpiPP, pg8::StaticOrder, DBG_ALIGN, DBG_SP2>(L + RING_OFF, g, S, E); }
        xcd_barrier(bar);
    }
    if (IN(7)) {
#pragma unroll 1
        for (int pass_ = 0; pass_ < 2; ++pass_) if ((pass_ == 1) == late_) {
        for (int task = vcu; task < 16 * (DM / 64); task += G) { const int rb = task & 15, col0 = (task >> 4) * 64;
            const f32x4 vp = sk::tile(PB, WPP, PLE, (size_t)MP + rb * 32, col0, (SK_LAS char*)(L + RING_OFF));
            const f32x4 vg = sk::tile(XN, WPG, DM, (size_t)MP + rb * 32, col0, (SK_LAS char*)(L + RING_OFF));
            const int t = threadIdx.x, r = MP + rb * 32 + (t >> 4), c = col0 + (t & 15) * 4;
            const float rs_ = sk::rstd16(SSQ2, r, t);
            const f32x4 x3 = sk::up4(*(const GAS unsigned long long*)(Xb + (size_t)r * DM + c)) + pg8::sigm4(vg * rs_) * vp;
            const float ss = sk::sum16(pg8::dot4(x3)); if ((t & 15) == 0) __hip_atomic_store(SSQ3 + (size_t)r * 16 + (col0 >> 6), ss, __ATOMIC_RELAXED, __HIP_MEMORY_SCOPE_AGENT);
            asm volatile("s_waitcnt vmcnt(0)" ::: "memory");
            unsigned* cw = (unsigned*)(ctl + CW_FINS + 64 * rb);
            if ((t & 63) == 0) __hip_atomic_fetch_add(cw, 1u, __ATOMIC_RELAXED, __HIP_MEMORY_SCOPE_AGENT);
            { unsigned spins = 0; while ((unsigned)__builtin_amdgcn_readfirstlane(__hip_atomic_load(cw, __ATOMIC_RELAXED, __HIP_MEMORY_SCOPE_AGENT)) < 128u) { __builtin_amdgcn_s_sleep(2); if (++spins > (1u << 22)) break; } }
            const float r3 = __builtin_amdgcn_rsqf(sk::sum16(__hip_atomic_load(SSQ3 + (size_t)r * 16 + (t & 15), __ATOMIC_RELAXED, __HIP_MEMORY_SCOPE_AGENT)) * (1.0f / 1024.0f) + EPS);
            *(GAS f32x4*)(Yo + (size_t)r * DM + c) = x3 * r3 * *(const GAS f32x4*)(g_final + c);
        }
        } else {
        { pg8::Gemm g{PB, WPP, MP, DM, PLE}; pg8::StaticOrder S; S.init(MP, DM, G, bx); pg8::EpiPP E{PPb};
          pg8::gemm_phase<pg8::EpiPP, pg8::StaticOrder, DBG_ALIGN, DBG_SP2>(L + RING_OFF, g, S, E); }
        { pg8::Gemm g{XN, WPG, MP, DM, DM}; pg8::StaticOrder S; S.init(MP, DM, G, bx); pg8::EpiPleFinal E{SSQ2, PPb, Xb, Yo, SSQ3, g_final, (unsigned*)(ctl + CW_FIN)};
          pg8::gemm_phase<pg8::EpiPleFinal, pg8::StaticOrder, DBG_ALIGN, DBG_SP2>(L + RING_OFF, g, S, E); }
        }
    }
#undef IN
#undef SEAM
}

extern "C" void kernel_launch(void* const* d_in, const int* in_sizes, int n_in, void* d_out, int out_size, void* d_ws, size_t ws_size, hipStream_t stream) {
    static int grid = 0;
    if (grid == 0) {
        if (n_in != 22 || out_size != (int)O_END || ws_size < WS_END) { fprintf(stderr, "kernel_launch: unexpected sizes: n_in %d out %d ws %zu\n", n_in, out_size, ws_size); grid = -1; return; }
        int dev = 0, cus = 0, per_cu = 0;
        if (hipGetDevice(&dev) != hipSuccess || hipDeviceGetAttribute(&cus, hipDeviceAttributeMultiprocessorCount, dev) != hipSuccess) { grid = -1; return; }
        if (hipFuncSetAttribute((const void*)mega_fwd, hipFuncAttributeMaxDynamicSharedMemorySize, LDS_BYTES) != hipSuccess) { fprintf(stderr, "kernel_launch: hipFuncSetAttribute failed\n"); grid = -1; return; }
        if (hipOccupancyMaxActiveBlocksPerMultiprocessor(&per_cu, (const void*)mega_fwd, NWAVES * 64, LDS_BYTES) != hipSuccess || per_cu < 1) { fprintf(stderr, "kernel_launch: occupancy query says %d\n", per_cu); (void)hipGetLastError(); per_cu = 1; }
        grid = cus;
    }
    if (grid < 0) return;
    (void)hipMemsetAsync((char*)d_ws + WS_CTL, 0, CTL_ZERO_BYTES, stream);
    Args a{};
    for (int i = 0; i < 22; ++i) a.in[i] = (const float*)d_in[i];
    a.out = (float*)d_out; a.ws = (unsigned char*)d_ws;
#ifndef DBG_PH_HI
#define DBG_PH_HI N_PHASES
#endif
    if (MK_N_LAUNCHES == 1) { a.ph_lo = 0; a.ph_hi = DBG_PH_HI; a.li = 0; hipLaunchKernelGGL(mega_fwd, dim3(grid), dim3(NWAVES * 64), LDS_BYTES, stream, a); }
    else for (int li = 0; li < N_PHASES; ++li) { a.ph_lo = li; a.ph_hi = li + 1; a.li = li; hipLaunchKernelGGL(mega_fwd, dim3(grid), dim3(NWAVES * 64), LDS_BYTES, stream, a);
#if defined(HYB_ATTN)
        if (li == 2) hyb_attn<<<(MT * NH + 63) / 64, 64, 0, stream>>>((const unsigned short*)((char*)d_ws + WS_Q), (const unsigned short*)((char*)d_ws + WS_K), (const unsigned short*)((char*)d_ws + WS_V), (const float*)d_in[2], (const float*)d_in[3], (unsigned short*)((char*)d_ws + WS_YSB));
#endif
#if defined(HYB_POOL)
        if (li == 2) hyb_pool<<<(int)(((size_t)MT * PW + 255) / 256), 256, 0, stream>>>((const unsigned short*)((char*)d_ws + WS_U), (const float*)d_in[4], (unsigned short*)((char*)d_ws + WS_Y));
#endif
    }
}
```

```cpp
#include <hip/hip_runtime.h>
#include <hip/hip_bf16.h>
#include <cstdio>
#include <cstdint>
#include <cmath>
namespace cfg {
constexpr int DM = 1024, NB = 8, SEQ = 2048, DB = 16, DS = 32, PAST = 1024, PW = 512, SBW = 512, HD = 64, NH = 8, DFF = 4096, PLE = 256, INW = 4096;
constexpr int MP = NB * SEQ, MS = DB * DS, MT = MP + MS;
constexpr float EPS = 1e-6f;
constexpr float QSCALE = 0.125f * 1.4426950408889634f;
}
namespace pg8 {
#define PG8_LAS __attribute__((address_space(3)))
typedef unsigned short bf16_t;
typedef short bf16x8 __attribute__((ext_vector_type(8)));
typedef float f32x4 __attribute__((ext_vector_type(4)));
typedef unsigned u32x4 __attribute__((ext_vector_type(4)));
constexpr int BM = 256, BK = 64, HALF = 128, HTB = HALF * BK * 2  , STAGE_BYTES = 8 * HTB, NXCD = 8, WGM = 8;

__host__ __device__ __forceinline__ int lds_byte(int r, int c) { const int st = (r >> 4) * 2 + (c >> 5), rr = r & 15, cc = c & 31, ob = rr * 64 + cc * 2; return st * 1024 + (ob ^ (((ob >> 9) & 1) << 5)); }
__host__ __device__ __forceinline__ void stage_rc(int b, int& R, int& C) { const int st = b / 1024, sb = b % 1024, swz = sb ^ (((sb >> 9) & 1) << 5); R = (st >> 1) * 16 + swz / 64; C = (st & 1) * 32 + (swz % 64) / 2; }
__host__ __device__ __forceinline__ int perm32(int rho) { const int n = rho >> 4, i = rho & 15; return 8 * (i >> 2) + 4 * n + (i & 3); }

struct Unit { int pm, pn; };
struct Gemm { const bf16_t* A; const bf16_t* Bt; int M, N, K; };

struct StaticOrder {
    int nM, nN, nwg, G, c;
    __host__ __device__ void init(int M, int N, int G_, int c_) { nM = M / BM; nN = N / BM; nwg = nM * nN; G = G_; c = c_; }
    __host__ __device__ bool next(int i, Unit& u) const {
        const long L = (long)i * G + c; if (L >= nwg) return false;
        int wgid = (int)L; { const int q = nwg / NXCD, r = nwg % NXCD, xcd = wgid % NXCD, off = wgid / NXCD; wgid = (xcd < r ? xcd * (q + 1) : r * (q + 1) + (xcd - r) * q) + off; }
        const int nig = WGM * nN, gid = wgid / nig, fm = gid * WGM, gsz = (nM - fm) < WGM ? (nM - fm) : WGM;
        u.pm = fm + ((wgid % nig) % gsz); u.pn = (wgid % nig) / gsz; return true;
    }
    __device__ __forceinline__ void a_ready(const Unit&) const {}
    __device__ __forceinline__ void done(const Unit&) const {}
};
struct RotOrder : StaticOrder {
    int rot, cnt;
    __host__ __device__ void init(int M, int N, int G_, int c_, int rot_) { StaticOrder::init(M, N, G_, c_); cnt = (nwg % G_ == 0) ? nwg / G_ : 0; rot = rot_; }
    __host__ __device__ bool next(int i, Unit& u) const { if (cnt == 0) return StaticOrder::next(i, u); if (i >= cnt) return false; return StaticOrder::next((i + rot) % cnt, u); }
};
typedef float f32x2v_t __attribute__((ext_vector_type(2))); typedef __bf16 bf16x2v_t __attribute__((ext_vector_type(2)));
__device__ __forceinline__ unsigned cvt_pk_bf16(float lo, float hi) { f32x2v_t v = {lo, hi}; bf16x2v_t b = __builtin_convertvector(v, bf16x2v_t); return __builtin_bit_cast(unsigned, b); }
typedef float f32x2 __attribute__((ext_vector_type(2)));
__device__ __forceinline__ float bf_lo(unsigned w) { return __uint_as_float(w << 16); }
__device__ __forceinline__ float bf_hi(unsigned w) { return __uint_as_float(w & 0xffff0000u); }
__device__ __forceinline__ u32x4 pack8(f32x4 a, f32x4 b) { u32x4 w; w.x = cvt_pk_bf16(a[0], a[1]); w.y = cvt_pk_bf16(a[2], a[3]); w.z = cvt_pk_bf16(b[0], b[1]); w.w = cvt_pk_bf16(b[2], b[3]); return w; }
__device__ __forceinline__ void unpack8(u32x4 w, f32x4& a, f32x4& b) { a = (f32x4){bf_lo(w.x), bf_hi(w.x), bf_lo(w.y), bf_hi(w.y)}; b = (f32x4){bf_lo(w.z), bf_hi(w.z), bf_lo(w.w), bf_hi(w.w)}; }
__device__ __forceinline__ float sigm(float x) { return __builtin_amdgcn_rcpf(1.f + __builtin_amdgcn_exp2f(-1.4426950408889634f * x)); }
__device__ __forceinline__ f32x4 sigm4(f32x4 x) { return (f32x4){sigm(x[0]), sigm(x[1]), sigm(x[2]), sigm(x[3])}; }
__device__ __forceinline__ float dot4(f32x4 a) { return (a[0] * a[0] + a[1] * a[1]) + (a[2] * a[2] + a[3] * a[3]); }
#ifndef DBG_LDAUX
#define DBG_LDAUX 16
#endif
__device__ __forceinline__ u32x4 ld16_sc1(const void* base, size_t byte_off) {
    const __amdgpu_buffer_rsrc_t rs = __builtin_amdgcn_make_buffer_rsrc((void*)base, (short)0, 0x7fffffff, 0x00020000);
    return __builtin_bit_cast(u32x4, __builtin_amdgcn_raw_buffer_load_b128(rs, (unsigned)byte_off, 0, DBG_LDAUX));
}
__device__ __forceinline__ float row_rstd(const float* SSQ, int r, int fq) {
    const f32x4 p = *(const f32x4*)(SSQ + (size_t)r * 16 + 4 * fq); float s = (p[0] + p[1]) + (p[2] + p[3]);
    s += __shfl_xor(s, 16); s += __shfl_xor(s, 32);
    return __builtin_amdgcn_rsqf(s * (1.0f / 1024.0f) + cfg::EPS);
}
#define PG8_ROWS(...) _Pragma("unroll") for (int ai = 0; ai < 2; ++ai) _Pragma("unroll") for (int m = 0; m < 4; ++m) { const int r = u.pm * BM + ai * HALF + wr * 64 + m * 16 + fr; __VA_ARGS__; if (m == 3) asm volatile("" ::: "memory"); }
#define PG8_COLS(...) _Pragma("unroll") for (int bj = 0; bj < 2; ++bj) { const int c = ct + bj * HALF + wc * 32 + 8 * fq; const f32x4 v0 = acc[ai][bj][m][0], v1 = acc[ai][bj][m][1]; __VA_ARGS__; }

struct EpiIn {
    static constexpr bool PERM = true, AFTER_DRAIN = false;
    bf16_t *U, *Q, *K, *V, *G; const float* b_gate; float *k_p, *v_p, *k_s, *v_s, *pool_p, *pool_s;
    __device__ __forceinline__ void operator()(const f32x4 (&acc)[2][2][4][2], const Unit& u, int wr, int wc, int fr, int fq) const {
        const int pn = u.pn;
        if (pn >= 8) {
            const int ct = (pn - 8) * BM; f32x4 bv[2][2];
#pragma unroll
            for (int bj = 0; bj < 2; ++bj) { const int c = ct + bj * HALF + wc * 32 + 8 * fq; bv[bj][0] = *(const f32x4*)(b_gate + c); bv[bj][1] = *(const f32x4*)(b_gate + c + 4); }
            PG8_ROWS(PG8_COLS(*(u32x4*)(G + (size_t)r * 2048 + c) = pack8(sigm4(v0 + bv[bj][0]), sigm4(v1 + bv[bj][1]))))
        } else if (pn >= 4) {
            const bool isv = pn >= 6; const int ct = (pn - (isv ? 6 : 4)) * BM; bf16_t* B = isv ? V : K; float* op = isv ? v_p : k_p; float* os = isv ? v_s : k_s;
            PG8_ROWS(float* orow = r < cfg::MP ? op + (size_t)r * 512 : os + (size_t)(r - cfg::MP) * 512;
                     PG8_COLS(*(u32x4*)(B + (size_t)r * 512 + c) = pack8(v0, v1); *(f32x4*)(orow + c) = v0; *(f32x4*)(orow + c + 4) = v1))
        } else if (pn >= 2) {
            const int ct = (pn - 2) * BM;
            PG8_ROWS(PG8_COLS(*(u32x4*)(Q + (size_t)r * 512 + c) = pack8(v0 * cfg::QSCALE, v1 * cfg::QSCALE)))
        } else {
            const int ct = pn * BM;
            PG8_ROWS(float* prow = nullptr;
                     if (r < cfg::MP) { const int t = r & (cfg::SEQ - 1); if (t >= cfg::SEQ - 15) prow = pool_p + ((size_t)(r >> 11) * 15 + (t - (cfg::SEQ - 15))) * 512; }
                     else { const int i = (r - cfg::MP) & 31; if (i >= 17) prow = pool_s + ((size_t)((r - cfg::MP) >> 5) * 15 + (i - 17)) * 512; }
                     PG8_COLS(*(u32x4*)(U + (size_t)r * 512 + c) = pack8(v0, v1); if (prow) { *(f32x4*)(prow + c) = v0; *(f32x4*)(prow + c + 4) = v1; }))
        }
    }
};
#if defined(DBG_ONLYG)
#define DBG_NOG_STMT *(u32x4*)(MG + (size_t)r * 1024 + c) = gw; continue;
#elif defined(DBG_NOG)
#define DBG_NOG_STMT g0 = (f32x4){0.5f, 0.5f, 0.5f, 0.5f}; g1 = g0;
#else
#define DBG_NOG_STMT
#endif
struct EpiMerge0 {
    static constexpr bool PERM = true, AFTER_DRAIN = false;
    const bf16_t* G; bf16_t* MG;
    __device__ __forceinline__ void operator()(const f32x4 (&acc)[2][2][4][2], const Unit& u, int wr, int wc, int fr, int fq) const {
        const int ct = u.pn * BM;
        PG8_ROWS(PG8_COLS(const u32x4 gw = ld16_sc1(G, ((size_t)r * 2048 + c) * 2); f32x4 g0; f32x4 g1; unpack8(gw, g0, g1); DBG_NOG_STMT *(u32x4*)(MG + (size_t)r * 1024 + c) = pack8(v0 * g0, v1 * g1)))
    }
};
#ifdef DBG_NORAW
#define DBG_NORAW_STMT m0 = (f32x4){0.f, 0.f, 0.f, 0.f}; m1 = m0;
#else
#define DBG_NORAW_STMT
#endif
struct EpiMerge1 {
    static constexpr bool PERM = true, AFTER_DRAIN = false;
    const bf16_t* G; bf16_t* MG;
    __device__ __forceinline__ void operator()(const f32x4 (&acc)[2][2][4][2], const Unit& u, int wr, int wc, int fr, int fq) const {
        const int ct = u.pn * BM;
        PG8_ROWS(PG8_COLS(const u32x4 gw = *(const u32x4*)(G + (size_t)r * 2048 + 1024 + c); const u32x4 mw = *(const u32x4*)(MG + (size_t)r * 1024 + c);
                          f32x4 g0; f32x4 g1; f32x4 m0; f32x4 m1; unpack8(gw, g0, g1); unpack8(mw, m0, m1); DBG_NORAW_STMT *(u32x4*)(MG + (size_t)r * 1024 + c) = pack8(m0 + v0 * g0, m1 + v1 * g1)))
    }
};
template <bool F32RES>
struct EpiResid {
    static constexpr bool PERM = true, AFTER_DRAIN = false;
    const float* res_p; bf16_t* X; bf16_t* XG; const float* gvec; float* SSQ;
    __device__ __forceinline__ void operator()(const f32x4 (&acc)[2][2][4][2], const Unit& u, int wr, int wc, int fr, int fq) const {
        const int ct = u.pn * BM; f32x4 gv[2][2];
#pragma unroll
        for (int bj = 0; bj < 2; ++bj) { const int c = ct + bj * HALF + wc * 32 + 8 * fq; gv[bj][0] = *(const f32x4*)(gvec + c); gv[bj][1] = *(const f32x4*)(gvec + c + 4); }
        PG8_ROWS(float s = 0.f;
                 PG8_COLS(f32x4 a; f32x4 b;
                          if (F32RES) { a = *(const f32x4*)(res_p + (size_t)r * 1024 + c); b = *(const f32x4*)(res_p + (size_t)r * 1024 + c + 4); }
                          else { const u32x4 xw = *(const u32x4*)(X + (size_t)r * 1024 + c); unpack8(xw, a, b); }
                          a += v0; b += v1; *(u32x4*)(X + (size_t)r * 1024 + c) = pack8(a, b); s += dot4(a) + dot4(b);
                          *(u32x4*)(XG + (size_t)r * 1024 + c) = pack8(a * gv[bj][0], b * gv[bj][1]))
                 s += __shfl_xor(s, 16); s += __shfl_xor(s, 32); if (fq == 0) SSQ[(size_t)r * 16 + u.pn * 4 + wc] = s)
    }
};
struct EpiUp {
    static constexpr bool PERM = true, AFTER_DRAIN = false;
    const float* SSQ; bf16_t* H;
    __device__ __forceinline__ void operator()(const f32x4 (&acc)[2][2][4][2], const Unit& u, int wr, int wc, int fr, int fq) const {
        const int ct = u.pn * BM; float rsv[2][4];
#pragma unroll
        for (int ai = 0; ai < 2; ++ai)
#pragma unroll
            for (int m = 0; m < 4; ++m) rsv[ai][m] = row_rstd(SSQ, u.pm * BM + ai * HALF + wr * 64 + m * 16 + fr, fq);
        PG8_ROWS(const float rs = rsv[ai][m];
                 PG8_COLS(f32x4 a = v0 * rs; f32x4 b = v1 * rs; a = __builtin_elementwise_max(a, (f32x4){0.f, 0.f, 0.f, 0.f}); b = __builtin_elementwise_max(b, (f32x4){0.f, 0.f, 0.f, 0.f});
                          *(u32x4*)(H + (size_t)r * 4096 + c) = pack8(a * a, b * b)))
    }
};
struct EpiNull {
    static constexpr bool PERM = true, AFTER_DRAIN = false;
    float* sink;
    __device__ __forceinline__ void operator()(const f32x4 (&acc)[2][2][4][2], const Unit& u, int wr, int wc, int fr, int fq) const {
        float s = 0.f;
#pragma unroll
        for (int ai = 0; ai < 2; ++ai)
#pragma unroll
            for (int bj = 0; bj < 2; ++bj)
#pragma unroll
                for (int m = 0; m < 4; ++m)
#pragma unroll
                    for (int n = 0; n < 2; ++n) s += acc[ai][bj][m][n][0] + acc[ai][bj][m][n][3];
        if (s == 1.2345e33f) sink[0] = s;
    }
};
struct EpiPP {
    static constexpr bool PERM = true, AFTER_DRAIN = false;
    bf16_t* PP;
    __device__ __forceinline__ void operator()(const f32x4 (&acc)[2][2][4][2], const Unit& u, int wr, int wc, int fr, int fq) const {
        const int ct = u.pn * BM;
        PG8_ROWS(PG8_COLS(*(u32x4*)(PP + (size_t)r * 1024 + c) = pack8(v0, v1)))
    }
};
struct EpiPleFinal {
    static constexpr bool PERM = true, AFTER_DRAIN = false;
    const float* SSQ; const bf16_t* PP; const bf16_t* X; float* Y; float* SSQo; const float* gfin; unsigned* cnt;
    __device__ __forceinline__ void operator()(f32x4 (&acc)[2][2][4][2], const Unit& u, int wr, int wc, int fr, int fq) const {
        const int ct = u.pn * BM; float rsv[2][4];
#pragma unroll
        for (int ai = 0; ai < 2; ++ai)
#pragma unroll
            for (int m = 0; m < 4; ++m) rsv[ai][m] = row_rstd(SSQ, u.pm * BM + ai * HALF + wr * 64 + m * 16 + fr, fq);
        PG8_ROWS(const float rs = rsv[ai][m]; float s = 0.f;
                 PG8_COLS(const u32x4 pw = *(const u32x4*)(PP + (size_t)r * 1024 + c); f32x4 p0; f32x4 p1; unpack8(pw, p0, p1);
                          const u32x4 xw = *(const u32x4*)(X + (size_t)r * 1024 + c); f32x4 a; f32x4 b; unpack8(xw, a, b); a += sigm4(v0 * rs) * p0; b += sigm4(v1 * rs) * p1;
                          acc[ai][bj][m][0] = a; acc[ai][bj][m][1] = b; s += dot4(a) + dot4(b))
                 s += __shfl_xor(s, 16); s += __shfl_xor(s, 32);
                 if (fq == 0) __hip_atomic_store(SSQo + (size_t)r * 16 + u.pn * 4 + wc, s, __ATOMIC_RELAXED, __HIP_MEMORY_SCOPE_AGENT))
        asm volatile("s_waitcnt vmcnt(0)" ::: "memory");
        unsigned* cw = cnt + 64 * (2 * u.pm + wr);
        if (fr == 0 && fq == 0) __hip_atomic_fetch_add(cw, 1u, __ATOMIC_RELAXED, __HIP_MEMORY_SCOPE_AGENT);
        { unsigned spins = 0;
          while ((unsigned)__builtin_amdgcn_readfirstlane(__hip_atomic_load(cw, __ATOMIC_RELAXED, __HIP_MEMORY_SCOPE_AGENT)) < 16u) { __builtin_amdgcn_s_sleep(2); if (++spins > (1u << 16)) break; } }
        f32x4 gv[2][2];
#pragma unroll
        for (int bj = 0; bj < 2; ++bj) { const int c = ct + bj * HALF + wc * 32 + 8 * fq; gv[bj][0] = *(const f32x4*)(gfin + c); gv[bj][1] = *(const f32x4*)(gfin + c + 4); }
        PG8_ROWS(const f32x4 pq = __builtin_bit_cast(f32x4, ld16_sc1(SSQo, ((size_t)r * 16 + 4 * fq) * 4)); float t = (pq[0] + pq[1]) + (pq[2] + pq[3]); t += __shfl_xor(t, 16); t += __shfl_xor(t, 32);
                 const float r3 = __builtin_amdgcn_rsqf(t * (1.0f / 1024.0f) + cfg::EPS);
                 PG8_COLS(*(f32x4*)(Y + (size_t)r * 1024 + c) = v0 * r3 * gv[bj][0]; *(f32x4*)(Y + (size_t)r * 1024 + c + 4) = v1 * r3 * gv[bj][1]))
    }
};
template <class Epi, class Sched, bool ALIGN_EPI = false, bool SP2 = false>
__device__ __forceinline__ void gemm_phase(PG8_LAS unsigned char* lds, const Gemm g, const Sched& S, const Epi& E) {
    int tid = threadIdx.x; asm volatile("" : "+v"(tid));
    const int wid = __builtin_amdgcn_readfirstlane(tid >> 6), lane = tid & 63, wr = wid >> 2, wc = wid & 3, fr = lane & 15, fq = lane >> 4;
    int K = g.K; asm volatile("" : "+s"(K)); const int nt = K / BK;
    unsigned voffA[2], voffB[2];
#pragma unroll
    for (int i = 0; i < 2; ++i) { int R, C; stage_rc(tid * 16 + i * 8192, R, C); const int Rb = Epi::PERM ? ((R & ~31) + perm32(R & 31)) : R;
        voffA[i] = (unsigned)(R * K + C) * 2u; voffB[i] = (unsigned)(Rb * K + C) * 2u; }
    const size_t kstep = (size_t)(BK * 2);
    const size_t hstep = (size_t)HALF * K * 2;
    const size_t tstep = 2 * hstep;
    const size_t bhs = hstep;
    const unsigned ldsw = (unsigned)wid * 1024u;
    const int aoff = lds_byte(wr * 64 + fr, fq * 8), boff = lds_byte(wc * 32 + fr, fq * 8);
#define PG8_SA(b, h) (((b) * 2 + (h)) * HTB)
#define PG8_SB(b, h) ((4 + (b) * 2 + (h)) * HTB)
#define PG8_STAGE(bufoff, gbase, voff) do { _Pragma("unroll") for (int _i = 0; _i < 2; ++_i) \
        __builtin_amdgcn_global_load_lds((const unsigned*)((const char*)(gbase) + (voff)[_i]), (PG8_LAS unsigned*)(lds + (bufoff) + ldsw + _i * 8192), 16, 0, 0); } while (0)
#define PG8_LDA(dst, b, h) do { _Pragma("unroll") for (int m = 0; m < 4; ++m) _Pragma("unroll") for (int k = 0; k < 2; ++k) dst[m][k] = *(const PG8_LAS bf16x8*)(lds + PG8_SA(b, h) + aoff + m * 2048 + k * 1024); } while (0)
#define PG8_LDB(dst, b, h) do { _Pragma("unroll") for (int n = 0; n < 2; ++n) _Pragma("unroll") for (int k = 0; k < 2; ++k) dst[n][k] = *(const PG8_LAS bf16x8*)(lds + PG8_SB(b, h) + boff + n * 2048 + k * 1024); } while (0)
#define PG8_MMA(ai, bj, At, Bt) do { __builtin_amdgcn_s_setprio(1); _Pragma("unroll") for (int m = 0; m < 4; ++m) _Pragma("unroll") for (int n = 0; n < 2; ++n) _Pragma("unroll") for (int k = 0; k < 2; ++k) \
        acc[ai][bj][m][n] = __builtin_amdgcn_mfma_f32_16x16x32_bf16(Bt[n][k], At[m][k], acc[ai][bj][m][n], 0, 0, 0); __builtin_amdgcn_s_setprio(0); } while (0)
#ifdef DRAIN_ALL
#define PG8_WAIT_V(n) asm volatile("s_waitcnt vmcnt(0)" ::: "memory")
#else
#define PG8_WAIT_V(n) asm volatile("s_waitcnt vmcnt(" #n ")" ::: "memory")
#endif
#define PG8_WAIT_L(n) asm volatile("s_waitcnt lgkmcnt(" #n ")" ::: "memory")
#define PG8_BAR __builtin_amdgcn_s_barrier()
#define PG8_SCHED __builtin_amdgcn_sched_barrier(0)
    Unit cur, nxt; int ui = 0;
    if (!S.next(0, cur)) return;
    f32x4 acc[2][2][4][2];
#pragma unroll
    for (int a = 0; a < 2; ++a)
#pragma unroll
        for (int b = 0; b < 2; ++b)
#pragma unroll
            for (int m = 0; m < 4; ++m)
#pragma unroll
                for (int n = 0; n < 2; ++n) acc[a][b][m][n] = (f32x4){0.f, 0.f, 0.f, 0.f};
    bf16x8 At[4][2], B0[2][2], B1[2][2];
    const char* cA = (const char*)g.A + (size_t)cur.pm * tstep; const char* cB = (const char*)g.Bt + (size_t)cur.pn * tstep;
    S.a_ready(cur);
    if constexpr (SP2) {
        PG8_STAGE(PG8_SB(0, 0), cB, voffB); PG8_STAGE(PG8_SB(0, 1), cB + bhs, voffB); PG8_STAGE(PG8_SA(0, 0), cA, voffA); PG8_STAGE(PG8_SA(0, 1), cA + hstep, voffA);
        if (wr == 1) PG8_BAR;
        PG8_WAIT_V(2); PG8_BAR;
        PG8_STAGE(PG8_SB(1, 0), cB + kstep, voffB); PG8_STAGE(PG8_SA(1, 0), cA + kstep, voffA); PG8_STAGE(PG8_SB(1, 1), cB + bhs + kstep, voffB);
        PG8_WAIT_V(6); PG8_BAR;
    } else {
        PG8_STAGE(PG8_SB(0, 0), cB, voffB); PG8_STAGE(PG8_SA(0, 0), cA, voffA); PG8_STAGE(PG8_SB(0, 1), cB + bhs, voffB); PG8_STAGE(PG8_SA(0, 1), cA + hstep, voffA);
        if (wr == 1) PG8_BAR;
        PG8_WAIT_V(4); PG8_BAR;
        PG8_STAGE(PG8_SB(1, 0), cB + kstep, voffB); PG8_STAGE(PG8_SA(1, 0), cA + kstep, voffA); PG8_STAGE(PG8_SB(1, 1), cB + bhs + kstep, voffB);
        PG8_WAIT_V(6); PG8_BAR;
    }
    for (;;) {
        const bool has_next = S.next(ui + 1, nxt);
        const char* nA = has_next ? (const char*)g.A + (size_t)nxt.pm * tstep : cA; const char* nB = has_next ? (const char*)g.Bt + (size_t)nxt.pn * tstep : cB;
        for (int t = 0; t < nt; t += 2) {
            const bool last = (t == nt - 2);
            const char* a1 = cA + (size_t)(t + 1) * kstep;
            const char* a2 = last ? nA : cA + (size_t)(t + 2) * kstep; const char* b2 = last ? nB : cB + (size_t)(t + 2) * kstep;
            const char* a3 = a2 + kstep; const char* b3 = b2 + kstep;
            if (last && has_next) S.a_ready(nxt);
            if constexpr (SP2) {
            PG8_LDB(B0, 0, 0); PG8_LDB(B1, 0, 1); PG8_SCHED; PG8_LDA(At, 0, 0); PG8_STAGE(PG8_SA(1, 1), a1 + hstep, voffA);
            PG8_WAIT_V(8); PG8_WAIT_L(0); PG8_BAR; PG8_MMA(0, 0, At, B0); PG8_MMA(0, 1, At, B1); PG8_BAR; PG8_SCHED;
            PG8_LDA(At, 0, 1); PG8_STAGE(PG8_SB(0, 0), b2, voffB); PG8_STAGE(PG8_SB(0, 1), b2 + bhs, voffB); PG8_STAGE(PG8_SA(0, 0), a2, voffA);
            PG8_WAIT_V(8); PG8_WAIT_L(0); PG8_BAR; PG8_MMA(1, 0, At, B0); PG8_MMA(1, 1, At, B1); PG8_BAR; PG8_SCHED;
            PG8_LDB(B0, 1, 0); PG8_LDB(B1, 1, 1); PG8_SCHED; PG8_LDA(At, 1, 0); PG8_STAGE(PG8_SA(0, 1), a2 + hstep, voffA);
            PG8_WAIT_V(8); PG8_WAIT_L(0); PG8_BAR; PG8_MMA(0, 0, At, B0); PG8_MMA(0, 1, At, B1); PG8_BAR; PG8_SCHED;
            PG8_LDA(At, 1, 1); PG8_STAGE(PG8_SB(1, 0), b3, voffB); PG8_STAGE(PG8_SB(1, 1), b3 + bhs, voffB); PG8_STAGE(PG8_SA(1, 0), a3, voffA);
            PG8_WAIT_V(8); PG8_WAIT_L(0); PG8_BAR; PG8_MMA(1, 0, At, B0); PG8_MMA(1, 1, At, B1); PG8_BAR; PG8_SCHED;
            } else {
            PG8_LDB(B0, 0, 0); PG8_SCHED; PG8_LDA(At, 0, 0); PG8_STAGE(PG8_SA(1, 1), a1 + hstep, voffA);
            PG8_WAIT_L(8); PG8_BAR; PG8_WAIT_L(0); PG8_MMA(0, 0, At, B0); PG8_BAR; PG8_SCHED;
            PG8_LDB(B1, 0, 1); PG8_STAGE(PG8_SB(0, 0), b2, voffB);
            PG8_BAR; PG8_WAIT_L(0); PG8_MMA(0, 1, At, B1); PG8_BAR;
            PG8_LDA(At, 0, 1); PG8_STAGE(PG8_SA(0, 0), a2, voffA);
            PG8_BAR; PG8_WAIT_L(0); PG8_MMA(1, 0, At, B0); PG8_BAR; PG8_SCHED;
            PG8_STAGE(PG8_SB(0, 1), b2 + bhs, voffB);
            PG8_WAIT_V(6); PG8_BAR; PG8_MMA(1, 1, At, B1); PG8_BAR;
            PG8_LDB(B0, 1, 0); PG8_SCHED; PG8_LDA(At, 1, 0); PG8_STAGE(PG8_SA(0, 1), a2 + hstep, voffA);
            PG8_WAIT_L(8); PG8_BAR; PG8_WAIT_L(0); PG8_MMA(0, 0, At, B0); PG8_BAR; PG8_SCHED;
            PG8_LDB(B1, 1, 1); PG8_STAGE(PG8_SB(1, 0), b3, voffB);
            PG8_BAR; PG8_WAIT_L(0); PG8_MMA(0, 1, At, B1); PG8_BAR;
            PG8_LDA(At, 1, 1); PG8_STAGE(PG8_SA(1, 0), a3, voffA);
            PG8_BAR; PG8_WAIT_L(0); PG8_MMA(1, 0, At, B0); PG8_BAR; PG8_SCHED;
            PG8_STAGE(PG8_SB(1, 1), b3 + bhs, voffB);
            PG8_WAIT_V(6); PG8_BAR; PG8_MMA(1, 1, At, B1); PG8_BAR;
            }
        }
        if constexpr (ALIGN_EPI) { if (wr == 0) PG8_BAR; }
        if constexpr (!Epi::AFTER_DRAIN) { int t_ = threadIdx.x; asm volatile("" : "+v"(t_)); const int l_ = t_ & 63; E(acc, cur, wr, wc, l_ & 15, l_ >> 4); S.done(cur); }
        if (!has_next) break;
#pragma unroll
        for (int a = 0; a < 2; ++a)
#pragma unroll
            for (int b = 0; b < 2; ++b)
#pragma unroll
                for (int m = 0; m < 4; ++m)
#pragma unroll
                    for (int n = 0; n < 2; ++n) acc[a][b][m][n] = (f32x4){0.f, 0.f, 0.f, 0.f};
        cur = nxt; cA = nA; cB = nB; ++ui;
        if constexpr (ALIGN_EPI) { if (wr == 1) PG8_BAR; }
    }
    PG8_WAIT_V(0);
    if constexpr (!ALIGN_EPI) { if (wr == 0) PG8_BAR; }
    PG8_BAR;
    if constexpr (Epi::AFTER_DRAIN) { E.fused(acc, cur, wr, wc, fr, fq, lds, wid, lane); S.done(cur); }
#undef PG8_SA
#undef PG8_SB
#undef PG8_STAGE
#undef PG8_LDA
#undef PG8_LDB
#undef PG8_MMA
#undef PG8_WAIT_V
#undef PG8_WAIT_L
#undef PG8_BAR
#undef PG8_SCHED
}
}
namespace sba {
typedef short bf16x8 __attribute__((ext_vector_type(8)));
typedef short s16x4 __attribute__((ext_vector_type(4)));
typedef float f32x16 __attribute__((ext_vector_type(16)));
typedef float f32x4 __attribute__((ext_vector_type(4)));
typedef unsigned u32x4 __attribute__((ext_vector_type(4)));
typedef unsigned short bf16_t;
#define SB_LAS __attribute__((address_space(3)))
constexpr int PITCH = 512, SLOTB = 16384  , OFF_FLAGS = 2 * SLOTB, OFF_OST = OFF_FLAGS + 256, LDS_BYTES = OFF_OST + 8 * 4096;
constexpr float THR2 = 48.0f, NEGBIG = -1.0e30f;
typedef float f32x2_t __attribute__((ext_vector_type(2))); typedef __bf16 bf16x2_t __attribute__((ext_vector_type(2)));
__device__ __forceinline__ unsigned cvtpk(float lo, float hi) { f32x2_t v = {lo, hi}; bf16x2_t b = __builtin_convertvector(v, bf16x2_t); return __builtin_bit_cast(unsigned, b); }
__device__ __forceinline__ bf16x8 pack8f(float a0, float a1, float a2, float a3, float a4, float a5, float a6, float a7) {
    u32x4 w; w.x = cvtpk(a0, a1); w.y = cvtpk(a2, a3); w.z = cvtpk(a4, a5); w.w = cvtpk(a6, a7); return __builtin_bit_cast(bf16x8, w); }
typedef short v4i16_t __attribute__((ext_vector_type(4)));
__device__ __forceinline__ s16x4 vtr(const SB_LAS char* p) { return __builtin_bit_cast(s16x4, __builtin_amdgcn_ds_read_tr16_b64_v4i16((SB_LAS v4i16_t*)p)); }
__device__ __forceinline__ int crow(int r, int hi) { return (r & 3) + 8 * (r >> 2) + 4 * hi; }

template <int SUB>
__device__ __forceinline__ void sub_front(const SB_LAS char* Kslot, bool mask, int kq, const bf16x8 (&qr)[4], f32x16& w, bf16x8 (&spb)[2], int r32, int hi) {
    const SB_LAS char* kb = Kslot + hi * 1024 + r32 * 16 + SUB * 512;
    f32x16 p = {};
#pragma unroll
    for (int d0 = 0; d0 < 4; ++d0) { const bf16x8 kf = *(const SB_LAS bf16x8*)(kb + d0 * 2048); p = __builtin_amdgcn_mfma_f32_32x32x16_bf16(kf, qr[d0], p, 0, 0, 0); }
    float sp[16];
#pragma unroll
    for (int r = 0; r < 16; ++r) {
        float x = p[r];
        if (mask && (kq + 32 * SUB + (r & 3) + 8 * (r >> 2) >= 0)) x = NEGBIG;
        const float t = __builtin_amdgcn_exp2f(-__builtin_fabsf(x));
        const float l = __builtin_amdgcn_logf(1.0f + t);
        sp[r] = __builtin_fmaxf(x, 0.f) + l; w[r] = __builtin_fminf(x, 0.f) - l;
    }
    spb[0] = pack8f(sp[0], sp[1], sp[2], sp[3], sp[4], sp[5], sp[6], sp[7]);
    spb[1] = pack8f(sp[8], sp[9], sp[10], sp[11], sp[12], sp[13], sp[14], sp[15]);
}
template <int SUB>
__device__ __forceinline__ void sub_back(const SB_LAS char* vp, const f32x16& w, const f32x16& sx, f32x16 (&o)[2]) {
    float pr[16];
#pragma unroll
    for (int r = 0; r < 16; ++r) pr[r] = __builtin_amdgcn_exp2f(w[r] - sx[r]);
    bf16x8 pa[2];
    pa[0] = pack8f(pr[0], pr[1], pr[2], pr[3], pr[4], pr[5], pr[6], pr[7]);
    pa[1] = pack8f(pr[8], pr[9], pr[10], pr[11], pr[12], pr[13], pr[14], pr[15]);
#pragma unroll
    for (int d0 = 0; d0 < 2; ++d0)
#pragma unroll
        for (int s = 0; s < 2; ++s) { const int ks = 2 * SUB + s;
            const s16x4 lo = vtr(vp + d0 * 4096 + ks * 1024), hi4 = vtr(vp + d0 * 4096 + ks * 1024 + 512);
            const bf16x8 vf = (bf16x8){lo[0], lo[1], lo[2], lo[3], hi4[0], hi4[1], hi4[2], hi4[3]};
            o[d0] = __builtin_amdgcn_mfma_f32_32x32x16_bf16(pa[s], vf, o[d0], 0, 0, 0); }
}
__device__ __forceinline__ void sb_tile(const SB_LAS char* slot, bool mask, bool skip1, int kq, const bf16x8 (&qr)[4], f32x16& Rb, f32x16 (&o)[2], const bf16x8 (&Um)[2], const bf16x8 Jm, int r32, int hi, int lane) {
    const SB_LAS char* vp = slot + 8192 + ((lane >> 4) & 1) * 32 + (lane & 3) * 8 + (4 * hi + ((lane & 15) >> 2)) * 64;
    f32x16 w1, w0; bf16x8 sb1[2], sb0[2];
    f32x16 t1 = Rb;
    if (!skip1) {
    sub_front<1>(slot, mask, kq, qr, w1, sb1, r32, hi);
    f32x16 a1 = __builtin_amdgcn_mfma_f32_32x32x16_bf16(Um[0], sb1[0], Rb, 0, 0, 0); a1 = __builtin_amdgcn_mfma_f32_32x32x16_bf16(Um[1], sb1[1], a1, 0, 0, 0);
    t1 = __builtin_amdgcn_mfma_f32_32x32x16_bf16(Jm, sb1[0], Rb, 0, 0, 0); t1 = __builtin_amdgcn_mfma_f32_32x32x16_bf16(Jm, sb1[1], t1, 0, 0, 0);
    sub_back<1>(vp, w1, a1, o);
    }
    sub_front<0>(slot, mask, kq, qr, w0, sb0, r32, hi);
    f32x16 a0 = __builtin_amdgcn_mfma_f32_32x32x16_bf16(Um[0], sb0[0], t1, 0, 0, 0); a0 = __builtin_amdgcn_mfma_f32_32x32x16_bf16(Um[1], sb0[1], a0, 0, 0, 0);
    f32x16 rn = __builtin_amdgcn_mfma_f32_32x32x16_bf16(Jm, sb0[0], t1, 0, 0, 0); rn = __builtin_amdgcn_mfma_f32_32x32x16_bf16(Jm, sb0[1], rn, 0, 0, 0);
    sub_back<0>(vp, w0, a0, o);
    Rb = rn;
}
struct Tensors { const bf16_t* Q; const bf16_t* K; const bf16_t* V; bf16_t* O; const float* ck; const float* cv; };

template <bool SAMPLE>
__device__ __forceinline__ void sb_unit(int b, int h, int qb, const Tensors& T, SB_LAS char* lds) {
    int tid = threadIdx.x; asm volatile("" : "+v"(tid)); const int lane = tid & 63, r32 = lane & 31, hi = lane >> 5; const int wid = __builtin_amdgcn_readfirstlane(tid >> 6);
    const size_t rowbase = SAMPLE ? (size_t)cfg::MP + (size_t)b * 32 : (size_t)b * cfg::SEQ; const int q0 = SAMPLE ? 0 : qb * 256;
    const int jd = SAMPLE ? 16 : (q0 >> 6) + (wid >> 1), jtop = SAMPLE ? 16 : (q0 >> 6) + 3;
    const bool worker = SAMPLE ? (wid == 0) : true;
    const int wq = SAMPLE ? 0 : wid;
    const int qpos = (SAMPLE ? cfg::PAST : q0 + 32 * wq) + r32;
    volatile SB_LAS unsigned* flags = (volatile SB_LAS unsigned*)(lds + OFF_FLAGS);
    bf16x8 Um[2], Jm;
#pragma unroll
    for (int s = 0; s < 2; ++s)
#pragma unroll
        for (int jj = 0; jj < 8; ++jj) Um[s][jj] = (16 * s + 8 * (jj >> 2) + 4 * hi + (jj & 3) > r32) ? (short)0x3F80 : (short)0;
#pragma unroll
    for (int jj = 0; jj < 8; ++jj) Jm[jj] = (short)0x3F80;
    bf16x8 qr[4];
    { const bf16_t* Qw = T.Q + (rowbase + q0 + 32 * wq + r32) * PITCH + h * 64 + hi * 8;
#pragma unroll
      for (int d0 = 0; d0 < 4; ++d0) qr[d0] = *(const bf16x8*)(Qw + d0 * 16); }
    f32x16 Rb = {}, o[2]; o[0] = f32x16{}; o[1] = f32x16{};
    bool done = false;
    u32x4 kreg, vreg;
    const int vkey = 16 * (wid & 3) + (lane >> 2), vcol = (wid >> 2) * 32 + (lane & 3) * 8;
#define SB_LOAD(j) do { \
        if (!SAMPLE) { kreg = *(const u32x4*)(T.K + (rowbase + (size_t)(64 * (j) + lane)) * PITCH + h * 64 + wid * 8); vreg = *(const u32x4*)(T.V + (rowbase + (size_t)(64 * (j) + vkey)) * PITCH + h * 64 + vcol); } \
        else if ((j) == 16) { const int kr_ = lane < 31 ? lane : 31, vr_ = vkey < 31 ? vkey : 31; \
            kreg = *(const u32x4*)(T.K + (rowbase + kr_) * PITCH + h * 64 + wid * 8); vreg = *(const u32x4*)(T.V + (rowbase + vr_) * PITCH + h * 64 + vcol); } \
        else { const float* kp_ = T.ck + ((size_t)b * cfg::PAST + 64 * (j) + lane) * PITCH + h * 64 + wid * 8; const float* vp_ = T.cv + ((size_t)b * cfg::PAST + 64 * (j) + vkey) * PITCH + h * 64 + vcol; \
            const f32x4 k0_ = *(const f32x4*)kp_, k1_ = *(const f32x4*)(kp_ + 4), v0_ = *(const f32x4*)vp_, v1_ = *(const f32x4*)(vp_ + 4); \
            kreg = (u32x4){cvtpk(k0_[0], k0_[1]), cvtpk(k0_[2], k0_[3]), cvtpk(k1_[0], k1_[1]), cvtpk(k1_[2], k1_[3])}; vreg = (u32x4){cvtpk(v0_[0], v0_[1]), cvtpk(v0_[2], v0_[3]), cvtpk(v1_[0], v1_[1]), cvtpk(v1_[2], v1_[3])}; } } while (0)
    SB_LOAD(jtop);
    for (int j = jtop; j >= 0; --j) {
        SB_LAS char* slot = lds + (j & 1) * SLOTB;
        *(SB_LAS u32x4*)(slot + wid * 1024 + lane * 16) = kreg; *(SB_LAS u32x4*)(slot + 8192 + wid * 1024 + lane * 16) = vreg;
        __syncthreads();
        if (j != jtop) { const volatile SB_LAS unsigned* f = flags + ((j + 1) & 1) * 8; unsigned all = 1u;
#pragma unroll
            for (int w8 = 0; w8 < 8; ++w8) all &= f[w8];
            if (all) break; }
        if (j > 0) SB_LOAD(j - 1);
        if (worker && !done && j <= jd) {
            const int key0 = (SAMPLE && j == 16) ? cfg::PAST : 64 * j;
            sb_tile(slot, j == jd, (j == jd) && (SAMPLE || (wid & 1) == 0), key0 + 4 * hi - qpos, qr, Rb, o, Um, Jm, r32, hi, lane);
            done = __all(Rb[0] > THR2) != 0;
        }
        if (lane == 0) flags[(j & 1) * 8 + wid] = (done || !worker) ? 1u : 0u;
    }
#undef SB_LOAD
    if (worker) {
        SB_LAS bf16_t* stg = (SB_LAS bf16_t*)(lds + OFF_OST) + wid * 2048;
#pragma unroll
        for (int r = 0; r < 16; ++r) { const int orow = crow(r, hi);
#pragma unroll
            for (int d0 = 0; d0 < 2; ++d0) stg[orow * 64 + d0 * 32 + r32] = (bf16_t)(cvtpk(o[d0][r], 0.f) & 0xffffu); }
        asm volatile("s_waitcnt lgkmcnt(0)" ::: "memory");
        bf16_t* Ow = T.O + (rowbase + q0 + 32 * wq) * PITCH + h * 64;
#pragma unroll
        for (int i = 0; i < 4; ++i) { const int row = i * 8 + (lane >> 3), ch = lane & 7; const u32x4 v = *(const SB_LAS u32x4*)(stg + row * 64 + ch * 8); *(u32x4*)(Ow + (size_t)row * PITCH + ch * 8) = v; }
    }
    __syncthreads();
}
}
namespace sk {
typedef short bf16x8 __attribute__((ext_vector_type(8)));
typedef float f32x16 __attribute__((ext_vector_type(16)));
typedef float f32x4 __attribute__((ext_vector_type(4)));
typedef unsigned short bf16_t;
#define SK_LAS __attribute__((address_space(3)))
constexpr int PLD = 36;
constexpr int LDS_BYTES = 8 * 2 * 32 * PLD * 4;
__device__ __forceinline__ f32x4 tile(const bf16_t* A, const bf16_t* Bt, int K, size_t arow0, int col0, SK_LAS char* lds) {
    int tid = threadIdx.x; asm volatile("" : "+v"(tid)); const int lane = tid & 63, r32 = lane & 31, hi = lane >> 5; const int wid = __builtin_amdgcn_readfirstlane(tid >> 6);
    const int nsplit = (K >= 512) ? 8 : (K >> 6), ks = K / nsplit;
    const bf16_t* ap = A + (arow0 + r32) * K + wid * ks + hi * 32;
    const bf16_t* bp0 = Bt + (size_t)(col0 + r32) * K + wid * ks + hi * 32; const bf16_t* bp1 = bp0 + (size_t)32 * K;
    f32x16 acc0 = {}, acc1 = {};
#pragma unroll 2
    for (int s = 0; s < ((wid < nsplit) ? ks : 0); s += 64) {
        bf16x8 a[4], b0[4], b1[4];
#pragma unroll
        for (int j = 0; j < 4; ++j) { a[j] = *(const bf16x8*)(ap + s + 8 * j); b0[j] = *(const bf16x8*)(bp0 + s + 8 * j); b1[j] = *(const bf16x8*)(bp1 + s + 8 * j); }
#pragma unroll
        for (int j = 0; j < 4; ++j) {
            acc0 = __builtin_amdgcn_mfma_f32_32x32x16_bf16(b0[j], a[j], acc0, 0, 0, 0);
            acc1 = __builtin_amdgcn_mfma_f32_32x32x16_bf16(b1[j], a[j], acc1, 0, 0, 0); }
    }
    SK_LAS float* P0 = (SK_LAS float*)lds + ((wid * 2 + 0) * 32 + r32) * PLD + 4 * hi; SK_LAS float* P1 = P0 + 32 * PLD;
#pragma unroll
    for (int g = 0; g < 4; ++g) { *(SK_LAS f32x4*)(P0 + 8 * g) = (f32x4){acc0[4 * g], acc0[4 * g + 1], acc0[4 * g + 2], acc0[4 * g + 3]};
                                  *(SK_LAS f32x4*)(P1 + 8 * g) = (f32x4){acc1[4 * g], acc1[4 * g + 1], acc1[4 * g + 2], acc1[4 * g + 3]}; }
    __syncthreads();
    const int row = tid >> 4, c = (tid & 15) * 4, cb = c >> 5, cc = c & 31;
    f32x4 s = {0.f, 0.f, 0.f, 0.f};
#pragma unroll
    for (int w = 0; w < 8; ++w) s += *(const SK_LAS f32x4*)((SK_LAS float*)lds + ((w * 2 + cb) * 32 + row) * PLD + cc);
    __syncthreads();
    return s;
}
__device__ __forceinline__ void tile4(const bf16_t* A, const bf16_t* Bt, int K, size_t arow0, int col0, SK_LAS char* lds, f32x4 (&out)[2][2]) {
    int tid = threadIdx.x; asm volatile("" : "+v"(tid)); const int lane = tid & 63, r32 = lane & 31, hi = lane >> 5; const int wid = __builtin_amdgcn_readfirstlane(tid >> 6);
    const int half = wid >> 2, kq = wid & 3, ks = K >> 2;
    const bf16_t* ap = A + (arow0 + r32) * K + kq * ks + hi * 32;
    const bf16_t* bp = Bt + (size_t)(col0 + half * 128 + r32) * K + kq * ks + hi * 32;
    f32x16 acc[4]; acc[0] = f32x16{}; acc[1] = f32x16{}; acc[2] = f32x16{}; acc[3] = f32x16{};
#pragma unroll 1
    for (int s = 0; s < ks; s += 64) {
        bf16x8 a[4], b[4][4];
#pragma unroll
        for (int e = 0; e < 4; ++e) { a[e] = *(const bf16x8*)(ap + s + 8 * e);
#pragma unroll
            for (int j = 0; j < 4; ++j) b[j][e] = *(const bf16x8*)(bp + (size_t)(32 * j) * K + s + 8 * e); }
#pragma unroll
        for (int e = 0; e < 4; ++e)
#pragma unroll
            for (int j = 0; j < 4; ++j) acc[j] = __builtin_amdgcn_mfma_f32_32x32x16_bf16(b[j][e], a[e], acc[j], 0, 0, 0);
    }
    const int row = tid >> 4, cc = (tid & 15) * 4;
#pragma unroll
    for (int q = 0; q < 2; ++q) {
        SK_LAS float* P0 = (SK_LAS float*)lds + ((wid * 2 + 0) * 32 + r32) * PLD + 4 * hi; SK_LAS float* P1 = P0 + 32 * PLD;
#pragma unroll
        for (int g = 0; g < 4; ++g) { *(SK_LAS f32x4*)(P0 + 8 * g) = (f32x4){acc[2 * q][4 * g], acc[2 * q][4 * g + 1], acc[2 * q][4 * g + 2], acc[2 * q][4 * g + 3]};
                                      *(SK_LAS f32x4*)(P1 + 8 * g) = (f32x4){acc[2 * q + 1][4 * g], acc[2 * q + 1][4 * g + 1], acc[2 * q + 1][4 * g + 2], acc[2 * q + 1][4 * g + 3]}; }
        __syncthreads();
#pragma unroll
        for (int h = 0; h < 2; ++h) { f32x4 sum = {0.f, 0.f, 0.f, 0.f};
#pragma unroll
            for (int w = 0; w < 4; ++w) sum += *(const SK_LAS f32x4*)((SK_LAS float*)lds + (((h * 4 + w) * 2 + (cc >> 5)) * 32 + row) * PLD + (cc & 31));
            out[h][q] = sum; }
        __syncthreads();
    }
}
__device__ __forceinline__ float sum16(float v) { v += __shfl_xor(v, 1); v += __shfl_xor(v, 2); v += __shfl_xor(v, 4); v += __shfl_xor(v, 8); return v; }
__device__ __forceinline__ float rstd16(const float* SSQ, int r, int t) { return __builtin_amdgcn_rsqf(sum16(SSQ[(size_t)r * 16 + (t & 15)]) * (1.0f / 1024.0f) + cfg::EPS); }
__device__ __forceinline__ unsigned long long pk4(f32x4 v) { return (unsigned long long)pg8::cvt_pk_bf16(v[0], v[1]) | ((unsigned long long)pg8::cvt_pk_bf16(v[2], v[3]) << 32); }
__device__ __forceinline__ f32x4 up4(unsigned long long w) { const unsigned lo = (unsigned)w, hi = (unsigned)(w >> 32); return (f32x4){pg8::bf_lo(lo), pg8::bf_hi(lo), pg8::bf_lo(hi), pg8::bf_hi(hi)}; }
}
#define GAS __attribute__((address_space(1)))
#define LAS __attribute__((address_space(3)))
typedef unsigned short bf16;
typedef unsigned v4u __attribute__((ext_vector_type(4)));
typedef float f32x4 __attribute__((ext_vector_type(4)));
typedef short bf16x8 __attribute__((ext_vector_type(8)));
typedef GAS unsigned gu32;
typedef GAS unsigned long long gu64;
#define RLX_AGENT __ATOMIC_RELAXED, __HIP_MEMORY_SCOPE_AGENT
#define LDS_WAIT() asm volatile("s_waitcnt lgkmcnt(0)" ::: "memory")
#define VM_WAIT() asm volatile("s_waitcnt vmcnt(0)" ::: "memory")
__device__ __forceinline__ unsigned long long rt() { return __builtin_amdgcn_s_memrealtime(); }
__device__ __forceinline__ unsigned f2bf(float f) { unsigned u = __builtin_bit_cast(unsigned, f); return (u + 0x7fffu + ((u >> 16) & 1u)) >> 16; }
__device__ __forceinline__ unsigned pk2(float lo, float hi) { return f2bf(lo) | (f2bf(hi) << 16); }
#define XB_TMO      128
#define XB_XCNT(j)  (256  + 64 * (j))
#define XB_XSUB(j)  (1280 + 64 * (j))
#define XB_XGEN(j)  (2304 + 64 * (j))
#define XB_TOP      3328
#define XB_TOPGEN   3392
#define XCD_BAR_WORDS 3456
#define XB_SPIN_CAP (1u << 18)

__device__ __forceinline__ unsigned xb_ld(unsigned* p)              { return __hip_atomic_load(p, __ATOMIC_RELAXED, __HIP_MEMORY_SCOPE_AGENT); }
__device__ __forceinline__ unsigned xb_add(unsigned* p, unsigned v) { return __hip_atomic_fetch_add(p, v, __ATOMIC_RELAXED, __HIP_MEMORY_SCOPE_AGENT); }
__device__ __forceinline__ unsigned xb_xcc_id() { return (unsigned)__builtin_amdgcn_s_getreg((3 << 11) | 20) & 0xFu; }
#define XB_SPIN(cond, bar) do { unsigned _sp = 0; while (cond) { __builtin_amdgcn_s_sleep(1); \
    if ((++_sp & 255u) == 0u) { if (xb_ld(&(bar)[XB_TMO])) break; if (_sp > XB_SPIN_CAP) { atomicAdd(&(bar)[XB_TMO], 1u); break; } } } } while (0)

struct XcdBarrier {
    unsigned* bar; unsigned x;
    volatile LAS unsigned* st;
};

__device__ __forceinline__ XcdBarrier xcd_barrier_post(unsigned* bar, volatile LAS unsigned* st) {
    XcdBarrier b; b.bar = bar; b.x = xb_xcc_id(); b.st = st;
    if (threadIdx.x == 0) (void)xb_add(&bar[XB_XCNT(b.x)], 1u);
    return b;
}
__device__ __forceinline__ void xcd_barrier_complete(unsigned* bar, unsigned x, unsigned& nloc, unsigned& nx) {
    const unsigned G = gridDim.x * gridDim.y * gridDim.z;
    unsigned sum, cnt, mine, sp = 0u;
    for (;;) {
        sum = 0u; cnt = 0u; mine = 0u;
#pragma unroll
        for (unsigned j = 0; j < 16; ++j) { const unsigned c = xb_ld(&bar[XB_XCNT(j)]); sum += c; cnt += (c > 0u) ? 1u : 0u; mine = (j == x) ? c : mine; }
        if (sum == G) break;
        __builtin_amdgcn_s_sleep(1);
        if ((++sp & 255u) == 0u) { if (xb_ld(&bar[XB_TMO])) break; if (sp > XB_SPIN_CAP) { atomicAdd(&bar[XB_TMO], 1u); break; } }
    }
    nloc = mine > 0u ? mine : 1u; nx = cnt > 0u ? cnt : 1u;
}

__device__ __forceinline__ void xcd_barrier(const XcdBarrier& b) {
    asm volatile("s_waitcnt vmcnt(0)" ::: "memory");
    __syncthreads();
    if (threadIdx.x == 0) {
        unsigned* bar = b.bar;
        __builtin_amdgcn_s_waitcnt(0);
        unsigned nloc = b.st[0], nx = b.st[1];
        if (nloc == 0u) { xcd_barrier_complete(bar, b.x, nloc, nx); b.st[0] = nloc; b.st[1] = nx; }
        const unsigned old = xb_add(&bar[XB_XSUB(b.x)], 1u);
        const unsigned gen = old / nloc;
        if (old + 1u == (gen + 1u) * nloc) {
            __builtin_amdgcn_fence(__ATOMIC_RELEASE, "agent");
            asm volatile("s_waitcnt vmcnt(0)" ::: "memory");
            const unsigned og = xb_add(&bar[XB_TOP], 1u);
            const unsigned tg = og / nx;
            if (og + 1u == (tg + 1u) * nx) xb_add(&bar[XB_TOPGEN], 1u);
            else XB_SPIN(xb_ld(&bar[XB_TOPGEN]) == tg, bar);
            __builtin_amdgcn_fence(__ATOMIC_ACQUIRE, "agent");
            xb_add(&bar[XB_XGEN(b.x)], 1u);
            asm volatile("s_waitcnt vmcnt(0)" ::: "memory");
        } else {
            XB_SPIN(xb_ld(&bar[XB_XGEN(b.x)]) == gen, bar);
            __builtin_amdgcn_fence(__ATOMIC_ACQUIRE, "agent");
            asm volatile("s_waitcnt vmcnt(0)" ::: "memory");
        }
    }
    __syncthreads();
}
__device__ __forceinline__ float wave_sum(float v) {
#pragma unroll
    for (int o = 1; o < 64; o <<= 1) v += __shfl_xor(v, o);
    return v;
}
__device__ __forceinline__ void p0_transpose_item(const float* W, int K, int N, bf16* WT, int row_off, LAS float* scr, int item, int lane) {
    const int nblk = N / 32, kb = item / nblk, nb = item % nblk, k0 = 64 * kb, n0 = 32 * nb;
    float tv[32];
#pragma unroll
    for (int i = 0; i < 32; ++i) { const int kk = 2 * i + (lane >> 5); tv[i] = W[(size_t)(k0 + kk) * N + n0 + (lane & 31)]; }
#pragma unroll
    for (int i = 0; i < 32; ++i) { const int kk = 2 * i + (lane >> 5); scr[kk * 33 + (lane & 31)] = tv[i]; }
    LDS_WAIT(); asm volatile("" ::: "memory");
    const int c = lane & 7;
#pragma unroll
    for (int j = 0; j < 4; ++j) { const int n = (lane >> 3) + 8 * j; const LAS float* s = scr + (8 * c) * 33 + n;
        v4u o; o.x = pk2(s[0 * 33], s[1 * 33]); o.y = pk2(s[2 * 33], s[3 * 33]); o.z = pk2(s[4 * 33], s[5 * 33]); o.w = pk2(s[6 * 33], s[7 * 33]);
        *(GAS v4u*)(WT + (size_t)(row_off + n0 + n) * K + k0 + 8 * c) = o; }
    LDS_WAIT(); asm volatile("" ::: "memory");
}
constexpr int NWAVES = 8;
#ifndef MK_N_LAUNCHES
#define MK_N_LAUNCHES 1
#endif
constexpr int N_PHASES = 8;
#ifndef DBG_ROT
#define DBG_ROT 0
#endif
#ifndef DBG_REPEAT
#define DBG_REPEAT -1
#endif
#ifndef DBG_P2PART
#define DBG_P2PART 0
#endif
#ifndef DBG_ALIGN
#define DBG_ALIGN true
#endif
#ifndef DBG_SP2
#define DBG_SP2 true
#endif
using namespace cfg;
constexpr size_t MiB = 1u << 20;
constexpr size_t WS_CTL = 0, CTL_ZERO_BYTES = 1 * MiB;
constexpr size_t WS_WIN = 2 * MiB, WS_WEFF = 10 * MiB, WS_WSB = 11 * MiB, WS_WOUT = 12 * MiB, WS_WUP = 14 * MiB, WS_WDOWN = 22 * MiB, WS_WPG = 30 * MiB, WS_WPP = 32 * MiB;
constexpr size_t WS_SSQ1 = 33 * MiB, WS_SSQ2 = 35 * MiB, WS_SSQ3 = 37 * MiB;
constexpr size_t WS_PB = 40 * MiB;
constexpr size_t WS_XN = 49 * MiB;
constexpr size_t WS_BIG = 82 * MiB;
constexpr size_t WS_U = WS_BIG, WS_Q = WS_BIG + 16 * MiB + MiB / 2, WS_K = WS_BIG + 33 * MiB, WS_V = WS_BIG + 49 * MiB + MiB / 2;
constexpr size_t WS_G = WS_BIG + 66 * MiB;
constexpr size_t WS_Y = WS_BIG + 132 * MiB, WS_YSB = WS_Y + 16 * MiB + MiB / 2;
constexpr size_t WS_MG = WS_BIG;
constexpr size_t WS_H = WS_BIG;
constexpr size_t WS_PP = WS_BIG;
constexpr size_t WS_X = WS_Y;
constexpr size_t WS_END = WS_BIG + 165 * MiB;
static_assert((size_t)MT * 512 * 2 == 16 * MiB + MiB / 2 && (size_t)MT * 1024 * 2 == 33 * MiB && (size_t)MT * 16 * 4 <= 2 * MiB && (size_t)MT * 256 * 2 <= 9 * MiB && WS_END <= 256 * MiB, "d_ws map");
constexpr int CW_BAR = 4096, CW_FIN = 8192  , CW_FINS = 16384  ;
constexpr size_t O_Y = 0, O_KP = 17301504, O_VP = 25690112, O_POOLP = 34078720, O_KS = 34140160, O_VS = 34402304, O_POOLS = 34664448, O_END = 34787328;
constexpr int RING_OFF = 0, RING_BYTES = 131072, LDSCTL_OFF = RING_BYTES, MISC_OFF = LDSCTL_OFF + 320, LDS_BYTES = 147456;
static_assert(sk::LDS_BYTES <= RING_BYTES && sba::LDS_BYTES <= RING_BYTES, "attention scratch fits the ring region");

struct Args { const float* in[22]; float* out; unsigned char* ws; int ph_lo, ph_hi, li, pad; };

__device__ __forceinline__ void rms_rows_to_bf16(const float* xrow0, const float* xrow1, const float* g, bf16* orow0, bf16* orow1, int lane) {
    const GAS f32x4* xr0 = (const GAS f32x4*)xrow0 + lane; const GAS f32x4* xr1 = (const GAS f32x4*)(xrow1 ? xrow1 : xrow0) + lane; const GAS f32x4* gr = (const GAS f32x4*)g + lane;
    f32x4 v[4], w[4], gg[4]; float s = 0.f, t = 0.f;
#pragma unroll
    for (int j = 0; j < 4; ++j) { v[j] = xr0[64 * j]; w[j] = xr1[64 * j]; gg[j] = gr[64 * j]; }
#pragma unroll
    for (int j = 0; j < 4; ++j) { s += (v[j].x * v[j].x + v[j].y * v[j].y) + (v[j].z * v[j].z + v[j].w * v[j].w); t += (w[j].x * w[j].x + w[j].y * w[j].y) + (w[j].z * w[j].z + w[j].w * w[j].w); }
#pragma unroll
    for (int o = 1; o < 64; o <<= 1) { s += __shfl_xor(s, o); t += __shfl_xor(t, o); }
    const float rs = 1.f / sqrtf(s * (1.f / DM) + EPS), rt = 1.f / sqrtf(t * (1.f / DM) + EPS);
    GAS unsigned long long* o0 = (GAS unsigned long long*)orow0 + lane; GAS unsigned long long* o1 = (GAS unsigned long long*)orow1 + lane;
#pragma unroll
    for (int j = 0; j < 4; ++j) { o0[64 * j] = (unsigned long long)pk2(v[j].x * rs * gg[j].x, v[j].y * rs * gg[j].y) | ((unsigned long long)pk2(v[j].z * rs * gg[j].z, v[j].w * rs * gg[j].w) << 32);
        if (xrow1) o1[64 * j] = (unsigned long long)pk2(w[j].x * rt * gg[j].x, w[j].y * rt * gg[j].y) | ((unsigned long long)pk2(w[j].z * rt * gg[j].z, w[j].w * rt * gg[j].w) << 32); }
}
__device__ __forceinline__ void weff_item(const float* wgrp, const float* scale, const float* wpu, bf16* WT, int item, int lane) {
    const int nb = item & 15, cb = (item >> 4) & 15, g = item >> 8, n = nb * 64 + lane;
    float wg[8][2];
#pragma unroll
    for (int cc = 0; cc < 8; ++cc)
#pragma unroll
        for (int hh = 0; hh < 2; ++hh) wg[cc][hh] = wgrp[((size_t)(g * 128 + cb * 8 + cc)) * 128 + lane + 64 * hh] * scale[g * 128 + lane + 64 * hh];
    float acc[8];
#pragma unroll
    for (int cc = 0; cc < 8; ++cc) acc[cc] = 0.f;
#pragma unroll
    for (int hh = 0; hh < 2; ++hh)
#pragma unroll 16
        for (int d2 = 0; d2 < 64; ++d2) { const float wv = wpu[(size_t)(g * 128 + hh * 64 + d2) * 1024 + n];
#pragma unroll
            for (int cc = 0; cc < 8; ++cc) acc[cc] = fmaf(__builtin_bit_cast(float, __builtin_amdgcn_readlane(__builtin_bit_cast(int, wg[cc][hh]), d2)), wv, acc[cc]); }
    v4u o; o.x = pk2(acc[0], acc[1]); o.y = pk2(acc[2], acc[3]); o.z = pk2(acc[4], acc[5]); o.w = pk2(acc[6], acc[7]);
    *(GAS v4u*)(WT + (size_t)n * 512 + g * 128 + cb * 8) = o;
}

template <int W, int R>
__device__ __forceinline__ void pool_run(const bf16* Ub, const float* state_pool, bf16* Yb, int run, int c) {
    const int r0 = run * R; const bool sample = r0 >= MP; const int t0 = sample ? ((r0 - MP) & 31) : (r0 & (SEQ - 1)); const int b_ = sample ? ((r0 - MP) >> 5) : 0;
    v4u rw[R - 1 + W];
#pragma unroll
    for (int k = 0; k < W - 1; ++k) { const int pos = t0 + k - (W - 1);
        if (pos >= 0) rw[k] = *(const GAS v4u*)(Ub + (size_t)(r0 - (W - 1) + k) * 512 + c);
        else if (sample) { const float* sp = state_pool + ((size_t)b_ * 15 + 15 + pos) * 512 + c; const f32x4 a = *(const GAS f32x4*)sp, b = *(const GAS f32x4*)(sp + 4); rw[k] = pg8::pack8(a, b); }
        else rw[k] = (v4u){0u, 0u, 0u, 0u}; }
#pragma unroll
    for (int k = W - 1; k < R - 1 + W; ++k) rw[k] = *(const GAS v4u*)(Ub + (size_t)(r0 - (W - 1) + k) * 512 + c);
    f32x4 s0 = {0.f, 0.f, 0.f, 0.f}, s1 = {0.f, 0.f, 0.f, 0.f};
#pragma unroll
    for (int k = 0; k < W - 1; ++k) { f32x4 a, b; pg8::unpack8(rw[k], a, b); s0 += a; s1 += b; }
#pragma unroll
    for (int i = 0; i < R; ++i) { f32x4 a, b, u0, u1; pg8::unpack8(rw[W - 1 + i], u0, u1); s0 += u0; s1 += u1;
        const int cnt = sample ? W : ((t0 + i + 1 < W) ? t0 + i + 1 : W); const float ic = 1.0f / (float)cnt;
        *(GAS v4u*)(Yb + (size_t)(r0 + i) * 512 + c) = pg8::pack8(s0 * ic - u0, s1 * ic - u1);
        pg8::unpack8(rw[i], a, b); s0 -= a; s1 -= b; }
}
#if defined(HYB_ATTN) || defined(HYB_POOL)
__device__ __forceinline__ float hb2f(unsigned short v) { return __uint_as_float((unsigned)v << 16); }
__global__ void __launch_bounds__(64) hyb_attn(const unsigned short* Qb, const unsigned short* Kb, const unsigned short* Vb, const float* ck, const float* cv, unsigned short* YSB) {
    const int idx = blockIdx.x * 64 + threadIdx.x; if (idx >= MT * NH) return;
    const int h = idx / MT, m = idx % MT;
    float qr[HD], o[HD];
#pragma unroll
    for (int d = 0; d < HD; ++d) { qr[d] = hb2f(Qb[(size_t)m * 512 + h * HD + d]) * 0.6931471805599453f; o[d] = 0.f; }
    float S = 0.f; bool done = false; size_t kb; int nk;
    if (m < MP) { kb = (size_t)(m / SEQ) * SEQ; nk = m % SEQ; } else { const int ms = m - MP; kb = (size_t)MP + (size_t)(ms / DS) * DS; nk = ms % DS; }
    for (int s = nk - 1; s >= 0 && !done; --s) {
        const unsigned short* kr = Kb + (kb + s) * 512 + h * HD; const unsigned short* vr = Vb + (kb + s) * 512 + h * HD; float z = 0.f;
#pragma unroll
        for (int d = 0; d < HD; ++d) z = fmaf(qr[d], hb2f(kr[d]), z);
        const float sp = fmaxf(z, 0.f) + log1pf(expf(-fabsf(z))), a = expf(z - sp - S);
#pragma unroll
        for (int d = 0; d < HD; ++d) o[d] = fmaf(a, hb2f(vr[d]), o[d]);
        S += sp; if (S > 110.f) done = true;
    }
    if (m >= MP) { const int b = (m - MP) / DS; const float* kc = ck + (size_t)b * PAST * 512 + h * HD; const float* vc = cv + (size_t)b * PAST * 512 + h * HD;
        for (int s = PAST - 1; s >= 0 && !done; --s) {
            const float* kr = kc + (size_t)s * 512; const float* vr = vc + (size_t)s * 512; float z = 0.f;
#pragma unroll
            for (int d = 0; d < HD; ++d) z = fmaf(qr[d], kr[d], z);
            const float sp = fmaxf(z, 0.f) + log1pf(expf(-fabsf(z))), a = expf(z - sp - S);
#pragma unroll
            for (int d = 0; d < HD; ++d) o[d] = fmaf(a, vr[d], o[d]);
            S += sp; if (S > 110.f) done = true;
        } }
#pragma unroll
    for (int d = 0; d < HD; ++d) YSB[(size_t)m * 512 + h * HD + d] = (unsigned short)f2bf(o[d]);
}
__global__ void hyb_pool(const unsigned short* Ub, const float* state_pool, unsigned short* Yb) {
    const size_t i = (size_t)blockIdx.x * blockDim.x + threadIdx.x; if (i >= (size_t)MT * PW) return;
    const int m = (int)(i / PW), c = (int)(i % PW), g = c / 128, w = 2 << g;
    float s = 0.f; float cnt;
    if (m < MP) { const int t = m % SEQ; const int n = (t + 1 < w) ? t + 1 : w; for (int j = 0; j < n; ++j) s += hb2f(Ub[(size_t)(m - j) * PW + c]); cnt = (float)n; }
    else { const int ms = m - MP, b = ms / DS, t = ms % DS; for (int j = 0; j < w; ++j) { const int r = 15 + t - j; s += (r >= 15) ? hb2f(Ub[(size_t)(m - j) * PW + c]) : state_pool[((size_t)b * 15 + r) * PW + c]; } cnt = (float)w; }
    Yb[i] = (unsigned short)f2bf(s / cnt - hb2f(Ub[i]));
}
#endif

__global__ void __launch_bounds__(NWAVES * 64, 2) mega_fwd(Args args) {
    extern __shared__ __attribute__((aligned(16))) unsigned char lds[];
    LAS unsigned char* L = (LAS unsigned char*)lds;
    volatile LAS unsigned* MISC = (volatile LAS unsigned*)(L + MISC_OFF);
    const int wave = __builtin_amdgcn_readfirstlane(threadIdx.x >> 6);
#define FRESH_TID() int tid = threadIdx.x; asm volatile("" : "+v"(tid)); const int lane = tid & 63; (void)lane
    const int G = gridDim.x, bx = blockIdx.x, vcu = (G % 8 == 0) ? (bx % 8) * (G / 8) + bx / 8 : bx;
    unsigned char* ws = args.ws;
    gu32* ctl = (gu32*)(ws + WS_CTL);
    const float* x_p = args.in[0]; const float* x_s = args.in[1]; const float* cache_k = args.in[2]; const float* cache_v = args.in[3]; const float* state_pool = args.in[4];
    const float* p_p = args.in[5]; const float* p_s = args.in[6]; const float* g_mix = args.in[7]; const float* w_in = args.in[8]; const float* b_gate = args.in[9]; const float* w_grp = args.in[10];
    const float* pool_scale = args.in[11]; const float* w_pool_up = args.in[12]; const float* w_sb_up = args.in[13]; const float* w_out = args.in[14]; const float* g_mlp = args.in[15];
    const float* w_up = args.in[16]; const float* w_down = args.in[17]; const float* g_ple = args.in[18]; const float* w_ple_gate = args.in[19]; const float* w_ple_proj = args.in[20]; const float* g_final = args.in[21];
    float* out = args.out; float* Yo = out + O_Y;
    bf16 *WIN = (bf16*)(ws + WS_WIN), *WEFF = (bf16*)(ws + WS_WEFF), *WSB = (bf16*)(ws + WS_WSB), *WOUT = (bf16*)(ws + WS_WOUT), *WUP = (bf16*)(ws + WS_WUP), *WDOWN = (bf16*)(ws + WS_WDOWN), *WPG = (bf16*)(ws + WS_WPG), *WPP = (bf16*)(ws + WS_WPP);
    float *SSQ1 = (float*)(ws + WS_SSQ1), *SSQ2 = (float*)(ws + WS_SSQ2), *SSQ3 = (float*)(ws + WS_SSQ3);
    bf16 *PB = (bf16*)(ws + WS_PB), *XN = (bf16*)(ws + WS_XN), *Ub = (bf16*)(ws + WS_U), *Qb = (bf16*)(ws + WS_Q), *Kb = (bf16*)(ws + WS_K), *Vb = (bf16*)(ws + WS_V), *Gb = (bf16*)(ws + WS_G);
    bf16 *Yb = (bf16*)(ws + WS_Y), *YSB = (bf16*)(ws + WS_YSB), *MG = (bf16*)(ws + WS_MG), *Hb = (bf16*)(ws + WS_H), *PPb = (bf16*)(ws + WS_PP), *Xb = (bf16*)(ws + WS_X);

    for (int i = threadIdx.x; i < (LDS_BYTES - LDSCTL_OFF) / 4; i += NWAVES * 64) ((LAS unsigned*)(L + LDSCTL_OFF))[i] = 0u;
    __syncthreads();
    XcdBarrier bar; bar.bar = (unsigned*)(ctl + CW_BAR); bar.x = 0; bar.st = nullptr;
    if (MK_N_LAUNCHES == 1) bar = xcd_barrier_post((unsigned*)(ctl + CW_BAR), MISC + 8);
    const int lo = args.ph_lo, hi = args.ph_hi;
#define IN(k) (lo <= (k) && (k) < hi)
#ifdef DBG_BARCHK
#define SEAM(k) do { if (IN(k) && IN((k) + 1)) { if (threadIdx.x == 0) __hip_atomic_fetch_add((unsigned*)(ctl + 65536 + 64 * (k)), 1u, __ATOMIC_RELAXED, __HIP_MEMORY_SCOPE_AGENT); xcd_barrier(bar); \
    if (threadIdx.x == 0) { const unsigned v_ = __hip_atomic_load((unsigned*)(ctl + 65536 + 64 * (k)), __ATOMIC_RELAXED, __HIP_MEMORY_SCOPE_AGENT); if (v_ != (unsigned)G) { __hip_atomic_store((unsigned*)(ctl + 65536 + 64 * 32), 1u, __ATOMIC_RELAXED, __HIP_MEMORY_SCOPE_AGENT); out[O_KP + (k)] = __builtin_nanf(""); } } } } while (0)
#else
#define SEAM(k) do { if (IN(k) && IN((k) + 1)) xcd_barrier(bar); } while (0)
#endif
    const int gw = vcu * NWAVES + wave, NGW = G * NWAVES;
    const bool late_ = (vcu & 1) != 0;

#pragma unroll 1
    for (int rep_ = 0; rep_ < ((IN(0)) ? ((DBG_REPEAT == 0) ? 2 : 1) : 0); ++rep_) {
        if (rep_ > 0) xcd_barrier(bar);
        FRESH_TID();
        LAS float* scr = (LAS float*)(L + RING_OFF + wave * 16384);
        constexpr int I_IN = (DM / 64) * (INW / 32), I_SB = (SBW / 64) * (DM / 32), I_OUT = (DM / 64) * (DM / 32), I_UP = (DM / 64) * (DFF / 32), I_DOWN = (DFF / 64) * (DM / 32), I_PG = I_OUT, I_PP = (PLE / 64) * (DM / 32), I_EFF = 4 * 16 * 16;
        constexpr int NITEMS = I_IN + I_SB + I_OUT + I_UP + I_DOWN + I_PG + I_PP + I_EFF;
        for (int it = gw; it < NITEMS; it += NGW) {
            int r = it;
            if (r < I_EFF) { weff_item(w_grp, pool_scale, w_pool_up, WEFF, r, lane); continue; } r -= I_EFF;
            if (r < I_IN) { p0_transpose_item(w_in, DM, INW, WIN, 0, scr, r, lane); continue; } r -= I_IN;
            if (r < I_SB) { p0_transpose_item(w_sb_up, SBW, DM, WSB, 0, scr, r, lane); continue; } r -= I_SB;
            if (r < I_OUT) { p0_transpose_item(w_out, DM, DM, WOUT, 0, scr, r, lane); continue; } r -= I_OUT;
            if (r < I_UP) { p0_transpose_item(w_up, DM, DFF, WUP, 0, scr, r, lane); continue; } r -= I_UP;
            if (r < I_DOWN) { p0_transpose_item(w_down, DFF, DM, WDOWN, 0, scr, r, lane); continue; } r -= I_DOWN;
            if (r < I_PG) { p0_transpose_item(w_ple_gate, DM, DM, WPG, 0, scr, r, lane); continue; } r -= I_PG;
            p0_transpose_item(w_ple_proj, PLE, DM, WPP, 0, scr, r, lane);
        }
        for (int m = gw; m < MT; m += 2 * NGW) { const int m1 = m + NGW; const bool two = m1 < MT;
            const float* xr0 = m < MP ? x_p + (size_t)m * DM : x_s + (size_t)(m - MP) * DM;
            const float* xr1 = !two ? nullptr : (m1 < MP ? x_p + (size_t)m1 * DM : x_s + (size_t)(m1 - MP) * DM);
            const float* pr0 = m < MP ? p_p + (size_t)m * PLE : p_s + (size_t)(m - MP) * PLE;
            const float* pr1 = !two ? pr0 : (m1 < MP ? p_p + (size_t)m1 * PLE : p_s + (size_t)(m1 - MP) * PLE);
            const f32x4 pv0 = *((const GAS f32x4*)pr0 + lane), pv1 = *((const GAS f32x4*)pr1 + lane);
            rms_rows_to_bf16(xr0, xr1, g_mix, XN + (size_t)m * DM, XN + (size_t)(two ? m1 : m) * DM, lane);
            *((GAS unsigned long long*)(PB + (size_t)m * PLE) + lane) = (unsigned long long)pk2(pv0.x, pv0.y) | ((unsigned long long)pk2(pv0.z, pv0.w) << 32);
            if (two) *((GAS unsigned long long*)(PB + (size_t)m1 * PLE) + lane) = (unsigned long long)pk2(pv1.x, pv1.y) | ((unsigned long long)pk2(pv1.z, pv1.w) << 32);
        }
    }
    SEAM(0);
#pragma unroll 1
    for (int rep_ = 0; rep_ < ((IN(1)) ? ((DBG_REPEAT == 1) ? 2 : 1) : 0); ++rep_) {
        if (rep_ > 0) xcd_barrier(bar);
#pragma unroll 1
        for (int pass_ = 0; pass_ < 2; ++pass_) if ((pass_ == 1) == late_) {
        for (int task = vcu; task < 16 * (INW / 256); task += G) { const int rb = task & 15, col0 = (task >> 4) * 256; f32x4 vv[2][2];
            sk::tile4(XN, WIN, DM, (size_t)MP + rb * 32, col0, (SK_LAS char*)(L + RING_OFF), vv);
            const int t = threadIdx.x, rs = rb * 32 + (t >> 4), r = MP + rs;
#pragma unroll
            for (int h = 0; h < 2; ++h)
#pragma unroll
                for (int q = 0; q < 2; ++q) { const f32x4 v = vv[h][q]; const int c = col0 + 128 * h + 64 * q + (t & 15) * 4;
            if (c < 512) { *(GAS unsigned long long*)(Ub + (size_t)r * 512 + c) = sk::pk4(v); const int i = rs & 31; if (i >= 17) *(GAS f32x4*)(out + O_POOLS + ((size_t)(rs >> 5) * 15 + (i - 17)) * 512 + c) = v; }
            else if (c < 1024) *(GAS unsigned long long*)(Qb + (size_t)r * 512 + c - 512) = sk::pk4(v * QSCALE);
            else if (c < 1536) { *(GAS unsigned long long*)(Kb + (size_t)r * 512 + c - 1024) = sk::pk4(v); *(GAS f32x4*)(out + O_KS + (size_t)rs * 512 + c - 1024) = v; }
            else if (c < 2048) { *(GAS unsigned long long*)(Vb + (size_t)r * 512 + c - 1536) = sk::pk4(v); *(GAS f32x4*)(out + O_VS + (size_t)rs * 512 + c - 1536) = v; }
            else { const f32x4 bg = *(const GAS f32x4*)(b_gate + c - 2048); *(GAS unsigned long long*)(Gb + (size_t)r * 2048 + c - 2048) = sk::pk4(pg8::sigm4(v + bg)); } }
        }
        } else {
        pg8::Gemm g{XN, WIN, MP, INW, DM}; pg8::RotOrder S; S.init(MP, INW, G, bx, DBG_ROT);
        pg8::EpiIn E{Ub, Qb, Kb, Vb, Gb, b_gate, out + O_KP, out + O_VP, out + O_KS, out + O_VS, out + O_POOLP, out + O_POOLS};
        pg8::gemm_phase<pg8::EpiIn, pg8::RotOrder, DBG_ALIGN, DBG_SP2>(L + RING_OFF, g, S, E);
        }
#ifdef DBG_PREDELAY
        { const unsigned long long t0_ = __builtin_amdgcn_s_memrealtime(); while (__builtin_amdgcn_s_memrealtime() - t0_ < DBG_PREDELAY) __builtin_amdgcn_s_sleep(16); __syncthreads(); }
#endif
#ifdef DBG_PREFENCE
        __threadfence(); __syncthreads();
#endif
    }
    SEAM(1);
#ifdef DBG_GDUMP
#ifndef DBG_DUMPBUF
#define DBG_DUMPBUF WS_G
#define DBG_DUMPLD 2048
#endif
    for (int it = (vcu * NWAVES * 64 + (int)threadIdx.x); it < MT * 128; it += G * NWAVES * 64) {
        const int m = it >> 7, c = (it & 127) * 8; const v4u w = *(const GAS v4u*)((const bf16*)(ws + DBG_DUMPBUF) + (size_t)m * DBG_DUMPLD + ((DBG_GDUMP + c) % DBG_DUMPLD)); f32x4 a, b; pg8::unpack8(w, a, b);
        *(GAS f32x4*)(Yo + (size_t)m * 1024 + c) = a; *(GAS f32x4*)(Yo + (size_t)m * 1024 + c + 4) = b; }
#endif
#ifdef DBG_DELAY
    { const unsigned long long t0_ = __builtin_amdgcn_s_memrealtime(); while (__builtin_amdgcn_s_memrealtime() - t0_ < DBG_DELAY) __builtin_amdgcn_s_sleep(16); __syncthreads(); }
#endif
#ifndef DBG_SKIP_P2
#define DBG_SKIP_P2 0
#endif
    if (IN(2) && (DBG_SKIP_P2 & 8)) {
        for (int it = (vcu * NWAVES * 64 + (int)threadIdx.x); it < MT * 64; it += G * NWAVES * 64) {
            const int m = it >> 6, c = (it & 63) * 8; f32x4 a, b;
            for (int e = 0; e < 4; ++e) { a[e] = (float)(((m * 31 + (c + e) * 17) & 255) - 128) * (1.0f / 128.0f); b[e] = (float)(((m * 13 + (c + 4 + e) * 29) & 255) - 128) * (1.0f / 128.0f); }
            *(GAS v4u*)(Yb + (size_t)m * 512 + c) = pg8::pack8(a, b); *(GAS v4u*)(YSB + (size_t)m * 512 + c) = pg8::pack8(b, a);
            if (DBG_SKIP_P2 & 16) { *(GAS v4u*)(MG + (size_t)m * 1024 + c) = pg8::pack8(a, b); *(GAS v4u*)(MG + (size_t)m * 1024 + 512 + c) = pg8::pack8(b, a); }
        }
    }
#pragma unroll 1
    for (int rep_ = 0; rep_ < ((IN(2) && !(DBG_SKIP_P2 & 12)) ? ((DBG_REPEAT == 2) ? 2 : 1) : 0); ++rep_) {
        if (rep_ > 0) xcd_barrier(bar);
        FRESH_TID();
        const bool do_pool_ = (rep_ == 0) || DBG_P2PART == 0 || DBG_P2PART == 1, do_att_ = (rep_ == 0) || DBG_P2PART == 0 || DBG_P2PART == 2, do_sam_ = (rep_ == 0) || DBG_P2PART == 0 || DBG_P2PART == 3;
        if (do_pool_)
        for (int wi = wave * G + vcu; wi < 4 * (MT / 64); wi += NGW) { const int g = wi & 3, run = (wi >> 2) * 4 + (lane >> 4), c = g * 128 + (lane & 15) * 8;
            if (g == 0) pool_run<2, 16>(Ub, state_pool, Yb, run, c); else if (g == 1) pool_run<4, 16>(Ub, state_pool, Yb, run, c); else if (g == 2) pool_run<8, 16>(Ub, state_pool, Yb, run, c);
            else { pool_run<16, 8>(Ub, state_pool, Yb, 2 * run, c); asm volatile("" ::: "memory"); pool_run<16, 8>(Ub, state_pool, Yb, 2 * run + 1, c); } }
        const sba::Tensors T{Qb, Kb, Vb, YSB, cache_k, cache_v};
        if (do_att_) {
#pragma unroll 1
        for (int i2 = 2 * vcu; i2 < 512; i2 += ((i2 & 1) ? 2 * G - 1 : 1)) { const int i = i2 >> 1, bh = i >> 2, s = i & 3;
            sba::sb_unit<false>(bh >> 3, bh & 7, (i2 & 1) ? 7 - s : s, T, (SB_LAS char*)(L + RING_OFF)); }
        }
        if (do_sam_) {
        for (int i = G - 1 - vcu; i < 128; i += G) sba::sb_unit<true>(i >> 3, i & 7, 0, T, (SB_LAS char*)(L + RING_OFF));
        }
    }
    SEAM(2);
#pragma unroll 1
    for (int rep_ = 0; rep_ < ((IN(3) && !(DBG_SKIP_P2 & 16)) ? ((DBG_REPEAT == 3) ? 2 : 1) : 0); ++rep_) {
        if (rep_ > 0) xcd_barrier(bar);
#pragma unroll 1
        for (int pass_ = 0; pass_ < 2; ++pass_) if ((pass_ == 1) == late_) {
        for (int task = vcu; task < 16 * (DM / 64); task += G) { const int rb = task & 15, col0 = (task >> 4) * 64;
            const f32x4 va = sk::tile(Yb, WEFF, PW, (size_t)MP + rb * 32, col0, (SK_LAS char*)(L + RING_OFF));
            const f32x4 vb = sk::tile(YSB, WSB, SBW, (size_t)MP + rb * 32, col0, (SK_LAS char*)(L + RING_OFF));
            const int t = threadIdx.x, r = MP + rb * 32 + (t >> 4), c = col0 + (t & 15) * 4;
            const f32x4 ga = sk::up4(*(const GAS unsigned long long*)(Gb + (size_t)r * 2048 + c)), gb = sk::up4(*(const GAS unsigned long long*)(Gb + (size_t)r * 2048 + 1024 + c));
            *(GAS unsigned long long*)(MG + (size_t)r * 1024 + c) = sk::pk4(ga * va + gb * vb);
        }
        } else {
        { pg8::Gemm g{Yb, WEFF, MP, DM, PW}; pg8::StaticOrder S; S.init(MP, DM, G, bx); pg8::EpiMerge0 E{Gb, MG};
          pg8::gemm_phase<pg8::EpiMerge0, pg8::StaticOrder, DBG_ALIGN, DBG_SP2>(L + RING_OFF, g, S, E); }
        { pg8::Gemm g{YSB, WSB, MP, DM, SBW}; pg8::StaticOrder S; S.init(MP, DM, G, bx); pg8::EpiMerge1 E{Gb, MG};
          pg8::gemm_phase<pg8::EpiMerge1, pg8::StaticOrder, DBG_ALIGN, DBG_SP2>(L + RING_OFF, g, S, E); }
        }
    }
    SEAM(3);
#pragma unroll 1
    for (int rep_ = 0; rep_ < ((IN(4)) ? ((DBG_REPEAT == 4) ? 2 : 1) : 0); ++rep_) {
        if (rep_ > 0) xcd_barrier(bar);
#pragma unroll 1
        for (int pass_ = 0; pass_ < 2; ++pass_) if ((pass_ == 1) == late_) {
        for (int task = vcu; task < 16 * (DM / 64); task += G) { const int rb = task & 15, col0 = (task >> 4) * 64;
            const f32x4 v = sk::tile(MG, WOUT, DM, (size_t)MP + rb * 32, col0, (SK_LAS char*)(L + RING_OFF));
            const int t = threadIdx.x, rs = rb * 32 + (t >> 4), r = MP + rs, c = col0 + (t & 15) * 4;
            const f32x4 x1 = *(const GAS f32x4*)(x_s + (size_t)rs * DM + c) + v; *(GAS unsigned long long*)(Xb + (size_t)r * DM + c) = sk::pk4(x1);
            *(GAS unsigned long long*)(XN + (size_t)r * DM + c) = sk::pk4(x1 * *(const GAS f32x4*)(g_mlp + c));
            const float ss = sk::sum16(pg8::dot4(x1)); if ((t & 15) == 0) SSQ1[(size_t)r * 16 + (col0 >> 6)] = ss;
        }
        } else {
        pg8::Gemm g{MG, WOUT, MP, DM, DM}; pg8::StaticOrder S; S.init(MP, DM, G, bx); pg8::EpiResid<true> E{x_p, Xb, XN, g_mlp, SSQ1};
        pg8::gemm_phase<pg8::EpiResid<true>, pg8::StaticOrder, DBG_ALIGN, DBG_SP2>(L + RING_OFF, g, S, E);
        }
    }
    SEAM(4);
#pragma unroll 1
    for (int rep_ = 0; rep_ < ((IN(5)) ? ((DBG_REPEAT == 5) ? 2 : 1) : 0); ++rep_) {
        if (rep_ > 0) xcd_barrier(bar);
#pragma unroll 1
        for (int pass_ = 0; pass_ < 2; ++pass_) if ((pass_ == 1) == late_) {
        for (int task = vcu; task < 16 * (DFF / 256); task += G) { const int rb = task & 15, col0 = (task >> 4) * 256; f32x4 vv[2][2];
            sk::tile4(XN, WUP, DM, (size_t)MP + rb * 32, col0, (SK_LAS char*)(L + RING_OFF), vv);
            const int t = threadIdx.x, r = MP + rb * 32 + (t >> 4); const float rs_ = sk::rstd16(SSQ1, r, t);
#pragma unroll
            for (int h = 0; h < 2; ++h)
#pragma unroll
                for (int q = 0; q < 2; ++q) { const int c = col0 + 128 * h + 64 * q + (t & 15) * 4; const f32x4 a = __builtin_elementwise_max(vv[h][q] * rs_, (f32x4){0.f, 0.f, 0.f, 0.f});
                    *(GAS unsigned long long*)(Hb + (size_t)r * DFF + c) = sk::pk4(a * a); }
        }
        } else {
        pg8::Gemm g{XN, WUP, MP, DFF, DM}; pg8::StaticOrder S; S.init(MP, DFF, G, bx); pg8::EpiUp E{SSQ1, Hb};
        pg8::gemm_phase<pg8::EpiUp, pg8::StaticOrder, DBG_ALIGN, DBG_SP2>(L + RING_OFF, g, S, E);
        }
    }
    SEAM(5);
    if (IN(5) && DBG_REPEAT == 15) {
        { pg8::Gemm g{XN, WUP, MP, DFF, DM}; pg8::StaticOrder S; S.init(MP, DFF, G, bx); pg8::EpiNull E{SSQ3};
          pg8::gemm_phase<pg8::EpiNull, pg8::StaticOrder, DBG_ALIGN, DBG_SP2>(L + RING_OFF, g, S, E); }
        xcd_barrier(bar);
    }
    if (IN(5) && DBG_REPEAT == 25) {
        for (int task = vcu; task < 16 * (DFF / 256); task += G) { const int rb = task & 15, col0 = (task >> 4) * 256; f32x4 vv[2][2];
            sk::tile4(XN, WUP, DM, (size_t)MP + rb * 32, col0, (SK_LAS char*)(L + RING_OFF), vv); if (vv[0][0][0] + vv[1][1][0] + vv[0][1][0] + vv[1][0][0] == 1.2345e33f) SSQ3[0] = vv[0][0][1]; }
        xcd_barrier(bar);
    }
    if (IN(6) && DBG_REPEAT == 6) {
        { pg8::Gemm g{Hb, WDOWN, MP, DM, DFF}; pg8::StaticOrder S; S.init(MP, DM, G, bx); pg8::EpiNull E{SSQ3};
          pg8::gemm_phase<pg8::EpiNull, pg8::StaticOrder, DBG_ALIGN, DBG_SP2>(L + RING_OFF, g, S, E); }
        xcd_barrier(bar);
    }
    if (IN(6) && DBG_REPEAT == 16) {
        for (int task = vcu; task < 16 * (DM / 64); task += G) { const int rb = task & 15, col0 = (task >> 4) * 64;
            const f32x4 v = sk::tile(Hb, WDOWN, DFF, (size_t)MP + rb * 32, col0, (SK_LAS char*)(L + RING_OFF)); if (v[0] == 1.2345e33f) SSQ3[0] = v[1]; }
        xcd_barrier(bar);
    }
    if (IN(6)) {
#pragma unroll 1
        for (int pass_ = 0; pass_ < 2; ++pass_) if ((pass_ == 1) == late_) {
        for (int task = vcu; task < 16 * (DM / 64); task += G) { const int rb = task & 15, col0 = (task >> 4) * 64;
            const f32x4 v = sk::tile(Hb, WDOWN, DFF, (size_t)MP + rb * 32, col0, (SK_LAS char*)(L + RING_OFF));
            const int t = threadIdx.x, r = MP + rb * 32 + (t >> 4), c = col0 + (t & 15) * 4;
            const f32x4 x2 = sk::up4(*(const GAS unsigned long long*)(Xb + (size_t)r * DM + c)) + v; *(GAS unsigned long long*)(Xb + (size_t)r * DM + c) = sk::pk4(x2);
            *(GAS unsigned long long*)(XN + (size_t)r * DM + c) = sk::pk4(x2 * *(const GAS f32x4*)(g_ple + c));
            const float ss = sk::sum16(pg8::dot4(x2)); if ((t & 15) == 0) SSQ2[(size_t)r * 16 + (col0 >> 6)] = ss;
        }
        } else {
        { pg8::Gemm g{Hb, WDOWN, MP, DM, DFF}; pg8::StaticOrder S; S.init(MP, DM, G, bx); pg8::EpiResid<false> E{nullptr, Xb, XN, g_ple, SSQ2};
          pg8::gemm_phase<pg8::EpiResid<false>, pg8::StaticOrder, DBG_ALIGN, DBG_SP2>(L + RING_OFF, g, S, E); }
        }
    }
    SEAM(6);
    if (IN(7) && DBG_REPEAT == 7) {
        { pg8::Gemm g{PB, WPP, MP, DM, PLE}; pg8::StaticOrder S; S.init(MP, DM, G, bx); pg8::EpiNull E{SSQ3};
          pg8::gemm_phase<pg8::EpiNull, pg8::StaticOrder, DBG_ALIGN, DBG_SP2>(L + RING_OFF, g, S, E); }
        { pg8::Gemm g{XN, WPG, MP, DM, DM}; pg8::StaticOrder S; S.init(MP, DM, G, bx); pg8::EpiNull E{SSQ3};
          pg8::gemm_phase<pg8::EpiNull, pg8::StaticOrder, DBG_ALIGN, DBG_SP2>(L + RING_OFF, g, S, E); }
        xcd_barrier(bar);
    }
    if (IN(7) && DBG_REPEAT == 17) {
        for (int task = vcu; task < 16 * (DM / 64); task += G) { const int rb = task & 15, col0 = (task >> 4) * 64;
            const f32x4 vp = sk::tile(PB, WPP, PLE, (size_t)MP + rb * 32, col0, (SK_LAS char*)(L + RING_OFF));
            const f32x4 vg = sk::tile(XN, WPG, DM, (size_t)MP + rb * 32, col0, (SK_LAS char*)(L + RING_OFF)); if (vp[0] + vg[0] == 1.2345e33f) SSQ3[0] = vp[1]; }
        xcd_barrier(bar);
    }
    if (IN(7) && DBG_REPEAT == 27) {
        { pg8::Gemm g{PB, WPP, MP, DM, PLE}; pg8::StaticOrder S; S.init(MP, DM, G, bx); pg8::EpiPP E{PPb};
          pg8::gemm_phase<pg8::EpiPP, pg8::StaticOrder, DBG_ALIGN, DBG_SP2>(L + RING_OFF, g, S, E); }
        xcd_barrier(bar);
    }
    if (IN(7)) {
#pragma unroll 1
        for (int pass_ = 0; pass_ < 2; ++pass_) if ((pass_ == 1) == late_) {
        for (int task = vcu; task < 16 * (DM / 64); task += G) { const int rb = task & 15, col0 = (task >> 4) * 64;
            const f32x4 vp = sk::tile(PB, WPP, PLE, (size_t)MP + rb * 32, col0, (SK_LAS char*)(L + RING_OFF));
            const f32x4 vg = sk::tile(XN, WPG, DM, (size_t)MP + rb * 32, col0, (SK_LAS char*)(L + RING_OFF));
            const int t = threadIdx.x, r = MP + rb * 32 + (t >> 4), c = col0 + (t & 15) * 4;
            const float rs_ = sk::rstd16(SSQ2, r, t);
            const f32x4 x3 = sk::up4(*(const GAS unsigned long long*)(Xb + (size_t)r * DM + c)) + pg8::sigm4(vg * rs_) * vp;
            const float ss = sk::sum16(pg8::dot4(x3)); if ((t & 15) == 0) __hip_atomic_store(SSQ3 + (size_t)r * 16 + (col0 >> 6), ss, __ATOMIC_RELAXED, __HIP_MEMORY_SCOPE_AGENT);
            asm volatile("s_waitcnt vmcnt(0)" ::: "memory");
            unsigned* cw = (unsigned*)(ctl + CW_FINS + 64 * rb);
            if ((t & 63) == 0) __hip_atomic_fetch_add(cw, 1u, __ATOMIC_RELAXED, __HIP_MEMORY_SCOPE_AGENT);
            { unsigned spins = 0; while ((unsigned)__builtin_amdgcn_readfirstlane(__hip_atomic_load(cw, __ATOMIC_RELAXED, __HIP_MEMORY_SCOPE_AGENT)) < 128u) { __builtin_amdgcn_s_sleep(2); if (++spins > (1u << 16)) break; } }
            const float r3 = __builtin_amdgcn_rsqf(sk::sum16(__hip_atomic_load(SSQ3 + (size_t)r * 16 + (t & 15), __ATOMIC_RELAXED, __HIP_MEMORY_SCOPE_AGENT)) * (1.0f / 1024.0f) + EPS);
            *(GAS f32x4*)(Yo + (size_t)r * DM + c) = x3 * r3 * *(const GAS f32x4*)(g_final + c);
        }
        } else {
        { pg8::Gemm g{PB, WPP, MP, DM, PLE}; pg8::StaticOrder S; S.init(MP, DM, G, bx); pg8::EpiPP E{PPb};
          pg8::gemm_phase<pg8::EpiPP, pg8::StaticOrder, DBG_ALIGN, DBG_SP2>(L + RING_OFF, g, S, E); }
        { pg8::Gemm g{XN, WPG, MP, DM, DM}; pg8::StaticOrder S; S.init(MP, DM, G, bx); pg8::EpiPleFinal E{SSQ2, PPb, Xb, Yo, SSQ3, g_final, (unsigned*)(ctl + CW_FIN)};
          pg8::gemm_phase<pg8::EpiPleFinal, pg8::StaticOrder, DBG_ALIGN, DBG_SP2>(L + RING_OFF, g, S, E); }
        }
    }
#undef IN
#undef SEAM
}

extern "C" void kernel_launch(void* const* d_in, const int* in_sizes, int n_in, void* d_out, int out_size, void* d_ws, size_t ws_size, hipStream_t stream) {
    static int grid = 0;
    if (grid == 0) {
        if (n_in != 22 || out_size != (int)O_END || ws_size < WS_END) { fprintf(stderr, "kernel_launch: unexpected sizes: n_in %d out %d ws %zu\n", n_in, out_size, ws_size); grid = -1; return; }
        int dev = 0, cus = 0, per_cu = 0;
        if (hipGetDevice(&dev) != hipSuccess || hipDeviceGetAttribute(&cus, hipDeviceAttributeMultiprocessorCount, dev) != hipSuccess) { grid = -1; return; }
        if (hipFuncSetAttribute((const void*)mega_fwd, hipFuncAttributeMaxDynamicSharedMemorySize, LDS_BYTES) != hipSuccess) { fprintf(stderr, "kernel_launch: hipFuncSetAttribute failed\n"); grid = -1; return; }
        if (hipOccupancyMaxActiveBlocksPerMultiprocessor(&per_cu, (const void*)mega_fwd, NWAVES * 64, LDS_BYTES) != hipSuccess || per_cu < 1) { fprintf(stderr, "kernel_launch: occupancy query says %d\n", per_cu); (void)hipGetLastError(); per_cu = 1; }
        grid = cus;
    }
    if (grid < 0) return;
    (void)hipMemsetAsync((char*)d_ws + WS_CTL, 0, CTL_ZERO_BYTES, stream);
    Args a{};
    for (int i = 0; i < 22; ++i) a.in[i] = (const float*)d_in[i];
    a.out = (float*)d_out; a.ws = (unsigned char*)d_ws;
#ifndef DBG_PH_HI
#define DBG_PH_HI N_PHASES
#endif
    if (MK_N_LAUNCHES == 1) { a.ph_lo = 0; a.ph_hi = DBG_PH_HI; a.li = 0; hipLaunchKernelGGL(mega_fwd, dim3(grid), dim3(NWAVES * 64), LDS_BYTES, stream, a); }
    else for (int li = 0; li < N_PHASES; ++li) { a.ph_lo = li; a.ph_hi = li + 1; a.li = li; hipLaunchKernelGGL(mega_fwd, dim3(grid), dim3(NWAVES * 64), LDS_BYTES, stream, a);
#if defined(HYB_ATTN)
        if (li == 2) hyb_attn<<<(MT * NH + 63) / 64, 64, 0, stream>>>((const unsigned short*)((char*)d_ws + WS_Q), (const unsigned short*)((char*)d_ws + WS_K), (const unsigned short*)((char*)d_ws + WS_V), (const float*)d_in[2], (const float*)d_in[3], (unsigned short*)((char*)d_ws + WS_YSB));
#endif
#if defined(HYB_POOL)
        if (li == 2) hyb_pool<<<(int)(((size_t)MT * PW + 255) / 256), 256, 0, stream>>>((const unsigned short*)((char*)d_ws + WS_U), (const float*)d_in[4], (unsigned short*)((char*)d_ws + WS_Y));
#endif
    }
}
```

```cpp
#include <hip/hip_runtime.h>
#include <hip/hip_bf16.h>
#include <cstdio>
#include <cstdint>
#include <cmath>
namespace cfg {
constexpr int DM = 1024, NB = 8, SEQ = 2048, DB = 16, DS = 32, PAST = 1024, PW = 512, SBW = 512, HD = 64, NH = 8, DFF = 4096, PLE = 256, INW = 4096;
constexpr int MP = NB * SEQ, MS = DB * DS, MT = MP + MS;
constexpr float EPS = 1e-6f;
constexpr float QSCALE = 0.125f * 1.4426950408889634f;
}
namespace pg8 {
#define PG8_LAS __attribute__((address_space(3)))
typedef unsigned short bf16_t;
typedef short bf16x8 __attribute__((ext_vector_type(8)));
typedef float f32x4 __attribute__((ext_vector_type(4)));
typedef unsigned u32x4 __attribute__((ext_vector_type(4)));
constexpr int BM = 256, BK = 64, HALF = 128, HTB = HALF * BK * 2  , STAGE_BYTES = 8 * HTB, NXCD = 8, WGM = 8;

__host__ __device__ __forceinline__ int lds_byte(int r, int c) { const int st = (r >> 4) * 2 + (c >> 5), rr = r & 15, cc = c & 31, ob = rr * 64 + cc * 2; return st * 1024 + (ob ^ (((ob >> 9) & 1) << 5)); }
__host__ __device__ __forceinline__ void stage_rc(int b, int& R, int& C) { const int st = b / 1024, sb = b % 1024, swz = sb ^ (((sb >> 9) & 1) << 5); R = (st >> 1) * 16 + swz / 64; C = (st & 1) * 32 + (swz % 64) / 2; }
__host__ __device__ __forceinline__ int perm32(int rho) { const int n = rho >> 4, i = rho & 15; return 8 * (i >> 2) + 4 * n + (i & 3); }

struct Unit { int pm, pn, seg; };
struct Gemm { const bf16_t* A; const bf16_t* Bt; int M, N, K; const bf16_t* A1 = nullptr; const bf16_t* Bt1 = nullptr; };

struct StaticOrder {
    int nM, nN, nwg, G, c;
    __host__ __device__ void init(int M, int N, int G_, int c_) { nM = M / BM; nN = N / BM; nwg = nM * nN; G = G_; c = c_; }
    __host__ __device__ bool next(int i, Unit& u) const {
        const long L = (long)i * G + c; if (L >= nwg) return false;
        int wgid = (int)L; { const int q = nwg / NXCD, r = nwg % NXCD, xcd = wgid % NXCD, off = wgid / NXCD; wgid = (xcd < r ? xcd * (q + 1) : r * (q + 1) + (xcd - r) * q) + off; }
        const int nig = WGM * nN, gid = wgid / nig, fm = gid * WGM, gsz = (nM - fm) < WGM ? (nM - fm) : WGM;
        u.pm = fm + ((wgid % nig) % gsz); u.pn = (wgid % nig) / gsz; u.seg = 0; return true;
    }
    __device__ __forceinline__ void a_ready(const Unit&) const {}
    __device__ __forceinline__ void done(const Unit&) const {}
};
struct RotOrder : StaticOrder {
    int rot, cnt;
    __host__ __device__ void init(int M, int N, int G_, int c_, int rot_) { StaticOrder::init(M, N, G_, c_); cnt = (nwg % G_ == 0) ? nwg / G_ : 0; rot = rot_; }
    __host__ __device__ bool next(int i, Unit& u) const { if (cnt == 0) return StaticOrder::next(i, u); if (i >= cnt) return false; return StaticOrder::next((i + rot) % cnt, u); }
};
struct PairOrder : StaticOrder {
    __host__ __device__ bool next(int i, Unit& u) const { if (!StaticOrder::next(i >> 1, u)) return false; u.seg = i & 1; return true; }
};
typedef float f32x2v_t __attribute__((ext_vector_type(2))); typedef __bf16 bf16x2v_t __attribute__((ext_vector_type(2)));
__device__ __forceinline__ unsigned cvt_pk_bf16(float lo, float hi) { f32x2v_t v = {lo, hi}; bf16x2v_t b = __builtin_convertvector(v, bf16x2v_t); return __builtin_bit_cast(unsigned, b); }
typedef float f32x2 __attribute__((ext_vector_type(2)));
__device__ __forceinline__ float bf_lo(unsigned w) { return __uint_as_float(w << 16); }
__device__ __forceinline__ float bf_hi(unsigned w) { return __uint_as_float(w & 0xffff0000u); }
__device__ __forceinline__ u32x4 pack8(f32x4 a, f32x4 b) { u32x4 w; w.x = cvt_pk_bf16(a[0], a[1]); w.y = cvt_pk_bf16(a[2], a[3]); w.z = cvt_pk_bf16(b[0], b[1]); w.w = cvt_pk_bf16(b[2], b[3]); return w; }
__device__ __forceinline__ void unpack8(u32x4 w, f32x4& a, f32x4& b) { a = (f32x4){bf_lo(w.x), bf_hi(w.x), bf_lo(w.y), bf_hi(w.y)}; b = (f32x4){bf_lo(w.z), bf_hi(w.z), bf_lo(w.w), bf_hi(w.w)}; }
__device__ __forceinline__ float sigm(float x) { return __builtin_amdgcn_rcpf(1.f + __builtin_amdgcn_exp2f(-1.4426950408889634f * x)); }
__device__ __forceinline__ f32x4 sigm4(f32x4 x) { return (f32x4){sigm(x[0]), sigm(x[1]), sigm(x[2]), sigm(x[3])}; }
__device__ __forceinline__ float dot4(f32x4 a) { return (a[0] * a[0] + a[1] * a[1]) + (a[2] * a[2] + a[3] * a[3]); }
#ifndef DBG_LDAUX
#define DBG_LDAUX 16
#endif
__device__ __forceinline__ u32x4 ld16_sc1(const void* base, size_t byte_off) {
    const __amdgpu_buffer_rsrc_t rs = __builtin_amdgcn_make_buffer_rsrc((void*)base, (short)0, 0x7fffffff, 0x00020000);
    return __builtin_bit_cast(u32x4, __builtin_amdgcn_raw_buffer_load_b128(rs, (unsigned)byte_off, 0, DBG_LDAUX));
}
__device__ __forceinline__ unsigned pk_u8x4(f32x4 g) { unsigned w = 0u; w = __builtin_amdgcn_cvt_pk_u8_f32(g[0] * 255.0f, 0, w); w = __builtin_amdgcn_cvt_pk_u8_f32(g[1] * 255.0f, 1, w); w = __builtin_amdgcn_cvt_pk_u8_f32(g[2] * 255.0f, 2, w); w = __builtin_amdgcn_cvt_pk_u8_f32(g[3] * 255.0f, 3, w); return w; }
__device__ __forceinline__ f32x4 up_u8x4(unsigned w) { return (f32x4){(float)(w & 0xffu), (float)((w >> 8) & 0xffu), (float)((w >> 16) & 0xffu), (float)(w >> 24)} * (1.0f / 255.0f); }
typedef unsigned u32x2 __attribute__((ext_vector_type(2)));
__device__ __forceinline__ float row_rstd(const float* SSQ, int r, int fq) {
    const f32x4 p = *(const f32x4*)(SSQ + (size_t)r * 16 + 4 * fq); float s = (p[0] + p[1]) + (p[2] + p[3]);
    s += __shfl_xor(s, 16); s += __shfl_xor(s, 32);
    return __builtin_amdgcn_rsqf(s * (1.0f / 1024.0f) + cfg::EPS);
}
#define PG8_ROWS(...) _Pragma("unroll") for (int ai = 0; ai < 2; ++ai) _Pragma("unroll") for (int m = 0; m < 4; ++m) { const int r = u.pm * BM + ai * HALF + wr * 64 + m * 16 + fr; __VA_ARGS__; if (m == 3) asm volatile("" ::: "memory"); }
#define PG8_COLS(...) _Pragma("unroll") for (int bj = 0; bj < 2; ++bj) { const int c = ct + bj * HALF + wc * 32 + 8 * fq; const f32x4 v0 = acc[ai][bj][m][0], v1 = acc[ai][bj][m][1]; __VA_ARGS__; }

struct EpiIn {
    static constexpr bool PERM = true, AFTER_DRAIN = false;
    bf16_t *U, *Q, *K, *V, *G; const float* b_gate; float *k_p, *v_p, *k_s, *v_s, *pool_p, *pool_s;
    __device__ __forceinline__ void operator()(const f32x4 (&acc)[2][2][4][2], const Unit& u, int wr, int wc, int fr, int fq) const {
        const int pn = u.pn;
        if (pn >= 8) {
            const int ct = (pn - 8) * BM; f32x4 bv[2][2];
#pragma unroll
            for (int bj = 0; bj < 2; ++bj) { const int c = ct + bj * HALF + wc * 32 + 8 * fq; bv[bj][0] = *(const f32x4*)(b_gate + c); bv[bj][1] = *(const f32x4*)(b_gate + c + 4); }
            PG8_ROWS(PG8_COLS(*(u32x2*)((unsigned char*)G + (size_t)r * 2048 + c) = (u32x2){pk_u8x4(sigm4(v0 + bv[bj][0])), pk_u8x4(sigm4(v1 + bv[bj][1]))}))
        } else if (pn >= 4) {
            const bool isv = pn >= 6; const int ct = (pn - (isv ? 6 : 4)) * BM; bf16_t* B = isv ? V : K; float* op = isv ? v_p : k_p; float* os = isv ? v_s : k_s;
            PG8_ROWS(float* orow = r < cfg::MP ? op + (size_t)r * 512 : os + (size_t)(r - cfg::MP) * 512;
                     PG8_COLS(*(u32x4*)(B + (size_t)r * 512 + c) = pack8(v0, v1); *(f32x4*)(orow + c) = v0; *(f32x4*)(orow + c + 4) = v1))
        } else if (pn >= 2) {
            const int ct = (pn - 2) * BM;
            PG8_ROWS(PG8_COLS(*(u32x4*)(Q + (size_t)r * 512 + c) = pack8(v0 * cfg::QSCALE, v1 * cfg::QSCALE)))
        } else {
            const int ct = pn * BM;
            PG8_ROWS(float* prow = nullptr;
                     if (r < cfg::MP) { const int t = r & (cfg::SEQ - 1); if (t >= cfg::SEQ - 15) prow = pool_p + ((size_t)(r >> 11) * 15 + (t - (cfg::SEQ - 15))) * 512; }
                     else { const int i = (r - cfg::MP) & 31; if (i >= 17) prow = pool_s + ((size_t)((r - cfg::MP) >> 5) * 15 + (i - 17)) * 512; }
                     PG8_COLS(*(u32x4*)(U + (size_t)r * 512 + c) = pack8(v0, v1); if (prow) { *(f32x4*)(prow + c) = v0; *(f32x4*)(prow + c + 4) = v1; }))
        }
    }
};
#if defined(DBG_ONLYG)
#define DBG_NOG_STMT *(u32x4*)(MG + (size_t)r * 1024 + c) = gw; continue;
#elif defined(DBG_NOG)
#define DBG_NOG_STMT g0 = (f32x4){0.5f, 0.5f, 0.5f, 0.5f}; g1 = g0;
#else
#define DBG_NOG_STMT
#endif
struct EpiMerge;
struct EpiMerge0 {
    static constexpr bool PERM = true, AFTER_DRAIN = false;
    const bf16_t* G; bf16_t* MG;
    __device__ __forceinline__ void operator()(const f32x4 (&acc)[2][2][4][2], const Unit& u, int wr, int wc, int fr, int fq) const {
        const int ct = u.pn * BM;
        PG8_ROWS(PG8_COLS(const u32x2 gw = *(const u32x2*)((const unsigned char*)G + (size_t)r * 2048 + c); const f32x4 g0 = up_u8x4(gw.x); const f32x4 g1 = up_u8x4(gw.y); *(u32x4*)(MG + (size_t)r * 1024 + c) = pack8(v0 * g0, v1 * g1)))
    }
};
#ifdef DBG_NORAW
#define DBG_NORAW_STMT m0 = (f32x4){0.f, 0.f, 0.f, 0.f}; m1 = m0;
#else
#define DBG_NORAW_STMT
#endif
struct EpiMerge1 {
    static constexpr bool PERM = true, AFTER_DRAIN = false;
    const bf16_t* G; bf16_t* MG;
    __device__ __forceinline__ void operator()(const f32x4 (&acc)[2][2][4][2], const Unit& u, int wr, int wc, int fr, int fq) const {
        const int ct = u.pn * BM;
        PG8_ROWS(PG8_COLS(const u32x2 gw = *(const u32x2*)((const unsigned char*)G + (size_t)r * 2048 + 1024 + c); const u32x4 mw = *(const u32x4*)(MG + (size_t)r * 1024 + c);
                          const f32x4 g0 = up_u8x4(gw.x); const f32x4 g1 = up_u8x4(gw.y); f32x4 m0; f32x4 m1; unpack8(mw, m0, m1); *(u32x4*)(MG + (size_t)r * 1024 + c) = pack8(m0 + v0 * g0, m1 + v1 * g1)))
    }
};
struct EpiMerge {
    static constexpr bool PERM = true, AFTER_DRAIN = false;
    const bf16_t* G; bf16_t* MG;
    __device__ __forceinline__ void operator()(const f32x4 (&acc)[2][2][4][2], const Unit& u, int wr, int wc, int fr, int fq) const {
        if (u.seg == 0) { const EpiMerge0 E0{G, MG}; E0(acc, u, wr, wc, fr, fq); } else { const EpiMerge1 E1{G, MG}; E1(acc, u, wr, wc, fr, fq); }
    }
};
template <bool F32RES>
struct EpiResid {
    static constexpr bool PERM = true, AFTER_DRAIN = false;
    const float* res_p; bf16_t* X; bf16_t* XG; const float* gvec; float* SSQ;
    __device__ __forceinline__ void operator()(const f32x4 (&acc)[2][2][4][2], const Unit& u, int wr, int wc, int fr, int fq) const {
        const int ct = u.pn * BM; f32x4 gv[2][2];
#pragma unroll
        for (int bj = 0; bj < 2; ++bj) { const int c = ct + bj * HALF + wc * 32 + 8 * fq; gv[bj][0] = *(const f32x4*)(gvec + c); gv[bj][1] = *(const f32x4*)(gvec + c + 4); }
        PG8_ROWS(float s = 0.f;
                 PG8_COLS(f32x4 a; f32x4 b;
                          if (F32RES) { a = *(const f32x4*)(res_p + (size_t)r * 1024 + c); b = *(const f32x4*)(res_p + (size_t)r * 1024 + c + 4); }
                          else { const u32x4 xw = *(const u32x4*)(X + (size_t)r * 1024 + c); unpack8(xw, a, b); }
                          a += v0; b += v1; *(u32x4*)(X + (size_t)r * 1024 + c) = pack8(a, b); s += dot4(a) + dot4(b);
                          *(u32x4*)(XG + (size_t)r * 1024 + c) = pack8(a * gv[bj][0], b * gv[bj][1]))
                 s += __shfl_xor(s, 16); s += __shfl_xor(s, 32); if (fq == 0) SSQ[(size_t)r * 16 + u.pn * 4 + wc] = s)
    }
};
struct EpiUp {
    static constexpr bool PERM = true, AFTER_DRAIN = false;
    const float* SSQ; bf16_t* H;
    __device__ __forceinline__ void operator()(const f32x4 (&acc)[2][2][4][2], const Unit& u, int wr, int wc, int fr, int fq) const {
        const int ct = u.pn * BM; float rsv[2][4];
#pragma unroll
        for (int ai = 0; ai < 2; ++ai)
#pragma unroll
            for (int m = 0; m < 4; ++m) rsv[ai][m] = row_rstd(SSQ, u.pm * BM + ai * HALF + wr * 64 + m * 16 + fr, fq);
        PG8_ROWS(const float rs = rsv[ai][m];
                 PG8_COLS(f32x4 a = v0 * rs; f32x4 b = v1 * rs; a = __builtin_elementwise_max(a, (f32x4){0.f, 0.f, 0.f, 0.f}); b = __builtin_elementwise_max(b, (f32x4){0.f, 0.f, 0.f, 0.f});
                          *(u32x4*)(H + (size_t)r * 4096 + c) = pack8(a * a, b * b)))
    }
};
struct EpiNull {
    static constexpr bool PERM = true, AFTER_DRAIN = false;
    float* sink;
    __device__ __forceinline__ void operator()(const f32x4 (&acc)[2][2][4][2], const Unit& u, int wr, int wc, int fr, int fq) const {
        float s = 0.f;
#pragma unroll
        for (int ai = 0; ai < 2; ++ai)
#pragma unroll
            for (int bj = 0; bj < 2; ++bj)
#pragma unroll
                for (int m = 0; m < 4; ++m)
#pragma unroll
                    for (int n = 0; n < 2; ++n) s += acc[ai][bj][m][n][0] + acc[ai][bj][m][n][3];
        if (s == 1.2345e33f) sink[0] = s;
    }
};
struct EpiPP {
    static constexpr bool PERM = true, AFTER_DRAIN = false;
    bf16_t* PP;
    __device__ __forceinline__ void operator()(const f32x4 (&acc)[2][2][4][2], const Unit& u, int wr, int wc, int fr, int fq) const {
        const int ct = u.pn * BM;
        PG8_ROWS(PG8_COLS(*(u32x4*)(PP + (size_t)r * 1024 + c) = pack8(v0, v1)))
    }
};
struct EpiPleFinal {
    static constexpr bool PERM = true, AFTER_DRAIN = false;
    const float* SSQ; const bf16_t* PP; const bf16_t* X; float* Y; float* SSQo; const float* gfin; unsigned* cnt;
    __device__ __forceinline__ void operator()(f32x4 (&acc)[2][2][4][2], const Unit& u, int wr, int wc, int fr, int fq) const {
        const int ct = u.pn * BM; float rsv[2][4];
#pragma unroll
        for (int ai = 0; ai < 2; ++ai)
#pragma unroll
            for (int m = 0; m < 4; ++m) rsv[ai][m] = row_rstd(SSQ, u.pm * BM + ai * HALF + wr * 64 + m * 16 + fr, fq);
        PG8_ROWS(const float rs = rsv[ai][m]; float s = 0.f;
                 PG8_COLS(const u32x4 pw = *(const u32x4*)(PP + (size_t)r * 1024 + c); f32x4 p0; f32x4 p1; unpack8(pw, p0, p1);
                          const u32x4 xw = *(const u32x4*)(X + (size_t)r * 1024 + c); f32x4 a; f32x4 b; unpack8(xw, a, b); a += sigm4(v0 * rs) * p0; b += sigm4(v1 * rs) * p1;
                          acc[ai][bj][m][0] = a; acc[ai][bj][m][1] = b; s += dot4(a) + dot4(b))
                 s += __shfl_xor(s, 16); s += __shfl_xor(s, 32);
                 if (fq == 0) __hip_atomic_store(SSQo + (size_t)r * 16 + u.pn * 4 + wc, s, __ATOMIC_RELAXED, __HIP_MEMORY_SCOPE_AGENT))
        asm volatile("s_waitcnt vmcnt(0)" ::: "memory");
        unsigned* cw = cnt + 64 * (2 * u.pm + wr);
        if (fr == 0 && fq == 0) __hip_atomic_fetch_add(cw, 1u, __ATOMIC_RELAXED, __HIP_MEMORY_SCOPE_AGENT);
        { unsigned spins = 0;
          while ((unsigned)__builtin_amdgcn_readfirstlane(__hip_atomic_load(cw, __ATOMIC_RELAXED, __HIP_MEMORY_SCOPE_AGENT)) < 16u) { __builtin_amdgcn_s_sleep(2); if (++spins > (1u << 16)) break; } }
        f32x4 gv[2][2];
#pragma unroll
        for (int bj = 0; bj < 2; ++bj) { const int c = ct + bj * HALF + wc * 32 + 8 * fq; gv[bj][0] = *(const f32x4*)(gfin + c); gv[bj][1] = *(const f32x4*)(gfin + c + 4); }
        PG8_ROWS(const f32x4 pq = __builtin_bit_cast(f32x4, ld16_sc1(SSQo, ((size_t)r * 16 + 4 * fq) * 4)); float t = (pq[0] + pq[1]) + (pq[2] + pq[3]); t += __shfl_xor(t, 16); t += __shfl_xor(t, 32);
                 const float r3 = __builtin_amdgcn_rsqf(t * (1.0f / 1024.0f) + cfg::EPS);
                 PG8_COLS(*(f32x4*)(Y + (size_t)r * 1024 + c) = v0 * r3 * gv[bj][0]; *(f32x4*)(Y + (size_t)r * 1024 + c + 4) = v1 * r3 * gv[bj][1]))
    }
};
template <class Epi, class Sched, bool ALIGN_EPI = false, bool SP2 = false>
__device__ __forceinline__ void gemm_phase(PG8_LAS unsigned char* lds, const Gemm g, const Sched& S, const Epi& E) {
    int tid = threadIdx.x; asm volatile("" : "+v"(tid));
    const int wid = __builtin_amdgcn_readfirstlane(tid >> 6), lane = tid & 63, wr = wid >> 2, wc = wid & 3, fr = lane & 15, fq = lane >> 4;
    int K = g.K; asm volatile("" : "+s"(K)); const int nt = K / BK;
    unsigned voffA[2], voffB[2];
#pragma unroll
    for (int i = 0; i < 2; ++i) { int R, C; stage_rc(tid * 16 + i * 8192, R, C); const int Rb = Epi::PERM ? ((R & ~31) + perm32(R & 31)) : R;
        voffA[i] = (unsigned)(R * K + C) * 2u; voffB[i] = (unsigned)(Rb * K + C) * 2u; }
    const size_t kstep = (size_t)(BK * 2);
    const size_t hstep = (size_t)HALF * K * 2;
    const size_t tstep = 2 * hstep;
    const size_t bhs = hstep;
    const unsigned ldsw = (unsigned)wid * 1024u;
    const int aoff = lds_byte(wr * 64 + fr, fq * 8), boff = lds_byte(wc * 32 + fr, fq * 8);
#define PG8_SA(b, h) (((b) * 2 + (h)) * HTB)
#define PG8_SB(b, h) ((4 + (b) * 2 + (h)) * HTB)
#define PG8_STAGE(bufoff, gbase, voff) do { _Pragma("unroll") for (int _i = 0; _i < 2; ++_i) \
        __builtin_amdgcn_global_load_lds((const unsigned*)((const char*)(gbase) + (voff)[_i]), (PG8_LAS unsigned*)(lds + (bufoff) + ldsw + _i * 8192), 16, 0, 0); } while (0)
#define PG8_LDA(dst, b, h) do { _Pragma("unroll") for (int m = 0; m < 4; ++m) _Pragma("unroll") for (int k = 0; k < 2; ++k) dst[m][k] = *(const PG8_LAS bf16x8*)(lds + PG8_SA(b, h) + aoff + m * 2048 + k * 1024); } while (0)
#define PG8_LDB(dst, b, h) do { _Pragma("unroll") for (int n = 0; n < 2; ++n) _Pragma("unroll") for (int k = 0; k < 2; ++k) dst[n][k] = *(const PG8_LAS bf16x8*)(lds + PG8_SB(b, h) + boff + n * 2048 + k * 1024); } while (0)
#define PG8_MMA(ai, bj, At, Bt) do { __builtin_amdgcn_s_setprio(1); _Pragma("unroll") for (int m = 0; m < 4; ++m) _Pragma("unroll") for (int n = 0; n < 2; ++n) _Pragma("unroll") for (int k = 0; k < 2; ++k) \
        acc[ai][bj][m][n] = __builtin_amdgcn_mfma_f32_16x16x32_bf16(Bt[n][k], At[m][k], acc[ai][bj][m][n], 0, 0, 0); __builtin_amdgcn_s_setprio(0); } while (0)
#ifdef DRAIN_ALL
#define PG8_WAIT_V(n) asm volatile("s_waitcnt vmcnt(0)" ::: "memory")
#else
#define PG8_WAIT_V(n) asm volatile("s_waitcnt vmcnt(" #n ")" ::: "memory")
#endif
#define PG8_WAIT_L(n) asm volatile("s_waitcnt lgkmcnt(" #n ")" ::: "memory")
#define PG8_BAR __builtin_amdgcn_s_barrier()
#define PG8_SCHED __builtin_amdgcn_sched_barrier(0)
    Unit cur, nxt; int ui = 0;
    if (!S.next(0, cur)) return;
    f32x4 acc[2][2][4][2];
#pragma unroll
    for (int a = 0; a < 2; ++a)
#pragma unroll
        for (int b = 0; b < 2; ++b)
#pragma unroll
            for (int m = 0; m < 4; ++m)
#pragma unroll
                for (int n = 0; n < 2; ++n) acc[a][b][m][n] = (f32x4){0.f, 0.f, 0.f, 0.f};
    bf16x8 At[4][2], B0[2][2], B1[2][2];
    const char* cA = (const char*)(cur.seg ? g.A1 : g.A) + (size_t)cur.pm * tstep; const char* cB = (const char*)(cur.seg ? g.Bt1 : g.Bt) + (size_t)cur.pn * tstep;
    S.a_ready(cur);
    if constexpr (SP2) {
        PG8_STAGE(PG8_SB(0, 0), cB, voffB); PG8_STAGE(PG8_SB(0, 1), cB + bhs, voffB); PG8_STAGE(PG8_SA(0, 0), cA, voffA); PG8_STAGE(PG8_SA(0, 1), cA + hstep, voffA);
        if (wr == 1) PG8_BAR;
        PG8_WAIT_V(2); PG8_BAR;
        PG8_STAGE(PG8_SB(1, 0), cB + kstep, voffB); PG8_STAGE(PG8_SA(1, 0), cA + kstep, voffA); PG8_STAGE(PG8_SB(1, 1), cB + bhs + kstep, voffB);
        PG8_WAIT_V(6); PG8_BAR;
    } else {
        PG8_STAGE(PG8_SB(0, 0), cB, voffB); PG8_STAGE(PG8_SA(0, 0), cA, voffA); PG8_STAGE(PG8_SB(0, 1), cB + bhs, voffB); PG8_STAGE(PG8_SA(0, 1), cA + hstep, voffA);
        if (wr == 1) PG8_BAR;
        PG8_WAIT_V(4); PG8_BAR;
        PG8_STAGE(PG8_SB(1, 0), cB + kstep, voffB); PG8_STAGE(PG8_SA(1, 0), cA + kstep, voffA); PG8_STAGE(PG8_SB(1, 1), cB + bhs + kstep, voffB);
        PG8_WAIT_V(6); PG8_BAR;
    }
    for (;;) {
        const bool has_next = S.next(ui + 1, nxt);
        const char* nA = has_next ? (const char*)(nxt.seg ? g.A1 : g.A) + (size_t)nxt.pm * tstep : cA; const char* nB = has_next ? (const char*)(nxt.seg ? g.Bt1 : g.Bt) + (size_t)nxt.pn * tstep : cB;
        for (int t = 0; t < nt; t += 2) {
            const bool last = (t == nt - 2);
            const char* a1 = cA + (size_t)(t + 1) * kstep;
            const char* a2 = last ? nA : cA + (size_t)(t + 2) * kstep; const char* b2 = last ? nB : cB + (size_t)(t + 2) * kstep;
            const char* a3 = a2 + kstep; const char* b3 = b2 + kstep;
            if (last && has_next) S.a_ready(nxt);
            if constexpr (SP2) {
            PG8_LDB(B0, 0, 0); PG8_LDB(B1, 0, 1); PG8_SCHED; PG8_LDA(At, 0, 0); PG8_STAGE(PG8_SA(1, 1), a1 + hstep, voffA);
            PG8_WAIT_V(8); PG8_WAIT_L(0); PG8_BAR; PG8_MMA(0, 0, At, B0); PG8_MMA(0, 1, At, B1); PG8_BAR; PG8_SCHED;
            PG8_LDA(At, 0, 1); PG8_STAGE(PG8_SB(0, 0), b2, voffB); PG8_STAGE(PG8_SB(0, 1), b2 + bhs, voffB); PG8_STAGE(PG8_SA(0, 0), a2, voffA);
            PG8_WAIT_V(8); PG8_WAIT_L(0); PG8_BAR; PG8_MMA(1, 0, At, B0); PG8_MMA(1, 1, At, B1); PG8_BAR; PG8_SCHED;
            PG8_LDB(B0, 1, 0); PG8_LDB(B1, 1, 1); PG8_SCHED; PG8_LDA(At, 1, 0); PG8_STAGE(PG8_SA(0, 1), a2 + hstep, voffA);
            PG8_WAIT_V(8); PG8_WAIT_L(0); PG8_BAR; PG8_MMA(0, 0, At, B0); PG8_MMA(0, 1, At, B1); PG8_BAR; PG8_SCHED;
            PG8_LDA(At, 1, 1); PG8_STAGE(PG8_SB(1, 0), b3, voffB); PG8_STAGE(PG8_SB(1, 1), b3 + bhs, voffB); PG8_STAGE(PG8_SA(1, 0), a3, voffA);
            PG8_WAIT_V(8); PG8_WAIT_L(0); PG8_BAR; PG8_MMA(1, 0, At, B0); PG8_MMA(1, 1, At, B1); PG8_BAR; PG8_SCHED;
            } else {
            PG8_LDB(B0, 0, 0); PG8_SCHED; PG8_LDA(At, 0, 0); PG8_STAGE(PG8_SA(1, 1), a1 + hstep, voffA);
            PG8_WAIT_L(8); PG8_BAR; PG8_WAIT_L(0); PG8_MMA(0, 0, At, B0); PG8_BAR; PG8_SCHED;
            PG8_LDB(B1, 0, 1); PG8_STAGE(PG8_SB(0, 0), b2, voffB);
            PG8_BAR; PG8_WAIT_L(0); PG8_MMA(0, 1, At, B1); PG8_BAR;
            PG8_LDA(At, 0, 1); PG8_STAGE(PG8_SA(0, 0), a2, voffA);
            PG8_BAR; PG8_WAIT_L(0); PG8_MMA(1, 0, At, B0); PG8_BAR; PG8_SCHED;
            PG8_STAGE(PG8_SB(0, 1), b2 + bhs, voffB);
            PG8_WAIT_V(6); PG8_BAR; PG8_MMA(1, 1, At, B1); PG8_BAR;
            PG8_LDB(B0, 1, 0); PG8_SCHED; PG8_LDA(At, 1, 0); PG8_STAGE(PG8_SA(0, 1), a2 + hstep, voffA);
            PG8_WAIT_L(8); PG8_BAR; PG8_WAIT_L(0); PG8_MMA(0, 0, At, B0); PG8_BAR; PG8_SCHED;
            PG8_LDB(B1, 1, 1); PG8_STAGE(PG8_SB(1, 0), b3, voffB);
            PG8_BAR; PG8_WAIT_L(0); PG8_MMA(0, 1, At, B1); PG8_BAR;
            PG8_LDA(At, 1, 1); PG8_STAGE(PG8_SA(1, 0), a3, voffA);
            PG8_BAR; PG8_WAIT_L(0); PG8_MMA(1, 0, At, B0); PG8_BAR; PG8_SCHED;
            PG8_STAGE(PG8_SB(1, 1), b3 + bhs, voffB);
            PG8_WAIT_V(6); PG8_BAR; PG8_MMA(1, 1, At, B1); PG8_BAR;
            }
        }
        if constexpr (ALIGN_EPI) { if (wr == 0) PG8_BAR; }
        if constexpr (!Epi::AFTER_DRAIN) { int t_ = threadIdx.x; asm volatile("" : "+v"(t_)); const int l_ = t_ & 63; E(acc, cur, wr, wc, l_ & 15, l_ >> 4); S.done(cur); }
        if (!has_next) break;
#pragma unroll
        for (int a = 0; a < 2; ++a)
#pragma unroll
            for (int b = 0; b < 2; ++b)
#pragma unroll
                for (int m = 0; m < 4; ++m)
#pragma unroll
                    for (int n = 0; n < 2; ++n) acc[a][b][m][n] = (f32x4){0.f, 0.f, 0.f, 0.f};
        cur = nxt; cA = nA; cB = nB; ++ui;
        if constexpr (ALIGN_EPI) { if (wr == 1) PG8_BAR; }
    }
    PG8_WAIT_V(0);
    if constexpr (!ALIGN_EPI) { if (wr == 0) PG8_BAR; }
    PG8_BAR;
    if constexpr (Epi::AFTER_DRAIN) { E.fused(acc, cur, wr, wc, fr, fq, lds, wid, lane); S.done(cur); }
#undef PG8_SA
#undef PG8_SB
#undef PG8_STAGE
#undef PG8_LDA
#undef PG8_LDB
#undef PG8_MMA
#undef PG8_WAIT_V
#undef PG8_WAIT_L
#undef PG8_BAR
#undef PG8_SCHED
}
}
namespace sba {
typedef short bf16x8 __attribute__((ext_vector_type(8)));
typedef short s16x4 __attribute__((ext_vector_type(4)));
typedef float f32x16 __attribute__((ext_vector_type(16)));
typedef float f32x4 __attribute__((ext_vector_type(4)));
typedef unsigned u32x4 __attribute__((ext_vector_type(4)));
typedef unsigned short bf16_t;
#define SB_LAS __attribute__((address_space(3)))
constexpr int PITCH = 512, SLOTB = 16384  , OFF_FLAGS = 2 * SLOTB, OFF_OST = OFF_FLAGS + 256, LDS_BYTES = OFF_OST + 8 * 4096;
constexpr float THR2 = 48.0f, NEGBIG = -1.0e30f;
typedef float f32x2_t __attribute__((ext_vector_type(2))); typedef __bf16 bf16x2_t __attribute__((ext_vector_type(2)));
__device__ __forceinline__ unsigned cvtpk(float lo, float hi) { f32x2_t v = {lo, hi}; bf16x2_t b = __builtin_convertvector(v, bf16x2_t); return __builtin_bit_cast(unsigned, b); }
__device__ __forceinline__ bf16x8 pack8f(float a0, float a1, float a2, float a3, float a4, float a5, float a6, float a7) {
    u32x4 w; w.x = cvtpk(a0, a1); w.y = cvtpk(a2, a3); w.z = cvtpk(a4, a5); w.w = cvtpk(a6, a7); return __builtin_bit_cast(bf16x8, w); }
typedef short v4i16_t __attribute__((ext_vector_type(4)));
__device__ __forceinline__ s16x4 vtr(const SB_LAS char* p) { return __builtin_bit_cast(s16x4, __builtin_amdgcn_ds_read_tr16_b64_v4i16((SB_LAS v4i16_t*)p)); }
__device__ __forceinline__ int crow(int r, int hi) { return (r & 3) + 8 * (r >> 2) + 4 * hi; }

template <int SUB>
__device__ __forceinline__ void sub_front(const SB_LAS char* Kslot, bool mask, int kq, const bf16x8 (&qr)[4], f32x16& w, bf16x8 (&spb)[2], int r32, int hi) {
    const SB_LAS char* kb = Kslot + hi * 1024 + r32 * 16 + SUB * 512;
    f32x16 p = {};
#pragma unroll
    for (int d0 = 0; d0 < 4; ++d0) { const bf16x8 kf = *(const SB_LAS bf16x8*)(kb + d0 * 2048); p = __builtin_amdgcn_mfma_f32_32x32x16_bf16(kf, qr[d0], p, 0, 0, 0); }
    float sp[16];
#pragma unroll
    for (int r = 0; r < 16; ++r) {
        float x = p[r];
        if (mask && (kq + 32 * SUB + (r & 3) + 8 * (r >> 2) >= 0)) x = NEGBIG;
        const float t = __builtin_amdgcn_exp2f(-__builtin_fabsf(x));
        const float l = __builtin_amdgcn_logf(1.0f + t);
        sp[r] = __builtin_fmaxf(x, 0.f) + l; w[r] = __builtin_fminf(x, 0.f) - l;
    }
    spb[0] = pack8f(sp[0], sp[1], sp[2], sp[3], sp[4], sp[5], sp[6], sp[7]);
    spb[1] = pack8f(sp[8], sp[9], sp[10], sp[11], sp[12], sp[13], sp[14], sp[15]);
}
template <int SUB>
__device__ __forceinline__ void sub_back(const SB_LAS char* vp, const f32x16& w, const f32x16& sx, f32x16 (&o)[2]) {
    float pr[16];
#pragma unroll
    for (int r = 0; r < 16; ++r) pr[r] = __builtin_amdgcn_exp2f(w[r] - sx[r]);
    bf16x8 pa[2];
    pa[0] = pack8f(pr[0], pr[1], pr[2], pr[3], pr[4], pr[5], pr[6], pr[7]);
    pa[1] = pack8f(pr[8], pr[9], pr[10], pr[11], pr[12], pr[13], pr[14], pr[15]);
#pragma unroll
    for (int d0 = 0; d0 < 2; ++d0)
#pragma unroll
        for (int s = 0; s < 2; ++s) { const int ks = 2 * SUB + s;
            const s16x4 lo = vtr(vp + d0 * 4096 + ks * 1024), hi4 = vtr(vp + d0 * 4096 + ks * 1024 + 512);
            const bf16x8 vf = (bf16x8){lo[0], lo[1], lo[2], lo[3], hi4[0], hi4[1], hi4[2], hi4[3]};
            o[d0] = __builtin_amdgcn_mfma_f32_32x32x16_bf16(pa[s], vf, o[d0], 0, 0, 0); }
}
__device__ __forceinline__ void sb_tile(const SB_LAS char* slot, bool mask, bool skip1, int kq, const bf16x8 (&qr)[4], f32x16& Rb, f32x16 (&o)[2], const bf16x8 (&Um)[2], const bf16x8 Jm, int r32, int hi, int lane) {
    const SB_LAS char* vp = slot + 8192 + ((lane >> 4) & 1) * 32 + (lane & 3) * 8 + (4 * hi + ((lane & 15) >> 2)) * 64;
    f32x16 w1, w0; bf16x8 sb1[2], sb0[2];
    f32x16 t1 = Rb;
    if (!skip1) {
    sub_front<1>(slot, mask, kq, qr, w1, sb1, r32, hi);
    f32x16 a1 = __builtin_amdgcn_mfma_f32_32x32x16_bf16(Um[0], sb1[0], Rb, 0, 0, 0); a1 = __builtin_amdgcn_mfma_f32_32x32x16_bf16(Um[1], sb1[1], a1, 0, 0, 0);
    t1 = __builtin_amdgcn_mfma_f32_32x32x16_bf16(Jm, sb1[0], Rb, 0, 0, 0); t1 = __builtin_amdgcn_mfma_f32_32x32x16_bf16(Jm, sb1[1], t1, 0, 0, 0);
    sub_back<1>(vp, w1, a1, o);
    }
    sub_front<0>(slot, mask, kq, qr, w0, sb0, r32, hi);
    f32x16 a0 = __builtin_amdgcn_mfma_f32_32x32x16_bf16(Um[0], sb0[0], t1, 0, 0, 0); a0 = __builtin_amdgcn_mfma_f32_32x32x16_bf16(Um[1], sb0[1], a0, 0, 0, 0);
    f32x16 rn = __builtin_amdgcn_mfma_f32_32x32x16_bf16(Jm, sb0[0], t1, 0, 0, 0); rn = __builtin_amdgcn_mfma_f32_32x32x16_bf16(Jm, sb0[1], rn, 0, 0, 0);
    sub_back<0>(vp, w0, a0, o);
    Rb = rn;
}
struct Tensors { const bf16_t* Q; const bf16_t* K; const bf16_t* V; bf16_t* O; const float* ck; const float* cv; };

template <bool SAMPLE>
__device__ __forceinline__ void sb_unit(int b, int h, int qb, const Tensors& T, SB_LAS char* lds) {
    int tid = threadIdx.x; asm volatile("" : "+v"(tid)); const int lane = tid & 63, r32 = lane & 31, hi = lane >> 5; const int wid = __builtin_amdgcn_readfirstlane(tid >> 6);
    const size_t rowbase = SAMPLE ? (size_t)cfg::MP + (size_t)b * 32 : (size_t)b * cfg::SEQ; const int q0 = SAMPLE ? 0 : qb * 256;
    const int jd = SAMPLE ? 16 : (q0 >> 6) + (wid >> 1), jtop = SAMPLE ? 16 : (q0 >> 6) + 3;
    const bool worker = SAMPLE ? (wid == 0) : true;
    const int wq = SAMPLE ? 0 : wid;
    const int qpos = (SAMPLE ? cfg::PAST : q0 + 32 * wq) + r32;
    volatile SB_LAS unsigned* flags = (volatile SB_LAS unsigned*)(lds + OFF_FLAGS);
    bf16x8 Um[2], Jm;
#pragma unroll
    for (int s = 0; s < 2; ++s)
#pragma unroll
        for (int jj = 0; jj < 8; ++jj) Um[s][jj] = (16 * s + 8 * (jj >> 2) + 4 * hi + (jj & 3) > r32) ? (short)0x3F80 : (short)0;
#pragma unroll
    for (int jj = 0; jj < 8; ++jj) Jm[jj] = (short)0x3F80;
    bf16x8 qr[4];
    { const bf16_t* Qw = T.Q + (rowbase + q0 + 32 * wq + r32) * PITCH + h * 64 + hi * 8;
#pragma unroll
      for (int d0 = 0; d0 < 4; ++d0) qr[d0] = *(const bf16x8*)(Qw + d0 * 16); }
    f32x16 Rb = {}, o[2]; o[0] = f32x16{}; o[1] = f32x16{};
    bool done = false;
    u32x4 kreg, vreg;
    const int vkey = 16 * (wid & 3) + (lane >> 2), vcol = (wid >> 2) * 32 + (lane & 3) * 8;
#define SB_LOAD(j) do { \
        if (!SAMPLE) { kreg = *(const u32x4*)(T.K + (rowbase + (size_t)(64 * (j) + lane)) * PITCH + h * 64 + wid * 8); vreg = *(const u32x4*)(T.V + (rowbase + (size_t)(64 * (j) + vkey)) * PITCH + h * 64 + vcol); } \
        else if ((j) == 16) { const int kr_ = lane < 31 ? lane : 31, vr_ = vkey < 31 ? vkey : 31; \
            kreg = *(const u32x4*)(T.K + (rowbase + kr_) * PITCH + h * 64 + wid * 8); vreg = *(const u32x4*)(T.V + (rowbase + vr_) * PITCH + h * 64 + vcol); } \
        else { const float* kp_ = T.ck + ((size_t)b * cfg::PAST + 64 * (j) + lane) * PITCH + h * 64 + wid * 8; const float* vp_ = T.cv + ((size_t)b * cfg::PAST + 64 * (j) + vkey) * PITCH + h * 64 + vcol; \
            const f32x4 k0_ = *(const f32x4*)kp_, k1_ = *(const f32x4*)(kp_ + 4), v0_ = *(const f32x4*)vp_, v1_ = *(const f32x4*)(vp_ + 4); \
            kreg = (u32x4){cvtpk(k0_[0], k0_[1]), cvtpk(k0_[2], k0_[3]), cvtpk(k1_[0], k1_[1]), cvtpk(k1_[2], k1_[3])}; vreg = (u32x4){cvtpk(v0_[0], v0_[1]), cvtpk(v0_[2], v0_[3]), cvtpk(v1_[0], v1_[1]), cvtpk(v1_[2], v1_[3])}; } } while (0)
    SB_LOAD(jtop);
    for (int j = jtop; j >= 0; --j) {
        SB_LAS char* slot = lds + (j & 1) * SLOTB;
        *(SB_LAS u32x4*)(slot + wid * 1024 + lane * 16) = kreg; *(SB_LAS u32x4*)(slot + 8192 + wid * 1024 + lane * 16) = vreg;
        __syncthreads();
        if (j != jtop) { const volatile SB_LAS unsigned* f = flags + ((j + 1) & 1) * 8; unsigned all = 1u;
#pragma unroll
            for (int w8 = 0; w8 < 8; ++w8) all &= f[w8];
            if (all) break; }
        if (j > 0) SB_LOAD(j - 1);
        if (worker && !done && j <= jd) {
            const int key0 = (SAMPLE && j == 16) ? cfg::PAST : 64 * j;
            sb_tile(slot, j == jd, (j == jd) && (SAMPLE || (wid & 1) == 0), key0 + 4 * hi - qpos, qr, Rb, o, Um, Jm, r32, hi, lane);
            done = __all(Rb[0] > THR2) != 0;
        }
        if (lane == 0) flags[(j & 1) * 8 + wid] = (done || !worker) ? 1u : 0u;
    }
#undef SB_LOAD
    if (worker) {
        SB_LAS bf16_t* stg = (SB_LAS bf16_t*)(lds + OFF_OST) + wid * 2048;
#pragma unroll
        for (int r = 0; r < 16; ++r) { const int orow = crow(r, hi);
#pragma unroll
            for (int d0 = 0; d0 < 2; ++d0) stg[orow * 64 + d0 * 32 + r32] = (bf16_t)(cvtpk(o[d0][r], 0.f) & 0xffffu); }
        asm volatile("s_waitcnt lgkmcnt(0)" ::: "memory");
        bf16_t* Ow = T.O + (rowbase + q0 + 32 * wq) * PITCH + h * 64;
#pragma unroll
        for (int i = 0; i < 4; ++i) { const int row = i * 8 + (lane >> 3), ch = lane & 7; const u32x4 v = *(const SB_LAS u32x4*)(stg + row * 64 + ch * 8); *(u32x4*)(Ow + (size_t)row * PITCH + ch * 8) = v; }
    }
    __syncthreads();
}
}
namespace sk {
typedef short bf16x8 __attribute__((ext_vector_type(8)));
typedef float f32x16 __attribute__((ext_vector_type(16)));
typedef float f32x4 __attribute__((ext_vector_type(4)));
typedef unsigned short bf16_t;
#define SK_LAS __attribute__((address_space(3)))
constexpr int PLD = 36;
constexpr int LDS_BYTES = 8 * 2 * 32 * PLD * 4;
__device__ __forceinline__ f32x4 tile(const bf16_t* A, const bf16_t* Bt, int K, size_t arow0, int col0, SK_LAS char* lds) {
    int tid = threadIdx.x; asm volatile("" : "+v"(tid)); const int lane = tid & 63, r32 = lane & 31, hi = lane >> 5; const int wid = __builtin_amdgcn_readfirstlane(tid >> 6);
    const int nsplit = (K >= 512) ? 8 : (K >> 6), ks = K / nsplit;
    const bf16_t* ap = A + (arow0 + r32) * K + wid * ks + hi * 32;
    const bf16_t* bp0 = Bt + (size_t)(col0 + r32) * K + wid * ks + hi * 32; const bf16_t* bp1 = bp0 + (size_t)32 * K;
    f32x16 acc0 = {}, acc1 = {};
#pragma unroll 2
    for (int s = 0; s < ((wid < nsplit) ? ks : 0); s += 64) {
        bf16x8 a[4], b0[4], b1[4];
#pragma unroll
        for (int j = 0; j < 4; ++j) { a[j] = *(const bf16x8*)(ap + s + 8 * j); b0[j] = *(const bf16x8*)(bp0 + s + 8 * j); b1[j] = *(const bf16x8*)(bp1 + s + 8 * j); }
#pragma unroll
        for (int j = 0; j < 4; ++j) {
            acc0 = __builtin_amdgcn_mfma_f32_32x32x16_bf16(b0[j], a[j], acc0, 0, 0, 0);
            acc1 = __builtin_amdgcn_mfma_f32_32x32x16_bf16(b1[j], a[j], acc1, 0, 0, 0); }
    }
    SK_LAS float* P0 = (SK_LAS float*)lds + ((wid * 2 + 0) * 32 + r32) * PLD + 4 * hi; SK_LAS float* P1 = P0 + 32 * PLD;
#pragma unroll
    for (int g = 0; g < 4; ++g) { *(SK_LAS f32x4*)(P0 + 8 * g) = (f32x4){acc0[4 * g], acc0[4 * g + 1], acc0[4 * g + 2], acc0[4 * g + 3]};
                                  *(SK_LAS f32x4*)(P1 + 8 * g) = (f32x4){acc1[4 * g], acc1[4 * g + 1], acc1[4 * g + 2], acc1[4 * g + 3]}; }
    __syncthreads();
    const int row = tid >> 4, c = (tid & 15) * 4, cb = c >> 5, cc = c & 31;
    f32x4 s = {0.f, 0.f, 0.f, 0.f};
#pragma unroll
    for (int w = 0; w < 8; ++w) s += *(const SK_LAS f32x4*)((SK_LAS float*)lds + ((w * 2 + cb) * 32 + row) * PLD + cc);
    __syncthreads();
    return s;
}
__device__ __forceinline__ void tile4(const bf16_t* A, const bf16_t* Bt, int K, size_t arow0, int col0, SK_LAS char* lds, f32x4 (&out)[2][2]) {
    int tid = threadIdx.x; asm volatile("" : "+v"(tid)); const int lane = tid & 63, r32 = lane & 31, hi = lane >> 5; const int wid = __builtin_amdgcn_readfirstlane(tid >> 6);
    const int half = wid >> 2, kq = wid & 3, ks = K >> 2;
    const bf16_t* ap = A + (arow0 + r32) * K + kq * ks + hi * 32;
    const bf16_t* bp = Bt + (size_t)(col0 + half * 128 + r32) * K + kq * ks + hi * 32;
    f32x16 acc[4]; acc[0] = f32x16{}; acc[1] = f32x16{}; acc[2] = f32x16{}; acc[3] = f32x16{};
#pragma unroll 1
    for (int s = 0; s < ks; s += 64) {
        bf16x8 a[4], b[4][4];
#pragma unroll
        for (int e = 0; e < 4; ++e) { a[e] = *(const bf16x8*)(ap + s + 8 * e);
#pragma unroll
            for (int j = 0; j < 4; ++j) b[j][e] = *(const bf16x8*)(bp + (size_t)(32 * j) * K + s + 8 * e); }
#pragma unroll
        for (int e = 0; e < 4; ++e)
#pragma unroll
            for (int j = 0; j < 4; ++j) acc[j] = __builtin_amdgcn_mfma_f32_32x32x16_bf16(b[j][e], a[e], acc[j], 0, 0, 0);
    }
    const int row = tid >> 4, cc = (tid & 15) * 4;
#pragma unroll
    for (int q = 0; q < 2; ++q) {
        SK_LAS float* P0 = (SK_LAS float*)lds + ((wid * 2 + 0) * 32 + r32) * PLD + 4 * hi; SK_LAS float* P1 = P0 + 32 * PLD;
#pragma unroll
        for (int g = 0; g < 4; ++g) { *(SK_LAS f32x4*)(P0 + 8 * g) = (f32x4){acc[2 * q][4 * g], acc[2 * q][4 * g + 1], acc[2 * q][4 * g + 2], acc[2 * q][4 * g + 3]};
                                      *(SK_LAS f32x4*)(P1 + 8 * g) = (f32x4){acc[2 * q + 1][4 * g], acc[2 * q + 1][4 * g + 1], acc[2 * q + 1][4 * g + 2], acc[2 * q + 1][4 * g + 3]}; }
        __syncthreads();
#pragma unroll
        for (int h = 0; h < 2; ++h) { f32x4 sum = {0.f, 0.f, 0.f, 0.f};
#pragma unroll
            for (int w = 0; w < 4; ++w) sum += *(const SK_LAS f32x4*)((SK_LAS float*)lds + (((h * 4 + w) * 2 + (cc >> 5)) * 32 + row) * PLD + (cc & 31));
            out[h][q] = sum; }
        __syncthreads();
    }
}
__device__ __forceinline__ float sum16(float v) { v += __shfl_xor(v, 1); v += __shfl_xor(v, 2); v += __shfl_xor(v, 4); v += __shfl_xor(v, 8); return v; }
__device__ __forceinline__ float rstd16(const float* SSQ, int r, int t) { return __builtin_amdgcn_rsqf(sum16(SSQ[(size_t)r * 16 + (t & 15)]) * (1.0f / 1024.0f) + cfg::EPS); }
__device__ __forceinline__ unsigned long long pk4(f32x4 v) { return (unsigned long long)pg8::cvt_pk_bf16(v[0], v[1]) | ((unsigned long long)pg8::cvt_pk_bf16(v[2], v[3]) << 32); }
__device__ __forceinline__ f32x4 up4(unsigned long long w) { const unsigned lo = (unsigned)w, hi = (unsigned)(w >> 32); return (f32x4){pg8::bf_lo(lo), pg8::bf_hi(lo), pg8::bf_lo(hi), pg8::bf_hi(hi)}; }
}
#define GAS __attribute__((address_space(1)))
#define LAS __attribute__((address_space(3)))
typedef unsigned short bf16;
typedef unsigned v4u __attribute__((ext_vector_type(4)));
typedef float f32x4 __attribute__((ext_vector_type(4)));
typedef short bf16x8 __attribute__((ext_vector_type(8)));
typedef GAS unsigned gu32;
typedef GAS unsigned long long gu64;
#define RLX_AGENT __ATOMIC_RELAXED, __HIP_MEMORY_SCOPE_AGENT
#define LDS_WAIT() asm volatile("s_waitcnt lgkmcnt(0)" ::: "memory")
#define VM_WAIT() asm volatile("s_waitcnt vmcnt(0)" ::: "memory")
__device__ __forceinline__ unsigned long long rt() { return __builtin_amdgcn_s_memrealtime(); }
__device__ __forceinline__ unsigned f2bf(float f) { unsigned u = __builtin_bit_cast(unsigned, f); return (u + 0x7fffu + ((u >> 16) & 1u)) >> 16; }
__device__ __forceinline__ unsigned pk2(float lo, float hi) { return f2bf(lo) | (f2bf(hi) << 16); }
#define XB_TMO      128
#define XB_XCNT(j)  (256  + 64 * (j))
#define XB_XSUB(j)  (1280 + 64 * (j))
#define XB_XGEN(j)  (2304 + 64 * (j))
#define XB_TOP      3328
#define XB_TOPGEN   3392
#define XCD_BAR_WORDS 3456
#define XB_SPIN_CAP (1u << 18)

__device__ __forceinline__ unsigned xb_ld(unsigned* p)              { return __hip_atomic_load(p, __ATOMIC_RELAXED, __HIP_MEMORY_SCOPE_AGENT); }
__device__ __forceinline__ unsigned xb_add(unsigned* p, unsigned v) { return __hip_atomic_fetch_add(p, v, __ATOMIC_RELAXED, __HIP_MEMORY_SCOPE_AGENT); }
__device__ __forceinline__ unsigned xb_xcc_id() { return (unsigned)__builtin_amdgcn_s_getreg((3 << 11) | 20) & 0xFu; }
#define XB_SPIN(cond, bar) do { unsigned _sp = 0; while (cond) { __builtin_amdgcn_s_sleep(1); \
    if ((++_sp & 255u) == 0u) { if (xb_ld(&(bar)[XB_TMO])) break; if (_sp > XB_SPIN_CAP) { atomicAdd(&(bar)[XB_TMO], 1u); break; } } } } while (0)

struct XcdBarrier {
    unsigned* bar; unsigned x;
    volatile LAS unsigned* st;
};

__device__ __forceinline__ XcdBarrier xcd_barrier_post(unsigned* bar, volatile LAS unsigned* st) {
    XcdBarrier b; b.bar = bar; b.x = xb_xcc_id(); b.st = st;
    if (threadIdx.x == 0) (void)xb_add(&bar[XB_XCNT(b.x)], 1u);
    return b;
}
__device__ __forceinline__ void xcd_barrier_complete(unsigned* bar, unsigned x, unsigned& nloc, unsigned& nx) {
    const unsigned G = gridDim.x * gridDim.y * gridDim.z;
    unsigned sum, cnt, mine, sp = 0u;
    for (;;) {
        sum = 0u; cnt = 0u; mine = 0u;
#pragma unroll
        for (unsigned j = 0; j < 16; ++j) { const unsigned c = xb_ld(&bar[XB_XCNT(j)]); sum += c; cnt += (c > 0u) ? 1u : 0u; mine = (j == x) ? c : mine; }
        if (sum == G) break;
        __builtin_amdgcn_s_sleep(1);
        if ((++sp & 255u) == 0u) { if (xb_ld(&bar[XB_TMO])) break; if (sp > XB_SPIN_CAP) { atomicAdd(&bar[XB_TMO], 1u); break; } }
    }
    nloc = mine > 0u ? mine : 1u; nx = cnt > 0u ? cnt : 1u;
}

__device__ __forceinline__ void xcd_barrier(const XcdBarrier& b) {
    asm volatile("s_waitcnt vmcnt(0)" ::: "memory");
    __syncthreads();
    if (threadIdx.x == 0) {
        unsigned* bar = b.bar;
        __builtin_amdgcn_s_waitcnt(0);
        unsigned nloc = b.st[0], nx = b.st[1];
        if (nloc == 0u) { xcd_barrier_complete(bar, b.x, nloc, nx); b.st[0] = nloc; b.st[1] = nx; }
        const unsigned old = xb_add(&bar[XB_XSUB(b.x)], 1u);
        const unsigned gen = old / nloc;
        if (old + 1u == (gen + 1u) * nloc) {
            __builtin_amdgcn_fence(__ATOMIC_RELEASE, "agent");
            asm volatile("s_waitcnt vmcnt(0)" ::: "memory");
            const unsigned og = xb_add(&bar[XB_TOP], 1u);
            const unsigned tg = og / nx;
            if (og + 1u == (tg + 1u) * nx) xb_add(&bar[XB_TOPGEN], 1u);
            else XB_SPIN(xb_ld(&bar[XB_TOPGEN]) == tg, bar);
            __builtin_amdgcn_fence(__ATOMIC_ACQUIRE, "agent");
            xb_add(&bar[XB_XGEN(b.x)], 1u);
            asm volatile("s_waitcnt vmcnt(0)" ::: "memory");
        } else {
            XB_SPIN(xb_ld(&bar[XB_XGEN(b.x)]) == gen, bar);
            __builtin_amdgcn_fence(__ATOMIC_ACQUIRE, "agent");
            asm volatile("s_waitcnt vmcnt(0)" ::: "memory");
        }
    }
    __syncthreads();
}
__device__ __forceinline__ float wave_sum(float v) {
#pragma unroll
    for (int o = 1; o < 64; o <<= 1) v += __shfl_xor(v, o);
    return v;
}
__device__ __forceinline__ void p0_transpose_item(const float* W, int K, int N, bf16* WT, int row_off, LAS float* scr, int item, int lane) {
    const int nblk = N / 32, kb = item / nblk, nb = item % nblk, k0 = 64 * kb, n0 = 32 * nb;
    float tv[32];
#pragma unroll
    for (int i = 0; i < 32; ++i) { const int kk = 2 * i + (lane >> 5); tv[i] = W[(size_t)(k0 + kk) * N + n0 + (lane & 31)]; }
#pragma unroll
    for (int i = 0; i < 32; ++i) { const int kk = 2 * i + (lane >> 5); scr[kk * 33 + (lane & 31)] = tv[i]; }
    LDS_WAIT(); asm volatile("" ::: "memory");
    const int c = lane & 7;
#pragma unroll
    for (int j = 0; j < 4; ++j) { const int n = (lane >> 3) + 8 * j; const LAS float* s = scr + (8 * c) * 33 + n;
        v4u o; o.x = pk2(s[0 * 33], s[1 * 33]); o.y = pk2(s[2 * 33], s[3 * 33]); o.z = pk2(s[4 * 33], s[5 * 33]); o.w = pk2(s[6 * 33], s[7 * 33]);
        *(GAS v4u*)(WT + (size_t)(row_off + n0 + n) * K + k0 + 8 * c) = o; }
    LDS_WAIT(); asm volatile("" ::: "memory");
}
constexpr int NWAVES = 8;
#ifndef MK_N_LAUNCHES
#define MK_N_LAUNCHES 1
#endif
constexpr int N_PHASES = 8;
#ifndef DBG_ROT
#define DBG_ROT 0
#endif
#ifndef DBG_REPEAT
#define DBG_REPEAT -1
#endif
#ifndef DBG_P2PART
#define DBG_P2PART 0
#endif
#ifndef DBG_ALIGN
#define DBG_ALIGN true
#endif
#ifndef DBG_SP2
#define DBG_SP2 true
#endif
using namespace cfg;
constexpr size_t MiB = 1u << 20;
constexpr size_t WS_CTL = 0, CTL_ZERO_BYTES = 1 * MiB;
constexpr size_t WS_WIN = 2 * MiB, WS_WEFF = 10 * MiB, WS_WSB = 11 * MiB, WS_WOUT = 12 * MiB, WS_WUP = 14 * MiB, WS_WDOWN = 22 * MiB, WS_WPG = 30 * MiB, WS_WPP = 32 * MiB;
constexpr size_t WS_SSQ1 = 33 * MiB, WS_SSQ2 = 35 * MiB, WS_SSQ3 = 37 * MiB;
constexpr size_t WS_PB = 40 * MiB;
constexpr size_t WS_XN = 49 * MiB;
constexpr size_t WS_BIG = 82 * MiB;
constexpr size_t WS_U = WS_BIG, WS_Q = WS_BIG + 16 * MiB + MiB / 2, WS_K = WS_BIG + 33 * MiB, WS_V = WS_BIG + 49 * MiB + MiB / 2;
constexpr size_t WS_G = WS_BIG + 66 * MiB;
constexpr size_t WS_Y = WS_BIG + 132 * MiB, WS_YSB = WS_Y + 16 * MiB + MiB / 2;
constexpr size_t WS_MG = WS_BIG;
constexpr size_t WS_H = WS_BIG;
constexpr size_t WS_PP = WS_BIG;
constexpr size_t WS_X = WS_Y;
constexpr size_t WS_END = WS_BIG + 165 * MiB;
static_assert((size_t)MT * 512 * 2 == 16 * MiB + MiB / 2 && (size_t)MT * 1024 * 2 == 33 * MiB && (size_t)MT * 16 * 4 <= 2 * MiB && (size_t)MT * 256 * 2 <= 9 * MiB && WS_END <= 256 * MiB, "d_ws map");
constexpr int CW_BAR = 4096, CW_FIN = 8192  , CW_FINS = 16384  ;
constexpr size_t O_Y = 0, O_KP = 17301504, O_VP = 25690112, O_POOLP = 34078720, O_KS = 34140160, O_VS = 34402304, O_POOLS = 34664448, O_END = 34787328;
constexpr int RING_OFF = 0, RING_BYTES = 131072, LDSCTL_OFF = RING_BYTES, MISC_OFF = LDSCTL_OFF + 320, LDS_BYTES = 147456;
static_assert(sk::LDS_BYTES <= RING_BYTES && sba::LDS_BYTES <= RING_BYTES, "attention scratch fits the ring region");

struct Args { const float* in[22]; float* out; unsigned char* ws; int ph_lo, ph_hi, li, pad; };

__device__ __forceinline__ void rms_rows_to_bf16(const float* xrow0, const float* xrow1, const float* g, bf16* orow0, bf16* orow1, int lane) {
    const GAS f32x4* xr0 = (const GAS f32x4*)xrow0 + lane; const GAS f32x4* xr1 = (const GAS f32x4*)(xrow1 ? xrow1 : xrow0) + lane; const GAS f32x4* gr = (const GAS f32x4*)g + lane;
    f32x4 v[4], w[4], gg[4]; float s = 0.f, t = 0.f;
#pragma unroll
    for (int j = 0; j < 4; ++j) { v[j] = xr0[64 * j]; w[j] = xr1[64 * j]; gg[j] = gr[64 * j]; }
#pragma unroll
    for (int j = 0; j < 4; ++j) { s += (v[j].x * v[j].x + v[j].y * v[j].y) + (v[j].z * v[j].z + v[j].w * v[j].w); t += (w[j].x * w[j].x + w[j].y * w[j].y) + (w[j].z * w[j].z + w[j].w * w[j].w); }
#pragma unroll
    for (int o = 1; o < 64; o <<= 1) { s += __shfl_xor(s, o); t += __shfl_xor(t, o); }
    const float rs = 1.f / sqrtf(s * (1.f / DM) + EPS), rt = 1.f / sqrtf(t * (1.f / DM) + EPS);
    GAS unsigned long long* o0 = (GAS unsigned long long*)orow0 + lane; GAS unsigned long long* o1 = (GAS unsigned long long*)orow1 + lane;
#pragma unroll
    for (int j = 0; j < 4; ++j) { o0[64 * j] = (unsigned long long)pk2(v[j].x * rs * gg[j].x, v[j].y * rs * gg[j].y) | ((unsigned long long)pk2(v[j].z * rs * gg[j].z, v[j].w * rs * gg[j].w) << 32);
        if (xrow1) o1[64 * j] = (unsigned long long)pk2(w[j].x * rt * gg[j].x, w[j].y * rt * gg[j].y) | ((unsigned long long)pk2(w[j].z * rt * gg[j].z, w[j].w * rt * gg[j].w) << 32); }
}
__device__ __forceinline__ void weff_item(const float* wgrp, const float* scale, const float* wpu, bf16* WT, int item, int lane) {
    const int nb = item & 15, cb = (item >> 4) & 15, g = item >> 8, n = nb * 64 + lane;
    float wg[8][2];
#pragma unroll
    for (int cc = 0; cc < 8; ++cc)
#pragma unroll
        for (int hh = 0; hh < 2; ++hh) wg[cc][hh] = wgrp[((size_t)(g * 128 + cb * 8 + cc)) * 128 + lane + 64 * hh] * scale[g * 128 + lane + 64 * hh];
    float acc[8];
#pragma unroll
    for (int cc = 0; cc < 8; ++cc) acc[cc] = 0.f;
#pragma unroll
    for (int hh = 0; hh < 2; ++hh)
#pragma unroll 16
        for (int d2 = 0; d2 < 64; ++d2) { const float wv = wpu[(size_t)(g * 128 + hh * 64 + d2) * 1024 + n];
#pragma unroll
            for (int cc = 0; cc < 8; ++cc) acc[cc] = fmaf(__builtin_bit_cast(float, __builtin_amdgcn_readlane(__builtin_bit_cast(int, wg[cc][hh]), d2)), wv, acc[cc]); }
    v4u o; o.x = pk2(acc[0], acc[1]); o.y = pk2(acc[2], acc[3]); o.z = pk2(acc[4], acc[5]); o.w = pk2(acc[6], acc[7]);
    *(GAS v4u*)(WT + (size_t)n * 512 + g * 128 + cb * 8) = o;
}

template <int W, int R>
__device__ __forceinline__ void pool_run(const bf16* Ub, const float* state_pool, bf16* Yb, int run, int c) {
    const int r0 = run * R; const bool sample = r0 >= MP; const int t0 = sample ? ((r0 - MP) & 31) : (r0 & (SEQ - 1)); const int b_ = sample ? ((r0 - MP) >> 5) : 0;
    v4u rw[R - 1 + W];
#pragma unroll
    for (int k = 0; k < W - 1; ++k) { const int pos = t0 + k - (W - 1);
        if (pos >= 0) rw[k] = *(const GAS v4u*)(Ub + (size_t)(r0 - (W - 1) + k) * 512 + c);
        else if (sample) { const float* sp = state_pool + ((size_t)b_ * 15 + 15 + pos) * 512 + c; const f32x4 a = *(const GAS f32x4*)sp, b = *(const GAS f32x4*)(sp + 4); rw[k] = pg8::pack8(a, b); }
        else rw[k] = (v4u){0u, 0u, 0u, 0u}; }
#pragma unroll
    for (int k = W - 1; k < R - 1 + W; ++k) rw[k] = *(const GAS v4u*)(Ub + (size_t)(r0 - (W - 1) + k) * 512 + c);
    f32x4 s0 = {0.f, 0.f, 0.f, 0.f}, s1 = {0.f, 0.f, 0.f, 0.f};
#pragma unroll
    for (int k = 0; k < W - 1; ++k) { f32x4 a, b; pg8::unpack8(rw[k], a, b); s0 += a; s1 += b; }
#pragma unroll
    for (int i = 0; i < R; ++i) { f32x4 a, b, u0, u1; pg8::unpack8(rw[W - 1 + i], u0, u1); s0 += u0; s1 += u1;
        const int cnt = sample ? W : ((t0 + i + 1 < W) ? t0 + i + 1 : W); const float ic = 1.0f / (float)cnt;
        *(GAS v4u*)(Yb + (size_t)(r0 + i) * 512 + c) = pg8::pack8(s0 * ic - u0, s1 * ic - u1);
        pg8::unpack8(rw[i], a, b); s0 -= a; s1 -= b; }
}
#if defined(HYB_ATTN) || defined(HYB_POOL)
__device__ __forceinline__ float hb2f(unsigned short v) { return __uint_as_float((unsigned)v << 16); }
__global__ void __launch_bounds__(64) hyb_attn(const unsigned short* Qb, const unsigned short* Kb, const unsigned short* Vb, const float* ck, const float* cv, unsigned short* YSB) {
    const int idx = blockIdx.x * 64 + threadIdx.x; if (idx >= MT * NH) return;
    const int h = idx / MT, m = idx % MT;
    float qr[HD], o[HD];
#pragma unroll
    for (int d = 0; d < HD; ++d) { qr[d] = hb2f(Qb[(size_t)m * 512 + h * HD + d]) * 0.6931471805599453f; o[d] = 0.f; }
    float S = 0.f; bool done = false; size_t kb; int nk;
    if (m < MP) { kb = (size_t)(m / SEQ) * SEQ; nk = m % SEQ; } else { const int ms = m - MP; kb = (size_t)MP + (size_t)(ms / DS) * DS; nk = ms % DS; }
    for (int s = nk - 1; s >= 0 && !done; --s) {
        const unsigned short* kr = Kb + (kb + s) * 512 + h * HD; const unsigned short* vr = Vb + (kb + s) * 512 + h * HD; float z = 0.f;
#pragma unroll
        for (int d = 0; d < HD; ++d) z = fmaf(qr[d], hb2f(kr[d]), z);
        const float sp = fmaxf(z, 0.f) + log1pf(expf(-fabsf(z))), a = expf(z - sp - S);
#pragma unroll
        for (int d = 0; d < HD; ++d) o[d] = fmaf(a, hb2f(vr[d]), o[d]);
        S += sp; if (S > 110.f) done = true;
    }
    if (m >= MP) { const int b = (m - MP) / DS; const float* kc = ck + (size_t)b * PAST * 512 + h * HD; const float* vc = cv + (size_t)b * PAST * 512 + h * HD;
        for (int s = PAST - 1; s >= 0 && !done; --s) {
            const float* kr = kc + (size_t)s * 512; const float* vr = vc + (size_t)s * 512; float z = 0.f;
#pragma unroll
            for (int d = 0; d < HD; ++d) z = fmaf(qr[d], kr[d], z);
            const float sp = fmaxf(z, 0.f) + log1pf(expf(-fabsf(z))), a = expf(z - sp - S);
#pragma unroll
            for (int d = 0; d < HD; ++d) o[d] = fmaf(a, vr[d], o[d]);
            S += sp; if (S > 110.f) done = true;
        } }
#pragma unroll
    for (int d = 0; d < HD; ++d) YSB[(size_t)m * 512 + h * HD + d] = (unsigned short)f2bf(o[d]);
}
__global__ void hyb_pool(const unsigned short* Ub, const float* state_pool, unsigned short* Yb) {
    const size_t i = (size_t)blockIdx.x * blockDim.x + threadIdx.x; if (i >= (size_t)MT * PW) return;
    const int m = (int)(i / PW), c = (int)(i % PW), g = c / 128, w = 2 << g;
    float s = 0.f; float cnt;
    if (m < MP) { const int t = m % SEQ; const int n = (t + 1 < w) ? t + 1 : w; for (int j = 0; j < n; ++j) s += hb2f(Ub[(size_t)(m - j) * PW + c]); cnt = (float)n; }
    else { const int ms = m - MP, b = ms / DS, t = ms % DS; for (int j = 0; j < w; ++j) { const int r = 15 + t - j; s += (r >= 15) ? hb2f(Ub[(size_t)(m - j) * PW + c]) : state_pool[((size_t)b * 15 + r) * PW + c]; } cnt = (float)w; }
    Yb[i] = (unsigned short)f2bf(s / cnt - hb2f(Ub[i]));
}
#endif

__global__ void __launch_bounds__(NWAVES * 64, 2) mega_fwd(Args args) {
    extern __shared__ __attribute__((aligned(16))) unsigned char lds[];
    LAS unsigned char* L = (LAS unsigned char*)lds;
    volatile LAS unsigned* MISC = (volatile LAS unsigned*)(L + MISC_OFF);
    const int wave = __builtin_amdgcn_readfirstlane(threadIdx.x >> 6);
#define FRESH_TID() int tid = threadIdx.x; asm volatile("" : "+v"(tid)); const int lane = tid & 63; (void)lane
    const int G = gridDim.x, bx = blockIdx.x, vcu = (G % 8 == 0) ? (bx % 8) * (G / 8) + bx / 8 : bx;
    unsigned char* ws = args.ws;
    gu32* ctl = (gu32*)(ws + WS_CTL);
    const float* x_p = args.in[0]; const float* x_s = args.in[1]; const float* cache_k = args.in[2]; const float* cache_v = args.in[3]; const float* state_pool = args.in[4];
    const float* p_p = args.in[5]; const float* p_s = args.in[6]; const float* g_mix = args.in[7]; const float* w_in = args.in[8]; const float* b_gate = args.in[9]; const float* w_grp = args.in[10];
    const float* pool_scale = args.in[11]; const float* w_pool_up = args.in[12]; const float* w_sb_up = args.in[13]; const float* w_out = args.in[14]; const float* g_mlp = args.in[15];
    const float* w_up = args.in[16]; const float* w_down = args.in[17]; const float* g_ple = args.in[18]; const float* w_ple_gate = args.in[19]; const float* w_ple_proj = args.in[20]; const float* g_final = args.in[21];
    float* out = args.out; float* Yo = out + O_Y;
    bf16 *WIN = (bf16*)(ws + WS_WIN), *WEFF = (bf16*)(ws + WS_WEFF), *WSB = (bf16*)(ws + WS_WSB), *WOUT = (bf16*)(ws + WS_WOUT), *WUP = (bf16*)(ws + WS_WUP), *WDOWN = (bf16*)(ws + WS_WDOWN), *WPG = (bf16*)(ws + WS_WPG), *WPP = (bf16*)(ws + WS_WPP);
    float *SSQ1 = (float*)(ws + WS_SSQ1), *SSQ2 = (float*)(ws + WS_SSQ2), *SSQ3 = (float*)(ws + WS_SSQ3);
    bf16 *PB = (bf16*)(ws + WS_PB), *XN = (bf16*)(ws + WS_XN), *Ub = (bf16*)(ws + WS_U), *Qb = (bf16*)(ws + WS_Q), *Kb = (bf16*)(ws + WS_K), *Vb = (bf16*)(ws + WS_V), *Gb = (bf16*)(ws + WS_G);
    bf16 *Yb = (bf16*)(ws + WS_Y), *YSB = (bf16*)(ws + WS_YSB), *MG = (bf16*)(ws + WS_MG), *Hb = (bf16*)(ws + WS_H), *PPb = (bf16*)(ws + WS_PP), *Xb = (bf16*)(ws + WS_X);

    for (int i = threadIdx.x; i < (LDS_BYTES - LDSCTL_OFF) / 4; i += NWAVES * 64) ((LAS unsigned*)(L + LDSCTL_OFF))[i] = 0u;
    __syncthreads();
    XcdBarrier bar; bar.bar = (unsigned*)(ctl + CW_BAR); bar.x = 0; bar.st = nullptr;
    if (MK_N_LAUNCHES == 1) bar = xcd_barrier_post((unsigned*)(ctl + CW_BAR), MISC + 8);
    const int lo = args.ph_lo, hi = args.ph_hi;
#define IN(k) (lo <= (k) && (k) < hi)
#ifdef DBG_BARCHK
#define SEAM(k) do { if (IN(k) && IN((k) + 1)) { if (threadIdx.x == 0) __hip_atomic_fetch_add((unsigned*)(ctl + 65536 + 64 * (k)), 1u, __ATOMIC_RELAXED, __HIP_MEMORY_SCOPE_AGENT); xcd_barrier(bar); \
    if (threadIdx.x == 0) { const unsigned v_ = __hip_atomic_load((unsigned*)(ctl + 65536 + 64 * (k)), __ATOMIC_RELAXED, __HIP_MEMORY_SCOPE_AGENT); if (v_ != (unsigned)G) { __hip_atomic_store((unsigned*)(ctl + 65536 + 64 * 32), 1u, __ATOMIC_RELAXED, __HIP_MEMORY_SCOPE_AGENT); out[O_KP + (k)] = __builtin_nanf(""); } } } } while (0)
#else
#define SEAM(k) do { if (IN(k) && IN((k) + 1)) xcd_barrier(bar); } while (0)
#endif
    const int gw = vcu * NWAVES + wave, NGW = G * NWAVES;
    const bool late_ = (vcu & 1) != 0;

#pragma unroll 1
    for (int rep_ = 0; rep_ < ((IN(0)) ? ((DBG_REPEAT == 0) ? 2 : 1) : 0); ++rep_) {
        if (rep_ > 0) xcd_barrier(bar);
        FRESH_TID();
        LAS float* scr = (LAS float*)(L + RING_OFF + wave * 16384);
        constexpr int I_IN = (DM / 64) * (INW / 32), I_SB = (SBW / 64) * (DM / 32), I_OUT = (DM / 64) * (DM / 32), I_UP = (DM / 64) * (DFF / 32), I_DOWN = (DFF / 64) * (DM / 32), I_PG = I_OUT, I_PP = (PLE / 64) * (DM / 32), I_EFF = 4 * 16 * 16;
        constexpr int NITEMS = I_IN + I_SB + I_OUT + I_UP + I_DOWN + I_PG + I_PP + I_EFF;
        for (int it = gw; it < NITEMS; it += NGW) {
            int r = it;
            if (r < I_EFF) { weff_item(w_grp, pool_scale, w_pool_up, WEFF, r, lane); continue; } r -= I_EFF;
            if (r < I_IN) { p0_transpose_item(w_in, DM, INW, WIN, 0, scr, r, lane); continue; } r -= I_IN;
            if (r < I_SB) { p0_transpose_item(w_sb_up, SBW, DM, WSB, 0, scr, r, lane); continue; } r -= I_SB;
            if (r < I_OUT) { p0_transpose_item(w_out, DM, DM, WOUT, 0, scr, r, lane); continue; } r -= I_OUT;
            if (r < I_UP) { p0_transpose_item(w_up, DM, DFF, WUP, 0, scr, r, lane); continue; } r -= I_UP;
            if (r < I_DOWN) { p0_transpose_item(w_down, DFF, DM, WDOWN, 0, scr, r, lane); continue; } r -= I_DOWN;
            if (r < I_PG) { p0_transpose_item(w_ple_gate, DM, DM, WPG, 0, scr, r, lane); continue; } r -= I_PG;
            p0_transpose_item(w_ple_proj, PLE, DM, WPP, 0, scr, r, lane);
        }
        for (int m = gw; m < MT; m += 2 * NGW) { const int m1 = m + NGW; const bool two = m1 < MT;
            const float* xr0 = m < MP ? x_p + (size_t)m * DM : x_s + (size_t)(m - MP) * DM;
            const float* xr1 = !two ? nullptr : (m1 < MP ? x_p + (size_t)m1 * DM : x_s + (size_t)(m1 - MP) * DM);
            const float* pr0 = m < MP ? p_p + (size_t)m * PLE : p_s + (size_t)(m - MP) * PLE;
            const float* pr1 = !two ? pr0 : (m1 < MP ? p_p + (size_t)m1 * PLE : p_s + (size_t)(m1 - MP) * PLE);
            const f32x4 pv0 = *((const GAS f32x4*)pr0 + lane), pv1 = *((const GAS f32x4*)pr1 + lane);
            rms_rows_to_bf16(xr0, xr1, g_mix, XN + (size_t)m * DM, XN + (size_t)(two ? m1 : m) * DM, lane);
            *((GAS unsigned long long*)(PB + (size_t)m * PLE) + lane) = (unsigned long long)pk2(pv0.x, pv0.y) | ((unsigned long long)pk2(pv0.z, pv0.w) << 32);
            if (two) *((GAS unsigned long long*)(PB + (size_t)m1 * PLE) + lane) = (unsigned long long)pk2(pv1.x, pv1.y) | ((unsigned long long)pk2(pv1.z, pv1.w) << 32);
        }
    }
    SEAM(0);
#pragma unroll 1
    for (int rep_ = 0; rep_ < ((IN(1)) ? ((DBG_REPEAT == 1) ? 2 : 1) : 0); ++rep_) {
        if (rep_ > 0) xcd_barrier(bar);
#pragma unroll 1
        for (int pass_ = 0; pass_ < 2; ++pass_) if ((pass_ == 1) == late_) {
        for (int task = vcu; task < 16 * (INW / 256); task += G) { const int rb = task & 15, col0 = (task >> 4) * 256; f32x4 vv[2][2];
            sk::tile4(XN, WIN, DM, (size_t)MP + rb * 32, col0, (SK_LAS char*)(L + RING_OFF), vv);
            const int t = threadIdx.x, rs = rb * 32 + (t >> 4), r = MP + rs;
#pragma unroll
            for (int h = 0; h < 2; ++h)
#pragma unroll
                for (int q = 0; q < 2; ++q) { const f32x4 v = vv[h][q]; const int c = col0 + 128 * h + 64 * q + (t & 15) * 4;
            if (c < 512) { *(GAS unsigned long long*)(Ub + (size_t)r * 512 + c) = sk::pk4(v); const int i = rs & 31; if (i >= 17) *(GAS f32x4*)(out + O_POOLS + ((size_t)(rs >> 5) * 15 + (i - 17)) * 512 + c) = v; }
            else if (c < 1024) *(GAS unsigned long long*)(Qb + (size_t)r * 512 + c - 512) = sk::pk4(v * QSCALE);
            else if (c < 1536) { *(GAS unsigned long long*)(Kb + (size_t)r * 512 + c - 1024) = sk::pk4(v); *(GAS f32x4*)(out + O_KS + (size_t)rs * 512 + c - 1024) = v; }
            else if (c < 2048) { *(GAS unsigned long long*)(Vb + (size_t)r * 512 + c - 1536) = sk::pk4(v); *(GAS f32x4*)(out + O_VS + (size_t)rs * 512 + c - 1536) = v; }
            else { const f32x4 bg = *(const GAS f32x4*)(b_gate + c - 2048); *(GAS unsigned*)((unsigned char*)Gb + (size_t)r * 2048 + c - 2048) = pg8::pk_u8x4(pg8::sigm4(v + bg)); } }
        }
        } else {
        pg8::Gemm g{XN, WIN, MP, INW, DM}; pg8::RotOrder S; S.init(MP, INW, G, bx, DBG_ROT);
        pg8::EpiIn E{Ub, Qb, Kb, Vb, Gb, b_gate, out + O_KP, out + O_VP, out + O_KS, out + O_VS, out + O_POOLP, out + O_POOLS};
        pg8::gemm_phase<pg8::EpiIn, pg8::RotOrder, DBG_ALIGN, DBG_SP2>(L + RING_OFF, g, S, E);
        }
#ifdef DBG_PREDELAY
        { const unsigned long long t0_ = __builtin_amdgcn_s_memrealtime(); while (__builtin_amdgcn_s_memrealtime() - t0_ < DBG_PREDELAY) __builtin_amdgcn_s_sleep(16); __syncthreads(); }
#endif
#ifdef DBG_PREFENCE
        __threadfence(); __syncthreads();
#endif
    }
    SEAM(1);
#ifdef DBG_GDUMP
#ifndef DBG_DUMPBUF
#define DBG_DUMPBUF WS_G
#define DBG_DUMPLD 2048
#endif
    for (int it = (vcu * NWAVES * 64 + (int)threadIdx.x); it < MT * 128; it += G * NWAVES * 64) {
        const int m = it >> 7, c = (it & 127) * 8; const v4u w = *(const GAS v4u*)((const bf16*)(ws + DBG_DUMPBUF) + (size_t)m * DBG_DUMPLD + ((DBG_GDUMP + c) % DBG_DUMPLD)); f32x4 a, b; pg8::unpack8(w, a, b);
        *(GAS f32x4*)(Yo + (size_t)m * 1024 + c) = a; *(GAS f32x4*)(Yo + (size_t)m * 1024 + c + 4) = b; }
#endif
#ifdef DBG_DELAY
    { const unsigned long long t0_ = __builtin_amdgcn_s_memrealtime(); while (__builtin_amdgcn_s_memrealtime() - t0_ < DBG_DELAY) __builtin_amdgcn_s_sleep(16); __syncthreads(); }
#endif
#ifndef DBG_SKIP_P2
#define DBG_SKIP_P2 0
#endif
    if (IN(2) && (DBG_SKIP_P2 & 8)) {
        for (int it = (vcu * NWAVES * 64 + (int)threadIdx.x); it < MT * 64; it += G * NWAVES * 64) {
            const int m = it >> 6, c = (it & 63) * 8; f32x4 a, b;
            for (int e = 0; e < 4; ++e) { a[e] = (float)(((m * 31 + (c + e) * 17) & 255) - 128) * (1.0f / 128.0f); b[e] = (float)(((m * 13 + (c + 4 + e) * 29) & 255) - 128) * (1.0f / 128.0f); }
            *(GAS v4u*)(Yb + (size_t)m * 512 + c) = pg8::pack8(a, b); *(GAS v4u*)(YSB + (size_t)m * 512 + c) = pg8::pack8(b, a);
            if (DBG_SKIP_P2 & 16) { *(GAS v4u*)(MG + (size_t)m * 1024 + c) = pg8::pack8(a, b); *(GAS v4u*)(MG + (size_t)m * 1024 + 512 + c) = pg8::pack8(b, a); }
        }
    }
#pragma unroll 1
    for (int rep_ = 0; rep_ < ((IN(2) && !(DBG_SKIP_P2 & 12)) ? ((DBG_REPEAT == 2) ? 2 : 1) : 0); ++rep_) {
        if (rep_ > 0) xcd_barrier(bar);
        FRESH_TID();
        const bool do_pool_ = (rep_ == 0) || DBG_P2PART == 0 || DBG_P2PART == 1, do_att_ = (rep_ == 0) || DBG_P2PART == 0 || DBG_P2PART == 2, do_sam_ = (rep_ == 0) || DBG_P2PART == 0 || DBG_P2PART == 3;
        if (do_pool_)
        for (int wi = wave * G + vcu; wi < 4 * (MT / 64); wi += NGW) { const int g = wi & 3, run = (wi >> 2) * 4 + (lane >> 4), c = g * 128 + (lane & 15) * 8;
            if (g == 0) pool_run<2, 16>(Ub, state_pool, Yb, run, c); else if (g == 1) pool_run<4, 16>(Ub, state_pool, Yb, run, c); else if (g == 2) pool_run<8, 16>(Ub, state_pool, Yb, run, c);
            else { pool_run<16, 8>(Ub, state_pool, Yb, 2 * run, c); asm volatile("" ::: "memory"); pool_run<16, 8>(Ub, state_pool, Yb, 2 * run + 1, c); } }
        const sba::Tensors T{Qb, Kb, Vb, YSB, cache_k, cache_v};
        if (do_att_) {
#pragma unroll 1
        for (int i2 = 2 * vcu; i2 < 512; i2 += ((i2 & 1) ? 2 * G - 1 : 1)) { const int i = i2 >> 1, bh = i >> 2, s = i & 3;
            sba::sb_unit<false>(bh >> 3, bh & 7, (i2 & 1) ? 7 - s : s, T, (SB_LAS char*)(L + RING_OFF)); }
        }
        if (do_sam_) {
        for (int i = G - 1 - vcu; i < 128; i += G) sba::sb_unit<true>(i >> 3, i & 7, 0, T, (SB_LAS char*)(L + RING_OFF));
        }
    }
    SEAM(2);
#pragma unroll 1
    for (int rep_ = 0; rep_ < ((IN(3) && !(DBG_SKIP_P2 & 16)) ? ((DBG_REPEAT == 3) ? 2 : 1) : 0); ++rep_) {
        if (rep_ > 0) xcd_barrier(bar);
#pragma unroll 1
        for (int pass_ = 0; pass_ < 2; ++pass_) if ((pass_ == 1) == late_) {
        for (int task = vcu; task < 16 * (DM / 64); task += G) { const int rb = task & 15, col0 = (task >> 4) * 64;
            const f32x4 va = sk::tile(Yb, WEFF, PW, (size_t)MP + rb * 32, col0, (SK_LAS char*)(L + RING_OFF));
            const f32x4 vb = sk::tile(YSB, WSB, SBW, (size_t)MP + rb * 32, col0, (SK_LAS char*)(L + RING_OFF));
            const int t = threadIdx.x, r = MP + rb * 32 + (t >> 4), c = col0 + (t & 15) * 4;
            const f32x4 ga = pg8::up_u8x4(*(const GAS unsigned*)((const unsigned char*)Gb + (size_t)r * 2048 + c)), gb = pg8::up_u8x4(*(const GAS unsigned*)((const unsigned char*)Gb + (size_t)r * 2048 + 1024 + c));
            *(GAS unsigned long long*)(MG + (size_t)r * 1024 + c) = sk::pk4(ga * va + gb * vb);
        }
        } else {
        { pg8::Gemm g{Yb, WEFF, MP, DM, PW, YSB, WSB}; pg8::PairOrder S; S.init(MP, DM, G, bx); pg8::EpiMerge E{Gb, MG};
          pg8::gemm_phase<pg8::EpiMerge, pg8::PairOrder, DBG_ALIGN, DBG_SP2>(L + RING_OFF, g, S, E); }
        }
    }
    SEAM(3);
#pragma unroll 1
    for (int rep_ = 0; rep_ < ((IN(4)) ? ((DBG_REPEAT == 4) ? 2 : 1) : 0); ++rep_) {
        if (rep_ > 0) xcd_barrier(bar);
#pragma unroll 1
        for (int pass_ = 0; pass_ < 2; ++pass_) if ((pass_ == 1) == late_) {
        for (int task = vcu; task < 16 * (DM / 64); task += G) { const int rb = task & 15, col0 = (task >> 4) * 64;
            const f32x4 v = sk::tile(MG, WOUT, DM, (size_t)MP + rb * 32, col0, (SK_LAS char*)(L + RING_OFF));
            const int t = threadIdx.x, rs = rb * 32 + (t >> 4), r = MP + rs, c = col0 + (t & 15) * 4;
            const f32x4 x1 = *(const GAS f32x4*)(x_s + (size_t)rs * DM + c) + v; *(GAS unsigned long long*)(Xb + (size_t)r * DM + c) = sk::pk4(x1);
            *(GAS unsigned long long*)(XN + (size_t)r * DM + c) = sk::pk4(x1 * *(const GAS f32x4*)(g_mlp + c));
            const float ss = sk::sum16(pg8::dot4(x1)); if ((t & 15) == 0) SSQ1[(size_t)r * 16 + (col0 >> 6)] = ss;
        }
        } else {
        pg8::Gemm g{MG, WOUT, MP, DM, DM}; pg8::StaticOrder S; S.init(MP, DM, G, bx); pg8::EpiResid<true> E{x_p, Xb, XN, g_mlp, SSQ1};
        pg8::gemm_phase<pg8::EpiResid<true>, pg8::StaticOrder, DBG_ALIGN, DBG_SP2>(L + RING_OFF, g, S, E);
        }
    }
    SEAM(4);
#pragma unroll 1
    for (int rep_ = 0; rep_ < ((IN(5)) ? ((DBG_REPEAT == 5) ? 2 : 1) : 0); ++rep_) {
        if (rep_ > 0) xcd_barrier(bar);
#pragma unroll 1
        for (int pass_ = 0; pass_ < 2; ++pass_) if ((pass_ == 1) == late_) {
        for (int task = vcu; task < 16 * (DFF / 256); task += G) { const int rb = task & 15, col0 = (task >> 4) * 256; f32x4 vv[2][2];
            sk::tile4(XN, WUP, DM, (size_t)MP + rb * 32, col0, (SK_LAS char*)(L + RING_OFF), vv);
            const int t = threadIdx.x, r = MP + rb * 32 + (t >> 4); const float rs_ = sk::rstd16(SSQ1, r, t);
#pragma unroll
            for (int h = 0; h < 2; ++h)
#pragma unroll
                for (int q = 0; q < 2; ++q) { const int c = col0 + 128 * h + 64 * q + (t & 15) * 4; const f32x4 a = __builtin_elementwise_max(vv[h][q] * rs_, (f32x4){0.f, 0.f, 0.f, 0.f});
                    *(GAS unsigned long long*)(Hb + (size_t)r * DFF + c) = sk::pk4(a * a); }
        }
        } else {
        pg8::Gemm g{XN, WUP, MP, DFF, DM}; pg8::StaticOrder S; S.init(MP, DFF, G, bx); pg8::EpiUp E{SSQ1, Hb};
        pg8::gemm_phase<pg8::EpiUp, pg8::StaticOrder, DBG_ALIGN, DBG_SP2>(L + RING_OFF, g, S, E);
        }
    }
    SEAM(5);
    if (IN(5) && DBG_REPEAT == 15) {
        { pg8::Gemm g{XN, WUP, MP, DFF, DM}; pg8::StaticOrder S; S.init(MP, DFF, G, bx); pg8::EpiNull E{SSQ3};
          pg8::gemm_phase<pg8::EpiNull, pg8::StaticOrder, DBG_ALIGN, DBG_SP2>(L + RING_OFF, g, S, E); }
        xcd_barrier(bar);
    }
    if (IN(5) && DBG_REPEAT == 25) {
        for (int task = vcu; task < 16 * (DFF / 256); task += G) { const int rb = task & 15, col0 = (task >> 4) * 256; f32x4 vv[2][2];
            sk::tile4(XN, WUP, DM, (size_t)MP + rb * 32, col0, (SK_LAS char*)(L + RING_OFF), vv); if (vv[0][0][0] + vv[1][1][0] + vv[0][1][0] + vv[1][0][0] == 1.2345e33f) SSQ3[0] = vv[0][0][1]; }
        xcd_barrier(bar);
    }
    if (IN(6) && DBG_REPEAT == 6) {
        { pg8::Gemm g{Hb, WDOWN, MP, DM, DFF}; pg8::StaticOrder S; S.init(MP, DM, G, bx); pg8::EpiNull E{SSQ3};
          pg8::gemm_phase<pg8::EpiNull, pg8::StaticOrder, DBG_ALIGN, DBG_SP2>(L + RING_OFF, g, S, E); }
        xcd_barrier(bar);
    }
    if (IN(6) && DBG_REPEAT == 16) {
        for (int task = vcu; task < 16 * (DM / 64); task += G) { const int rb = task & 15, col0 = (task >> 4) * 64;
            const f32x4 v = sk::tile(Hb, WDOWN, DFF, (size_t)MP + rb * 32, col0, (SK_LAS char*)(L + RING_OFF)); if (v[0] == 1.2345e33f) SSQ3[0] = v[1]; }
        xcd_barrier(bar);
    }
    if (IN(6)) {
#pragma unroll 1
        for (int pass_ = 0; pass_ < 2; ++pass_) if ((pass_ == 1) == late_) {
        for (int task = vcu; task < 16 * (DM / 64); task += G) { const int rb = task & 15, col0 = (task >> 4) * 64;
            const f32x4 v = sk::tile(Hb, WDOWN, DFF, (size_t)MP + rb * 32, col0, (SK_LAS char*)(L + RING_OFF));
            const int t = threadIdx.x, r = MP + rb * 32 + (t >> 4), c = col0 + (t & 15) * 4;
            const f32x4 x2 = sk::up4(*(const GAS unsigned long long*)(Xb + (size_t)r * DM + c)) + v; *(GAS unsigned long long*)(Xb + (size_t)r * DM + c) = sk::pk4(x2);
            *(GAS unsigned long long*)(XN + (size_t)r * DM + c) = sk::pk4(x2 * *(const GAS f32x4*)(g_ple + c));
            const float ss = sk::sum16(pg8::dot4(x2)); if ((t & 15) == 0) SSQ2[(size_t)r * 16 + (col0 >> 6)] = ss;
        }
        } else {
        { pg8::Gemm g{Hb, WDOWN, MP, DM, DFF}; pg8::StaticOrder S; S.init(MP, DM, G, bx); pg8::EpiResid<false> E{nullptr, Xb, XN, g_ple, SSQ2};
          pg8::gemm_phase<pg8::EpiResid<false>, pg8::StaticOrder, DBG_ALIGN, DBG_SP2>(L + RING_OFF, g, S, E); }
        }
    }
    SEAM(6);
    if (IN(7) && DBG_REPEAT == 7) {
        { pg8::Gemm g{PB, WPP, MP, DM, PLE}; pg8::StaticOrder S; S.init(MP, DM, G, bx); pg8::EpiNull E{SSQ3};
          pg8::gemm_phase<pg8::EpiNull, pg8::StaticOrder, DBG_ALIGN, DBG_SP2>(L + RING_OFF, g, S, E); }
        { pg8::Gemm g{XN, WPG, MP, DM, DM}; pg8::StaticOrder S; S.init(MP, DM, G, bx); pg8::EpiNull E{SSQ3};
          pg8::gemm_phase<pg8::EpiNull, pg8::StaticOrder, DBG_ALIGN, DBG_SP2>(L + RING_OFF, g, S, E); }
        xcd_barrier(bar);
    }
    if (IN(7) && DBG_REPEAT == 17) {
        for (int task = vcu; task < 16 * (DM / 64); task += G) { const int rb = task & 15, col0 = (task >> 4) * 64;
            const f32x4 vp = sk::tile(PB, WPP, PLE, (size_t)MP + rb * 32, col0, (SK_LAS char*)(L + RING_OFF));
            const f32x4 vg = sk::tile(XN, WPG, DM, (size_t)MP + rb * 32, col0, (SK_LAS char*)(L + RING_OFF)); if (vp[0] + vg[0] == 1.2345e33f) SSQ3[0] = vp[1]; }
        xcd_barrier(bar);
    }
    if (IN(7) && DBG_REPEAT == 27) {
        { pg8::Gemm g{PB, WPP, MP, DM, PLE}; pg8::StaticOrder S; S.init(MP, DM, G, bx); pg8::EpiPP E{PPb};
          pg8::gemm_phase<pg8::EpiPP, pg8::StaticOrder, DBG_ALIGN, DBG_SP2>(L + RING_OFF, g, S, E); }
        xcd_barrier(bar);
    }
    if (IN(7)) {
#pragma unroll 1
        for (int pass_ = 0; pass_ < 2; ++pass_) if ((pass_ == 1) == late_) {
        for (int task = vcu; task < 16 * (DM / 64); task += G) { const int rb = task & 15, col0 = (task >> 4) * 64;
            const f32x4 vp = sk::tile(PB, WPP, PLE, (size_t)MP + rb * 32, col0, (SK_LAS char*)(L + RING_OFF));
            const f32x4 vg = sk::tile(XN, WPG, DM, (size_t)MP + rb * 32, col0, (SK_LAS char*)(L + RING_OFF));
            const int t = threadIdx.x, r = MP + rb * 32 + (t >> 4), c = col0 + (t & 15) * 4;
            const float rs_ = sk::rstd16(SSQ2, r, t);
            const f32x4 x3 = sk::up4(*(const GAS unsigned long long*)(Xb + (size_t)r * DM + c)) + pg8::sigm4(vg * rs_) * vp;
            const float ss = sk::sum16(pg8::dot4(x3)); if ((t & 15) == 0) __hip_atomic_store(SSQ3 + (size_t)r * 16 + (col0 >> 6), ss, __ATOMIC_RELAXED, __HIP_MEMORY_SCOPE_AGENT);
            asm volatile("s_waitcnt vmcnt(0)" ::: "memory");
            unsigned* cw = (unsigned*)(ctl + CW_FINS + 64 * rb);
            if ((t & 63) == 0) __hip_atomic_fetch_add(cw, 1u, __ATOMIC_RELAXED, __HIP_MEMORY_SCOPE_AGENT);
            { unsigned spins = 0; while ((unsigned)__builtin_amdgcn_readfirstlane(__hip_atomic_load(cw, __ATOMIC_RELAXED, __HIP_MEMORY_SCOPE_AGENT)) < 128u) { __builtin_amdgcn_s_sleep(2); if (++spins > (1u << 16)) break; } }
            const float r3 = __builtin_amdgcn_rsqf(sk::sum16(__hip_atomic_load(SSQ3 + (size_t)r * 16 + (t & 15), __ATOMIC_RELAXED, __HIP_MEMORY_SCOPE_AGENT)) * (1.0f / 1024.0f) + EPS);
            *(GAS f32x4*)(Yo + (size_t)r * DM + c) = x3 * r3 * *(const GAS f32x4*)(g_final + c);
        }
        } else {
        { pg8::Gemm g{PB, WPP, MP, DM, PLE}; pg8::StaticOrder S; S.init(MP, DM, G, bx); pg8::EpiPP E{PPb};
          pg8::gemm_phase<pg8::EpiPP, pg8::StaticOrder, DBG_ALIGN, DBG_SP2>(L + RING_OFF, g, S, E); }
        { pg8::Gemm g{XN, WPG, MP, DM, DM}; pg8::StaticOrder S; S.init(MP, DM, G, bx); pg8::EpiPleFinal E{SSQ2, PPb, Xb, Yo, SSQ3, g_final, (unsigned*)(ctl + CW_FIN)};
          pg8::gemm_phase<pg8::EpiPleFinal, pg8::StaticOrder, DBG_ALIGN, DBG_SP2>(L + RING_OFF, g, S, E); }
        }
    }
#undef IN
#undef SEAM
}

extern "C" void kernel_launch(void* const* d_in, const int* in_sizes, int n_in, void* d_out, int out_size, void* d_ws, size_t ws_size, hipStream_t stream) {
    static int grid = 0;
    if (grid == 0) {
        if (n_in != 22 || out_size != (int)O_END || ws_size < WS_END) { fprintf(stderr, "kernel_launch: unexpected sizes: n_in %d out %d ws %zu\n", n_in, out_size, ws_size); grid = -1; return; }
        int dev = 0, cus = 0, per_cu = 0;
        if (hipGetDevice(&dev) != hipSuccess || hipDeviceGetAttribute(&cus, hipDeviceAttributeMultiprocessorCount, dev) != hipSuccess) { grid = -1; return; }
        if (hipFuncSetAttribute((const void*)mega_fwd, hipFuncAttributeMaxDynamicSharedMemorySize, LDS_BYTES) != hipSuccess) { fprintf(stderr, "kernel_launch: hipFuncSetAttribute failed\n"); grid = -1; return; }
        if (hipOccupancyMaxActiveBlocksPerMultiprocessor(&per_cu, (const void*)mega_fwd, NWAVES * 64, LDS_BYTES) != hipSuccess || per_cu < 1) { fprintf(stderr, "kernel_launch: occupancy query says %d\n", per_cu); (void)hipGetLastError(); per_cu = 1; }
        grid = cus;
    }
    if (grid < 0) return;
    (void)hipMemsetAsync((char*)d_ws + WS_CTL, 0, CTL_ZERO_BYTES, stream);
    Args a{};
    for (int i = 0; i < 22; ++i) a.in[i] = (const float*)d_in[i];
    a.out = (float*)d_out; a.ws = (unsigned char*)d_ws;
#ifndef DBG_PH_HI
#define DBG_PH_HI N_PHASES
#endif
    if (MK_N_LAUNCHES == 1) { a.ph_lo = 0; a.ph_hi = DBG_PH_HI; a.li = 0; hipLaunchKernelGGL(mega_fwd, dim3(grid), dim3(NWAVES * 64), LDS_BYTES, stream, a); }
    else for (int li = 0; li < N_PHASES; ++li) { a.ph_lo = li; a.ph_hi = li + 1; a.li = li; hipLaunchKernelGGL(mega_fwd, dim3(grid), dim3(NWAVES * 64), LDS_BYTES, stream, a);
#if defined(HYB_ATTN)
        if (li == 2) hyb_attn<<<(MT * NH + 63) / 64, 64, 0, stream>>>((const unsigned short*)((char*)d_ws + WS_Q), (const unsigned short*)((char*)d_ws + WS_K), (const unsigned short*)((char*)d_ws + WS_V), (const float*)d_in[2], (const float*)d_in[3], (unsigned short*)((char*)d_ws + WS_YSB));
#endif
#if defined(HYB_POOL)
        if (li == 2) hyb_pool<<<(int)(((size_t)MT * PW + 255) / 256), 256, 0, stream>>>((const unsigned short*)((char*)d_ws + WS_U), (const float*)d_in[4], (unsigned short*)((char*)d_ws + WS_Y));
#endif
    }
}
```

```cpp
#include <hip/hip_runtime.h>
#include <hip/hip_bf16.h>
#include <cstdio>
#include <cstdint>
#include <cmath>
namespace cfg {
constexpr int DM = 1024, NB = 8, SEQ = 2048, DB = 16, DS = 32, PAST = 1024, PW = 512, SBW = 512, HD = 64, NH = 8, DFF = 4096, PLE = 256, INW = 4096;
constexpr int MP = NB * SEQ, MS = DB * DS, MT = MP + MS;
constexpr float EPS = 1e-6f;
constexpr float QSCALE = 0.125f * 1.4426950408889634f;
}
namespace pg8 {
#define PG8_LAS __attribute__((address_space(3)))
typedef unsigned short bf16_t;
typedef short bf16x8 __attribute__((ext_vector_type(8)));
typedef float f32x4 __attribute__((ext_vector_type(4)));
typedef unsigned u32x4 __attribute__((ext_vector_type(4)));
constexpr int BM = 256, BK = 64, HALF = 128, HTB = HALF * BK * 2  , STAGE_BYTES = 8 * HTB, NXCD = 8, WGM = 8;

__host__ __device__ __forceinline__ int lds_byte(int r, int c) { const int st = (r >> 4) * 2 + (c >> 5), rr = r & 15, cc = c & 31, ob = rr * 64 + cc * 2; return st * 1024 + (ob ^ (((ob >> 9) & 1) << 5)); }
__host__ __device__ __forceinline__ void stage_rc(int b, int& R, int& C) { const int st = b / 1024, sb = b % 1024, swz = sb ^ (((sb >> 9) & 1) << 5); R = (st >> 1) * 16 + swz / 64; C = (st & 1) * 32 + (swz % 64) / 2; }
__host__ __device__ __forceinline__ int perm32(int rho) { const int n = rho >> 4, i = rho & 15; return 8 * (i >> 2) + 4 * n + (i & 3); }

struct Unit { int pm, pn, seg; };
struct Gemm { const bf16_t* A; const bf16_t* Bt; int M, N, K; const bf16_t* A1 = nullptr; const bf16_t* Bt1 = nullptr; };

struct StaticOrder {
    int nM, nN, nwg, G, c;
    __host__ __device__ void init(int M, int N, int G_, int c_) { nM = M / BM; nN = N / BM; nwg = nM * nN; G = G_; c = c_; }
    __host__ __device__ bool next(int i, Unit& u) const {
        const long L = (long)i * G + c; if (L >= nwg) return false;
        int wgid = (int)L; { const int q = nwg / NXCD, r = nwg % NXCD, xcd = wgid % NXCD, off = wgid / NXCD; wgid = (xcd < r ? xcd * (q + 1) : r * (q + 1) + (xcd - r) * q) + off; }
        const int nig = WGM * nN, gid = wgid / nig, fm = gid * WGM, gsz = (nM - fm) < WGM ? (nM - fm) : WGM;
        u.pm = fm + ((wgid % nig) % gsz); u.pn = (wgid % nig) / gsz; u.seg = 0; return true;
    }
    __device__ __forceinline__ void a_ready(const Unit&) const {}
    __device__ __forceinline__ void done(const Unit&) const {}
};
struct RotOrder : StaticOrder {
    int rot, cnt;
    __host__ __device__ void init(int M, int N, int G_, int c_, int rot_) { StaticOrder::init(M, N, G_, c_); cnt = (nwg % G_ == 0) ? nwg / G_ : 0; rot = rot_; }
    __host__ __device__ bool next(int i, Unit& u) const { if (cnt == 0) return StaticOrder::next(i, u); if (i >= cnt) return false; return StaticOrder::next((i + rot) % cnt, u); }
};
struct PairOrder : StaticOrder {
    __host__ __device__ bool next(int i, Unit& u) const { if (!StaticOrder::next(i >> 1, u)) return false; u.seg = i & 1; return true; }
};
typedef float f32x2v_t __attribute__((ext_vector_type(2))); typedef __bf16 bf16x2v_t __attribute__((ext_vector_type(2)));
__device__ __forceinline__ unsigned cvt_pk_bf16(float lo, float hi) { f32x2v_t v = {lo, hi}; bf16x2v_t b = __builtin_convertvector(v, bf16x2v_t); return __builtin_bit_cast(unsigned, b); }
typedef float f32x2 __attribute__((ext_vector_type(2)));
__device__ __forceinline__ float bf_lo(unsigned w) { return __uint_as_float(w << 16); }
__device__ __forceinline__ float bf_hi(unsigned w) { return __uint_as_float(w & 0xffff0000u); }
__device__ __forceinline__ u32x4 pack8(f32x4 a, f32x4 b) { u32x4 w; w.x = cvt_pk_bf16(a[0], a[1]); w.y = cvt_pk_bf16(a[2], a[3]); w.z = cvt_pk_bf16(b[0], b[1]); w.w = cvt_pk_bf16(b[2], b[3]); return w; }
__device__ __forceinline__ void unpack8(u32x4 w, f32x4& a, f32x4& b) { a = (f32x4){bf_lo(w.x), bf_hi(w.x), bf_lo(w.y), bf_hi(w.y)}; b = (f32x4){bf_lo(w.z), bf_hi(w.z), bf_lo(w.w), bf_hi(w.w)}; }
__device__ __forceinline__ float sigm(float x) { return __builtin_amdgcn_rcpf(1.f + __builtin_amdgcn_exp2f(-1.4426950408889634f * x)); }
__device__ __forceinline__ f32x4 sigm4(f32x4 x) { return (f32x4){sigm(x[0]), sigm(x[1]), sigm(x[2]), sigm(x[3])}; }
__device__ __forceinline__ float dot4(f32x4 a) { return (a[0] * a[0] + a[1] * a[1]) + (a[2] * a[2] + a[3] * a[3]); }
#ifndef DBG_LDAUX
#define DBG_LDAUX 16
#endif
__device__ __forceinline__ u32x4 ld16_sc1(const void* base, size_t byte_off) {
    const __amdgpu_buffer_rsrc_t rs = __builtin_amdgcn_make_buffer_rsrc((void*)base, (short)0, 0x7fffffff, 0x00020000);
    return __builtin_bit_cast(u32x4, __builtin_amdgcn_raw_buffer_load_b128(rs, (unsigned)byte_off, 0, DBG_LDAUX));
}
__device__ __forceinline__ unsigned pk_u8x4(f32x4 g) { unsigned w = 0u; w = __builtin_amdgcn_cvt_pk_u8_f32(g[0] * 255.0f, 0, w); w = __builtin_amdgcn_cvt_pk_u8_f32(g[1] * 255.0f, 1, w); w = __builtin_amdgcn_cvt_pk_u8_f32(g[2] * 255.0f, 2, w); w = __builtin_amdgcn_cvt_pk_u8_f32(g[3] * 255.0f, 3, w); return w; }
__device__ __forceinline__ f32x4 up_u8x4(unsigned w) { return (f32x4){(float)(w & 0xffu), (float)((w >> 8) & 0xffu), (float)((w >> 16) & 0xffu), (float)(w >> 24)} * (1.0f / 255.0f); }
typedef unsigned u32x2 __attribute__((ext_vector_type(2)));
__device__ __forceinline__ float row_rstd(const float* SSQ, int r, int fq) {
    const f32x4 p = *(const f32x4*)(SSQ + (size_t)r * 16 + 4 * fq); float s = (p[0] + p[1]) + (p[2] + p[3]);
    s += __shfl_xor(s, 16); s += __shfl_xor(s, 32);
    return __builtin_amdgcn_rsqf(s * (1.0f / 1024.0f) + cfg::EPS);
}
#define PG8_ROWS(...) _Pragma("unroll") for (int ai = 0; ai < 2; ++ai) _Pragma("unroll") for (int m = 0; m < 4; ++m) { const int r = u.pm * BM + ai * HALF + wr * 64 + m * 16 + fr; __VA_ARGS__; if (m == 3) asm volatile("" ::: "memory"); }
#define PG8_COLS(...) _Pragma("unroll") for (int bj = 0; bj < 2; ++bj) { const int c = ct + bj * HALF + wc * 32 + 8 * fq; const f32x4 v0 = acc[ai][bj][m][0], v1 = acc[ai][bj][m][1]; __VA_ARGS__; }

struct EpiIn {
    static constexpr bool PERM = true, AFTER_DRAIN = false;
    bf16_t *U, *Q, *K, *V, *G; const float* b_gate; float *k_p, *v_p, *k_s, *v_s, *pool_p, *pool_s;
    __device__ __forceinline__ void operator()(const f32x4 (&acc)[2][2][4][2], const Unit& u, int wr, int wc, int fr, int fq) const {
        const int pn = u.pn;
        if (pn >= 8) {
            const int ct = (pn - 8) * BM; f32x4 bv[2][2];
#pragma unroll
            for (int bj = 0; bj < 2; ++bj) { const int c = ct + bj * HALF + wc * 32 + 8 * fq; bv[bj][0] = *(const f32x4*)(b_gate + c); bv[bj][1] = *(const f32x4*)(b_gate + c + 4); }
            PG8_ROWS(PG8_COLS(*(u32x2*)((unsigned char*)G + (size_t)r * 2048 + c) = (u32x2){pk_u8x4(sigm4(v0 + bv[bj][0])), pk_u8x4(sigm4(v1 + bv[bj][1]))}))
        } else if (pn >= 4) {
            const bool isv = pn >= 6; const int ct = (pn - (isv ? 6 : 4)) * BM; bf16_t* B = isv ? V : K; float* op = isv ? v_p : k_p; float* os = isv ? v_s : k_s;
            PG8_ROWS(float* orow = r < cfg::MP ? op + (size_t)r * 512 : os + (size_t)(r - cfg::MP) * 512;
                     PG8_COLS(*(u32x4*)(B + (size_t)r * 512 + c) = pack8(v0, v1); __builtin_nontemporal_store(v0, (f32x4*)(orow + c)); __builtin_nontemporal_store(v1, (f32x4*)(orow + c + 4))))
        } else if (pn >= 2) {
            const int ct = (pn - 2) * BM;
            PG8_ROWS(PG8_COLS(*(u32x4*)(Q + (size_t)r * 512 + c) = pack8(v0 * cfg::QSCALE, v1 * cfg::QSCALE)))
        } else {
            const int ct = pn * BM;
            PG8_ROWS(float* prow = nullptr;
                     if (r < cfg::MP) { const int t = r & (cfg::SEQ - 1); if (t >= cfg::SEQ - 15) prow = pool_p + ((size_t)(r >> 11) * 15 + (t - (cfg::SEQ - 15))) * 512; }
                     else { const int i = (r - cfg::MP) & 31; if (i >= 17) prow = pool_s + ((size_t)((r - cfg::MP) >> 5) * 15 + (i - 17)) * 512; }
                     PG8_COLS(*(u32x4*)(U + (size_t)r * 512 + c) = pack8(v0, v1); if (prow) { *(f32x4*)(prow + c) = v0; *(f32x4*)(prow + c + 4) = v1; }))
        }
    }
};
#if defined(DBG_ONLYG)
#define DBG_NOG_STMT *(u32x4*)(MG + (size_t)r * 1024 + c) = gw; continue;
#elif defined(DBG_NOG)
#define DBG_NOG_STMT g0 = (f32x4){0.5f, 0.5f, 0.5f, 0.5f}; g1 = g0;
#else
#define DBG_NOG_STMT
#endif
struct EpiMerge;
struct EpiMerge0 {
    static constexpr bool PERM = true, AFTER_DRAIN = false;
    const bf16_t* G; bf16_t* MG;
    __device__ __forceinline__ void operator()(const f32x4 (&acc)[2][2][4][2], const Unit& u, int wr, int wc, int fr, int fq) const {
        const int ct = u.pn * BM;
        PG8_ROWS(PG8_COLS(const u32x2 gw = *(const u32x2*)((const unsigned char*)G + (size_t)r * 2048 + c); const f32x4 g0 = up_u8x4(gw.x); const f32x4 g1 = up_u8x4(gw.y); *(u32x4*)(MG + (size_t)r * 1024 + c) = pack8(v0 * g0, v1 * g1)))
    }
};
#ifdef DBG_NORAW
#define DBG_NORAW_STMT m0 = (f32x4){0.f, 0.f, 0.f, 0.f}; m1 = m0;
#else
#define DBG_NORAW_STMT
#endif
struct EpiMerge1 {
    static constexpr bool PERM = true, AFTER_DRAIN = false;
    const bf16_t* G; bf16_t* MG;
    __device__ __forceinline__ void operator()(const f32x4 (&acc)[2][2][4][2], const Unit& u, int wr, int wc, int fr, int fq) const {
        const int ct = u.pn * BM;
        PG8_ROWS(PG8_COLS(const u32x2 gw = *(const u32x2*)((const unsigned char*)G + (size_t)r * 2048 + 1024 + c); const u32x4 mw = *(const u32x4*)(MG + (size_t)r * 1024 + c);
                          const f32x4 g0 = up_u8x4(gw.x); const f32x4 g1 = up_u8x4(gw.y); f32x4 m0; f32x4 m1; unpack8(mw, m0, m1); *(u32x4*)(MG + (size_t)r * 1024 + c) = pack8(m0 + v0 * g0, m1 + v1 * g1)))
    }
};
struct EpiMerge {
    static constexpr bool PERM = true, AFTER_DRAIN = false;
    const bf16_t* G; bf16_t* MG;
    __device__ __forceinline__ void operator()(const f32x4 (&acc)[2][2][4][2], const Unit& u, int wr, int wc, int fr, int fq) const {
        if (u.seg == 0) { const EpiMerge0 E0{G, MG}; E0(acc, u, wr, wc, fr, fq); } else { const EpiMerge1 E1{G, MG}; E1(acc, u, wr, wc, fr, fq); }
    }
};
template <bool F32RES>
struct EpiResid {
    static constexpr bool PERM = true, AFTER_DRAIN = false;
    const float* res_p; bf16_t* X; bf16_t* XG; const float* gvec; float* SSQ;
    __device__ __forceinline__ void operator()(const f32x4 (&acc)[2][2][4][2], const Unit& u, int wr, int wc, int fr, int fq) const {
        const int ct = u.pn * BM; f32x4 gv[2][2];
#pragma unroll
        for (int bj = 0; bj < 2; ++bj) { const int c = ct + bj * HALF + wc * 32 + 8 * fq; gv[bj][0] = *(const f32x4*)(gvec + c); gv[bj][1] = *(const f32x4*)(gvec + c + 4); }
        PG8_ROWS(float s = 0.f;
                 PG8_COLS(f32x4 a; f32x4 b;
                          if (F32RES) { a = *(const f32x4*)(res_p + (size_t)r * 1024 + c); b = *(const f32x4*)(res_p + (size_t)r * 1024 + c + 4); }
                          else { const u32x4 xw = *(const u32x4*)(X + (size_t)r * 1024 + c); unpack8(xw, a, b); }
                          a += v0; b += v1; *(u32x4*)(X + (size_t)r * 1024 + c) = pack8(a, b); s += dot4(a) + dot4(b);
                          *(u32x4*)(XG + (size_t)r * 1024 + c) = pack8(a * gv[bj][0], b * gv[bj][1]))
                 s += __shfl_xor(s, 16); s += __shfl_xor(s, 32); if (fq == 0) SSQ[(size_t)r * 16 + u.pn * 4 + wc] = s)
    }
};
struct EpiUp {
    static constexpr bool PERM = true, AFTER_DRAIN = false;
    const float* SSQ; bf16_t* H;
    __device__ __forceinline__ void operator()(const f32x4 (&acc)[2][2][4][2], const Unit& u, int wr, int wc, int fr, int fq) const {
        const int ct = u.pn * BM; float rsv[2][4];
#pragma unroll
        for (int ai = 0; ai < 2; ++ai)
#pragma unroll
            for (int m = 0; m < 4; ++m) rsv[ai][m] = row_rstd(SSQ, u.pm * BM + ai * HALF + wr * 64 + m * 16 + fr, fq);
        PG8_ROWS(const float rs = rsv[ai][m];
                 PG8_COLS(f32x4 a = v0 * rs; f32x4 b = v1 * rs; a = __builtin_elementwise_max(a, (f32x4){0.f, 0.f, 0.f, 0.f}); b = __builtin_elementwise_max(b, (f32x4){0.f, 0.f, 0.f, 0.f});
                          *(u32x4*)(H + (size_t)r * 4096 + c) = pack8(a * a, b * b)))
    }
};
struct EpiNull {
    static constexpr bool PERM = true, AFTER_DRAIN = false;
    float* sink;
    __device__ __forceinline__ void operator()(const f32x4 (&acc)[2][2][4][2], const Unit& u, int wr, int wc, int fr, int fq) const {
        float s = 0.f;
#pragma unroll
        for (int ai = 0; ai < 2; ++ai)
#pragma unroll
            for (int bj = 0; bj < 2; ++bj)
#pragma unroll
                for (int m = 0; m < 4; ++m)
#pragma unroll
                    for (int n = 0; n < 2; ++n) s += acc[ai][bj][m][n][0] + acc[ai][bj][m][n][3];
        if (s == 1.2345e33f) sink[0] = s;
    }
};
struct EpiPP {
    static constexpr bool PERM = true, AFTER_DRAIN = false;
    bf16_t* PP;
    __device__ __forceinline__ void operator()(const f32x4 (&acc)[2][2][4][2], const Unit& u, int wr, int wc, int fr, int fq) const {
        const int ct = u.pn * BM;
        PG8_ROWS(PG8_COLS(*(u32x4*)(PP + (size_t)r * 1024 + c) = pack8(v0, v1)))
    }
};
struct EpiPleFinal {
    static constexpr bool PERM = true, AFTER_DRAIN = false;
    const float* SSQ; const bf16_t* PP; const bf16_t* X; float* Y; float* SSQo; const float* gfin; unsigned* cnt;
    __device__ __forceinline__ void operator()(f32x4 (&acc)[2][2][4][2], const Unit& u, int wr, int wc, int fr, int fq) const {
        const int ct = u.pn * BM; float rsv[2][4];
#pragma unroll
        for (int ai = 0; ai < 2; ++ai)
#pragma unroll
            for (int m = 0; m < 4; ++m) rsv[ai][m] = row_rstd(SSQ, u.pm * BM + ai * HALF + wr * 64 + m * 16 + fr, fq);
        PG8_ROWS(const float rs = rsv[ai][m]; float s = 0.f;
                 PG8_COLS(const u32x4 pw = *(const u32x4*)(PP + (size_t)r * 1024 + c); f32x4 p0; f32x4 p1; unpack8(pw, p0, p1);
                          const u32x4 xw = *(const u32x4*)(X + (size_t)r * 1024 + c); f32x4 a; f32x4 b; unpack8(xw, a, b); a += sigm4(v0 * rs) * p0; b += sigm4(v1 * rs) * p1;
                          acc[ai][bj][m][0] = a; acc[ai][bj][m][1] = b; s += dot4(a) + dot4(b))
                 s += __shfl_xor(s, 16); s += __shfl_xor(s, 32);
                 if (fq == 0) __hip_atomic_store(SSQo + (size_t)r * 16 + u.pn * 4 + wc, s, __ATOMIC_RELAXED, __HIP_MEMORY_SCOPE_AGENT))
        asm volatile("s_waitcnt vmcnt(0)" ::: "memory");
        unsigned* cw = cnt + 64 * (2 * u.pm + wr);
        if (fr == 0 && fq == 0) __hip_atomic_fetch_add(cw, 1u, __ATOMIC_RELAXED, __HIP_MEMORY_SCOPE_AGENT);
        { unsigned spins = 0;
          while ((unsigned)__builtin_amdgcn_readfirstlane(__hip_atomic_load(cw, __ATOMIC_RELAXED, __HIP_MEMORY_SCOPE_AGENT)) < 16u) { __builtin_amdgcn_s_sleep(2); if (++spins > (1u << 16)) break; } }
        f32x4 gv[2][2];
#pragma unroll
        for (int bj = 0; bj < 2; ++bj) { const int c = ct + bj * HALF + wc * 32 + 8 * fq; gv[bj][0] = *(const f32x4*)(gfin + c); gv[bj][1] = *(const f32x4*)(gfin + c + 4); }
        PG8_ROWS(const f32x4 pq = __builtin_bit_cast(f32x4, ld16_sc1(SSQo, ((size_t)r * 16 + 4 * fq) * 4)); float t = (pq[0] + pq[1]) + (pq[2] + pq[3]); t += __shfl_xor(t, 16); t += __shfl_xor(t, 32);
                 const float r3 = __builtin_amdgcn_rsqf(t * (1.0f / 1024.0f) + cfg::EPS);
                 PG8_COLS(__builtin_nontemporal_store(v0 * r3 * gv[bj][0], (f32x4*)(Y + (size_t)r * 1024 + c)); __builtin_nontemporal_store(v1 * r3 * gv[bj][1], (f32x4*)(Y + (size_t)r * 1024 + c + 4))))
    }
};
struct NoHook { __device__ __forceinline__ void operator()(int) const {} };
template <class Epi, class Sched, bool ALIGN_EPI = false, bool SP2 = false, class Hook = NoHook>
__device__ __forceinline__ void gemm_phase(PG8_LAS unsigned char* lds, const Gemm g, const Sched& S, const Epi& E, const Hook& H = Hook()) {
    int tid = threadIdx.x; asm volatile("" : "+v"(tid));
    const int wid = __builtin_amdgcn_readfirstlane(tid >> 6), lane = tid & 63, wr = wid >> 2, wc = wid & 3, fr = lane & 15, fq = lane >> 4;
    int K = g.K; asm volatile("" : "+s"(K)); const int nt = K / BK;
    unsigned voffA[2], voffB[2];
#pragma unroll
    for (int i = 0; i < 2; ++i) { int R, C; stage_rc(tid * 16 + i * 8192, R, C); const int Rb = Epi::PERM ? ((R & ~31) + perm32(R & 31)) : R;
        voffA[i] = (unsigned)(R * K + C) * 2u; voffB[i] = (unsigned)(Rb * K + C) * 2u; }
    const size_t kstep = (size_t)(BK * 2);
    const size_t hstep = (size_t)HALF * K * 2;
    const size_t tstep = 2 * hstep;
    const size_t bhs = hstep;
    const unsigned ldsw = (unsigned)wid * 1024u;
    const int aoff = lds_byte(wr * 64 + fr, fq * 8), boff = lds_byte(wc * 32 + fr, fq * 8);
#define PG8_SA(b, h) (((b) * 2 + (h)) * HTB)
#define PG8_SB(b, h) ((4 + (b) * 2 + (h)) * HTB)
#define PG8_STAGE(bufoff, gbase, voff) do { _Pragma("unroll") for (int _i = 0; _i < 2; ++_i) \
        __builtin_amdgcn_global_load_lds((const unsigned*)((const char*)(gbase) + (voff)[_i]), (PG8_LAS unsigned*)(lds + (bufoff) + ldsw + _i * 8192), 16, 0, 0); } while (0)
#define PG8_LDA(dst, b, h) do { _Pragma("unroll") for (int m = 0; m < 4; ++m) _Pragma("unroll") for (int k = 0; k < 2; ++k) dst[m][k] = *(const PG8_LAS bf16x8*)(lds + PG8_SA(b, h) + aoff + m * 2048 + k * 1024); } while (0)
#define PG8_LDB(dst, b, h) do { _Pragma("unroll") for (int n = 0; n < 2; ++n) _Pragma("unroll") for (int k = 0; k < 2; ++k) dst[n][k] = *(const PG8_LAS bf16x8*)(lds + PG8_SB(b, h) + boff + n * 2048 + k * 1024); } while (0)
#define PG8_MMA(ai, bj, At, Bt) do { __builtin_amdgcn_s_setprio(1); _Pragma("unroll") for (int m = 0; m < 4; ++m) _Pragma("unroll") for (int n = 0; n < 2; ++n) _Pragma("unroll") for (int k = 0; k < 2; ++k) \
        acc[ai][bj][m][n] = __builtin_amdgcn_mfma_f32_16x16x32_bf16(Bt[n][k], At[m][k], acc[ai][bj][m][n], 0, 0, 0); __builtin_amdgcn_s_setprio(0); } while (0)
#ifdef DRAIN_ALL
#define PG8_WAIT_V(n) asm volatile("s_waitcnt vmcnt(0)" ::: "memory")
#else
#define PG8_WAIT_V(n) asm volatile("s_waitcnt vmcnt(" #n ")" ::: "memory")
#endif
#define PG8_WAIT_L(n) asm volatile("s_waitcnt lgkmcnt(" #n ")" ::: "memory")
#define PG8_BAR __builtin_amdgcn_s_barrier()
#define PG8_SCHED __builtin_amdgcn_sched_barrier(0)
    Unit cur, nxt; int ui = 0;
    if (!S.next(0, cur)) return;
    f32x4 acc[2][2][4][2];
#pragma unroll
    for (int a = 0; a < 2; ++a)
#pragma unroll
        for (int b = 0; b < 2; ++b)
#pragma unroll
            for (int m = 0; m < 4; ++m)
#pragma unroll
                for (int n = 0; n < 2; ++n) acc[a][b][m][n] = (f32x4){0.f, 0.f, 0.f, 0.f};
    bf16x8 At[4][2], B0[2][2], B1[2][2];
    const char* cA = (const char*)(cur.seg ? g.A1 : g.A) + (size_t)cur.pm * tstep; const char* cB = (const char*)(cur.seg ? g.Bt1 : g.Bt) + (size_t)cur.pn * tstep;
    S.a_ready(cur);
    if constexpr (SP2) {
        PG8_STAGE(PG8_SB(0, 0), cB, voffB); PG8_STAGE(PG8_SB(0, 1), cB + bhs, voffB); PG8_STAGE(PG8_SA(0, 0), cA, voffA); PG8_STAGE(PG8_SA(0, 1), cA + hstep, voffA);
        if (wr == 1) PG8_BAR;
        PG8_WAIT_V(2); PG8_BAR;
        PG8_STAGE(PG8_SB(1, 0), cB + kstep, voffB); PG8_STAGE(PG8_SA(1, 0), cA + kstep, voffA); PG8_STAGE(PG8_SB(1, 1), cB + bhs + kstep, voffB);
        PG8_WAIT_V(6); PG8_BAR;
    } else {
        PG8_STAGE(PG8_SB(0, 0), cB, voffB); PG8_STAGE(PG8_SA(0, 0), cA, voffA); PG8_STAGE(PG8_SB(0, 1), cB + bhs, voffB); PG8_STAGE(PG8_SA(0, 1), cA + hstep, voffA);
        if (wr == 1) PG8_BAR;
        PG8_WAIT_V(4); PG8_BAR;
        PG8_STAGE(PG8_SB(1, 0), cB + kstep, voffB); PG8_STAGE(PG8_SA(1, 0), cA + kstep, voffA); PG8_STAGE(PG8_SB(1, 1), cB + bhs + kstep, voffB);
        PG8_WAIT_V(6); PG8_BAR;
    }
    for (;;) {
        const bool has_next = S.next(ui + 1, nxt);
        const char* nA = has_next ? (const char*)(nxt.seg ? g.A1 : g.A) + (size_t)nxt.pm * tstep : cA; const char* nB = has_next ? (const char*)(nxt.seg ? g.Bt1 : g.Bt) + (size_t)nxt.pn * tstep : cB;
        for (int t = 0; t < nt; t += 2) {
            const bool last = (t == nt - 2);
            const char* a1 = cA + (size_t)(t + 1) * kstep;
            const char* a2 = last ? nA : cA + (size_t)(t + 2) * kstep; const char* b2 = last ? nB : cB + (size_t)(t + 2) * kstep;
            const char* a3 = a2 + kstep; const char* b3 = b2 + kstep;
            if (last && has_next) S.a_ready(nxt);
            if constexpr (SP2) {
            PG8_LDB(B0, 0, 0); PG8_LDB(B1, 0, 1); PG8_SCHED; PG8_LDA(At, 0, 0); PG8_STAGE(PG8_SA(1, 1), a1 + hstep, voffA);
            PG8_WAIT_V(8); PG8_WAIT_L(0); PG8_BAR; PG8_MMA(0, 0, At, B0); PG8_MMA(0, 1, At, B1); PG8_BAR; PG8_SCHED;
            PG8_LDA(At, 0, 1); PG8_STAGE(PG8_SB(0, 0), b2, voffB); PG8_STAGE(PG8_SB(0, 1), b2 + bhs, voffB); PG8_STAGE(PG8_SA(0, 0), a2, voffA);
            PG8_WAIT_V(8); PG8_WAIT_L(0); PG8_BAR; PG8_MMA(1, 0, At, B0); PG8_MMA(1, 1, At, B1); PG8_BAR; PG8_SCHED;
            PG8_LDB(B0, 1, 0); PG8_LDB(B1, 1, 1); PG8_SCHED; PG8_LDA(At, 1, 0); PG8_STAGE(PG8_SA(0, 1), a2 + hstep, voffA);
            PG8_WAIT_V(8); PG8_WAIT_L(0); PG8_BAR; PG8_MMA(0, 0, At, B0); PG8_MMA(0, 1, At, B1); PG8_BAR; PG8_SCHED;
            PG8_LDA(At, 1, 1); PG8_STAGE(PG8_SB(1, 0), b3, voffB); PG8_STAGE(PG8_SB(1, 1), b3 + bhs, voffB); PG8_STAGE(PG8_SA(1, 0), a3, voffA);
            PG8_WAIT_V(8); PG8_WAIT_L(0); PG8_BAR; PG8_MMA(1, 0, At, B0); PG8_MMA(1, 1, At, B1); PG8_BAR; PG8_SCHED;
            } else {
            PG8_LDB(B0, 0, 0); PG8_SCHED; PG8_LDA(At, 0, 0); PG8_STAGE(PG8_SA(1, 1), a1 + hstep, voffA);
            PG8_WAIT_L(8); PG8_BAR; PG8_WAIT_L(0); PG8_MMA(0, 0, At, B0); PG8_BAR; PG8_SCHED;
            PG8_LDB(B1, 0, 1); PG8_STAGE(PG8_SB(0, 0), b2, voffB);
            PG8_BAR; PG8_WAIT_L(0); PG8_MMA(0, 1, At, B1); PG8_BAR;
            PG8_LDA(At, 0, 1); PG8_STAGE(PG8_SA(0, 0), a2, voffA);
            PG8_BAR; PG8_WAIT_L(0); PG8_MMA(1, 0, At, B0); PG8_BAR; PG8_SCHED;
            PG8_STAGE(PG8_SB(0, 1), b2 + bhs, voffB);
            PG8_WAIT_V(6); PG8_BAR; PG8_MMA(1, 1, At, B1); PG8_BAR;
            PG8_LDB(B0, 1, 0); PG8_SCHED; PG8_LDA(At, 1, 0); PG8_STAGE(PG8_SA(0, 1), a2 + hstep, voffA);
            PG8_WAIT_L(8); PG8_BAR; PG8_WAIT_L(0); PG8_MMA(0, 0, At, B0); PG8_BAR; PG8_SCHED;
            PG8_LDB(B1, 1, 1); PG8_STAGE(PG8_SB(1, 0), b3, voffB);
            PG8_BAR; PG8_WAIT_L(0); PG8_MMA(0, 1, At, B1); PG8_BAR;
            PG8_LDA(At, 1, 1); PG8_STAGE(PG8_SA(1, 0), a3, voffA);
            PG8_BAR; PG8_WAIT_L(0); PG8_MMA(1, 0, At, B0); PG8_BAR; PG8_SCHED;
            PG8_STAGE(PG8_SB(1, 1), b3 + bhs, voffB);
            PG8_WAIT_V(6); PG8_BAR; PG8_MMA(1, 1, At, B1); PG8_BAR;
            }
        }
        if constexpr (ALIGN_EPI) { if (wr == 0) PG8_BAR; }
        if constexpr (!Epi::AFTER_DRAIN) { int t_ = threadIdx.x; asm volatile("" : "+v"(t_)); const int l_ = t_ & 63; E(acc, cur, wr, wc, l_ & 15, l_ >> 4); S.done(cur); H(ui); }
        if (!has_next) break;
#pragma unroll
        for (int a = 0; a < 2; ++a)
#pragma unroll
            for (int b = 0; b < 2; ++b)
#pragma unroll
                for (int m = 0; m < 4; ++m)
#pragma unroll
                    for (int n = 0; n < 2; ++n) acc[a][b][m][n] = (f32x4){0.f, 0.f, 0.f, 0.f};
        cur = nxt; cA = nA; cB = nB; ++ui;
        if constexpr (ALIGN_EPI) { if (wr == 1) PG8_BAR; }
    }
    PG8_WAIT_V(0);
    if constexpr (!ALIGN_EPI) { if (wr == 0) PG8_BAR; }
    PG8_BAR;
    if constexpr (Epi::AFTER_DRAIN) { E.fused(acc, cur, wr, wc, fr, fq, lds, wid, lane); S.done(cur); }
#undef PG8_SA
#undef PG8_SB
#undef PG8_STAGE
#undef PG8_LDA
#undef PG8_LDB
#undef PG8_MMA
#undef PG8_WAIT_V
#undef PG8_WAIT_L
#undef PG8_BAR
#undef PG8_SCHED
}
}
namespace sba {
typedef short bf16x8 __attribute__((ext_vector_type(8)));
typedef short s16x4 __attribute__((ext_vector_type(4)));
typedef float f32x16 __attribute__((ext_vector_type(16)));
typedef float f32x4 __attribute__((ext_vector_type(4)));
typedef unsigned u32x4 __attribute__((ext_vector_type(4)));
typedef unsigned short bf16_t;
#define SB_LAS __attribute__((address_space(3)))
constexpr int PITCH = 512, SLOTB = 16384  , OFF_FLAGS = 2 * SLOTB, OFF_OST = OFF_FLAGS + 256, LDS_BYTES = OFF_OST + 8 * 4096;
constexpr float THR2 = 48.0f, NEGBIG = -1.0e30f;
typedef float f32x2_t __attribute__((ext_vector_type(2))); typedef __bf16 bf16x2_t __attribute__((ext_vector_type(2)));
__device__ __forceinline__ unsigned cvtpk(float lo, float hi) { f32x2_t v = {lo, hi}; bf16x2_t b = __builtin_convertvector(v, bf16x2_t); return __builtin_bit_cast(unsigned, b); }
__device__ __forceinline__ bf16x8 pack8f(float a0, float a1, float a2, float a3, float a4, float a5, float a6, float a7) {
    u32x4 w; w.x = cvtpk(a0, a1); w.y = cvtpk(a2, a3); w.z = cvtpk(a4, a5); w.w = cvtpk(a6, a7); return __builtin_bit_cast(bf16x8, w); }
typedef short v4i16_t __attribute__((ext_vector_type(4)));
__device__ __forceinline__ s16x4 vtr(const SB_LAS char* p) { return __builtin_bit_cast(s16x4, __builtin_amdgcn_ds_read_tr16_b64_v4i16((SB_LAS v4i16_t*)p)); }
__device__ __forceinline__ int crow(int r, int hi) { return (r & 3) + 8 * (r >> 2) + 4 * hi; }

template <int SUB>
__device__ __forceinline__ void sub_front(const SB_LAS char* Kslot, bool mask, int kq, const bf16x8 (&qr)[4], f32x16& w, bf16x8 (&spb)[2], int r32, int hi) {
    const SB_LAS char* kb = Kslot + hi * 1024 + r32 * 16 + SUB * 512;
    f32x16 p = {};
#pragma unroll
    for (int d0 = 0; d0 < 4; ++d0) { const bf16x8 kf = *(const SB_LAS bf16x8*)(kb + d0 * 2048); p = __builtin_amdgcn_mfma_f32_32x32x16_bf16(kf, qr[d0], p, 0, 0, 0); }
    float sp[16];
#pragma unroll
    for (int r = 0; r < 16; ++r) {
        float x = p[r];
        if (mask && (kq + 32 * SUB + (r & 3) + 8 * (r >> 2) >= 0)) x = NEGBIG;
        const float t = __builtin_amdgcn_exp2f(-__builtin_fabsf(x));
        const float l = __builtin_amdgcn_logf(1.0f + t);
        sp[r] = __builtin_fmaxf(x, 0.f) + l; w[r] = __builtin_fminf(x, 0.f) - l;
    }
    spb[0] = pack8f(sp[0], sp[1], sp[2], sp[3], sp[4], sp[5], sp[6], sp[7]);
    spb[1] = pack8f(sp[8], sp[9], sp[10], sp[11], sp[12], sp[13], sp[14], sp[15]);
}
template <int SUB>
__device__ __forceinline__ void sub_back(const SB_LAS char* vp, const f32x16& w, const f32x16& sx, f32x16 (&o)[2]) {
    float pr[16];
#pragma unroll
    for (int r = 0; r < 16; ++r) pr[r] = __builtin_amdgcn_exp2f(w[r] - sx[r]);
    bf16x8 pa[2];
    pa[0] = pack8f(pr[0], pr[1], pr[2], pr[3], pr[4], pr[5], pr[6], pr[7]);
    pa[1] = pack8f(pr[8], pr[9], pr[10], pr[11], pr[12], pr[13], pr[14], pr[15]);
#pragma unroll
    for (int d0 = 0; d0 < 2; ++d0)
#pragma unroll
        for (int s = 0; s < 2; ++s) { const int ks = 2 * SUB + s;
            const s16x4 lo = vtr(vp + d0 * 4096 + ks * 1024), hi4 = vtr(vp + d0 * 4096 + ks * 1024 + 512);
            const bf16x8 vf = (bf16x8){lo[0], lo[1], lo[2], lo[3], hi4[0], hi4[1], hi4[2], hi4[3]};
            o[d0] = __builtin_amdgcn_mfma_f32_32x32x16_bf16(pa[s], vf, o[d0], 0, 0, 0); }
}
__device__ __forceinline__ void sb_tile(const SB_LAS char* slot, bool mask, bool skip1, int kq, const bf16x8 (&qr)[4], f32x16& Rb, f32x16 (&o)[2], const bf16x8 (&Um)[2], const bf16x8 Jm, int r32, int hi, int lane) {
    const SB_LAS char* vp = slot + 8192 + ((lane >> 4) & 1) * 32 + (lane & 3) * 8 + (4 * hi + ((lane & 15) >> 2)) * 64;
    f32x16 w1, w0; bf16x8 sb1[2], sb0[2];
    f32x16 t1 = Rb;
    if (!skip1) {
    sub_front<1>(slot, mask, kq, qr, w1, sb1, r32, hi);
    f32x16 a1 = __builtin_amdgcn_mfma_f32_32x32x16_bf16(Um[0], sb1[0], Rb, 0, 0, 0); a1 = __builtin_amdgcn_mfma_f32_32x32x16_bf16(Um[1], sb1[1], a1, 0, 0, 0);
    t1 = __builtin_amdgcn_mfma_f32_32x32x16_bf16(Jm, sb1[0], Rb, 0, 0, 0); t1 = __builtin_amdgcn_mfma_f32_32x32x16_bf16(Jm, sb1[1], t1, 0, 0, 0);
    sub_back<1>(vp, w1, a1, o);
    }
    sub_front<0>(slot, mask, kq, qr, w0, sb0, r32, hi);
    f32x16 a0 = __builtin_amdgcn_mfma_f32_32x32x16_bf16(Um[0], sb0[0], t1, 0, 0, 0); a0 = __builtin_amdgcn_mfma_f32_32x32x16_bf16(Um[1], sb0[1], a0, 0, 0, 0);
    f32x16 rn = __builtin_amdgcn_mfma_f32_32x32x16_bf16(Jm, sb0[0], t1, 0, 0, 0); rn = __builtin_amdgcn_mfma_f32_32x32x16_bf16(Jm, sb0[1], rn, 0, 0, 0);
    sub_back<0>(vp, w0, a0, o);
    Rb = rn;
}
struct Tensors { const bf16_t* Q; const bf16_t* K; const bf16_t* V; bf16_t* O; const float* ck; const float* cv; };

template <bool SAMPLE>
__device__ __forceinline__ void sb_unit(int b, int h, int qb, const Tensors& T, SB_LAS char* lds) {
    int tid = threadIdx.x; asm volatile("" : "+v"(tid)); const int lane = tid & 63, r32 = lane & 31, hi = lane >> 5; const int wid = __builtin_amdgcn_readfirstlane(tid >> 6);
    const size_t rowbase = SAMPLE ? (size_t)cfg::MP + (size_t)b * 32 : (size_t)b * cfg::SEQ; const int q0 = SAMPLE ? 0 : qb * 256;
    const int jd = SAMPLE ? 16 : (q0 >> 6) + (wid >> 1), jtop = SAMPLE ? 16 : (q0 >> 6) + 3;
    const bool worker = SAMPLE ? (wid == 0) : true;
    const int wq = SAMPLE ? 0 : wid;
    const int qpos = (SAMPLE ? cfg::PAST : q0 + 32 * wq) + r32;
    volatile SB_LAS unsigned* flags = (volatile SB_LAS unsigned*)(lds + OFF_FLAGS);
    bf16x8 Um[2], Jm;
#pragma unroll
    for (int s = 0; s < 2; ++s)
#pragma unroll
        for (int jj = 0; jj < 8; ++jj) Um[s][jj] = (16 * s + 8 * (jj >> 2) + 4 * hi + (jj & 3) > r32) ? (short)0x3F80 : (short)0;
#pragma unroll
    for (int jj = 0; jj < 8; ++jj) Jm[jj] = (short)0x3F80;
    bf16x8 qr[4];
    { const bf16_t* Qw = T.Q + (rowbase + q0 + 32 * wq + r32) * PITCH + h * 64 + hi * 8;
#pragma unroll
      for (int d0 = 0; d0 < 4; ++d0) qr[d0] = *(const bf16x8*)(Qw + d0 * 16); }
    f32x16 Rb = {}, o[2]; o[0] = f32x16{}; o[1] = f32x16{};
    bool done = false;
    u32x4 kreg, vreg;
    const int vkey = 16 * (wid & 3) + (lane >> 2), vcol = (wid >> 2) * 32 + (lane & 3) * 8;
#define SB_LOAD(j) do { \
        if (!SAMPLE) { kreg = *(const u32x4*)(T.K + (rowbase + (size_t)(64 * (j) + lane)) * PITCH + h * 64 + wid * 8); vreg = *(const u32x4*)(T.V + (rowbase + (size_t)(64 * (j) + vkey)) * PITCH + h * 64 + vcol); } \
        else if ((j) == 16) { const int kr_ = lane < 31 ? lane : 31, vr_ = vkey < 31 ? vkey : 31; \
            kreg = *(const u32x4*)(T.K + (rowbase + kr_) * PITCH + h * 64 + wid * 8); vreg = *(const u32x4*)(T.V + (rowbase + vr_) * PITCH + h * 64 + vcol); } \
        else { const float* kp_ = T.ck + ((size_t)b * cfg::PAST + 64 * (j) + lane) * PITCH + h * 64 + wid * 8; const float* vp_ = T.cv + ((size_t)b * cfg::PAST + 64 * (j) + vkey) * PITCH + h * 64 + vcol; \
            const f32x4 k0_ = *(const f32x4*)kp_, k1_ = *(const f32x4*)(kp_ + 4), v0_ = *(const f32x4*)vp_, v1_ = *(const f32x4*)(vp_ + 4); \
            kreg = (u32x4){cvtpk(k0_[0], k0_[1]), cvtpk(k0_[2], k0_[3]), cvtpk(k1_[0], k1_[1]), cvtpk(k1_[2], k1_[3])}; vreg = (u32x4){cvtpk(v0_[0], v0_[1]), cvtpk(v0_[2], v0_[3]), cvtpk(v1_[0], v1_[1]), cvtpk(v1_[2], v1_[3])}; } } while (0)
    SB_LOAD(jtop);
    for (int j = jtop; j >= 0; --j) {
        SB_LAS char* slot = lds + (j & 1) * SLOTB;
        *(SB_LAS u32x4*)(slot + wid * 1024 + lane * 16) = kreg; *(SB_LAS u32x4*)(slot + 8192 + wid * 1024 + lane * 16) = vreg;
        __syncthreads();
        if (j != jtop) { const volatile SB_LAS unsigned* f = flags + ((j + 1) & 1) * 8; unsigned all = 1u;
#pragma unroll
            for (int w8 = 0; w8 < 8; ++w8) all &= f[w8];
            if (all) break; }
        if (j > 0) SB_LOAD(j - 1);
        if (worker && !done && j <= jd) {
            const int key0 = (SAMPLE && j == 16) ? cfg::PAST : 64 * j;
            sb_tile(slot, j == jd, (j == jd) && (SAMPLE || (wid & 1) == 0), key0 + 4 * hi - qpos, qr, Rb, o, Um, Jm, r32, hi, lane);
            done = __all(Rb[0] > THR2) != 0;
        }
        if (lane == 0) flags[(j & 1) * 8 + wid] = (done || !worker) ? 1u : 0u;
    }
#undef SB_LOAD
    if (worker) {
        SB_LAS bf16_t* stg = (SB_LAS bf16_t*)(lds + OFF_OST) + wid * 2048;
#pragma unroll
        for (int r = 0; r < 16; ++r) { const int orow = crow(r, hi);
#pragma unroll
            for (int d0 = 0; d0 < 2; ++d0) stg[orow * 64 + d0 * 32 + r32] = (bf16_t)(cvtpk(o[d0][r], 0.f) & 0xffffu); }
        asm volatile("s_waitcnt lgkmcnt(0)" ::: "memory");
        bf16_t* Ow = T.O + (rowbase + q0 + 32 * wq) * PITCH + h * 64;
#pragma unroll
        for (int i = 0; i < 4; ++i) { const int row = i * 8 + (lane >> 3), ch = lane & 7; const u32x4 v = *(const SB_LAS u32x4*)(stg + row * 64 + ch * 8); *(u32x4*)(Ow + (size_t)row * PITCH + ch * 8) = v; }
    }
    __syncthreads();
}
}
namespace sk {
typedef short bf16x8 __attribute__((ext_vector_type(8)));
typedef float f32x16 __attribute__((ext_vector_type(16)));
typedef float f32x4 __attribute__((ext_vector_type(4)));
typedef unsigned short bf16_t;
#define SK_LAS __attribute__((address_space(3)))
constexpr int PLD = 36;
constexpr int LDS_BYTES = 8 * 2 * 32 * PLD * 4;
__device__ __forceinline__ f32x4 tile(const bf16_t* A, const bf16_t* Bt, int K, size_t arow0, int col0, SK_LAS char* lds) {
    int tid = threadIdx.x; asm volatile("" : "+v"(tid)); const int lane = tid & 63, r32 = lane & 31, hi = lane >> 5; const int wid = __builtin_amdgcn_readfirstlane(tid >> 6);
    const int nsplit = (K >= 512) ? 8 : (K >> 6), ks = K / nsplit;
    const bf16_t* ap = A + (arow0 + r32) * K + wid * ks + hi * 32;
    const bf16_t* bp0 = Bt + (size_t)(col0 + r32) * K + wid * ks + hi * 32; const bf16_t* bp1 = bp0 + (size_t)32 * K;
    f32x16 acc0 = {}, acc1 = {};
#pragma unroll 2
    for (int s = 0; s < ((wid < nsplit) ? ks : 0); s += 64) {
        bf16x8 a[4], b0[4], b1[4];
#pragma unroll
        for (int j = 0; j < 4; ++j) { a[j] = *(const bf16x8*)(ap + s + 8 * j); b0[j] = *(const bf16x8*)(bp0 + s + 8 * j); b1[j] = *(const bf16x8*)(bp1 + s + 8 * j); }
#pragma unroll
        for (int j = 0; j < 4; ++j) {
            acc0 = __builtin_amdgcn_mfma_f32_32x32x16_bf16(b0[j], a[j], acc0, 0, 0, 0);
            acc1 = __builtin_amdgcn_mfma_f32_32x32x16_bf16(b1[j], a[j], acc1, 0, 0, 0); }
    }
    SK_LAS float* P0 = (SK_LAS float*)lds + ((wid * 2 + 0) * 32 + r32) * PLD + 4 * hi; SK_LAS float* P1 = P0 + 32 * PLD;
#pragma unroll
    for (int g = 0; g < 4; ++g) { *(SK_LAS f32x4*)(P0 + 8 * g) = (f32x4){acc0[4 * g], acc0[4 * g + 1], acc0[4 * g + 2], acc0[4 * g + 3]};
                                  *(SK_LAS f32x4*)(P1 + 8 * g) = (f32x4){acc1[4 * g], acc1[4 * g + 1], acc1[4 * g + 2], acc1[4 * g + 3]}; }
    __syncthreads();
    const int row = tid >> 4, c = (tid & 15) * 4, cb = c >> 5, cc = c & 31;
    f32x4 s = {0.f, 0.f, 0.f, 0.f};
#pragma unroll
    for (int w = 0; w < 8; ++w) s += *(const SK_LAS f32x4*)((SK_LAS float*)lds + ((w * 2 + cb) * 32 + row) * PLD + cc);
    __syncthreads();
    return s;
}
__device__ __forceinline__ void tile4(const bf16_t* A, const bf16_t* Bt, int K, size_t arow0, int col0, SK_LAS char* lds, f32x4 (&out)[2][2]) {
    int tid = threadIdx.x; asm volatile("" : "+v"(tid)); const int lane = tid & 63, r32 = lane & 31, hi = lane >> 5; const int wid = __builtin_amdgcn_readfirstlane(tid >> 6);
    const int half = wid >> 2, kq = wid & 3, ks = K >> 2;
    const bf16_t* ap = A + (arow0 + r32) * K + kq * ks + hi * 32;
    const bf16_t* bp = Bt + (size_t)(col0 + half * 128 + r32) * K + kq * ks + hi * 32;
    f32x16 acc[4]; acc[0] = f32x16{}; acc[1] = f32x16{}; acc[2] = f32x16{}; acc[3] = f32x16{};
#pragma unroll 1
    for (int s = 0; s < ks; s += 64) {
        bf16x8 a[4], b[4][4];
#pragma unroll
        for (int e = 0; e < 4; ++e) { a[e] = *(const bf16x8*)(ap + s + 8 * e);
#pragma unroll
            for (int j = 0; j < 4; ++j) b[j][e] = *(const bf16x8*)(bp + (size_t)(32 * j) * K + s + 8 * e); }
#pragma unroll
        for (int e = 0; e < 4; ++e)
#pragma unroll
            for (int j = 0; j < 4; ++j) acc[j] = __builtin_amdgcn_mfma_f32_32x32x16_bf16(b[j][e], a[e], acc[j], 0, 0, 0);
    }
    const int row = tid >> 4, cc = (tid & 15) * 4;
#pragma unroll
    for (int q = 0; q < 2; ++q) {
        SK_LAS float* P0 = (SK_LAS float*)lds + ((wid * 2 + 0) * 32 + r32) * PLD + 4 * hi; SK_LAS float* P1 = P0 + 32 * PLD;
#pragma unroll
        for (int g = 0; g < 4; ++g) { *(SK_LAS f32x4*)(P0 + 8 * g) = (f32x4){acc[2 * q][4 * g], acc[2 * q][4 * g + 1], acc[2 * q][4 * g + 2], acc[2 * q][4 * g + 3]};
                                      *(SK_LAS f32x4*)(P1 + 8 * g) = (f32x4){acc[2 * q + 1][4 * g], acc[2 * q + 1][4 * g + 1], acc[2 * q + 1][4 * g + 2], acc[2 * q + 1][4 * g + 3]}; }
        __syncthreads();
#pragma unroll
        for (int h = 0; h < 2; ++h) { f32x4 sum = {0.f, 0.f, 0.f, 0.f};
#pragma unroll
            for (int w = 0; w < 4; ++w) sum += *(const SK_LAS f32x4*)((SK_LAS float*)lds + (((h * 4 + w) * 2 + (cc >> 5)) * 32 + row) * PLD + (cc & 31));
            out[h][q] = sum; }
        __syncthreads();
    }
}
__device__ __forceinline__ f32x16 wtile(const bf16_t* A, const bf16_t* Bt, int K, size_t arow0, int colw, int lane) {
    const int r32 = lane & 31, hi = lane >> 5;
    const bf16_t* ap = A + (arow0 + r32) * K + hi * 32; const bf16_t* bp = Bt + (size_t)(colw + r32) * K + hi * 32;
    f32x16 acc = {};
#pragma unroll 4
    for (int s = 0; s < K; s += 64) {
        bf16x8 a[4], b[4];
#pragma unroll
        for (int e = 0; e < 4; ++e) { a[e] = *(const bf16x8*)(ap + s + 8 * e); b[e] = *(const bf16x8*)(bp + s + 8 * e); }
#pragma unroll
        for (int e = 0; e < 4; ++e) acc = __builtin_amdgcn_mfma_f32_32x32x16_bf16(b[e], a[e], acc, 0, 0, 0);
    }
    return acc;
}
__device__ __forceinline__ float sum16(float v) { v += __shfl_xor(v, 1); v += __shfl_xor(v, 2); v += __shfl_xor(v, 4); v += __shfl_xor(v, 8); return v; }
__device__ __forceinline__ float rstd16(const float* SSQ, int r, int t) { return __builtin_amdgcn_rsqf(sum16(SSQ[(size_t)r * 16 + (t & 15)]) * (1.0f / 1024.0f) + cfg::EPS); }
__device__ __forceinline__ float rstd_row(const float* SSQ, int r) { const f32x4* p = (const f32x4*)(SSQ + (size_t)r * 16); const f32x4 a = p[0], b = p[1], c = p[2], d = p[3];
    const float s = ((a[0] + a[1]) + (a[2] + a[3])) + ((b[0] + b[1]) + (b[2] + b[3])) + ((c[0] + c[1]) + (c[2] + c[3])) + ((d[0] + d[1]) + (d[2] + d[3])); return __builtin_amdgcn_rsqf(s * (1.0f / 1024.0f) + cfg::EPS); }
__device__ __forceinline__ unsigned long long pk4(f32x4 v) { return (unsigned long long)pg8::cvt_pk_bf16(v[0], v[1]) | ((unsigned long long)pg8::cvt_pk_bf16(v[2], v[3]) << 32); }
__device__ __forceinline__ f32x4 up4(unsigned long long w) { const unsigned lo = (unsigned)w, hi = (unsigned)(w >> 32); return (f32x4){pg8::bf_lo(lo), pg8::bf_hi(lo), pg8::bf_lo(hi), pg8::bf_hi(hi)}; }
}
#define GAS __attribute__((address_space(1)))
#define LAS __attribute__((address_space(3)))
typedef unsigned short bf16;
typedef unsigned v4u __attribute__((ext_vector_type(4)));
typedef float f32x4 __attribute__((ext_vector_type(4)));
typedef short bf16x8 __attribute__((ext_vector_type(8)));
typedef GAS unsigned gu32;
typedef GAS unsigned long long gu64;
#define RLX_AGENT __ATOMIC_RELAXED, __HIP_MEMORY_SCOPE_AGENT
#define LDS_WAIT() asm volatile("s_waitcnt lgkmcnt(0)" ::: "memory")
#define VM_WAIT() asm volatile("s_waitcnt vmcnt(0)" ::: "memory")
__device__ __forceinline__ unsigned long long rt() { return __builtin_amdgcn_s_memrealtime(); }
__device__ __forceinline__ unsigned f2bf(float f) { unsigned u = __builtin_bit_cast(unsigned, f); return (u + 0x7fffu + ((u >> 16) & 1u)) >> 16; }
__device__ __forceinline__ unsigned pk2(float lo, float hi) { return f2bf(lo) | (f2bf(hi) << 16); }
#define XB_TMO      128
#define XB_XCNT(j)  (256  + 64 * (j))
#define XB_XSUB(j)  (1280 + 64 * (j))
#define XB_XGEN(j)  (2304 + 64 * (j))
#define XB_TOP      3328
#define XB_TOPGEN   3392
#define XCD_BAR_WORDS 3456
#define XB_SPIN_CAP (1u << 18)

__device__ __forceinline__ unsigned xb_ld(unsigned* p)              { return __hip_atomic_load(p, __ATOMIC_RELAXED, __HIP_MEMORY_SCOPE_AGENT); }
__device__ __forceinline__ unsigned xb_add(unsigned* p, unsigned v) { return __hip_atomic_fetch_add(p, v, __ATOMIC_RELAXED, __HIP_MEMORY_SCOPE_AGENT); }
__device__ __forceinline__ unsigned xb_xcc_id() { return (unsigned)__builtin_amdgcn_s_getreg((3 << 11) | 20) & 0xFu; }
#define XB_SPIN(cond, bar) do { unsigned _sp = 0; while (cond) { __builtin_amdgcn_s_sleep(1); \
    if ((++_sp & 255u) == 0u) { if (xb_ld(&(bar)[XB_TMO])) break; if (_sp > XB_SPIN_CAP) { atomicAdd(&(bar)[XB_TMO], 1u); break; } } } } while (0)

struct XcdBarrier {
    unsigned* bar; unsigned x;
    volatile LAS unsigned* st;
};

__device__ __forceinline__ XcdBarrier xcd_barrier_post(unsigned* bar, volatile LAS unsigned* st) {
    XcdBarrier b; b.bar = bar; b.x = xb_xcc_id(); b.st = st;
    if (threadIdx.x == 0) (void)xb_add(&bar[XB_XCNT(b.x)], 1u);
    return b;
}
__device__ __forceinline__ void xcd_barrier_complete(unsigned* bar, unsigned x, unsigned& nloc, unsigned& nx) {
    const unsigned G = gridDim.x * gridDim.y * gridDim.z;
    unsigned sum, cnt, mine, sp = 0u;
    for (;;) {
        sum = 0u; cnt = 0u; mine = 0u;
#pragma unroll
        for (unsigned j = 0; j < 16; ++j) { const unsigned c = xb_ld(&bar[XB_XCNT(j)]); sum += c; cnt += (c > 0u) ? 1u : 0u; mine = (j == x) ? c : mine; }
        if (sum == G) break;
        __builtin_amdgcn_s_sleep(1);
        if ((++sp & 255u) == 0u) { if (xb_ld(&bar[XB_TMO])) break; if (sp > XB_SPIN_CAP) { atomicAdd(&bar[XB_TMO], 1u); break; } }
    }
    nloc = mine > 0u ? mine : 1u; nx = cnt > 0u ? cnt : 1u;
}

__device__ __forceinline__ void xcd_barrier(const XcdBarrier& b) {
    asm volatile("s_waitcnt vmcnt(0)" ::: "memory");
    __syncthreads();
    if (threadIdx.x == 0) {
        unsigned* bar = b.bar;
        __builtin_amdgcn_s_waitcnt(0);
        unsigned nloc = b.st[0], nx = b.st[1];
        if (nloc == 0u) { xcd_barrier_complete(bar, b.x, nloc, nx); b.st[0] = nloc; b.st[1] = nx; }
        const unsigned old = xb_add(&bar[XB_XSUB(b.x)], 1u);
        const unsigned gen = old / nloc;
        if (old + 1u == (gen + 1u) * nloc) {
            __builtin_amdgcn_fence(__ATOMIC_RELEASE, "agent");
            asm volatile("s_waitcnt vmcnt(0)" ::: "memory");
            const unsigned og = xb_add(&bar[XB_TOP], 1u);
            const unsigned tg = og / nx;
            if (og + 1u == (tg + 1u) * nx) xb_add(&bar[XB_TOPGEN], 1u);
            else XB_SPIN(xb_ld(&bar[XB_TOPGEN]) == tg, bar);
            __builtin_amdgcn_fence(__ATOMIC_ACQUIRE, "agent");
            xb_add(&bar[XB_XGEN(b.x)], 1u);
            asm volatile("s_waitcnt vmcnt(0)" ::: "memory");
        } else {
            XB_SPIN(xb_ld(&bar[XB_XGEN(b.x)]) == gen, bar);
            __builtin_amdgcn_fence(__ATOMIC_ACQUIRE, "agent");
            asm volatile("s_waitcnt vmcnt(0)" ::: "memory");
        }
    }
    __syncthreads();
}
__device__ __forceinline__ float wave_sum(float v) {
#pragma unroll
    for (int o = 1; o < 64; o <<= 1) v += __shfl_xor(v, o);
    return v;
}
__device__ __forceinline__ void p0_transpose_item(const float* W, int K, int N, bf16* WT, int row_off, LAS float* scr, int item, int lane) {
    const int nblk = N / 32, kb = item / nblk, nb = item % nblk, k0 = 64 * kb, n0 = 32 * nb;
    float tv[32];
#pragma unroll
    for (int i = 0; i < 32; ++i) { const int kk = 2 * i + (lane >> 5); tv[i] = __builtin_nontemporal_load(W + (size_t)(k0 + kk) * N + n0 + (lane & 31)); }
#pragma unroll
    for (int i = 0; i < 32; ++i) { const int kk = 2 * i + (lane >> 5); scr[kk * 33 + (lane & 31)] = tv[i]; }
    LDS_WAIT(); asm volatile("" ::: "memory");
    const int c = lane & 7;
#pragma unroll
    for (int j = 0; j < 4; ++j) { const int n = (lane >> 3) + 8 * j; const LAS float* s = scr + (8 * c) * 33 + n;
        v4u o; o.x = pk2(s[0 * 33], s[1 * 33]); o.y = pk2(s[2 * 33], s[3 * 33]); o.z = pk2(s[4 * 33], s[5 * 33]); o.w = pk2(s[6 * 33], s[7 * 33]);
        *(GAS v4u*)(WT + (size_t)(row_off + n0 + n) * K + k0 + 8 * c) = o; }
    LDS_WAIT(); asm volatile("" ::: "memory");
}
constexpr int NWAVES = 8;
#ifndef MK_N_LAUNCHES
#define MK_N_LAUNCHES 1
#endif
constexpr int N_PHASES = 8;
#ifndef DBG_ROT
#define DBG_ROT 0
#endif
#ifndef DBG_REPEAT
#define DBG_REPEAT -1
#endif
#ifndef DBG_P2PART
#define DBG_P2PART 0
#endif
#ifndef DBG_ALIGN
#define DBG_ALIGN true
#endif
#ifndef DBG_SP2
#define DBG_SP2 true
#endif
using namespace cfg;
constexpr size_t MiB = 1u << 20;
constexpr size_t WS_CTL = 0, CTL_ZERO_BYTES = 1 * MiB;
constexpr size_t WS_WIN = 2 * MiB, WS_WEFF = 10 * MiB, WS_WSB = 11 * MiB, WS_WOUT = 12 * MiB, WS_WUP = 14 * MiB, WS_WDOWN = 22 * MiB, WS_WPG = 30 * MiB, WS_WPP = 32 * MiB;
constexpr size_t WS_SSQ1 = 33 * MiB, WS_SSQ2 = 35 * MiB, WS_SSQ3 = 37 * MiB;
constexpr size_t WS_PB = 40 * MiB;
constexpr size_t WS_XN = 49 * MiB;
constexpr size_t WS_BIG = 82 * MiB;
constexpr size_t WS_U = WS_BIG, WS_Q = WS_BIG + 16 * MiB + MiB / 2, WS_K = WS_BIG + 33 * MiB, WS_V = WS_BIG + 49 * MiB + MiB / 2;
constexpr size_t WS_G = WS_BIG + 66 * MiB;
constexpr size_t WS_Y = WS_BIG + 132 * MiB, WS_YSB = WS_Y + 16 * MiB + MiB / 2;
constexpr size_t WS_MG = WS_BIG;
constexpr size_t WS_H = WS_BIG;
constexpr size_t WS_PP = WS_BIG;
constexpr size_t WS_X = WS_Y;
constexpr size_t WS_END = WS_BIG + 165 * MiB;
static_assert((size_t)MT * 512 * 2 == 16 * MiB + MiB / 2 && (size_t)MT * 1024 * 2 == 33 * MiB && (size_t)MT * 16 * 4 <= 2 * MiB && (size_t)MT * 256 * 2 <= 9 * MiB && WS_END <= 256 * MiB, "d_ws map");
constexpr int CW_BAR = 4096, CW_FIN = 8192  , CW_FINS = 16384  ;
constexpr size_t O_Y = 0, O_KP = 17301504, O_VP = 25690112, O_POOLP = 34078720, O_KS = 34140160, O_VS = 34402304, O_POOLS = 34664448, O_END = 34787328;
constexpr int RING_OFF = 0, RING_BYTES = 131072, LDSCTL_OFF = RING_BYTES, MISC_OFF = LDSCTL_OFF + 320, LDS_BYTES = 147456;
static_assert(sk::LDS_BYTES <= RING_BYTES && sba::LDS_BYTES <= RING_BYTES, "attention scratch fits the ring region");

struct Args { const float* in[22]; float* out; unsigned char* ws; int ph_lo, ph_hi, li, pad; };

__device__ __forceinline__ void rms_rows_to_bf16(const float* xrow0, const float* xrow1, const float* g, bf16* orow0, bf16* orow1, int lane) {
    const GAS f32x4* xr0 = (const GAS f32x4*)xrow0 + lane; const GAS f32x4* xr1 = (const GAS f32x4*)(xrow1 ? xrow1 : xrow0) + lane; const GAS f32x4* gr = (const GAS f32x4*)g + lane;
    f32x4 v[4], w[4], gg[4]; float s = 0.f, t = 0.f;
#pragma unroll
    for (int j = 0; j < 4; ++j) { v[j] = __builtin_nontemporal_load(xr0 + 64 * j); w[j] = __builtin_nontemporal_load(xr1 + 64 * j); gg[j] = gr[64 * j]; }
#pragma unroll
    for (int j = 0; j < 4; ++j) { s += (v[j].x * v[j].x + v[j].y * v[j].y) + (v[j].z * v[j].z + v[j].w * v[j].w); t += (w[j].x * w[j].x + w[j].y * w[j].y) + (w[j].z * w[j].z + w[j].w * w[j].w); }
#pragma unroll
    for (int o = 1; o < 64; o <<= 1) { s += __shfl_xor(s, o); t += __shfl_xor(t, o); }
    const float rs = 1.f / sqrtf(s * (1.f / DM) + EPS), rt = 1.f / sqrtf(t * (1.f / DM) + EPS);
    GAS unsigned long long* o0 = (GAS unsigned long long*)orow0 + lane; GAS unsigned long long* o1 = (GAS unsigned long long*)orow1 + lane;
#pragma unroll
    for (int j = 0; j < 4; ++j) { o0[64 * j] = (unsigned long long)pk2(v[j].x * rs * gg[j].x, v[j].y * rs * gg[j].y) | ((unsigned long long)pk2(v[j].z * rs * gg[j].z, v[j].w * rs * gg[j].w) << 32);
        if (xrow1) o1[64 * j] = (unsigned long long)pk2(w[j].x * rt * gg[j].x, w[j].y * rt * gg[j].y) | ((unsigned long long)pk2(w[j].z * rt * gg[j].z, w[j].w * rt * gg[j].w) << 32); }
}
__device__ __forceinline__ void weff_item(const float* wgrp, const float* scale, const float* wpu, bf16* WT, int item, int lane) {
    const int nb = item & 15, cb = (item >> 4) & 15, g = item >> 8, n = nb * 64 + lane;
    float wg[8][2];
#pragma unroll
    for (int cc = 0; cc < 8; ++cc)
#pragma unroll
        for (int hh = 0; hh < 2; ++hh) wg[cc][hh] = wgrp[((size_t)(g * 128 + cb * 8 + cc)) * 128 + lane + 64 * hh] * scale[g * 128 + lane + 64 * hh];
    float acc[8];
#pragma unroll
    for (int cc = 0; cc < 8; ++cc) acc[cc] = 0.f;
#pragma unroll
    for (int hh = 0; hh < 2; ++hh)
#pragma unroll 16
        for (int d2 = 0; d2 < 64; ++d2) { const float wv = wpu[(size_t)(g * 128 + hh * 64 + d2) * 1024 + n];
#pragma unroll
            for (int cc = 0; cc < 8; ++cc) acc[cc] = fmaf(__builtin_bit_cast(float, __builtin_amdgcn_readlane(__builtin_bit_cast(int, wg[cc][hh]), d2)), wv, acc[cc]); }
    v4u o; o.x = pk2(acc[0], acc[1]); o.y = pk2(acc[2], acc[3]); o.z = pk2(acc[4], acc[5]); o.w = pk2(acc[6], acc[7]);
    *(GAS v4u*)(WT + (size_t)n * 512 + g * 128 + cb * 8) = o;
}

template <int W, int R>
__device__ __forceinline__ void pool_run(const bf16* Ub, const float* state_pool, bf16* Yb, int run, int c) {
    const int r0 = run * R; const bool sample = r0 >= MP; const int t0 = sample ? ((r0 - MP) & 31) : (r0 & (SEQ - 1)); const int b_ = sample ? ((r0 - MP) >> 5) : 0;
    v4u rw[R - 1 + W];
#pragma unroll
    for (int k = 0; k < W - 1; ++k) { const int pos = t0 + k - (W - 1);
        if (pos >= 0) rw[k] = *(const GAS v4u*)(Ub + (size_t)(r0 - (W - 1) + k) * 512 + c);
        else if (sample) { const float* sp = state_pool + ((size_t)b_ * 15 + 15 + pos) * 512 + c; const f32x4 a = *(const GAS f32x4*)sp, b = *(const GAS f32x4*)(sp + 4); rw[k] = pg8::pack8(a, b); }
        else rw[k] = (v4u){0u, 0u, 0u, 0u}; }
#pragma unroll
    for (int k = W - 1; k < R - 1 + W; ++k) rw[k] = *(const GAS v4u*)(Ub + (size_t)(r0 - (W - 1) + k) * 512 + c);
    f32x4 s0 = {0.f, 0.f, 0.f, 0.f}, s1 = {0.f, 0.f, 0.f, 0.f};
#pragma unroll
    for (int k = 0; k < W - 1; ++k) { f32x4 a, b; pg8::unpack8(rw[k], a, b); s0 += a; s1 += b; }
#pragma unroll
    for (int i = 0; i < R; ++i) { f32x4 a, b, u0, u1; pg8::unpack8(rw[W - 1 + i], u0, u1); s0 += u0; s1 += u1;
        const int cnt = sample ? W : ((t0 + i + 1 < W) ? t0 + i + 1 : W); const float ic = 1.0f / (float)cnt;
        *(GAS v4u*)(Yb + (size_t)(r0 + i) * 512 + c) = pg8::pack8(s0 * ic - u0, s1 * ic - u1);
        pg8::unpack8(rw[i], a, b); s0 -= a; s1 -= b; }
}
#if defined(HYB_ATTN) || defined(HYB_POOL)
__device__ __forceinline__ float hb2f(unsigned short v) { return __uint_as_float((unsigned)v << 16); }
__global__ void __launch_bounds__(64) hyb_attn(const unsigned short* Qb, const unsigned short* Kb, const unsigned short* Vb, const float* ck, const float* cv, unsigned short* YSB) {
    const int idx = blockIdx.x * 64 + threadIdx.x; if (idx >= MT * NH) return;
    const int h = idx / MT, m = idx % MT;
    float qr[HD], o[HD];
#pragma unroll
    for (int d = 0; d < HD; ++d) { qr[d] = hb2f(Qb[(size_t)m * 512 + h * HD + d]) * 0.6931471805599453f; o[d] = 0.f; }
    float S = 0.f; bool done = false; size_t kb; int nk;
    if (m < MP) { kb = (size_t)(m / SEQ) * SEQ; nk = m % SEQ; } else { const int ms = m - MP; kb = (size_t)MP + (size_t)(ms / DS) * DS; nk = ms % DS; }
    for (int s = nk - 1; s >= 0 && !done; --s) {
        const unsigned short* kr = Kb + (kb + s) * 512 + h * HD; const unsigned short* vr = Vb + (kb + s) * 512 + h * HD; float z = 0.f;
#pragma unroll
        for (int d = 0; d < HD; ++d) z = fmaf(qr[d], hb2f(kr[d]), z);
        const float sp = fmaxf(z, 0.f) + log1pf(expf(-fabsf(z))), a = expf(z - sp - S);
#pragma unroll
        for (int d = 0; d < HD; ++d) o[d] = fmaf(a, hb2f(vr[d]), o[d]);
        S += sp; if (S > 110.f) done = true;
    }
    if (m >= MP) { const int b = (m - MP) / DS; const float* kc = ck + (size_t)b * PAST * 512 + h * HD; const float* vc = cv + (size_t)b * PAST * 512 + h * HD;
        for (int s = PAST - 1; s >= 0 && !done; --s) {
            const float* kr = kc + (size_t)s * 512; const float* vr = vc + (size_t)s * 512; float z = 0.f;
#pragma unroll
            for (int d = 0; d < HD; ++d) z = fmaf(qr[d], kr[d], z);
            const float sp = fmaxf(z, 0.f) + log1pf(expf(-fabsf(z))), a = expf(z - sp - S);
#pragma unroll
            for (int d = 0; d < HD; ++d) o[d] = fmaf(a, vr[d], o[d]);
            S += sp; if (S > 110.f) done = true;
        } }
#pragma unroll
    for (int d = 0; d < HD; ++d) YSB[(size_t)m * 512 + h * HD + d] = (unsigned short)f2bf(o[d]);
}
__global__ void hyb_pool(const unsigned short* Ub, const float* state_pool, unsigned short* Yb) {
    const size_t i = (size_t)blockIdx.x * blockDim.x + threadIdx.x; if (i >= (size_t)MT * PW) return;
    const int m = (int)(i / PW), c = (int)(i % PW), g = c / 128, w = 2 << g;
    float s = 0.f; float cnt;
    if (m < MP) { const int t = m % SEQ; const int n = (t + 1 < w) ? t + 1 : w; for (int j = 0; j < n; ++j) s += hb2f(Ub[(size_t)(m - j) * PW + c]); cnt = (float)n; }
    else { const int ms = m - MP, b = ms / DS, t = ms % DS; for (int j = 0; j < w; ++j) { const int r = 15 + t - j; s += (r >= 15) ? hb2f(Ub[(size_t)(m - j) * PW + c]) : state_pool[((size_t)b * 15 + r) * PW + c]; } cnt = (float)w; }
    Yb[i] = (unsigned short)f2bf(s / cnt - hb2f(Ub[i]));
}
#endif

__global__ void __launch_bounds__(NWAVES * 64, 2) mega_fwd(Args args) {
    extern __shared__ __attribute__((aligned(16))) unsigned char lds[];
    LAS unsigned char* L = (LAS unsigned char*)lds;
    volatile LAS unsigned* MISC = (volatile LAS unsigned*)(L + MISC_OFF);
    const int wave = __builtin_amdgcn_readfirstlane(threadIdx.x >> 6);
#define FRESH_TID() int tid = threadIdx.x; asm volatile("" : "+v"(tid)); const int lane = tid & 63; (void)lane
    const int G = gridDim.x, bx = blockIdx.x, vcu = (G % 8 == 0) ? (bx % 8) * (G / 8) + bx / 8 : bx;
    unsigned char* ws = args.ws;
    gu32* ctl = (gu32*)(ws + WS_CTL);
    const float* x_p = args.in[0]; const float* x_s = args.in[1]; const float* cache_k = args.in[2]; const float* cache_v = args.in[3]; const float* state_pool = args.in[4];
    const float* p_p = args.in[5]; const float* p_s = args.in[6]; const float* g_mix = args.in[7]; const float* w_in = args.in[8]; const float* b_gate = args.in[9]; const float* w_grp = args.in[10];
    const float* pool_scale = args.in[11]; const float* w_pool_up = args.in[12]; const float* w_sb_up = args.in[13]; const float* w_out = args.in[14]; const float* g_mlp = args.in[15];
    const float* w_up = args.in[16]; const float* w_down = args.in[17]; const float* g_ple = args.in[18]; const float* w_ple_gate = args.in[19]; const float* w_ple_proj = args.in[20]; const float* g_final = args.in[21];
    float* out = args.out; float* Yo = out + O_Y;
    bf16 *WIN = (bf16*)(ws + WS_WIN), *WEFF = (bf16*)(ws + WS_WEFF), *WSB = (bf16*)(ws + WS_WSB), *WOUT = (bf16*)(ws + WS_WOUT), *WUP = (bf16*)(ws + WS_WUP), *WDOWN = (bf16*)(ws + WS_WDOWN), *WPG = (bf16*)(ws + WS_WPG), *WPP = (bf16*)(ws + WS_WPP);
    float *SSQ1 = (float*)(ws + WS_SSQ1), *SSQ2 = (float*)(ws + WS_SSQ2), *SSQ3 = (float*)(ws + WS_SSQ3);
    bf16 *PB = (bf16*)(ws + WS_PB), *XN = (bf16*)(ws + WS_XN), *Ub = (bf16*)(ws + WS_U), *Qb = (bf16*)(ws + WS_Q), *Kb = (bf16*)(ws + WS_K), *Vb = (bf16*)(ws + WS_V), *Gb = (bf16*)(ws + WS_G);
    bf16 *Yb = (bf16*)(ws + WS_Y), *YSB = (bf16*)(ws + WS_YSB), *MG = (bf16*)(ws + WS_MG), *Hb = (bf16*)(ws + WS_H), *PPb = (bf16*)(ws + WS_PP), *Xb = (bf16*)(ws + WS_X);

    for (int i = threadIdx.x; i < (LDS_BYTES - LDSCTL_OFF) / 4; i += NWAVES * 64) ((LAS unsigned*)(L + LDSCTL_OFF))[i] = 0u;
    __syncthreads();
    XcdBarrier bar; bar.bar = (unsigned*)(ctl + CW_BAR); bar.x = 0; bar.st = nullptr;
    if (MK_N_LAUNCHES == 1) bar = xcd_barrier_post((unsigned*)(ctl + CW_BAR), MISC + 8);
    const int lo = args.ph_lo, hi = args.ph_hi;
#define IN(k) (lo <= (k) && (k) < hi)
#ifdef DBG_BARCHK
#define SEAM(k) do { if (IN(k) && IN((k) + 1)) { if (threadIdx.x == 0) __hip_atomic_fetch_add((unsigned*)(ctl + 65536 + 64 * (k)), 1u, __ATOMIC_RELAXED, __HIP_MEMORY_SCOPE_AGENT); xcd_barrier(bar); \
    if (threadIdx.x == 0) { const unsigned v_ = __hip_atomic_load((unsigned*)(ctl + 65536 + 64 * (k)), __ATOMIC_RELAXED, __HIP_MEMORY_SCOPE_AGENT); if (v_ != (unsigned)G) { __hip_atomic_store((unsigned*)(ctl + 65536 + 64 * 32), 1u, __ATOMIC_RELAXED, __HIP_MEMORY_SCOPE_AGENT); out[O_KP + (k)] = __builtin_nanf(""); } } } } while (0)
#else
#define SEAM(k) do { if (IN(k) && IN((k) + 1)) xcd_barrier(bar); } while (0)
#endif
    const int gw = vcu * NWAVES + wave, NGW = G * NWAVES;
    const bool late_ = (vcu & 1) != 0;

#pragma unroll 1
    for (int rep_ = 0; rep_ < ((IN(0)) ? ((DBG_REPEAT == 0) ? 2 : 1) : 0); ++rep_) {
        if (rep_ > 0) xcd_barrier(bar);
        FRESH_TID();
        LAS float* scr = (LAS float*)(L + RING_OFF + wave * 16384);
        constexpr int I_IN = (DM / 64) * (INW / 32), I_SB = (SBW / 64) * (DM / 32), I_OUT = (DM / 64) * (DM / 32), I_UP = (DM / 64) * (DFF / 32), I_DOWN = (DFF / 64) * (DM / 32), I_PG = I_OUT, I_PP = (PLE / 64) * (DM / 32), I_EFF = 4 * 16 * 16;
        constexpr int NITEMS = I_IN + I_SB + I_OUT + I_UP + I_DOWN + I_PG + I_PP + I_EFF;
        for (int it = gw; it < NITEMS; it += NGW) {
            int r = it;
            if (r < I_EFF) { weff_item(w_grp, pool_scale, w_pool_up, WEFF, r, lane); continue; } r -= I_EFF;
            if (r < I_IN) { p0_transpose_item(w_in, DM, INW, WIN, 0, scr, r, lane); continue; } r -= I_IN;
            if (r < I_SB) { p0_transpose_item(w_sb_up, SBW, DM, WSB, 0, scr, r, lane); continue; } r -= I_SB;
            if (r < I_OUT) { p0_transpose_item(w_out, DM, DM, WOUT, 0, scr, r, lane); continue; } r -= I_OUT;
            if (r < I_UP) { p0_transpose_item(w_up, DM, DFF, WUP, 0, scr, r, lane); continue; } r -= I_UP;
            if (r < I_DOWN) { p0_transpose_item(w_down, DFF, DM, WDOWN, 0, scr, r, lane); continue; } r -= I_DOWN;
            if (r < I_PG) { p0_transpose_item(w_ple_gate, DM, DM, WPG, 0, scr, r, lane); continue; } r -= I_PG;
            p0_transpose_item(w_ple_proj, PLE, DM, WPP, 0, scr, r, lane);
        }
        for (int m = gw; m < MT; m += 2 * NGW) { const int m1 = m + NGW; const bool two = m1 < MT;
            const float* xr0 = m < MP ? x_p + (size_t)m * DM : x_s + (size_t)(m - MP) * DM;
            const float* xr1 = !two ? nullptr : (m1 < MP ? x_p + (size_t)m1 * DM : x_s + (size_t)(m1 - MP) * DM);
            const float* pr0 = m < MP ? p_p + (size_t)m * PLE : p_s + (size_t)(m - MP) * PLE;
            const float* pr1 = !two ? pr0 : (m1 < MP ? p_p + (size_t)m1 * PLE : p_s + (size_t)(m1 - MP) * PLE);
            const f32x4 pv0 = *((const GAS f32x4*)pr0 + lane), pv1 = *((const GAS f32x4*)pr1 + lane);
            rms_rows_to_bf16(xr0, xr1, g_mix, XN + (size_t)m * DM, XN + (size_t)(two ? m1 : m) * DM, lane);
            *((GAS unsigned long long*)(PB + (size_t)m * PLE) + lane) = (unsigned long long)pk2(pv0.x, pv0.y) | ((unsigned long long)pk2(pv0.z, pv0.w) << 32);
            if (two) *((GAS unsigned long long*)(PB + (size_t)m1 * PLE) + lane) = (unsigned long long)pk2(pv1.x, pv1.y) | ((unsigned long long)pk2(pv1.z, pv1.w) << 32);
        }
    }
    SEAM(0);
#pragma unroll 1
    for (int rep_ = 0; rep_ < ((IN(1)) ? ((DBG_REPEAT == 1) ? 2 : 1) : 0); ++rep_) {
        if (rep_ > 0) xcd_barrier(bar);
#pragma unroll 1
        for (int pass_ = 0; pass_ < 2; ++pass_) if ((pass_ == 1) == late_) {
        for (int task = vcu; task < 16 * (INW / 256); task += G) { const int rb = task & 15, col0 = (task >> 4) * 256; f32x4 vv[2][2];
            sk::tile4(XN, WIN, DM, (size_t)MP + rb * 32, col0, (SK_LAS char*)(L + RING_OFF), vv);
            const int t = threadIdx.x, rs = rb * 32 + (t >> 4), r = MP + rs;
#pragma unroll
            for (int h = 0; h < 2; ++h)
#pragma unroll
                for (int q = 0; q < 2; ++q) { const f32x4 v = vv[h][q]; const int c = col0 + 128 * h + 64 * q + (t & 15) * 4;
            if (c < 512) { *(GAS unsigned long long*)(Ub + (size_t)r * 512 + c) = sk::pk4(v); const int i = rs & 31; if (i >= 17) *(GAS f32x4*)(out + O_POOLS + ((size_t)(rs >> 5) * 15 + (i - 17)) * 512 + c) = v; }
            else if (c < 1024) *(GAS unsigned long long*)(Qb + (size_t)r * 512 + c - 512) = sk::pk4(v * QSCALE);
            else if (c < 1536) { *(GAS unsigned long long*)(Kb + (size_t)r * 512 + c - 1024) = sk::pk4(v); *(GAS f32x4*)(out + O_KS + (size_t)rs * 512 + c - 1024) = v; }
            else if (c < 2048) { *(GAS unsigned long long*)(Vb + (size_t)r * 512 + c - 1536) = sk::pk4(v); *(GAS f32x4*)(out + O_VS + (size_t)rs * 512 + c - 1536) = v; }
            else { const f32x4 bg = *(const GAS f32x4*)(b_gate + c - 2048); *(GAS unsigned*)((unsigned char*)Gb + (size_t)r * 2048 + c - 2048) = pg8::pk_u8x4(pg8::sigm4(v + bg)); } }
        }
        } else {
        pg8::Gemm g{XN, WIN, MP, INW, DM}; pg8::RotOrder S; S.init(MP, INW, G, bx, DBG_ROT);
        pg8::EpiIn E{Ub, Qb, Kb, Vb, Gb, b_gate, out + O_KP, out + O_VP, out + O_KS, out + O_VS, out + O_POOLP, out + O_POOLS};
        pg8::gemm_phase<pg8::EpiIn, pg8::RotOrder, DBG_ALIGN, DBG_SP2>(L + RING_OFF, g, S, E);
        }
#ifdef DBG_PREDELAY
        { const unsigned long long t0_ = __builtin_amdgcn_s_memrealtime(); while (__builtin_amdgcn_s_memrealtime() - t0_ < DBG_PREDELAY) __builtin_amdgcn_s_sleep(16); __syncthreads(); }
#endif
#ifdef DBG_PREFENCE
        __threadfence(); __syncthreads();
#endif
    }
    SEAM(1);
#ifdef DBG_GDUMP
#ifndef DBG_DUMPBUF
#define DBG_DUMPBUF WS_G
#define DBG_DUMPLD 2048
#endif
    for (int it = (vcu * NWAVES * 64 + (int)threadIdx.x); it < MT * 128; it += G * NWAVES * 64) {
        const int m = it >> 7, c = (it & 127) * 8; const v4u w = *(const GAS v4u*)((const bf16*)(ws + DBG_DUMPBUF) + (size_t)m * DBG_DUMPLD + ((DBG_GDUMP + c) % DBG_DUMPLD)); f32x4 a, b; pg8::unpack8(w, a, b);
        *(GAS f32x4*)(Yo + (size_t)m * 1024 + c) = a; *(GAS f32x4*)(Yo + (size_t)m * 1024 + c + 4) = b; }
#endif
#ifdef DBG_DELAY
    { const unsigned long long t0_ = __builtin_amdgcn_s_memrealtime(); while (__builtin_amdgcn_s_memrealtime() - t0_ < DBG_DELAY) __builtin_amdgcn_s_sleep(16); __syncthreads(); }
#endif
#ifndef DBG_SKIP_P2
#define DBG_SKIP_P2 0
#endif
    if (IN(2) && (DBG_SKIP_P2 & 8)) {
        for (int it = (vcu * NWAVES * 64 + (int)threadIdx.x); it < MT * 64; it += G * NWAVES * 64) {
            const int m = it >> 6, c = (it & 63) * 8; f32x4 a, b;
            for (int e = 0; e < 4; ++e) { a[e] = (float)(((m * 31 + (c + e) * 17) & 255) - 128) * (1.0f / 128.0f); b[e] = (float)(((m * 13 + (c + 4 + e) * 29) & 255) - 128) * (1.0f / 128.0f); }
            *(GAS v4u*)(Yb + (size_t)m * 512 + c) = pg8::pack8(a, b); *(GAS v4u*)(YSB + (size_t)m * 512 + c) = pg8::pack8(b, a);
            if (DBG_SKIP_P2 & 16) { *(GAS v4u*)(MG + (size_t)m * 1024 + c) = pg8::pack8(a, b); *(GAS v4u*)(MG + (size_t)m * 1024 + 512 + c) = pg8::pack8(b, a); }
        }
    }
#pragma unroll 1
    for (int rep_ = 0; rep_ < ((IN(2) && !(DBG_SKIP_P2 & 12)) ? ((DBG_REPEAT == 2) ? 2 : 1) : 0); ++rep_) {
        if (rep_ > 0) xcd_barrier(bar);
        FRESH_TID();
        const bool do_pool_ = (rep_ == 0) || DBG_P2PART == 0 || DBG_P2PART == 1, do_att_ = (rep_ == 0) || DBG_P2PART == 0 || DBG_P2PART == 2, do_sam_ = (rep_ == 0) || DBG_P2PART == 0 || DBG_P2PART == 3;
        if (do_pool_)
        for (int wi = wave * G + vcu; wi < 4 * (MT / 64); wi += NGW) { const int g = wi & 3, run = (wi >> 2) * 4 + (lane >> 4), c = g * 128 + (lane & 15) * 8;
            if (g == 0) pool_run<2, 16>(Ub, state_pool, Yb, run, c); else if (g == 1) pool_run<4, 16>(Ub, state_pool, Yb, run, c); else if (g == 2) pool_run<8, 16>(Ub, state_pool, Yb, run, c);
            else { pool_run<16, 8>(Ub, state_pool, Yb, 2 * run, c); asm volatile("" ::: "memory"); pool_run<16, 8>(Ub, state_pool, Yb, 2 * run + 1, c); } }
        const sba::Tensors T{Qb, Kb, Vb, YSB, cache_k, cache_v};
        if (do_att_) {
#pragma unroll 1
        for (int i2 = 2 * vcu; i2 < 512; i2 += ((i2 & 1) ? 2 * G - 1 : 1)) { const int i = i2 >> 1, bh = i >> 2, s = i & 3;
            sba::sb_unit<false>(bh >> 3, bh & 7, (i2 & 1) ? 7 - s : s, T, (SB_LAS char*)(L + RING_OFF)); }
        }
        if (do_sam_) {
        for (int i = G - 1 - vcu; i < 128; i += G) sba::sb_unit<true>(i >> 3, i & 7, 0, T, (SB_LAS char*)(L + RING_OFF));
        }
    }
    SEAM(2);
#pragma unroll 1
    for (int rep_ = 0; rep_ < ((IN(3) && !(DBG_SKIP_P2 & 16)) ? ((DBG_REPEAT == 3) ? 2 : 1) : 0); ++rep_) {
        if (rep_ > 0) xcd_barrier(bar);
#pragma unroll 1
        for (int pass_ = 0; pass_ < 2; ++pass_) if ((pass_ == 1) == late_) {
        for (int task = vcu; task < 16 * (DM / 64); task += G) { const int rb = task & 15, col0 = (task >> 4) * 64;
            const f32x4 va = sk::tile(Yb, WEFF, PW, (size_t)MP + rb * 32, col0, (SK_LAS char*)(L + RING_OFF));
            const f32x4 vb = sk::tile(YSB, WSB, SBW, (size_t)MP + rb * 32, col0, (SK_LAS char*)(L + RING_OFF));
            const int t = threadIdx.x, r = MP + rb * 32 + (t >> 4), c = col0 + (t & 15) * 4;
            const f32x4 ga = pg8::up_u8x4(*(const GAS unsigned*)((const unsigned char*)Gb + (size_t)r * 2048 + c)), gb = pg8::up_u8x4(*(const GAS unsigned*)((const unsigned char*)Gb + (size_t)r * 2048 + 1024 + c));
            *(GAS unsigned long long*)(MG + (size_t)r * 1024 + c) = sk::pk4(ga * va + gb * vb);
        }
        } else {
        { pg8::Gemm g{Yb, WEFF, MP, DM, PW, YSB, WSB}; pg8::PairOrder S; S.init(MP, DM, G, bx); pg8::EpiMerge E{Gb, MG};
          pg8::gemm_phase<pg8::EpiMerge, pg8::PairOrder, DBG_ALIGN, DBG_SP2>(L + RING_OFF, g, S, E); }
        }
    }
    SEAM(3);
#pragma unroll 1
    for (int rep_ = 0; rep_ < ((IN(4)) ? ((DBG_REPEAT == 4) ? 2 : 1) : 0); ++rep_) {
        if (rep_ > 0) xcd_barrier(bar);
#pragma unroll 1
        for (int pass_ = 0; pass_ < 2; ++pass_) if ((pass_ == 1) == late_) {
        for (int task = vcu; task < 16 * (DM / 64); task += G) { const int rb = task & 15, col0 = (task >> 4) * 64;
            const f32x4 v = sk::tile(MG, WOUT, DM, (size_t)MP + rb * 32, col0, (SK_LAS char*)(L + RING_OFF));
            const int t = threadIdx.x, rs = rb * 32 + (t >> 4), r = MP + rs, c = col0 + (t & 15) * 4;
            const f32x4 x1 = *(const GAS f32x4*)(x_s + (size_t)rs * DM + c) + v; *(GAS unsigned long long*)(Xb + (size_t)r * DM + c) = sk::pk4(x1);
            *(GAS unsigned long long*)(XN + (size_t)r * DM + c) = sk::pk4(x1 * *(const GAS f32x4*)(g_mlp + c));
            const float ss = sk::sum16(pg8::dot4(x1)); if ((t & 15) == 0) SSQ1[(size_t)r * 16 + (col0 >> 6)] = ss;
        }
        } else {
        pg8::Gemm g{MG, WOUT, MP, DM, DM}; pg8::StaticOrder S; S.init(MP, DM, G, bx); pg8::EpiResid<true> E{x_p, Xb, XN, g_mlp, SSQ1};
        pg8::gemm_phase<pg8::EpiResid<true>, pg8::StaticOrder, DBG_ALIGN, DBG_SP2>(L + RING_OFF, g, S, E);
        }
    }
    SEAM(4);
#pragma unroll 1
    for (int rep_ = 0; rep_ < ((IN(5)) ? ((DBG_REPEAT == 5) ? 2 : 1) : 0); ++rep_) {
        if (rep_ > 0) xcd_barrier(bar);
#pragma unroll 1
        for (int pass_ = 0; pass_ < 2; ++pass_) if ((pass_ == 1) == late_) {
        for (int task = vcu; task < 16 * (DFF / 256); task += G) { const int rb = task & 15, col0 = (task >> 4) * 256; f32x4 vv[2][2];
            sk::tile4(XN, WUP, DM, (size_t)MP + rb * 32, col0, (SK_LAS char*)(L + RING_OFF), vv);
            const int t = threadIdx.x, r = MP + rb * 32 + (t >> 4); const float rs_ = sk::rstd16(SSQ1, r, t);
#pragma unroll
            for (int h = 0; h < 2; ++h)
#pragma unroll
                for (int q = 0; q < 2; ++q) { const int c = col0 + 128 * h + 64 * q + (t & 15) * 4; const f32x4 a = __builtin_elementwise_max(vv[h][q] * rs_, (f32x4){0.f, 0.f, 0.f, 0.f});
                    *(GAS unsigned long long*)(Hb + (size_t)r * DFF + c) = sk::pk4(a * a); }
        }
        } else {
        pg8::Gemm g{XN, WUP, MP, DFF, DM}; pg8::StaticOrder S; S.init(MP, DFF, G, bx); pg8::EpiUp E{SSQ1, Hb};
        pg8::gemm_phase<pg8::EpiUp, pg8::StaticOrder, DBG_ALIGN, DBG_SP2>(L + RING_OFF, g, S, E);
        }
    }
    SEAM(5);
    if (IN(5) && DBG_REPEAT == 15) {
        { pg8::Gemm g{XN, WUP, MP, DFF, DM}; pg8::StaticOrder S; S.init(MP, DFF, G, bx); pg8::EpiNull E{SSQ3};
          pg8::gemm_phase<pg8::EpiNull, pg8::StaticOrder, DBG_ALIGN, DBG_SP2>(L + RING_OFF, g, S, E); }
        xcd_barrier(bar);
    }
    if (IN(5) && DBG_REPEAT == 25) {
        for (int task = vcu; task < 16 * (DFF / 256); task += G) { const int rb = task & 15, col0 = (task >> 4) * 256; f32x4 vv[2][2];
            sk::tile4(XN, WUP, DM, (size_t)MP + rb * 32, col0, (SK_LAS char*)(L + RING_OFF), vv); if (vv[0][0][0] + vv[1][1][0] + vv[0][1][0] + vv[1][0][0] == 1.2345e33f) SSQ3[0] = vv[0][0][1]; }
        xcd_barrier(bar);
    }
    if (IN(6) && DBG_REPEAT == 6) {
        { pg8::Gemm g{Hb, WDOWN, MP, DM, DFF}; pg8::StaticOrder S; S.init(MP, DM, G, bx); pg8::EpiNull E{SSQ3};
          pg8::gemm_phase<pg8::EpiNull, pg8::StaticOrder, DBG_ALIGN, DBG_SP2>(L + RING_OFF, g, S, E); }
        xcd_barrier(bar);
    }
    if (IN(6) && DBG_REPEAT == 16) {
        for (int task = vcu; task < 16 * (DM / 64); task += G) { const int rb = task & 15, col0 = (task >> 4) * 64;
            const f32x4 v = sk::tile(Hb, WDOWN, DFF, (size_t)MP + rb * 32, col0, (SK_LAS char*)(L + RING_OFF)); if (v[0] == 1.2345e33f) SSQ3[0] = v[1]; }
        xcd_barrier(bar);
    }
    if (IN(6)) {
#pragma unroll 1
        for (int pass_ = 0; pass_ < 2; ++pass_) if ((pass_ == 1) == late_) {
        for (int task = vcu; task < 16 * (DM / 64); task += G) { const int rb = task & 15, col0 = (task >> 4) * 64;
            const f32x4 v = sk::tile(Hb, WDOWN, DFF, (size_t)MP + rb * 32, col0, (SK_LAS char*)(L + RING_OFF));
            const int t = threadIdx.x, r = MP + rb * 32 + (t >> 4), c = col0 + (t & 15) * 4;
            const f32x4 x2 = sk::up4(*(const GAS unsigned long long*)(Xb + (size_t)r * DM + c)) + v; *(GAS unsigned long long*)(Xb + (size_t)r * DM + c) = sk::pk4(x2);
            *(GAS unsigned long long*)(XN + (size_t)r * DM + c) = sk::pk4(x2 * *(const GAS f32x4*)(g_ple + c));
            const float ss = sk::sum16(pg8::dot4(x2)); if ((t & 15) == 0) SSQ2[(size_t)r * 16 + (col0 >> 6)] = ss;
        }
        } else {
        { pg8::Gemm g{Hb, WDOWN, MP, DM, DFF}; pg8::StaticOrder S; S.init(MP, DM, G, bx); pg8::EpiResid<false> E{nullptr, Xb, XN, g_ple, SSQ2};
          pg8::gemm_phase<pg8::EpiResid<false>, pg8::StaticOrder, DBG_ALIGN, DBG_SP2>(L + RING_OFF, g, S, E); }
        }
    }
    SEAM(6);
    if (IN(7) && DBG_REPEAT == 7) {
        { pg8::Gemm g{PB, WPP, MP, DM, PLE}; pg8::StaticOrder S; S.init(MP, DM, G, bx); pg8::EpiNull E{SSQ3};
          pg8::gemm_phase<pg8::EpiNull, pg8::StaticOrder, DBG_ALIGN, DBG_SP2>(L + RING_OFF, g, S, E); }
        { pg8::Gemm g{XN, WPG, MP, DM, DM}; pg8::StaticOrder S; S.init(MP, DM, G, bx); pg8::EpiNull E{SSQ3};
          pg8::gemm_phase<pg8::EpiNull, pg8::StaticOrder, DBG_ALIGN, DBG_SP2>(L + RING_OFF, g, S, E); }
        xcd_barrier(bar);
    }
    if (IN(7) && DBG_REPEAT == 17) {
        for (int task = vcu; task < 16 * (DM / 64); task += G) { const int rb = task & 15, col0 = (task >> 4) * 64;
            const f32x4 vp = sk::tile(PB, WPP, PLE, (size_t)MP + rb * 32, col0, (SK_LAS char*)(L + RING_OFF));
            const f32x4 vg = sk::tile(XN, WPG, DM, (size_t)MP + rb * 32, col0, (SK_LAS char*)(L + RING_OFF)); if (vp[0] + vg[0] == 1.2345e33f) SSQ3[0] = vp[1]; }
        xcd_barrier(bar);
    }
    if (IN(7) && DBG_REPEAT == 27) {
        { pg8::Gemm g{PB, WPP, MP, DM, PLE}; pg8::StaticOrder S; S.init(MP, DM, G, bx); pg8::EpiPP E{PPb};
          pg8::gemm_phase<pg8::EpiPP, pg8::StaticOrder, DBG_ALIGN, DBG_SP2>(L + RING_OFF, g, S, E); }
        xcd_barrier(bar);
    }
    if (IN(7)) {
#pragma unroll 1
        for (int pass_ = 0; pass_ < 2; ++pass_) if ((pass_ == 1) == late_) {
        for (int task = vcu; task < 16 * (DM / 64); task += G) { const int rb = task & 15, col0 = (task >> 4) * 64;
            const f32x4 vp = sk::tile(PB, WPP, PLE, (size_t)MP + rb * 32, col0, (SK_LAS char*)(L + RING_OFF));
            const f32x4 vg = sk::tile(XN, WPG, DM, (size_t)MP + rb * 32, col0, (SK_LAS char*)(L + RING_OFF));
            const int t = threadIdx.x, r = MP + rb * 32 + (t >> 4), c = col0 + (t & 15) * 4;
            const float rs_ = sk::rstd16(SSQ2, r, t);
            const f32x4 x3 = sk::up4(*(const GAS unsigned long long*)(Xb + (size_t)r * DM + c)) + pg8::sigm4(vg * rs_) * vp;
            const float ss = sk::sum16(pg8::dot4(x3)); if ((t & 15) == 0) __hip_atomic_store(SSQ3 + (size_t)r * 16 + (col0 >> 6), ss, __ATOMIC_RELAXED, __HIP_MEMORY_SCOPE_AGENT);
            asm volatile("s_waitcnt vmcnt(0)" ::: "memory");
            unsigned* cw = (unsigned*)(ctl + CW_FINS + 64 * rb);
            if ((t & 63) == 0) __hip_atomic_fetch_add(cw, 1u, __ATOMIC_RELAXED, __HIP_MEMORY_SCOPE_AGENT);
            { unsigned spins = 0; while ((unsigned)__builtin_amdgcn_readfirstlane(__hip_atomic_load(cw, __ATOMIC_RELAXED, __HIP_MEMORY_SCOPE_AGENT)) < 128u) { __builtin_amdgcn_s_sleep(2); if (++spins > (1u << 16)) break; } }
            const float r3 = __builtin_amdgcn_rsqf(sk::sum16(__hip_atomic_load(SSQ3 + (size_t)r * 16 + (t & 15), __ATOMIC_RELAXED, __HIP_MEMORY_SCOPE_AGENT)) * (1.0f / 1024.0f) + EPS);
            *(GAS f32x4*)(Yo + (size_t)r * DM + c) = x3 * r3 * *(const GAS f32x4*)(g_final + c);
        }
        } else {
        { pg8::Gemm g{PB, WPP, MP, DM, PLE}; pg8::StaticOrder S; S.init(MP, DM, G, bx); pg8::EpiPP E{PPb};
          pg8::gemm_phase<pg8::EpiPP, pg8::StaticOrder, DBG_ALIGN, DBG_SP2>(L + RING_OFF, g, S, E); }
        { pg8::Gemm g{XN, WPG, MP, DM, DM}; pg8::StaticOrder S; S.init(MP, DM, G, bx); pg8::EpiPleFinal E{SSQ2, PPb, Xb, Yo, SSQ3, g_final, (unsigned*)(ctl + CW_FIN)};
          pg8::gemm_phase<pg8::EpiPleFinal, pg8::StaticOrder, DBG_ALIGN, DBG_SP2>(L + RING_OFF, g, S, E); }
        }
    }
#undef IN
#undef SEAM
}

extern "C" void kernel_launch(void* const* d_in, const int* in_sizes, int n_in, void* d_out, int out_size, void* d_ws, size_t ws_size, hipStream_t stream) {
    static int grid = 0;
    if (grid == 0) {
        if (n_in != 22 || out_size != (int)O_END || ws_size < WS_END) { fprintf(stderr, "kernel_launch: unexpected sizes: n_in %d out %d ws %zu\n", n_in, out_size, ws_size); grid = -1; return; }
        int dev = 0, cus = 0, per_cu = 0;
        if (hipGetDevice(&dev) != hipSuccess || hipDeviceGetAttribute(&cus, hipDeviceAttributeMultiprocessorCount, dev) != hipSuccess) { grid = -1; return; }
        if (hipFuncSetAttribute((const void*)mega_fwd, hipFuncAttributeMaxDynamicSharedMemorySize, LDS_BYTES) != hipSuccess) { fprintf(stderr, "kernel_launch: hipFuncSetAttribute failed\n"); grid = -1; return; }
        if (hipOccupancyMaxActiveBlocksPerMultiprocessor(&per_cu, (const void*)mega_fwd, NWAVES * 64, LDS_BYTES) != hipSuccess || per_cu < 1) { fprintf(stderr, "kernel_launch: occupancy query says %d\n", per_cu); (void)hipGetLastError(); per_cu = 1; }
        grid = cus;
    }
    if (grid < 0) return;
    (void)hipMemsetAsync((char*)d_ws + WS_CTL, 0, CTL_ZERO_BYTES, stream);
    Args a{};
    for (int i = 0; i < 22; ++i) a.in[i] = (const float*)d_in[i];
    a.out = (float*)d_out; a.ws = (unsigned char*)d_ws;
#ifndef DBG_PH_HI
#define DBG_PH_HI N_PHASES
#endif
    if (MK_N_LAUNCHES == 1) { a.ph_lo = 0; a.ph_hi = DBG_PH_HI; a.li = 0; hipLaunchKernelGGL(mega_fwd, dim3(grid), dim3(NWAVES * 64), LDS_BYTES, stream, a); }
    else for (int li = 0; li < N_PHASES; ++li) { a.ph_lo = li; a.ph_hi = li + 1; a.li = li; hipLaunchKernelGGL(mega_fwd, dim3(grid), dim3(NWAVES * 64), LDS_BYTES, stream, a);
#if defined(HYB_ATTN)
        if (li == 2) hyb_attn<<<(MT * NH + 63) / 64, 64, 0, stream>>>((const unsigned short*)((char*)d_ws + WS_Q), (const unsigned short*)((char*)d_ws + WS_K), (const unsigned short*)((char*)d_ws + WS_V), (const float*)d_in[2], (const float*)d_in[3], (unsigned short*)((char*)d_ws + WS_YSB));
#endif
#if defined(HYB_POOL)
        if (li == 2) hyb_pool<<<(int)(((size_t)MT * PW + 255) / 256), 256, 0, stream>>>((const unsigned short*)((char*)d_ws + WS_U), (const float*)d_in[4], (unsigned short*)((char*)d_ws + WS_Y));
#endif
    }
}
```

```cpp
#include <hip/hip_runtime.h>
#include <hip/hip_bf16.h>
#include <cstdio>
#include <cstdint>
#include <cmath>
namespace cfg {
constexpr int DM = 1024, NB = 8, SEQ = 2048, DB = 16, DS = 32, PAST = 1024, PW = 512, SBW = 512, HD = 64, NH = 8, DFF = 4096, PLE = 256, INW = 4096;
constexpr int MP = NB * SEQ, MS = DB * DS, MT = MP + MS;
constexpr float EPS = 1e-6f;
constexpr float QSCALE = 0.125f * 1.4426950408889634f;
}
namespace pg8 {
#define PG8_LAS __attribute__((address_space(3)))
typedef unsigned short bf16_t;
typedef short bf16x8 __attribute__((ext_vector_type(8)));
typedef float f32x4 __attribute__((ext_vector_type(4)));
typedef unsigned u32x4 __attribute__((ext_vector_type(4)));
constexpr int BM = 256, BK = 64, HALF = 128, HTB = HALF * BK * 2  , STAGE_BYTES = 8 * HTB, NXCD = 8, WGM = 8;

__host__ __device__ __forceinline__ int lds_byte(int r, int c) { const int st = (r >> 4) * 2 + (c >> 5), rr = r & 15, cc = c & 31, ob = rr * 64 + cc * 2; return st * 1024 + (ob ^ (((ob >> 9) & 1) << 5)); }
__host__ __device__ __forceinline__ void stage_rc(int b, int& R, int& C) { const int st = b / 1024, sb = b % 1024, swz = sb ^ (((sb >> 9) & 1) << 5); R = (st >> 1) * 16 + swz / 64; C = (st & 1) * 32 + (swz % 64) / 2; }
__host__ __device__ __forceinline__ int perm32(int rho) { const int n = rho >> 4, i = rho & 15; return 8 * (i >> 2) + 4 * n + (i & 3); }

struct Unit { int pm, pn, seg; };
struct Gemm { const bf16_t* A; const bf16_t* Bt; int M, N, K; const bf16_t* A1 = nullptr; const bf16_t* Bt1 = nullptr; };

struct StaticOrder {
    int nM, nN, nwg, G, c;
    __host__ __device__ void init(int M, int N, int G_, int c_) { nM = M / BM; nN = N / BM; nwg = nM * nN; G = G_; c = c_; }
    __host__ __device__ bool next(int i, Unit& u) const {
        const long L = (long)i * G + c; if (L >= nwg) return false;
        int wgid = (int)L; { const int q = nwg / NXCD, r = nwg % NXCD, xcd = wgid % NXCD, off = wgid / NXCD; wgid = (xcd < r ? xcd * (q + 1) : r * (q + 1) + (xcd - r) * q) + off; }
        const int nig = WGM * nN, gid = wgid / nig, fm = gid * WGM, gsz = (nM - fm) < WGM ? (nM - fm) : WGM;
        u.pm = fm + ((wgid % nig) % gsz); u.pn = (wgid % nig) / gsz; u.seg = 0; return true;
    }
    __device__ __forceinline__ void a_ready(const Unit&) const {}
    __device__ __forceinline__ void done(const Unit&) const {}
};
struct RotOrder : StaticOrder {
    int rot, cnt;
    __host__ __device__ void init(int M, int N, int G_, int c_, int rot_) { StaticOrder::init(M, N, G_, c_); cnt = (nwg % G_ == 0) ? nwg / G_ : 0; rot = rot_; }
    __host__ __device__ bool next(int i, Unit& u) const { if (cnt == 0) return StaticOrder::next(i, u); if (i >= cnt) return false; return StaticOrder::next((i + rot) % cnt, u); }
};
struct PairOrder : StaticOrder {
    __host__ __device__ bool next(int i, Unit& u) const { if (!StaticOrder::next(i >> 1, u)) return false; u.seg = i & 1; return true; }
};
typedef float f32x2v_t __attribute__((ext_vector_type(2))); typedef __bf16 bf16x2v_t __attribute__((ext_vector_type(2)));
__device__ __forceinline__ unsigned cvt_pk_bf16(float lo, float hi) { f32x2v_t v = {lo, hi}; bf16x2v_t b = __builtin_convertvector(v, bf16x2v_t); return __builtin_bit_cast(unsigned, b); }
typedef float f32x2 __attribute__((ext_vector_type(2)));
__device__ __forceinline__ float bf_lo(unsigned w) { return __uint_as_float(w << 16); }
__device__ __forceinline__ float bf_hi(unsigned w) { return __uint_as_float(w & 0xffff0000u); }
__device__ __forceinline__ u32x4 pack8(f32x4 a, f32x4 b) { u32x4 w; w.x = cvt_pk_bf16(a[0], a[1]); w.y = cvt_pk_bf16(a[2], a[3]); w.z = cvt_pk_bf16(b[0], b[1]); w.w = cvt_pk_bf16(b[2], b[3]); return w; }
__device__ __forceinline__ void unpack8(u32x4 w, f32x4& a, f32x4& b) { a = (f32x4){bf_lo(w.x), bf_hi(w.x), bf_lo(w.y), bf_hi(w.y)}; b = (f32x4){bf_lo(w.z), bf_hi(w.z), bf_lo(w.w), bf_hi(w.w)}; }
__device__ __forceinline__ float sigm(float x) { return __builtin_amdgcn_rcpf(1.f + __builtin_amdgcn_exp2f(-1.4426950408889634f * x)); }
__device__ __forceinline__ f32x4 sigm4(f32x4 x) { return (f32x4){sigm(x[0]), sigm(x[1]), sigm(x[2]), sigm(x[3])}; }
__device__ __forceinline__ float dot4(f32x4 a) { return (a[0] * a[0] + a[1] * a[1]) + (a[2] * a[2] + a[3] * a[3]); }
#ifndef DBG_LDAUX
#define DBG_LDAUX 16
#endif
__device__ __forceinline__ u32x4 ld16_sc1(const void* base, size_t byte_off) {
    const __amdgpu_buffer_rsrc_t rs = __builtin_amdgcn_make_buffer_rsrc((void*)base, (short)0, 0x7fffffff, 0x00020000);
    return __builtin_bit_cast(u32x4, __builtin_amdgcn_raw_buffer_load_b128(rs, (unsigned)byte_off, 0, DBG_LDAUX));
}
__device__ __forceinline__ unsigned pk_u8x4(f32x4 g) { unsigned w = 0u; w = __builtin_amdgcn_cvt_pk_u8_f32(g[0] * 255.0f, 0, w); w = __builtin_amdgcn_cvt_pk_u8_f32(g[1] * 255.0f, 1, w); w = __builtin_amdgcn_cvt_pk_u8_f32(g[2] * 255.0f, 2, w); w = __builtin_amdgcn_cvt_pk_u8_f32(g[3] * 255.0f, 3, w); return w; }
__device__ __forceinline__ f32x4 up_u8x4(unsigned w) { return (f32x4){(float)(w & 0xffu), (float)((w >> 8) & 0xffu), (float)((w >> 16) & 0xffu), (float)(w >> 24)} * (1.0f / 255.0f); }
typedef unsigned u32x2 __attribute__((ext_vector_type(2)));
__device__ __forceinline__ float row_rstd(const float* SSQ, int r, int fq) {
    const f32x4 p = *(const f32x4*)(SSQ + (size_t)r * 16 + 4 * fq); float s = (p[0] + p[1]) + (p[2] + p[3]);
    s += __shfl_xor(s, 16); s += __shfl_xor(s, 32);
    return __builtin_amdgcn_rsqf(s * (1.0f / 1024.0f) + cfg::EPS);
}
#define PG8_ROWS(...) _Pragma("unroll") for (int ai = 0; ai < 2; ++ai) _Pragma("unroll") for (int m = 0; m < 4; ++m) { const int r = u.pm * BM + ai * HALF + wr * 64 + m * 16 + fr; __VA_ARGS__; if (m == 3) asm volatile("" ::: "memory"); }
#define PG8_COLS(...) _Pragma("unroll") for (int bj = 0; bj < 2; ++bj) { const int c = ct + bj * HALF + wc * 32 + 8 * fq; const f32x4 v0 = acc[ai][bj][m][0], v1 = acc[ai][bj][m][1]; __VA_ARGS__; }

struct EpiIn {
    static constexpr bool PERM = true, AFTER_DRAIN = false;
    bf16_t *U, *Q, *K, *V, *G; const float* b_gate; float *k_p, *v_p, *k_s, *v_s, *pool_p, *pool_s;
    __device__ __forceinline__ void operator()(const f32x4 (&acc)[2][2][4][2], const Unit& u, int wr, int wc, int fr, int fq) const {
        const int pn = u.pn;
        if (pn >= 8) {
            const int ct = (pn - 8) * BM; f32x4 bv[2][2];
#pragma unroll
            for (int bj = 0; bj < 2; ++bj) { const int c = ct + bj * HALF + wc * 32 + 8 * fq; bv[bj][0] = *(const f32x4*)(b_gate + c); bv[bj][1] = *(const f32x4*)(b_gate + c + 4); }
            PG8_ROWS(PG8_COLS(*(u32x2*)((unsigned char*)G + (size_t)r * 2048 + c) = (u32x2){pk_u8x4(sigm4(v0 + bv[bj][0])), pk_u8x4(sigm4(v1 + bv[bj][1]))}))
        } else if (pn >= 4) {
            const bool isv = pn >= 6; const int ct = (pn - (isv ? 6 : 4)) * BM; bf16_t* B = isv ? V : K; float* op = isv ? v_p : k_p; float* os = isv ? v_s : k_s;
            PG8_ROWS(float* orow = r < cfg::MP ? op + (size_t)r * 512 : os + (size_t)(r - cfg::MP) * 512;
                     PG8_COLS(*(u32x4*)(B + (size_t)r * 512 + c) = pack8(v0, v1); __builtin_nontemporal_store(v0, (f32x4*)(orow + c)); __builtin_nontemporal_store(v1, (f32x4*)(orow + c + 4))))
        } else if (pn >= 2) {
            const int ct = (pn - 2) * BM;
            PG8_ROWS(PG8_COLS(*(u32x4*)(Q + (size_t)r * 512 + c) = pack8(v0 * cfg::QSCALE, v1 * cfg::QSCALE)))
        } else {
            const int ct = pn * BM;
            PG8_ROWS(float* prow = nullptr;
                     if (r < cfg::MP) { const int t = r & (cfg::SEQ - 1); if (t >= cfg::SEQ - 15) prow = pool_p + ((size_t)(r >> 11) * 15 + (t - (cfg::SEQ - 15))) * 512; }
                     else { const int i = (r - cfg::MP) & 31; if (i >= 17) prow = pool_s + ((size_t)((r - cfg::MP) >> 5) * 15 + (i - 17)) * 512; }
                     PG8_COLS(*(u32x4*)(U + (size_t)r * 512 + c) = pack8(v0, v1); if (prow) { *(f32x4*)(prow + c) = v0; *(f32x4*)(prow + c + 4) = v1; }))
        }
    }
};
#if defined(DBG_ONLYG)
#define DBG_NOG_STMT *(u32x4*)(MG + (size_t)r * 1024 + c) = gw; continue;
#elif defined(DBG_NOG)
#define DBG_NOG_STMT g0 = (f32x4){0.5f, 0.5f, 0.5f, 0.5f}; g1 = g0;
#else
#define DBG_NOG_STMT
#endif
struct EpiMerge;
struct EpiMerge0 {
    static constexpr bool PERM = true, AFTER_DRAIN = false;
    const bf16_t* G; bf16_t* MG;
    __device__ __forceinline__ void operator()(const f32x4 (&acc)[2][2][4][2], const Unit& u, int wr, int wc, int fr, int fq) const {
        const int ct = u.pn * BM;
        PG8_ROWS(PG8_COLS(const u32x2 gw = *(const u32x2*)((const unsigned char*)G + (size_t)r * 2048 + c); const f32x4 g0 = up_u8x4(gw.x); const f32x4 g1 = up_u8x4(gw.y); *(u32x4*)(MG + (size_t)r * 1024 + c) = pack8(v0 * g0, v1 * g1)))
    }
};
#ifdef DBG_NORAW
#define DBG_NORAW_STMT m0 = (f32x4){0.f, 0.f, 0.f, 0.f}; m1 = m0;
#else
#define DBG_NORAW_STMT
#endif
struct EpiMerge1 {
    static constexpr bool PERM = true, AFTER_DRAIN = false;
    const bf16_t* G; bf16_t* MG;
    __device__ __forceinline__ void operator()(const f32x4 (&acc)[2][2][4][2], const Unit& u, int wr, int wc, int fr, int fq) const {
        const int ct = u.pn * BM;
        PG8_ROWS(PG8_COLS(const u32x2 gw = *(const u32x2*)((const unsigned char*)G + (size_t)r * 2048 + 1024 + c); const u32x4 mw = *(const u32x4*)(MG + (size_t)r * 1024 + c);
                          const f32x4 g0 = up_u8x4(gw.x); const f32x4 g1 = up_u8x4(gw.y); f32x4 m0; f32x4 m1; unpack8(mw, m0, m1); *(u32x4*)(MG + (size_t)r * 1024 + c) = pack8(m0 + v0 * g0, m1 + v1 * g1)))
    }
};
struct EpiMerge {
    static constexpr bool PERM = true, AFTER_DRAIN = false;
    const bf16_t* G; bf16_t* MG;
    __device__ __forceinline__ void operator()(const f32x4 (&acc)[2][2][4][2], const Unit& u, int wr, int wc, int fr, int fq) const {
        if (u.seg == 0) { const EpiMerge0 E0{G, MG}; E0(acc, u, wr, wc, fr, fq); } else { const EpiMerge1 E1{G, MG}; E1(acc, u, wr, wc, fr, fq); }
    }
};
template <bool F32RES>
struct EpiResid {
    static constexpr bool PERM = true, AFTER_DRAIN = false;
    const float* res_p; bf16_t* X; bf16_t* XG; const float* gvec; float* SSQ;
    __device__ __forceinline__ void operator()(const f32x4 (&acc)[2][2][4][2], const Unit& u, int wr, int wc, int fr, int fq) const {
        const int ct = u.pn * BM; f32x4 gv[2][2];
#pragma unroll
        for (int bj = 0; bj < 2; ++bj) { const int c = ct + bj * HALF + wc * 32 + 8 * fq; gv[bj][0] = *(const f32x4*)(gvec + c); gv[bj][1] = *(const f32x4*)(gvec + c + 4); }
        PG8_ROWS(float s = 0.f;
                 PG8_COLS(f32x4 a; f32x4 b;
                          if (F32RES) { a = __builtin_nontemporal_load((const f32x4*)(res_p + (size_t)r * 1024 + c)); b = __builtin_nontemporal_load((const f32x4*)(res_p + (size_t)r * 1024 + c + 4)); }
                          else { const u32x4 xw = *(const u32x4*)(X + (size_t)r * 1024 + c); unpack8(xw, a, b); }
                          a += v0; b += v1; *(u32x4*)(X + (size_t)r * 1024 + c) = pack8(a, b); s += dot4(a) + dot4(b);
                          *(u32x4*)(XG + (size_t)r * 1024 + c) = pack8(a * gv[bj][0], b * gv[bj][1]))
                 s += __shfl_xor(s, 16); s += __shfl_xor(s, 32); if (fq == 0) SSQ[(size_t)r * 16 + u.pn * 4 + wc] = s)
    }
};
struct EpiUp {
    static constexpr bool PERM = true, AFTER_DRAIN = false;
    const float* SSQ; bf16_t* H;
    __device__ __forceinline__ void operator()(const f32x4 (&acc)[2][2][4][2], const Unit& u, int wr, int wc, int fr, int fq) const {
        const int ct = u.pn * BM; float rsv[2][4];
#pragma unroll
        for (int ai = 0; ai < 2; ++ai)
#pragma unroll
            for (int m = 0; m < 4; ++m) rsv[ai][m] = row_rstd(SSQ, u.pm * BM + ai * HALF + wr * 64 + m * 16 + fr, fq);
        PG8_ROWS(const float rs = rsv[ai][m];
                 PG8_COLS(f32x4 a = v0 * rs; f32x4 b = v1 * rs; a = __builtin_elementwise_max(a, (f32x4){0.f, 0.f, 0.f, 0.f}); b = __builtin_elementwise_max(b, (f32x4){0.f, 0.f, 0.f, 0.f});
                          *(u32x4*)(H + (size_t)r * 4096 + c) = pack8(a * a, b * b)))
    }
};
struct EpiNull {
    static constexpr bool PERM = true, AFTER_DRAIN = false;
    float* sink;
    __device__ __forceinline__ void operator()(const f32x4 (&acc)[2][2][4][2], const Unit& u, int wr, int wc, int fr, int fq) const {
        float s = 0.f;
#pragma unroll
        for (int ai = 0; ai < 2; ++ai)
#pragma unroll
            for (int bj = 0; bj < 2; ++bj)
#pragma unroll
                for (int m = 0; m < 4; ++m)
#pragma unroll
                    for (int n = 0; n < 2; ++n) s += acc[ai][bj][m][n][0] + acc[ai][bj][m][n][3];
        if (s == 1.2345e33f) sink[0] = s;
    }
};
struct EpiPP {
    static constexpr bool PERM = true, AFTER_DRAIN = false;
    bf16_t* PP;
    __device__ __forceinline__ void operator()(const f32x4 (&acc)[2][2][4][2], const Unit& u, int wr, int wc, int fr, int fq) const {
        const int ct = u.pn * BM;
        PG8_ROWS(PG8_COLS(*(u32x4*)(PP + (size_t)r * 1024 + c) = pack8(v0, v1)))
    }
};
struct EpiPleFinal {
    static constexpr bool PERM = true, AFTER_DRAIN = false;
    const float* SSQ; const bf16_t* PP; const bf16_t* X; float* Y; float* SSQo; const float* gfin; unsigned* cnt;
    __device__ __forceinline__ void operator()(f32x4 (&acc)[2][2][4][2], const Unit& u, int wr, int wc, int fr, int fq) const {
        const int ct = u.pn * BM; float rsv[2][4];
#pragma unroll
        for (int ai = 0; ai < 2; ++ai)
#pragma unroll
            for (int m = 0; m < 4; ++m) rsv[ai][m] = row_rstd(SSQ, u.pm * BM + ai * HALF + wr * 64 + m * 16 + fr, fq);
        PG8_ROWS(const float rs = rsv[ai][m]; float s = 0.f;
                 PG8_COLS(const u32x4 pw = *(const u32x4*)(PP + (size_t)r * 1024 + c); f32x4 p0; f32x4 p1; unpack8(pw, p0, p1);
                          const u32x4 xw = *(const u32x4*)(X + (size_t)r * 1024 + c); f32x4 a; f32x4 b; unpack8(xw, a, b); a += sigm4(v0 * rs) * p0; b += sigm4(v1 * rs) * p1;
                          acc[ai][bj][m][0] = a; acc[ai][bj][m][1] = b; s += dot4(a) + dot4(b))
                 s += __shfl_xor(s, 16); s += __shfl_xor(s, 32);
                 if (fq == 0) __hip_atomic_store(SSQo + (size_t)r * 16 + u.pn * 4 + wc, s, __ATOMIC_RELAXED, __HIP_MEMORY_SCOPE_AGENT))
        asm volatile("s_waitcnt vmcnt(0)" ::: "memory");
        unsigned* cw = cnt + 64 * (2 * u.pm + wr);
        if (fr == 0 && fq == 0) __hip_atomic_fetch_add(cw, 1u, __ATOMIC_RELAXED, __HIP_MEMORY_SCOPE_AGENT);
        { unsigned spins = 0;
          while ((unsigned)__builtin_amdgcn_readfirstlane(__hip_atomic_load(cw, __ATOMIC_RELAXED, __HIP_MEMORY_SCOPE_AGENT)) < 16u) { __builtin_amdgcn_s_sleep(2); if (++spins > (1u << 16)) break; } }
        f32x4 gv[2][2];
#pragma unroll
        for (int bj = 0; bj < 2; ++bj) { const int c = ct + bj * HALF + wc * 32 + 8 * fq; gv[bj][0] = *(const f32x4*)(gfin + c); gv[bj][1] = *(const f32x4*)(gfin + c + 4); }
        PG8_ROWS(const f32x4 pq = __builtin_bit_cast(f32x4, ld16_sc1(SSQo, ((size_t)r * 16 + 4 * fq) * 4)); float t = (pq[0] + pq[1]) + (pq[2] + pq[3]); t += __shfl_xor(t, 16); t += __shfl_xor(t, 32);
                 const float r3 = __builtin_amdgcn_rsqf(t * (1.0f / 1024.0f) + cfg::EPS);
                 PG8_COLS(__builtin_nontemporal_store(v0 * r3 * gv[bj][0], (f32x4*)(Y + (size_t)r * 1024 + c)); __builtin_nontemporal_store(v1 * r3 * gv[bj][1], (f32x4*)(Y + (size_t)r * 1024 + c + 4))))
    }
};
struct NoHook { __device__ __forceinline__ void operator()(int) const {} };
template <class Epi, class Sched, bool ALIGN_EPI = false, bool SP2 = false, class Hook = NoHook>
__device__ __forceinline__ void gemm_phase(PG8_LAS unsigned char* lds, const Gemm g, const Sched& S, const Epi& E, const Hook& H = Hook()) {
    int tid = threadIdx.x; asm volatile("" : "+v"(tid));
    const int wid = __builtin_amdgcn_readfirstlane(tid >> 6), lane = tid & 63, wr = wid >> 2, wc = wid & 3, fr = lane & 15, fq = lane >> 4;
    int K = g.K; asm volatile("" : "+s"(K)); const int nt = K / BK;
    unsigned voffA[2], voffB[2];
#pragma unroll
    for (int i = 0; i < 2; ++i) { int R, C; stage_rc(tid * 16 + i * 8192, R, C); const int Rb = Epi::PERM ? ((R & ~31) + perm32(R & 31)) : R;
        voffA[i] = (unsigned)(R * K + C) * 2u; voffB[i] = (unsigned)(Rb * K + C) * 2u; }
    const size_t kstep = (size_t)(BK * 2);
    const size_t hstep = (size_t)HALF * K * 2;
    const size_t tstep = 2 * hstep;
    const size_t bhs = hstep;
    const unsigned ldsw = (unsigned)wid * 1024u;
    const int aoff = lds_byte(wr * 64 + fr, fq * 8), boff = lds_byte(wc * 32 + fr, fq * 8);
#define PG8_SA(b, h) (((b) * 2 + (h)) * HTB)
#define PG8_SB(b, h) ((4 + (b) * 2 + (h)) * HTB)
#define PG8_STAGE(bufoff, gbase, voff) do { _Pragma("unroll") for (int _i = 0; _i < 2; ++_i) \
        __builtin_amdgcn_global_load_lds((const unsigned*)((const char*)(gbase) + (voff)[_i]), (PG8_LAS unsigned*)(lds + (bufoff) + ldsw + _i * 8192), 16, 0, 0); } while (0)
#define PG8_LDA(dst, b, h) do { _Pragma("unroll") for (int m = 0; m < 4; ++m) _Pragma("unroll") for (int k = 0; k < 2; ++k) dst[m][k] = *(const PG8_LAS bf16x8*)(lds + PG8_SA(b, h) + aoff + m * 2048 + k * 1024); } while (0)
#define PG8_LDB(dst, b, h) do { _Pragma("unroll") for (int n = 0; n < 2; ++n) _Pragma("unroll") for (int k = 0; k < 2; ++k) dst[n][k] = *(const PG8_LAS bf16x8*)(lds + PG8_SB(b, h) + boff + n * 2048 + k * 1024); } while (0)
#define PG8_MMA(ai, bj, At, Bt) do { __builtin_amdgcn_s_setprio(1); _Pragma("unroll") for (int m = 0; m < 4; ++m) _Pragma("unroll") for (int n = 0; n < 2; ++n) _Pragma("unroll") for (int k = 0; k < 2; ++k) \
        acc[ai][bj][m][n] = __builtin_amdgcn_mfma_f32_16x16x32_bf16(Bt[n][k], At[m][k], acc[ai][bj][m][n], 0, 0, 0); __builtin_amdgcn_s_setprio(0); } while (0)
#ifdef DRAIN_ALL
#define PG8_WAIT_V(n) asm volatile("s_waitcnt vmcnt(0)" ::: "memory")
#else
#define PG8_WAIT_V(n) asm volatile("s_waitcnt vmcnt(" #n ")" ::: "memory")
#endif
#define PG8_WAIT_L(n) asm volatile("s_waitcnt lgkmcnt(" #n ")" ::: "memory")
#define PG8_BAR __builtin_amdgcn_s_barrier()
#define PG8_SCHED __builtin_amdgcn_sched_barrier(0)
    Unit cur, nxt; int ui = 0;
    if (!S.next(0, cur)) return;
    f32x4 acc[2][2][4][2];
#pragma unroll
    for (int a = 0; a < 2; ++a)
#pragma unroll
        for (int b = 0; b < 2; ++b)
#pragma unroll
            for (int m = 0; m < 4; ++m)
#pragma unroll
                for (int n = 0; n < 2; ++n) acc[a][b][m][n] = (f32x4){0.f, 0.f, 0.f, 0.f};
    bf16x8 At[4][2], B0[2][2], B1[2][2];
    const char* cA = (const char*)(cur.seg ? g.A1 : g.A) + (size_t)cur.pm * tstep; const char* cB = (const char*)(cur.seg ? g.Bt1 : g.Bt) + (size_t)cur.pn * tstep;
    S.a_ready(cur);
    if constexpr (SP2) {
        PG8_STAGE(PG8_SB(0, 0), cB, voffB); PG8_STAGE(PG8_SB(0, 1), cB + bhs, voffB); PG8_STAGE(PG8_SA(0, 0), cA, voffA); PG8_STAGE(PG8_SA(0, 1), cA + hstep, voffA);
        if (wr == 1) PG8_BAR;
        PG8_WAIT_V(2); PG8_BAR;
        PG8_STAGE(PG8_SB(1, 0), cB + kstep, voffB); PG8_STAGE(PG8_SA(1, 0), cA + kstep, voffA); PG8_STAGE(PG8_SB(1, 1), cB + bhs + kstep, voffB);
        PG8_WAIT_V(6); PG8_BAR;
    } else {
        PG8_STAGE(PG8_SB(0, 0), cB, voffB); PG8_STAGE(PG8_SA(0, 0), cA, voffA); PG8_STAGE(PG8_SB(0, 1), cB + bhs, voffB); PG8_STAGE(PG8_SA(0, 1), cA + hstep, voffA);
        if (wr == 1) PG8_BAR;
        PG8_WAIT_V(4); PG8_BAR;
        PG8_STAGE(PG8_SB(1, 0), cB + kstep, voffB); PG8_STAGE(PG8_SA(1, 0), cA + kstep, voffA); PG8_STAGE(PG8_SB(1, 1), cB + bhs + kstep, voffB);
        PG8_WAIT_V(6); PG8_BAR;
    }
    for (;;) {
        const bool has_next = S.next(ui + 1, nxt);
        const char* nA = has_next ? (const char*)(nxt.seg ? g.A1 : g.A) + (size_t)nxt.pm * tstep : cA; const char* nB = has_next ? (const char*)(nxt.seg ? g.Bt1 : g.Bt) + (size_t)nxt.pn * tstep : cB;
        for (int t = 0; t < nt; t += 2) {
            const bool last = (t == nt - 2);
            const char* a1 = cA + (size_t)(t + 1) * kstep;
            const char* a2 = last ? nA : cA + (size_t)(t + 2) * kstep; const char* b2 = last ? nB : cB + (size_t)(t + 2) * kstep;
            const char* a3 = a2 + kstep; const char* b3 = b2 + kstep;
            if (last && has_next) S.a_ready(nxt);
            if constexpr (SP2) {
            PG8_LDB(B0, 0, 0); PG8_LDB(B1, 0, 1); PG8_SCHED; PG8_LDA(At, 0, 0); PG8_STAGE(PG8_SA(1, 1), a1 + hstep, voffA);
            PG8_WAIT_V(8); PG8_WAIT_L(0); PG8_BAR; PG8_MMA(0, 0, At, B0); PG8_MMA(0, 1, At, B1); PG8_BAR; PG8_SCHED;
            PG8_LDA(At, 0, 1); PG8_STAGE(PG8_SB(0, 0), b2, voffB); PG8_STAGE(PG8_SB(0, 1), b2 + bhs, voffB); PG8_STAGE(PG8_SA(0, 0), a2, voffA);
            PG8_WAIT_V(8); PG8_WAIT_L(0); PG8_BAR; PG8_MMA(1, 0, At, B0); PG8_MMA(1, 1, At, B1); PG8_BAR; PG8_SCHED;
            PG8_LDB(B0, 1, 0); PG8_LDB(B1, 1, 1); PG8_SCHED; PG8_LDA(At, 1, 0); PG8_STAGE(PG8_SA(0, 1), a2 + hstep, voffA);
            PG8_WAIT_V(8); PG8_WAIT_L(0); PG8_BAR; PG8_MMA(0, 0, At, B0); PG8_MMA(0, 1, At, B1); PG8_BAR; PG8_SCHED;
            PG8_LDA(At, 1, 1); PG8_STAGE(PG8_SB(1, 0), b3, voffB); PG8_STAGE(PG8_SB(1, 1), b3 + bhs, voffB); PG8_STAGE(PG8_SA(1, 0), a3, voffA);
            PG8_WAIT_V(8); PG8_WAIT_L(0); PG8_BAR; PG8_MMA(1, 0, At, B0); PG8_MMA(1, 1, At, B1); PG8_BAR; PG8_SCHED;
            } else {
            PG8_LDB(B0, 0, 0); PG8_SCHED; PG8_LDA(At, 0, 0); PG8_STAGE(PG8_SA(1, 1), a1 + hstep, voffA);
            PG8_WAIT_L(8); PG8_BAR; PG8_WAIT_L(0); PG8_MMA(0, 0, At, B0); PG8_BAR; PG8_SCHED;
            PG8_LDB(B1, 0, 1); PG8_STAGE(PG8_SB(0, 0), b2, voffB);
            PG8_BAR; PG8_WAIT_L(0); PG8_MMA(0, 1, At, B1); PG8_BAR;
            PG8_LDA(At, 0, 1); PG8_STAGE(PG8_SA(0, 0), a2, voffA);
            PG8_BAR; PG8_WAIT_L(0); PG8_MMA(1, 0, At, B0); PG8_BAR; PG8_SCHED;
            PG8_STAGE(PG8_SB(0, 1), b2 + bhs, voffB);
            PG8_WAIT_V(6); PG8_BAR; PG8_MMA(1, 1, At, B1); PG8_BAR;
            PG8_LDB(B0, 1, 0); PG8_SCHED; PG8_LDA(At, 1, 0); PG8_STAGE(PG8_SA(0, 1), a2 + hstep, voffA);
            PG8_WAIT_L(8); PG8_BAR; PG8_WAIT_L(0); PG8_MMA(0, 0, At, B0); PG8_BAR; PG8_SCHED;
            PG8_LDB(B1, 1, 1); PG8_STAGE(PG8_SB(1, 0), b3, voffB);
            PG8_BAR; PG8_WAIT_L(0); PG8_MMA(0, 1, At, B1); PG8_BAR;
            PG8_LDA(At, 1, 1); PG8_STAGE(PG8_SA(1, 0), a3, voffA);
            PG8_BAR; PG8_WAIT_L(0); PG8_MMA(1, 0, At, B0); PG8_BAR; PG8_SCHED;
            PG8_STAGE(PG8_SB(1, 1), b3 + bhs, voffB);
            PG8_WAIT_V(6); PG8_BAR; PG8_MMA(1, 1, At, B1); PG8_BAR;
            }
        }
        if constexpr (ALIGN_EPI) { if (wr == 0) PG8_BAR; }
        if constexpr (!Epi::AFTER_DRAIN) { int t_ = threadIdx.x; asm volatile("" : "+v"(t_)); const int l_ = t_ & 63; E(acc, cur, wr, wc, l_ & 15, l_ >> 4); S.done(cur); H(ui); }
        if (!has_next) break;
#pragma unroll
        for (int a = 0; a < 2; ++a)
#pragma unroll
            for (int b = 0; b < 2; ++b)
#pragma unroll
                for (int m = 0; m < 4; ++m)
#pragma unroll
                    for (int n = 0; n < 2; ++n) acc[a][b][m][n] = (f32x4){0.f, 0.f, 0.f, 0.f};
        cur = nxt; cA = nA; cB = nB; ++ui;
        if constexpr (ALIGN_EPI) { if (wr == 1) PG8_BAR; }
    }
    PG8_WAIT_V(0);
    if constexpr (!ALIGN_EPI) { if (wr == 0) PG8_BAR; }
    PG8_BAR;
    if constexpr (Epi::AFTER_DRAIN) { E.fused(acc, cur, wr, wc, fr, fq, lds, wid, lane); S.done(cur); }
#undef PG8_SA
#undef PG8_SB
#undef PG8_STAGE
#undef PG8_LDA
#undef PG8_LDB
#undef PG8_MMA
#undef PG8_WAIT_V
#undef PG8_WAIT_L
#undef PG8_BAR
#undef PG8_SCHED
}
}
namespace sba {
typedef short bf16x8 __attribute__((ext_vector_type(8)));
typedef short s16x4 __attribute__((ext_vector_type(4)));
typedef float f32x16 __attribute__((ext_vector_type(16)));
typedef float f32x4 __attribute__((ext_vector_type(4)));
typedef unsigned u32x4 __attribute__((ext_vector_type(4)));
typedef unsigned short bf16_t;
#define SB_LAS __attribute__((address_space(3)))
constexpr int PITCH = 512, SLOTB = 16384  , OFF_FLAGS = 2 * SLOTB, OFF_OST = OFF_FLAGS + 256, LDS_BYTES = OFF_OST + 8 * 4096;
constexpr float THR2 = 48.0f, NEGBIG = -1.0e30f;
typedef float f32x2_t __attribute__((ext_vector_type(2))); typedef __bf16 bf16x2_t __attribute__((ext_vector_type(2)));
__device__ __forceinline__ unsigned cvtpk(float lo, float hi) { f32x2_t v = {lo, hi}; bf16x2_t b = __builtin_convertvector(v, bf16x2_t); return __builtin_bit_cast(unsigned, b); }
__device__ __forceinline__ bf16x8 pack8f(float a0, float a1, float a2, float a3, float a4, float a5, float a6, float a7) {
    u32x4 w; w.x = cvtpk(a0, a1); w.y = cvtpk(a2, a3); w.z = cvtpk(a4, a5); w.w = cvtpk(a6, a7); return __builtin_bit_cast(bf16x8, w); }
typedef short v4i16_t __attribute__((ext_vector_type(4)));
__device__ __forceinline__ s16x4 vtr(const SB_LAS char* p) { return __builtin_bit_cast(s16x4, __builtin_amdgcn_ds_read_tr16_b64_v4i16((SB_LAS v4i16_t*)p)); }
__device__ __forceinline__ int crow(int r, int hi) { return (r & 3) + 8 * (r >> 2) + 4 * hi; }

template <int SUB>
__device__ __forceinline__ void sub_front(const SB_LAS char* Kslot, bool mask, int kq, const bf16x8 (&qr)[4], f32x16& w, bf16x8 (&spb)[2], int r32, int hi) {
    const SB_LAS char* kb = Kslot + hi * 1024 + r32 * 16 + SUB * 512;
    f32x16 p = {};
#pragma unroll
    for (int d0 = 0; d0 < 4; ++d0) { const bf16x8 kf = *(const SB_LAS bf16x8*)(kb + d0 * 2048); p = __builtin_amdgcn_mfma_f32_32x32x16_bf16(kf, qr[d0], p, 0, 0, 0); }
    float sp[16];
#pragma unroll
    for (int r = 0; r < 16; ++r) {
        float x = p[r];
        if (mask && (kq + 32 * SUB + (r & 3) + 8 * (r >> 2) >= 0)) x = NEGBIG;
        const float t = __builtin_amdgcn_exp2f(-__builtin_fabsf(x));
        const float l = __builtin_amdgcn_logf(1.0f + t);
        sp[r] = __builtin_fmaxf(x, 0.f) + l; w[r] = __builtin_fminf(x, 0.f) - l;
    }
    spb[0] = pack8f(sp[0], sp[1], sp[2], sp[3], sp[4], sp[5], sp[6], sp[7]);
    spb[1] = pack8f(sp[8], sp[9], sp[10], sp[11], sp[12], sp[13], sp[14], sp[15]);
}
template <int SUB>
__device__ __forceinline__ void sub_back(const SB_LAS char* vp, const f32x16& w, const f32x16& sx, f32x16 (&o)[2]) {
    float pr[16];
#pragma unroll
    for (int r = 0; r < 16; ++r) pr[r] = __builtin_amdgcn_exp2f(w[r] - sx[r]);
    bf16x8 pa[2];
    pa[0] = pack8f(pr[0], pr[1], pr[2], pr[3], pr[4], pr[5], pr[6], pr[7]);
    pa[1] = pack8f(pr[8], pr[9], pr[10], pr[11], pr[12], pr[13], pr[14], pr[15]);
#pragma unroll
    for (int d0 = 0; d0 < 2; ++d0)
#pragma unroll
        for (int s = 0; s < 2; ++s) { const int ks = 2 * SUB + s;
            const s16x4 lo = vtr(vp + d0 * 4096 + ks * 1024), hi4 = vtr(vp + d0 * 4096 + ks * 1024 + 512);
            const bf16x8 vf = (bf16x8){lo[0], lo[1], lo[2], lo[3], hi4[0], hi4[1], hi4[2], hi4[3]};
            o[d0] = __builtin_amdgcn_mfma_f32_32x32x16_bf16(pa[s], vf, o[d0], 0, 0, 0); }
}
__device__ __forceinline__ void sb_tile(const SB_LAS char* slot, bool mask, bool skip1, int kq, const bf16x8 (&qr)[4], f32x16& Rb, f32x16 (&o)[2], const bf16x8 (&Um)[2], const bf16x8 Jm, int r32, int hi, int lane) {
    const SB_LAS char* vp = slot + 8192 + ((lane >> 4) & 1) * 32 + (lane & 3) * 8 + (4 * hi + ((lane & 15) >> 2)) * 64;
    f32x16 w1, w0; bf16x8 sb1[2], sb0[2];
    f32x16 t1 = Rb;
    if (!skip1) {
    sub_front<1>(slot, mask, kq, qr, w1, sb1, r32, hi);
    f32x16 a1 = __builtin_amdgcn_mfma_f32_32x32x16_bf16(Um[0], sb1[0], Rb, 0, 0, 0); a1 = __builtin_amdgcn_mfma_f32_32x32x16_bf16(Um[1], sb1[1], a1, 0, 0, 0);
    t1 = __builtin_amdgcn_mfma_f32_32x32x16_bf16(Jm, sb1[0], Rb, 0, 0, 0); t1 = __builtin_amdgcn_mfma_f32_32x32x16_bf16(Jm, sb1[1], t1, 0, 0, 0);
    sub_back<1>(vp, w1, a1, o);
    }
    sub_front<0>(slot, mask, kq, qr, w0, sb0, r32, hi);
    f32x16 a0 = __builtin_amdgcn_mfma_f32_32x32x16_bf16(Um[0], sb0[0], t1, 0, 0, 0); a0 = __builtin_amdgcn_mfma_f32_32x32x16_bf16(Um[1], sb0[1], a0, 0, 0, 0);
    f32x16 rn = __builtin_amdgcn_mfma_f32_32x32x16_bf16(Jm, sb0[0], t1, 0, 0, 0); rn = __builtin_amdgcn_mfma_f32_32x32x16_bf16(Jm, sb0[1], rn, 0, 0, 0);
    sub_back<0>(vp, w0, a0, o);
    Rb = rn;
}
struct Tensors { const bf16_t* Q; const bf16_t* K; const bf16_t* V; bf16_t* O; const float* ck; const float* cv; };

template <bool SAMPLE>
__device__ __forceinline__ void sb_unit(int b, int h, int qb, const Tensors& T, SB_LAS char* lds) {
    int tid = threadIdx.x; asm volatile("" : "+v"(tid)); const int lane = tid & 63, r32 = lane & 31, hi = lane >> 5; const int wid = __builtin_amdgcn_readfirstlane(tid >> 6);
    const size_t rowbase = SAMPLE ? (size_t)cfg::MP + (size_t)b * 32 : (size_t)b * cfg::SEQ; const int q0 = SAMPLE ? 0 : qb * 256;
    const int jd = SAMPLE ? 16 : (q0 >> 6) + (wid >> 1), jtop = SAMPLE ? 16 : (q0 >> 6) + 3;
    const bool worker = SAMPLE ? (wid == 0) : true;
    const int wq = SAMPLE ? 0 : wid;
    const int qpos = (SAMPLE ? cfg::PAST : q0 + 32 * wq) + r32;
    volatile SB_LAS unsigned* flags = (volatile SB_LAS unsigned*)(lds + OFF_FLAGS);
    bf16x8 Um[2], Jm;
#pragma unroll
    for (int s = 0; s < 2; ++s)
#pragma unroll
        for (int jj = 0; jj < 8; ++jj) Um[s][jj] = (16 * s + 8 * (jj >> 2) + 4 * hi + (jj & 3) > r32) ? (short)0x3F80 : (short)0;
#pragma unroll
    for (int jj = 0; jj < 8; ++jj) Jm[jj] = (short)0x3F80;
    bf16x8 qr[4];
    { const bf16_t* Qw = T.Q + (rowbase + q0 + 32 * wq + r32) * PITCH + h * 64 + hi * 8;
#pragma unroll
      for (int d0 = 0; d0 < 4; ++d0) qr[d0] = *(const bf16x8*)(Qw + d0 * 16); }
    f32x16 Rb = {}, o[2]; o[0] = f32x16{}; o[1] = f32x16{};
    bool done = false;
    u32x4 kreg, vreg;
    const int vkey = 16 * (wid & 3) + (lane >> 2), vcol = (wid >> 2) * 32 + (lane & 3) * 8;
#define SB_LOAD(j) do { \
        if (!SAMPLE) { kreg = *(const u32x4*)(T.K + (rowbase + (size_t)(64 * (j) + lane)) * PITCH + h * 64 + wid * 8); vreg = *(const u32x4*)(T.V + (rowbase + (size_t)(64 * (j) + vkey)) * PITCH + h * 64 + vcol); } \
        else if ((j) == 16) { const int kr_ = lane < 31 ? lane : 31, vr_ = vkey < 31 ? vkey : 31; \
            kreg = *(const u32x4*)(T.K + (rowbase + kr_) * PITCH + h * 64 + wid * 8); vreg = *(const u32x4*)(T.V + (rowbase + vr_) * PITCH + h * 64 + vcol); } \
        else { const float* kp_ = T.ck + ((size_t)b * cfg::PAST + 64 * (j) + lane) * PITCH + h * 64 + wid * 8; const float* vp_ = T.cv + ((size_t)b * cfg::PAST + 64 * (j) + vkey) * PITCH + h * 64 + vcol; \
            const f32x4 k0_ = *(const f32x4*)kp_, k1_ = *(const f32x4*)(kp_ + 4), v0_ = *(const f32x4*)vp_, v1_ = *(const f32x4*)(vp_ + 4); \
            kreg = (u32x4){cvtpk(k0_[0], k0_[1]), cvtpk(k0_[2], k0_[3]), cvtpk(k1_[0], k1_[1]), cvtpk(k1_[2], k1_[3])}; vreg = (u32x4){cvtpk(v0_[0], v0_[1]), cvtpk(v0_[2], v0_[3]), cvtpk(v1_[0], v1_[1]), cvtpk(v1_[2], v1_[3])}; } } while (0)
    SB_LOAD(jtop);
    for (int j = jtop; j >= 0; --j) {
        SB_LAS char* slot = lds + (j & 1) * SLOTB;
        *(SB_LAS u32x4*)(slot + wid * 1024 + lane * 16) = kreg; *(SB_LAS u32x4*)(slot + 8192 + wid * 1024 + lane * 16) = vreg;
        __syncthreads();
        if (j != jtop) { const volatile SB_LAS unsigned* f = flags + ((j + 1) & 1) * 8; unsigned all = 1u;
#pragma unroll
            for (int w8 = 0; w8 < 8; ++w8) all &= f[w8];
            if (all) break; }
        if (j > 0) SB_LOAD(j - 1);
        if (worker && !done && j <= jd) {
            const int key0 = (SAMPLE && j == 16) ? cfg::PAST : 64 * j;
            sb_tile(slot, j == jd, (j == jd) && (SAMPLE || (wid & 1) == 0), key0 + 4 * hi - qpos, qr, Rb, o, Um, Jm, r32, hi, lane);
            done = __all(Rb[0] > THR2) != 0;
        }
        if (lane == 0) flags[(j & 1) * 8 + wid] = (done || !worker) ? 1u : 0u;
    }
#undef SB_LOAD
    if (worker) {
        SB_LAS bf16_t* stg = (SB_LAS bf16_t*)(lds + OFF_OST) + wid * 2048;
#pragma unroll
        for (int r = 0; r < 16; ++r) { const int orow = crow(r, hi);
#pragma unroll
            for (int d0 = 0; d0 < 2; ++d0) stg[orow * 64 + d0 * 32 + r32] = (bf16_t)(cvtpk(o[d0][r], 0.f) & 0xffffu); }
        asm volatile("s_waitcnt lgkmcnt(0)" ::: "memory");
        bf16_t* Ow = T.O + (rowbase + q0 + 32 * wq) * PITCH + h * 64;
#pragma unroll
        for (int i = 0; i < 4; ++i) { const int row = i * 8 + (lane >> 3), ch = lane & 7; const u32x4 v = *(const SB_LAS u32x4*)(stg + row * 64 + ch * 8); *(u32x4*)(Ow + (size_t)row * PITCH + ch * 8) = v; }
    }
    __syncthreads();
}
}
namespace sk {
typedef short bf16x8 __attribute__((ext_vector_type(8)));
typedef float f32x16 __attribute__((ext_vector_type(16)));
typedef float f32x4 __attribute__((ext_vector_type(4)));
typedef unsigned short bf16_t;
#define SK_LAS __attribute__((address_space(3)))
constexpr int PLD = 36;
constexpr int LDS_BYTES = 8 * 2 * 32 * PLD * 4;
__device__ __forceinline__ f32x4 tile(const bf16_t* A, const bf16_t* Bt, int K, size_t arow0, int col0, SK_LAS char* lds) {
    int tid = threadIdx.x; asm volatile("" : "+v"(tid)); const int lane = tid & 63, r32 = lane & 31, hi = lane >> 5; const int wid = __builtin_amdgcn_readfirstlane(tid >> 6);
    const int nsplit = (K >= 512) ? 8 : (K >> 6), ks = K / nsplit;
    const bf16_t* ap = A + (arow0 + r32) * K + wid * ks + hi * 32;
    const bf16_t* bp0 = Bt + (size_t)(col0 + r32) * K + wid * ks + hi * 32; const bf16_t* bp1 = bp0 + (size_t)32 * K;
    f32x16 acc0 = {}, acc1 = {};
#pragma unroll 2
    for (int s = 0; s < ((wid < nsplit) ? ks : 0); s += 64) {
        bf16x8 a[4], b0[4], b1[4];
#pragma unroll
        for (int j = 0; j < 4; ++j) { a[j] = *(const bf16x8*)(ap + s + 8 * j); b0[j] = *(const bf16x8*)(bp0 + s + 8 * j); b1[j] = *(const bf16x8*)(bp1 + s + 8 * j); }
#pragma unroll
        for (int j = 0; j < 4; ++j) {
            acc0 = __builtin_amdgcn_mfma_f32_32x32x16_bf16(b0[j], a[j], acc0, 0, 0, 0);
            acc1 = __builtin_amdgcn_mfma_f32_32x32x16_bf16(b1[j], a[j], acc1, 0, 0, 0); }
    }
    SK_LAS float* P0 = (SK_LAS float*)lds + ((wid * 2 + 0) * 32 + r32) * PLD + 4 * hi; SK_LAS float* P1 = P0 + 32 * PLD;
#pragma unroll
    for (int g = 0; g < 4; ++g) { *(SK_LAS f32x4*)(P0 + 8 * g) = (f32x4){acc0[4 * g], acc0[4 * g + 1], acc0[4 * g + 2], acc0[4 * g + 3]};
                                  *(SK_LAS f32x4*)(P1 + 8 * g) = (f32x4){acc1[4 * g], acc1[4 * g + 1], acc1[4 * g + 2], acc1[4 * g + 3]}; }
    __syncthreads();
    const int row = tid >> 4, c = (tid & 15) * 4, cb = c >> 5, cc = c & 31;
    f32x4 s = {0.f, 0.f, 0.f, 0.f};
#pragma unroll
    for (int w = 0; w < 8; ++w) s += *(const SK_LAS f32x4*)((SK_LAS float*)lds + ((w * 2 + cb) * 32 + row) * PLD + cc);
    __syncthreads();
    return s;
}
__device__ __forceinline__ void tile4(const bf16_t* A, const bf16_t* Bt, int K, size_t arow0, int col0, SK_LAS char* lds, f32x4 (&out)[2][2]) {
    int tid = threadIdx.x; asm volatile("" : "+v"(tid)); const int lane = tid & 63, r32 = lane & 31, hi = lane >> 5; const int wid = __builtin_amdgcn_readfirstlane(tid >> 6);
    const int half = wid >> 2, kq = wid & 3, ks = K >> 2;
    const bf16_t* ap = A + (arow0 + r32) * K + kq * ks + hi * 32;
    const bf16_t* bp = Bt + (size_t)(col0 + half * 128 + r32) * K + kq * ks + hi * 32;
    f32x16 acc[4]; acc[0] = f32x16{}; acc[1] = f32x16{}; acc[2] = f32x16{}; acc[3] = f32x16{};
#pragma unroll 1
    for (int s = 0; s < ks; s += 64) {
        bf16x8 a[4], b[4][4];
#pragma unroll
        for (int e = 0; e < 4; ++e) { a[e] = *(const bf16x8*)(ap + s + 8 * e);
#pragma unroll
            for (int j = 0; j < 4; ++j) b[j][e] = *(const bf16x8*)(bp + (size_t)(32 * j) * K + s + 8 * e); }
#pragma unroll
        for (int e = 0; e < 4; ++e)
#pragma unroll
            for (int j = 0; j < 4; ++j) acc[j] = __builtin_amdgcn_mfma_f32_32x32x16_bf16(b[j][e], a[e], acc[j], 0, 0, 0);
    }
    const int row = tid >> 4, cc = (tid & 15) * 4;
#pragma unroll
    for (int q = 0; q < 2; ++q) {
        SK_LAS float* P0 = (SK_LAS float*)lds + ((wid * 2 + 0) * 32 + r32) * PLD + 4 * hi; SK_LAS float* P1 = P0 + 32 * PLD;
#pragma unroll
        for (int g = 0; g < 4; ++g) { *(SK_LAS f32x4*)(P0 + 8 * g) = (f32x4){acc[2 * q][4 * g], acc[2 * q][4 * g + 1], acc[2 * q][4 * g + 2], acc[2 * q][4 * g + 3]};
                                      *(SK_LAS f32x4*)(P1 + 8 * g) = (f32x4){acc[2 * q + 1][4 * g], acc[2 * q + 1][4 * g + 1], acc[2 * q + 1][4 * g + 2], acc[2 * q + 1][4 * g + 3]}; }
        __syncthreads();
#pragma unroll
        for (int h = 0; h < 2; ++h) { f32x4 sum = {0.f, 0.f, 0.f, 0.f};
#pragma unroll
            for (int w = 0; w < 4; ++w) sum += *(const SK_LAS f32x4*)((SK_LAS float*)lds + (((h * 4 + w) * 2 + (cc >> 5)) * 32 + row) * PLD + (cc & 31));
            out[h][q] = sum; }
        __syncthreads();
    }
}
__device__ __forceinline__ f32x16 wtile(const bf16_t* A, const bf16_t* Bt, int K, size_t arow0, int colw, int lane) {
    const int r32 = lane & 31, hi = lane >> 5;
    const bf16_t* ap = A + (arow0 + r32) * K + hi * 32; const bf16_t* bp = Bt + (size_t)(colw + r32) * K + hi * 32;
    f32x16 acc = {};
#pragma unroll 4
    for (int s = 0; s < K; s += 64) {
        bf16x8 a[4], b[4];
#pragma unroll
        for (int e = 0; e < 4; ++e) { a[e] = *(const bf16x8*)(ap + s + 8 * e); b[e] = *(const bf16x8*)(bp + s + 8 * e); }
#pragma unroll
        for (int e = 0; e < 4; ++e) acc = __builtin_amdgcn_mfma_f32_32x32x16_bf16(b[e], a[e], acc, 0, 0, 0);
    }
    return acc;
}
__device__ __forceinline__ float sum16(float v) { v += __shfl_xor(v, 1); v += __shfl_xor(v, 2); v += __shfl_xor(v, 4); v += __shfl_xor(v, 8); return v; }
__device__ __forceinline__ float rstd16(const float* SSQ, int r, int t) { return __builtin_amdgcn_rsqf(sum16(SSQ[(size_t)r * 16 + (t & 15)]) * (1.0f / 1024.0f) + cfg::EPS); }
__device__ __forceinline__ float rstd_row(const float* SSQ, int r) { const f32x4* p = (const f32x4*)(SSQ + (size_t)r * 16); const f32x4 a = p[0], b = p[1], c = p[2], d = p[3];
    const float s = ((a[0] + a[1]) + (a[2] + a[3])) + ((b[0] + b[1]) + (b[2] + b[3])) + ((c[0] + c[1]) + (c[2] + c[3])) + ((d[0] + d[1]) + (d[2] + d[3])); return __builtin_amdgcn_rsqf(s * (1.0f / 1024.0f) + cfg::EPS); }
__device__ __forceinline__ unsigned long long pk4(f32x4 v) { return (unsigned long long)pg8::cvt_pk_bf16(v[0], v[1]) | ((unsigned long long)pg8::cvt_pk_bf16(v[2], v[3]) << 32); }
__device__ __forceinline__ f32x4 up4(unsigned long long w) { const unsigned lo = (unsigned)w, hi = (unsigned)(w >> 32); return (f32x4){pg8::bf_lo(lo), pg8::bf_hi(lo), pg8::bf_lo(hi), pg8::bf_hi(hi)}; }
}
#define GAS __attribute__((address_space(1)))
#define LAS __attribute__((address_space(3)))
typedef unsigned short bf16;
typedef unsigned v4u __attribute__((ext_vector_type(4)));
typedef float f32x4 __attribute__((ext_vector_type(4)));
typedef short bf16x8 __attribute__((ext_vector_type(8)));
typedef GAS unsigned gu32;
typedef GAS unsigned long long gu64;
#define RLX_AGENT __ATOMIC_RELAXED, __HIP_MEMORY_SCOPE_AGENT
#define LDS_WAIT() asm volatile("s_waitcnt lgkmcnt(0)" ::: "memory")
#define VM_WAIT() asm volatile("s_waitcnt vmcnt(0)" ::: "memory")
__device__ __forceinline__ unsigned long long rt() { return __builtin_amdgcn_s_memrealtime(); }
__device__ __forceinline__ unsigned f2bf(float f) { unsigned u = __builtin_bit_cast(unsigned, f); return (u + 0x7fffu + ((u >> 16) & 1u)) >> 16; }
__device__ __forceinline__ unsigned pk2(float lo, float hi) { return f2bf(lo) | (f2bf(hi) << 16); }
#define XB_TMO      128
#define XB_XCNT(j)  (256  + 64 * (j))
#define XB_XSUB(j)  (1280 + 64 * (j))
#define XB_XGEN(j)  (2304 + 64 * (j))
#define XB_TOP      3328
#define XB_TOPGEN   3392
#define XCD_BAR_WORDS 3456
#define XB_SPIN_CAP (1u << 18)

__device__ __forceinline__ unsigned xb_ld(unsigned* p)              { return __hip_atomic_load(p, __ATOMIC_RELAXED, __HIP_MEMORY_SCOPE_AGENT); }
__device__ __forceinline__ unsigned xb_add(unsigned* p, unsigned v) { return __hip_atomic_fetch_add(p, v, __ATOMIC_RELAXED, __HIP_MEMORY_SCOPE_AGENT); }
__device__ __forceinline__ unsigned xb_xcc_id() { return (unsigned)__builtin_amdgcn_s_getreg((3 << 11) | 20) & 0xFu; }
#define XB_SPIN(cond, bar) do { unsigned _sp = 0; while (cond) { __builtin_amdgcn_s_sleep(1); \
    if ((++_sp & 255u) == 0u) { if (xb_ld(&(bar)[XB_TMO])) break; if (_sp > XB_SPIN_CAP) { atomicAdd(&(bar)[XB_TMO], 1u); break; } } } } while (0)

struct XcdBarrier {
    unsigned* bar; unsigned x;
    volatile LAS unsigned* st;
};

__device__ __forceinline__ XcdBarrier xcd_barrier_post(unsigned* bar, volatile LAS unsigned* st) {
    XcdBarrier b; b.bar = bar; b.x = xb_xcc_id(); b.st = st;
    if (threadIdx.x == 0) (void)xb_add(&bar[XB_XCNT(b.x)], 1u);
    return b;
}
__device__ __forceinline__ void xcd_barrier_complete(unsigned* bar, unsigned x, unsigned& nloc, unsigned& nx) {
    const unsigned G = gridDim.x * gridDim.y * gridDim.z;
    unsigned sum, cnt, mine, sp = 0u;
    for (;;) {
        sum = 0u; cnt = 0u; mine = 0u;
#pragma unroll
        for (unsigned j = 0; j < 16; ++j) { const unsigned c = xb_ld(&bar[XB_XCNT(j)]); sum += c; cnt += (c > 0u) ? 1u : 0u; mine = (j == x) ? c : mine; }
        if (sum == G) break;
        __builtin_amdgcn_s_sleep(1);
        if ((++sp & 255u) == 0u) { if (xb_ld(&bar[XB_TMO])) break; if (sp > XB_SPIN_CAP) { atomicAdd(&bar[XB_TMO], 1u); break; } }
    }
    nloc = mine > 0u ? mine : 1u; nx = cnt > 0u ? cnt : 1u;
}

__device__ __forceinline__ void xcd_barrier(const XcdBarrier& b) {
    asm volatile("s_waitcnt vmcnt(0)" ::: "memory");
    __syncthreads();
    if (threadIdx.x == 0) {
        unsigned* bar = b.bar;
        __builtin_amdgcn_s_waitcnt(0);
        unsigned nloc = b.st[0], nx = b.st[1];
        if (nloc == 0u) { xcd_barrier_complete(bar, b.x, nloc, nx); b.st[0] = nloc; b.st[1] = nx; }
        const unsigned old = xb_add(&bar[XB_XSUB(b.x)], 1u);
        const unsigned gen = old / nloc;
        if (old + 1u == (gen + 1u) * nloc) {
            __builtin_amdgcn_fence(__ATOMIC_RELEASE, "agent");
            asm volatile("s_waitcnt vmcnt(0)" ::: "memory");
            const unsigned og = xb_add(&bar[XB_TOP], 1u);
            const unsigned tg = og / nx;
            if (og + 1u == (tg + 1u) * nx) xb_add(&bar[XB_TOPGEN], 1u);
            else XB_SPIN(xb_ld(&bar[XB_TOPGEN]) == tg, bar);
            __builtin_amdgcn_fence(__ATOMIC_ACQUIRE, "agent");
            xb_add(&bar[XB_XGEN(b.x)], 1u);
            asm volatile("s_waitcnt vmcnt(0)" ::: "memory");
        } else {
            XB_SPIN(xb_ld(&bar[XB_XGEN(b.x)]) == gen, bar);
            __builtin_amdgcn_fence(__ATOMIC_ACQUIRE, "agent");
            asm volatile("s_waitcnt vmcnt(0)" ::: "memory");
        }
    }
    __syncthreads();
}
__device__ __forceinline__ float wave_sum(float v) {
#pragma unroll
    for (int o = 1; o < 64; o <<= 1) v += __shfl_xor(v, o);
    return v;
}
__device__ __forceinline__ void p0_transpose_item(const float* W, int K, int N, bf16* WT, int row_off, LAS float* scr, int item, int lane) {
    const int nblk = N / 32, kb = item / nblk, nb = item % nblk, k0 = 64 * kb, n0 = 32 * nb;
    float tv[32];
#pragma unroll
    for (int i = 0; i < 32; ++i) { const int kk = 2 * i + (lane >> 5); tv[i] = __builtin_nontemporal_load(W + (size_t)(k0 + kk) * N + n0 + (lane & 31)); }
#pragma unroll
    for (int i = 0; i < 32; ++i) { const int kk = 2 * i + (lane >> 5); scr[kk * 33 + (lane & 31)] = tv[i]; }
    LDS_WAIT(); asm volatile("" ::: "memory");
    const int c = lane & 7;
#pragma unroll
    for (int j = 0; j < 4; ++j) { const int n = (lane >> 3) + 8 * j; const LAS float* s = scr + (8 * c) * 33 + n;
        v4u o; o.x = pk2(s[0 * 33], s[1 * 33]); o.y = pk2(s[2 * 33], s[3 * 33]); o.z = pk2(s[4 * 33], s[5 * 33]); o.w = pk2(s[6 * 33], s[7 * 33]);
        *(GAS v4u*)(WT + (size_t)(row_off + n0 + n) * K + k0 + 8 * c) = o; }
    LDS_WAIT(); asm volatile("" ::: "memory");
}
constexpr int NWAVES = 8;
#ifndef MK_N_LAUNCHES
#define MK_N_LAUNCHES 1
#endif
constexpr int N_PHASES = 8;
#ifndef DBG_ROT
#define DBG_ROT 0
#endif
#ifndef DBG_REPEAT
#define DBG_REPEAT -1
#endif
#ifndef DBG_P2PART
#define DBG_P2PART 0
#endif
#ifndef DBG_ALIGN
#define DBG_ALIGN true
#endif
#ifndef DBG_SP2
#define DBG_SP2 true
#endif
using namespace cfg;
constexpr size_t MiB = 1u << 20;
constexpr size_t WS_CTL = 0, CTL_ZERO_BYTES = 1 * MiB;
constexpr size_t WS_WIN = 2 * MiB, WS_WEFF = 10 * MiB, WS_WSB = 11 * MiB, WS_WOUT = 12 * MiB, WS_WUP = 14 * MiB, WS_WDOWN = 22 * MiB, WS_WPG = 30 * MiB, WS_WPP = 32 * MiB;
constexpr size_t WS_SSQ1 = 33 * MiB, WS_SSQ2 = 35 * MiB, WS_SSQ3 = 37 * MiB;
constexpr size_t WS_PB = 40 * MiB;
constexpr size_t WS_XN = 49 * MiB;
constexpr size_t WS_BIG = 82 * MiB;
constexpr size_t WS_U = WS_BIG, WS_Q = WS_BIG + 16 * MiB + MiB / 2, WS_K = WS_BIG + 33 * MiB, WS_V = WS_BIG + 49 * MiB + MiB / 2;
constexpr size_t WS_G = WS_BIG + 66 * MiB;
constexpr size_t WS_Y = WS_BIG + 132 * MiB, WS_YSB = WS_Y + 16 * MiB + MiB / 2;
constexpr size_t WS_MG = WS_BIG;
constexpr size_t WS_H = WS_BIG;
constexpr size_t WS_PP = WS_BIG;
constexpr size_t WS_X = WS_Y;
constexpr size_t WS_END = WS_BIG + 165 * MiB;
static_assert((size_t)MT * 512 * 2 == 16 * MiB + MiB / 2 && (size_t)MT * 1024 * 2 == 33 * MiB && (size_t)MT * 16 * 4 <= 2 * MiB && (size_t)MT * 256 * 2 <= 9 * MiB && WS_END <= 256 * MiB, "d_ws map");
constexpr int CW_BAR = 4096, CW_FIN = 8192  , CW_FINS = 16384  ;
constexpr size_t O_Y = 0, O_KP = 17301504, O_VP = 25690112, O_POOLP = 34078720, O_KS = 34140160, O_VS = 34402304, O_POOLS = 34664448, O_END = 34787328;
constexpr int RING_OFF = 0, RING_BYTES = 131072, LDSCTL_OFF = RING_BYTES, MISC_OFF = LDSCTL_OFF + 320, LDS_BYTES = 147456;
static_assert(sk::LDS_BYTES <= RING_BYTES && sba::LDS_BYTES <= RING_BYTES, "attention scratch fits the ring region");

struct Args { const float* in[22]; float* out; unsigned char* ws; int ph_lo, ph_hi, li, pad; };

__device__ __forceinline__ void rms_rows_to_bf16(const float* xrow0, const float* xrow1, const float* g, bf16* orow0, bf16* orow1, int lane) {
    const GAS f32x4* xr0 = (const GAS f32x4*)xrow0 + lane; const GAS f32x4* xr1 = (const GAS f32x4*)(xrow1 ? xrow1 : xrow0) + lane; const GAS f32x4* gr = (const GAS f32x4*)g + lane;
    f32x4 v[4], w[4], gg[4]; float s = 0.f, t = 0.f;
#pragma unroll
    for (int j = 0; j < 4; ++j) { v[j] = __builtin_nontemporal_load(xr0 + 64 * j); w[j] = __builtin_nontemporal_load(xr1 + 64 * j); gg[j] = gr[64 * j]; }
#pragma unroll
    for (int j = 0; j < 4; ++j) { s += (v[j].x * v[j].x + v[j].y * v[j].y) + (v[j].z * v[j].z + v[j].w * v[j].w); t += (w[j].x * w[j].x + w[j].y * w[j].y) + (w[j].z * w[j].z + w[j].w * w[j].w); }
#pragma unroll
    for (int o = 1; o < 64; o <<= 1) { s += __shfl_xor(s, o); t += __shfl_xor(t, o); }
    const float rs = 1.f / sqrtf(s * (1.f / DM) + EPS), rt = 1.f / sqrtf(t * (1.f / DM) + EPS);
    GAS unsigned long long* o0 = (GAS unsigned long long*)orow0 + lane; GAS unsigned long long* o1 = (GAS unsigned long long*)orow1 + lane;
#pragma unroll
    for (int j = 0; j < 4; ++j) { o0[64 * j] = (unsigned long long)pk2(v[j].x * rs * gg[j].x, v[j].y * rs * gg[j].y) | ((unsigned long long)pk2(v[j].z * rs * gg[j].z, v[j].w * rs * gg[j].w) << 32);
        if (xrow1) o1[64 * j] = (unsigned long long)pk2(w[j].x * rt * gg[j].x, w[j].y * rt * gg[j].y) | ((unsigned long long)pk2(w[j].z * rt * gg[j].z, w[j].w * rt * gg[j].w) << 32); }
}
__device__ __forceinline__ void weff_item(const float* wgrp, const float* scale, const float* wpu, bf16* WT, int item, int lane) {
    const int nb = item & 15, cb = (item >> 4) & 15, g = item >> 8, n = nb * 64 + lane;
    float wg[8][2];
#pragma unroll
    for (int cc = 0; cc < 8; ++cc)
#pragma unroll
        for (int hh = 0; hh < 2; ++hh) wg[cc][hh] = wgrp[((size_t)(g * 128 + cb * 8 + cc)) * 128 + lane + 64 * hh] * scale[g * 128 + lane + 64 * hh];
    float acc[8];
#pragma unroll
    for (int cc = 0; cc < 8; ++cc) acc[cc] = 0.f;
#pragma unroll
    for (int hh = 0; hh < 2; ++hh)
#pragma unroll 16
        for (int d2 = 0; d2 < 64; ++d2) { const float wv = wpu[(size_t)(g * 128 + hh * 64 + d2) * 1024 + n];
#pragma unroll
            for (int cc = 0; cc < 8; ++cc) acc[cc] = fmaf(__builtin_bit_cast(float, __builtin_amdgcn_readlane(__builtin_bit_cast(int, wg[cc][hh]), d2)), wv, acc[cc]); }
    v4u o; o.x = pk2(acc[0], acc[1]); o.y = pk2(acc[2], acc[3]); o.z = pk2(acc[4], acc[5]); o.w = pk2(acc[6], acc[7]);
    *(GAS v4u*)(WT + (size_t)n * 512 + g * 128 + cb * 8) = o;
}

template <int W, int R>
__device__ __forceinline__ void pool_run(const bf16* Ub, const float* state_pool, bf16* Yb, int run, int c) {
    const int r0 = run * R; const bool sample = r0 >= MP; const int t0 = sample ? ((r0 - MP) & 31) : (r0 & (SEQ - 1)); const int b_ = sample ? ((r0 - MP) >> 5) : 0;
    v4u rw[R - 1 + W];
#pragma unroll
    for (int k = 0; k < W - 1; ++k) { const int pos = t0 + k - (W - 1);
        if (pos >= 0) rw[k] = *(const GAS v4u*)(Ub + (size_t)(r0 - (W - 1) + k) * 512 + c);
        else if (sample) { const float* sp = state_pool + ((size_t)b_ * 15 + 15 + pos) * 512 + c; const f32x4 a = *(const GAS f32x4*)sp, b = *(const GAS f32x4*)(sp + 4); rw[k] = pg8::pack8(a, b); }
        else rw[k] = (v4u){0u, 0u, 0u, 0u}; }
#pragma unroll
    for (int k = W - 1; k < R - 1 + W; ++k) rw[k] = *(const GAS v4u*)(Ub + (size_t)(r0 - (W - 1) + k) * 512 + c);
    f32x4 s0 = {0.f, 0.f, 0.f, 0.f}, s1 = {0.f, 0.f, 0.f, 0.f};
#pragma unroll
    for (int k = 0; k < W - 1; ++k) { f32x4 a, b; pg8::unpack8(rw[k], a, b); s0 += a; s1 += b; }
#pragma unroll
    for (int i = 0; i < R; ++i) { f32x4 a, b, u0, u1; pg8::unpack8(rw[W - 1 + i], u0, u1); s0 += u0; s1 += u1;
        const int cnt = sample ? W : ((t0 + i + 1 < W) ? t0 + i + 1 : W); const float ic = 1.0f / (float)cnt;
        *(GAS v4u*)(Yb + (size_t)(r0 + i) * 512 + c) = pg8::pack8(s0 * ic - u0, s1 * ic - u1);
        pg8::unpack8(rw[i], a, b); s0 -= a; s1 -= b; }
}
#if defined(HYB_ATTN) || defined(HYB_POOL)
__device__ __forceinline__ float hb2f(unsigned short v) { return __uint_as_float((unsigned)v << 16); }
__global__ void __launch_bounds__(64) hyb_attn(const unsigned short* Qb, const unsigned short* Kb, const unsigned short* Vb, const float* ck, const float* cv, unsigned short* YSB) {
    const int idx = blockIdx.x * 64 + threadIdx.x; if (idx >= MT * NH) return;
    const int h = idx / MT, m = idx % MT;
    float qr[HD], o[HD];
#pragma unroll
    for (int d = 0; d < HD; ++d) { qr[d] = hb2f(Qb[(size_t)m * 512 + h * HD + d]) * 0.6931471805599453f; o[d] = 0.f; }
    float S = 0.f; bool done = false; size_t kb; int nk;
    if (m < MP) { kb = (size_t)(m / SEQ) * SEQ; nk = m % SEQ; } else { const int ms = m - MP; kb = (size_t)MP + (size_t)(ms / DS) * DS; nk = ms % DS; }
    for (int s = nk - 1; s >= 0 && !done; --s) {
        const unsigned short* kr = Kb + (kb + s) * 512 + h * HD; const unsigned short* vr = Vb + (kb + s) * 512 + h * HD; float z = 0.f;
#pragma unroll
        for (int d = 0; d < HD; ++d) z = fmaf(qr[d], hb2f(kr[d]), z);
        const float sp = fmaxf(z, 0.f) + log1pf(expf(-fabsf(z))), a = expf(z - sp - S);
#pragma unroll
        for (int d = 0; d < HD; ++d) o[d] = fmaf(a, hb2f(vr[d]), o[d]);
        S += sp; if (S > 110.f) done = true;
    }
    if (m >= MP) { const int b = (m - MP) / DS; const float* kc = ck + (size_t)b * PAST * 512 + h * HD; const float* vc = cv + (size_t)b * PAST * 512 + h * HD;
        for (int s = PAST - 1; s >= 0 && !done; --s) {
            const float* kr = kc + (size_t)s * 512; const float* vr = vc + (size_t)s * 512; float z = 0.f;
#pragma unroll
            for (int d = 0; d < HD; ++d) z = fmaf(qr[d], kr[d], z);
            const float sp = fmaxf(z, 0.f) + log1pf(expf(-fabsf(z))), a = expf(z - sp - S);
#pragma unroll
            for (int d = 0; d < HD; ++d) o[d] = fmaf(a, vr[d], o[d]);
            S += sp; if (S > 110.f) done = true;
        } }
#pragma unroll
    for (int d = 0; d < HD; ++d) YSB[(size_t)m * 512 + h * HD + d] = (unsigned short)f2bf(o[d]);
}
__global__ void hyb_pool(const unsigned short* Ub, const float* state_pool, unsigned short* Yb) {
    const size_t i = (size_t)blockIdx.x * blockDim.x + threadIdx.x; if (i >= (size_t)MT * PW) return;
    const int m = (int)(i / PW), c = (int)(i % PW), g = c / 128, w = 2 << g;
    float s = 0.f; float cnt;
    if (m < MP) { const int t = m % SEQ; const int n = (t + 1 < w) ? t + 1 : w; for (int j = 0; j < n; ++j) s += hb2f(Ub[(size_t)(m - j) * PW + c]); cnt = (float)n; }
    else { const int ms = m - MP, b = ms / DS, t = ms % DS; for (int j = 0; j < w; ++j) { const int r = 15 + t - j; s += (r >= 15) ? hb2f(Ub[(size_t)(m - j) * PW + c]) : state_pool[((size_t)b * 15 + r) * PW + c]; } cnt = (float)w; }
    Yb[i] = (unsigned short)f2bf(s / cnt - hb2f(Ub[i]));
}
#endif

__global__ void __launch_bounds__(NWAVES * 64, 2) mega_fwd(Args args) {
    extern __shared__ __attribute__((aligned(16))) unsigned char lds[];
    LAS unsigned char* L = (LAS unsigned char*)lds;
    volatile LAS unsigned* MISC = (volatile LAS unsigned*)(L + MISC_OFF);
    const int wave = __builtin_amdgcn_readfirstlane(threadIdx.x >> 6);
#define FRESH_TID() int tid = threadIdx.x; asm volatile("" : "+v"(tid)); const int lane = tid & 63; (void)lane
    const int G = gridDim.x, bx = blockIdx.x, vcu = (G % 8 == 0) ? (bx % 8) * (G / 8) + bx / 8 : bx;
    unsigned char* ws = args.ws;
    gu32* ctl = (gu32*)(ws + WS_CTL);
    const float* x_p = args.in[0]; const float* x_s = args.in[1]; const float* cache_k = args.in[2]; const float* cache_v = args.in[3]; const float* state_pool = args.in[4];
    const float* p_p = args.in[5]; const float* p_s = args.in[6]; const float* g_mix = args.in[7]; const float* w_in = args.in[8]; const float* b_gate = args.in[9]; const float* w_grp = args.in[10];
    const float* pool_scale = args.in[11]; const float* w_pool_up = args.in[12]; const float* w_sb_up = args.in[13]; const float* w_out = args.in[14]; const float* g_mlp = args.in[15];
    const float* w_up = args.in[16]; const float* w_down = args.in[17]; const float* g_ple = args.in[18]; const float* w_ple_gate = args.in[19]; const float* w_ple_proj = args.in[20]; const float* g_final = args.in[21];
    float* out = args.out; float* Yo = out + O_Y;
    bf16 *WIN = (bf16*)(ws + WS_WIN), *WEFF = (bf16*)(ws + WS_WEFF), *WSB = (bf16*)(ws + WS_WSB), *WOUT = (bf16*)(ws + WS_WOUT), *WUP = (bf16*)(ws + WS_WUP), *WDOWN = (bf16*)(ws + WS_WDOWN), *WPG = (bf16*)(ws + WS_WPG), *WPP = (bf16*)(ws + WS_WPP);
    float *SSQ1 = (float*)(ws + WS_SSQ1), *SSQ2 = (float*)(ws + WS_SSQ2), *SSQ3 = (float*)(ws + WS_SSQ3);
    bf16 *PB = (bf16*)(ws + WS_PB), *XN = (bf16*)(ws + WS_XN), *Ub = (bf16*)(ws + WS_U), *Qb = (bf16*)(ws + WS_Q), *Kb = (bf16*)(ws + WS_K), *Vb = (bf16*)(ws + WS_V), *Gb = (bf16*)(ws + WS_G);
    bf16 *Yb = (bf16*)(ws + WS_Y), *YSB = (bf16*)(ws + WS_YSB), *MG = (bf16*)(ws + WS_MG), *Hb = (bf16*)(ws + WS_H), *PPb = (bf16*)(ws + WS_PP), *Xb = (bf16*)(ws + WS_X);

    for (int i = threadIdx.x; i < (LDS_BYTES - LDSCTL_OFF) / 4; i += NWAVES * 64) ((LAS unsigned*)(L + LDSCTL_OFF))[i] = 0u;
    __syncthreads();
    XcdBarrier bar; bar.bar = (unsigned*)(ctl + CW_BAR); bar.x = 0; bar.st = nullptr;
    if (MK_N_LAUNCHES == 1) bar = xcd_barrier_post((unsigned*)(ctl + CW_BAR), MISC + 8);
    const int lo = args.ph_lo, hi = args.ph_hi;
#define IN(k) (lo <= (k) && (k) < hi)
#ifdef DBG_BARCHK
#define SEAM(k) do { if (IN(k) && IN((k) + 1)) { if (threadIdx.x == 0) __hip_atomic_fetch_add((unsigned*)(ctl + 65536 + 64 * (k)), 1u, __ATOMIC_RELAXED, __HIP_MEMORY_SCOPE_AGENT); xcd_barrier(bar); \
    if (threadIdx.x == 0) { const unsigned v_ = __hip_atomic_load((unsigned*)(ctl + 65536 + 64 * (k)), __ATOMIC_RELAXED, __HIP_MEMORY_SCOPE_AGENT); if (v_ != (unsigned)G) { __hip_atomic_store((unsigned*)(ctl + 65536 + 64 * 32), 1u, __ATOMIC_RELAXED, __HIP_MEMORY_SCOPE_AGENT); out[O_KP + (k)] = __builtin_nanf(""); } } } } while (0)
#else
#define SEAM(k) do { if (IN(k) && IN((k) + 1)) xcd_barrier(bar); } while (0)
#endif
    const int gw = vcu * NWAVES + wave, NGW = G * NWAVES;
    const bool late_ = (vcu & 1) != 0;

#pragma unroll 1
    for (int rep_ = 0; rep_ < ((IN(0)) ? ((DBG_REPEAT == 0) ? 2 : 1) : 0); ++rep_) {
        if (rep_ > 0) xcd_barrier(bar);
        FRESH_TID();
        LAS float* scr = (LAS float*)(L + RING_OFF + wave * 16384);
        constexpr int I_IN = (DM / 64) * (INW / 32), I_SB = (SBW / 64) * (DM / 32), I_OUT = (DM / 64) * (DM / 32), I_UP = (DM / 64) * (DFF / 32), I_DOWN = (DFF / 64) * (DM / 32), I_PG = I_OUT, I_PP = (PLE / 64) * (DM / 32), I_EFF = 4 * 16 * 16;
        constexpr int NITEMS = I_IN + I_SB + I_OUT + I_UP + I_DOWN + I_PG + I_PP + I_EFF;
        for (int it = gw; it < NITEMS; it += NGW) {
            int r = it;
            if (r < I_EFF) { weff_item(w_grp, pool_scale, w_pool_up, WEFF, r, lane); continue; } r -= I_EFF;
            if (r < I_IN) { p0_transpose_item(w_in, DM, INW, WIN, 0, scr, r, lane); continue; } r -= I_IN;
            if (r < I_SB) { p0_transpose_item(w_sb_up, SBW, DM, WSB, 0, scr, r, lane); continue; } r -= I_SB;
            if (r < I_OUT) { p0_transpose_item(w_out, DM, DM, WOUT, 0, scr, r, lane); continue; } r -= I_OUT;
            if (r < I_UP) { p0_transpose_item(w_up, DM, DFF, WUP, 0, scr, r, lane); continue; } r -= I_UP;
            if (r < I_DOWN) { p0_transpose_item(w_down, DFF, DM, WDOWN, 0, scr, r, lane); continue; } r -= I_DOWN;
            if (r < I_PG) { p0_transpose_item(w_ple_gate, DM, DM, WPG, 0, scr, r, lane); continue; } r -= I_PG;
            p0_transpose_item(w_ple_proj, PLE, DM, WPP, 0, scr, r, lane);
        }
        for (int m = gw; m < MT; m += 2 * NGW) { const int m1 = m + NGW; const bool two = m1 < MT;
            const float* xr0 = m < MP ? x_p + (size_t)m * DM : x_s + (size_t)(m - MP) * DM;
            const float* xr1 = !two ? nullptr : (m1 < MP ? x_p + (size_t)m1 * DM : x_s + (size_t)(m1 - MP) * DM);
            const float* pr0 = m < MP ? p_p + (size_t)m * PLE : p_s + (size_t)(m - MP) * PLE;
            const float* pr1 = !two ? pr0 : (m1 < MP ? p_p + (size_t)m1 * PLE : p_s + (size_t)(m1 - MP) * PLE);
            const f32x4 pv0 = __builtin_nontemporal_load((const GAS f32x4*)pr0 + lane), pv1 = __builtin_nontemporal_load((const GAS f32x4*)pr1 + lane);
            rms_rows_to_bf16(xr0, xr1, g_mix, XN + (size_t)m * DM, XN + (size_t)(two ? m1 : m) * DM, lane);
            *((GAS unsigned long long*)(PB + (size_t)m * PLE) + lane) = (unsigned long long)pk2(pv0.x, pv0.y) | ((unsigned long long)pk2(pv0.z, pv0.w) << 32);
            if (two) *((GAS unsigned long long*)(PB + (size_t)m1 * PLE) + lane) = (unsigned long long)pk2(pv1.x, pv1.y) | ((unsigned long long)pk2(pv1.z, pv1.w) << 32);
        }
    }
    SEAM(0);
#pragma unroll 1
    for (int rep_ = 0; rep_ < ((IN(1)) ? ((DBG_REPEAT == 1) ? 2 : 1) : 0); ++rep_) {
        if (rep_ > 0) xcd_barrier(bar);
#pragma unroll 1
        for (int pass_ = 0; pass_ < 2; ++pass_) if ((pass_ == 1) == late_) {
        for (int task = vcu; task < 16 * (INW / 256); task += G) { const int rb = task & 15, col0 = (task >> 4) * 256; f32x4 vv[2][2];
            sk::tile4(XN, WIN, DM, (size_t)MP + rb * 32, col0, (SK_LAS char*)(L + RING_OFF), vv);
            const int t = threadIdx.x, rs = rb * 32 + (t >> 4), r = MP + rs;
#pragma unroll
            for (int h = 0; h < 2; ++h)
#pragma unroll
                for (int q = 0; q < 2; ++q) { const f32x4 v = vv[h][q]; const int c = col0 + 128 * h + 64 * q + (t & 15) * 4;
            if (c < 512) { *(GAS unsigned long long*)(Ub + (size_t)r * 512 + c) = sk::pk4(v); const int i = rs & 31; if (i >= 17) *(GAS f32x4*)(out + O_POOLS + ((size_t)(rs >> 5) * 15 + (i - 17)) * 512 + c) = v; }
            else if (c < 1024) *(GAS unsigned long long*)(Qb + (size_t)r * 512 + c - 512) = sk::pk4(v * QSCALE);
            else if (c < 1536) { *(GAS unsigned long long*)(Kb + (size_t)r * 512 + c - 1024) = sk::pk4(v); *(GAS f32x4*)(out + O_KS + (size_t)rs * 512 + c - 1024) = v; }
            else if (c < 2048) { *(GAS unsigned long long*)(Vb + (size_t)r * 512 + c - 1536) = sk::pk4(v); *(GAS f32x4*)(out + O_VS + (size_t)rs * 512 + c - 1536) = v; }
            else { const f32x4 bg = *(const GAS f32x4*)(b_gate + c - 2048); *(GAS unsigned*)((unsigned char*)Gb + (size_t)r * 2048 + c - 2048) = pg8::pk_u8x4(pg8::sigm4(v + bg)); } }
        }
        } else {
        pg8::Gemm g{XN, WIN, MP, INW, DM}; pg8::RotOrder S; S.init(MP, INW, G, bx, DBG_ROT);
        pg8::EpiIn E{Ub, Qb, Kb, Vb, Gb, b_gate, out + O_KP, out + O_VP, out + O_KS, out + O_VS, out + O_POOLP, out + O_POOLS};
        pg8::gemm_phase<pg8::EpiIn, pg8::RotOrder, DBG_ALIGN, DBG_SP2>(L + RING_OFF, g, S, E);
        }
#ifdef DBG_PREDELAY
        { const unsigned long long t0_ = __builtin_amdgcn_s_memrealtime(); while (__builtin_amdgcn_s_memrealtime() - t0_ < DBG_PREDELAY) __builtin_amdgcn_s_sleep(16); __syncthreads(); }
#endif
#ifdef DBG_PREFENCE
        __threadfence(); __syncthreads();
#endif
    }
    SEAM(1);
#ifdef DBG_GDUMP
#ifndef DBG_DUMPBUF
#define DBG_DUMPBUF WS_G
#define DBG_DUMPLD 2048
#endif
    for (int it = (vcu * NWAVES * 64 + (int)threadIdx.x); it < MT * 128; it += G * NWAVES * 64) {
        const int m = it >> 7, c = (it & 127) * 8; const v4u w = *(const GAS v4u*)((const bf16*)(ws + DBG_DUMPBUF) + (size_t)m * DBG_DUMPLD + ((DBG_GDUMP + c) % DBG_DUMPLD)); f32x4 a, b; pg8::unpack8(w, a, b);
        *(GAS f32x4*)(Yo + (size_t)m * 1024 + c) = a; *(GAS f32x4*)(Yo + (size_t)m * 1024 + c + 4) = b; }
#endif
#ifdef DBG_DELAY
    { const unsigned long long t0_ = __builtin_amdgcn_s_memrealtime(); while (__builtin_amdgcn_s_memrealtime() - t0_ < DBG_DELAY) __builtin_amdgcn_s_sleep(16); __syncthreads(); }
#endif
#ifndef DBG_SKIP_P2
#define DBG_SKIP_P2 0
#endif
    if (IN(2) && (DBG_SKIP_P2 & 8)) {
        for (int it = (vcu * NWAVES * 64 + (int)threadIdx.x); it < MT * 64; it += G * NWAVES * 64) {
            const int m = it >> 6, c = (it & 63) * 8; f32x4 a, b;
            for (int e = 0; e < 4; ++e) { a[e] = (float)(((m * 31 + (c + e) * 17) & 255) - 128) * (1.0f / 128.0f); b[e] = (float)(((m * 13 + (c + 4 + e) * 29) & 255) - 128) * (1.0f / 128.0f); }
            *(GAS v4u*)(Yb + (size_t)m * 512 + c) = pg8::pack8(a, b); *(GAS v4u*)(YSB + (size_t)m * 512 + c) = pg8::pack8(b, a);
            if (DBG_SKIP_P2 & 16) { *(GAS v4u*)(MG + (size_t)m * 1024 + c) = pg8::pack8(a, b); *(GAS v4u*)(MG + (size_t)m * 1024 + 512 + c) = pg8::pack8(b, a); }
        }
    }
#pragma unroll 1
    for (int rep_ = 0; rep_ < ((IN(2) && !(DBG_SKIP_P2 & 12)) ? ((DBG_REPEAT == 2) ? 2 : 1) : 0); ++rep_) {
        if (rep_ > 0) xcd_barrier(bar);
        FRESH_TID();
        const bool do_pool_ = (rep_ == 0) || DBG_P2PART == 0 || DBG_P2PART == 1, do_att_ = (rep_ == 0) || DBG_P2PART == 0 || DBG_P2PART == 2, do_sam_ = (rep_ == 0) || DBG_P2PART == 0 || DBG_P2PART == 3;
        if (do_pool_)
        for (int wi = wave * G + vcu; wi < 4 * (MT / 64); wi += NGW) { const int g = wi & 3, run = (wi >> 2) * 4 + (lane >> 4), c = g * 128 + (lane & 15) * 8;
            if (g == 0) pool_run<2, 16>(Ub, state_pool, Yb, run, c); else if (g == 1) pool_run<4, 16>(Ub, state_pool, Yb, run, c); else if (g == 2) pool_run<8, 16>(Ub, state_pool, Yb, run, c);
            else { pool_run<16, 8>(Ub, state_pool, Yb, 2 * run, c); asm volatile("" ::: "memory"); pool_run<16, 8>(Ub, state_pool, Yb, 2 * run + 1, c); } }
        const sba::Tensors T{Qb, Kb, Vb, YSB, cache_k, cache_v};
        if (do_att_) {
#pragma unroll 1
        for (int i2 = 2 * vcu; i2 < 512; i2 += ((i2 & 1) ? 2 * G - 1 : 1)) { const int i = i2 >> 1, bh = i >> 2, s = i & 3;
            sba::sb_unit<false>(bh >> 3, bh & 7, (i2 & 1) ? 7 - s : s, T, (SB_LAS char*)(L + RING_OFF)); }
        }
        if (do_sam_) {
        for (int i = G - 1 - vcu; i < 128; i += G) sba::sb_unit<true>(i >> 3, i & 7, 0, T, (SB_LAS char*)(L + RING_OFF));
        }
    }
    SEAM(2);
#pragma unroll 1
    for (int rep_ = 0; rep_ < ((IN(3) && !(DBG_SKIP_P2 & 16)) ? ((DBG_REPEAT == 3) ? 2 : 1) : 0); ++rep_) {
        if (rep_ > 0) xcd_barrier(bar);
#pragma unroll 1
        for (int pass_ = 0; pass_ < 2; ++pass_) if ((pass_ == 1) == late_) {
        for (int task = vcu; task < 16 * (DM / 64); task += G) { const int rb = task & 15, col0 = (task >> 4) * 64;
            const f32x4 va = sk::tile(Yb, WEFF, PW, (size_t)MP + rb * 32, col0, (SK_LAS char*)(L + RING_OFF));
            const f32x4 vb = sk::tile(YSB, WSB, SBW, (size_t)MP + rb * 32, col0, (SK_LAS char*)(L + RING_OFF));
            const int t = threadIdx.x, r = MP + rb * 32 + (t >> 4), c = col0 + (t & 15) * 4;
            const f32x4 ga = pg8::up_u8x4(*(const GAS unsigned*)((const unsigned char*)Gb + (size_t)r * 2048 + c)), gb = pg8::up_u8x4(*(const GAS unsigned*)((const unsigned char*)Gb + (size_t)r * 2048 + 1024 + c));
            *(GAS unsigned long long*)(MG + (size_t)r * 1024 + c) = sk::pk4(ga * va + gb * vb);
        }
        } else {
        { pg8::Gemm g{Yb, WEFF, MP, DM, PW, YSB, WSB}; pg8::PairOrder S; S.init(MP, DM, G, bx); pg8::EpiMerge E{Gb, MG};
          pg8::gemm_phase<pg8::EpiMerge, pg8::PairOrder, DBG_ALIGN, DBG_SP2>(L + RING_OFF, g, S, E); }
        }
    }
    SEAM(3);
#pragma unroll 1
    for (int rep_ = 0; rep_ < ((IN(4)) ? ((DBG_REPEAT == 4) ? 2 : 1) : 0); ++rep_) {
        if (rep_ > 0) xcd_barrier(bar);
#pragma unroll 1
        for (int pass_ = 0; pass_ < 2; ++pass_) if ((pass_ == 1) == late_) {
        for (int task = vcu; task < 16 * (DM / 64); task += G) { const int rb = task & 15, col0 = (task >> 4) * 64;
            const f32x4 v = sk::tile(MG, WOUT, DM, (size_t)MP + rb * 32, col0, (SK_LAS char*)(L + RING_OFF));
            const int t = threadIdx.x, rs = rb * 32 + (t >> 4), r = MP + rs, c = col0 + (t & 15) * 4;
            const f32x4 x1 = *(const GAS f32x4*)(x_s + (size_t)rs * DM + c) + v; *(GAS unsigned long long*)(Xb + (size_t)r * DM + c) = sk::pk4(x1);
            *(GAS unsigned long long*)(XN + (size_t)r * DM + c) = sk::pk4(x1 * *(const GAS f32x4*)(g_mlp + c));
            const float ss = sk::sum16(pg8::dot4(x1)); if ((t & 15) == 0) SSQ1[(size_t)r * 16 + (col0 >> 6)] = ss;
        }
        } else {
        pg8::Gemm g{MG, WOUT, MP, DM, DM}; pg8::StaticOrder S; S.init(MP, DM, G, bx); pg8::EpiResid<true> E{x_p, Xb, XN, g_mlp, SSQ1};
        pg8::gemm_phase<pg8::EpiResid<true>, pg8::StaticOrder, DBG_ALIGN, DBG_SP2>(L + RING_OFF, g, S, E);
        }
    }
    SEAM(4);
#pragma unroll 1
    for (int rep_ = 0; rep_ < ((IN(5)) ? ((DBG_REPEAT == 5) ? 2 : 1) : 0); ++rep_) {
        if (rep_ > 0) xcd_barrier(bar);
#pragma unroll 1
        for (int pass_ = 0; pass_ < 2; ++pass_) if ((pass_ == 1) == late_) {
        for (int task = vcu; task < 16 * (DFF / 256); task += G) { const int rb = task & 15, col0 = (task >> 4) * 256; f32x4 vv[2][2];
            sk::tile4(XN, WUP, DM, (size_t)MP + rb * 32, col0, (SK_LAS char*)(L + RING_OFF), vv);
            const int t = threadIdx.x, r = MP + rb * 32 + (t >> 4); const float rs_ = sk::rstd16(SSQ1, r, t);
#pragma unroll
            for (int h = 0; h < 2; ++h)
#pragma unroll
                for (int q = 0; q < 2; ++q) { const int c = col0 + 128 * h + 64 * q + (t & 15) * 4; const f32x4 a = __builtin_elementwise_max(vv[h][q] * rs_, (f32x4){0.f, 0.f, 0.f, 0.f});
                    *(GAS unsigned long long*)(Hb + (size_t)r * DFF + c) = sk::pk4(a * a); }
        }
        } else {
        pg8::Gemm g{XN, WUP, MP, DFF, DM}; pg8::StaticOrder S; S.init(MP, DFF, G, bx); pg8::EpiUp E{SSQ1, Hb};
        pg8::gemm_phase<pg8::EpiUp, pg8::StaticOrder, DBG_ALIGN, DBG_SP2>(L + RING_OFF, g, S, E);
        }
    }
    SEAM(5);
    if (IN(5) && DBG_REPEAT == 15) {
        { pg8::Gemm g{XN, WUP, MP, DFF, DM}; pg8::StaticOrder S; S.init(MP, DFF, G, bx); pg8::EpiNull E{SSQ3};
          pg8::gemm_phase<pg8::EpiNull, pg8::StaticOrder, DBG_ALIGN, DBG_SP2>(L + RING_OFF, g, S, E); }
        xcd_barrier(bar);
    }
    if (IN(5) && DBG_REPEAT == 25) {
        for (int task = vcu; task < 16 * (DFF / 256); task += G) { const int rb = task & 15, col0 = (task >> 4) * 256; f32x4 vv[2][2];
            sk::tile4(XN, WUP, DM, (size_t)MP + rb * 32, col0, (SK_LAS char*)(L + RING_OFF), vv); if (vv[0][0][0] + vv[1][1][0] + vv[0][1][0] + vv[1][0][0] == 1.2345e33f) SSQ3[0] = vv[0][0][1]; }
        xcd_barrier(bar);
    }
    if (IN(6) && DBG_REPEAT == 6) {
        { pg8::Gemm g{Hb, WDOWN, MP, DM, DFF}; pg8::StaticOrder S; S.init(MP, DM, G, bx); pg8::EpiNull E{SSQ3};
          pg8::gemm_phase<pg8::EpiNull, pg8::StaticOrder, DBG_ALIGN, DBG_SP2>(L + RING_OFF, g, S, E); }
        xcd_barrier(bar);
    }
    if (IN(6) && DBG_REPEAT == 16) {
        for (int task = vcu; task < 16 * (DM / 64); task += G) { const int rb = task & 15, col0 = (task >> 4) * 64;
            const f32x4 v = sk::tile(Hb, WDOWN, DFF, (size_t)MP + rb * 32, col0, (SK_LAS char*)(L + RING_OFF)); if (v[0] == 1.2345e33f) SSQ3[0] = v[1]; }
        xcd_barrier(bar);
    }
    if (IN(6)) {
#pragma unroll 1
        for (int pass_ = 0; pass_ < 2; ++pass_) if ((pass_ == 1) == late_) {
        for (int task = vcu; task < 16 * (DM / 64); task += G) { const int rb = task & 15, col0 = (task >> 4) * 64;
            const f32x4 v = sk::tile(Hb, WDOWN, DFF, (size_t)MP + rb * 32, col0, (SK_LAS char*)(L + RING_OFF));
            const int t = threadIdx.x, r = MP + rb * 32 + (t >> 4), c = col0 + (t & 15) * 4;
            const f32x4 x2 = sk::up4(*(const GAS unsigned long long*)(Xb + (size_t)r * DM + c)) + v; *(GAS unsigned long long*)(Xb + (size_t)r * DM + c) = sk::pk4(x2);
            *(GAS unsigned long long*)(XN + (size_t)r * DM + c) = sk::pk4(x2 * *(const GAS f32x4*)(g_ple + c));
            const float ss = sk::sum16(pg8::dot4(x2)); if ((t & 15) == 0) SSQ2[(size_t)r * 16 + (col0 >> 6)] = ss;
        }
        } else {
        { pg8::Gemm g{Hb, WDOWN, MP, DM, DFF}; pg8::StaticOrder S; S.init(MP, DM, G, bx); pg8::EpiResid<false> E{nullptr, Xb, XN, g_ple, SSQ2};
          pg8::gemm_phase<pg8::EpiResid<false>, pg8::StaticOrder, DBG_ALIGN, DBG_SP2>(L + RING_OFF, g, S, E); }
        }
    }
    SEAM(6);
    if (IN(7) && DBG_REPEAT == 7) {
        { pg8::Gemm g{PB, WPP, MP, DM, PLE}; pg8::StaticOrder S; S.init(MP, DM, G, bx); pg8::EpiNull E{SSQ3};
          pg8::gemm_phase<pg8::EpiNull, pg8::StaticOrder, DBG_ALIGN, DBG_SP2>(L + RING_OFF, g, S, E); }
        { pg8::Gemm g{XN, WPG, MP, DM, DM}; pg8::StaticOrder S; S.init(MP, DM, G, bx); pg8::EpiNull E{SSQ3};
          pg8::gemm_phase<pg8::EpiNull, pg8::StaticOrder, DBG_ALIGN, DBG_SP2>(L + RING_OFF, g, S, E); }
        xcd_barrier(bar);
    }
    if (IN(7) && DBG_REPEAT == 17) {
        for (int task = vcu; task < 16 * (DM / 64); task += G) { const int rb = task & 15, col0 = (task >> 4) * 64;
            const f32x4 vp = sk::tile(PB, WPP, PLE, (size_t)MP + rb * 32, col0, (SK_LAS char*)(L + RING_OFF));
            const f32x4 vg = sk::tile(XN, WPG, DM, (size_t)MP + rb * 32, col0, (SK_LAS char*)(L + RING_OFF)); if (vp[0] + vg[0] == 1.2345e33f) SSQ3[0] = vp[1]; }
        xcd_barrier(bar);
    }
    if (IN(7) && DBG_REPEAT == 27) {
        { pg8::Gemm g{PB, WPP, MP, DM, PLE}; pg8::StaticOrder S; S.init(MP, DM, G, bx); pg8::EpiPP E{PPb};
          pg8::gemm_phase<pg8::EpiPP, pg8::StaticOrder, DBG_ALIGN, DBG_SP2>(L + RING_OFF, g, S, E); }
        xcd_barrier(bar);
    }
    if (IN(7)) {
#pragma unroll 1
        for (int pass_ = 0; pass_ < 2; ++pass_) if ((pass_ == 1) == late_) {
        for (int task = vcu; task < 16 * (DM / 64); task += G) { const int rb = task & 15, col0 = (task >> 4) * 64;
            const f32x4 vp = sk::tile(PB, WPP, PLE, (size_t)MP + rb * 32, col0, (SK_LAS char*)(L + RING_OFF));
            const f32x4 vg = sk::tile(XN, WPG, DM, (size_t)MP + rb * 32, col0, (SK_LAS char*)(L + RING_OFF));
            const int t = threadIdx.x, r = MP + rb * 32 + (t >> 4), c = col0 + (t & 15) * 4;
            const float rs_ = sk::rstd16(SSQ2, r, t);
            const f32x4 x3 = sk::up4(*(const GAS unsigned long long*)(Xb + (size_t)r * DM + c)) + pg8::sigm4(vg * rs_) * vp;
            const float ss = sk::sum16(pg8::dot4(x3)); if ((t & 15) == 0) __hip_atomic_store(SSQ3 + (size_t)r * 16 + (col0 >> 6), ss, __ATOMIC_RELAXED, __HIP_MEMORY_SCOPE_AGENT);
            asm volatile("s_waitcnt vmcnt(0)" ::: "memory");
            unsigned* cw = (unsigned*)(ctl + CW_FINS + 64 * rb);
            if ((t & 63) == 0) __hip_atomic_fetch_add(cw, 1u, __ATOMIC_RELAXED, __HIP_MEMORY_SCOPE_AGENT);
            { unsigned spins = 0; while ((unsigned)__builtin_amdgcn_readfirstlane(__hip_atomic_load(cw, __ATOMIC_RELAXED, __HIP_MEMORY_SCOPE_AGENT)) < 128u) { __builtin_amdgcn_s_sleep(2); if (++spins > (1u << 16)) break; } }
            const float r3 = __builtin_amdgcn_rsqf(sk::sum16(__hip_atomic_load(SSQ3 + (size_t)r * 16 + (t & 15), __ATOMIC_RELAXED, __HIP_MEMORY_SCOPE_AGENT)) * (1.0f / 1024.0f) + EPS);
            *(GAS f32x4*)(Yo + (size_t)r * DM + c) = x3 * r3 * *(const GAS f32x4*)(g_final + c);
        }
        } else {
        { pg8::Gemm g{PB, WPP, MP, DM, PLE}; pg8::StaticOrder S; S.init(MP, DM, G, bx); pg8::EpiPP E{PPb};
          pg8::gemm_phase<pg8::EpiPP, pg8::StaticOrder, DBG_ALIGN, DBG_SP2>(L + RING_OFF, g, S, E); }
        { pg8::Gemm g{XN, WPG, MP, DM, DM}; pg8::StaticOrder S; S.init(MP, DM, G, bx); pg8::EpiPleFinal E{SSQ2, PPb, Xb, Yo, SSQ3, g_final, (unsigned*)(ctl + CW_FIN)};
          pg8::gemm_phase<pg8::EpiPleFinal, pg8::StaticOrder, DBG_ALIGN, DBG_SP2>(L + RING_OFF, g, S, E); }
        }
    }
#undef IN
#undef SEAM
}

extern "C" void kernel_launch(void* const* d_in, const int* in_sizes, int n_in, void* d_out, int out_size, void* d_ws, size_t ws_size, hipStream_t stream) {
    static int grid = 0;
    if (grid == 0) {
        if (n_in != 22 || out_size != (int)O_END || ws_size < WS_END) { fprintf(stderr, "kernel_launch: unexpected sizes: n_in %d out %d ws %zu\n", n_in, out_size, ws_size); grid = -1; return; }
        int dev = 0, cus = 0, per_cu = 0;
        if (hipGetDevice(&dev) != hipSuccess || hipDeviceGetAttribute(&cus, hipDeviceAttributeMultiprocessorCount, dev) != hipSuccess) { grid = -1; return; }
        if (hipFuncSetAttribute((const void*)mega_fwd, hipFuncAttributeMaxDynamicSharedMemorySize, LDS_BYTES) != hipSuccess) { fprintf(stderr, "kernel_launch: hipFuncSetAttribute failed\n"); grid = -1; return; }
        if (hipOccupancyMaxActiveBlocksPerMultiprocessor(&per_cu, (const void*)mega_fwd, NWAVES * 64, LDS_BYTES) != hipSuccess || per_cu < 1) { fprintf(stderr, "kernel_launch: occupancy query says %d\n", per_cu); (void)hipGetLastError(); per_cu = 1; }
        grid = cus;
    }
    if (grid < 0) return;
    (void)hipMemsetAsync((char*)d_ws + WS_CTL, 0, CTL_ZERO_BYTES, stream);
    Args a{};
    for (int i = 0; i < 22; ++i) a.in[i] = (const float*)d_in[i];
    a.out = (float*)d_out; a.ws = (unsigned char*)d_ws;
#ifndef DBG_PH_HI
#define DBG_PH_HI N_PHASES
#endif
    if (MK_N_LAUNCHES == 1) { a.ph_lo = 0; a.ph_hi = DBG_PH_HI; a.li = 0; hipLaunchKernelGGL(mega_fwd, dim3(grid), dim3(NWAVES * 64), LDS_BYTES, stream, a); }
    else for (int li = 0; li < N_PHASES; ++li) { a.ph_lo = li; a.ph_hi = li + 1; a.li = li; hipLaunchKernelGGL(mega_fwd, dim3(grid), dim3(NWAVES * 64), LDS_BYTES, stream, a);
#if defined(HYB_ATTN)
        if (li == 2) hyb_attn<<<(MT * NH + 63) / 64, 64, 0, stream>>>((const unsigned short*)((char*)d_ws + WS_Q), (const unsigned short*)((char*)d_ws + WS_K), (const unsigned short*)((char*)d_ws + WS_V), (const float*)d_in[2], (const float*)d_in[3], (unsigned short*)((char*)d_ws + WS_YSB));
#endif
#if defined(HYB_POOL)
        if (li == 2) hyb_pool<<<(int)(((size_t)MT * PW + 255) / 256), 256, 0, stream>>>((const unsigned short*)((char*)d_ws + WS_U), (const float*)d_in[4], (unsigned short*)((char*)d_ws + WS_Y));
#endif
    }
}
```

```cpp
#include <hip/hip_runtime.h>
#include <hip/hip_bf16.h>
#include <cstdio>
#include <cstdint>
#include <cmath>
namespace cfg {
constexpr int DM = 1024, NB = 8, SEQ = 2048, DB = 16, DS = 32, PAST = 1024, PW = 512, SBW = 512, HD = 64, NH = 8, DFF = 4096, PLE = 256, INW = 4096;
constexpr int MP = NB * SEQ, MS = DB * DS, MT = MP + MS;
constexpr float EPS = 1e-6f;
constexpr float QSCALE = 0.125f * 1.4426950408889634f;
}
namespace pg8 {
#define PG8_LAS __attribute__((address_space(3)))
typedef unsigned short bf16_t;
typedef short bf16x8 __attribute__((ext_vector_type(8)));
typedef float f32x4 __attribute__((ext_vector_type(4)));
typedef unsigned u32x4 __attribute__((ext_vector_type(4)));
constexpr int BM = 256, BK = 64, HALF = 128, HTB = HALF * BK * 2  , STAGE_BYTES = 8 * HTB, NXCD = 8, WGM = 8;

__host__ __device__ __forceinline__ int lds_byte(int r, int c) { const int st = (r >> 4) * 2 + (c >> 5), rr = r & 15, cc = c & 31, ob = rr * 64 + cc * 2; return st * 1024 + (ob ^ (((ob >> 9) & 1) << 5)); }
__host__ __device__ __forceinline__ void stage_rc(int b, int& R, int& C) { const int st = b / 1024, sb = b % 1024, swz = sb ^ (((sb >> 9) & 1) << 5); R = (st >> 1) * 16 + swz / 64; C = (st & 1) * 32 + (swz % 64) / 2; }
__host__ __device__ __forceinline__ int perm32(int rho) { const int n = rho >> 4, i = rho & 15; return 8 * (i >> 2) + 4 * n + (i & 3); }

struct Unit { int pm, pn, seg; };
struct Gemm { const bf16_t* A; const bf16_t* Bt; int M, N, K; const bf16_t* A1 = nullptr; const bf16_t* Bt1 = nullptr; };

struct StaticOrder {
    int nM, nN, nwg, G, c;
    __host__ __device__ void init(int M, int N, int G_, int c_) { nM = M / BM; nN = N / BM; nwg = nM * nN; G = G_; c = c_; }
    __host__ __device__ bool next(int i, Unit& u) const {
        const long L = (long)i * G + c; if (L >= nwg) return false;
        int wgid = (int)L; { const int q = nwg / NXCD, r = nwg % NXCD, xcd = wgid % NXCD, off = wgid / NXCD; wgid = (xcd < r ? xcd * (q + 1) : r * (q + 1) + (xcd - r) * q) + off; }
        const int nig = WGM * nN, gid = wgid / nig, fm = gid * WGM, gsz = (nM - fm) < WGM ? (nM - fm) : WGM;
        u.pm = fm + ((wgid % nig) % gsz); u.pn = (wgid % nig) / gsz; u.seg = 0; return true;
    }
    __device__ __forceinline__ void a_ready(const Unit&) const {}
    __device__ __forceinline__ void done(const Unit&) const {}
};
struct RotOrder : StaticOrder {
    int rot, cnt;
    __host__ __device__ void init(int M, int N, int G_, int c_, int rot_) { StaticOrder::init(M, N, G_, c_); cnt = (nwg % G_ == 0) ? nwg / G_ : 0; rot = rot_; }
    __host__ __device__ bool next(int i, Unit& u) const { if (cnt == 0) return StaticOrder::next(i, u); if (i >= cnt) return false; return StaticOrder::next((i + rot) % cnt, u); }
};
struct PairOrder : StaticOrder {
    __host__ __device__ bool next(int i, Unit& u) const { if (!StaticOrder::next(i >> 1, u)) return false; u.seg = i & 1; return true; }
};
typedef float f32x2v_t __attribute__((ext_vector_type(2))); typedef __bf16 bf16x2v_t __attribute__((ext_vector_type(2)));
__device__ __forceinline__ unsigned cvt_pk_bf16(float lo, float hi) { f32x2v_t v = {lo, hi}; bf16x2v_t b = __builtin_convertvector(v, bf16x2v_t); return __builtin_bit_cast(unsigned, b); }
typedef float f32x2 __attribute__((ext_vector_type(2)));
__device__ __forceinline__ float bf_lo(unsigned w) { return __uint_as_float(w << 16); }
__device__ __forceinline__ float bf_hi(unsigned w) { return __uint_as_float(w & 0xffff0000u); }
__device__ __forceinline__ u32x4 pack8(f32x4 a, f32x4 b) { u32x4 w; w.x = cvt_pk_bf16(a[0], a[1]); w.y = cvt_pk_bf16(a[2], a[3]); w.z = cvt_pk_bf16(b[0], b[1]); w.w = cvt_pk_bf16(b[2], b[3]); return w; }
__device__ __forceinline__ void unpack8(u32x4 w, f32x4& a, f32x4& b) { a = (f32x4){bf_lo(w.x), bf_hi(w.x), bf_lo(w.y), bf_hi(w.y)}; b = (f32x4){bf_lo(w.z), bf_hi(w.z), bf_lo(w.w), bf_hi(w.w)}; }
__device__ __forceinline__ float sigm(float x) { return __builtin_amdgcn_rcpf(1.f + __builtin_amdgcn_exp2f(-1.4426950408889634f * x)); }
__device__ __forceinline__ f32x4 sigm4(f32x4 x) { return (f32x4){sigm(x[0]), sigm(x[1]), sigm(x[2]), sigm(x[3])}; }
__device__ __forceinline__ float dot4(f32x4 a) { return (a[0] * a[0] + a[1] * a[1]) + (a[2] * a[2] + a[3] * a[3]); }
#ifndef DBG_LDAUX
#define DBG_LDAUX 16
#endif
__device__ __forceinline__ u32x4 ld16_sc1(const void* base, size_t byte_off) {
    const __amdgpu_buffer_rsrc_t rs = __builtin_amdgcn_make_buffer_rsrc((void*)base, (short)0, 0x7fffffff, 0x00020000);
    return __builtin_bit_cast(u32x4, __builtin_amdgcn_raw_buffer_load_b128(rs, (unsigned)byte_off, 0, DBG_LDAUX));
}
__device__ __forceinline__ unsigned pk_u8x4(f32x4 g) { unsigned w = 0u; w = __builtin_amdgcn_cvt_pk_u8_f32(g[0] * 255.0f, 0, w); w = __builtin_amdgcn_cvt_pk_u8_f32(g[1] * 255.0f, 1, w); w = __builtin_amdgcn_cvt_pk_u8_f32(g[2] * 255.0f, 2, w); w = __builtin_amdgcn_cvt_pk_u8_f32(g[3] * 255.0f, 3, w); return w; }
__device__ __forceinline__ f32x4 up_u8x4(unsigned w) { return (f32x4){(float)(w & 0xffu), (float)((w >> 8) & 0xffu), (float)((w >> 16) & 0xffu), (float)(w >> 24)} * (1.0f / 255.0f); }
typedef unsigned u32x2 __attribute__((ext_vector_type(2)));
__device__ __forceinline__ float row_rstd(const float* SSQ, int r, int fq) {
    const f32x4 p = *(const f32x4*)(SSQ + (size_t)r * 16 + 4 * fq); float s = (p[0] + p[1]) + (p[2] + p[3]);
    s += __shfl_xor(s, 16); s += __shfl_xor(s, 32);
    return __builtin_amdgcn_rsqf(s * (1.0f / 1024.0f) + cfg::EPS);
}
#define PG8_ROWS(...) _Pragma("unroll") for (int ai = 0; ai < 2; ++ai) _Pragma("unroll") for (int m = 0; m < 4; ++m) { const int r = u.pm * BM + ai * HALF + wr * 64 + m * 16 + fr; __VA_ARGS__; if (m == 3) asm volatile("" ::: "memory"); }
#define PG8_COLS(...) _Pragma("unroll") for (int bj = 0; bj < 2; ++bj) { const int c = ct + bj * HALF + wc * 32 + 8 * fq; const f32x4 v0 = acc[ai][bj][m][0], v1 = acc[ai][bj][m][1]; __VA_ARGS__; }

struct EpiIn {
    static constexpr bool PERM = true, AFTER_DRAIN = false;
    bf16_t *U, *Q, *K, *V, *G; const float* b_gate; float *k_p, *v_p, *k_s, *v_s, *pool_p, *pool_s;
    __device__ __forceinline__ void operator()(const f32x4 (&acc)[2][2][4][2], const Unit& u, int wr, int wc, int fr, int fq) const {
        const int pn = u.pn;
        if (pn >= 8) {
            const int ct = (pn - 8) * BM; f32x4 bv[2][2];
#pragma unroll
            for (int bj = 0; bj < 2; ++bj) { const int c = ct + bj * HALF + wc * 32 + 8 * fq; bv[bj][0] = *(const f32x4*)(b_gate + c); bv[bj][1] = *(const f32x4*)(b_gate + c + 4); }
            PG8_ROWS(PG8_COLS(*(u32x2*)((unsigned char*)G + (size_t)r * 2048 + c) = (u32x2){pk_u8x4(sigm4(v0 + bv[bj][0])), pk_u8x4(sigm4(v1 + bv[bj][1]))}))
        } else if (pn >= 4) {
            const bool isv = pn >= 6; const int ct = (pn - (isv ? 6 : 4)) * BM; bf16_t* B = isv ? V : K; float* op = isv ? v_p : k_p; float* os = isv ? v_s : k_s;
            PG8_ROWS(float* orow = r < cfg::MP ? op + (size_t)r * 512 : os + (size_t)(r - cfg::MP) * 512;
                     PG8_COLS(*(u32x4*)(B + (size_t)r * 512 + c) = pack8(v0, v1); __builtin_nontemporal_store(v0, (f32x4*)(orow + c)); __builtin_nontemporal_store(v1, (f32x4*)(orow + c + 4))))
        } else if (pn >= 2) {
            const int ct = (pn - 2) * BM;
            PG8_ROWS(PG8_COLS(*(u32x4*)(Q + (size_t)r * 512 + c) = pack8(v0 * cfg::QSCALE, v1 * cfg::QSCALE)))
        } else {
            const int ct = pn * BM;
            PG8_ROWS(float* prow = nullptr;
                     if (r < cfg::MP) { const int t = r & (cfg::SEQ - 1); if (t >= cfg::SEQ - 15) prow = pool_p + ((size_t)(r >> 11) * 15 + (t - (cfg::SEQ - 15))) * 512; }
                     else { const int i = (r - cfg::MP) & 31; if (i >= 17) prow = pool_s + ((size_t)((r - cfg::MP) >> 5) * 15 + (i - 17)) * 512; }
                     PG8_COLS(*(u32x4*)(U + (size_t)r * 512 + c) = pack8(v0, v1); if (prow) { *(f32x4*)(prow + c) = v0; *(f32x4*)(prow + c + 4) = v1; }))
        }
    }
};
#if defined(DBG_ONLYG)
#define DBG_NOG_STMT *(u32x4*)(MG + (size_t)r * 1024 + c) = gw; continue;
#elif defined(DBG_NOG)
#define DBG_NOG_STMT g0 = (f32x4){0.5f, 0.5f, 0.5f, 0.5f}; g1 = g0;
#else
#define DBG_NOG_STMT
#endif
struct EpiMerge;
struct EpiMerge0 {
    static constexpr bool PERM = true, AFTER_DRAIN = false;
    const bf16_t* G; bf16_t* MG;
    __device__ __forceinline__ void operator()(const f32x4 (&acc)[2][2][4][2], const Unit& u, int wr, int wc, int fr, int fq) const {
        const int ct = u.pn * BM;
        PG8_ROWS(PG8_COLS(const u32x2 gw = *(const u32x2*)((const unsigned char*)G + (size_t)r * 2048 + c); const f32x4 g0 = up_u8x4(gw.x); const f32x4 g1 = up_u8x4(gw.y); *(u32x4*)(MG + (size_t)r * 1024 + c) = pack8(v0 * g0, v1 * g1)))
    }
};
#ifdef DBG_NORAW
#define DBG_NORAW_STMT m0 = (f32x4){0.f, 0.f, 0.f, 0.f}; m1 = m0;
#else
#define DBG_NORAW_STMT
#endif
struct EpiMerge1 {
    static constexpr bool PERM = true, AFTER_DRAIN = false;
    const bf16_t* G; bf16_t* MG;
    __device__ __forceinline__ void operator()(const f32x4 (&acc)[2][2][4][2], const Unit& u, int wr, int wc, int fr, int fq) const {
        const int ct = u.pn * BM;
        PG8_ROWS(PG8_COLS(const u32x2 gw = *(const u32x2*)((const unsigned char*)G + (size_t)r * 2048 + 1024 + c); const u32x4 mw = *(const u32x4*)(MG + (size_t)r * 1024 + c);
                          const f32x4 g0 = up_u8x4(gw.x); const f32x4 g1 = up_u8x4(gw.y); f32x4 m0; f32x4 m1; unpack8(mw, m0, m1); *(u32x4*)(MG + (size_t)r * 1024 + c) = pack8(m0 + v0 * g0, m1 + v1 * g1)))
    }
};
struct EpiMerge {
    static constexpr bool PERM = true, AFTER_DRAIN = false;
    const bf16_t* G; bf16_t* MG;
    __device__ __forceinline__ void operator()(const f32x4 (&acc)[2][2][4][2], const Unit& u, int wr, int wc, int fr, int fq) const {
        if (u.seg == 0) { const EpiMerge0 E0{G, MG}; E0(acc, u, wr, wc, fr, fq); } else { const EpiMerge1 E1{G, MG}; E1(acc, u, wr, wc, fr, fq); }
    }
};
template <bool F32RES>
struct EpiResid {
    static constexpr bool PERM = true, AFTER_DRAIN = false;
    const float* res_p; bf16_t* X; bf16_t* XG; const float* gvec; float* SSQ;
    __device__ __forceinline__ void operator()(const f32x4 (&acc)[2][2][4][2], const Unit& u, int wr, int wc, int fr, int fq) const {
        const int ct = u.pn * BM; f32x4 gv[2][2];
#pragma unroll
        for (int bj = 0; bj < 2; ++bj) { const int c = ct + bj * HALF + wc * 32 + 8 * fq; gv[bj][0] = *(const f32x4*)(gvec + c); gv[bj][1] = *(const f32x4*)(gvec + c + 4); }
        PG8_ROWS(float s = 0.f;
                 PG8_COLS(f32x4 a; f32x4 b;
                          if (F32RES) { a = __builtin_nontemporal_load((const f32x4*)(res_p + (size_t)r * 1024 + c)); b = __builtin_nontemporal_load((const f32x4*)(res_p + (size_t)r * 1024 + c + 4)); }
                          else { const u32x4 xw = *(const u32x4*)(X + (size_t)r * 1024 + c); unpack8(xw, a, b); }
                          a += v0; b += v1; *(u32x4*)(X + (size_t)r * 1024 + c) = pack8(a, b); s += dot4(a) + dot4(b);
                          *(u32x4*)(XG + (size_t)r * 1024 + c) = pack8(a * gv[bj][0], b * gv[bj][1]))
                 s += __shfl_xor(s, 16); s += __shfl_xor(s, 32); if (fq == 0) SSQ[(size_t)r * 16 + u.pn * 4 + wc] = s)
    }
};
struct EpiUp {
    static constexpr bool PERM = true, AFTER_DRAIN = false;
    const float* SSQ; bf16_t* H;
    __device__ __forceinline__ void operator()(const f32x4 (&acc)[2][2][4][2], const Unit& u, int wr, int wc, int fr, int fq) const {
        const int ct = u.pn * BM; float rsv[2][4];
#pragma unroll
        for (int ai = 0; ai < 2; ++ai)
#pragma unroll
            for (int m = 0; m < 4; ++m) rsv[ai][m] = row_rstd(SSQ, u.pm * BM + ai * HALF + wr * 64 + m * 16 + fr, fq);
        PG8_ROWS(const float rs = rsv[ai][m];
                 PG8_COLS(f32x4 a = v0 * rs; f32x4 b = v1 * rs; a = __builtin_elementwise_max(a, (f32x4){0.f, 0.f, 0.f, 0.f}); b = __builtin_elementwise_max(b, (f32x4){0.f, 0.f, 0.f, 0.f});
                          *(u32x4*)(H + (size_t)r * 4096 + c) = pack8(a * a, b * b)))
    }
};
struct EpiNull {
    static constexpr bool PERM = true, AFTER_DRAIN = false;
    float* sink;
    __device__ __forceinline__ void operator()(const f32x4 (&acc)[2][2][4][2], const Unit& u, int wr, int wc, int fr, int fq) const {
        float s = 0.f;
#pragma unroll
        for (int ai = 0; ai < 2; ++ai)
#pragma unroll
            for (int bj = 0; bj < 2; ++bj)
#pragma unroll
                for (int m = 0; m < 4; ++m)
#pragma unroll
                    for (int n = 0; n < 2; ++n) s += acc[ai][bj][m][n][0] + acc[ai][bj][m][n][3];
        if (s == 1.2345e33f) sink[0] = s;
    }
};
struct EpiPP {
    static constexpr bool PERM = true, AFTER_DRAIN = false;
    bf16_t* PP;
    __device__ __forceinline__ void operator()(const f32x4 (&acc)[2][2][4][2], const Unit& u, int wr, int wc, int fr, int fq) const {
        const int ct = u.pn * BM;
        PG8_ROWS(PG8_COLS(*(u32x4*)(PP + (size_t)r * 1024 + c) = pack8(v0, v1)))
    }
};
struct EpiPleFinal {
    static constexpr bool PERM = true, AFTER_DRAIN = false;
    const float* SSQ; const bf16_t* PP; const bf16_t* X; float* Y; float* SSQo; const float* gfin; unsigned* cnt;
    __device__ __forceinline__ void operator()(f32x4 (&acc)[2][2][4][2], const Unit& u, int wr, int wc, int fr, int fq) const {
        const int ct = u.pn * BM; float rsv[2][4];
#pragma unroll
        for (int ai = 0; ai < 2; ++ai)
#pragma unroll
            for (int m = 0; m < 4; ++m) rsv[ai][m] = row_rstd(SSQ, u.pm * BM + ai * HALF + wr * 64 + m * 16 + fr, fq);
        PG8_ROWS(const float rs = rsv[ai][m]; float s = 0.f;
                 PG8_COLS(const u32x4 pw = *(const u32x4*)(PP + (size_t)r * 1024 + c); f32x4 p0; f32x4 p1; unpack8(pw, p0, p1);
                          const u32x4 xw = *(const u32x4*)(X + (size_t)r * 1024 + c); f32x4 a; f32x4 b; unpack8(xw, a, b); a += sigm4(v0 * rs) * p0; b += sigm4(v1 * rs) * p1;
                          acc[ai][bj][m][0] = a; acc[ai][bj][m][1] = b; s += dot4(a) + dot4(b))
                 s += __shfl_xor(s, 16); s += __shfl_xor(s, 32);
                 if (fq == 0) __hip_atomic_store(SSQo + (size_t)r * 16 + u.pn * 4 + wc, s, __ATOMIC_RELAXED, __HIP_MEMORY_SCOPE_AGENT))
        asm volatile("s_waitcnt vmcnt(0)" ::: "memory");
        unsigned* cw = cnt + 64 * (2 * u.pm + wr);
        if (fr == 0 && fq == 0) __hip_atomic_fetch_add(cw, 1u, __ATOMIC_RELAXED, __HIP_MEMORY_SCOPE_AGENT);
        { unsigned spins = 0;
          while ((unsigned)__builtin_amdgcn_readfirstlane(__hip_atomic_load(cw, __ATOMIC_RELAXED, __HIP_MEMORY_SCOPE_AGENT)) < 16u) { __builtin_amdgcn_s_sleep(2); if (++spins > (1u << 16)) break; } }
        f32x4 gv[2][2];
#pragma unroll
        for (int bj = 0; bj < 2; ++bj) { const int c = ct + bj * HALF + wc * 32 + 8 * fq; gv[bj][0] = *(const f32x4*)(gfin + c); gv[bj][1] = *(const f32x4*)(gfin + c + 4); }
        PG8_ROWS(const f32x4 pq = __builtin_bit_cast(f32x4, ld16_sc1(SSQo, ((size_t)r * 16 + 4 * fq) * 4)); float t = (pq[0] + pq[1]) + (pq[2] + pq[3]); t += __shfl_xor(t, 16); t += __shfl_xor(t, 32);
                 const float r3 = __builtin_amdgcn_rsqf(t * (1.0f / 1024.0f) + cfg::EPS);
                 PG8_COLS(__builtin_nontemporal_store(v0 * r3 * gv[bj][0], (f32x4*)(Y + (size_t)r * 1024 + c)); __builtin_nontemporal_store(v1 * r3 * gv[bj][1], (f32x4*)(Y + (size_t)r * 1024 + c + 4))))
    }
};
struct NoHook { __device__ __forceinline__ void operator()(int) const {} };
template <class Epi, class Sched, bool ALIGN_EPI = false, bool SP2 = false, class Hook = NoHook>
__device__ __forceinline__ void gemm_phase(PG8_LAS unsigned char* lds, const Gemm g, const Sched& S, const Epi& E, const Hook& H = Hook()) {
    int tid = threadIdx.x; asm volatile("" : "+v"(tid));
    const int wid = __builtin_amdgcn_readfirstlane(tid >> 6), lane = tid & 63, wr = wid >> 2, wc = wid & 3, fr = lane & 15, fq = lane >> 4;
    int K = g.K; asm volatile("" : "+s"(K)); const int nt = K / BK;
    unsigned voffA[2], voffB[2];
#pragma unroll
    for (int i = 0; i < 2; ++i) { int R, C; stage_rc(tid * 16 + i * 8192, R, C); const int Rb = Epi::PERM ? ((R & ~31) + perm32(R & 31)) : R;
        voffA[i] = (unsigned)(R * K + C) * 2u; voffB[i] = (unsigned)(Rb * K + C) * 2u; }
    const size_t kstep = (size_t)(BK * 2);
    const size_t hstep = (size_t)HALF * K * 2;
    const size_t tstep = 2 * hstep;
    const size_t bhs = hstep;
    const unsigned ldsw = (unsigned)wid * 1024u;
    const int aoff = lds_byte(wr * 64 + fr, fq * 8), boff = lds_byte(wc * 32 + fr, fq * 8);
#define PG8_SA(b, h) (((b) * 2 + (h)) * HTB)
#define PG8_SB(b, h) ((4 + (b) * 2 + (h)) * HTB)
#define PG8_STAGE(bufoff, gbase, voff) do { _Pragma("unroll") for (int _i = 0; _i < 2; ++_i) \
        __builtin_amdgcn_global_load_lds((const unsigned*)((const char*)(gbase) + (voff)[_i]), (PG8_LAS unsigned*)(lds + (bufoff) + ldsw + _i * 8192), 16, 0, 0); } while (0)
#define PG8_LDA(dst, b, h) do { _Pragma("unroll") for (int m = 0; m < 4; ++m) _Pragma("unroll") for (int k = 0; k < 2; ++k) dst[m][k] = *(const PG8_LAS bf16x8*)(lds + PG8_SA(b, h) + aoff + m * 2048 + k * 1024); } while (0)
#define PG8_LDB(dst, b, h) do { _Pragma("unroll") for (int n = 0; n < 2; ++n) _Pragma("unroll") for (int k = 0; k < 2; ++k) dst[n][k] = *(const PG8_LAS bf16x8*)(lds + PG8_SB(b, h) + boff + n * 2048 + k * 1024); } while (0)
#define PG8_MMA(ai, bj, At, Bt) do { __builtin_amdgcn_s_setprio(1); _Pragma("unroll") for (int m = 0; m < 4; ++m) _Pragma("unroll") for (int n = 0; n < 2; ++n) _Pragma("unroll") for (int k = 0; k < 2; ++k) \
        acc[ai][bj][m][n] = __builtin_amdgcn_mfma_f32_16x16x32_bf16(Bt[n][k], At[m][k], acc[ai][bj][m][n], 0, 0, 0); __builtin_amdgcn_s_setprio(0); } while (0)
#ifdef DRAIN_ALL
#define PG8_WAIT_V(n) asm volatile("s_waitcnt vmcnt(0)" ::: "memory")
#else
#define PG8_WAIT_V(n) asm volatile("s_waitcnt vmcnt(" #n ")" ::: "memory")
#endif
#define PG8_WAIT_L(n) asm volatile("s_waitcnt lgkmcnt(" #n ")" ::: "memory")
#define PG8_BAR __builtin_amdgcn_s_barrier()
#define PG8_SCHED __builtin_amdgcn_sched_barrier(0)
    Unit cur, nxt; int ui = 0;
    if (!S.next(0, cur)) return;
    f32x4 acc[2][2][4][2];
#pragma unroll
    for (int a = 0; a < 2; ++a)
#pragma unroll
        for (int b = 0; b < 2; ++b)
#pragma unroll
            for (int m = 0; m < 4; ++m)
#pragma unroll
                for (int n = 0; n < 2; ++n) acc[a][b][m][n] = (f32x4){0.f, 0.f, 0.f, 0.f};
    bf16x8 At[4][2], B0[2][2], B1[2][2];
    const char* cA = (const char*)(cur.seg ? g.A1 : g.A) + (size_t)cur.pm * tstep; const char* cB = (const char*)(cur.seg ? g.Bt1 : g.Bt) + (size_t)cur.pn * tstep;
    S.a_ready(cur);
    if constexpr (SP2) {
        PG8_STAGE(PG8_SB(0, 0), cB, voffB); PG8_STAGE(PG8_SB(0, 1), cB + bhs, voffB); PG8_STAGE(PG8_SA(0, 0), cA, voffA); PG8_STAGE(PG8_SA(0, 1), cA + hstep, voffA);
        if (wr == 1) PG8_BAR;
        PG8_WAIT_V(2); PG8_BAR;
        PG8_STAGE(PG8_SB(1, 0), cB + kstep, voffB); PG8_STAGE(PG8_SA(1, 0), cA + kstep, voffA); PG8_STAGE(PG8_SB(1, 1), cB + bhs + kstep, voffB);
        PG8_WAIT_V(6); PG8_BAR;
    } else {
        PG8_STAGE(PG8_SB(0, 0), cB, voffB); PG8_STAGE(PG8_SA(0, 0), cA, voffA); PG8_STAGE(PG8_SB(0, 1), cB + bhs, voffB); PG8_STAGE(PG8_SA(0, 1), cA + hstep, voffA);
        if (wr == 1) PG8_BAR;
        PG8_WAIT_V(4); PG8_BAR;
        PG8_STAGE(PG8_SB(1, 0), cB + kstep, voffB); PG8_STAGE(PG8_SA(1, 0), cA + kstep, voffA); PG8_STAGE(PG8_SB(1, 1), cB + bhs + kstep, voffB);
        PG8_WAIT_V(6); PG8_BAR;
    }
    for (;;) {
        const bool has_next = S.next(ui + 1, nxt);
        const char* nA = has_next ? (const char*)(nxt.seg ? g.A1 : g.A) + (size_t)nxt.pm * tstep : cA; const char* nB = has_next ? (const char*)(nxt.seg ? g.Bt1 : g.Bt) + (size_t)nxt.pn * tstep : cB;
        for (int t = 0; t < nt; t += 2) {
            const bool last = (t == nt - 2);
            const char* a1 = cA + (size_t)(t + 1) * kstep;
            const char* a2 = last ? nA : cA + (size_t)(t + 2) * kstep; const char* b2 = last ? nB : cB + (size_t)(t + 2) * kstep;
            const char* a3 = a2 + kstep; const char* b3 = b2 + kstep;
            if (last && has_next) S.a_ready(nxt);
            if constexpr (SP2) {
            PG8_LDB(B0, 0, 0); PG8_LDB(B1, 0, 1); PG8_SCHED; PG8_LDA(At, 0, 0); PG8_STAGE(PG8_SA(1, 1), a1 + hstep, voffA);
            PG8_WAIT_V(8); PG8_WAIT_L(0); PG8_BAR; PG8_MMA(0, 0, At, B0); PG8_MMA(0, 1, At, B1); PG8_BAR; PG8_SCHED;
            PG8_LDA(At, 0, 1); PG8_STAGE(PG8_SB(0, 0), b2, voffB); PG8_STAGE(PG8_SB(0, 1), b2 + bhs, voffB); PG8_STAGE(PG8_SA(0, 0), a2, voffA);
            PG8_WAIT_V(8); PG8_WAIT_L(0); PG8_BAR; PG8_MMA(1, 0, At, B0); PG8_MMA(1, 1, At, B1); PG8_BAR; PG8_SCHED;
            PG8_LDB(B0, 1, 0); PG8_LDB(B1, 1, 1); PG8_SCHED; PG8_LDA(At, 1, 0); PG8_STAGE(PG8_SA(0, 1), a2 + hstep, voffA);
            PG8_WAIT_V(8); PG8_WAIT_L(0); PG8_BAR; PG8_MMA(0, 0, At, B0); PG8_MMA(0, 1, At, B1); PG8_BAR; PG8_SCHED;
            PG8_LDA(At, 1, 1); PG8_STAGE(PG8_SB(1, 0), b3, voffB); PG8_STAGE(PG8_SB(1, 1), b3 + bhs, voffB); PG8_STAGE(PG8_SA(1, 0), a3, voffA);
            PG8_WAIT_V(8); PG8_WAIT_L(0); PG8_BAR; PG8_MMA(1, 0, At, B0); PG8_MMA(1, 1, At, B1); PG8_BAR; PG8_SCHED;
            } else {
            PG8_LDB(B0, 0, 0); PG8_SCHED; PG8_LDA(At, 0, 0); PG8_STAGE(PG8_SA(1, 1), a1 + hstep, voffA);
            PG8_WAIT_L(8); PG8_BAR; PG8_WAIT_L(0); PG8_MMA(0, 0, At, B0); PG8_BAR; PG8_SCHED;
            PG8_LDB(B1, 0, 1); PG8_STAGE(PG8_SB(0, 0), b2, voffB);
            PG8_BAR; PG8_WAIT_L(0); PG8_MMA(0, 1, At, B1); PG8_BAR;
            PG8_LDA(At, 0, 1); PG8_STAGE(PG8_SA(0, 0), a2, voffA);
            PG8_BAR; PG8_WAIT_L(0); PG8_MMA(1, 0, At, B0); PG8_BAR; PG8_SCHED;
            PG8_STAGE(PG8_SB(0, 1), b2 + bhs, voffB);
            PG8_WAIT_V(6); PG8_BAR; PG8_MMA(1, 1, At, B1); PG8_BAR;
            PG8_LDB(B0, 1, 0); PG8_SCHED; PG8_LDA(At, 1, 0); PG8_STAGE(PG8_SA(0, 1), a2 + hstep, voffA);
            PG8_WAIT_L(8); PG8_BAR; PG8_WAIT_L(0); PG8_MMA(0, 0, At, B0); PG8_BAR; PG8_SCHED;
            PG8_LDB(B1, 1, 1); PG8_STAGE(PG8_SB(1, 0), b3, voffB);
            PG8_BAR; PG8_WAIT_L(0); PG8_MMA(0, 1, At, B1); PG8_BAR;
            PG8_LDA(At, 1, 1); PG8_STAGE(PG8_SA(1, 0), a3, voffA);
            PG8_BAR; PG8_WAIT_L(0); PG8_MMA(1, 0, At, B0); PG8_BAR; PG8_SCHED;
            PG8_STAGE(PG8_SB(1, 1), b3 + bhs, voffB);
            PG8_WAIT_V(6); PG8_BAR; PG8_MMA(1, 1, At, B1); PG8_BAR;
            }
        }
        if constexpr (ALIGN_EPI) { if (wr == 0) PG8_BAR; }
        if constexpr (!Epi::AFTER_DRAIN) { int t_ = threadIdx.x; asm volatile("" : "+v"(t_)); const int l_ = t_ & 63; E(acc, cur, wr, wc, l_ & 15, l_ >> 4); S.done(cur); H(ui); }
        if (!has_next) break;
#pragma unroll
        for (int a = 0; a < 2; ++a)
#pragma unroll
            for (int b = 0; b < 2; ++b)
#pragma unroll
                for (int m = 0; m < 4; ++m)
#pragma unroll
                    for (int n = 0; n < 2; ++n) acc[a][b][m][n] = (f32x4){0.f, 0.f, 0.f, 0.f};
        cur = nxt; cA = nA; cB = nB; ++ui;
        if constexpr (ALIGN_EPI) { if (wr == 1) PG8_BAR; }
    }
    PG8_WAIT_V(0);
    if constexpr (!ALIGN_EPI) { if (wr == 0) PG8_BAR; }
    PG8_BAR;
    if constexpr (Epi::AFTER_DRAIN) { E.fused(acc, cur, wr, wc, fr, fq, lds, wid, lane); S.done(cur); }
#undef PG8_SA
#undef PG8_SB
#undef PG8_STAGE
#undef PG8_LDA
#undef PG8_LDB
#undef PG8_MMA
#undef PG8_WAIT_V
#undef PG8_WAIT_L
#undef PG8_BAR
#undef PG8_SCHED
}
}
namespace sba {
typedef short bf16x8 __attribute__((ext_vector_type(8)));
typedef short s16x4 __attribute__((ext_vector_type(4)));
typedef float f32x16 __attribute__((ext_vector_type(16)));
typedef float f32x4 __attribute__((ext_vector_type(4)));
typedef unsigned u32x4 __attribute__((ext_vector_type(4)));
typedef unsigned short bf16_t;
#define SB_LAS __attribute__((address_space(3)))
constexpr int PITCH = 512, SLOTB = 16384  , OFF_FLAGS = 2 * SLOTB, OFF_OST = OFF_FLAGS + 256, LDS_BYTES = OFF_OST + 8 * 4096;
constexpr float THR2 = 48.0f, NEGBIG = -1.0e30f;
typedef float f32x2_t __attribute__((ext_vector_type(2))); typedef __bf16 bf16x2_t __attribute__((ext_vector_type(2)));
__device__ __forceinline__ unsigned cvtpk(float lo, float hi) { f32x2_t v = {lo, hi}; bf16x2_t b = __builtin_convertvector(v, bf16x2_t); return __builtin_bit_cast(unsigned, b); }
__device__ __forceinline__ bf16x8 pack8f(float a0, float a1, float a2, float a3, float a4, float a5, float a6, float a7) {
    u32x4 w; w.x = cvtpk(a0, a1); w.y = cvtpk(a2, a3); w.z = cvtpk(a4, a5); w.w = cvtpk(a6, a7); return __builtin_bit_cast(bf16x8, w); }
typedef short v4i16_t __attribute__((ext_vector_type(4)));
__device__ __forceinline__ s16x4 vtr(const SB_LAS char* p) { return __builtin_bit_cast(s16x4, __builtin_amdgcn_ds_read_tr16_b64_v4i16((SB_LAS v4i16_t*)p)); }
__device__ __forceinline__ int crow(int r, int hi) { return (r & 3) + 8 * (r >> 2) + 4 * hi; }

template <int SUB>
__device__ __forceinline__ void sub_front(const SB_LAS char* Kslot, bool mask, int kq, const bf16x8 (&qr)[4], f32x16& w, bf16x8 (&spb)[2], int r32, int hi) {
    const SB_LAS char* kb = Kslot + hi * 1024 + r32 * 16 + SUB * 512;
    f32x16 p = {};
#pragma unroll
    for (int d0 = 0; d0 < 4; ++d0) { const bf16x8 kf = *(const SB_LAS bf16x8*)(kb + d0 * 2048); p = __builtin_amdgcn_mfma_f32_32x32x16_bf16(kf, qr[d0], p, 0, 0, 0); }
    float sp[16];
#pragma unroll
    for (int r = 0; r < 16; ++r) {
        float x = p[r];
        if (mask && (kq + 32 * SUB + (r & 3) + 8 * (r >> 2) >= 0)) x = NEGBIG;
        const float t = __builtin_amdgcn_exp2f(-__builtin_fabsf(x));
        const float l = __builtin_amdgcn_logf(1.0f + t);
        sp[r] = __builtin_fmaxf(x, 0.f) + l; w[r] = __builtin_fminf(x, 0.f) - l;
    }
    spb[0] = pack8f(sp[0], sp[1], sp[2], sp[3], sp[4], sp[5], sp[6], sp[7]);
    spb[1] = pack8f(sp[8], sp[9], sp[10], sp[11], sp[12], sp[13], sp[14], sp[15]);
}
template <int SUB>
__device__ __forceinline__ void sub_back(const SB_LAS char* vp, const f32x16& w, const f32x16& sx, f32x16 (&o)[2]) {
    float pr[16];
#pragma unroll
    for (int r = 0; r < 16; ++r) pr[r] = __builtin_amdgcn_exp2f(w[r] - sx[r]);
    bf16x8 pa[2];
    pa[0] = pack8f(pr[0], pr[1], pr[2], pr[3], pr[4], pr[5], pr[6], pr[7]);
    pa[1] = pack8f(pr[8], pr[9], pr[10], pr[11], pr[12], pr[13], pr[14], pr[15]);
#pragma unroll
    for (int d0 = 0; d0 < 2; ++d0)
#pragma unroll
        for (int s = 0; s < 2; ++s) { const int ks = 2 * SUB + s;
            const s16x4 lo = vtr(vp + d0 * 4096 + ks * 1024), hi4 = vtr(vp + d0 * 4096 + ks * 1024 + 512);
            const bf16x8 vf = (bf16x8){lo[0], lo[1], lo[2], lo[3], hi4[0], hi4[1], hi4[2], hi4[3]};
            o[d0] = __builtin_amdgcn_mfma_f32_32x32x16_bf16(pa[s], vf, o[d0], 0, 0, 0); }
}
__device__ __forceinline__ void sb_tile(const SB_LAS char* slot, bool mask, bool skip1, int kq, const bf16x8 (&qr)[4], f32x16& Rb, f32x16 (&o)[2], const bf16x8 (&Um)[2], const bf16x8 Jm, int r32, int hi, int lane) {
    const SB_LAS char* vp = slot + 8192 + ((lane >> 4) & 1) * 32 + (lane & 3) * 8 + (4 * hi + ((lane & 15) >> 2)) * 64;
    f32x16 w1, w0; bf16x8 sb1[2], sb0[2];
    f32x16 t1 = Rb;
    if (!skip1) {
    sub_front<1>(slot, mask, kq, qr, w1, sb1, r32, hi);
    f32x16 a1 = __builtin_amdgcn_mfma_f32_32x32x16_bf16(Um[0], sb1[0], Rb, 0, 0, 0); a1 = __builtin_amdgcn_mfma_f32_32x32x16_bf16(Um[1], sb1[1], a1, 0, 0, 0);
    t1 = __builtin_amdgcn_mfma_f32_32x32x16_bf16(Jm, sb1[0], Rb, 0, 0, 0); t1 = __builtin_amdgcn_mfma_f32_32x32x16_bf16(Jm, sb1[1], t1, 0, 0, 0);
    sub_back<1>(vp, w1, a1, o);
    }
    sub_front<0>(slot, mask, kq, qr, w0, sb0, r32, hi);
    f32x16 a0 = __builtin_amdgcn_mfma_f32_32x32x16_bf16(Um[0], sb0[0], t1, 0, 0, 0); a0 = __builtin_amdgcn_mfma_f32_32x32x16_bf16(Um[1], sb0[1], a0, 0, 0, 0);
    f32x16 rn = __builtin_amdgcn_mfma_f32_32x32x16_bf16(Jm, sb0[0], t1, 0, 0, 0); rn = __builtin_amdgcn_mfma_f32_32x32x16_bf16(Jm, sb0[1], rn, 0, 0, 0);
    sub_back<0>(vp, w0, a0, o);
    Rb = rn;
}
struct Tensors { const bf16_t* Q; const bf16_t* K; const bf16_t* V; bf16_t* O; const float* ck; const float* cv; };

template <bool SAMPLE>
__device__ __forceinline__ void sb_unit(int b, int h, int qb, const Tensors& T, SB_LAS char* lds) {
    int tid = threadIdx.x; asm volatile("" : "+v"(tid)); const int lane = tid & 63, r32 = lane & 31, hi = lane >> 5; const int wid = __builtin_amdgcn_readfirstlane(tid >> 6);
    const size_t rowbase = SAMPLE ? (size_t)cfg::MP + (size_t)b * 32 : (size_t)b * cfg::SEQ; const int q0 = SAMPLE ? 0 : qb * 256;
    const int jd = SAMPLE ? 16 : (q0 >> 6) + (wid >> 1), jtop = SAMPLE ? 16 : (q0 >> 6) + 3;
    const bool worker = SAMPLE ? (wid == 0) : true;
    const int wq = SAMPLE ? 0 : wid;
    const int qpos = (SAMPLE ? cfg::PAST : q0 + 32 * wq) + r32;
    volatile SB_LAS unsigned* flags = (volatile SB_LAS unsigned*)(lds + OFF_FLAGS);
    bf16x8 Um[2], Jm;
#pragma unroll
    for (int s = 0; s < 2; ++s)
#pragma unroll
        for (int jj = 0; jj < 8; ++jj) Um[s][jj] = (16 * s + 8 * (jj >> 2) + 4 * hi + (jj & 3) > r32) ? (short)0x3F80 : (short)0;
#pragma unroll
    for (int jj = 0; jj < 8; ++jj) Jm[jj] = (short)0x3F80;
    bf16x8 qr[4];
    { const bf16_t* Qw = T.Q + (rowbase + q0 + 32 * wq + r32) * PITCH + h * 64 + hi * 8;
#pragma unroll
      for (int d0 = 0; d0 < 4; ++d0) qr[d0] = *(const bf16x8*)(Qw + d0 * 16); }
    f32x16 Rb = {}, o[2]; o[0] = f32x16{}; o[1] = f32x16{};
    bool done = false;
    u32x4 kreg, vreg;
    const int vkey = 16 * (wid & 3) + (lane >> 2), vcol = (wid >> 2) * 32 + (lane & 3) * 8;
#define SB_LOAD(j) do { \
        if (!SAMPLE) { kreg = *(const u32x4*)(T.K + (rowbase + (size_t)(64 * (j) + lane)) * PITCH + h * 64 + wid * 8); vreg = *(const u32x4*)(T.V + (rowbase + (size_t)(64 * (j) + vkey)) * PITCH + h * 64 + vcol); } \
        else if ((j) == 16) { const int kr_ = lane < 31 ? lane : 31, vr_ = vkey < 31 ? vkey : 31; \
            kreg = *(const u32x4*)(T.K + (rowbase + kr_) * PITCH + h * 64 + wid * 8); vreg = *(const u32x4*)(T.V + (rowbase + vr_) * PITCH + h * 64 + vcol); } \
        else { const float* kp_ = T.ck + ((size_t)b * cfg::PAST + 64 * (j) + lane) * PITCH + h * 64 + wid * 8; const float* vp_ = T.cv + ((size_t)b * cfg::PAST + 64 * (j) + vkey) * PITCH + h * 64 + vcol; \
            const f32x4 k0_ = *(const f32x4*)kp_, k1_ = *(const f32x4*)(kp_ + 4), v0_ = *(const f32x4*)vp_, v1_ = *(const f32x4*)(vp_ + 4); \
            kreg = (u32x4){cvtpk(k0_[0], k0_[1]), cvtpk(k0_[2], k0_[3]), cvtpk(k1_[0], k1_[1]), cvtpk(k1_[2], k1_[3])}; vreg = (u32x4){cvtpk(v0_[0], v0_[1]), cvtpk(v0_[2], v0_[3]), cvtpk(v1_[0], v1_[1]), cvtpk(v1_[2], v1_[3])}; } } while (0)
    SB_LOAD(jtop);
    for (int j = jtop; j >= 0; --j) {
        SB_LAS char* slot = lds + (j & 1) * SLOTB;
        *(SB_LAS u32x4*)(slot + wid * 1024 + lane * 16) = kreg; *(SB_LAS u32x4*)(slot + 8192 + wid * 1024 + lane * 16) = vreg;
        __syncthreads();
        if (j != jtop) { const volatile SB_LAS unsigned* f = flags + ((j + 1) & 1) * 8; unsigned all = 1u;
#pragma unroll
            for (int w8 = 0; w8 < 8; ++w8) all &= f[w8];
            if (all) break; }
        if (j > 0) SB_LOAD(j - 1);
        if (worker && !done && j <= jd) {
            const int key0 = (SAMPLE && j == 16) ? cfg::PAST : 64 * j;
            sb_tile(slot, j == jd, (j == jd) && (SAMPLE || (wid & 1) == 0), key0 + 4 * hi - qpos, qr, Rb, o, Um, Jm, r32, hi, lane);
            done = __all(Rb[0] > THR2) != 0;
        }
        if (lane == 0) flags[(j & 1) * 8 + wid] = (done || !worker) ? 1u : 0u;
    }
#undef SB_LOAD
    if (worker) {
        SB_LAS bf16_t* stg = (SB_LAS bf16_t*)(lds + OFF_OST) + wid * 2048;
#pragma unroll
        for (int r = 0; r < 16; ++r) { const int orow = crow(r, hi);
#pragma unroll
            for (int d0 = 0; d0 < 2; ++d0) stg[orow * 64 + d0 * 32 + r32] = (bf16_t)(cvtpk(o[d0][r], 0.f) & 0xffffu); }
        asm volatile("s_waitcnt lgkmcnt(0)" ::: "memory");
        bf16_t* Ow = T.O + (rowbase + q0 + 32 * wq) * PITCH + h * 64;
#pragma unroll
        for (int i = 0; i < 4; ++i) { const int row = i * 8 + (lane >> 3), ch = lane & 7; const u32x4 v = *(const SB_LAS u32x4*)(stg + row * 64 + ch * 8); *(u32x4*)(Ow + (size_t)row * PITCH + ch * 8) = v; }
    }
    __syncthreads();
}
}
namespace sk {
typedef short bf16x8 __attribute__((ext_vector_type(8)));
typedef float f32x16 __attribute__((ext_vector_type(16)));
typedef float f32x4 __attribute__((ext_vector_type(4)));
typedef unsigned short bf16_t;
#define SK_LAS __attribute__((address_space(3)))
constexpr int PLD = 36;
constexpr int LDS_BYTES = 8 * 2 * 32 * PLD * 4;
__device__ __forceinline__ f32x4 tile(const bf16_t* A, const bf16_t* Bt, int K, size_t arow0, int col0, SK_LAS char* lds) {
    int tid = threadIdx.x; asm volatile("" : "+v"(tid)); const int lane = tid & 63, r32 = lane & 31, hi = lane >> 5; const int wid = __builtin_amdgcn_readfirstlane(tid >> 6);
    const int nsplit = (K >= 512) ? 8 : (K >> 6), ks = K / nsplit;
    const bf16_t* ap = A + (arow0 + r32) * K + wid * ks + hi * 32;
    const bf16_t* bp0 = Bt + (size_t)(col0 + r32) * K + wid * ks + hi * 32; const bf16_t* bp1 = bp0 + (size_t)32 * K;
    f32x16 acc0 = {}, acc1 = {};
#pragma unroll 2
    for (int s = 0; s < ((wid < nsplit) ? ks : 0); s += 64) {
        bf16x8 a[4], b0[4], b1[4];
#pragma unroll
        for (int j = 0; j < 4; ++j) { a[j] = *(const bf16x8*)(ap + s + 8 * j); b0[j] = *(const bf16x8*)(bp0 + s + 8 * j); b1[j] = *(const bf16x8*)(bp1 + s + 8 * j); }
#pragma unroll
        for (int j = 0; j < 4; ++j) {
            acc0 = __builtin_amdgcn_mfma_f32_32x32x16_bf16(b0[j], a[j], acc0, 0, 0, 0);
            acc1 = __builtin_amdgcn_mfma_f32_32x32x16_bf16(b1[j], a[j], acc1, 0, 0, 0); }
    }
    SK_LAS float* P0 = (SK_LAS float*)lds + ((wid * 2 + 0) * 32 + r32) * PLD + 4 * hi; SK_LAS float* P1 = P0 + 32 * PLD;
#pragma unroll
    for (int g = 0; g < 4; ++g) { *(SK_LAS f32x4*)(P0 + 8 * g) = (f32x4){acc0[4 * g], acc0[4 * g + 1], acc0[4 * g + 2], acc0[4 * g + 3]};
                                  *(SK_LAS f32x4*)(P1 + 8 * g) = (f32x4){acc1[4 * g], acc1[4 * g + 1], acc1[4 * g + 2], acc1[4 * g + 3]}; }
    __syncthreads();
    const int row = tid >> 4, c = (tid & 15) * 4, cb = c >> 5, cc = c & 31;
    f32x4 s = {0.f, 0.f, 0.f, 0.f};
#pragma unroll
    for (int w = 0; w < 8; ++w) s += *(const SK_LAS f32x4*)((SK_LAS float*)lds + ((w * 2 + cb) * 32 + row) * PLD + cc);
    __syncthreads();
    return s;
}
__device__ __forceinline__ void tile4(const bf16_t* A, const bf16_t* Bt, int K, size_t arow0, int col0, SK_LAS char* lds, f32x4 (&out)[2][2]) {
    int tid = threadIdx.x; asm volatile("" : "+v"(tid)); const int lane = tid & 63, r32 = lane & 31, hi = lane >> 5; const int wid = __builtin_amdgcn_readfirstlane(tid >> 6);
    const int half = wid >> 2, kq = wid & 3, ks = K >> 2;
    const bf16_t* ap = A + (arow0 + r32) * K + kq * ks + hi * 32;
    const bf16_t* bp = Bt + (size_t)(col0 + half * 128 + r32) * K + kq * ks + hi * 32;
    f32x16 acc[4]; acc[0] = f32x16{}; acc[1] = f32x16{}; acc[2] = f32x16{}; acc[3] = f32x16{};
#pragma unroll 1
    for (int s = 0; s < ks; s += 64) {
        bf16x8 a[4], b[4][4];
#pragma unroll
        for (int e = 0; e < 4; ++e) { a[e] = *(const bf16x8*)(ap + s + 8 * e);
#pragma unroll
            for (int j = 0; j < 4; ++j) b[j][e] = *(const bf16x8*)(bp + (size_t)(32 * j) * K + s + 8 * e); }
#pragma unroll
        for (int e = 0; e < 4; ++e)
#pragma unroll
            for (int j = 0; j < 4; ++j) acc[j] = __builtin_amdgcn_mfma_f32_32x32x16_bf16(b[j][e], a[e], acc[j], 0, 0, 0);
    }
    const int row = tid >> 4, cc = (tid & 15) * 4;
#pragma unroll
    for (int q = 0; q < 2; ++q) {
        SK_LAS float* P0 = (SK_LAS float*)lds + ((wid * 2 + 0) * 32 + r32) * PLD + 4 * hi; SK_LAS float* P1 = P0 + 32 * PLD;
#pragma unroll
        for (int g = 0; g < 4; ++g) { *(SK_LAS f32x4*)(P0 + 8 * g) = (f32x4){acc[2 * q][4 * g], acc[2 * q][4 * g + 1], acc[2 * q][4 * g + 2], acc[2 * q][4 * g + 3]};
                                      *(SK_LAS f32x4*)(P1 + 8 * g) = (f32x4){acc[2 * q + 1][4 * g], acc[2 * q + 1][4 * g + 1], acc[2 * q + 1][4 * g + 2], acc[2 * q + 1][4 * g + 3]}; }
        __syncthreads();
#pragma unroll
        for (int h = 0; h < 2; ++h) { f32x4 sum = {0.f, 0.f, 0.f, 0.f};
#pragma unroll
            for (int w = 0; w < 4; ++w) sum += *(const SK_LAS f32x4*)((SK_LAS float*)lds + (((h * 4 + w) * 2 + (cc >> 5)) * 32 + row) * PLD + (cc & 31));
            out[h][q] = sum; }
        __syncthreads();
    }
}
__device__ __forceinline__ f32x16 wtile(const bf16_t* A, const bf16_t* Bt, int K, size_t arow0, int colw, int lane) {
    const int r32 = lane & 31, hi = lane >> 5;
    const bf16_t* ap = A + (arow0 + r32) * K + hi * 32; const bf16_t* bp = Bt + (size_t)(colw + r32) * K + hi * 32;
    f32x16 acc = {};
#pragma unroll 4
    for (int s = 0; s < K; s += 64) {
        bf16x8 a[4], b[4];
#pragma unroll
        for (int e = 0; e < 4; ++e) { a[e] = *(const bf16x8*)(ap + s + 8 * e); b[e] = *(const bf16x8*)(bp + s + 8 * e); }
#pragma unroll
        for (int e = 0; e < 4; ++e) acc = __builtin_amdgcn_mfma_f32_32x32x16_bf16(b[e], a[e], acc, 0, 0, 0);
    }
    return acc;
}
__device__ __forceinline__ float sum16(float v) { v += __shfl_xor(v, 1); v += __shfl_xor(v, 2); v += __shfl_xor(v, 4); v += __shfl_xor(v, 8); return v; }
__device__ __forceinline__ float rstd16(const float* SSQ, int r, int t) { return __builtin_amdgcn_rsqf(sum16(SSQ[(size_t)r * 16 + (t & 15)]) * (1.0f / 1024.0f) + cfg::EPS); }
__device__ __forceinline__ float rstd_row(const float* SSQ, int r) { const f32x4* p = (const f32x4*)(SSQ + (size_t)r * 16); const f32x4 a = p[0], b = p[1], c = p[2], d = p[3];
    const float s = ((a[0] + a[1]) + (a[2] + a[3])) + ((b[0] + b[1]) + (b[2] + b[3])) + ((c[0] + c[1]) + (c[2] + c[3])) + ((d[0] + d[1]) + (d[2] + d[3])); return __builtin_amdgcn_rsqf(s * (1.0f / 1024.0f) + cfg::EPS); }
__device__ __forceinline__ unsigned long long pk4(f32x4 v) { return (unsigned long long)pg8::cvt_pk_bf16(v[0], v[1]) | ((unsigned long long)pg8::cvt_pk_bf16(v[2], v[3]) << 32); }
__device__ __forceinline__ f32x4 up4(unsigned long long w) { const unsigned lo = (unsigned)w, hi = (unsigned)(w >> 32); return (f32x4){pg8::bf_lo(lo), pg8::bf_hi(lo), pg8::bf_lo(hi), pg8::bf_hi(hi)}; }
}
#define GAS __attribute__((address_space(1)))
#define LAS __attribute__((address_space(3)))
typedef unsigned short bf16;
typedef unsigned v4u __attribute__((ext_vector_type(4)));
typedef float f32x4 __attribute__((ext_vector_type(4)));
typedef short bf16x8 __attribute__((ext_vector_type(8)));
typedef GAS unsigned gu32;
typedef GAS unsigned long long gu64;
#define RLX_AGENT __ATOMIC_RELAXED, __HIP_MEMORY_SCOPE_AGENT
#define LDS_WAIT() asm volatile("s_waitcnt lgkmcnt(0)" ::: "memory")
#define VM_WAIT() asm volatile("s_waitcnt vmcnt(0)" ::: "memory")
__device__ __forceinline__ unsigned long long rt() { return __builtin_amdgcn_s_memrealtime(); }
__device__ __forceinline__ unsigned f2bf(float f) { unsigned u = __builtin_bit_cast(unsigned, f); return (u + 0x7fffu + ((u >> 16) & 1u)) >> 16; }
__device__ __forceinline__ unsigned pk2(float lo, float hi) { return f2bf(lo) | (f2bf(hi) << 16); }
#define XB_TMO      128
#define XB_XCNT(j)  (256  + 64 * (j))
#define XB_XSUB(j)  (1280 + 64 * (j))
#define XB_XGEN(j)  (2304 + 64 * (j))
#define XB_TOP      3328
#define XB_TOPGEN   3392
#define XCD_BAR_WORDS 3456
#define XB_SPIN_CAP (1u << 18)

__device__ __forceinline__ unsigned xb_ld(unsigned* p)              { return __hip_atomic_load(p, __ATOMIC_RELAXED, __HIP_MEMORY_SCOPE_AGENT); }
__device__ __forceinline__ unsigned xb_add(unsigned* p, unsigned v) { return __hip_atomic_fetch_add(p, v, __ATOMIC_RELAXED, __HIP_MEMORY_SCOPE_AGENT); }
__device__ __forceinline__ unsigned xb_xcc_id() { return (unsigned)__builtin_amdgcn_s_getreg((3 << 11) | 20) & 0xFu; }
#define XB_SPIN(cond, bar) do { unsigned _sp = 0; while (cond) { __builtin_amdgcn_s_sleep(1); \
    if ((++_sp & 255u) == 0u) { if (xb_ld(&(bar)[XB_TMO])) break; if (_sp > XB_SPIN_CAP) { atomicAdd(&(bar)[XB_TMO], 1u); break; } } } } while (0)

struct XcdBarrier {
    unsigned* bar; unsigned x;
    volatile LAS unsigned* st;
};

__device__ __forceinline__ XcdBarrier xcd_barrier_post(unsigned* bar, volatile LAS unsigned* st) {
    XcdBarrier b; b.bar = bar; b.x = xb_xcc_id(); b.st = st;
    if (threadIdx.x == 0) (void)xb_add(&bar[XB_XCNT(b.x)], 1u);
    return b;
}
__device__ __forceinline__ void xcd_barrier_complete(unsigned* bar, unsigned x, unsigned& nloc, unsigned& nx) {
    const unsigned G = gridDim.x * gridDim.y * gridDim.z;
    unsigned sum, cnt, mine, sp = 0u;
    for (;;) {
        sum = 0u; cnt = 0u; mine = 0u;
#pragma unroll
        for (unsigned j = 0; j < 16; ++j) { const unsigned c = xb_ld(&bar[XB_XCNT(j)]); sum += c; cnt += (c > 0u) ? 1u : 0u; mine = (j == x) ? c : mine; }
        if (sum == G) break;
        __builtin_amdgcn_s_sleep(1);
        if ((++sp & 255u) == 0u) { if (xb_ld(&bar[XB_TMO])) break; if (sp > XB_SPIN_CAP) { atomicAdd(&bar[XB_TMO], 1u); break; } }
    }
    nloc = mine > 0u ? mine : 1u; nx = cnt > 0u ? cnt : 1u;
}

__device__ __forceinline__ void xcd_barrier(const XcdBarrier& b) {
    asm volatile("s_waitcnt vmcnt(0)" ::: "memory");
    __syncthreads();
    if (threadIdx.x == 0) {
        unsigned* bar = b.bar;
        __builtin_amdgcn_s_waitcnt(0);
        unsigned nloc = b.st[0], nx = b.st[1];
        if (nloc == 0u) { xcd_barrier_complete(bar, b.x, nloc, nx); b.st[0] = nloc; b.st[1] = nx; }
        const unsigned old = xb_add(&bar[XB_XSUB(b.x)], 1u);
        const unsigned gen = old / nloc;
        if (old + 1u == (gen + 1u) * nloc) {
            __builtin_amdgcn_fence(__ATOMIC_RELEASE, "agent");
            asm volatile("s_waitcnt vmcnt(0)" ::: "memory");
            const unsigned og = xb_add(&bar[XB_TOP], 1u);
            const unsigned tg = og / nx;
            if (og + 1u == (tg + 1u) * nx) xb_add(&bar[XB_TOPGEN], 1u);
            else XB_SPIN(xb_ld(&bar[XB_TOPGEN]) == tg, bar);
            __builtin_amdgcn_fence(__ATOMIC_ACQUIRE, "agent");
            xb_add(&bar[XB_XGEN(b.x)], 1u);
            asm volatile("s_waitcnt vmcnt(0)" ::: "memory");
        } else {
            XB_SPIN(xb_ld(&bar[XB_XGEN(b.x)]) == gen, bar);
            __builtin_amdgcn_fence(__ATOMIC_ACQUIRE, "agent");
            asm volatile("s_waitcnt vmcnt(0)" ::: "memory");
        }
    }
    __syncthreads();
}
__device__ __forceinline__ float wave_sum(float v) {
#pragma unroll
    for (int o = 1; o < 64; o <<= 1) v += __shfl_xor(v, o);
    return v;
}
__device__ __forceinline__ void p0_transpose_item(const float* W, int K, int N, bf16* WT, int row_off, LAS float* scr, int item, int lane) {
    const int nblk = N / 32, kb = item / nblk, nb = item % nblk, k0 = 64 * kb, n0 = 32 * nb;
    float tv[32];
#pragma unroll
    for (int i = 0; i < 32; ++i) { const int kk = 2 * i + (lane >> 5); tv[i] = __builtin_nontemporal_load(W + (size_t)(k0 + kk) * N + n0 + (lane & 31)); }
#pragma unroll
    for (int i = 0; i < 32; ++i) { const int kk = 2 * i + (lane >> 5); scr[kk * 33 + (lane & 31)] = tv[i]; }
    LDS_WAIT(); asm volatile("" ::: "memory");
    const int c = lane & 7;
#pragma unroll
    for (int j = 0; j < 4; ++j) { const int n = (lane >> 3) + 8 * j; const LAS float* s = scr + (8 * c) * 33 + n;
        v4u o; o.x = pk2(s[0 * 33], s[1 * 33]); o.y = pk2(s[2 * 33], s[3 * 33]); o.z = pk2(s[4 * 33], s[5 * 33]); o.w = pk2(s[6 * 33], s[7 * 33]);
        *(GAS v4u*)(WT + (size_t)(row_off + n0 + n) * K + k0 + 8 * c) = o; }
    LDS_WAIT(); asm volatile("" ::: "memory");
}
constexpr int NWAVES = 8;
#ifndef MK_N_LAUNCHES
#define MK_N_LAUNCHES 1
#endif
constexpr int N_PHASES = 8;
#ifndef DBG_ROT
#define DBG_ROT 0
#endif
#ifndef DBG_REPEAT
#define DBG_REPEAT -1
#endif
#ifndef DBG_P2PART
#define DBG_P2PART 0
#endif
#ifndef DBG_ALIGN
#define DBG_ALIGN true
#endif
#ifndef DBG_SP2
#define DBG_SP2 true
#endif
using namespace cfg;
constexpr size_t MiB = 1u << 20;
constexpr size_t WS_CTL = 0, CTL_ZERO_BYTES = MiB / 8;
constexpr size_t WS_WIN = 2 * MiB, WS_WEFF = 10 * MiB, WS_WSB = 11 * MiB, WS_WOUT = 12 * MiB, WS_WUP = 14 * MiB, WS_WDOWN = 22 * MiB, WS_WPG = 30 * MiB, WS_WPP = 32 * MiB;
constexpr size_t WS_SSQ1 = 33 * MiB, WS_SSQ2 = 35 * MiB, WS_SSQ3 = 37 * MiB;
constexpr size_t WS_PB = 40 * MiB;
constexpr size_t WS_XN = 49 * MiB;
constexpr size_t WS_BIG = 82 * MiB;
constexpr size_t WS_U = WS_BIG, WS_Q = WS_BIG + 16 * MiB + MiB / 2, WS_K = WS_BIG + 33 * MiB, WS_V = WS_BIG + 49 * MiB + MiB / 2;
constexpr size_t WS_G = WS_BIG + 66 * MiB;
constexpr size_t WS_Y = WS_BIG + 132 * MiB, WS_YSB = WS_Y + 16 * MiB + MiB / 2;
constexpr size_t WS_MG = WS_BIG;
constexpr size_t WS_H = WS_BIG;
constexpr size_t WS_PP = WS_BIG;
constexpr size_t WS_X = WS_Y;
constexpr size_t WS_END = WS_BIG + 165 * MiB;
static_assert((size_t)MT * 512 * 2 == 16 * MiB + MiB / 2 && (size_t)MT * 1024 * 2 == 33 * MiB && (size_t)MT * 16 * 4 <= 2 * MiB && (size_t)MT * 256 * 2 <= 9 * MiB && WS_END <= 256 * MiB, "d_ws map");
constexpr int CW_BAR = 4096, CW_FIN = 8192  , CW_FINS = 16384  ;
constexpr size_t O_Y = 0, O_KP = 17301504, O_VP = 25690112, O_POOLP = 34078720, O_KS = 34140160, O_VS = 34402304, O_POOLS = 34664448, O_END = 34787328;
constexpr int RING_OFF = 0, RING_BYTES = 131072, LDSCTL_OFF = RING_BYTES, MISC_OFF = LDSCTL_OFF + 320, LDS_BYTES = 147456;
static_assert(sk::LDS_BYTES <= RING_BYTES && sba::LDS_BYTES <= RING_BYTES, "attention scratch fits the ring region");

struct Args { const float* in[22]; float* out; unsigned char* ws; int ph_lo, ph_hi, li, pad; };

__device__ __forceinline__ void rms_rows_to_bf16(const float* xrow0, const float* xrow1, const float* g, bf16* orow0, bf16* orow1, int lane) {
    const GAS f32x4* xr0 = (const GAS f32x4*)xrow0 + lane; const GAS f32x4* xr1 = (const GAS f32x4*)(xrow1 ? xrow1 : xrow0) + lane; const GAS f32x4* gr = (const GAS f32x4*)g + lane;
    f32x4 v[4], w[4], gg[4]; float s = 0.f, t = 0.f;
#pragma unroll
    for (int j = 0; j < 4; ++j) { v[j] = __builtin_nontemporal_load(xr0 + 64 * j); w[j] = __builtin_nontemporal_load(xr1 + 64 * j); gg[j] = gr[64 * j]; }
#pragma unroll
    for (int j = 0; j < 4; ++j) { s += (v[j].x * v[j].x + v[j].y * v[j].y) + (v[j].z * v[j].z + v[j].w * v[j].w); t += (w[j].x * w[j].x + w[j].y * w[j].y) + (w[j].z * w[j].z + w[j].w * w[j].w); }
#pragma unroll
    for (int o = 1; o < 64; o <<= 1) { s += __shfl_xor(s, o); t += __shfl_xor(t, o); }
    const float rs = 1.f / sqrtf(s * (1.f / DM) + EPS), rt = 1.f / sqrtf(t * (1.f / DM) + EPS);
    GAS unsigned long long* o0 = (GAS unsigned long long*)orow0 + lane; GAS unsigned long long* o1 = (GAS unsigned long long*)orow1 + lane;
#pragma unroll
    for (int j = 0; j < 4; ++j) { o0[64 * j] = (unsigned long long)pk2(v[j].x * rs * gg[j].x, v[j].y * rs * gg[j].y) | ((unsigned long long)pk2(v[j].z * rs * gg[j].z, v[j].w * rs * gg[j].w) << 32);
        if (xrow1) o1[64 * j] = (unsigned long long)pk2(w[j].x * rt * gg[j].x, w[j].y * rt * gg[j].y) | ((unsigned long long)pk2(w[j].z * rt * gg[j].z, w[j].w * rt * gg[j].w) << 32); }
}
__device__ __forceinline__ void weff_item(const float* wgrp, const float* scale, const float* wpu, bf16* WT, int item, int lane) {
    const int nb = item & 15, cb = (item >> 4) & 15, g = item >> 8, n = nb * 64 + lane;
    float wg[8][2];
#pragma unroll
    for (int cc = 0; cc < 8; ++cc)
#pragma unroll
        for (int hh = 0; hh < 2; ++hh) wg[cc][hh] = wgrp[((size_t)(g * 128 + cb * 8 + cc)) * 128 + lane + 64 * hh] * scale[g * 128 + lane + 64 * hh];
    float acc[8];
#pragma unroll
    for (int cc = 0; cc < 8; ++cc) acc[cc] = 0.f;
#pragma unroll
    for (int hh = 0; hh < 2; ++hh)
#pragma unroll 16
        for (int d2 = 0; d2 < 64; ++d2) { const float wv = wpu[(size_t)(g * 128 + hh * 64 + d2) * 1024 + n];
#pragma unroll
            for (int cc = 0; cc < 8; ++cc) acc[cc] = fmaf(__builtin_bit_cast(float, __builtin_amdgcn_readlane(__builtin_bit_cast(int, wg[cc][hh]), d2)), wv, acc[cc]); }
    v4u o; o.x = pk2(acc[0], acc[1]); o.y = pk2(acc[2], acc[3]); o.z = pk2(acc[4], acc[5]); o.w = pk2(acc[6], acc[7]);
    *(GAS v4u*)(WT + (size_t)n * 512 + g * 128 + cb * 8) = o;
}

template <int W, int R>
__device__ __forceinline__ void pool_run(const bf16* Ub, const float* state_pool, bf16* Yb, int run, int c) {
    const int r0 = run * R; const bool sample = r0 >= MP; const int t0 = sample ? ((r0 - MP) & 31) : (r0 & (SEQ - 1)); const int b_ = sample ? ((r0 - MP) >> 5) : 0;
    v4u rw[R - 1 + W];
#pragma unroll
    for (int k = 0; k < W - 1; ++k) { const int pos = t0 + k - (W - 1);
        if (pos >= 0) rw[k] = *(const GAS v4u*)(Ub + (size_t)(r0 - (W - 1) + k) * 512 + c);
        else if (sample) { const float* sp = state_pool + ((size_t)b_ * 15 + 15 + pos) * 512 + c; const f32x4 a = *(const GAS f32x4*)sp, b = *(const GAS f32x4*)(sp + 4); rw[k] = pg8::pack8(a, b); }
        else rw[k] = (v4u){0u, 0u, 0u, 0u}; }
#pragma unroll
    for (int k = W - 1; k < R - 1 + W; ++k) rw[k] = *(const GAS v4u*)(Ub + (size_t)(r0 - (W - 1) + k) * 512 + c);
    f32x4 s0 = {0.f, 0.f, 0.f, 0.f}, s1 = {0.f, 0.f, 0.f, 0.f};
#pragma unroll
    for (int k = 0; k < W - 1; ++k) { f32x4 a, b; pg8::unpack8(rw[k], a, b); s0 += a; s1 += b; }
#pragma unroll
    for (int i = 0; i < R; ++i) { f32x4 a, b, u0, u1; pg8::unpack8(rw[W - 1 + i], u0, u1); s0 += u0; s1 += u1;
        const int cnt = sample ? W : ((t0 + i + 1 < W) ? t0 + i + 1 : W); const float ic = 1.0f / (float)cnt;
        *(GAS v4u*)(Yb + (size_t)(r0 + i) * 512 + c) = pg8::pack8(s0 * ic - u0, s1 * ic - u1);
        pg8::unpack8(rw[i], a, b); s0 -= a; s1 -= b; }
}
#if defined(HYB_ATTN) || defined(HYB_POOL)
__device__ __forceinline__ float hb2f(unsigned short v) { return __uint_as_float((unsigned)v << 16); }
__global__ void __launch_bounds__(64) hyb_attn(const unsigned short* Qb, const unsigned short* Kb, const unsigned short* Vb, const float* ck, const float* cv, unsigned short* YSB) {
    const int idx = blockIdx.x * 64 + threadIdx.x; if (idx >= MT * NH) return;
    const int h = idx / MT, m = idx % MT;
    float qr[HD], o[HD];
#pragma unroll
    for (int d = 0; d < HD; ++d) { qr[d] = hb2f(Qb[(size_t)m * 512 + h * HD + d]) * 0.6931471805599453f; o[d] = 0.f; }
    float S = 0.f; bool done = false; size_t kb; int nk;
    if (m < MP) { kb = (size_t)(m / SEQ) * SEQ; nk = m % SEQ; } else { const int ms = m - MP; kb = (size_t)MP + (size_t)(ms / DS) * DS; nk = ms % DS; }
    for (int s = nk - 1; s >= 0 && !done; --s) {
        const unsigned short* kr = Kb + (kb + s) * 512 + h * HD; const unsigned short* vr = Vb + (kb + s) * 512 + h * HD; float z = 0.f;
#pragma unroll
        for (int d = 0; d < HD; ++d) z = fmaf(qr[d], hb2f(kr[d]), z);
        const float sp = fmaxf(z, 0.f) + log1pf(expf(-fabsf(z))), a = expf(z - sp - S);
#pragma unroll
        for (int d = 0; d < HD; ++d) o[d] = fmaf(a, hb2f(vr[d]), o[d]);
        S += sp; if (S > 110.f) done = true;
    }
    if (m >= MP) { const int b = (m - MP) / DS; const float* kc = ck + (size_t)b * PAST * 512 + h * HD; const float* vc = cv + (size_t)b * PAST * 512 + h * HD;
        for (int s = PAST - 1; s >= 0 && !done; --s) {
            const float* kr = kc + (size_t)s * 512; const float* vr = vc + (size_t)s * 512; float z = 0.f;
#pragma unroll
            for (int d = 0; d < HD; ++d) z = fmaf(qr[d], kr[d], z);
            const float sp = fmaxf(z, 0.f) + log1pf(expf(-fabsf(z))), a = expf(z - sp - S);
#pragma unroll
            for (int d = 0; d < HD; ++d) o[d] = fmaf(a, vr[d], o[d]);
            S += sp; if (S > 110.f) done = true;
        } }
#pragma unroll
    for (int d = 0; d < HD; ++d) YSB[(size_t)m * 512 + h * HD + d] = (unsigned short)f2bf(o[d]);
}
__global__ void hyb_pool(const unsigned short* Ub, const float* state_pool, unsigned short* Yb) {
    const size_t i = (size_t)blockIdx.x * blockDim.x + threadIdx.x; if (i >= (size_t)MT * PW) return;
    const int m = (int)(i / PW), c = (int)(i % PW), g = c / 128, w = 2 << g;
    float s = 0.f; float cnt;
    if (m < MP) { const int t = m % SEQ; const int n = (t + 1 < w) ? t + 1 : w; for (int j = 0; j < n; ++j) s += hb2f(Ub[(size_t)(m - j) * PW + c]); cnt = (float)n; }
    else { const int ms = m - MP, b = ms / DS, t = ms % DS; for (int j = 0; j < w; ++j) { const int r = 15 + t - j; s += (r >= 15) ? hb2f(Ub[(size_t)(m - j) * PW + c]) : state_pool[((size_t)b * 15 + r) * PW + c]; } cnt = (float)w; }
    Yb[i] = (unsigned short)f2bf(s / cnt - hb2f(Ub[i]));
}
#endif

__global__ void __launch_bounds__(NWAVES * 64, 2) mega_fwd(Args args) {
    extern __shared__ __attribute__((aligned(16))) unsigned char lds[];
    LAS unsigned char* L = (LAS unsigned char*)lds;
    volatile LAS unsigned* MISC = (volatile LAS unsigned*)(L + MISC_OFF);
    const int wave = __builtin_amdgcn_readfirstlane(threadIdx.x >> 6);
#define FRESH_TID() int tid = threadIdx.x; asm volatile("" : "+v"(tid)); const int lane = tid & 63; (void)lane
    const int G = gridDim.x, bx = blockIdx.x, vcu = (G % 8 == 0) ? (bx % 8) * (G / 8) + bx / 8 : bx;
    unsigned char* ws = args.ws;
    gu32* ctl = (gu32*)(ws + WS_CTL);
    const float* x_p = args.in[0]; const float* x_s = args.in[1]; const float* cache_k = args.in[2]; const float* cache_v = args.in[3]; const float* state_pool = args.in[4];
    const float* p_p = args.in[5]; const float* p_s = args.in[6]; const float* g_mix = args.in[7]; const float* w_in = args.in[8]; const float* b_gate = args.in[9]; const float* w_grp = args.in[10];
    const float* pool_scale = args.in[11]; const float* w_pool_up = args.in[12]; const float* w_sb_up = args.in[13]; const float* w_out = args.in[14]; const float* g_mlp = args.in[15];
    const float* w_up = args.in[16]; const float* w_down = args.in[17]; const float* g_ple = args.in[18]; const float* w_ple_gate = args.in[19]; const float* w_ple_proj = args.in[20]; const float* g_final = args.in[21];
    float* out = args.out; float* Yo = out + O_Y;
    bf16 *WIN = (bf16*)(ws + WS_WIN), *WEFF = (bf16*)(ws + WS_WEFF), *WSB = (bf16*)(ws + WS_WSB), *WOUT = (bf16*)(ws + WS_WOUT), *WUP = (bf16*)(ws + WS_WUP), *WDOWN = (bf16*)(ws + WS_WDOWN), *WPG = (bf16*)(ws + WS_WPG), *WPP = (bf16*)(ws + WS_WPP);
    float *SSQ1 = (float*)(ws + WS_SSQ1), *SSQ2 = (float*)(ws + WS_SSQ2), *SSQ3 = (float*)(ws + WS_SSQ3);
    bf16 *PB = (bf16*)(ws + WS_PB), *XN = (bf16*)(ws + WS_XN), *Ub = (bf16*)(ws + WS_U), *Qb = (bf16*)(ws + WS_Q), *Kb = (bf16*)(ws + WS_K), *Vb = (bf16*)(ws + WS_V), *Gb = (bf16*)(ws + WS_G);
    bf16 *Yb = (bf16*)(ws + WS_Y), *YSB = (bf16*)(ws + WS_YSB), *MG = (bf16*)(ws + WS_MG), *Hb = (bf16*)(ws + WS_H), *PPb = (bf16*)(ws + WS_PP), *Xb = (bf16*)(ws + WS_X);

    for (int i = threadIdx.x; i < (LDS_BYTES - LDSCTL_OFF) / 4; i += NWAVES * 64) ((LAS unsigned*)(L + LDSCTL_OFF))[i] = 0u;
    __syncthreads();
    XcdBarrier bar; bar.bar = (unsigned*)(ctl + CW_BAR); bar.x = 0; bar.st = nullptr;
    if (MK_N_LAUNCHES == 1) bar = xcd_barrier_post((unsigned*)(ctl + CW_BAR), MISC + 8);
    const int lo = args.ph_lo, hi = args.ph_hi;
#define IN(k) (lo <= (k) && (k) < hi)
#ifdef DBG_BARCHK
#define SEAM(k) do { if (IN(k) && IN((k) + 1)) { if (threadIdx.x == 0) __hip_atomic_fetch_add((unsigned*)(ctl + 65536 + 64 * (k)), 1u, __ATOMIC_RELAXED, __HIP_MEMORY_SCOPE_AGENT); xcd_barrier(bar); \
    if (threadIdx.x == 0) { const unsigned v_ = __hip_atomic_load((unsigned*)(ctl + 65536 + 64 * (k)), __ATOMIC_RELAXED, __HIP_MEMORY_SCOPE_AGENT); if (v_ != (unsigned)G) { __hip_atomic_store((unsigned*)(ctl + 65536 + 64 * 32), 1u, __ATOMIC_RELAXED, __HIP_MEMORY_SCOPE_AGENT); out[O_KP + (k)] = __builtin_nanf(""); } } } } while (0)
#else
#define SEAM(k) do { if (IN(k) && IN((k) + 1)) xcd_barrier(bar); } while (0)
#endif
    const int gw = vcu * NWAVES + wave, NGW = G * NWAVES;
    const bool late_ = (vcu & 1) != 0;

#pragma unroll 1
    for (int rep_ = 0; rep_ < ((IN(0)) ? ((DBG_REPEAT == 0) ? 2 : 1) : 0); ++rep_) {
        if (rep_ > 0) xcd_barrier(bar);
        FRESH_TID();
        LAS float* scr = (LAS float*)(L + RING_OFF + wave * 16384);
        constexpr int I_IN = (DM / 64) * (INW / 32), I_SB = (SBW / 64) * (DM / 32), I_OUT = (DM / 64) * (DM / 32), I_UP = (DM / 64) * (DFF / 32), I_DOWN = (DFF / 64) * (DM / 32), I_PG = I_OUT, I_PP = (PLE / 64) * (DM / 32), I_EFF = 4 * 16 * 16;
        constexpr int NITEMS = I_IN + I_SB + I_OUT + I_UP + I_DOWN + I_PG + I_PP + I_EFF;
        for (int it = gw; it < NITEMS; it += NGW) {
            int r = it;
            if (r < I_EFF) { weff_item(w_grp, pool_scale, w_pool_up, WEFF, r, lane); continue; } r -= I_EFF;
            if (r < I_IN) { p0_transpose_item(w_in, DM, INW, WIN, 0, scr, r, lane); continue; } r -= I_IN;
            if (r < I_SB) { p0_transpose_item(w_sb_up, SBW, DM, WSB, 0, scr, r, lane); continue; } r -= I_SB;
            if (r < I_OUT) { p0_transpose_item(w_out, DM, DM, WOUT, 0, scr, r, lane); continue; } r -= I_OUT;
            if (r < I_UP) { p0_transpose_item(w_up, DM, DFF, WUP, 0, scr, r, lane); continue; } r -= I_UP;
            if (r < I_DOWN) { p0_transpose_item(w_down, DFF, DM, WDOWN, 0, scr, r, lane); continue; } r -= I_DOWN;
            if (r < I_PG) { p0_transpose_item(w_ple_gate, DM, DM, WPG, 0, scr, r, lane); continue; } r -= I_PG;
            p0_transpose_item(w_ple_proj, PLE, DM, WPP, 0, scr, r, lane);
        }
        for (int m = gw; m < MT; m += 2 * NGW) { const int m1 = m + NGW; const bool two = m1 < MT;
            const float* xr0 = m < MP ? x_p + (size_t)m * DM : x_s + (size_t)(m - MP) * DM;
            const float* xr1 = !two ? nullptr : (m1 < MP ? x_p + (size_t)m1 * DM : x_s + (size_t)(m1 - MP) * DM);
            const float* pr0 = m < MP ? p_p + (size_t)m * PLE : p_s + (size_t)(m - MP) * PLE;
            const float* pr1 = !two ? pr0 : (m1 < MP ? p_p + (size_t)m1 * PLE : p_s + (size_t)(m1 - MP) * PLE);
            const f32x4 pv0 = __builtin_nontemporal_load((const GAS f32x4*)pr0 + lane), pv1 = __builtin_nontemporal_load((const GAS f32x4*)pr1 + lane);
            rms_rows_to_bf16(xr0, xr1, g_mix, XN + (size_t)m * DM, XN + (size_t)(two ? m1 : m) * DM, lane);
            *((GAS unsigned long long*)(PB + (size_t)m * PLE) + lane) = (unsigned long long)pk2(pv0.x, pv0.y) | ((unsigned long long)pk2(pv0.z, pv0.w) << 32);
            if (two) *((GAS unsigned long long*)(PB + (size_t)m1 * PLE) + lane) = (unsigned long long)pk2(pv1.x, pv1.y) | ((unsigned long long)pk2(pv1.z, pv1.w) << 32);
        }
    }
    SEAM(0);
#pragma unroll 1
    for (int rep_ = 0; rep_ < ((IN(1)) ? ((DBG_REPEAT == 1) ? 2 : 1) : 0); ++rep_) {
        if (rep_ > 0) xcd_barrier(bar);
#pragma unroll 1
        for (int pass_ = 0; pass_ < 2; ++pass_) if ((pass_ == 1) == late_) {
        for (int task = vcu; task < 16 * (INW / 256); task += G) { const int rb = task & 15, col0 = (task >> 4) * 256; f32x4 vv[2][2];
            sk::tile4(XN, WIN, DM, (size_t)MP + rb * 32, col0, (SK_LAS char*)(L + RING_OFF), vv);
            const int t = threadIdx.x, rs = rb * 32 + (t >> 4), r = MP + rs;
#pragma unroll
            for (int h = 0; h < 2; ++h)
#pragma unroll
                for (int q = 0; q < 2; ++q) { const f32x4 v = vv[h][q]; const int c = col0 + 128 * h + 64 * q + (t & 15) * 4;
            if (c < 512) { *(GAS unsigned long long*)(Ub + (size_t)r * 512 + c) = sk::pk4(v); const int i = rs & 31; if (i >= 17) *(GAS f32x4*)(out + O_POOLS + ((size_t)(rs >> 5) * 15 + (i - 17)) * 512 + c) = v; }
            else if (c < 1024) *(GAS unsigned long long*)(Qb + (size_t)r * 512 + c - 512) = sk::pk4(v * QSCALE);
            else if (c < 1536) { *(GAS unsigned long long*)(Kb + (size_t)r * 512 + c - 1024) = sk::pk4(v); *(GAS f32x4*)(out + O_KS + (size_t)rs * 512 + c - 1024) = v; }
            else if (c < 2048) { *(GAS unsigned long long*)(Vb + (size_t)r * 512 + c - 1536) = sk::pk4(v); *(GAS f32x4*)(out + O_VS + (size_t)rs * 512 + c - 1536) = v; }
            else { const f32x4 bg = *(const GAS f32x4*)(b_gate + c - 2048); *(GAS unsigned*)((unsigned char*)Gb + (size_t)r * 2048 + c - 2048) = pg8::pk_u8x4(pg8::sigm4(v + bg)); } }
        }
        } else {
        pg8::Gemm g{XN, WIN, MP, INW, DM}; pg8::RotOrder S; S.init(MP, INW, G, bx, DBG_ROT);
        pg8::EpiIn E{Ub, Qb, Kb, Vb, Gb, b_gate, out + O_KP, out + O_VP, out + O_KS, out + O_VS, out + O_POOLP, out + O_POOLS};
        pg8::gemm_phase<pg8::EpiIn, pg8::RotOrder, DBG_ALIGN, DBG_SP2>(L + RING_OFF, g, S, E);
        }
#ifdef DBG_PREDELAY
        { const unsigned long long t0_ = __builtin_amdgcn_s_memrealtime(); while (__builtin_amdgcn_s_memrealtime() - t0_ < DBG_PREDELAY) __builtin_amdgcn_s_sleep(16); __syncthreads(); }
#endif
#ifdef DBG_PREFENCE
        __threadfence(); __syncthreads();
#endif
    }
    SEAM(1);
#ifdef DBG_GDUMP
#ifndef DBG_DUMPBUF
#define DBG_DUMPBUF WS_G
#define DBG_DUMPLD 2048
#endif
    for (int it = (vcu * NWAVES * 64 + (int)threadIdx.x); it < MT * 128; it += G * NWAVES * 64) {
        const int m = it >> 7, c = (it & 127) * 8; const v4u w = *(const GAS v4u*)((const bf16*)(ws + DBG_DUMPBUF) + (size_t)m * DBG_DUMPLD + ((DBG_GDUMP + c) % DBG_DUMPLD)); f32x4 a, b; pg8::unpack8(w, a, b);
        *(GAS f32x4*)(Yo + (size_t)m * 1024 + c) = a; *(GAS f32x4*)(Yo + (size_t)m * 1024 + c + 4) = b; }
#endif
#ifdef DBG_DELAY
    { const unsigned long long t0_ = __builtin_amdgcn_s_memrealtime(); while (__builtin_amdgcn_s_memrealtime() - t0_ < DBG_DELAY) __builtin_amdgcn_s_sleep(16); __syncthreads(); }
#endif
#ifndef DBG_SKIP_P2
#define DBG_SKIP_P2 0
#endif
    if (IN(2) && (DBG_SKIP_P2 & 8)) {
        for (int it = (vcu * NWAVES * 64 + (int)threadIdx.x); it < MT * 64; it += G * NWAVES * 64) {
            const int m = it >> 6, c = (it & 63) * 8; f32x4 a, b;
            for (int e = 0; e < 4; ++e) { a[e] = (float)(((m * 31 + (c + e) * 17) & 255) - 128) * (1.0f / 128.0f); b[e] = (float)(((m * 13 + (c + 4 + e) * 29) & 255) - 128) * (1.0f / 128.0f); }
            *(GAS v4u*)(Yb + (size_t)m * 512 + c) = pg8::pack8(a, b); *(GAS v4u*)(YSB + (size_t)m * 512 + c) = pg8::pack8(b, a);
            if (DBG_SKIP_P2 & 16) { *(GAS v4u*)(MG + (size_t)m * 1024 + c) = pg8::pack8(a, b); *(GAS v4u*)(MG + (size_t)m * 1024 + 512 + c) = pg8::pack8(b, a); }
        }
    }
#pragma unroll 1
    for (int rep_ = 0; rep_ < ((IN(2) && !(DBG_SKIP_P2 & 12)) ? ((DBG_REPEAT == 2) ? 2 : 1) : 0); ++rep_) {
        if (rep_ > 0) xcd_barrier(bar);
        FRESH_TID();
        const bool do_pool_ = (rep_ == 0) || DBG_P2PART == 0 || DBG_P2PART == 1, do_att_ = (rep_ == 0) || DBG_P2PART == 0 || DBG_P2PART == 2, do_sam_ = (rep_ == 0) || DBG_P2PART == 0 || DBG_P2PART == 3;
        if (do_pool_)
        for (int wi = wave * G + vcu; wi < 4 * (MT / 64); wi += NGW) { const int g = wi & 3, run = (wi >> 2) * 4 + (lane >> 4), c = g * 128 + (lane & 15) * 8;
            if (g == 0) pool_run<2, 16>(Ub, state_pool, Yb, run, c); else if (g == 1) pool_run<4, 16>(Ub, state_pool, Yb, run, c); else if (g == 2) pool_run<8, 16>(Ub, state_pool, Yb, run, c);
            else { pool_run<16, 8>(Ub, state_pool, Yb, 2 * run, c); asm volatile("" ::: "memory"); pool_run<16, 8>(Ub, state_pool, Yb, 2 * run + 1, c); } }
        const sba::Tensors T{Qb, Kb, Vb, YSB, cache_k, cache_v};
        if (do_att_) {
#pragma unroll 1
        for (int i2 = 2 * vcu; i2 < 512; i2 += ((i2 & 1) ? 2 * G - 1 : 1)) { const int i = i2 >> 1, bh = i >> 2, s = i & 3;
            sba::sb_unit<false>(bh >> 3, bh & 7, (i2 & 1) ? 7 - s : s, T, (SB_LAS char*)(L + RING_OFF)); }
        }
        if (do_sam_) {
        for (int i = G - 1 - vcu; i < 128; i += G) sba::sb_unit<true>(i >> 3, i & 7, 0, T, (SB_LAS char*)(L + RING_OFF));
        }
    }
    SEAM(2);
#pragma unroll 1
    for (int rep_ = 0; rep_ < ((IN(3) && !(DBG_SKIP_P2 & 16)) ? ((DBG_REPEAT == 3) ? 2 : 1) : 0); ++rep_) {
        if (rep_ > 0) xcd_barrier(bar);
#pragma unroll 1
        for (int pass_ = 0; pass_ < 2; ++pass_) if ((pass_ == 1) == late_) {
        for (int task = vcu; task < 16 * (DM / 64); task += G) { const int rb = task & 15, col0 = (task >> 4) * 64;
            const f32x4 va = sk::tile(Yb, WEFF, PW, (size_t)MP + rb * 32, col0, (SK_LAS char*)(L + RING_OFF));
            const f32x4 vb = sk::tile(YSB, WSB, SBW, (size_t)MP + rb * 32, col0, (SK_LAS char*)(L + RING_OFF));
            const int t = threadIdx.x, r = MP + rb * 32 + (t >> 4), c = col0 + (t & 15) * 4;
            const f32x4 ga = pg8::up_u8x4(*(const GAS unsigned*)((const unsigned char*)Gb + (size_t)r * 2048 + c)), gb = pg8::up_u8x4(*(const GAS unsigned*)((const unsigned char*)Gb + (size_t)r * 2048 + 1024 + c));
            *(GAS unsigned long long*)(MG + (size_t)r * 1024 + c) = sk::pk4(ga * va + gb * vb);
        }
        } else {
        { pg8::Gemm g{Yb, WEFF, MP, DM, PW, YSB, WSB}; pg8::PairOrder S; S.init(MP, DM, G, bx); pg8::EpiMerge E{Gb, MG};
          pg8::gemm_phase<pg8::EpiMerge, pg8::PairOrder, DBG_ALIGN, DBG_SP2>(L + RING_OFF, g, S, E); }
        }
    }
    SEAM(3);
#pragma unroll 1
    for (int rep_ = 0; rep_ < ((IN(4)) ? ((DBG_REPEAT == 4) ? 2 : 1) : 0); ++rep_) {
        if (rep_ > 0) xcd_barrier(bar);
#pragma unroll 1
        for (int pass_ = 0; pass_ < 2; ++pass_) if ((pass_ == 1) == late_) {
        for (int task = vcu; task < 16 * (DM / 64); task += G) { const int rb = task & 15, col0 = (task >> 4) * 64;
            const f32x4 v = sk::tile(MG, WOUT, DM, (size_t)MP + rb * 32, col0, (SK_LAS char*)(L + RING_OFF));
            const int t = threadIdx.x, rs = rb * 32 + (t >> 4), r = MP + rs, c = col0 + (t & 15) * 4;
            const f32x4 x1 = *(const GAS f32x4*)(x_s + (size_t)rs * DM + c) + v; *(GAS unsigned long long*)(Xb + (size_t)r * DM + c) = sk::pk4(x1);
            *(GAS unsigned long long*)(XN + (size_t)r * DM + c) = sk::pk4(x1 * *(const GAS f32x4*)(g_mlp + c));
            const float ss = sk::sum16(pg8::dot4(x1)); if ((t & 15) == 0) SSQ1[(size_t)r * 16 + (col0 >> 6)] = ss;
        }
        } else {
        pg8::Gemm g{MG, WOUT, MP, DM, DM}; pg8::StaticOrder S; S.init(MP, DM, G, bx); pg8::EpiResid<true> E{x_p, Xb, XN, g_mlp, SSQ1};
        pg8::gemm_phase<pg8::EpiResid<true>, pg8::StaticOrder, DBG_ALIGN, DBG_SP2>(L + RING_OFF, g, S, E);
        }
    }
    SEAM(4);
#pragma unroll 1
    for (int rep_ = 0; rep_ < ((IN(5)) ? ((DBG_REPEAT == 5) ? 2 : 1) : 0); ++rep_) {
        if (rep_ > 0) xcd_barrier(bar);
#pragma unroll 1
        for (int pass_ = 0; pass_ < 2; ++pass_) if ((pass_ == 1) == late_) {
        for (int task = vcu; task < 16 * (DFF / 256); task += G) { const int rb = task & 15, col0 = (task >> 4) * 256; f32x4 vv[2][2];
            sk::tile4(XN, WUP, DM, (size_t)MP + rb * 32, col0, (SK_LAS char*)(L + RING_OFF), vv);
            const int t = threadIdx.x, r = MP + rb * 32 + (t >> 4); const float rs_ = sk::rstd16(SSQ1, r, t);
#pragma unroll
            for (int h = 0; h < 2; ++h)
#pragma unroll
                for (int q = 0; q < 2; ++q) { const int c = col0 + 128 * h + 64 * q + (t & 15) * 4; const f32x4 a = __builtin_elementwise_max(vv[h][q] * rs_, (f32x4){0.f, 0.f, 0.f, 0.f});
                    *(GAS unsigned long long*)(Hb + (size_t)r * DFF + c) = sk::pk4(a * a); }
        }
        } else {
        pg8::Gemm g{XN, WUP, MP, DFF, DM}; pg8::StaticOrder S; S.init(MP, DFF, G, bx); pg8::EpiUp E{SSQ1, Hb};
        pg8::gemm_phase<pg8::EpiUp, pg8::StaticOrder, DBG_ALIGN, DBG_SP2>(L + RING_OFF, g, S, E);
        }
    }
    SEAM(5);
    if (IN(5) && DBG_REPEAT == 15) {
        { pg8::Gemm g{XN, WUP, MP, DFF, DM}; pg8::StaticOrder S; S.init(MP, DFF, G, bx); pg8::EpiNull E{SSQ3};
          pg8::gemm_phase<pg8::EpiNull, pg8::StaticOrder, DBG_ALIGN, DBG_SP2>(L + RING_OFF, g, S, E); }
        xcd_barrier(bar);
    }
    if (IN(5) && DBG_REPEAT == 25) {
        for (int task = vcu; task < 16 * (DFF / 256); task += G) { const int rb = task & 15, col0 = (task >> 4) * 256; f32x4 vv[2][2];
            sk::tile4(XN, WUP, DM, (size_t)MP + rb * 32, col0, (SK_LAS char*)(L + RING_OFF), vv); if (vv[0][0][0] + vv[1][1][0] + vv[0][1][0] + vv[1][0][0] == 1.2345e33f) SSQ3[0] = vv[0][0][1]; }
        xcd_barrier(bar);
    }
    if (IN(6) && DBG_REPEAT == 6) {
        { pg8::Gemm g{Hb, WDOWN, MP, DM, DFF}; pg8::StaticOrder S; S.init(MP, DM, G, bx); pg8::EpiNull E{SSQ3};
          pg8::gemm_phase<pg8::EpiNull, pg8::StaticOrder, DBG_ALIGN, DBG_SP2>(L + RING_OFF, g, S, E); }
        xcd_barrier(bar);
    }
    if (IN(6) && DBG_REPEAT == 16) {
        for (int task = vcu; task < 16 * (DM / 64); task += G) { const int rb = task & 15, col0 = (task >> 4) * 64;
            const f32x4 v = sk::tile(Hb, WDOWN, DFF, (size_t)MP + rb * 32, col0, (SK_LAS char*)(L + RING_OFF)); if (v[0] == 1.2345e33f) SSQ3[0] = v[1]; }
        xcd_barrier(bar);
    }
    if (IN(6)) {
#pragma unroll 1
        for (int pass_ = 0; pass_ < 2; ++pass_) if ((pass_ == 1) == late_) {
        for (int task = vcu; task < 16 * (DM / 64); task += G) { const int rb = task & 15, col0 = (task >> 4) * 64;
            const f32x4 v = sk::tile(Hb, WDOWN, DFF, (size_t)MP + rb * 32, col0, (SK_LAS char*)(L + RING_OFF));
            const int t = threadIdx.x, r = MP + rb * 32 + (t >> 4), c = col0 + (t & 15) * 4;
            const f32x4 x2 = sk::up4(*(const GAS unsigned long long*)(Xb + (size_t)r * DM + c)) + v; *(GAS unsigned long long*)(Xb + (size_t)r * DM + c) = sk::pk4(x2);
            *(GAS unsigned long long*)(XN + (size_t)r * DM + c) = sk::pk4(x2 * *(const GAS f32x4*)(g_ple + c));
            const float ss = sk::sum16(pg8::dot4(x2)); if ((t & 15) == 0) SSQ2[(size_t)r * 16 + (col0 >> 6)] = ss;
        }
        } else {
        { pg8::Gemm g{Hb, WDOWN, MP, DM, DFF}; pg8::StaticOrder S; S.init(MP, DM, G, bx); pg8::EpiResid<false> E{nullptr, Xb, XN, g_ple, SSQ2};
          pg8::gemm_phase<pg8::EpiResid<false>, pg8::StaticOrder, DBG_ALIGN, DBG_SP2>(L + RING_OFF, g, S, E); }
        }
    }
    SEAM(6);
    if (IN(7) && DBG_REPEAT == 7) {
        { pg8::Gemm g{PB, WPP, MP, DM, PLE}; pg8::StaticOrder S; S.init(MP, DM, G, bx); pg8::EpiNull E{SSQ3};
          pg8::gemm_phase<pg8::EpiNull, pg8::StaticOrder, DBG_ALIGN, DBG_SP2>(L + RING_OFF, g, S, E); }
        { pg8::Gemm g{XN, WPG, MP, DM, DM}; pg8::StaticOrder S; S.init(MP, DM, G, bx); pg8::EpiNull E{SSQ3};
          pg8::gemm_phase<pg8::EpiNull, pg8::StaticOrder, DBG_ALIGN, DBG_SP2>(L + RING_OFF, g, S, E); }
        xcd_barrier(bar);
    }
    if (IN(7) && DBG_REPEAT == 17) {
        for (int task = vcu; task < 16 * (DM / 64); task += G) { const int rb = task & 15, col0 = (task >> 4) * 64;
            const f32x4 vp = sk::tile(PB, WPP, PLE, (size_t)MP + rb * 32, col0, (SK_LAS char*)(L + RING_OFF));
            const f32x4 vg = sk::tile(XN, WPG, DM, (size_t)MP + rb * 32, col0, (SK_LAS char*)(L + RING_OFF)); if (vp[0] + vg[0] == 1.2345e33f) SSQ3[0] = vp[1]; }
        xcd_barrier(bar);
    }
    if (IN(7) && DBG_REPEAT == 27) {
        { pg8::Gemm g{PB, WPP, MP, DM, PLE}; pg8::StaticOrder S; S.init(MP, DM, G, bx); pg8::EpiPP E{PPb};
          pg8::gemm_phase<pg8::EpiPP, pg8::StaticOrder, DBG_ALIGN, DBG_SP2>(L + RING_OFF, g, S, E); }
        xcd_barrier(bar);
    }
    if (IN(7)) {
#pragma unroll 1
        for (int pass_ = 0; pass_ < 2; ++pass_) if ((pass_ == 1) == late_) {
        for (int task = vcu; task < 16 * (DM / 64); task += G) { const int rb = task & 15, col0 = (task >> 4) * 64;
            const f32x4 vp = sk::tile(PB, WPP, PLE, (size_t)MP + rb * 32, col0, (SK_LAS char*)(L + RING_OFF));
            const f32x4 vg = sk::tile(XN, WPG, DM, (size_t)MP + rb * 32, col0, (SK_LAS char*)(L + RING_OFF));
            const int t = threadIdx.x, r = MP + rb * 32 + (t >> 4), c = col0 + (t & 15) * 4;
            const float rs_ = sk::rstd16(SSQ2, r, t);
            const f32x4 x3 = sk::up4(*(const GAS unsigned long long*)(Xb + (size_t)r * DM + c)) + pg8::sigm4(vg * rs_) * vp;
            const float ss = sk::sum16(pg8::dot4(x3)); if ((t & 15) == 0) __hip_atomic_store(SSQ3 + (size_t)r * 16 + (col0 >> 6), ss, __ATOMIC_RELAXED, __HIP_MEMORY_SCOPE_AGENT);
            asm volatile("s_waitcnt vmcnt(0)" ::: "memory");
            unsigned* cw = (unsigned*)(ctl + CW_FINS + 64 * rb);
            if ((t & 63) == 0) __hip_atomic_fetch_add(cw, 1u, __ATOMIC_RELAXED, __HIP_MEMORY_SCOPE_AGENT);
            { unsigned spins = 0; while ((unsigned)__builtin_amdgcn_readfirstlane(__hip_atomic_load(cw, __ATOMIC_RELAXED, __HIP_MEMORY_SCOPE_AGENT)) < 128u) { __builtin_amdgcn_s_sleep(2); if (++spins > (1u << 16)) break; } }
            const float r3 = __builtin_amdgcn_rsqf(sk::sum16(__hip_atomic_load(SSQ3 + (size_t)r * 16 + (t & 15), __ATOMIC_RELAXED, __HIP_MEMORY_SCOPE_AGENT)) * (1.0f / 1024.0f) + EPS);
            *(GAS f32x4*)(Yo + (size_t)r * DM + c) = x3 * r3 * *(const GAS f32x4*)(g_final + c);
        }
        } else {
        { pg8::Gemm g{PB, WPP, MP, DM, PLE}; pg8::StaticOrder S; S.init(MP, DM, G, bx); pg8::EpiPP E{PPb};
          pg8::gemm_phase<pg8::EpiPP, pg8::StaticOrder, DBG_ALIGN, DBG_SP2>(L + RING_OFF, g, S, E); }
        { pg8::Gemm g{XN, WPG, MP, DM, DM}; pg8::StaticOrder S; S.init(MP, DM, G, bx); pg8::EpiPleFinal E{SSQ2, PPb, Xb, Yo, SSQ3, g_final, (unsigned*)(ctl + CW_FIN)};
          pg8::gemm_phase<pg8::EpiPleFinal, pg8::StaticOrder, DBG_ALIGN, DBG_SP2>(L + RING_OFF, g, S, E); }
        }
    }
#undef IN
#undef SEAM
}

extern "C" void kernel_launch(void* const* d_in, const int* in_sizes, int n_in, void* d_out, int out_size, void* d_ws, size_t ws_size, hipStream_t stream) {
    static int grid = 0;
    if (grid == 0) {
        if (n_in != 22 || out_size != (int)O_END || ws_size < WS_END) { fprintf(stderr, "kernel_launch: unexpected sizes: n_in %d out %d ws %zu\n", n_in, out_size, ws_size); grid = -1; return; }
        int dev = 0, cus = 0, per_cu = 0;
        if (hipGetDevice(&dev) != hipSuccess || hipDeviceGetAttribute(&cus, hipDeviceAttributeMultiprocessorCount, dev) != hipSuccess) { grid = -1; return; }
        if (hipFuncSetAttribute((const void*)mega_fwd, hipFuncAttributeMaxDynamicSharedMemorySize, LDS_BYTES) != hipSuccess) { fprintf(stderr, "kernel_launch: hipFuncSetAttribute failed\n"); grid = -1; return; }
        if (hipOccupancyMaxActiveBlocksPerMultiprocessor(&per_cu, (const void*)mega_fwd, NWAVES * 64, LDS_BYTES) != hipSuccess || per_cu < 1) { fprintf(stderr, "kernel_launch: occupancy query says %d\n", per_cu); (void)hipGetLastError(); per_cu = 1; }
        grid = cus;
    }
    if (grid < 0) return;
    (void)hipMemsetAsync((char*)d_ws + WS_CTL, 0, CTL_ZERO_BYTES, stream);
    Args a{};
    for (int i = 0; i < 22; ++i) a.in[i] = (const float*)d_in[i];
    a.out = (float*)d_out; a.ws = (unsigned char*)d_ws;
#ifndef DBG_PH_HI
#define DBG_PH_HI N_PHASES
#endif
    if (MK_N_LAUNCHES == 1) { a.ph_lo = 0; a.ph_hi = DBG_PH_HI; a.li = 0; hipLaunchKernelGGL(mega_fwd, dim3(grid), dim3(NWAVES * 64), LDS_BYTES, stream, a); }
    else for (int li = 0; li < N_PHASES; ++li) { a.ph_lo = li; a.ph_hi = li + 1; a.li = li; hipLaunchKernelGGL(mega_fwd, dim3(grid), dim3(NWAVES * 64), LDS_BYTES, stream, a);
#if defined(HYB_ATTN)
        if (li == 2) hyb_attn<<<(MT * NH + 63) / 64, 64, 0, stream>>>((const unsigned short*)((char*)d_ws + WS_Q), (const unsigned short*)((char*)d_ws + WS_K), (const unsigned short*)((char*)d_ws + WS_V), (const float*)d_in[2], (const float*)d_in[3], (unsigned short*)((char*)d_ws + WS_YSB));
#endif
#if defined(HYB_POOL)
        if (li == 2) hyb_pool<<<(int)(((size_t)MT * PW + 255) / 256), 256, 0, stream>>>((const unsigned short*)((char*)d_ws + WS_U), (const float*)d_in[4], (unsigned short*)((char*)d_ws + WS_Y));
#endif
    }
}
```

```cpp
#include <hip/hip_runtime.h>
#include <hip/hip_bf16.h>
#include <cstdio>
#include <cstdint>
#include <cmath>
namespace cfg {
constexpr int DM = 1024, NB = 8, SEQ = 2048, DB = 16, DS = 32, PAST = 1024, PW = 512, SBW = 512, HD = 64, NH = 8, DFF = 4096, PLE = 256, INW = 4096;
constexpr int MP = NB * SEQ, MS = DB * DS, MT = MP + MS;
constexpr float EPS = 1e-6f;
constexpr float QSCALE = 0.125f * 1.4426950408889634f;
}
namespace pg8 {
#define PG8_LAS __attribute__((address_space(3)))
typedef unsigned short bf16_t;
typedef short bf16x8 __attribute__((ext_vector_type(8)));
typedef float f32x4 __attribute__((ext_vector_type(4)));
typedef unsigned u32x4 __attribute__((ext_vector_type(4)));
constexpr int BM = 256, BK = 64, HALF = 128, HTB = HALF * BK * 2  , STAGE_BYTES = 8 * HTB, NXCD = 8, WGM = 8;

__host__ __device__ __forceinline__ int lds_byte(int r, int c) { const int st = (r >> 4) * 2 + (c >> 5), rr = r & 15, cc = c & 31, ob = rr * 64 + cc * 2; return st * 1024 + (ob ^ (((ob >> 9) & 1) << 5)); }
__host__ __device__ __forceinline__ void stage_rc(int b, int& R, int& C) { const int st = b / 1024, sb = b % 1024, swz = sb ^ (((sb >> 9) & 1) << 5); R = (st >> 1) * 16 + swz / 64; C = (st & 1) * 32 + (swz % 64) / 2; }
__host__ __device__ __forceinline__ int perm32(int rho) { const int n = rho >> 4, i = rho & 15; return 8 * (i >> 2) + 4 * n + (i & 3); }

struct Unit { int pm, pn, seg; };
struct Gemm { const bf16_t* A; const bf16_t* Bt; int M, N, K; const bf16_t* A1 = nullptr; const bf16_t* Bt1 = nullptr; };

struct StaticOrder {
    int nM, nN, nwg, G, c;
    __host__ __device__ void init(int M, int N, int G_, int c_) { nM = M / BM; nN = N / BM; nwg = nM * nN; G = G_; c = c_; }
    __host__ __device__ bool next(int i, Unit& u) const {
        const long L = (long)i * G + c; if (L >= nwg) return false;
        int wgid = (int)L; { const int q = nwg / NXCD, r = nwg % NXCD, xcd = wgid % NXCD, off = wgid / NXCD; wgid = (xcd < r ? xcd * (q + 1) : r * (q + 1) + (xcd - r) * q) + off; }
        const int nig = WGM * nN, gid = wgid / nig, fm = gid * WGM, gsz = (nM - fm) < WGM ? (nM - fm) : WGM;
        u.pm = fm + ((wgid % nig) % gsz); u.pn = (wgid % nig) / gsz; u.seg = 0; return true;
    }
    __device__ __forceinline__ void a_ready(const Unit&) const {}
    __device__ __forceinline__ void done(const Unit&) const {}
};
struct RotOrder : StaticOrder {
    int rot, cnt;
    __host__ __device__ void init(int M, int N, int G_, int c_, int rot_) { StaticOrder::init(M, N, G_, c_); cnt = (nwg % G_ == 0) ? nwg / G_ : 0; rot = rot_; }
    __host__ __device__ bool next(int i, Unit& u) const { if (cnt == 0) return StaticOrder::next(i, u); if (i >= cnt) return false; return StaticOrder::next((i + rot) % cnt, u); }
};
struct PairOrder : StaticOrder {
    __host__ __device__ bool next(int i, Unit& u) const { if (!StaticOrder::next(i >> 1, u)) return false; u.seg = i & 1; return true; }
};
typedef float f32x2v_t __attribute__((ext_vector_type(2))); typedef __bf16 bf16x2v_t __attribute__((ext_vector_type(2)));
__device__ __forceinline__ unsigned cvt_pk_bf16(float lo, float hi) { f32x2v_t v = {lo, hi}; bf16x2v_t b = __builtin_convertvector(v, bf16x2v_t); return __builtin_bit_cast(unsigned, b); }
typedef float f32x2 __attribute__((ext_vector_type(2)));
__device__ __forceinline__ float bf_lo(unsigned w) { return __uint_as_float(w << 16); }
__device__ __forceinline__ float bf_hi(unsigned w) { return __uint_as_float(w & 0xffff0000u); }
__device__ __forceinline__ u32x4 pack8(f32x4 a, f32x4 b) { u32x4 w; w.x = cvt_pk_bf16(a[0], a[1]); w.y = cvt_pk_bf16(a[2], a[3]); w.z = cvt_pk_bf16(b[0], b[1]); w.w = cvt_pk_bf16(b[2], b[3]); return w; }
__device__ __forceinline__ void unpack8(u32x4 w, f32x4& a, f32x4& b) { a = (f32x4){bf_lo(w.x), bf_hi(w.x), bf_lo(w.y), bf_hi(w.y)}; b = (f32x4){bf_lo(w.z), bf_hi(w.z), bf_lo(w.w), bf_hi(w.w)}; }
__device__ __forceinline__ float sigm(float x) { return __builtin_amdgcn_rcpf(1.f + __builtin_amdgcn_exp2f(-1.4426950408889634f * x)); }
__device__ __forceinline__ f32x4 sigm4(f32x4 x) { return (f32x4){sigm(x[0]), sigm(x[1]), sigm(x[2]), sigm(x[3])}; }
__device__ __forceinline__ float dot4(f32x4 a) { return (a[0] * a[0] + a[1] * a[1]) + (a[2] * a[2] + a[3] * a[3]); }
#ifndef DBG_LDAUX
#define DBG_LDAUX 16
#endif
__device__ __forceinline__ u32x4 ld16_sc1(const void* base, size_t byte_off) {
    const __amdgpu_buffer_rsrc_t rs = __builtin_amdgcn_make_buffer_rsrc((void*)base, (short)0, 0x7fffffff, 0x00020000);
    return __builtin_bit_cast(u32x4, __builtin_amdgcn_raw_buffer_load_b128(rs, (unsigned)byte_off, 0, DBG_LDAUX));
}
__device__ __forceinline__ unsigned pk_u8x4(f32x4 g) { unsigned w = 0u; w = __builtin_amdgcn_cvt_pk_u8_f32(g[0] * 255.0f, 0, w); w = __builtin_amdgcn_cvt_pk_u8_f32(g[1] * 255.0f, 1, w); w = __builtin_amdgcn_cvt_pk_u8_f32(g[2] * 255.0f, 2, w); w = __builtin_amdgcn_cvt_pk_u8_f32(g[3] * 255.0f, 3, w); return w; }
__device__ __forceinline__ f32x4 up_u8x4(unsigned w) { return (f32x4){(float)(w & 0xffu), (float)((w >> 8) & 0xffu), (float)((w >> 16) & 0xffu), (float)(w >> 24)} * (1.0f / 255.0f); }
typedef unsigned u32x2 __attribute__((ext_vector_type(2)));
template <int AUX> __device__ __forceinline__ void st16_aux(void* base, size_t byte_off, u32x4 v) {
    if constexpr (AUX == 0) { *(u32x4*)((char*)base + byte_off) = v; }
    else { const __amdgpu_buffer_rsrc_t rs = __builtin_amdgcn_make_buffer_rsrc(base, (short)0, 0x7fffffff, 0x00020000); __builtin_amdgcn_raw_buffer_store_b128(v, rs, (unsigned)byte_off, 0, AUX); }
}
#ifndef DBG_AUXHS
#define DBG_AUXHS 0
#endif
__device__ __forceinline__ float row_rstd(const float* SSQ, int r, int fq) {
    const f32x4 p = *(const f32x4*)(SSQ + (size_t)r * 16 + 4 * fq); float s = (p[0] + p[1]) + (p[2] + p[3]);
    s += __shfl_xor(s, 16); s += __shfl_xor(s, 32);
    return __builtin_amdgcn_rsqf(s * (1.0f / 1024.0f) + cfg::EPS);
}
#define PG8_ROWS(...) _Pragma("unroll") for (int ai = 0; ai < 2; ++ai) _Pragma("unroll") for (int m = 0; m < 4; ++m) { const int r = u.pm * BM + ai * HALF + wr * 64 + m * 16 + fr; __VA_ARGS__; if (m == 3) asm volatile("" ::: "memory"); }
#define PG8_COLS(...) _Pragma("unroll") for (int bj = 0; bj < 2; ++bj) { const int c = ct + bj * HALF + wc * 32 + 8 * fq; const f32x4 v0 = acc[ai][bj][m][0], v1 = acc[ai][bj][m][1]; __VA_ARGS__; }

struct EpiIn {
    static constexpr bool PERM = true, AFTER_DRAIN = false;
    bf16_t *U, *Q, *K, *V, *G; const float* b_gate; float *k_p, *v_p, *k_s, *v_s, *pool_p, *pool_s;
    __device__ __forceinline__ void operator()(const f32x4 (&acc)[2][2][4][2], const Unit& u, int wr, int wc, int fr, int fq) const {
        const int pn = u.pn;
        if (pn >= 8) {
            const int ct = (pn - 8) * BM; f32x4 bv[2][2];
#pragma unroll
            for (int bj = 0; bj < 2; ++bj) { const int c = ct + bj * HALF + wc * 32 + 8 * fq; bv[bj][0] = *(const f32x4*)(b_gate + c); bv[bj][1] = *(const f32x4*)(b_gate + c + 4); }
            PG8_ROWS(PG8_COLS(*(u32x2*)((unsigned char*)G + (size_t)r * 2048 + c) = (u32x2){pk_u8x4(sigm4(v0 + bv[bj][0])), pk_u8x4(sigm4(v1 + bv[bj][1]))}))
        } else if (pn >= 4) {
            const bool isv = pn >= 6; const int ct = (pn - (isv ? 6 : 4)) * BM; bf16_t* B = isv ? V : K; float* op = isv ? v_p : k_p; float* os = isv ? v_s : k_s;
            PG8_ROWS(float* orow = r < cfg::MP ? op + (size_t)r * 512 : os + (size_t)(r - cfg::MP) * 512;
                     PG8_COLS(*(u32x4*)(B + (size_t)r * 512 + c) = pack8(v0, v1); __builtin_nontemporal_store(v0, (f32x4*)(orow + c)); __builtin_nontemporal_store(v1, (f32x4*)(orow + c + 4))))
        } else if (pn >= 2) {
            const int ct = (pn - 2) * BM;
            PG8_ROWS(PG8_COLS(*(u32x4*)(Q + (size_t)r * 512 + c) = pack8(v0 * cfg::QSCALE, v1 * cfg::QSCALE)))
        } else {
            const int ct = pn * BM;
            PG8_ROWS(float* prow = nullptr;
                     if (r < cfg::MP) { const int t = r & (cfg::SEQ - 1); if (t >= cfg::SEQ - 15) prow = pool_p + ((size_t)(r >> 11) * 15 + (t - (cfg::SEQ - 15))) * 512; }
                     else { const int i = (r - cfg::MP) & 31; if (i >= 17) prow = pool_s + ((size_t)((r - cfg::MP) >> 5) * 15 + (i - 17)) * 512; }
                     PG8_COLS(*(u32x4*)(U + (size_t)r * 512 + c) = pack8(v0, v1); if (prow) { *(f32x4*)(prow + c) = v0; *(f32x4*)(prow + c + 4) = v1; }))
        }
    }
};
#if defined(DBG_ONLYG)
#define DBG_NOG_STMT *(u32x4*)(MG + (size_t)r * 1024 + c) = gw; continue;
#elif defined(DBG_NOG)
#define DBG_NOG_STMT g0 = (f32x4){0.5f, 0.5f, 0.5f, 0.5f}; g1 = g0;
#else
#define DBG_NOG_STMT
#endif
struct EpiMerge;
struct EpiMerge0 {
    static constexpr bool PERM = true, AFTER_DRAIN = false;
    const bf16_t* G; bf16_t* MG;
    __device__ __forceinline__ void operator()(const f32x4 (&acc)[2][2][4][2], const Unit& u, int wr, int wc, int fr, int fq) const {
        const int ct = u.pn * BM;
        PG8_ROWS(PG8_COLS(const u32x2 gw = *(const u32x2*)((const unsigned char*)G + (size_t)r * 2048 + c); const f32x4 g0 = up_u8x4(gw.x); const f32x4 g1 = up_u8x4(gw.y); *(u32x4*)(MG + (size_t)r * 1024 + c) = pack8(v0 * g0, v1 * g1)))
    }
};
#ifdef DBG_NORAW
#define DBG_NORAW_STMT m0 = (f32x4){0.f, 0.f, 0.f, 0.f}; m1 = m0;
#else
#define DBG_NORAW_STMT
#endif
struct EpiMerge1 {
    static constexpr bool PERM = true, AFTER_DRAIN = false;
    const bf16_t* G; bf16_t* MG;
    __device__ __forceinline__ void operator()(const f32x4 (&acc)[2][2][4][2], const Unit& u, int wr, int wc, int fr, int fq) const {
        const int ct = u.pn * BM;
        PG8_ROWS(PG8_COLS(const u32x2 gw = *(const u32x2*)((const unsigned char*)G + (size_t)r * 2048 + 1024 + c); const u32x4 mw = *(const u32x4*)(MG + (size_t)r * 1024 + c);
                          const f32x4 g0 = up_u8x4(gw.x); const f32x4 g1 = up_u8x4(gw.y); f32x4 m0; f32x4 m1; unpack8(mw, m0, m1); *(u32x4*)(MG + (size_t)r * 1024 + c) = pack8(m0 + v0 * g0, m1 + v1 * g1)))
    }
};
struct EpiMerge {
    static constexpr bool PERM = true, AFTER_DRAIN = false;
    const bf16_t* G; bf16_t* MG;
    __device__ __forceinline__ void operator()(const f32x4 (&acc)[2][2][4][2], const Unit& u, int wr, int wc, int fr, int fq) const {
        if (u.seg == 0) { const EpiMerge0 E0{G, MG}; E0(acc, u, wr, wc, fr, fq); } else { const EpiMerge1 E1{G, MG}; E1(acc, u, wr, wc, fr, fq); }
    }
};
template <bool F32RES>
struct EpiResid {
    static constexpr bool PERM = true, AFTER_DRAIN = false;
    const float* res_p; bf16_t* X; bf16_t* XG; const float* gvec; float* SSQ;
    __device__ __forceinline__ void operator()(const f32x4 (&acc)[2][2][4][2], const Unit& u, int wr, int wc, int fr, int fq) const {
        const int ct = u.pn * BM; f32x4 gv[2][2];
#pragma unroll
        for (int bj = 0; bj < 2; ++bj) { const int c = ct + bj * HALF + wc * 32 + 8 * fq; gv[bj][0] = *(const f32x4*)(gvec + c); gv[bj][1] = *(const f32x4*)(gvec + c + 4); }
        PG8_ROWS(float s = 0.f;
                 PG8_COLS(f32x4 a; f32x4 b;
                          if (F32RES) { a = __builtin_nontemporal_load((const f32x4*)(res_p + (size_t)r * 1024 + c)); b = __builtin_nontemporal_load((const f32x4*)(res_p + (size_t)r * 1024 + c + 4)); }
                          else { const u32x4 xw = *(const u32x4*)(X + (size_t)r * 1024 + c); unpack8(xw, a, b); }
                          a += v0; b += v1; *(u32x4*)(X + (size_t)r * 1024 + c) = pack8(a, b); s += dot4(a) + dot4(b);
                          *(u32x4*)(XG + (size_t)r * 1024 + c) = pack8(a * gv[bj][0], b * gv[bj][1]))
                 s += __shfl_xor(s, 16); s += __shfl_xor(s, 32); if (fq == 0) SSQ[(size_t)r * 16 + u.pn * 4 + wc] = s)
    }
};
struct EpiUp {
    static constexpr bool PERM = true, AFTER_DRAIN = false;
    const float* SSQ; bf16_t* H;
    __device__ __forceinline__ void operator()(const f32x4 (&acc)[2][2][4][2], const Unit& u, int wr, int wc, int fr, int fq) const {
        const int ct = u.pn * BM; float rsv[2][4];
#pragma unroll
        for (int ai = 0; ai < 2; ++ai)
#pragma unroll
            for (int m = 0; m < 4; ++m) rsv[ai][m] = row_rstd(SSQ, u.pm * BM + ai * HALF + wr * 64 + m * 16 + fr, fq);
        PG8_ROWS(const float rs = rsv[ai][m];
                 PG8_COLS(f32x4 a = v0 * rs; f32x4 b = v1 * rs; a = __builtin_elementwise_max(a, (f32x4){0.f, 0.f, 0.f, 0.f}); b = __builtin_elementwise_max(b, (f32x4){0.f, 0.f, 0.f, 0.f});
                          st16_aux<DBG_AUXHS>(H, ((size_t)r * 4096 + c) * 2, pack8(a * a, b * b))))
    }
};
struct EpiNull {
    static constexpr bool PERM = true, AFTER_DRAIN = false;
    float* sink;
    __device__ __forceinline__ void operator()(const f32x4 (&acc)[2][2][4][2], const Unit& u, int wr, int wc, int fr, int fq) const {
        float s = 0.f;
#pragma unroll
        for (int ai = 0; ai < 2; ++ai)
#pragma unroll
            for (int bj = 0; bj < 2; ++bj)
#pragma unroll
                for (int m = 0; m < 4; ++m)
#pragma unroll
                    for (int n = 0; n < 2; ++n) s += acc[ai][bj][m][n][0] + acc[ai][bj][m][n][3];
        if (s == 1.2345e33f) sink[0] = s;
    }
};
struct EpiPP {
    static constexpr bool PERM = true, AFTER_DRAIN = false;
    bf16_t* PP;
    __device__ __forceinline__ void operator()(const f32x4 (&acc)[2][2][4][2], const Unit& u, int wr, int wc, int fr, int fq) const {
        const int ct = u.pn * BM;
        PG8_ROWS(PG8_COLS(*(u32x4*)(PP + (size_t)r * 1024 + c) = pack8(v0, v1)))
    }
};
struct EpiPleFinal {
    static constexpr bool PERM = true, AFTER_DRAIN = false;
    const float* SSQ; const bf16_t* PP; const bf16_t* X; float* Y; float* SSQo; const float* gfin; unsigned* cnt;
    __device__ __forceinline__ void operator()(f32x4 (&acc)[2][2][4][2], const Unit& u, int wr, int wc, int fr, int fq) const {
        const int ct = u.pn * BM; float rsv[2][4];
#pragma unroll
        for (int ai = 0; ai < 2; ++ai)
#pragma unroll
            for (int m = 0; m < 4; ++m) rsv[ai][m] = row_rstd(SSQ, u.pm * BM + ai * HALF + wr * 64 + m * 16 + fr, fq);
        PG8_ROWS(const float rs = rsv[ai][m]; float s = 0.f;
                 PG8_COLS(const u32x4 pw = *(const u32x4*)(PP + (size_t)r * 1024 + c); f32x4 p0; f32x4 p1; unpack8(pw, p0, p1);
                          const u32x4 xw = *(const u32x4*)(X + (size_t)r * 1024 + c); f32x4 a; f32x4 b; unpack8(xw, a, b); a += sigm4(v0 * rs) * p0; b += sigm4(v1 * rs) * p1;
                          acc[ai][bj][m][0] = a; acc[ai][bj][m][1] = b; s += dot4(a) + dot4(b))
                 s += __shfl_xor(s, 16); s += __shfl_xor(s, 32);
                 if (fq == 0) __hip_atomic_store(SSQo + (size_t)r * 16 + u.pn * 4 + wc, s, __ATOMIC_RELAXED, __HIP_MEMORY_SCOPE_AGENT))
        asm volatile("s_waitcnt vmcnt(0)" ::: "memory");
        unsigned* cw = cnt + 64 * (2 * u.pm + wr);
        if (fr == 0 && fq == 0) __hip_atomic_fetch_add(cw, 1u, __ATOMIC_RELAXED, __HIP_MEMORY_SCOPE_AGENT);
        { unsigned spins = 0;
          while ((unsigned)__builtin_amdgcn_readfirstlane(__hip_atomic_load(cw, __ATOMIC_RELAXED, __HIP_MEMORY_SCOPE_AGENT)) < 16u) { __builtin_amdgcn_s_sleep(2); if (++spins > (1u << 16)) break; } }
        f32x4 gv[2][2];
#pragma unroll
        for (int bj = 0; bj < 2; ++bj) { const int c = ct + bj * HALF + wc * 32 + 8 * fq; gv[bj][0] = *(const f32x4*)(gfin + c); gv[bj][1] = *(const f32x4*)(gfin + c + 4); }
        PG8_ROWS(const f32x4 pq = __builtin_bit_cast(f32x4, ld16_sc1(SSQo, ((size_t)r * 16 + 4 * fq) * 4)); float t = (pq[0] + pq[1]) + (pq[2] + pq[3]); t += __shfl_xor(t, 16); t += __shfl_xor(t, 32);
                 const float r3 = __builtin_amdgcn_rsqf(t * (1.0f / 1024.0f) + cfg::EPS);
                 PG8_COLS(__builtin_nontemporal_store(v0 * r3 * gv[bj][0], (f32x4*)(Y + (size_t)r * 1024 + c)); __builtin_nontemporal_store(v1 * r3 * gv[bj][1], (f32x4*)(Y + (size_t)r * 1024 + c + 4))))
    }
};
struct NoHook { __device__ __forceinline__ void operator()(int) const {} };
template <class Epi, class Sched, bool ALIGN_EPI = false, bool SP2 = false, class Hook = NoHook, int AUXA = 0>
__device__ __forceinline__ void gemm_phase(PG8_LAS unsigned char* lds, const Gemm g, const Sched& S, const Epi& E, const Hook& H = Hook()) {
    int tid = threadIdx.x; asm volatile("" : "+v"(tid));
    const int wid = __builtin_amdgcn_readfirstlane(tid >> 6), lane = tid & 63, wr = wid >> 2, wc = wid & 3, fr = lane & 15, fq = lane >> 4;
    int K = g.K; asm volatile("" : "+s"(K)); const int nt = K / BK;
    unsigned voffA[2], voffB[2];
#pragma unroll
    for (int i = 0; i < 2; ++i) { int R, C; stage_rc(tid * 16 + i * 8192, R, C); const int Rb = Epi::PERM ? ((R & ~31) + perm32(R & 31)) : R;
        voffA[i] = (unsigned)(R * K + C) * 2u; voffB[i] = (unsigned)(Rb * K + C) * 2u; }
    const size_t kstep = (size_t)(BK * 2);
    const size_t hstep = (size_t)HALF * K * 2;
    const size_t tstep = 2 * hstep;
    const size_t bhs = hstep;
    const unsigned ldsw = (unsigned)wid * 1024u;
    const int aoff = lds_byte(wr * 64 + fr, fq * 8), boff = lds_byte(wc * 32 + fr, fq * 8);
#define PG8_SA(b, h) (((b) * 2 + (h)) * HTB)
#define PG8_SB(b, h) ((4 + (b) * 2 + (h)) * HTB)
#define PG8_STAGE_X(bufoff, gbase, voff, AUX) do { _Pragma("unroll") for (int _i = 0; _i < 2; ++_i) \
        __builtin_amdgcn_global_load_lds((const unsigned*)((const char*)(gbase) + (voff)[_i]), (PG8_LAS unsigned*)(lds + (bufoff) + ldsw + _i * 8192), 16, 0, AUX); } while (0)
#define PG8_LDA(dst, b, h) do { _Pragma("unroll") for (int m = 0; m < 4; ++m) _Pragma("unroll") for (int k = 0; k < 2; ++k) dst[m][k] = *(const PG8_LAS bf16x8*)(lds + PG8_SA(b, h) + aoff + m * 2048 + k * 1024); } while (0)
#define PG8_LDB(dst, b, h) do { _Pragma("unroll") for (int n = 0; n < 2; ++n) _Pragma("unroll") for (int k = 0; k < 2; ++k) dst[n][k] = *(const PG8_LAS bf16x8*)(lds + PG8_SB(b, h) + boff + n * 2048 + k * 1024); } while (0)
#define PG8_MMA(ai, bj, At, Bt) do { __builtin_amdgcn_s_setprio(1); _Pragma("unroll") for (int m = 0; m < 4; ++m) _Pragma("unroll") for (int n = 0; n < 2; ++n) _Pragma("unroll") for (int k = 0; k < 2; ++k) \
        acc[ai][bj][m][n] = __builtin_amdgcn_mfma_f32_16x16x32_bf16(Bt[n][k], At[m][k], acc[ai][bj][m][n], 0, 0, 0); __builtin_amdgcn_s_setprio(0); } while (0)
#ifdef DRAIN_ALL
#define PG8_WAIT_V(n) asm volatile("s_waitcnt vmcnt(0)" ::: "memory")
#else
#define PG8_WAIT_V(n) asm volatile("s_waitcnt vmcnt(" #n ")" ::: "memory")
#endif
#define PG8_WAIT_L(n) asm volatile("s_waitcnt lgkmcnt(" #n ")" ::: "memory")
#define PG8_BAR __builtin_amdgcn_s_barrier()
#define PG8_SCHED __builtin_amdgcn_sched_barrier(0)
    Unit cur, nxt; int ui = 0;
    if (!S.next(0, cur)) return;
    f32x4 acc[2][2][4][2];
#pragma unroll
    for (int a = 0; a < 2; ++a)
#pragma unroll
        for (int b = 0; b < 2; ++b)
#pragma unroll
            for (int m = 0; m < 4; ++m)
#pragma unroll
                for (int n = 0; n < 2; ++n) acc[a][b][m][n] = (f32x4){0.f, 0.f, 0.f, 0.f};
    bf16x8 At[4][2], B0[2][2], B1[2][2];
    const char* cA = (const char*)(cur.seg ? g.A1 : g.A) + (size_t)cur.pm * tstep; const char* cB = (const char*)(cur.seg ? g.Bt1 : g.Bt) + (size_t)cur.pn * tstep;
    S.a_ready(cur);
    if constexpr (SP2) {
        PG8_STAGE_X(PG8_SB(0, 0), cB, voffB, 0); PG8_STAGE_X(PG8_SB(0, 1), cB + bhs, voffB, 0); PG8_STAGE_X(PG8_SA(0, 0), cA, voffA, AUXA); PG8_STAGE_X(PG8_SA(0, 1), cA + hstep, voffA, AUXA);
        if (wr == 1) PG8_BAR;
        PG8_WAIT_V(2); PG8_BAR;
        PG8_STAGE_X(PG8_SB(1, 0), cB + kstep, voffB, 0); PG8_STAGE_X(PG8_SA(1, 0), cA + kstep, voffA, AUXA); PG8_STAGE_X(PG8_SB(1, 1), cB + bhs + kstep, voffB, 0);
        PG8_WAIT_V(6); PG8_BAR;
    } else {
        PG8_STAGE_X(PG8_SB(0, 0), cB, voffB, 0); PG8_STAGE_X(PG8_SA(0, 0), cA, voffA, AUXA); PG8_STAGE_X(PG8_SB(0, 1), cB + bhs, voffB, 0); PG8_STAGE_X(PG8_SA(0, 1), cA + hstep, voffA, AUXA);
        if (wr == 1) PG8_BAR;
        PG8_WAIT_V(4); PG8_BAR;
        PG8_STAGE_X(PG8_SB(1, 0), cB + kstep, voffB, 0); PG8_STAGE_X(PG8_SA(1, 0), cA + kstep, voffA, AUXA); PG8_STAGE_X(PG8_SB(1, 1), cB + bhs + kstep, voffB, 0);
        PG8_WAIT_V(6); PG8_BAR;
    }
    for (;;) {
        const bool has_next = S.next(ui + 1, nxt);
        const char* nA = has_next ? (const char*)(nxt.seg ? g.A1 : g.A) + (size_t)nxt.pm * tstep : cA; const char* nB = has_next ? (const char*)(nxt.seg ? g.Bt1 : g.Bt) + (size_t)nxt.pn * tstep : cB;
        for (int t = 0; t < nt; t += 2) {
            const bool last = (t == nt - 2);
            const char* a1 = cA + (size_t)(t + 1) * kstep;
            const char* a2 = last ? nA : cA + (size_t)(t + 2) * kstep; const char* b2 = last ? nB : cB + (size_t)(t + 2) * kstep;
            const char* a3 = a2 + kstep; const char* b3 = b2 + kstep;
            if (last && has_next) S.a_ready(nxt);
            if constexpr (SP2) {
            PG8_LDB(B0, 0, 0); PG8_LDB(B1, 0, 1); PG8_SCHED; PG8_LDA(At, 0, 0); PG8_STAGE_X(PG8_SA(1, 1), a1 + hstep, voffA, AUXA);
            PG8_WAIT_V(8); PG8_WAIT_L(0); PG8_BAR; PG8_MMA(0, 0, At, B0); PG8_MMA(0, 1, At, B1); PG8_BAR; PG8_SCHED;
            PG8_LDA(At, 0, 1); PG8_STAGE_X(PG8_SB(0, 0), b2, voffB, 0); PG8_STAGE_X(PG8_SB(0, 1), b2 + bhs, voffB, 0); PG8_STAGE_X(PG8_SA(0, 0), a2, voffA, AUXA);
            PG8_WAIT_V(8); PG8_WAIT_L(0); PG8_BAR; PG8_MMA(1, 0, At, B0); PG8_MMA(1, 1, At, B1); PG8_BAR; PG8_SCHED;
            PG8_LDB(B0, 1, 0); PG8_LDB(B1, 1, 1); PG8_SCHED; PG8_LDA(At, 1, 0); PG8_STAGE_X(PG8_SA(0, 1), a2 + hstep, voffA, AUXA);
            PG8_WAIT_V(8); PG8_WAIT_L(0); PG8_BAR; PG8_MMA(0, 0, At, B0); PG8_MMA(0, 1, At, B1); PG8_BAR; PG8_SCHED;
            PG8_LDA(At, 1, 1); PG8_STAGE_X(PG8_SB(1, 0), b3, voffB, 0); PG8_STAGE_X(PG8_SB(1, 1), b3 + bhs, voffB, 0); PG8_STAGE_X(PG8_SA(1, 0), a3, voffA, AUXA);
            PG8_WAIT_V(8); PG8_WAIT_L(0); PG8_BAR; PG8_MMA(1, 0, At, B0); PG8_MMA(1, 1, At, B1); PG8_BAR; PG8_SCHED;
            } else {
            PG8_LDB(B0, 0, 0); PG8_SCHED; PG8_LDA(At, 0, 0); PG8_STAGE_X(PG8_SA(1, 1), a1 + hstep, voffA, AUXA);
            PG8_WAIT_L(8); PG8_BAR; PG8_WAIT_L(0); PG8_MMA(0, 0, At, B0); PG8_BAR; PG8_SCHED;
            PG8_LDB(B1, 0, 1); PG8_STAGE_X(PG8_SB(0, 0), b2, voffB, 0);
            PG8_BAR; PG8_WAIT_L(0); PG8_MMA(0, 1, At, B1); PG8_BAR;
            PG8_LDA(At, 0, 1); PG8_STAGE_X(PG8_SA(0, 0), a2, voffA, AUXA);
            PG8_BAR; PG8_WAIT_L(0); PG8_MMA(1, 0, At, B0); PG8_BAR; PG8_SCHED;
            PG8_STAGE_X(PG8_SB(0, 1), b2 + bhs, voffB, 0);
            PG8_WAIT_V(6); PG8_BAR; PG8_MMA(1, 1, At, B1); PG8_BAR;
            PG8_LDB(B0, 1, 0); PG8_SCHED; PG8_LDA(At, 1, 0); PG8_STAGE_X(PG8_SA(0, 1), a2 + hstep, voffA, AUXA);
            PG8_WAIT_L(8); PG8_BAR; PG8_WAIT_L(0); PG8_MMA(0, 0, At, B0); PG8_BAR; PG8_SCHED;
            PG8_LDB(B1, 1, 1); PG8_STAGE_X(PG8_SB(1, 0), b3, voffB, 0);
            PG8_BAR; PG8_WAIT_L(0); PG8_MMA(0, 1, At, B1); PG8_BAR;
            PG8_LDA(At, 1, 1); PG8_STAGE_X(PG8_SA(1, 0), a3, voffA, AUXA);
            PG8_BAR; PG8_WAIT_L(0); PG8_MMA(1, 0, At, B0); PG8_BAR; PG8_SCHED;
            PG8_STAGE_X(PG8_SB(1, 1), b3 + bhs, voffB, 0);
            PG8_WAIT_V(6); PG8_BAR; PG8_MMA(1, 1, At, B1); PG8_BAR;
            }
        }
        if constexpr (ALIGN_EPI) { if (wr == 0) PG8_BAR; }
        if constexpr (!Epi::AFTER_DRAIN) { int t_ = threadIdx.x; asm volatile("" : "+v"(t_)); const int l_ = t_ & 63; E(acc, cur, wr, wc, l_ & 15, l_ >> 4); S.done(cur); H(ui); }
        if (!has_next) break;
#pragma unroll
        for (int a = 0; a < 2; ++a)
#pragma unroll
            for (int b = 0; b < 2; ++b)
#pragma unroll
                for (int m = 0; m < 4; ++m)
#pragma unroll
                    for (int n = 0; n < 2; ++n) acc[a][b][m][n] = (f32x4){0.f, 0.f, 0.f, 0.f};
        cur = nxt; cA = nA; cB = nB; ++ui;
        if constexpr (ALIGN_EPI) { if (wr == 1) PG8_BAR; }
    }
    PG8_WAIT_V(0);
    if constexpr (!ALIGN_EPI) { if (wr == 0) PG8_BAR; }
    PG8_BAR;
    if constexpr (Epi::AFTER_DRAIN) { E.fused(acc, cur, wr, wc, fr, fq, lds, wid, lane); S.done(cur); }
#undef PG8_SA
#undef PG8_SB
#undef PG8_STAGE_X
#undef PG8_LDA
#undef PG8_LDB
#undef PG8_MMA
#undef PG8_WAIT_V
#undef PG8_WAIT_L
#undef PG8_BAR
#undef PG8_SCHED
}
}
namespace sba {
typedef short bf16x8 __attribute__((ext_vector_type(8)));
typedef short s16x4 __attribute__((ext_vector_type(4)));
typedef float f32x16 __attribute__((ext_vector_type(16)));
typedef float f32x4 __attribute__((ext_vector_type(4)));
typedef unsigned u32x4 __attribute__((ext_vector_type(4)));
typedef unsigned short bf16_t;
#define SB_LAS __attribute__((address_space(3)))
constexpr int PITCH = 512, SLOTB = 16384  , OFF_FLAGS = 2 * SLOTB, OFF_OST = OFF_FLAGS + 256, LDS_BYTES = OFF_OST + 8 * 4096;
constexpr float THR2 = 48.0f, NEGBIG = -1.0e30f;
typedef float f32x2_t __attribute__((ext_vector_type(2))); typedef __bf16 bf16x2_t __attribute__((ext_vector_type(2)));
__device__ __forceinline__ unsigned cvtpk(float lo, float hi) { f32x2_t v = {lo, hi}; bf16x2_t b = __builtin_convertvector(v, bf16x2_t); return __builtin_bit_cast(unsigned, b); }
__device__ __forceinline__ bf16x8 pack8f(float a0, float a1, float a2, float a3, float a4, float a5, float a6, float a7) {
    u32x4 w; w.x = cvtpk(a0, a1); w.y = cvtpk(a2, a3); w.z = cvtpk(a4, a5); w.w = cvtpk(a6, a7); return __builtin_bit_cast(bf16x8, w); }
typedef short v4i16_t __attribute__((ext_vector_type(4)));
__device__ __forceinline__ s16x4 vtr(const SB_LAS char* p) { return __builtin_bit_cast(s16x4, __builtin_amdgcn_ds_read_tr16_b64_v4i16((SB_LAS v4i16_t*)p)); }
__device__ __forceinline__ int crow(int r, int hi) { return (r & 3) + 8 * (r >> 2) + 4 * hi; }

template <int SUB>
__device__ __forceinline__ void sub_front(const SB_LAS char* Kslot, bool mask, int kq, const bf16x8 (&qr)[4], f32x16& w, bf16x8 (&spb)[2], int r32, int hi) {
    const SB_LAS char* kb = Kslot + hi * 1024 + r32 * 16 + SUB * 512;
    f32x16 p = {};
#pragma unroll
    for (int d0 = 0; d0 < 4; ++d0) { const bf16x8 kf = *(const SB_LAS bf16x8*)(kb + d0 * 2048); p = __builtin_amdgcn_mfma_f32_32x32x16_bf16(kf, qr[d0], p, 0, 0, 0); }
    float sp[16];
#pragma unroll
    for (int r = 0; r < 16; ++r) {
        float x = p[r];
        if (mask && (kq + 32 * SUB + (r & 3) + 8 * (r >> 2) >= 0)) x = NEGBIG;
        const float t = __builtin_amdgcn_exp2f(-__builtin_fabsf(x));
        const float l = __builtin_amdgcn_logf(1.0f + t);
        sp[r] = __builtin_fmaxf(x, 0.f) + l; w[r] = __builtin_fminf(x, 0.f) - l;
    }
    spb[0] = pack8f(sp[0], sp[1], sp[2], sp[3], sp[4], sp[5], sp[6], sp[7]);
    spb[1] = pack8f(sp[8], sp[9], sp[10], sp[11], sp[12], sp[13], sp[14], sp[15]);
}
template <int SUB>
__device__ __forceinline__ void sub_back(const SB_LAS char* vp, const f32x16& w, const f32x16& sx, f32x16 (&o)[2]) {
    float pr[16];
#pragma unroll
    for (int r = 0; r < 16; ++r) pr[r] = __builtin_amdgcn_exp2f(w[r] - sx[r]);
    bf16x8 pa[2];
    pa[0] = pack8f(pr[0], pr[1], pr[2], pr[3], pr[4], pr[5], pr[6], pr[7]);
    pa[1] = pack8f(pr[8], pr[9], pr[10], pr[11], pr[12], pr[13], pr[14], pr[15]);
#pragma unroll
    for (int d0 = 0; d0 < 2; ++d0)
#pragma unroll
        for (int s = 0; s < 2; ++s) { const int ks = 2 * SUB + s;
            const s16x4 lo = vtr(vp + d0 * 4096 + ks * 1024), hi4 = vtr(vp + d0 * 4096 + ks * 1024 + 512);
            const bf16x8 vf = (bf16x8){lo[0], lo[1], lo[2], lo[3], hi4[0], hi4[1], hi4[2], hi4[3]};
            o[d0] = __builtin_amdgcn_mfma_f32_32x32x16_bf16(pa[s], vf, o[d0], 0, 0, 0); }
}
__device__ __forceinline__ void sb_tile(const SB_LAS char* slot, bool mask, bool skip1, int kq, const bf16x8 (&qr)[4], f32x16& Rb, f32x16 (&o)[2], const bf16x8 (&Um)[2], const bf16x8 Jm, int r32, int hi, int lane) {
    const SB_LAS char* vp = slot + 8192 + ((lane >> 4) & 1) * 32 + (lane & 3) * 8 + (4 * hi + ((lane & 15) >> 2)) * 64;
    f32x16 w1, w0; bf16x8 sb1[2], sb0[2];
    f32x16 t1 = Rb;
    if (!skip1) {
    sub_front<1>(slot, mask, kq, qr, w1, sb1, r32, hi);
    f32x16 a1 = __builtin_amdgcn_mfma_f32_32x32x16_bf16(Um[0], sb1[0], Rb, 0, 0, 0); a1 = __builtin_amdgcn_mfma_f32_32x32x16_bf16(Um[1], sb1[1], a1, 0, 0, 0);
    t1 = __builtin_amdgcn_mfma_f32_32x32x16_bf16(Jm, sb1[0], Rb, 0, 0, 0); t1 = __builtin_amdgcn_mfma_f32_32x32x16_bf16(Jm, sb1[1], t1, 0, 0, 0);
    sub_back<1>(vp, w1, a1, o);
    }
    sub_front<0>(slot, mask, kq, qr, w0, sb0, r32, hi);
    f32x16 a0 = __builtin_amdgcn_mfma_f32_32x32x16_bf16(Um[0], sb0[0], t1, 0, 0, 0); a0 = __builtin_amdgcn_mfma_f32_32x32x16_bf16(Um[1], sb0[1], a0, 0, 0, 0);
    f32x16 rn = __builtin_amdgcn_mfma_f32_32x32x16_bf16(Jm, sb0[0], t1, 0, 0, 0); rn = __builtin_amdgcn_mfma_f32_32x32x16_bf16(Jm, sb0[1], rn, 0, 0, 0);
    sub_back<0>(vp, w0, a0, o);
    Rb = rn;
}
struct Tensors { const bf16_t* Q; const bf16_t* K; const bf16_t* V; bf16_t* O; const float* ck; const float* cv; };

template <bool SAMPLE>
__device__ __forceinline__ void sb_unit(int b, int h, int qb, const Tensors& T, SB_LAS char* lds) {
    int tid = threadIdx.x; asm volatile("" : "+v"(tid)); const int lane = tid & 63, r32 = lane & 31, hi = lane >> 5; const int wid = __builtin_amdgcn_readfirstlane(tid >> 6);
    const size_t rowbase = SAMPLE ? (size_t)cfg::MP + (size_t)b * 32 : (size_t)b * cfg::SEQ; const int q0 = SAMPLE ? 0 : qb * 256;
    const int jd = SAMPLE ? 16 : (q0 >> 6) + (wid >> 1), jtop = SAMPLE ? 16 : (q0 >> 6) + 3;
    const bool worker = SAMPLE ? (wid == 0) : true;
    const int wq = SAMPLE ? 0 : wid;
    const int qpos = (SAMPLE ? cfg::PAST : q0 + 32 * wq) + r32;
    volatile SB_LAS unsigned* flags = (volatile SB_LAS unsigned*)(lds + OFF_FLAGS);
    bf16x8 Um[2], Jm;
#pragma unroll
    for (int s = 0; s < 2; ++s)
#pragma unroll
        for (int jj = 0; jj < 8; ++jj) Um[s][jj] = (16 * s + 8 * (jj >> 2) + 4 * hi + (jj & 3) > r32) ? (short)0x3F80 : (short)0;
#pragma unroll
    for (int jj = 0; jj < 8; ++jj) Jm[jj] = (short)0x3F80;
    bf16x8 qr[4];
    { const bf16_t* Qw = T.Q + (rowbase + q0 + 32 * wq + r32) * PITCH + h * 64 + hi * 8;
#pragma unroll
      for (int d0 = 0; d0 < 4; ++d0) qr[d0] = *(const bf16x8*)(Qw + d0 * 16); }
    f32x16 Rb = {}, o[2]; o[0] = f32x16{}; o[1] = f32x16{};
    bool done = false;
    u32x4 kreg, vreg;
    const int vkey = 16 * (wid & 3) + (lane >> 2), vcol = (wid >> 2) * 32 + (lane & 3) * 8;
#define SB_LOAD(j) do { \
        if (!SAMPLE) {   \
            const char* kb_ = (const char*)(T.K + (rowbase + (size_t)(64 * (j))) * PITCH + h * 64 + wid * 8); const char* vb_ = (const char*)(T.V + (rowbase + (size_t)(64 * (j))) * PITCH + h * 64); \
            kreg = *(const u32x4*)(kb_ + (unsigned)(lane * (PITCH * 2))); vreg = *(const u32x4*)(vb_ + (unsigned)(vkey * (PITCH * 2) + vcol * 2)); } \
        else if ((j) == 16) { const int kr_ = lane < 31 ? lane : 31, vr_ = vkey < 31 ? vkey : 31; \
            kreg = *(const u32x4*)((const char*)(T.K + rowbase * PITCH + h * 64 + wid * 8) + (unsigned)(kr_ * (PITCH * 2))); vreg = *(const u32x4*)((const char*)(T.V + rowbase * PITCH + h * 64) + (unsigned)(vr_ * (PITCH * 2) + vcol * 2)); } \
        else { const float* kp_ = (const float*)((const char*)(T.ck + ((size_t)b * cfg::PAST + 64 * (j)) * PITCH + h * 64 + wid * 8) + (unsigned)(lane * (PITCH * 4))); const float* vp_ = (const float*)((const char*)(T.cv + ((size_t)b * cfg::PAST + 64 * (j)) * PITCH + h * 64) + (unsigned)(vkey * (PITCH * 4) + vcol * 4)); \
            const f32x4 k0_ = *(const f32x4*)kp_, k1_ = *(const f32x4*)(kp_ + 4), v0_ = *(const f32x4*)vp_, v1_ = *(const f32x4*)(vp_ + 4); \
            kreg = (u32x4){cvtpk(k0_[0], k0_[1]), cvtpk(k0_[2], k0_[3]), cvtpk(k1_[0], k1_[1]), cvtpk(k1_[2], k1_[3])}; vreg = (u32x4){cvtpk(v0_[0], v0_[1]), cvtpk(v0_[2], v0_[3]), cvtpk(v1_[0], v1_[1]), cvtpk(v1_[2], v1_[3])}; } } while (0)
    SB_LOAD(jtop);
    for (int j = jtop; j >= 0; --j) {
        SB_LAS char* slot = lds + (j & 1) * SLOTB;
        *(SB_LAS u32x4*)(slot + wid * 1024 + lane * 16) = kreg; *(SB_LAS u32x4*)(slot + 8192 + wid * 1024 + lane * 16) = vreg;
        __syncthreads();
        if (j != jtop) { const volatile SB_LAS unsigned* f = flags + ((j + 1) & 1) * 8; unsigned all = 1u;
#pragma unroll
            for (int w8 = 0; w8 < 8; ++w8) all &= f[w8];
            if (all) break; }
        if (j > 0) SB_LOAD(j - 1);
        if (worker && !done && j <= jd) {
            const int key0 = (SAMPLE && j == 16) ? cfg::PAST : 64 * j;
            sb_tile(slot, j == jd, (j == jd) && (SAMPLE || (wid & 1) == 0), key0 + 4 * hi - qpos, qr, Rb, o, Um, Jm, r32, hi, lane);
            done = __all(Rb[0] > THR2) != 0;
        }
        if (lane == 0) flags[(j & 1) * 8 + wid] = (done || !worker) ? 1u : 0u;
    }
#undef SB_LOAD
    if (worker) {
        SB_LAS bf16_t* stg = (SB_LAS bf16_t*)(lds + OFF_OST) + wid * 2048;
#pragma unroll
        for (int r = 0; r < 16; ++r) { const int orow = crow(r, hi);
#pragma unroll
            for (int d0 = 0; d0 < 2; ++d0) stg[orow * 64 + d0 * 32 + r32] = (bf16_t)(cvtpk(o[d0][r], 0.f) & 0xffffu); }
        asm volatile("s_waitcnt lgkmcnt(0)" ::: "memory");
        bf16_t* Ow = T.O + (rowbase + q0 + 32 * wq) * PITCH + h * 64;
        if (SAMPLE) asm volatile("s_waitcnt vmcnt(0)" ::: "memory");
#pragma unroll
        for (int i = 0; i < 4; ++i) { const int row = i * 8 + (lane >> 3), ch = lane & 7; const u32x4 v = *(const SB_LAS u32x4*)(stg + row * 64 + ch * 8); if (SAMPLE) { unsigned long long* po = (unsigned long long*)(Ow + (size_t)row * PITCH + ch * 8);
                __hip_atomic_store(po, (unsigned long long)v.x | ((unsigned long long)v.y << 32), __ATOMIC_RELAXED, __HIP_MEMORY_SCOPE_AGENT); __hip_atomic_store(po + 1, (unsigned long long)v.z | ((unsigned long long)v.w << 32), __ATOMIC_RELAXED, __HIP_MEMORY_SCOPE_AGENT); }
            else *(u32x4*)(Ow + (size_t)row * PITCH + ch * 8) = v; }
    }
    if (SAMPLE) { asm volatile("s_waitcnt lgkmcnt(0)" ::: "memory"); __builtin_amdgcn_s_barrier(); }
    else __syncthreads();
}
}
namespace sk {
typedef short bf16x8 __attribute__((ext_vector_type(8)));
typedef float f32x16 __attribute__((ext_vector_type(16)));
typedef float f32x4 __attribute__((ext_vector_type(4)));
typedef unsigned short bf16_t;
#define SK_LAS __attribute__((address_space(3)))
constexpr int PLD = 36;
constexpr int LDS_BYTES = 8 * 2 * 32 * PLD * 4;
__device__ __forceinline__ f32x4 tile(const bf16_t* A, const bf16_t* Bt, int K, size_t arow0, int col0, SK_LAS char* lds) {
    int tid = threadIdx.x; asm volatile("" : "+v"(tid)); const int lane = tid & 63, r32 = lane & 31, hi = lane >> 5; const int wid = __builtin_amdgcn_readfirstlane(tid >> 6);
    const int nsplit = (K >= 512) ? 8 : (K >> 6), ks = K / nsplit;
    const bf16_t* ap = A + (arow0 + r32) * K + wid * ks + hi * 32;
    const bf16_t* bp0 = Bt + (size_t)(col0 + r32) * K + wid * ks + hi * 32; const bf16_t* bp1 = bp0 + (size_t)32 * K;
    f32x16 acc0 = {}, acc1 = {};
#pragma unroll 2
    for (int s = 0; s < ((wid < nsplit) ? ks : 0); s += 64) {
        bf16x8 a[4], b0[4], b1[4];
#pragma unroll
        for (int j = 0; j < 4; ++j) { a[j] = *(const bf16x8*)(ap + s + 8 * j); b0[j] = *(const bf16x8*)(bp0 + s + 8 * j); b1[j] = *(const bf16x8*)(bp1 + s + 8 * j); }
#pragma unroll
        for (int j = 0; j < 4; ++j) {
            acc0 = __builtin_amdgcn_mfma_f32_32x32x16_bf16(b0[j], a[j], acc0, 0, 0, 0);
            acc1 = __builtin_amdgcn_mfma_f32_32x32x16_bf16(b1[j], a[j], acc1, 0, 0, 0); }
    }
    SK_LAS float* P0 = (SK_LAS float*)lds + ((wid * 2 + 0) * 32 + r32) * PLD + 4 * hi; SK_LAS float* P1 = P0 + 32 * PLD;
#pragma unroll
    for (int g = 0; g < 4; ++g) { *(SK_LAS f32x4*)(P0 + 8 * g) = (f32x4){acc0[4 * g], acc0[4 * g + 1], acc0[4 * g + 2], acc0[4 * g + 3]};
                                  *(SK_LAS f32x4*)(P1 + 8 * g) = (f32x4){acc1[4 * g], acc1[4 * g + 1], acc1[4 * g + 2], acc1[4 * g + 3]}; }
    __syncthreads();
    const int row = tid >> 4, c = (tid & 15) * 4, cb = c >> 5, cc = c & 31;
    f32x4 s = {0.f, 0.f, 0.f, 0.f};
#pragma unroll
    for (int w = 0; w < 8; ++w) s += *(const SK_LAS f32x4*)((SK_LAS float*)lds + ((w * 2 + cb) * 32 + row) * PLD + cc);
    __syncthreads();
    return s;
}
__device__ __forceinline__ void tile4(const bf16_t* A, const bf16_t* Bt, int K, size_t arow0, int col0, SK_LAS char* lds, f32x4 (&out)[2][2]) {
    int tid = threadIdx.x; asm volatile("" : "+v"(tid)); const int lane = tid & 63, r32 = lane & 31, hi = lane >> 5; const int wid = __builtin_amdgcn_readfirstlane(tid >> 6);
    const int half = wid >> 2, kq = wid & 3, ks = K >> 2;
    const bf16_t* ap = A + (arow0 + r32) * K + kq * ks + hi * 32;
    const bf16_t* bp = Bt + (size_t)(col0 + half * 128 + r32) * K + kq * ks + hi * 32;
    f32x16 acc[4]; acc[0] = f32x16{}; acc[1] = f32x16{}; acc[2] = f32x16{}; acc[3] = f32x16{};
#pragma unroll 1
    for (int s = 0; s < ks; s += 64) {
        bf16x8 a[4], b[4][4];
#pragma unroll
        for (int e = 0; e < 4; ++e) { a[e] = *(const bf16x8*)(ap + s + 8 * e);
#pragma unroll
            for (int j = 0; j < 4; ++j) b[j][e] = *(const bf16x8*)(bp + (size_t)(32 * j) * K + s + 8 * e); }
#pragma unroll
        for (int e = 0; e < 4; ++e)
#pragma unroll
            for (int j = 0; j < 4; ++j) acc[j] = __builtin_amdgcn_mfma_f32_32x32x16_bf16(b[j][e], a[e], acc[j], 0, 0, 0);
    }
    const int row = tid >> 4, cc = (tid & 15) * 4;
#pragma unroll
    for (int q = 0; q < 2; ++q) {
        SK_LAS float* P0 = (SK_LAS float*)lds + ((wid * 2 + 0) * 32 + r32) * PLD + 4 * hi; SK_LAS float* P1 = P0 + 32 * PLD;
#pragma unroll
        for (int g = 0; g < 4; ++g) { *(SK_LAS f32x4*)(P0 + 8 * g) = (f32x4){acc[2 * q][4 * g], acc[2 * q][4 * g + 1], acc[2 * q][4 * g + 2], acc[2 * q][4 * g + 3]};
                                      *(SK_LAS f32x4*)(P1 + 8 * g) = (f32x4){acc[2 * q + 1][4 * g], acc[2 * q + 1][4 * g + 1], acc[2 * q + 1][4 * g + 2], acc[2 * q + 1][4 * g + 3]}; }
        __syncthreads();
#pragma unroll
        for (int h = 0; h < 2; ++h) { f32x4 sum = {0.f, 0.f, 0.f, 0.f};
#pragma unroll
            for (int w = 0; w < 4; ++w) sum += *(const SK_LAS f32x4*)((SK_LAS float*)lds + (((h * 4 + w) * 2 + (cc >> 5)) * 32 + row) * PLD + (cc & 31));
            out[h][q] = sum; }
        __syncthreads();
    }
}
__device__ __forceinline__ f32x16 wtile(const bf16_t* A, const bf16_t* Bt, int K, size_t arow0, int colw, int lane) {
    const int r32 = lane & 31, hi = lane >> 5;
    const bf16_t* ap = A + (arow0 + r32) * K + hi * 32; const bf16_t* bp = Bt + (size_t)(colw + r32) * K + hi * 32;
    f32x16 acc = {};
#pragma unroll 4
    for (int s = 0; s < K; s += 64) {
        bf16x8 a[4], b[4];
#pragma unroll
        for (int e = 0; e < 4; ++e) { a[e] = *(const bf16x8*)(ap + s + 8 * e); b[e] = *(const bf16x8*)(bp + s + 8 * e); }
#pragma unroll
        for (int e = 0; e < 4; ++e) acc = __builtin_amdgcn_mfma_f32_32x32x16_bf16(b[e], a[e], acc, 0, 0, 0);
    }
    return acc;
}
__device__ __forceinline__ float sum16(float v) { v += __shfl_xor(v, 1); v += __shfl_xor(v, 2); v += __shfl_xor(v, 4); v += __shfl_xor(v, 8); return v; }
__device__ __forceinline__ float rstd16(const float* SSQ, int r, int t) { return __builtin_amdgcn_rsqf(sum16(SSQ[(size_t)r * 16 + (t & 15)]) * (1.0f / 1024.0f) + cfg::EPS); }
__device__ __forceinline__ float rstd_row(const float* SSQ, int r) { const f32x4* p = (const f32x4*)(SSQ + (size_t)r * 16); const f32x4 a = p[0], b = p[1], c = p[2], d = p[3];
    const float s = ((a[0] + a[1]) + (a[2] + a[3])) + ((b[0] + b[1]) + (b[2] + b[3])) + ((c[0] + c[1]) + (c[2] + c[3])) + ((d[0] + d[1]) + (d[2] + d[3])); return __builtin_amdgcn_rsqf(s * (1.0f / 1024.0f) + cfg::EPS); }
__device__ __forceinline__ unsigned long long pk4(f32x4 v) { return (unsigned long long)pg8::cvt_pk_bf16(v[0], v[1]) | ((unsigned long long)pg8::cvt_pk_bf16(v[2], v[3]) << 32); }
__device__ __forceinline__ f32x4 up4(unsigned long long w) { const unsigned lo = (unsigned)w, hi = (unsigned)(w >> 32); return (f32x4){pg8::bf_lo(lo), pg8::bf_hi(lo), pg8::bf_lo(hi), pg8::bf_hi(hi)}; }
}
#define GAS __attribute__((address_space(1)))
#define LAS __attribute__((address_space(3)))
typedef unsigned short bf16;
typedef unsigned v4u __attribute__((ext_vector_type(4)));
typedef float f32x4 __attribute__((ext_vector_type(4)));
typedef short bf16x8 __attribute__((ext_vector_type(8)));
typedef GAS unsigned gu32;
typedef GAS unsigned long long gu64;
#define RLX_AGENT __ATOMIC_RELAXED, __HIP_MEMORY_SCOPE_AGENT
#define LDS_WAIT() asm volatile("s_waitcnt lgkmcnt(0)" ::: "memory")
#define VM_WAIT() asm volatile("s_waitcnt vmcnt(0)" ::: "memory")
__device__ __forceinline__ unsigned long long rt() { return __builtin_amdgcn_s_memrealtime(); }
__device__ __forceinline__ unsigned f2bf(float f) { unsigned u = __builtin_bit_cast(unsigned, f); return (u + 0x7fffu + ((u >> 16) & 1u)) >> 16; }
__device__ __forceinline__ unsigned pk2(float lo, float hi) { return f2bf(lo) | (f2bf(hi) << 16); }
#define XB_TMO      128
#define XB_XCNT(j)  (256  + 64 * (j))
#define XB_XSUB(j)  (1280 + 64 * (j))
#define XB_XGEN(j)  (2304 + 64 * (j))
#define XB_TOP      3328
#define XB_TOPGEN   3392
#define XCD_BAR_WORDS 3456
#define XB_SPIN_CAP (1u << 18)

__device__ __forceinline__ unsigned xb_ld(unsigned* p)              { return __hip_atomic_load(p, __ATOMIC_RELAXED, __HIP_MEMORY_SCOPE_AGENT); }
__device__ __forceinline__ unsigned xb_add(unsigned* p, unsigned v) { return __hip_atomic_fetch_add(p, v, __ATOMIC_RELAXED, __HIP_MEMORY_SCOPE_AGENT); }
__device__ __forceinline__ unsigned xb_xcc_id() { return (unsigned)__builtin_amdgcn_s_getreg((3 << 11) | 20) & 0xFu; }
#define XB_SPIN(cond, bar) do { unsigned _sp = 0; while (cond) { __builtin_amdgcn_s_sleep(1); \
    if ((++_sp & 255u) == 0u) { if (xb_ld(&(bar)[XB_TMO])) break; if (_sp > XB_SPIN_CAP) { atomicAdd(&(bar)[XB_TMO], 1u); break; } } } } while (0)

struct XcdBarrier {
    unsigned* bar; unsigned x;
    volatile LAS unsigned* st;
};

__device__ __forceinline__ XcdBarrier xcd_barrier_post(unsigned* bar, volatile LAS unsigned* st) {
    XcdBarrier b; b.bar = bar; b.x = xb_xcc_id(); b.st = st;
    if (threadIdx.x == 0) (void)xb_add(&bar[XB_XCNT(b.x)], 1u);
    return b;
}
__device__ __forceinline__ void xcd_barrier_complete(unsigned* bar, unsigned x, unsigned& nloc, unsigned& nx) {
    const unsigned G = gridDim.x * gridDim.y * gridDim.z;
    unsigned sum, cnt, mine, sp = 0u;
    for (;;) {
        sum = 0u; cnt = 0u; mine = 0u;
#pragma unroll
        for (unsigned j = 0; j < 16; ++j) { const unsigned c = xb_ld(&bar[XB_XCNT(j)]); sum += c; cnt += (c > 0u) ? 1u : 0u; mine = (j == x) ? c : mine; }
        if (sum == G) break;
        __builtin_amdgcn_s_sleep(1);
        if ((++sp & 255u) == 0u) { if (xb_ld(&bar[XB_TMO])) break; if (sp > XB_SPIN_CAP) { atomicAdd(&bar[XB_TMO], 1u); break; } }
    }
    nloc = mine > 0u ? mine : 1u; nx = cnt > 0u ? cnt : 1u;
}

__device__ __forceinline__ void xcd_barrier(const XcdBarrier& b) {
    asm volatile("s_waitcnt vmcnt(0)" ::: "memory");
    __syncthreads();
    if (threadIdx.x == 0) {
        unsigned* bar = b.bar;
        __builtin_amdgcn_s_waitcnt(0);
        unsigned nloc = b.st[0], nx = b.st[1];
        if (nloc == 0u) { xcd_barrier_complete(bar, b.x, nloc, nx); b.st[0] = nloc; b.st[1] = nx; }
        const unsigned old = xb_add(&bar[XB_XSUB(b.x)], 1u);
        const unsigned gen = old / nloc;
        if (old + 1u == (gen + 1u) * nloc) {
            __builtin_amdgcn_fence(__ATOMIC_RELEASE, "agent");
            asm volatile("s_waitcnt vmcnt(0)" ::: "memory");
            const unsigned og = xb_add(&bar[XB_TOP], 1u);
            const unsigned tg = og / nx;
            if (og + 1u == (tg + 1u) * nx) xb_add(&bar[XB_TOPGEN], 1u);
            else XB_SPIN(xb_ld(&bar[XB_TOPGEN]) == tg, bar);
            __builtin_amdgcn_fence(__ATOMIC_ACQUIRE, "agent");
            xb_add(&bar[XB_XGEN(b.x)], 1u);
            asm volatile("s_waitcnt vmcnt(0)" ::: "memory");
        } else {
            XB_SPIN(xb_ld(&bar[XB_XGEN(b.x)]) == gen, bar);
            __builtin_amdgcn_fence(__ATOMIC_ACQUIRE, "agent");
            asm volatile("s_waitcnt vmcnt(0)" ::: "memory");
        }
    }
    __syncthreads();
}
__device__ __forceinline__ float wave_sum(float v) {
#pragma unroll
    for (int o = 1; o < 64; o <<= 1) v += __shfl_xor(v, o);
    return v;
}
__device__ __forceinline__ void p0_transpose_item(const float* W, int K, int N, bf16* WT, int row_off, LAS float* scr, int item, int lane) {
    const int nblk = N / 32, kb = item / nblk, nb = item % nblk, k0 = 64 * kb, n0 = 32 * nb;
    float tv[32];
#pragma unroll
    for (int i = 0; i < 32; ++i) { const int kk = 2 * i + (lane >> 5); tv[i] = __builtin_nontemporal_load(W + (size_t)(k0 + kk) * N + n0 + (lane & 31)); }
#pragma unroll
    for (int i = 0; i < 32; ++i) { const int kk = 2 * i + (lane >> 5); scr[kk * 33 + (lane & 31)] = tv[i]; }
    LDS_WAIT(); asm volatile("" ::: "memory");
    const int c = lane & 7;
#pragma unroll
    for (int j = 0; j < 4; ++j) { const int n = (lane >> 3) + 8 * j; const LAS float* s = scr + (8 * c) * 33 + n;
        v4u o; o.x = pk2(s[0 * 33], s[1 * 33]); o.y = pk2(s[2 * 33], s[3 * 33]); o.z = pk2(s[4 * 33], s[5 * 33]); o.w = pk2(s[6 * 33], s[7 * 33]);
        *(GAS v4u*)(WT + (size_t)(row_off + n0 + n) * K + k0 + 8 * c) = o; }
    LDS_WAIT(); asm volatile("" ::: "memory");
}
constexpr int NWAVES = 8;
#ifndef GROUP_BAR
#define GROUP_BAR 1
#endif
using namespace cfg;
constexpr size_t MiB = 1u << 20;
constexpr size_t WS_CTL = 0, CTL_ZERO_BYTES = MiB / 4;
constexpr size_t WS_WIN = 2 * MiB, WS_WEFF = 10 * MiB, WS_WSB = 11 * MiB, WS_WOUT = 12 * MiB, WS_WUP = 14 * MiB, WS_WDOWN = 22 * MiB, WS_WPG = 30 * MiB, WS_WPP = 32 * MiB;
constexpr size_t WS_SSQ1 = 33 * MiB, WS_SSQ2 = 35 * MiB, WS_SSQ3 = 37 * MiB;
constexpr size_t WS_PB = 40 * MiB;
constexpr size_t WS_XN = 49 * MiB;
constexpr size_t WS_BIG = 82 * MiB;
#ifndef LAYOUT_V085
#define LAYOUT_V085 0
#endif
#if LAYOUT_V085
constexpr size_t ARENA = 0, HM = MiB / 2;
constexpr size_t AR_U = 0, AR_Q = 16 * MiB + HM, AR_K = 33 * MiB, AR_V = 49 * MiB + HM, AR_G = 66 * MiB, AR_Y = 132 * MiB, AR_YSB = 148 * MiB + HM, AR_MG = 0, AR_H = 0, AR_PP = 0;
constexpr size_t WS_S = WS_BIG, SR_U = AR_U, SR_Q = AR_Q, SR_K = AR_K, SR_V = AR_V, SR_G = AR_G, SR_Y = AR_Y, SR_YSB = AR_YSB, SR_MG = AR_MG, SR_H = AR_H, SR_XN1 = 0, SR_XN2 = 0;
constexpr size_t WS_X = WS_BIG + AR_Y, WS_END = WS_BIG + 165 * MiB;
#else
constexpr int NRG = 2048;
constexpr size_t ARK = (size_t)NRG * 1024;
constexpr size_t AR_U = 0, AR_Q = ARK, AR_K = 2 * ARK, AR_V = 3 * ARK, AR_G = 4 * ARK  , AR_Y = 6 * ARK, AR_YSB = 7 * ARK, ARENA = 8 * ARK;
constexpr size_t AR_MG = 0;
constexpr size_t AR_H = 0;
constexpr size_t AR_PP = 0;
constexpr size_t WS_X = WS_BIG + 8 * ARENA;
constexpr size_t WS_S = WS_X + 33 * MiB;
constexpr size_t SR_U = 0, SR_Q = 512 * 1024, SR_K = 2 * 512 * 1024, SR_V = 3 * 512 * 1024, SR_G = 4 * 512 * 1024  , SR_Y = 6 * 512 * 1024, SR_YSB = 7 * 512 * 1024,
                 SR_MG = 8 * 512 * 1024  , SR_H = 10 * 512 * 1024  , SR_XN1 = 18 * 512 * 1024  , SR_XN2 = 20 * 512 * 1024  , SR_END = 22 * 512 * 1024;
constexpr size_t WS_END = WS_S + SR_END;
#endif
static_assert((size_t)MT * 1024 * 2 == 33 * MiB && (size_t)MT * 16 * 4 <= 2 * MiB && (size_t)MT * 256 * 2 <= 9 * MiB && WS_END <= 256 * MiB && ARENA % 16 == 0, "d_ws map");
constexpr int CW_BAR = 4096, CW_FIN = 8192  , CW_FINS = 16384  , CW_XCC = 20480  , CW_GRP = 24576  , CW_SC = 28672  ;
static_assert((CW_SC + 64 * 16 * 7) * 4 <= (int)CTL_ZERO_BYTES, "control words inside the memset region");
constexpr size_t O_Y = 0, O_KP = 17301504, O_VP = 25690112, O_POOLP = 34078720, O_KS = 34140160, O_VS = 34402304, O_POOLS = 34664448, O_END = 34787328;
constexpr int RING_OFF = 0, RING_BYTES = 131072, LDSCTL_OFF = RING_BYTES, MISC_OFF = LDSCTL_OFF + 320, LDS_BYTES = 147456;
static_assert(sk::LDS_BYTES <= RING_BYTES && sba::LDS_BYTES <= RING_BYTES, "phase scratch fits the ring region");

struct Args { const float* in[22]; float* out; unsigned char* ws; };

#if LAYOUT_V085
__device__ __forceinline__ unsigned char* effp(unsigned char* ws, size_t aoff, int pitchB, int g) { return ws + WS_BIG + aoff; }
__device__ __forceinline__ unsigned char* effs(unsigned char* ws, size_t soff, int pitchB) { return ws + WS_BIG + soff; }
#else
__device__ __forceinline__ unsigned char* effp(unsigned char* ws, size_t aoff, int pitchB, int g) { return ws + WS_BIG + (size_t)g * ARENA + aoff - (size_t)(2048 * g) * (size_t)pitchB; }
__device__ __forceinline__ unsigned char* effs(unsigned char* ws, size_t soff, int pitchB) { return ws + WS_S + soff - (size_t)MP * (size_t)pitchB; }
#endif
#ifndef DBG_NOWT
#define DBG_NOWT 0
#endif
__device__ __forceinline__ void st8_wt(void* p, unsigned long long v) { if (DBG_NOWT) *(GAS unsigned long long*)p = v; else __hip_atomic_store((unsigned long long*)p, v, __ATOMIC_RELAXED, __HIP_MEMORY_SCOPE_AGENT); }
__device__ __forceinline__ void st4_wt(void* p, unsigned v) { if (DBG_NOWT) *(GAS unsigned*)p = v; else __hip_atomic_store((unsigned*)p, v, __ATOMIC_RELAXED, __HIP_MEMORY_SCOPE_AGENT); }
__device__ __forceinline__ void stf_wt(float* p, float v) { if (DBG_NOWT) *(GAS float*)p = v; else __hip_atomic_store(p, v, __ATOMIC_RELAXED, __HIP_MEMORY_SCOPE_AGENT); }
#ifndef CHAIN_FENCE
#define CHAIN_FENCE 0
#endif
#ifndef DBG_NOCHAIN
#define DBG_NOCHAIN 0
#endif
__device__ __forceinline__ void chain_post_wave(gu32* ctl, int s, int rb) {
    if (DBG_NOCHAIN == 1) return;
    asm volatile("s_waitcnt vmcnt(0)" ::: "memory");
    if ((threadIdx.x & 63) == 0) __hip_atomic_fetch_add((unsigned*)(ctl + CW_SC + 64 * (16 * s + rb)), 1u, __ATOMIC_RELAXED, __HIP_MEMORY_SCOPE_AGENT);
}
struct PostHook { gu32* ctl; int s, rb; bool on;
    __device__ __forceinline__ void operator()(int ui) const { if (on && ui == 0) chain_post_wave(ctl, s, rb); } };
__device__ __forceinline__ void chain_wait_wave(gu32* ctl, int s, int rb, unsigned target) {
    if (DBG_NOCHAIN == 1 || (DBG_NOCHAIN == 3 && s >= 3)) return;
    unsigned spins = 0;
    while ((unsigned)__builtin_amdgcn_readfirstlane(__hip_atomic_load((unsigned*)(ctl + CW_SC + 64 * (16 * s + rb)), __ATOMIC_RELAXED, __HIP_MEMORY_SCOPE_AGENT)) < target) { __builtin_amdgcn_s_sleep(2); if (++spins > (1u << 18)) break; }
    if (CHAIN_FENCE) { __builtin_amdgcn_fence(__ATOMIC_ACQUIRE, "agent"); asm volatile("s_waitcnt vmcnt(0)" ::: "memory"); }
}
__device__ __forceinline__ void chain_wait(gu32* ctl, int s, int rb, unsigned target) {
    if (threadIdx.x < 64) chain_wait_wave(ctl, s, rb, target);
    __syncthreads();
}

__device__ __forceinline__ void rms_rows_to_bf16(const float* xrow0, const float* xrow1, const float* g, bf16* orow0, bf16* orow1, int lane) {
    const GAS f32x4* xr0 = (const GAS f32x4*)xrow0 + lane; const GAS f32x4* xr1 = (const GAS f32x4*)(xrow1 ? xrow1 : xrow0) + lane; const GAS f32x4* gr = (const GAS f32x4*)g + lane;
    f32x4 v[4], w[4], gg[4]; float s = 0.f, t = 0.f;
#pragma unroll
    for (int j = 0; j < 4; ++j) { v[j] = __builtin_nontemporal_load(xr0 + 64 * j); w[j] = __builtin_nontemporal_load(xr1 + 64 * j); gg[j] = gr[64 * j]; }
#pragma unroll
    for (int j = 0; j < 4; ++j) { s += (v[j].x * v[j].x + v[j].y * v[j].y) + (v[j].z * v[j].z + v[j].w * v[j].w); t += (w[j].x * w[j].x + w[j].y * w[j].y) + (w[j].z * w[j].z + w[j].w * w[j].w); }
#pragma unroll
    for (int o = 1; o < 64; o <<= 1) { s += __shfl_xor(s, o); t += __shfl_xor(t, o); }
    const float rs = 1.f / sqrtf(s * (1.f / DM) + EPS), rt = 1.f / sqrtf(t * (1.f / DM) + EPS);
    GAS unsigned long long* o0 = (GAS unsigned long long*)orow0 + lane; GAS unsigned long long* o1 = (GAS unsigned long long*)orow1 + lane;
#pragma unroll
    for (int j = 0; j < 4; ++j) { o0[64 * j] = (unsigned long long)pk2(v[j].x * rs * gg[j].x, v[j].y * rs * gg[j].y) | ((unsigned long long)pk2(v[j].z * rs * gg[j].z, v[j].w * rs * gg[j].w) << 32);
        if (xrow1) o1[64 * j] = (unsigned long long)pk2(w[j].x * rt * gg[j].x, w[j].y * rt * gg[j].y) | ((unsigned long long)pk2(w[j].z * rt * gg[j].z, w[j].w * rt * gg[j].w) << 32); }
}
__device__ __forceinline__ void weff_item(const float* wgrp, const float* scale, const float* wpu, bf16* WT, int item, int lane) {
    const int nb = item & 15, cb = (item >> 4) & 15, g = item >> 8, n = nb * 64 + lane;
    float wg[8][2];
#pragma unroll
    for (int cc = 0; cc < 8; ++cc)
#pragma unroll
        for (int hh = 0; hh < 2; ++hh) wg[cc][hh] = wgrp[((size_t)(g * 128 + cb * 8 + cc)) * 128 + lane + 64 * hh] * scale[g * 128 + lane + 64 * hh];
    float acc[8];
#pragma unroll
    for (int cc = 0; cc < 8; ++cc) acc[cc] = 0.f;
#pragma unroll
    for (int hh = 0; hh < 2; ++hh)
#pragma unroll 16
        for (int d2 = 0; d2 < 64; ++d2) { const float wv = wpu[(size_t)(g * 128 + hh * 64 + d2) * 1024 + n];
#pragma unroll
            for (int cc = 0; cc < 8; ++cc) acc[cc] = fmaf(__builtin_bit_cast(float, __builtin_amdgcn_readlane(__builtin_bit_cast(int, wg[cc][hh]), d2)), wv, acc[cc]); }
    v4u o; o.x = pk2(acc[0], acc[1]); o.y = pk2(acc[2], acc[3]); o.z = pk2(acc[4], acc[5]); o.w = pk2(acc[6], acc[7]);
    *(GAS v4u*)(WT + (size_t)n * 512 + g * 128 + cb * 8) = o;
}
template <int W, int R, bool WT>
__device__ __forceinline__ void pool_run(const bf16* Ub, const float* state_pool, bf16* Yb, int r0, int c, bool sample, int t0, int b_) {
    v4u rw[R - 1 + W];
#pragma unroll
    for (int k = 0; k < W - 1; ++k) { const int pos = t0 + k - (W - 1);
        if (pos >= 0) rw[k] = *(const GAS v4u*)(Ub + (size_t)(r0 - (W - 1) + k) * 512 + c);
        else if (sample) { const float* sp = state_pool + ((size_t)b_ * 15 + 15 + pos) * 512 + c; const f32x4 a = *(const GAS f32x4*)sp, b = *(const GAS f32x4*)(sp + 4); rw[k] = pg8::pack8(a, b); }
        else rw[k] = (v4u){0u, 0u, 0u, 0u}; }
#pragma unroll
    for (int k = W - 1; k < R - 1 + W; ++k) rw[k] = *(const GAS v4u*)(Ub + (size_t)(r0 - (W - 1) + k) * 512 + c);
    f32x4 s0 = {0.f, 0.f, 0.f, 0.f}, s1 = {0.f, 0.f, 0.f, 0.f};
#pragma unroll
    for (int k = 0; k < W - 1; ++k) { f32x4 a, b; pg8::unpack8(rw[k], a, b); s0 += a; s1 += b; }
#pragma unroll
    for (int i = 0; i < R; ++i) { f32x4 a, b, u0, u1; pg8::unpack8(rw[W - 1 + i], u0, u1); s0 += u0; s1 += u1;
        const int cnt = sample ? W : ((t0 + i + 1 < W) ? t0 + i + 1 : W); const float ic = 1.0f / (float)cnt;
        { const v4u yv = pg8::pack8(s0 * ic - u0, s1 * ic - u1);
          if (WT) { st8_wt(Yb + (size_t)(r0 + i) * 512 + c, (unsigned long long)yv.x | ((unsigned long long)yv.y << 32)); st8_wt(Yb + (size_t)(r0 + i) * 512 + c + 4, (unsigned long long)yv.z | ((unsigned long long)yv.w << 32)); }
          else *(GAS v4u*)(Yb + (size_t)(r0 + i) * 512 + c) = yv; }
        pg8::unpack8(rw[i], a, b); s0 -= a; s1 -= b; }
}
template <bool WT>
__device__ __forceinline__ void pool_item(int cg, const bf16* Ub, const float* state_pool, bf16* Yb, int r0, int c, bool sample, int t0, int b_) {
    if (cg == 0) pool_run<2, 16, WT>(Ub, state_pool, Yb, r0, c, sample, t0, b_); else if (cg == 1) pool_run<4, 16, WT>(Ub, state_pool, Yb, r0, c, sample, t0, b_); else if (cg == 2) pool_run<8, 16, WT>(Ub, state_pool, Yb, r0, c, sample, t0, b_);
    else { pool_run<16, 8, WT>(Ub, state_pool, Yb, r0, c, sample, t0, b_); asm volatile("" ::: "memory"); pool_run<16, 8, WT>(Ub, state_pool, Yb, r0 + 8, c, sample, t0 + 8, b_); }
}

__device__ __forceinline__ void grp_barrier(unsigned* cnt, unsigned members, volatile LAS unsigned* round_word, bool raw) {
    if (raw) { asm volatile("s_waitcnt lgkmcnt(0)" ::: "memory"); __builtin_amdgcn_s_barrier(); }
    else { asm volatile("s_waitcnt vmcnt(0)" ::: "memory");
           __syncthreads(); }
    if (threadIdx.x == 0) {
        const unsigned round = round_word[0] + 1u; round_word[0] = round;
        __hip_atomic_fetch_add(cnt, 1u, __ATOMIC_RELAXED, __HIP_MEMORY_SCOPE_AGENT);
        unsigned spins = 0;
        while (__hip_atomic_load(cnt, __ATOMIC_RELAXED, __HIP_MEMORY_SCOPE_AGENT) < members * round) { __builtin_amdgcn_s_sleep(1); if (++spins > (1u << 20)) break; }
        __builtin_amdgcn_fence(__ATOMIC_ACQUIRE, "agent");
        asm volatile("s_waitcnt vmcnt(0)" ::: "memory");
    }
    __syncthreads();
}

__global__ void __launch_bounds__(NWAVES * 64, 2) mega_fwd(Args args) {
    extern __shared__ __attribute__((aligned(16))) unsigned char lds[];
    LAS unsigned char* L = (LAS unsigned char*)lds;
    volatile LAS unsigned* MISC = (volatile LAS unsigned*)(L + MISC_OFF);
    const int wave = __builtin_amdgcn_readfirstlane(threadIdx.x >> 6);
#define FRESH_TID() int tid = threadIdx.x; asm volatile("" : "+v"(tid)); const int lane = tid & 63; (void)lane
    const int G = gridDim.x, bx = blockIdx.x, vcu = (bx % 8) * (G / 8) + bx / 8;
    const int grp = vcu >> 5, gi = vcu & 31;
    unsigned char* ws = args.ws;
    gu32* ctl = (gu32*)(ws + WS_CTL);
    const float* x_p = args.in[0]; const float* x_s = args.in[1]; const float* cache_k = args.in[2]; const float* cache_v = args.in[3]; const float* state_pool = args.in[4];
    const float* p_p = args.in[5]; const float* p_s = args.in[6]; const float* g_mix = args.in[7]; const float* w_in = args.in[8]; const float* b_gate = args.in[9]; const float* w_grp = args.in[10];
    const float* pool_scale = args.in[11]; const float* w_pool_up = args.in[12]; const float* w_sb_up = args.in[13]; const float* w_out = args.in[14]; const float* g_mlp = args.in[15];
    const float* w_up = args.in[16]; const float* w_down = args.in[17]; const float* g_ple = args.in[18]; const float* w_ple_gate = args.in[19]; const float* w_ple_proj = args.in[20]; const float* g_final = args.in[21];
    float* out = args.out; float* Yo = out + O_Y;
    bf16 *WIN = (bf16*)(ws + WS_WIN), *WEFF = (bf16*)(ws + WS_WEFF), *WSB = (bf16*)(ws + WS_WSB), *WOUT = (bf16*)(ws + WS_WOUT), *WUP = (bf16*)(ws + WS_WUP), *WDOWN = (bf16*)(ws + WS_WDOWN), *WPG = (bf16*)(ws + WS_WPG), *WPP = (bf16*)(ws + WS_WPP);
    float *SSQ1 = (float*)(ws + WS_SSQ1), *SSQ2 = (float*)(ws + WS_SSQ2), *SSQ3 = (float*)(ws + WS_SSQ3);
    bf16 *PB = (bf16*)(ws + WS_PB), *XN = (bf16*)(ws + WS_XN), *XB = (bf16*)(ws + WS_X);
    const int srb = vcu & 15, scb = vcu >> 4;
#define PV(aoff, pitchB) ((bf16*)effp(ws, aoff, pitchB, g_))
#define SV(soff, pitchB) ((bf16*)effs(ws, soff, pitchB))
#define OPQ() int g_ = grp, r_ = srb; asm volatile("" : "+s"(g_), "+s"(r_))

    for (int i = threadIdx.x; i < (LDS_BYTES - LDSCTL_OFF) / 4; i += NWAVES * 64) ((LAS unsigned*)(L + LDSCTL_OFF))[i] = 0u;
    __syncthreads();
    XcdBarrier bar = xcd_barrier_post((unsigned*)(ctl + CW_BAR), MISC + 8);
    if (threadIdx.x == 0) __hip_atomic_fetch_add((unsigned*)(ctl + CW_XCC + 16 * grp + (int)(bar.x & 15u)), 1u, __ATOMIC_RELAXED, __HIP_MEMORY_SCOPE_AGENT);
    const int gw = vcu * NWAVES + wave, NGW = G * NWAVES;
    const bool late_ = (vcu & 1) != 0;

    {
        FRESH_TID();
        LAS float* scr = (LAS float*)(L + RING_OFF + wave * 16384);
        constexpr int I_IN = (DM / 64) * (INW / 32), I_SB = (SBW / 64) * (DM / 32), I_OUT = (DM / 64) * (DM / 32), I_UP = (DM / 64) * (DFF / 32), I_DOWN = (DFF / 64) * (DM / 32), I_PG = I_OUT, I_PP = (PLE / 64) * (DM / 32), I_EFF = 4 * 16 * 16;
        constexpr int NITEMS = I_IN + I_SB + I_OUT + I_UP + I_DOWN + I_PG + I_PP + I_EFF;
        for (int it = gw; it < NITEMS; it += NGW) {
            int r = it;
            if (r < I_EFF) { weff_item(w_grp, pool_scale, w_pool_up, WEFF, r, lane); continue; } r -= I_EFF;
            if (r < I_IN) { p0_transpose_item(w_in, DM, INW, WIN, 0, scr, r, lane); continue; } r -= I_IN;
            if (r < I_SB) { p0_transpose_item(w_sb_up, SBW, DM, WSB, 0, scr, r, lane); continue; } r -= I_SB;
            if (r < I_OUT) { p0_transpose_item(w_out, DM, DM, WOUT, 0, scr, r, lane); continue; } r -= I_OUT;
            if (r < I_UP) { p0_transpose_item(w_up, DM, DFF, WUP, 0, scr, r, lane); continue; } r -= I_UP;
            if (r < I_DOWN) { p0_transpose_item(w_down, DFF, DM, WDOWN, 0, scr, r, lane); continue; } r -= I_DOWN;
            if (r < I_PG) { p0_transpose_item(w_ple_gate, DM, DM, WPG, 0, scr, r, lane); continue; } r -= I_PG;
            p0_transpose_item(w_ple_proj, PLE, DM, WPP, 0, scr, r, lane);
        }
        for (int m = gw; m < MT; m += 2 * NGW) { const int m1 = m + NGW; const bool two = m1 < MT;
            const float* xr0 = m < MP ? x_p + (size_t)m * DM : x_s + (size_t)(m - MP) * DM;
            const float* xr1 = !two ? nullptr : (m1 < MP ? x_p + (size_t)m1 * DM : x_s + (size_t)(m1 - MP) * DM);
            const float* pr0 = m < MP ? p_p + (size_t)m * PLE : p_s + (size_t)(m - MP) * PLE;
            const float* pr1 = !two ? pr0 : (m1 < MP ? p_p + (size_t)m1 * PLE : p_s + (size_t)(m1 - MP) * PLE);
            const f32x4 pv0 = __builtin_nontemporal_load((const GAS f32x4*)pr0 + lane), pv1 = __builtin_nontemporal_load((const GAS f32x4*)pr1 + lane);
            rms_rows_to_bf16(xr0, xr1, g_mix, XN + (size_t)m * DM, XN + (size_t)(two ? m1 : m) * DM, lane);
            *((GAS unsigned long long*)(PB + (size_t)m * PLE) + lane) = (unsigned long long)pk2(pv0.x, pv0.y) | ((unsigned long long)pk2(pv0.z, pv0.w) << 32);
            if (two) *((GAS unsigned long long*)(PB + (size_t)m1 * PLE) + lane) = (unsigned long long)pk2(pv1.x, pv1.y) | ((unsigned long long)pk2(pv1.z, pv1.w) << 32);
        }
    }
    xcd_barrier(bar);
    bool fast = false;
    if (GROUP_BAR) {
        bool okg = false;
        if (threadIdx.x < 128) okg = __hip_atomic_load((unsigned*)(ctl + CW_XCC + (int)threadIdx.x), __ATOMIC_RELAXED, __HIP_MEMORY_SCOPE_AGENT) == 32u;
        const unsigned long long bm = __ballot(okg);
        if ((threadIdx.x & 63) == 0 && wave < 2) MISC[16 + wave] = (unsigned)__builtin_popcountll(bm);
        __syncthreads();
        fast = (MISC[16] + MISC[17] == 8u) && (G == 256);
    }
    unsigned* gcnt = (unsigned*)(ctl + CW_GRP + 64 * grp);
#define SEAM(RAW) do { if (fast) grp_barrier(gcnt, 32u, MISC + 12, (RAW)); else xcd_barrier(bar); } while (0)
#define LATE_POST(S) do { if (late_) chain_post_wave(ctl, (S), srb); } while (0)

#pragma unroll 1
    for (int pass_ = 0; pass_ < 2; ++pass_) { OPQ(); if ((pass_ == 1) == late_) {
        { const int col0 = scb * 256; f32x4 vv[2][2];
            sk::tile4(XN, WIN, DM, (size_t)MP + srb * 32, col0, (SK_LAS char*)(L + RING_OFF), vv);
            int t_raw_ = threadIdx.x; asm volatile("" : "+v"(t_raw_)); const int t = t_raw_, rs = srb * 32 + (t >> 4), r = MP + rs;
#pragma unroll
            for (int h = 0; h < 2; ++h)
#pragma unroll
                for (int q = 0; q < 2; ++q) { const f32x4 v = vv[h][q]; const int c = col0 + 128 * h + 64 * q + (t & 15) * 4;
            if (c < 512) { st8_wt(SV(SR_U, 1024) + (size_t)r * 512 + c, sk::pk4(v)); const int i = rs & 31; if (i >= 17) *(GAS f32x4*)(out + O_POOLS + ((size_t)(rs >> 5) * 15 + (i - 17)) * 512 + c) = v; }
            else if (c < 1024) st8_wt(SV(SR_Q, 1024) + (size_t)r * 512 + c - 512, sk::pk4(v * QSCALE));
            else if (c < 1536) { st8_wt(SV(SR_K, 1024) + (size_t)r * 512 + c - 1024, sk::pk4(v)); *(GAS f32x4*)(out + O_KS + (size_t)rs * 512 + c - 1024) = v; }
            else if (c < 2048) { st8_wt(SV(SR_V, 1024) + (size_t)r * 512 + c - 1536, sk::pk4(v)); *(GAS f32x4*)(out + O_VS + (size_t)rs * 512 + c - 1536) = v; }
            else { const f32x4 bg = *(const GAS f32x4*)(b_gate + c - 2048); st4_wt((unsigned char*)SV(SR_G, 2048) + (size_t)r * 2048 + c - 2048, pg8::pk_u8x4(pg8::sigm4(v + bg))); } }
        }
    } else {
        pg8::Gemm g{XN, WIN, MP, INW, DM}; pg8::StaticOrder S; S.init(MP, INW, G, bx);
        pg8::EpiIn E{PV(AR_U, 1024), PV(AR_Q, 1024), PV(AR_K, 1024), PV(AR_V, 1024), PV(AR_G, 2048), b_gate, out + O_KP, out + O_VP, out + O_KS, out + O_VS, out + O_POOLP, out + O_POOLS};
        pg8::gemm_phase<pg8::EpiIn, pg8::StaticOrder, true, true, PostHook>(L + RING_OFF, g, S, E, PostHook{ctl, 1, srb, !late_});
    } }
    SEAM(late_); LATE_POST(1);
    {
        FRESH_TID(); OPQ();
        if (wave < 4) { const int wi = wave * 32 + gi, cg = wi & 3, k = lane >> 4, lrow = ((wi >> 2) * 4 + k) * 16;
            const bf16* ub = (const bf16*)(effp(ws, AR_U, 1024, g_) + (size_t)g_ * 2048 * 1024); bf16* yb = (bf16*)(effp(ws, AR_Y, 1024, g_) + (size_t)g_ * 2048 * 1024);
            pool_item<false>(cg, ub, state_pool, yb, lrow, cg * 128 + (lane & 15) * 8, false, lrow & (SEQ - 1), 0); }
        if (wave == 4 && (vcu & 7) == 0) { const int si = vcu >> 3, cg = si & 3, run4 = si >> 2, k = lane >> 4, rs = (run4 * 4 + k) * 16;
            chain_wait_wave(ctl, 1, 2 * run4, 128u); chain_wait_wave(ctl, 1, 2 * run4 + 1, 128u);
            pool_item<true>(cg, SV(SR_U, 1024), state_pool, SV(SR_Y, 1024), MP + rs, cg * 128 + (lane & 15) * 8, true, rs & 31, rs >> 5);
            asm volatile("s_waitcnt vmcnt(0)" ::: "memory");
            if (lane == 0) { __hip_atomic_fetch_add((unsigned*)(ctl + CW_SC + 64 * (16 * 2 + 2 * run4)), 1u, __ATOMIC_RELAXED, __HIP_MEMORY_SCOPE_AGENT); __hip_atomic_fetch_add((unsigned*)(ctl + CW_SC + 64 * (16 * 2 + 2 * run4 + 1)), 1u, __ATOMIC_RELAXED, __HIP_MEMORY_SCOPE_AGENT); } }
        { const sba::Tensors T{PV(AR_Q, 1024), PV(AR_K, 1024), PV(AR_V, 1024), PV(AR_YSB, 1024), cache_k, cache_v}; const int h = gi >> 2, s = gi & 3;
#pragma unroll 1
          for (int k = 0; k < 2; ++k) sba::sb_unit<false>(grp, h, k ? 7 - s : s, T, (SB_LAS char*)(L + RING_OFF)); }
        if (vcu >= 128) { const int i = 255 - vcu, rb = i >> 3, h = i & 7;
            chain_wait(ctl, 1, rb, 128u);
            const sba::Tensors T{SV(SR_Q, 1024), SV(SR_K, 1024), SV(SR_V, 1024), SV(SR_YSB, 1024), cache_k, cache_v};
            sba::sb_unit<true>(rb, h, 0, T, (SB_LAS char*)(L + RING_OFF)); }
    }
    SEAM(vcu >= 128);
    if (vcu >= 128 && wave == 0) chain_post_wave(ctl, 2, (255 - vcu) >> 3);
#pragma unroll 1
    for (int pass_ = 0; pass_ < 2; ++pass_) { OPQ(); if ((pass_ == 1) == late_) {
        { const int rb = srb, col0 = scb * 64;
            chain_wait(ctl, 2, rb, 12u);
            const f32x4 va = sk::tile(SV(SR_Y, 1024), WEFF, PW, (size_t)MP + rb * 32, col0, (SK_LAS char*)(L + RING_OFF));
            const f32x4 vb = sk::tile(SV(SR_YSB, 1024), WSB, SBW, (size_t)MP + rb * 32, col0, (SK_LAS char*)(L + RING_OFF));
            int t_raw_ = threadIdx.x; asm volatile("" : "+v"(t_raw_)); const int t = t_raw_, r = MP + rb * 32 + (t >> 4), c = col0 + (t & 15) * 4;
            const f32x4 ga = pg8::up_u8x4(*(const GAS unsigned*)((const unsigned char*)SV(SR_G, 2048) + (size_t)r * 2048 + c)), gb = pg8::up_u8x4(*(const GAS unsigned*)((const unsigned char*)SV(SR_G, 2048) + (size_t)r * 2048 + 1024 + c));
            st8_wt(SV(SR_MG, 2048) + (size_t)r * 1024 + c, sk::pk4(ga * va + gb * vb));
        }
    } else {
        pg8::Gemm g{PV(AR_Y, 1024), WEFF, MP, DM, PW, PV(AR_YSB, 1024), WSB}; pg8::PairOrder S; S.init(MP, DM, G, bx); pg8::EpiMerge E{PV(AR_G, 2048), PV(AR_MG, 2048)};
        pg8::gemm_phase<pg8::EpiMerge, pg8::PairOrder, true, true, PostHook>(L + RING_OFF, g, S, E, PostHook{ctl, 3, srb, !late_});
    } }
    SEAM(late_); LATE_POST(3);
#pragma unroll 1
    for (int pass_ = 0; pass_ < 2; ++pass_) { OPQ(); if ((pass_ == 1) == late_) {
        { const int rb = srb, col0 = scb * 64;
            chain_wait(ctl, 3, rb, 128u);
            const f32x4 v = sk::tile(SV(SR_MG, 2048), WOUT, DM, (size_t)MP + rb * 32, col0, (SK_LAS char*)(L + RING_OFF));
            int t_raw_ = threadIdx.x; asm volatile("" : "+v"(t_raw_)); const int t = t_raw_, rs = rb * 32 + (t >> 4), r = MP + rs, c = col0 + (t & 15) * 4;
            const f32x4 x1 = *(const GAS f32x4*)(x_s + (size_t)rs * DM + c) + v; st8_wt(XB + (size_t)r * DM + c, sk::pk4(x1));
            st8_wt(SV(SR_XN1, 2048) + (size_t)r * DM + c, sk::pk4(x1 * *(const GAS f32x4*)(g_mlp + c)));
            const float ss = sk::sum16(pg8::dot4(x1)); if ((t & 15) == 0) stf_wt(SSQ1 + (size_t)r * 16 + (col0 >> 6), ss);
        }
    } else {
        pg8::Gemm g{PV(AR_MG, 2048), WOUT, MP, DM, DM}; pg8::StaticOrder S; S.init(MP, DM, G, bx); pg8::EpiResid<true> E{x_p, XB, XN, g_mlp, SSQ1};
        pg8::gemm_phase<pg8::EpiResid<true>, pg8::StaticOrder, true, true, PostHook>(L + RING_OFF, g, S, E, PostHook{ctl, 4, srb, !late_});
    } }
    SEAM(late_); LATE_POST(4);
#pragma unroll 1
    for (int pass_ = 0; pass_ < 2; ++pass_) { OPQ(); if ((pass_ == 1) == late_) {
        { const int rb = srb, col0 = scb * 256; f32x4 vv[2][2];
            chain_wait(ctl, 4, rb, 128u);
            sk::tile4(SV(SR_XN1, 2048), WUP, DM, (size_t)MP + rb * 32, col0, (SK_LAS char*)(L + RING_OFF), vv);
            int t_raw_ = threadIdx.x; asm volatile("" : "+v"(t_raw_)); const int t = t_raw_, r = MP + rb * 32 + (t >> 4); const float rs_ = sk::rstd16(SSQ1, r, t);
#pragma unroll
            for (int h = 0; h < 2; ++h)
#pragma unroll
                for (int q = 0; q < 2; ++q) { const int c = col0 + 128 * h + 64 * q + (t & 15) * 4; const f32x4 a = __builtin_elementwise_max(vv[h][q] * rs_, (f32x4){0.f, 0.f, 0.f, 0.f});
                    st8_wt(SV(SR_H, 8192) + (size_t)r * DFF + c, sk::pk4(a * a)); }
        }
    } else {
        pg8::Gemm g{XN, WUP, MP, DFF, DM}; pg8::StaticOrder S; S.init(MP, DFF, G, bx); pg8::EpiUp E{SSQ1, PV(AR_H, 8192)};
        pg8::gemm_phase<pg8::EpiUp, pg8::StaticOrder, true, true, PostHook>(L + RING_OFF, g, S, E, PostHook{ctl, 5, srb, !late_});
    } }
    SEAM(late_); LATE_POST(5);
#pragma unroll 1
    for (int pass_ = 0; pass_ < 2; ++pass_) { OPQ(); if ((pass_ == 1) == late_) {
        { const int rb = srb, col0 = scb * 64;
            chain_wait(ctl, 5, rb, 128u);
            const f32x4 v = sk::tile(SV(SR_H, 8192), WDOWN, DFF, (size_t)MP + rb * 32, col0, (SK_LAS char*)(L + RING_OFF));
            int t_raw_ = threadIdx.x; asm volatile("" : "+v"(t_raw_)); const int t = t_raw_, r = MP + rb * 32 + (t >> 4), c = col0 + (t & 15) * 4;
            const f32x4 x2 = sk::up4(*(const GAS unsigned long long*)(XB + (size_t)r * DM + c)) + v; st8_wt(XB + (size_t)r * DM + c, sk::pk4(x2));
            st8_wt(SV(SR_XN2, 2048) + (size_t)r * DM + c, sk::pk4(x2 * *(const GAS f32x4*)(g_ple + c)));
            const float ss = sk::sum16(pg8::dot4(x2)); if ((t & 15) == 0) stf_wt(SSQ2 + (size_t)r * 16 + (col0 >> 6), ss);
        }
    } else {
        pg8::Gemm g{PV(AR_H, 8192), WDOWN, MP, DM, DFF}; pg8::StaticOrder S; S.init(MP, DM, G, bx); pg8::EpiResid<false> E{nullptr, XB, XN, g_ple, SSQ2};
        pg8::gemm_phase<pg8::EpiResid<false>, pg8::StaticOrder, true, true, PostHook>(L + RING_OFF, g, S, E, PostHook{ctl, 6, srb, !late_});
    } }
    SEAM(late_); LATE_POST(6);
#pragma unroll 1
    for (int pass_ = 0; pass_ < 2; ++pass_) { OPQ(); if ((pass_ == 1) == late_) {
        { const int rb = srb, col0 = scb * 64;
            chain_wait(ctl, 6, rb, 128u);
            const f32x4 vp = sk::tile(PB, WPP, PLE, (size_t)MP + rb * 32, col0, (SK_LAS char*)(L + RING_OFF));
            const f32x4 vg = sk::tile(SV(SR_XN2, 2048), WPG, DM, (size_t)MP + rb * 32, col0, (SK_LAS char*)(L + RING_OFF));
            int t_raw_ = threadIdx.x; asm volatile("" : "+v"(t_raw_)); const int t = t_raw_, r = MP + rb * 32 + (t >> 4), c = col0 + (t & 15) * 4;
            const float rs_ = sk::rstd16(SSQ2, r, t);
            const f32x4 x3 = sk::up4(*(const GAS unsigned long long*)(XB + (size_t)r * DM + c)) + pg8::sigm4(vg * rs_) * vp;
            const float ss = sk::sum16(pg8::dot4(x3)); if ((t & 15) == 0) __hip_atomic_store(SSQ3 + (size_t)r * 16 + (col0 >> 6), ss, __ATOMIC_RELAXED, __HIP_MEMORY_SCOPE_AGENT);
            asm volatile("s_waitcnt vmcnt(0)" ::: "memory");
            unsigned* cw = (unsigned*)(ctl + CW_FINS + 64 * rb);
            if ((t & 63) == 0) __hip_atomic_fetch_add(cw, 1u, __ATOMIC_RELAXED, __HIP_MEMORY_SCOPE_AGENT);
            { unsigned spins = 0; while ((unsigned)__builtin_amdgcn_readfirstlane(__hip_atomic_load(cw, __ATOMIC_RELAXED, __HIP_MEMORY_SCOPE_AGENT)) < 128u) { __builtin_amdgcn_s_sleep(2); if (++spins > (1u << 16)) break; } }
            const float r3 = __builtin_amdgcn_rsqf(sk::sum16(__hip_atomic_load(SSQ3 + (size_t)r * 16 + (t & 15), __ATOMIC_RELAXED, __HIP_MEMORY_SCOPE_AGENT)) * (1.0f / 1024.0f) + EPS);
            *(GAS f32x4*)(Yo + (size_t)r * DM + c) = x3 * r3 * *(const GAS f32x4*)(g_final + c);
        }
    } else {
        { pg8::Gemm g{PB, WPP, MP, DM, PLE}; pg8::StaticOrder S; S.init(MP, DM, G, bx); pg8::EpiPP E{PV(AR_PP, 2048)};
          pg8::gemm_phase<pg8::EpiPP, pg8::StaticOrder, true, true>(L + RING_OFF, g, S, E); }
        { pg8::Gemm g{XN, WPG, MP, DM, DM}; pg8::StaticOrder S; S.init(MP, DM, G, bx); pg8::EpiPleFinal E{SSQ2, PV(AR_PP, 2048), XB, Yo, SSQ3, g_final, (unsigned*)(ctl + CW_FIN)};
          pg8::gemm_phase<pg8::EpiPleFinal, pg8::StaticOrder, true, true>(L + RING_OFF, g, S, E); }
    } }
#undef SEAM
#undef LATE_POST
#undef PV
#undef SV
#undef OPQ
#undef FRESH_TID
}

extern "C" void kernel_launch(void* const* d_in, const int* in_sizes, int n_in, void* d_out, int out_size, void* d_ws, size_t ws_size, hipStream_t stream) {
    static int grid = 0;
    if (grid == 0) {
        if (n_in != 22 || out_size != (int)O_END || ws_size < WS_END) { fprintf(stderr, "kernel_launch: unexpected sizes: n_in %d out %d ws %zu\n", n_in, out_size, ws_size); grid = -1; return; }
        int dev = 0, cus = 0, per_cu = 0;
        if (hipGetDevice(&dev) != hipSuccess || hipDeviceGetAttribute(&cus, hipDeviceAttributeMultiprocessorCount, dev) != hipSuccess) { grid = -1; return; }
        if (hipFuncSetAttribute((const void*)mega_fwd, hipFuncAttributeMaxDynamicSharedMemorySize, LDS_BYTES) != hipSuccess) { fprintf(stderr, "kernel_launch: hipFuncSetAttribute failed\n"); grid = -1; return; }
        if (hipOccupancyMaxActiveBlocksPerMultiprocessor(&per_cu, (const void*)mega_fwd, NWAVES * 64, LDS_BYTES) != hipSuccess || per_cu < 1) { fprintf(stderr, "kernel_launch: occupancy query says %d\n", per_cu); (void)hipGetLastError(); }
        if (cus != 256) { fprintf(stderr, "kernel_launch: built for a 256-CU device (one workgroup per CU, 8 groups of 32); found %d CUs\n", cus); grid = -1; return; }
        grid = cus;
    }
    if (grid < 0) return;
    (void)hipMemsetAsync((char*)d_ws + WS_CTL, 0, CTL_ZERO_BYTES, stream);
    Args a{};
    for (int i = 0; i < 22; ++i) a.in[i] = (const float*)d_in[i];
    a.out = (float*)d_out; a.ws = (unsigned char*)d_ws;
    hipLaunchKernelGGL(mega_fwd, dim3(grid), dim3(NWAVES * 64), LDS_BYTES, stream, a);
}
```

```cpp
#include <hip/hip_runtime.h>
#include <hip/hip_bf16.h>
#include <cstdio>
#include <cstdint>
#include <cmath>
namespace cfg {
constexpr int DM = 1024, NB = 8, SEQ = 2048, DB = 16, DS = 32, PAST = 1024, PW = 512, SBW = 512, HD = 64, NH = 8, DFF = 4096, PLE = 256, INW = 4096;
constexpr int MP = NB * SEQ, MS = DB * DS, MT = MP + MS;
constexpr float EPS = 1e-6f;
constexpr float QSCALE = 0.125f * 1.4426950408889634f;
}
namespace pg8 {
#define PG8_LAS __attribute__((address_space(3)))
typedef unsigned short bf16_t;
typedef short bf16x8 __attribute__((ext_vector_type(8)));
typedef float f32x4 __attribute__((ext_vector_type(4)));
typedef unsigned u32x4 __attribute__((ext_vector_type(4)));
constexpr int BM = 256, BK = 64, HALF = 128, HTB = HALF * BK * 2  , STAGE_BYTES = 8 * HTB, NXCD = 8, WGM = 8;

__host__ __device__ __forceinline__ int lds_byte(int r, int c) { const int st = (r >> 4) * 2 + (c >> 5), rr = r & 15, cc = c & 31, ob = rr * 64 + cc * 2; return st * 1024 + (ob ^ (((ob >> 9) & 1) << 5)); }
__host__ __device__ __forceinline__ void stage_rc(int b, int& R, int& C) { const int st = b / 1024, sb = b % 1024, swz = sb ^ (((sb >> 9) & 1) << 5); R = (st >> 1) * 16 + swz / 64; C = (st & 1) * 32 + (swz % 64) / 2; }
__host__ __device__ __forceinline__ int perm32(int rho) { const int n = rho >> 4, i = rho & 15; return 8 * (i >> 2) + 4 * n + (i & 3); }

struct Unit { int pm, pn, seg; };
struct Gemm { const bf16_t* A; const bf16_t* Bt; int M, N, K; const bf16_t* A1 = nullptr; const bf16_t* Bt1 = nullptr; };

struct StaticOrder {
    int nM, nN, nwg, G, c;
    __host__ __device__ void init(int M, int N, int G_, int c_) { nM = M / BM; nN = N / BM; nwg = nM * nN; G = G_; c = c_; }
    __host__ __device__ bool next(int i, Unit& u) const {
        const long L = (long)i * G + c; if (L >= nwg) return false;
        int wgid = (int)L; { const int q = nwg / NXCD, r = nwg % NXCD, xcd = wgid % NXCD, off = wgid / NXCD; wgid = (xcd < r ? xcd * (q + 1) : r * (q + 1) + (xcd - r) * q) + off; }
        const int nig = WGM * nN, gid = wgid / nig, fm = gid * WGM, gsz = (nM - fm) < WGM ? (nM - fm) : WGM;
        u.pm = fm + ((wgid % nig) % gsz); u.pn = (wgid % nig) / gsz; u.seg = 0; return true;
    }
    __device__ __forceinline__ void a_ready(const Unit&) const {}
    __device__ __forceinline__ void done(const Unit&) const {}
};
struct RotOrder : StaticOrder {
    int rot, cnt;
    __host__ __device__ void init(int M, int N, int G_, int c_, int rot_) { StaticOrder::init(M, N, G_, c_); cnt = (nwg % G_ == 0) ? nwg / G_ : 0; rot = rot_; }
    __host__ __device__ bool next(int i, Unit& u) const { if (cnt == 0) return StaticOrder::next(i, u); if (i >= cnt) return false; return StaticOrder::next((i + rot) % cnt, u); }
};
struct PairOrder : StaticOrder {
    __host__ __device__ bool next(int i, Unit& u) const { if (!StaticOrder::next(i >> 1, u)) return false; u.seg = i & 1; return true; }
};
typedef float f32x2v_t __attribute__((ext_vector_type(2))); typedef __bf16 bf16x2v_t __attribute__((ext_vector_type(2)));
__device__ __forceinline__ unsigned cvt_pk_bf16(float lo, float hi) { f32x2v_t v = {lo, hi}; bf16x2v_t b = __builtin_convertvector(v, bf16x2v_t); return __builtin_bit_cast(unsigned, b); }
typedef float f32x2 __attribute__((ext_vector_type(2)));
__device__ __forceinline__ float bf_lo(unsigned w) { return __uint_as_float(w << 16); }
__device__ __forceinline__ float bf_hi(unsigned w) { return __uint_as_float(w & 0xffff0000u); }
__device__ __forceinline__ u32x4 pack8(f32x4 a, f32x4 b) { u32x4 w; w.x = cvt_pk_bf16(a[0], a[1]); w.y = cvt_pk_bf16(a[2], a[3]); w.z = cvt_pk_bf16(b[0], b[1]); w.w = cvt_pk_bf16(b[2], b[3]); return w; }
__device__ __forceinline__ void unpack8(u32x4 w, f32x4& a, f32x4& b) { a = (f32x4){bf_lo(w.x), bf_hi(w.x), bf_lo(w.y), bf_hi(w.y)}; b = (f32x4){bf_lo(w.z), bf_hi(w.z), bf_lo(w.w), bf_hi(w.w)}; }
__device__ __forceinline__ float sigm(float x) { return __builtin_amdgcn_rcpf(1.f + __builtin_amdgcn_exp2f(-1.4426950408889634f * x)); }
__device__ __forceinline__ f32x4 sigm4(f32x4 x) { return (f32x4){sigm(x[0]), sigm(x[1]), sigm(x[2]), sigm(x[3])}; }
__device__ __forceinline__ float dot4(f32x4 a) { return (a[0] * a[0] + a[1] * a[1]) + (a[2] * a[2] + a[3] * a[3]); }
#ifndef DBG_LDAUX
#define DBG_LDAUX 16
#endif
__device__ __forceinline__ u32x4 ld16_sc1(const void* base, size_t byte_off) {
    const __amdgpu_buffer_rsrc_t rs = __builtin_amdgcn_make_buffer_rsrc((void*)base, (short)0, 0x7fffffff, 0x00020000);
    return __builtin_bit_cast(u32x4, __builtin_amdgcn_raw_buffer_load_b128(rs, (unsigned)byte_off, 0, DBG_LDAUX));
}
__device__ __forceinline__ unsigned pk_u8x4(f32x4 g) { unsigned w = 0u; w = __builtin_amdgcn_cvt_pk_u8_f32(g[0] * 255.0f, 0, w); w = __builtin_amdgcn_cvt_pk_u8_f32(g[1] * 255.0f, 1, w); w = __builtin_amdgcn_cvt_pk_u8_f32(g[2] * 255.0f, 2, w); w = __builtin_amdgcn_cvt_pk_u8_f32(g[3] * 255.0f, 3, w); return w; }
__device__ __forceinline__ f32x4 up_u8x4(unsigned w) { return (f32x4){(float)(w & 0xffu), (float)((w >> 8) & 0xffu), (float)((w >> 16) & 0xffu), (float)(w >> 24)} * (1.0f / 255.0f); }
typedef unsigned u32x2 __attribute__((ext_vector_type(2)));
template <int AUX> __device__ __forceinline__ void st16_aux(void* base, size_t byte_off, u32x4 v) {
    if constexpr (AUX == 0) { *(u32x4*)((char*)base + byte_off) = v; }
    else { const __amdgpu_buffer_rsrc_t rs = __builtin_amdgcn_make_buffer_rsrc(base, (short)0, 0x7fffffff, 0x00020000); __builtin_amdgcn_raw_buffer_store_b128(v, rs, (unsigned)byte_off, 0, AUX); }
}
#ifndef DBG_AUXHS
#define DBG_AUXHS 0
#endif
__device__ __forceinline__ float row_rstd(const float* SSQ, int r, int fq) {
    const f32x4 p = *(const f32x4*)(SSQ + (size_t)r * 16 + 4 * fq); float s = (p[0] + p[1]) + (p[2] + p[3]);
    s += __shfl_xor(s, 16); s += __shfl_xor(s, 32);
    return __builtin_amdgcn_rsqf(s * (1.0f / 1024.0f) + cfg::EPS);
}
#define PG8_ROWS(...) _Pragma("unroll") for (int ai = 0; ai < 2; ++ai) _Pragma("unroll") for (int m = 0; m < 4; ++m) { const int r = u.pm * BM + ai * HALF + wr * 64 + m * 16 + fr; __VA_ARGS__; if (m == 3) asm volatile("" ::: "memory"); }
#define PG8_COLS(...) _Pragma("unroll") for (int bj = 0; bj < 2; ++bj) { const int c = ct + bj * HALF + wc * 32 + 8 * fq; const f32x4 v0 = acc[ai][bj][m][0], v1 = acc[ai][bj][m][1]; __VA_ARGS__; }

struct EpiIn {
    static constexpr bool PERM = true, AFTER_DRAIN = false;
    bf16_t *U, *Q, *K, *V, *G; const float* b_gate; float *k_p, *v_p, *k_s, *v_s, *pool_p, *pool_s;
    __device__ __forceinline__ void operator()(const f32x4 (&acc)[2][2][4][2], const Unit& u, int wr, int wc, int fr, int fq) const {
        const int pn = u.pn;
        if (pn >= 8) {
            const int ct = (pn - 8) * BM; f32x4 bv[2][2];
#pragma unroll
            for (int bj = 0; bj < 2; ++bj) { const int c = ct + bj * HALF + wc * 32 + 8 * fq; bv[bj][0] = *(const f32x4*)(b_gate + c); bv[bj][1] = *(const f32x4*)(b_gate + c + 4); }
            PG8_ROWS(PG8_COLS(*(u32x2*)((unsigned char*)G + (size_t)r * 2048 + c) = (u32x2){pk_u8x4(sigm4(v0 + bv[bj][0])), pk_u8x4(sigm4(v1 + bv[bj][1]))}))
        } else if (pn >= 4) {
            const bool isv = pn >= 6; const int ct = (pn - (isv ? 6 : 4)) * BM; bf16_t* B = isv ? V : K; float* op = isv ? v_p : k_p; float* os = isv ? v_s : k_s;
            PG8_ROWS(float* orow = r < cfg::MP ? op + (size_t)r * 512 : os + (size_t)(r - cfg::MP) * 512;
                     PG8_COLS(*(u32x4*)(B + (size_t)r * 512 + c) = pack8(v0, v1); __builtin_nontemporal_store(v0, (f32x4*)(orow + c)); __builtin_nontemporal_store(v1, (f32x4*)(orow + c + 4))))
        } else if (pn >= 2) {
            const int ct = (pn - 2) * BM;
            PG8_ROWS(PG8_COLS(*(u32x4*)(Q + (size_t)r * 512 + c) = pack8(v0 * cfg::QSCALE, v1 * cfg::QSCALE)))
        } else {
            const int ct = pn * BM;
            PG8_ROWS(float* prow = nullptr;
                     if (r < cfg::MP) { const int t = r & (cfg::SEQ - 1); if (t >= cfg::SEQ - 15) prow = pool_p + ((size_t)(r >> 11) * 15 + (t - (cfg::SEQ - 15))) * 512; }
                     else { const int i = (r - cfg::MP) & 31; if (i >= 17) prow = pool_s + ((size_t)((r - cfg::MP) >> 5) * 15 + (i - 17)) * 512; }
                     PG8_COLS(*(u32x4*)(U + (size_t)r * 512 + c) = pack8(v0, v1); if (prow) { *(f32x4*)(prow + c) = v0; *(f32x4*)(prow + c + 4) = v1; }))
        }
    }
};
#if defined(DBG_ONLYG)
#define DBG_NOG_STMT *(u32x4*)(MG + (size_t)r * 1024 + c) = gw; continue;
#elif defined(DBG_NOG)
#define DBG_NOG_STMT g0 = (f32x4){0.5f, 0.5f, 0.5f, 0.5f}; g1 = g0;
#else
#define DBG_NOG_STMT
#endif
struct EpiMerge;
struct EpiMerge0 {
    static constexpr bool PERM = true, AFTER_DRAIN = false;
    const bf16_t* G; bf16_t* MG;
    __device__ __forceinline__ void operator()(const f32x4 (&acc)[2][2][4][2], const Unit& u, int wr, int wc, int fr, int fq) const {
        const int ct = u.pn * BM;
        PG8_ROWS(PG8_COLS(const u32x2 gw = *(const u32x2*)((const unsigned char*)G + (size_t)r * 2048 + c); const f32x4 g0 = up_u8x4(gw.x); const f32x4 g1 = up_u8x4(gw.y); *(u32x4*)(MG + (size_t)r * 1024 + c) = pack8(v0 * g0, v1 * g1)))
    }
};
#ifdef DBG_NORAW
#define DBG_NORAW_STMT m0 = (f32x4){0.f, 0.f, 0.f, 0.f}; m1 = m0;
#else
#define DBG_NORAW_STMT
#endif
struct EpiMerge1 {
    static constexpr bool PERM = true, AFTER_DRAIN = false;
    const bf16_t* G; bf16_t* MG;
    __device__ __forceinline__ void operator()(const f32x4 (&acc)[2][2][4][2], const Unit& u, int wr, int wc, int fr, int fq) const {
        const int ct = u.pn * BM;
        PG8_ROWS(PG8_COLS(const u32x2 gw = *(const u32x2*)((const unsigned char*)G + (size_t)r * 2048 + 1024 + c); const u32x4 mw = *(const u32x4*)(MG + (size_t)r * 1024 + c);
                          const f32x4 g0 = up_u8x4(gw.x); const f32x4 g1 = up_u8x4(gw.y); f32x4 m0; f32x4 m1; unpack8(mw, m0, m1); *(u32x4*)(MG + (size_t)r * 1024 + c) = pack8(m0 + v0 * g0, m1 + v1 * g1)))
    }
};
struct EpiMerge {
    static constexpr bool PERM = true, AFTER_DRAIN = false;
    const bf16_t* G; bf16_t* MG;
    __device__ __forceinline__ void operator()(const f32x4 (&acc)[2][2][4][2], const Unit& u, int wr, int wc, int fr, int fq) const {
        if (u.seg == 0) { const EpiMerge0 E0{G, MG}; E0(acc, u, wr, wc, fr, fq); } else { const EpiMerge1 E1{G, MG}; E1(acc, u, wr, wc, fr, fq); }
    }
};
template <bool F32RES>
struct EpiResid {
    static constexpr bool PERM = true, AFTER_DRAIN = false;
    const float* res_p; bf16_t* X; bf16_t* XG; const float* gvec; float* SSQ;
    __device__ __forceinline__ void operator()(const f32x4 (&acc)[2][2][4][2], const Unit& u, int wr, int wc, int fr, int fq) const {
        const int ct = u.pn * BM; f32x4 gv[2][2];
#pragma unroll
        for (int bj = 0; bj < 2; ++bj) { const int c = ct + bj * HALF + wc * 32 + 8 * fq; gv[bj][0] = *(const f32x4*)(gvec + c); gv[bj][1] = *(const f32x4*)(gvec + c + 4); }
        PG8_ROWS(float s = 0.f;
                 PG8_COLS(f32x4 a; f32x4 b;
                          if (F32RES) { a = __builtin_nontemporal_load((const f32x4*)(res_p + (size_t)r * 1024 + c)); b = __builtin_nontemporal_load((const f32x4*)(res_p + (size_t)r * 1024 + c + 4)); }
                          else { const u32x4 xw = *(const u32x4*)(X + (size_t)r * 1024 + c); unpack8(xw, a, b); }
                          a += v0; b += v1; *(u32x4*)(X + (size_t)r * 1024 + c) = pack8(a, b); s += dot4(a) + dot4(b);
                          *(u32x4*)(XG + (size_t)r * 1024 + c) = pack8(a * gv[bj][0], b * gv[bj][1]))
                 s += __shfl_xor(s, 16); s += __shfl_xor(s, 32); if (fq == 0) SSQ[(size_t)r * 16 + u.pn * 4 + wc] = s)
    }
};
struct EpiUp {
    static constexpr bool PERM = true, AFTER_DRAIN = false;
    const float* SSQ; bf16_t* H;
    __device__ __forceinline__ void operator()(const f32x4 (&acc)[2][2][4][2], const Unit& u, int wr, int wc, int fr, int fq) const {
        const int ct = u.pn * BM; float rsv[2][4];
#pragma unroll
        for (int ai = 0; ai < 2; ++ai)
#pragma unroll
            for (int m = 0; m < 4; ++m) rsv[ai][m] = row_rstd(SSQ, u.pm * BM + ai * HALF + wr * 64 + m * 16 + fr, fq);
        PG8_ROWS(const float rs = rsv[ai][m];
                 PG8_COLS(f32x4 a = v0 * rs; f32x4 b = v1 * rs; a = __builtin_elementwise_max(a, (f32x4){0.f, 0.f, 0.f, 0.f}); b = __builtin_elementwise_max(b, (f32x4){0.f, 0.f, 0.f, 0.f});
                          st16_aux<DBG_AUXHS>(H, ((size_t)r * 4096 + c) * 2, pack8(a * a, b * b))))
    }
};
struct EpiNull {
    static constexpr bool PERM = true, AFTER_DRAIN = false;
    float* sink;
    __device__ __forceinline__ void operator()(const f32x4 (&acc)[2][2][4][2], const Unit& u, int wr, int wc, int fr, int fq) const {
        float s = 0.f;
#pragma unroll
        for (int ai = 0; ai < 2; ++ai)
#pragma unroll
            for (int bj = 0; bj < 2; ++bj)
#pragma unroll
                for (int m = 0; m < 4; ++m)
#pragma unroll
                    for (int n = 0; n < 2; ++n) s += acc[ai][bj][m][n][0] + acc[ai][bj][m][n][3];
        if (s == 1.2345e33f) sink[0] = s;
    }
};
struct EpiPP {
    static constexpr bool PERM = true, AFTER_DRAIN = false;
    bf16_t* PP;
    __device__ __forceinline__ void operator()(const f32x4 (&acc)[2][2][4][2], const Unit& u, int wr, int wc, int fr, int fq) const {
        const int ct = u.pn * BM;
        PG8_ROWS(PG8_COLS(*(u32x4*)(PP + (size_t)r * 1024 + c) = pack8(v0, v1)))
    }
};
struct EpiPleFinal {
    static constexpr bool PERM = true, AFTER_DRAIN = false;
    const float* SSQ; const bf16_t* PP; const bf16_t* X; float* Y; float* SSQo; const float* gfin; unsigned* cnt;
    __device__ __forceinline__ void operator()(f32x4 (&acc)[2][2][4][2], const Unit& u, int wr, int wc, int fr, int fq) const {
        const int ct = u.pn * BM; float rsv[2][4];
#pragma unroll
        for (int ai = 0; ai < 2; ++ai)
#pragma unroll
            for (int m = 0; m < 4; ++m) rsv[ai][m] = row_rstd(SSQ, u.pm * BM + ai * HALF + wr * 64 + m * 16 + fr, fq);
        PG8_ROWS(const float rs = rsv[ai][m]; float s = 0.f;
                 PG8_COLS(const u32x4 pw = *(const u32x4*)(PP + (size_t)r * 1024 + c); f32x4 p0; f32x4 p1; unpack8(pw, p0, p1);
                          const u32x4 xw = *(const u32x4*)(X + (size_t)r * 1024 + c); f32x4 a; f32x4 b; unpack8(xw, a, b); a += sigm4(v0 * rs) * p0; b += sigm4(v1 * rs) * p1;
                          acc[ai][bj][m][0] = a; acc[ai][bj][m][1] = b; s += dot4(a) + dot4(b))
                 s += __shfl_xor(s, 16); s += __shfl_xor(s, 32);
                 if (fq == 0) __hip_atomic_store(SSQo + (size_t)r * 16 + u.pn * 4 + wc, s, __ATOMIC_RELAXED, __HIP_MEMORY_SCOPE_AGENT))
        asm volatile("s_waitcnt vmcnt(0)" ::: "memory");
        unsigned* cw = cnt + 64 * (2 * u.pm + wr);
        if (fr == 0 && fq == 0) __hip_atomic_fetch_add(cw, 1u, __ATOMIC_RELAXED, __HIP_MEMORY_SCOPE_AGENT);
        { unsigned spins = 0;
          while ((unsigned)__builtin_amdgcn_readfirstlane(__hip_atomic_load(cw, __ATOMIC_RELAXED, __HIP_MEMORY_SCOPE_AGENT)) < 16u) { __builtin_amdgcn_s_sleep(2); if (++spins > (1u << 16)) break; } }
        f32x4 gv[2][2];
#pragma unroll
        for (int bj = 0; bj < 2; ++bj) { const int c = ct + bj * HALF + wc * 32 + 8 * fq; gv[bj][0] = *(const f32x4*)(gfin + c); gv[bj][1] = *(const f32x4*)(gfin + c + 4); }
        PG8_ROWS(const f32x4 pq = __builtin_bit_cast(f32x4, ld16_sc1(SSQo, ((size_t)r * 16 + 4 * fq) * 4)); float t = (pq[0] + pq[1]) + (pq[2] + pq[3]); t += __shfl_xor(t, 16); t += __shfl_xor(t, 32);
                 const float r3 = __builtin_amdgcn_rsqf(t * (1.0f / 1024.0f) + cfg::EPS);
                 PG8_COLS(__builtin_nontemporal_store(v0 * r3 * gv[bj][0], (f32x4*)(Y + (size_t)r * 1024 + c)); __builtin_nontemporal_store(v1 * r3 * gv[bj][1], (f32x4*)(Y + (size_t)r * 1024 + c + 4))))
    }
};
struct NoHook { __device__ __forceinline__ void operator()(int) const {} };
template <class Epi, class Sched, bool ALIGN_EPI = false, bool SP2 = false, class Hook = NoHook, int AUXA = 0>
__device__ __forceinline__ void gemm_phase(PG8_LAS unsigned char* lds, const Gemm g, const Sched& S, const Epi& E, const Hook& H = Hook()) {
    int tid = threadIdx.x; asm volatile("" : "+v"(tid));
    const int wid = __builtin_amdgcn_readfirstlane(tid >> 6), lane = tid & 63, wr = wid >> 2, wc = wid & 3, fr = lane & 15, fq = lane >> 4;
    int K = g.K; asm volatile("" : "+s"(K)); const int nt = K / BK;
    unsigned voffA[2], voffB[2];
#pragma unroll
    for (int i = 0; i < 2; ++i) { int R, C; stage_rc(tid * 16 + i * 8192, R, C); const int Rb = Epi::PERM ? ((R & ~31) + perm32(R & 31)) : R;
        voffA[i] = (unsigned)(R * K + C) * 2u; voffB[i] = (unsigned)(Rb * K + C) * 2u; }
    const size_t kstep = (size_t)(BK * 2);
    const size_t hstep = (size_t)HALF * K * 2;
    const size_t tstep = 2 * hstep;
    const size_t bhs = hstep;
    const unsigned ldsw = (unsigned)wid * 1024u;
    const int aoff = lds_byte(wr * 64 + fr, fq * 8), boff = lds_byte(wc * 32 + fr, fq * 8);
#define PG8_SA(b, h) (((b) * 2 + (h)) * HTB)
#define PG8_SB(b, h) ((4 + (b) * 2 + (h)) * HTB)
#define PG8_STAGE_X(bufoff, gbase, voff, AUX) do { _Pragma("unroll") for (int _i = 0; _i < 2; ++_i) \
        __builtin_amdgcn_global_load_lds((const unsigned*)((const char*)(gbase) + (voff)[_i]), (PG8_LAS unsigned*)(lds + (bufoff) + ldsw + _i * 8192), 16, 0, AUX); } while (0)
#define PG8_LDA(dst, b, h) do { _Pragma("unroll") for (int m = 0; m < 4; ++m) _Pragma("unroll") for (int k = 0; k < 2; ++k) dst[m][k] = *(const PG8_LAS bf16x8*)(lds + PG8_SA(b, h) + aoff + m * 2048 + k * 1024); } while (0)
#define PG8_LDB(dst, b, h) do { _Pragma("unroll") for (int n = 0; n < 2; ++n) _Pragma("unroll") for (int k = 0; k < 2; ++k) dst[n][k] = *(const PG8_LAS bf16x8*)(lds + PG8_SB(b, h) + boff + n * 2048 + k * 1024); } while (0)
#define PG8_MMA(ai, bj, At, Bt) do { __builtin_amdgcn_s_setprio(1); _Pragma("unroll") for (int m = 0; m < 4; ++m) _Pragma("unroll") for (int n = 0; n < 2; ++n) _Pragma("unroll") for (int k = 0; k < 2; ++k) \
        acc[ai][bj][m][n] = __builtin_amdgcn_mfma_f32_16x16x32_bf16(Bt[n][k], At[m][k], acc[ai][bj][m][n], 0, 0, 0); __builtin_amdgcn_s_setprio(0); } while (0)
#ifdef DRAIN_ALL
#define PG8_WAIT_V(n) asm volatile("s_waitcnt vmcnt(0)" ::: "memory")
#else
#define PG8_WAIT_V(n) asm volatile("s_waitcnt vmcnt(" #n ")" ::: "memory")
#endif
#define PG8_WAIT_L(n) asm volatile("s_waitcnt lgkmcnt(" #n ")" ::: "memory")
#define PG8_BAR __builtin_amdgcn_s_barrier()
#define PG8_SCHED __builtin_amdgcn_sched_barrier(0)
    Unit cur, nxt; int ui = 0;
    if (!S.next(0, cur)) return;
    f32x4 acc[2][2][4][2];
#pragma unroll
    for (int a = 0; a < 2; ++a)
#pragma unroll
        for (int b = 0; b < 2; ++b)
#pragma unroll
            for (int m = 0; m < 4; ++m)
#pragma unroll
                for (int n = 0; n < 2; ++n) acc[a][b][m][n] = (f32x4){0.f, 0.f, 0.f, 0.f};
    bf16x8 At[4][2], B0[2][2], B1[2][2];
    const char* cA = (const char*)(cur.seg ? g.A1 : g.A) + (size_t)cur.pm * tstep; const char* cB = (const char*)(cur.seg ? g.Bt1 : g.Bt) + (size_t)cur.pn * tstep;
    S.a_ready(cur);
    if constexpr (SP2) {
        PG8_STAGE_X(PG8_SB(0, 0), cB, voffB, 0); PG8_STAGE_X(PG8_SB(0, 1), cB + bhs, voffB, 0); PG8_STAGE_X(PG8_SA(0, 0), cA, voffA, AUXA); PG8_STAGE_X(PG8_SA(0, 1), cA + hstep, voffA, AUXA);
        if (wr == 1) PG8_BAR;
        PG8_WAIT_V(2); PG8_BAR;
        PG8_STAGE_X(PG8_SB(1, 0), cB + kstep, voffB, 0); PG8_STAGE_X(PG8_SA(1, 0), cA + kstep, voffA, AUXA); PG8_STAGE_X(PG8_SB(1, 1), cB + bhs + kstep, voffB, 0);
        PG8_WAIT_V(6); PG8_BAR;
    } else {
        PG8_STAGE_X(PG8_SB(0, 0), cB, voffB, 0); PG8_STAGE_X(PG8_SA(0, 0), cA, voffA, AUXA); PG8_STAGE_X(PG8_SB(0, 1), cB + bhs, voffB, 0); PG8_STAGE_X(PG8_SA(0, 1), cA + hstep, voffA, AUXA);
        if (wr == 1) PG8_BAR;
        PG8_WAIT_V(4); PG8_BAR;
        PG8_STAGE_X(PG8_SB(1, 0), cB + kstep, voffB, 0); PG8_STAGE_X(PG8_SA(1, 0), cA + kstep, voffA, AUXA); PG8_STAGE_X(PG8_SB(1, 1), cB + bhs + kstep, voffB, 0);
        PG8_WAIT_V(6); PG8_BAR;
    }
    for (;;) {
        const bool has_next = S.next(ui + 1, nxt);
        const char* nA = has_next ? (const char*)(nxt.seg ? g.A1 : g.A) + (size_t)nxt.pm * tstep : cA; const char* nB = has_next ? (const char*)(nxt.seg ? g.Bt1 : g.Bt) + (size_t)nxt.pn * tstep : cB;
        for (int t = 0; t < nt; t += 2) {
            const bool last = (t == nt - 2);
            const char* a1 = cA + (size_t)(t + 1) * kstep;
            const char* a2 = last ? nA : cA + (size_t)(t + 2) * kstep; const char* b2 = last ? nB : cB + (size_t)(t + 2) * kstep;
            const char* a3 = a2 + kstep; const char* b3 = b2 + kstep;
            if (last && has_next) S.a_ready(nxt);
            if constexpr (SP2) {
            PG8_LDB(B0, 0, 0); PG8_LDB(B1, 0, 1); PG8_SCHED; PG8_LDA(At, 0, 0); PG8_STAGE_X(PG8_SA(1, 1), a1 + hstep, voffA, AUXA);
            PG8_WAIT_V(8); PG8_WAIT_L(0); PG8_BAR; PG8_MMA(0, 0, At, B0); PG8_MMA(0, 1, At, B1); PG8_BAR; PG8_SCHED;
            PG8_LDA(At, 0, 1); PG8_STAGE_X(PG8_SB(0, 0), b2, voffB, 0); PG8_STAGE_X(PG8_SB(0, 1), b2 + bhs, voffB, 0); PG8_STAGE_X(PG8_SA(0, 0), a2, voffA, AUXA);
            PG8_WAIT_V(8); PG8_WAIT_L(0); PG8_BAR; PG8_MMA(1, 0, At, B0); PG8_MMA(1, 1, At, B1); PG8_BAR; PG8_SCHED;
            PG8_LDB(B0, 1, 0); PG8_LDB(B1, 1, 1); PG8_SCHED; PG8_LDA(At, 1, 0); PG8_STAGE_X(PG8_SA(0, 1), a2 + hstep, voffA, AUXA);
            PG8_WAIT_V(8); PG8_WAIT_L(0); PG8_BAR; PG8_MMA(0, 0, At, B0); PG8_MMA(0, 1, At, B1); PG8_BAR; PG8_SCHED;
            PG8_LDA(At, 1, 1); PG8_STAGE_X(PG8_SB(1, 0), b3, voffB, 0); PG8_STAGE_X(PG8_SB(1, 1), b3 + bhs, voffB, 0); PG8_STAGE_X(PG8_SA(1, 0), a3, voffA, AUXA);
            PG8_WAIT_V(8); PG8_WAIT_L(0); PG8_BAR; PG8_MMA(1, 0, At, B0); PG8_MMA(1, 1, At, B1); PG8_BAR; PG8_SCHED;
            } else {
            PG8_LDB(B0, 0, 0); PG8_SCHED; PG8_LDA(At, 0, 0); PG8_STAGE_X(PG8_SA(1, 1), a1 + hstep, voffA, AUXA);
            PG8_WAIT_L(8); PG8_BAR; PG8_WAIT_L(0); PG8_MMA(0, 0, At, B0); PG8_BAR; PG8_SCHED;
            PG8_LDB(B1, 0, 1); PG8_STAGE_X(PG8_SB(0, 0), b2, voffB, 0);
            PG8_BAR; PG8_WAIT_L(0); PG8_MMA(0, 1, At, B1); PG8_BAR;
            PG8_LDA(At, 0, 1); PG8_STAGE_X(PG8_SA(0, 0), a2, voffA, AUXA);
            PG8_BAR; PG8_WAIT_L(0); PG8_MMA(1, 0, At, B0); PG8_BAR; PG8_SCHED;
            PG8_STAGE_X(PG8_SB(0, 1), b2 + bhs, voffB, 0);
            PG8_WAIT_V(6); PG8_BAR; PG8_MMA(1, 1, At, B1); PG8_BAR;
            PG8_LDB(B0, 1, 0); PG8_SCHED; PG8_LDA(At, 1, 0); PG8_STAGE_X(PG8_SA(0, 1), a2 + hstep, voffA, AUXA);
            PG8_WAIT_L(8); PG8_BAR; PG8_WAIT_L(0); PG8_MMA(0, 0, At, B0); PG8_BAR; PG8_SCHED;
            PG8_LDB(B1, 1, 1); PG8_STAGE_X(PG8_SB(1, 0), b3, voffB, 0);
            PG8_BAR; PG8_WAIT_L(0); PG8_MMA(0, 1, At, B1); PG8_BAR;
            PG8_LDA(At, 1, 1); PG8_STAGE_X(PG8_SA(1, 0), a3, voffA, AUXA);
            PG8_BAR; PG8_WAIT_L(0); PG8_MMA(1, 0, At, B0); PG8_BAR; PG8_SCHED;
            PG8_STAGE_X(PG8_SB(1, 1), b3 + bhs, voffB, 0);
            PG8_WAIT_V(6); PG8_BAR; PG8_MMA(1, 1, At, B1); PG8_BAR;
            }
        }
        if constexpr (ALIGN_EPI) { if (wr == 0) PG8_BAR; }
        if constexpr (!Epi::AFTER_DRAIN) { int t_ = threadIdx.x; asm volatile("" : "+v"(t_)); const int l_ = t_ & 63; E(acc, cur, wr, wc, l_ & 15, l_ >> 4); S.done(cur); H(ui); }
        if (!has_next) break;
#pragma unroll
        for (int a = 0; a < 2; ++a)
#pragma unroll
            for (int b = 0; b < 2; ++b)
#pragma unroll
                for (int m = 0; m < 4; ++m)
#pragma unroll
                    for (int n = 0; n < 2; ++n) acc[a][b][m][n] = (f32x4){0.f, 0.f, 0.f, 0.f};
        cur = nxt; cA = nA; cB = nB; ++ui;
        if constexpr (ALIGN_EPI) { if (wr == 1) PG8_BAR; }
    }
    PG8_WAIT_V(0);
    if constexpr (!ALIGN_EPI) { if (wr == 0) PG8_BAR; }
    PG8_BAR;
    if constexpr (Epi::AFTER_DRAIN) { E.fused(acc, cur, wr, wc, fr, fq, lds, wid, lane); S.done(cur); }
#undef PG8_SA
#undef PG8_SB
#undef PG8_STAGE_X
#undef PG8_LDA
#undef PG8_LDB
#undef PG8_MMA
#undef PG8_WAIT_V
#undef PG8_WAIT_L
#undef PG8_BAR
#undef PG8_SCHED
}
}
namespace sba {
typedef short bf16x8 __attribute__((ext_vector_type(8)));
typedef short s16x4 __attribute__((ext_vector_type(4)));
typedef float f32x16 __attribute__((ext_vector_type(16)));
typedef float f32x4 __attribute__((ext_vector_type(4)));
typedef unsigned u32x4 __attribute__((ext_vector_type(4)));
typedef unsigned short bf16_t;
#define SB_LAS __attribute__((address_space(3)))
constexpr int PITCH = 512, SLOTB = 16384  , OFF_FLAGS = 2 * SLOTB, OFF_OST = OFF_FLAGS + 256, LDS_BYTES = OFF_OST + 8 * 4096;
constexpr float THR2 = 48.0f, NEGBIG = -1.0e30f;
typedef float f32x2_t __attribute__((ext_vector_type(2))); typedef __bf16 bf16x2_t __attribute__((ext_vector_type(2)));
__device__ __forceinline__ unsigned cvtpk(float lo, float hi) { f32x2_t v = {lo, hi}; bf16x2_t b = __builtin_convertvector(v, bf16x2_t); return __builtin_bit_cast(unsigned, b); }
__device__ __forceinline__ bf16x8 pack8f(float a0, float a1, float a2, float a3, float a4, float a5, float a6, float a7) {
    u32x4 w; w.x = cvtpk(a0, a1); w.y = cvtpk(a2, a3); w.z = cvtpk(a4, a5); w.w = cvtpk(a6, a7); return __builtin_bit_cast(bf16x8, w); }
typedef short v4i16_t __attribute__((ext_vector_type(4)));
__device__ __forceinline__ s16x4 vtr(const SB_LAS char* p) { return __builtin_bit_cast(s16x4, __builtin_amdgcn_ds_read_tr16_b64_v4i16((SB_LAS v4i16_t*)p)); }
__device__ __forceinline__ int crow(int r, int hi) { return (r & 3) + 8 * (r >> 2) + 4 * hi; }

template <int SUB>
__device__ __forceinline__ void sub_front(const SB_LAS char* Kslot, bool mask, int kq, const bf16x8 (&qr)[4], f32x16& w, bf16x8 (&spb)[2], int r32, int hi) {
    const SB_LAS char* kb = Kslot + hi * 1024 + r32 * 16 + SUB * 512;
    f32x16 p = {};
#pragma unroll
    for (int d0 = 0; d0 < 4; ++d0) { const bf16x8 kf = *(const SB_LAS bf16x8*)(kb + d0 * 2048); p = __builtin_amdgcn_mfma_f32_32x32x16_bf16(kf, qr[d0], p, 0, 0, 0); }
    float sp[16];
#pragma unroll
    for (int r = 0; r < 16; ++r) {
        float x = p[r];
        if (mask && (kq + 32 * SUB + (r & 3) + 8 * (r >> 2) >= 0)) x = NEGBIG;
        const float t = __builtin_amdgcn_exp2f(-__builtin_fabsf(x));
        const float l = __builtin_amdgcn_logf(1.0f + t);
        sp[r] = __builtin_fmaxf(x, 0.f) + l; w[r] = __builtin_fminf(x, 0.f) - l;
    }
    spb[0] = pack8f(sp[0], sp[1], sp[2], sp[3], sp[4], sp[5], sp[6], sp[7]);
    spb[1] = pack8f(sp[8], sp[9], sp[10], sp[11], sp[12], sp[13], sp[14], sp[15]);
}
template <int SUB>
__device__ __forceinline__ void sub_back(const SB_LAS char* vp, const f32x16& w, const f32x16& sx, f32x16 (&o)[2]) {
    float pr[16];
#pragma unroll
    for (int r = 0; r < 16; ++r) pr[r] = __builtin_amdgcn_exp2f(w[r] - sx[r]);
    bf16x8 pa[2];
    pa[0] = pack8f(pr[0], pr[1], pr[2], pr[3], pr[4], pr[5], pr[6], pr[7]);
    pa[1] = pack8f(pr[8], pr[9], pr[10], pr[11], pr[12], pr[13], pr[14], pr[15]);
#pragma unroll
    for (int d0 = 0; d0 < 2; ++d0)
#pragma unroll
        for (int s = 0; s < 2; ++s) { const int ks = 2 * SUB + s;
            const s16x4 lo = vtr(vp + d0 * 4096 + ks * 1024), hi4 = vtr(vp + d0 * 4096 + ks * 1024 + 512);
            const bf16x8 vf = (bf16x8){lo[0], lo[1], lo[2], lo[3], hi4[0], hi4[1], hi4[2], hi4[3]};
            o[d0] = __builtin_amdgcn_mfma_f32_32x32x16_bf16(pa[s], vf, o[d0], 0, 0, 0); }
}
__device__ __forceinline__ void sb_tile(const SB_LAS char* slot, bool mask, bool skip1, int kq, const bf16x8 (&qr)[4], f32x16& Rb, f32x16 (&o)[2], const bf16x8 (&Um)[2], const bf16x8 Jm, int r32, int hi, int lane) {
    const SB_LAS char* vp = slot + 8192 + ((lane >> 4) & 1) * 32 + (lane & 3) * 8 + (4 * hi + ((lane & 15) >> 2)) * 64;
    f32x16 w1, w0; bf16x8 sb1[2], sb0[2];
    f32x16 t1 = Rb;
    if (!skip1) {
    sub_front<1>(slot, mask, kq, qr, w1, sb1, r32, hi);
    f32x16 a1 = __builtin_amdgcn_mfma_f32_32x32x16_bf16(Um[0], sb1[0], Rb, 0, 0, 0); a1 = __builtin_amdgcn_mfma_f32_32x32x16_bf16(Um[1], sb1[1], a1, 0, 0, 0);
    t1 = __builtin_amdgcn_mfma_f32_32x32x16_bf16(Jm, sb1[0], Rb, 0, 0, 0); t1 = __builtin_amdgcn_mfma_f32_32x32x16_bf16(Jm, sb1[1], t1, 0, 0, 0);
    sub_back<1>(vp, w1, a1, o);
    }
    sub_front<0>(slot, mask, kq, qr, w0, sb0, r32, hi);
    f32x16 a0 = __builtin_amdgcn_mfma_f32_32x32x16_bf16(Um[0], sb0[0], t1, 0, 0, 0); a0 = __builtin_amdgcn_mfma_f32_32x32x16_bf16(Um[1], sb0[1], a0, 0, 0, 0);
    f32x16 rn = __builtin_amdgcn_mfma_f32_32x32x16_bf16(Jm, sb0[0], t1, 0, 0, 0); rn = __builtin_amdgcn_mfma_f32_32x32x16_bf16(Jm, sb0[1], rn, 0, 0, 0);
    sub_back<0>(vp, w0, a0, o);
    Rb = rn;
}
struct Tensors { const bf16_t* Q; const bf16_t* K; const bf16_t* V; bf16_t* O; const float* ck; const float* cv; };

template <bool SAMPLE>
__device__ __forceinline__ void sb_unit(int b, int h, int qb, const Tensors& T, SB_LAS char* lds) {
    int tid = threadIdx.x; asm volatile("" : "+v"(tid)); const int lane = tid & 63, r32 = lane & 31, hi = lane >> 5; const int wid = __builtin_amdgcn_readfirstlane(tid >> 6);
    const size_t rowbase = SAMPLE ? (size_t)cfg::MP + (size_t)b * 32 : (size_t)b * cfg::SEQ; const int q0 = SAMPLE ? 0 : qb * 256;
    const int jd = SAMPLE ? 16 : (q0 >> 6) + (wid >> 1), jtop = SAMPLE ? 16 : (q0 >> 6) + 3;
    const bool worker = SAMPLE ? (wid == 0) : true;
    const int wq = SAMPLE ? 0 : wid;
    const int qpos = (SAMPLE ? cfg::PAST : q0 + 32 * wq) + r32;
    volatile SB_LAS unsigned* flags = (volatile SB_LAS unsigned*)(lds + OFF_FLAGS);
    bf16x8 Um[2], Jm;
#pragma unroll
    for (int s = 0; s < 2; ++s)
#pragma unroll
        for (int jj = 0; jj < 8; ++jj) Um[s][jj] = (16 * s + 8 * (jj >> 2) + 4 * hi + (jj & 3) > r32) ? (short)0x3F80 : (short)0;
#pragma unroll
    for (int jj = 0; jj < 8; ++jj) Jm[jj] = (short)0x3F80;
    bf16x8 qr[4];
    { const bf16_t* Qw = T.Q + (rowbase + q0 + 32 * wq + r32) * PITCH + h * 64 + hi * 8;
#pragma unroll
      for (int d0 = 0; d0 < 4; ++d0) qr[d0] = *(const bf16x8*)(Qw + d0 * 16); }
    f32x16 Rb = {}, o[2]; o[0] = f32x16{}; o[1] = f32x16{};
    bool done = false;
    u32x4 kreg, vreg;
    const int vkey = 16 * (wid & 3) + (lane >> 2), vcol = (wid >> 2) * 32 + (lane & 3) * 8;
#define SB_LOAD(j) do { \
        if (!SAMPLE) {   \
            const char* kb_ = (const char*)(T.K + (rowbase + (size_t)(64 * (j))) * PITCH + h * 64 + wid * 8); const char* vb_ = (const char*)(T.V + (rowbase + (size_t)(64 * (j))) * PITCH + h * 64); \
            kreg = *(const u32x4*)(kb_ + (unsigned)(lane * (PITCH * 2))); vreg = *(const u32x4*)(vb_ + (unsigned)(vkey * (PITCH * 2) + vcol * 2)); } \
        else if ((j) == 16) { const int kr_ = lane < 31 ? lane : 31, vr_ = vkey < 31 ? vkey : 31; \
            kreg = *(const u32x4*)((const char*)(T.K + rowbase * PITCH + h * 64 + wid * 8) + (unsigned)(kr_ * (PITCH * 2))); vreg = *(const u32x4*)((const char*)(T.V + rowbase * PITCH + h * 64) + (unsigned)(vr_ * (PITCH * 2) + vcol * 2)); } \
        else { const float* kp_ = (const float*)((const char*)(T.ck + ((size_t)b * cfg::PAST + 64 * (j)) * PITCH + h * 64 + wid * 8) + (unsigned)(lane * (PITCH * 4))); const float* vp_ = (const float*)((const char*)(T.cv + ((size_t)b * cfg::PAST + 64 * (j)) * PITCH + h * 64) + (unsigned)(vkey * (PITCH * 4) + vcol * 4)); \
            const f32x4 k0_ = *(const f32x4*)kp_, k1_ = *(const f32x4*)(kp_ + 4), v0_ = *(const f32x4*)vp_, v1_ = *(const f32x4*)(vp_ + 4); \
            kreg = (u32x4){cvtpk(k0_[0], k0_[1]), cvtpk(k0_[2], k0_[3]), cvtpk(k1_[0], k1_[1]), cvtpk(k1_[2], k1_[3])}; vreg = (u32x4){cvtpk(v0_[0], v0_[1]), cvtpk(v0_[2], v0_[3]), cvtpk(v1_[0], v1_[1]), cvtpk(v1_[2], v1_[3])}; } } while (0)
    SB_LOAD(jtop);
    for (int j = jtop; j >= 0; --j) {
        SB_LAS char* slot = lds + (j & 1) * SLOTB;
        *(SB_LAS u32x4*)(slot + wid * 1024 + lane * 16) = kreg; *(SB_LAS u32x4*)(slot + 8192 + wid * 1024 + lane * 16) = vreg;
        __syncthreads();
        if (j != jtop) { const volatile SB_LAS unsigned* f = flags + ((j + 1) & 1) * 8; unsigned all = 1u;
#pragma unroll
            for (int w8 = 0; w8 < 8; ++w8) all &= f[w8];
            if (all) break; }
        if (j > 0) SB_LOAD(j - 1);
        if (worker && !done && j <= jd) {
            const int key0 = (SAMPLE && j == 16) ? cfg::PAST : 64 * j;
            sb_tile(slot, j == jd, (j == jd) && (SAMPLE || (wid & 1) == 0), key0 + 4 * hi - qpos, qr, Rb, o, Um, Jm, r32, hi, lane);
            done = __all(Rb[0] > THR2) != 0;
        }
        if (lane == 0) flags[(j & 1) * 8 + wid] = (done || !worker) ? 1u : 0u;
    }
#undef SB_LOAD
    if (worker) {
        SB_LAS bf16_t* stg = (SB_LAS bf16_t*)(lds + OFF_OST) + wid * 2048;
#pragma unroll
        for (int r = 0; r < 16; ++r) { const int orow = crow(r, hi);
#pragma unroll
            for (int d0 = 0; d0 < 2; ++d0) stg[orow * 64 + d0 * 32 + r32] = (bf16_t)(cvtpk(o[d0][r], 0.f) & 0xffffu); }
        asm volatile("s_waitcnt lgkmcnt(0)" ::: "memory");
        bf16_t* Ow = T.O + (rowbase + q0 + 32 * wq) * PITCH + h * 64;
        if (SAMPLE) asm volatile("s_waitcnt vmcnt(0)" ::: "memory");
#pragma unroll
        for (int i = 0; i < 4; ++i) { const int row = i * 8 + (lane >> 3), ch = lane & 7; const u32x4 v = *(const SB_LAS u32x4*)(stg + row * 64 + ch * 8); if (SAMPLE) { unsigned long long* po = (unsigned long long*)(Ow + (size_t)row * PITCH + ch * 8);
                __hip_atomic_store(po, (unsigned long long)v.x | ((unsigned long long)v.y << 32), __ATOMIC_RELAXED, __HIP_MEMORY_SCOPE_AGENT); __hip_atomic_store(po + 1, (unsigned long long)v.z | ((unsigned long long)v.w << 32), __ATOMIC_RELAXED, __HIP_MEMORY_SCOPE_AGENT); }
            else *(u32x4*)(Ow + (size_t)row * PITCH + ch * 8) = v; }
    }
    if (SAMPLE) { asm volatile("s_waitcnt lgkmcnt(0)" ::: "memory"); __builtin_amdgcn_s_barrier(); }
    else __syncthreads();
}
}
namespace sk {
typedef short bf16x8 __attribute__((ext_vector_type(8)));
typedef float f32x16 __attribute__((ext_vector_type(16)));
typedef float f32x4 __attribute__((ext_vector_type(4)));
typedef unsigned short bf16_t;
#define SK_LAS __attribute__((address_space(3)))
constexpr int PLD = 36;
constexpr int LDS_BYTES = 8 * 2 * 32 * PLD * 4;
__device__ __forceinline__ f32x4 tile(const bf16_t* A, const bf16_t* Bt, int K, size_t arow0, int col0, SK_LAS char* lds) {
    int tid = threadIdx.x; asm volatile("" : "+v"(tid)); const int lane = tid & 63, r32 = lane & 31, hi = lane >> 5; const int wid = __builtin_amdgcn_readfirstlane(tid >> 6);
    const int nsplit = (K >= 512) ? 8 : (K >> 6), ks = K / nsplit;
    const bf16_t* ap = A + (arow0 + r32) * K + wid * ks + hi * 32;
    const bf16_t* bp0 = Bt + (size_t)(col0 + r32) * K + wid * ks + hi * 32; const bf16_t* bp1 = bp0 + (size_t)32 * K;
    f32x16 acc0 = {}, acc1 = {};
#pragma unroll 2
    for (int s = 0; s < ((wid < nsplit) ? ks : 0); s += 64) {
        bf16x8 a[4], b0[4], b1[4];
#pragma unroll
        for (int j = 0; j < 4; ++j) { a[j] = *(const bf16x8*)(ap + s + 8 * j); b0[j] = *(const bf16x8*)(bp0 + s + 8 * j); b1[j] = *(const bf16x8*)(bp1 + s + 8 * j); }
#pragma unroll
        for (int j = 0; j < 4; ++j) {
            acc0 = __builtin_amdgcn_mfma_f32_32x32x16_bf16(b0[j], a[j], acc0, 0, 0, 0);
            acc1 = __builtin_amdgcn_mfma_f32_32x32x16_bf16(b1[j], a[j], acc1, 0, 0, 0); }
    }
    SK_LAS float* P0 = (SK_LAS float*)lds + ((wid * 2 + 0) * 32 + r32) * PLD + 4 * hi; SK_LAS float* P1 = P0 + 32 * PLD;
#pragma unroll
    for (int g = 0; g < 4; ++g) { *(SK_LAS f32x4*)(P0 + 8 * g) = (f32x4){acc0[4 * g], acc0[4 * g + 1], acc0[4 * g + 2], acc0[4 * g + 3]};
                                  *(SK_LAS f32x4*)(P1 + 8 * g) = (f32x4){acc1[4 * g], acc1[4 * g + 1], acc1[4 * g + 2], acc1[4 * g + 3]}; }
    __syncthreads();
    const int row = tid >> 4, c = (tid & 15) * 4, cb = c >> 5, cc = c & 31;
    f32x4 s = {0.f, 0.f, 0.f, 0.f};
#pragma unroll
    for (int w = 0; w < 8; ++w) s += *(const SK_LAS f32x4*)((SK_LAS float*)lds + ((w * 2 + cb) * 32 + row) * PLD + cc);
    __syncthreads();
    return s;
}
__device__ __forceinline__ void tile4(const bf16_t* A, const bf16_t* Bt, int K, size_t arow0, int col0, SK_LAS char* lds, f32x4 (&out)[2][2]) {
    int tid = threadIdx.x; asm volatile("" : "+v"(tid)); const int lane = tid & 63, r32 = lane & 31, hi = lane >> 5; const int wid = __builtin_amdgcn_readfirstlane(tid >> 6);
    const int half = wid >> 2, kq = wid & 3, ks = K >> 2;
    const bf16_t* ap = A + (arow0 + r32) * K + kq * ks + hi * 32;
    const bf16_t* bp = Bt + (size_t)(col0 + half * 128 + r32) * K + kq * ks + hi * 32;
    f32x16 acc[4]; acc[0] = f32x16{}; acc[1] = f32x16{}; acc[2] = f32x16{}; acc[3] = f32x16{};
#pragma unroll 1
    for (int s = 0; s < ks; s += 64) {
        bf16x8 a[4], b[4][4];
#pragma unroll
        for (int e = 0; e < 4; ++e) { a[e] = *(const bf16x8*)(ap + s + 8 * e);
#pragma unroll
            for (int j = 0; j < 4; ++j) b[j][e] = *(const bf16x8*)(bp + (size_t)(32 * j) * K + s + 8 * e); }
#pragma unroll
        for (int e = 0; e < 4; ++e)
#pragma unroll
            for (int j = 0; j < 4; ++j) acc[j] = __builtin_amdgcn_mfma_f32_32x32x16_bf16(b[j][e], a[e], acc[j], 0, 0, 0);
    }
    const int row = tid >> 4, cc = (tid & 15) * 4;
#pragma unroll
    for (int q = 0; q < 2; ++q) {
        SK_LAS float* P0 = (SK_LAS float*)lds + ((wid * 2 + 0) * 32 + r32) * PLD + 4 * hi; SK_LAS float* P1 = P0 + 32 * PLD;
#pragma unroll
        for (int g = 0; g < 4; ++g) { *(SK_LAS f32x4*)(P0 + 8 * g) = (f32x4){acc[2 * q][4 * g], acc[2 * q][4 * g + 1], acc[2 * q][4 * g + 2], acc[2 * q][4 * g + 3]};
                                      *(SK_LAS f32x4*)(P1 + 8 * g) = (f32x4){acc[2 * q + 1][4 * g], acc[2 * q + 1][4 * g + 1], acc[2 * q + 1][4 * g + 2], acc[2 * q + 1][4 * g + 3]}; }
        __syncthreads();
#pragma unroll
        for (int h = 0; h < 2; ++h) { f32x4 sum = {0.f, 0.f, 0.f, 0.f};
#pragma unroll
            for (int w = 0; w < 4; ++w) sum += *(const SK_LAS f32x4*)((SK_LAS float*)lds + (((h * 4 + w) * 2 + (cc >> 5)) * 32 + row) * PLD + (cc & 31));
            out[h][q] = sum; }
        __syncthreads();
    }
}
__device__ __forceinline__ f32x16 wtile(const bf16_t* A, const bf16_t* Bt, int K, size_t arow0, int colw, int lane) {
    const int r32 = lane & 31, hi = lane >> 5;
    const bf16_t* ap = A + (arow0 + r32) * K + hi * 32; const bf16_t* bp = Bt + (size_t)(colw + r32) * K + hi * 32;
    f32x16 acc = {};
#pragma unroll 4
    for (int s = 0; s < K; s += 64) {
        bf16x8 a[4], b[4];
#pragma unroll
        for (int e = 0; e < 4; ++e) { a[e] = *(const bf16x8*)(ap + s + 8 * e); b[e] = *(const bf16x8*)(bp + s + 8 * e); }
#pragma unroll
        for (int e = 0; e < 4; ++e) acc = __builtin_amdgcn_mfma_f32_32x32x16_bf16(b[e], a[e], acc, 0, 0, 0);
    }
    return acc;
}
__device__ __forceinline__ float sum16(float v) { v += __shfl_xor(v, 1); v += __shfl_xor(v, 2); v += __shfl_xor(v, 4); v += __shfl_xor(v, 8); return v; }
__device__ __forceinline__ float rstd16(const float* SSQ, int r, int t) { return __builtin_amdgcn_rsqf(sum16(SSQ[(size_t)r * 16 + (t & 15)]) * (1.0f / 1024.0f) + cfg::EPS); }
__device__ __forceinline__ float rstd_row(const float* SSQ, int r) { const f32x4* p = (const f32x4*)(SSQ + (size_t)r * 16); const f32x4 a = p[0], b = p[1], c = p[2], d = p[3];
    const float s = ((a[0] + a[1]) + (a[2] + a[3])) + ((b[0] + b[1]) + (b[2] + b[3])) + ((c[0] + c[1]) + (c[2] + c[3])) + ((d[0] + d[1]) + (d[2] + d[3])); return __builtin_amdgcn_rsqf(s * (1.0f / 1024.0f) + cfg::EPS); }
__device__ __forceinline__ unsigned long long pk4(f32x4 v) { return (unsigned long long)pg8::cvt_pk_bf16(v[0], v[1]) | ((unsigned long long)pg8::cvt_pk_bf16(v[2], v[3]) << 32); }
__device__ __forceinline__ f32x4 up4(unsigned long long w) { const unsigned lo = (unsigned)w, hi = (unsigned)(w >> 32); return (f32x4){pg8::bf_lo(lo), pg8::bf_hi(lo), pg8::bf_lo(hi), pg8::bf_hi(hi)}; }
}
#define GAS __attribute__((address_space(1)))
#define LAS __attribute__((address_space(3)))
typedef unsigned short bf16;
typedef unsigned v4u __attribute__((ext_vector_type(4)));
typedef float f32x4 __attribute__((ext_vector_type(4)));
typedef short bf16x8 __attribute__((ext_vector_type(8)));
typedef GAS unsigned gu32;
typedef GAS unsigned long long gu64;
#define RLX_AGENT __ATOMIC_RELAXED, __HIP_MEMORY_SCOPE_AGENT
#define LDS_WAIT() asm volatile("s_waitcnt lgkmcnt(0)" ::: "memory")
#define VM_WAIT() asm volatile("s_waitcnt vmcnt(0)" ::: "memory")
__device__ __forceinline__ unsigned long long rt() { return __builtin_amdgcn_s_memrealtime(); }
__device__ __forceinline__ unsigned f2bf(float f) { unsigned u = __builtin_bit_cast(unsigned, f); return (u + 0x7fffu + ((u >> 16) & 1u)) >> 16; }
__device__ __forceinline__ unsigned pk2(float lo, float hi) { return f2bf(lo) | (f2bf(hi) << 16); }
#define XB_TMO      128
#define XB_XCNT(j)  (256  + 64 * (j))
#define XB_XSUB(j)  (1280 + 64 * (j))
#define XB_XGEN(j)  (2304 + 64 * (j))
#define XB_TOP      3328
#define XB_TOPGEN   3392
#define XCD_BAR_WORDS 3456
#define XB_SPIN_CAP (1u << 18)

__device__ __forceinline__ unsigned xb_ld(unsigned* p)              { return __hip_atomic_load(p, __ATOMIC_RELAXED, __HIP_MEMORY_SCOPE_AGENT); }
__device__ __forceinline__ unsigned xb_add(unsigned* p, unsigned v) { return __hip_atomic_fetch_add(p, v, __ATOMIC_RELAXED, __HIP_MEMORY_SCOPE_AGENT); }
__device__ __forceinline__ unsigned xb_xcc_id() { return (unsigned)__builtin_amdgcn_s_getreg((3 << 11) | 20) & 0xFu; }
#define XB_SPIN(cond, bar) do { unsigned _sp = 0; while (cond) { __builtin_amdgcn_s_sleep(1); \
    if ((++_sp & 255u) == 0u) { if (xb_ld(&(bar)[XB_TMO])) break; if (_sp > XB_SPIN_CAP) { atomicAdd(&(bar)[XB_TMO], 1u); break; } } } } while (0)

struct XcdBarrier {
    unsigned* bar; unsigned x;
    volatile LAS unsigned* st;
};

__device__ __forceinline__ XcdBarrier xcd_barrier_post(unsigned* bar, volatile LAS unsigned* st) {
    XcdBarrier b; b.bar = bar; b.x = xb_xcc_id(); b.st = st;
    if (threadIdx.x == 0) (void)xb_add(&bar[XB_XCNT(b.x)], 1u);
    return b;
}
__device__ __forceinline__ void xcd_barrier_complete(unsigned* bar, unsigned x, unsigned& nloc, unsigned& nx) {
    const unsigned G = gridDim.x * gridDim.y * gridDim.z;
    unsigned sum, cnt, mine, sp = 0u;
    for (;;) {
        sum = 0u; cnt = 0u; mine = 0u;
#pragma unroll
        for (unsigned j = 0; j < 16; ++j) { const unsigned c = xb_ld(&bar[XB_XCNT(j)]); sum += c; cnt += (c > 0u) ? 1u : 0u; mine = (j == x) ? c : mine; }
        if (sum == G) break;
        __builtin_amdgcn_s_sleep(1);
        if ((++sp & 255u) == 0u) { if (xb_ld(&bar[XB_TMO])) break; if (sp > XB_SPIN_CAP) { atomicAdd(&bar[XB_TMO], 1u); break; } }
    }
    nloc = mine > 0u ? mine : 1u; nx = cnt > 0u ? cnt : 1u;
}

__device__ __forceinline__ void xcd_barrier(const XcdBarrier& b) {
    asm volatile("s_waitcnt vmcnt(0)" ::: "memory");
    __syncthreads();
    if (threadIdx.x == 0) {
        unsigned* bar = b.bar;
        __builtin_amdgcn_s_waitcnt(0);
        unsigned nloc = b.st[0], nx = b.st[1];
        if (nloc == 0u) { xcd_barrier_complete(bar, b.x, nloc, nx); b.st[0] = nloc; b.st[1] = nx; }
        const unsigned old = xb_add(&bar[XB_XSUB(b.x)], 1u);
        const unsigned gen = old / nloc;
        if (old + 1u == (gen + 1u) * nloc) {
            __builtin_amdgcn_fence(__ATOMIC_RELEASE, "agent");
            asm volatile("s_waitcnt vmcnt(0)" ::: "memory");
            const unsigned og = xb_add(&bar[XB_TOP], 1u);
            const unsigned tg = og / nx;
            if (og + 1u == (tg + 1u) * nx) xb_add(&bar[XB_TOPGEN], 1u);
            else XB_SPIN(xb_ld(&bar[XB_TOPGEN]) == tg, bar);
            __builtin_amdgcn_fence(__ATOMIC_ACQUIRE, "agent");
            xb_add(&bar[XB_XGEN(b.x)], 1u);
            asm volatile("s_waitcnt vmcnt(0)" ::: "memory");
        } else {
            XB_SPIN(xb_ld(&bar[XB_XGEN(b.x)]) == gen, bar);
            __builtin_amdgcn_fence(__ATOMIC_ACQUIRE, "agent");
            asm volatile("s_waitcnt vmcnt(0)" ::: "memory");
        }
    }
    __syncthreads();
}
__device__ __forceinline__ float wave_sum(float v) {
#pragma unroll
    for (int o = 1; o < 64; o <<= 1) v += __shfl_xor(v, o);
    return v;
}
__device__ __forceinline__ void p0_transpose_item(const float* W, int K, int N, bf16* WT, int row_off, LAS float* scr, int item, int lane) {
    const int nblk = N / 32, kb = item / nblk, nb = item % nblk, k0 = 64 * kb, n0 = 32 * nb;
    float tv[32];
#pragma unroll
    for (int i = 0; i < 32; ++i) { const int kk = 2 * i + (lane >> 5); tv[i] = __builtin_nontemporal_load(W + (size_t)(k0 + kk) * N + n0 + (lane & 31)); }
#pragma unroll
    for (int i = 0; i < 32; ++i) { const int kk = 2 * i + (lane >> 5); scr[kk * 33 + (lane & 31)] = tv[i]; }
    LDS_WAIT(); asm volatile("" ::: "memory");
    const int c = lane & 7;
#pragma unroll
    for (int j = 0; j < 4; ++j) { const int n = (lane >> 3) + 8 * j; const LAS float* s = scr + (8 * c) * 33 + n;
        v4u o; o.x = pk2(s[0 * 33], s[1 * 33]); o.y = pk2(s[2 * 33], s[3 * 33]); o.z = pk2(s[4 * 33], s[5 * 33]); o.w = pk2(s[6 * 33], s[7 * 33]);
        *(GAS v4u*)(WT + (size_t)(row_off + n0 + n) * K + k0 + 8 * c) = o; }
    LDS_WAIT(); asm volatile("" ::: "memory");
}

struct P0T { const float* W; bf16* WT; int K, N, item; };
__device__ __forceinline__ void p0_t_load(const P0T& t, int lane, float (&tv)[32]) {
    const int nblk = t.N / 32, kb = t.item / nblk, nb = t.item % nblk, k0 = 64 * kb, n0 = 32 * nb;
#pragma unroll
    for (int i = 0; i < 32; ++i) { const int kk = 2 * i + (lane >> 5); tv[i] = __builtin_nontemporal_load(t.W + (size_t)(k0 + kk) * t.N + n0 + (lane & 31)); }
}
__device__ __forceinline__ void p0_t_finish(const P0T& t, LAS float* scr, int lane, const float (&tv)[32]) {
    const int nblk = t.N / 32, kb = t.item / nblk, nb = t.item % nblk, k0 = 64 * kb, n0 = 32 * nb;
#pragma unroll
    for (int i = 0; i < 32; ++i) { const int kk = 2 * i + (lane >> 5); scr[kk * 33 + (lane & 31)] = tv[i]; }
    LDS_WAIT(); asm volatile("" ::: "memory");
    const int c = lane & 7;
#pragma unroll
    for (int j = 0; j < 4; ++j) { const int n = (lane >> 3) + 8 * j; const LAS float* s = scr + (8 * c) * 33 + n;
        v4u o; o.x = pk2(s[0 * 33], s[1 * 33]); o.y = pk2(s[2 * 33], s[3 * 33]); o.z = pk2(s[4 * 33], s[5 * 33]); o.w = pk2(s[6 * 33], s[7 * 33]);
        *(GAS v4u*)(t.WT + (size_t)(n0 + n) * t.K + k0 + 8 * c) = o; }
    LDS_WAIT(); asm volatile("" ::: "memory");
}
constexpr int NWAVES = 8;
#ifndef GROUP_BAR
#define GROUP_BAR 1
#endif
using namespace cfg;
constexpr size_t MiB = 1u << 20;
constexpr size_t WS_CTL = 0, CTL_ZERO_BYTES = MiB / 4;
constexpr size_t WS_WIN = 2 * MiB, WS_WEFF = 10 * MiB, WS_WSB = 11 * MiB, WS_WOUT = 12 * MiB, WS_WUP = 14 * MiB, WS_WDOWN = 22 * MiB, WS_WPG = 30 * MiB, WS_WPP = 32 * MiB;
constexpr size_t WS_SSQ1 = 33 * MiB, WS_SSQ2 = 35 * MiB, WS_SSQ3 = 37 * MiB;
constexpr size_t WS_PB = 40 * MiB;
constexpr size_t WS_XN = 49 * MiB;
constexpr size_t WS_BIG = 82 * MiB;
#ifndef LAYOUT_V085
#define LAYOUT_V085 0
#endif
#if LAYOUT_V085
constexpr size_t ARENA = 0, HM = MiB / 2;
constexpr size_t AR_U = 0, AR_Q = 16 * MiB + HM, AR_K = 33 * MiB, AR_V = 49 * MiB + HM, AR_G = 66 * MiB, AR_Y = 132 * MiB, AR_YSB = 148 * MiB + HM, AR_MG = 0, AR_H = 0, AR_PP = 0;
constexpr size_t WS_S = WS_BIG, SR_U = AR_U, SR_Q = AR_Q, SR_K = AR_K, SR_V = AR_V, SR_G = AR_G, SR_Y = AR_Y, SR_YSB = AR_YSB, SR_MG = AR_MG, SR_H = AR_H, SR_XN1 = 0, SR_XN2 = 0;
constexpr size_t WS_X = WS_BIG + AR_Y, WS_END = WS_BIG + 165 * MiB;
#else
constexpr int NRG = 2048;
constexpr size_t ARK = (size_t)NRG * 1024;
constexpr size_t AR_U = 0, AR_Q = ARK, AR_K = 2 * ARK, AR_V = 3 * ARK, AR_G = 4 * ARK  , AR_Y = 6 * ARK, AR_YSB = 7 * ARK, ARENA = 8 * ARK;
constexpr size_t AR_MG = 0;
constexpr size_t AR_H = 0;
constexpr size_t AR_PP = 0;
constexpr size_t WS_X = WS_BIG + 8 * ARENA;
constexpr size_t WS_S = WS_X + 33 * MiB;
constexpr size_t SR_U = 0, SR_Q = 512 * 1024, SR_K = 2 * 512 * 1024, SR_V = 3 * 512 * 1024, SR_G = 4 * 512 * 1024  , SR_Y = 6 * 512 * 1024, SR_YSB = 7 * 512 * 1024,
                 SR_MG = 8 * 512 * 1024  , SR_H = 10 * 512 * 1024  , SR_XN1 = 18 * 512 * 1024  , SR_XN2 = 20 * 512 * 1024  , SR_END = 22 * 512 * 1024;
constexpr size_t WS_END = WS_S + SR_END;
#endif
static_assert((size_t)MT * 1024 * 2 == 33 * MiB && (size_t)MT * 16 * 4 <= 2 * MiB && (size_t)MT * 256 * 2 <= 9 * MiB && WS_END <= 256 * MiB && ARENA % 16 == 0, "d_ws map");
constexpr int CW_BAR = 4096, CW_FIN = 8192  , CW_FINS = 16384  , CW_XCC = 20480  , CW_GRP = 24576  , CW_SC = 28672  ;
static_assert((CW_SC + 64 * 16 * 7) * 4 <= (int)CTL_ZERO_BYTES, "control words inside the memset region");
constexpr size_t O_Y = 0, O_KP = 17301504, O_VP = 25690112, O_POOLP = 34078720, O_KS = 34140160, O_VS = 34402304, O_POOLS = 34664448, O_END = 34787328;
constexpr int RING_OFF = 0, RING_BYTES = 131072, LDSCTL_OFF = RING_BYTES, MISC_OFF = LDSCTL_OFF + 320, LDS_BYTES = 147456;
static_assert(sk::LDS_BYTES <= RING_BYTES && sba::LDS_BYTES <= RING_BYTES, "phase scratch fits the ring region");

struct Args { const float* in[22]; float* out; unsigned char* ws; };

#if LAYOUT_V085
__device__ __forceinline__ unsigned char* effp(unsigned char* ws, size_t aoff, int pitchB, int g) { return ws + WS_BIG + aoff; }
__device__ __forceinline__ unsigned char* effs(unsigned char* ws, size_t soff, int pitchB) { return ws + WS_BIG + soff; }
#else
__device__ __forceinline__ unsigned char* effp(unsigned char* ws, size_t aoff, int pitchB, int g) { return ws + WS_BIG + (size_t)g * ARENA + aoff - (size_t)(2048 * g) * (size_t)pitchB; }
__device__ __forceinline__ unsigned char* effs(unsigned char* ws, size_t soff, int pitchB) { return ws + WS_S + soff - (size_t)MP * (size_t)pitchB; }
#endif
#ifndef DBG_NOWT
#define DBG_NOWT 0
#endif
__device__ __forceinline__ void st8_wt(void* p, unsigned long long v) { if (DBG_NOWT) *(GAS unsigned long long*)p = v; else __hip_atomic_store((unsigned long long*)p, v, __ATOMIC_RELAXED, __HIP_MEMORY_SCOPE_AGENT); }
__device__ __forceinline__ void st4_wt(void* p, unsigned v) { if (DBG_NOWT) *(GAS unsigned*)p = v; else __hip_atomic_store((unsigned*)p, v, __ATOMIC_RELAXED, __HIP_MEMORY_SCOPE_AGENT); }
__device__ __forceinline__ void stf_wt(float* p, float v) { if (DBG_NOWT) *(GAS float*)p = v; else __hip_atomic_store(p, v, __ATOMIC_RELAXED, __HIP_MEMORY_SCOPE_AGENT); }
#ifndef DBG_NOPS
#define DBG_NOPS 0
#endif
#define DBG_STR2(x) #x
#define DBG_STR(x) DBG_STR2(x)
#ifndef P0_TN
#define P0_TN 2
#endif
#ifndef P0_RN
#define P0_RN 4
#endif
#ifndef GRP_L2_ATOMICS
#define GRP_L2_ATOMICS 1
#endif
#ifndef CHAIN_FENCE
#define CHAIN_FENCE 0
#endif
#ifndef DBG_NOCHAIN
#define DBG_NOCHAIN 0
#endif
__device__ __forceinline__ void chain_post_wave(gu32* ctl, int s, int rb) {
    if (DBG_NOCHAIN == 1) return;
    asm volatile("s_waitcnt vmcnt(0)" ::: "memory");
    if ((threadIdx.x & 63) == 0) __hip_atomic_fetch_add((unsigned*)(ctl + CW_SC + 64 * (16 * s + rb)), 1u, __ATOMIC_RELAXED, __HIP_MEMORY_SCOPE_AGENT);
}
struct PostHook { gu32* ctl; int s, rb; bool on;
    __device__ __forceinline__ void operator()(int ui) const { if (on && ui == 0) chain_post_wave(ctl, s, rb); } };
__device__ __forceinline__ void chain_wait_wave(gu32* ctl, int s, int rb, unsigned target) {
    if (DBG_NOCHAIN == 1 || (DBG_NOCHAIN == 3 && s >= 3)) return;
    unsigned spins = 0;
    while ((unsigned)__builtin_amdgcn_readfirstlane(__hip_atomic_load((unsigned*)(ctl + CW_SC + 64 * (16 * s + rb)), __ATOMIC_RELAXED, __HIP_MEMORY_SCOPE_AGENT)) < target) { __builtin_amdgcn_s_sleep(2); if (++spins > (1u << 18)) break; }
    if (CHAIN_FENCE) { __builtin_amdgcn_fence(__ATOMIC_ACQUIRE, "agent"); asm volatile("s_waitcnt vmcnt(0)" ::: "memory"); }
}
__device__ __forceinline__ void chain_wait(gu32* ctl, int s, int rb, unsigned target) {
    if (threadIdx.x < 64) chain_wait_wave(ctl, s, rb, target);
    __syncthreads();
}

template <int NR>
__device__ __forceinline__ void rms_rows_to_bf16(const float* const (&xrow)[NR], const f32x4 (&gg)[4], bf16* const (&orow)[NR], int lane) {
    f32x4 v[NR][4]; float s[NR];
#pragma unroll
    for (int i = 0; i < NR; ++i) { const GAS f32x4* xr = (const GAS f32x4*)(xrow[i] ? xrow[i] : xrow[0]) + lane;
#pragma unroll
        for (int j = 0; j < 4; ++j) v[i][j] = __builtin_nontemporal_load(xr + 64 * j); }
#pragma unroll
    for (int i = 0; i < NR; ++i) { s[i] = 0.f;
#pragma unroll
        for (int j = 0; j < 4; ++j) s[i] += (v[i][j].x * v[i][j].x + v[i][j].y * v[i][j].y) + (v[i][j].z * v[i][j].z + v[i][j].w * v[i][j].w); }
#pragma unroll
    for (int o = 1; o < 64; o <<= 1)
#pragma unroll
        for (int i = 0; i < NR; ++i) s[i] += __shfl_xor(s[i], o);
#pragma unroll
    for (int i = 0; i < NR; ++i) { const float rs = 1.f / sqrtf(s[i] * (1.f / DM) + EPS);
        if (xrow[i]) { GAS unsigned long long* o0 = (GAS unsigned long long*)orow[i] + lane;
#pragma unroll
            for (int j = 0; j < 4; ++j) o0[64 * j] = (unsigned long long)pk2(v[i][j].x * rs * gg[j].x, v[i][j].y * rs * gg[j].y) | ((unsigned long long)pk2(v[i][j].z * rs * gg[j].z, v[i][j].w * rs * gg[j].w) << 32); } }
}
__device__ __forceinline__ void weff_item(const float* wgrp, const float* scale, const float* wpu, bf16* WT, int item, int lane) {
    const int nb = item & 15, cb = (item >> 4) & 15, g = item >> 8, n = nb * 64 + lane;
    float wg[8][2];
#pragma unroll
    for (int cc = 0; cc < 8; ++cc)
#pragma unroll
        for (int hh = 0; hh < 2; ++hh) wg[cc][hh] = wgrp[((size_t)(g * 128 + cb * 8 + cc)) * 128 + lane + 64 * hh] * scale[g * 128 + lane + 64 * hh];
    float acc[8];
#pragma unroll
    for (int cc = 0; cc < 8; ++cc) acc[cc] = 0.f;
#pragma unroll
    for (int hh = 0; hh < 2; ++hh)
#pragma unroll 16
        for (int d2 = 0; d2 < 64; ++d2) { const float wv = wpu[(size_t)(g * 128 + hh * 64 + d2) * 1024 + n];
#pragma unroll
            for (int cc = 0; cc < 8; ++cc) acc[cc] = fmaf(__builtin_bit_cast(float, __builtin_amdgcn_readlane(__builtin_bit_cast(int, wg[cc][hh]), d2)), wv, acc[cc]); }
    v4u o; o.x = pk2(acc[0], acc[1]); o.y = pk2(acc[2], acc[3]); o.z = pk2(acc[4], acc[5]); o.w = pk2(acc[6], acc[7]);
    *(GAS v4u*)(WT + (size_t)n * 512 + g * 128 + cb * 8) = o;
}
template <int W, int R, bool WT>
__device__ __forceinline__ void pool_run(const bf16* Ub, const float* state_pool, bf16* Yb, int r0, int c, bool sample, int t0, int b_) {
    v4u rw[R - 1 + W];
#pragma unroll
    for (int k = 0; k < W - 1; ++k) { const int pos = t0 + k - (W - 1);
        if (pos >= 0) rw[k] = *(const GAS v4u*)(Ub + (size_t)(r0 - (W - 1) + k) * 512 + c);
        else if (sample) { const float* sp = state_pool + ((size_t)b_ * 15 + 15 + pos) * 512 + c; const f32x4 a = *(const GAS f32x4*)sp, b = *(const GAS f32x4*)(sp + 4); rw[k] = pg8::pack8(a, b); }
        else rw[k] = (v4u){0u, 0u, 0u, 0u}; }
#pragma unroll
    for (int k = W - 1; k < R - 1 + W; ++k) rw[k] = *(const GAS v4u*)(Ub + (size_t)(r0 - (W - 1) + k) * 512 + c);
    f32x4 s0 = {0.f, 0.f, 0.f, 0.f}, s1 = {0.f, 0.f, 0.f, 0.f};
#pragma unroll
    for (int k = 0; k < W - 1; ++k) { f32x4 a, b; pg8::unpack8(rw[k], a, b); s0 += a; s1 += b; }
#pragma unroll
    for (int i = 0; i < R; ++i) { f32x4 a, b, u0, u1; pg8::unpack8(rw[W - 1 + i], u0, u1); s0 += u0; s1 += u1;
        const int cnt = sample ? W : ((t0 + i + 1 < W) ? t0 + i + 1 : W); const float ic = 1.0f / (float)cnt;
        { const v4u yv = pg8::pack8(s0 * ic - u0, s1 * ic - u1);
          if (WT) { st8_wt(Yb + (size_t)(r0 + i) * 512 + c, (unsigned long long)yv.x | ((unsigned long long)yv.y << 32)); st8_wt(Yb + (size_t)(r0 + i) * 512 + c + 4, (unsigned long long)yv.z | ((unsigned long long)yv.w << 32)); }
          else *(GAS v4u*)(Yb + (size_t)(r0 + i) * 512 + c) = yv; }
        pg8::unpack8(rw[i], a, b); s0 -= a; s1 -= b; }
}
template <bool WT>
__device__ __forceinline__ void pool_item(int cg, const bf16* Ub, const float* state_pool, bf16* Yb, int r0, int c, bool sample, int t0, int b_) {
    if (cg == 0) pool_run<2, 16, WT>(Ub, state_pool, Yb, r0, c, sample, t0, b_); else if (cg == 1) pool_run<4, 16, WT>(Ub, state_pool, Yb, r0, c, sample, t0, b_); else if (cg == 2) pool_run<8, 16, WT>(Ub, state_pool, Yb, r0, c, sample, t0, b_);
    else { pool_run<16, 8, WT>(Ub, state_pool, Yb, r0, c, sample, t0, b_); asm volatile("" ::: "memory"); pool_run<16, 8, WT>(Ub, state_pool, Yb, r0 + 8, c, sample, t0 + 8, b_); }
}

__device__ __forceinline__ unsigned l2_add_ret(unsigned* p, unsigned v) {
    unsigned r;
    asm volatile("global_atomic_add %0, %1, %2, off sc0\n\ts_waitcnt vmcnt(0)" : "=&v"(r) : "v"(p), "v"(v) : "memory");
    return r;
}
__device__ __forceinline__ void grp_barrier(unsigned* cnt, unsigned members, volatile LAS unsigned* round_word, bool raw) {
    if (raw) { asm volatile("s_waitcnt lgkmcnt(0)" ::: "memory"); __builtin_amdgcn_s_barrier(); }
    else { asm volatile("s_waitcnt vmcnt(0)" ::: "memory");
           __syncthreads(); }
    if (threadIdx.x == 0) {
        const unsigned round = round_word[0] + 1u; round_word[0] = round;
#if GRP_L2_ATOMICS
        __hip_atomic_fetch_add(cnt, 1u, __ATOMIC_RELAXED, __HIP_MEMORY_SCOPE_WORKGROUP);
        unsigned spins = 0;
        const unsigned base = round_word[1];
        while (l2_add_ret(cnt, 0u) - base < members * round) { __builtin_amdgcn_s_sleep(1); if (++spins > (1u << 20)) break; }
#else
        __hip_atomic_fetch_add(cnt, 1u, __ATOMIC_RELAXED, __HIP_MEMORY_SCOPE_AGENT);
        unsigned spins = 0;
        while (__hip_atomic_load(cnt, __ATOMIC_RELAXED, __HIP_MEMORY_SCOPE_AGENT) < members * round) { __builtin_amdgcn_s_sleep(1); if (++spins > (1u << 20)) break; }
#endif
        __builtin_amdgcn_fence(__ATOMIC_ACQUIRE, "agent");
        asm volatile("s_waitcnt vmcnt(0)" ::: "memory");
    }
    __syncthreads();
}

__global__ void __launch_bounds__(NWAVES * 64, 2) mega_fwd(Args args) {
    extern __shared__ __attribute__((aligned(16))) unsigned char lds[];
    LAS unsigned char* L = (LAS unsigned char*)lds;
    volatile LAS unsigned* MISC = (volatile LAS unsigned*)(L + MISC_OFF);
    const int wave = __builtin_amdgcn_readfirstlane(threadIdx.x >> 6);
#define FRESH_TID() int tid = threadIdx.x; asm volatile("" : "+v"(tid)); const int lane = tid & 63; (void)lane
    const int G = gridDim.x, bx = blockIdx.x, vcu = (bx % 8) * (G / 8) + bx / 8;
    const int grp = vcu >> 5, gi = vcu & 31;
    unsigned char* ws = args.ws;
    gu32* ctl = (gu32*)(ws + WS_CTL);
    const float* x_p = args.in[0]; const float* x_s = args.in[1]; const float* cache_k = args.in[2]; const float* cache_v = args.in[3]; const float* state_pool = args.in[4];
    const float* p_p = args.in[5]; const float* p_s = args.in[6]; const float* g_mix = args.in[7]; const float* w_in = args.in[8]; const float* b_gate = args.in[9]; const float* w_grp = args.in[10];
    const float* pool_scale = args.in[11]; const float* w_pool_up = args.in[12]; const float* w_sb_up = args.in[13]; const float* w_out = args.in[14]; const float* g_mlp = args.in[15];
    const float* w_up = args.in[16]; const float* w_down = args.in[17]; const float* g_ple = args.in[18]; const float* w_ple_gate = args.in[19]; const float* w_ple_proj = args.in[20]; const float* g_final = args.in[21];
    float* out = args.out; float* Yo = out + O_Y;
    bf16 *WIN = (bf16*)(ws + WS_WIN), *WEFF = (bf16*)(ws + WS_WEFF), *WSB = (bf16*)(ws + WS_WSB), *WOUT = (bf16*)(ws + WS_WOUT), *WUP = (bf16*)(ws + WS_WUP), *WDOWN = (bf16*)(ws + WS_WDOWN), *WPG = (bf16*)(ws + WS_WPG), *WPP = (bf16*)(ws + WS_WPP);
    float *SSQ1 = (float*)(ws + WS_SSQ1), *SSQ2 = (float*)(ws + WS_SSQ2), *SSQ3 = (float*)(ws + WS_SSQ3);
    bf16 *PB = (bf16*)(ws + WS_PB), *XN = (bf16*)(ws + WS_XN), *XB = (bf16*)(ws + WS_X);
    const int srb = vcu & 15, scb = vcu >> 4;
#define PV(aoff, pitchB) ((bf16*)effp(ws, aoff, pitchB, g_))
#define SV(soff, pitchB) ((bf16*)effs(ws, soff, pitchB))
#define OPQ() int g_ = grp, r_ = srb; asm volatile("" : "+s"(g_), "+s"(r_))

#if DBG_NOPS
    asm volatile(".rept " DBG_STR(DBG_NOPS) "\n\ts_nop 0\n\t.endr" ::: "memory");
#endif
    for (int i = threadIdx.x; i < (LDS_BYTES - LDSCTL_OFF) / 4; i += NWAVES * 64) ((LAS unsigned*)(L + LDSCTL_OFF))[i] = 0u;
    __syncthreads();
    if (GRP_L2_ATOMICS && threadIdx.x == 0) MISC[13] = l2_add_ret((unsigned*)(ctl + CW_GRP + 64 * grp), 0u);
    XcdBarrier bar = xcd_barrier_post((unsigned*)(ctl + CW_BAR), MISC + 8);
    if (threadIdx.x == 0) __hip_atomic_fetch_add((unsigned*)(ctl + CW_XCC + 16 * grp + (int)(bar.x & 15u)), 1u, __ATOMIC_RELAXED, __HIP_MEMORY_SCOPE_AGENT);
    const int gw = vcu * NWAVES + wave, NGW = G * NWAVES;
    const bool late_ = (vcu & 1) != 0;

    {
        FRESH_TID();
        LAS float* scr = (LAS float*)(L + RING_OFF + wave * 16384);
        constexpr int I_IN = (DM / 64) * (INW / 32), I_SB = (SBW / 64) * (DM / 32), I_OUT = (DM / 64) * (DM / 32), I_UP = (DM / 64) * (DFF / 32), I_DOWN = (DFF / 64) * (DM / 32), I_PG = I_OUT, I_PP = (PLE / 64) * (DM / 32), I_EFF = 4 * 16 * 16;
        constexpr int NITEMS = I_IN + I_SB + I_OUT + I_UP + I_DOWN + I_PG + I_PP + I_EFF;
        for (int it = gw; it < I_EFF; it += NGW) weff_item(w_grp, pool_scale, w_pool_up, WEFF, it, lane);
        constexpr int NT = NITEMS - I_EFF;
        auto decode = [&](int r) -> P0T {
            if (r < I_IN) return P0T{w_in, WIN, DM, INW, r}; r -= I_IN;
            if (r < I_SB) return P0T{w_sb_up, WSB, SBW, DM, r}; r -= I_SB;
            if (r < I_OUT) return P0T{w_out, WOUT, DM, DM, r}; r -= I_OUT;
            if (r < I_UP) return P0T{w_up, WUP, DM, DFF, r}; r -= I_UP;
            if (r < I_DOWN) return P0T{w_down, WDOWN, DFF, DM, r}; r -= I_DOWN;
            if (r < I_PG) return P0T{w_ple_gate, WPG, DM, DM, r}; r -= I_PG;
            return P0T{w_ple_proj, WPP, PLE, DM, r}; };
#pragma unroll 1
        for (int it = NGW - 1 - gw; it < NT; it += P0_TN * NGW) {
            P0T tt[P0_TN]; float tv[P0_TN][32];
#pragma unroll
            for (int i = 0; i < P0_TN; ++i) { const int iti = it + i * NGW; tt[i] = decode(iti < NT ? iti : it); if (iti >= NT) tt[i].item = -1; }
#pragma unroll
            for (int i = 0; i < P0_TN; ++i) if (tt[i].item >= 0) p0_t_load(tt[i], lane, tv[i]);
#pragma unroll
            for (int i = 0; i < P0_TN; ++i) if (tt[i].item >= 0) p0_t_finish(tt[i], scr, lane, tv[i]);
        }
        f32x4 gg[4];
#pragma unroll
        for (int j = 0; j < 4; ++j) gg[j] = *((const GAS f32x4*)g_mix + lane + 64 * j);
#pragma unroll 1
        for (int m = gw; m < MT; m += P0_RN * NGW) {
            const float* xr[P0_RN]; bf16* orow[P0_RN]; const float* pr[P0_RN]; f32x4 pv[P0_RN];
#pragma unroll
            for (int i = 0; i < P0_RN; ++i) { const int mi = m + i * NGW; const bool ok = mi < MT;
                xr[i] = !ok ? nullptr : (mi < MP ? x_p + (size_t)mi * DM : x_s + (size_t)(mi - MP) * DM);
                pr[i] = !ok ? p_p : (mi < MP ? p_p + (size_t)mi * PLE : p_s + (size_t)(mi - MP) * PLE);
                orow[i] = XN + (size_t)(ok ? mi : m) * DM; }
#pragma unroll
            for (int i = 0; i < P0_RN; ++i) pv[i] = __builtin_nontemporal_load((const GAS f32x4*)pr[i] + lane);
            rms_rows_to_bf16<P0_RN>(xr, gg, orow, lane);
#pragma unroll
            for (int i = 0; i < P0_RN; ++i) if (xr[i]) *((GAS unsigned long long*)(PB + (size_t)(m + i * NGW) * PLE) + lane) = (unsigned long long)pk2(pv[i].x, pv[i].y) | ((unsigned long long)pk2(pv[i].z, pv[i].w) << 32);
        }
    }
    xcd_barrier(bar);
    bool fast = false;
    if (GROUP_BAR) {
        bool okg = false;
        if (threadIdx.x < 128) okg = __hip_atomic_load((unsigned*)(ctl + CW_XCC + (int)threadIdx.x), __ATOMIC_RELAXED, __HIP_MEMORY_SCOPE_AGENT) == 32u;
        const unsigned long long bm = __ballot(okg);
        if ((threadIdx.x & 63) == 0 && wave < 2) MISC[16 + wave] = (unsigned)__builtin_popcountll(bm);
        __syncthreads();
        fast = (MISC[16] + MISC[17] == 8u) && (G == 256);
    }
    unsigned* gcnt = (unsigned*)(ctl + CW_GRP + 64 * grp);
#define SEAM(RAW) do { if (fast) grp_barrier(gcnt, 32u, MISC + 12, (RAW)); else xcd_barrier(bar); } while (0)
#define LATE_POST(S) do { if (late_) chain_post_wave(ctl, (S), srb); } while (0)

#pragma unroll 1
    for (int pass_ = 0; pass_ < 2; ++pass_) { OPQ(); if ((pass_ == 1) == late_) {
        { const int col0 = scb * 256; f32x4 vv[2][2];
            sk::tile4(XN, WIN, DM, (size_t)MP + srb * 32, col0, (SK_LAS char*)(L + RING_OFF), vv);
            int t_raw_ = threadIdx.x; asm volatile("" : "+v"(t_raw_)); const int t = t_raw_, rs = srb * 32 + (t >> 4), r = MP + rs;
#pragma unroll
            for (int h = 0; h < 2; ++h)
#pragma unroll
                for (int q = 0; q < 2; ++q) { const f32x4 v = vv[h][q]; const int c = col0 + 128 * h + 64 * q + (t & 15) * 4;
            if (c < 512) { st8_wt(SV(SR_U, 1024) + (size_t)r * 512 + c, sk::pk4(v)); const int i = rs & 31; if (i >= 17) *(GAS f32x4*)(out + O_POOLS + ((size_t)(rs >> 5) * 15 + (i - 17)) * 512 + c) = v; }
            else if (c < 1024) st8_wt(SV(SR_Q, 1024) + (size_t)r * 512 + c - 512, sk::pk4(v * QSCALE));
            else if (c < 1536) { st8_wt(SV(SR_K, 1024) + (size_t)r * 512 + c - 1024, sk::pk4(v)); *(GAS f32x4*)(out + O_KS + (size_t)rs * 512 + c - 1024) = v; }
            else if (c < 2048) { st8_wt(SV(SR_V, 1024) + (size_t)r * 512 + c - 1536, sk::pk4(v)); *(GAS f32x4*)(out + O_VS + (size_t)rs * 512 + c - 1536) = v; }
            else { const f32x4 bg = *(const GAS f32x4*)(b_gate + c - 2048); st4_wt((unsigned char*)SV(SR_G, 2048) + (size_t)r * 2048 + c - 2048, pg8::pk_u8x4(pg8::sigm4(v + bg))); } }
        }
    } else {
        pg8::Gemm g{XN, WIN, MP, INW, DM}; pg8::StaticOrder S; S.init(MP, INW, G, bx);
        pg8::EpiIn E{PV(AR_U, 1024), PV(AR_Q, 1024), PV(AR_K, 1024), PV(AR_V, 1024), PV(AR_G, 2048), b_gate, out + O_KP, out + O_VP, out + O_KS, out + O_VS, out + O_POOLP, out + O_POOLS};
        pg8::gemm_phase<pg8::EpiIn, pg8::StaticOrder, true, true, PostHook>(L + RING_OFF, g, S, E, PostHook{ctl, 1, srb, !late_});
    } }
    SEAM(late_); LATE_POST(1);
    {
        FRESH_TID(); OPQ();
        if (wave < 4) { const int wi = wave * 32 + gi, cg = wi & 3, k = lane >> 4, lrow = ((wi >> 2) * 4 + k) * 16;
            const bf16* ub = (const bf16*)(effp(ws, AR_U, 1024, g_) + (size_t)g_ * 2048 * 1024); bf16* yb = (bf16*)(effp(ws, AR_Y, 1024, g_) + (size_t)g_ * 2048 * 1024);
            pool_item<false>(cg, ub, state_pool, yb, lrow, cg * 128 + (lane & 15) * 8, false, lrow & (SEQ - 1), 0); }
        if (wave == 4 && (vcu & 7) == 0) { const int si = vcu >> 3, cg = si & 3, run4 = si >> 2, k = lane >> 4, rs = (run4 * 4 + k) * 16;
            chain_wait_wave(ctl, 1, 2 * run4, 128u); chain_wait_wave(ctl, 1, 2 * run4 + 1, 128u);
            pool_item<true>(cg, SV(SR_U, 1024), state_pool, SV(SR_Y, 1024), MP + rs, cg * 128 + (lane & 15) * 8, true, rs & 31, rs >> 5);
            asm volatile("s_waitcnt vmcnt(0)" ::: "memory");
            if (lane == 0) { __hip_atomic_fetch_add((unsigned*)(ctl + CW_SC + 64 * (16 * 2 + 2 * run4)), 1u, __ATOMIC_RELAXED, __HIP_MEMORY_SCOPE_AGENT); __hip_atomic_fetch_add((unsigned*)(ctl + CW_SC + 64 * (16 * 2 + 2 * run4 + 1)), 1u, __ATOMIC_RELAXED, __HIP_MEMORY_SCOPE_AGENT); } }
        { const sba::Tensors T{PV(AR_Q, 1024), PV(AR_K, 1024), PV(AR_V, 1024), PV(AR_YSB, 1024), cache_k, cache_v}; const int h = gi >> 2, s = gi & 3;
#pragma unroll 1
          for (int k = 0; k < 2; ++k) sba::sb_unit<false>(grp, h, k ? 7 - s : s, T, (SB_LAS char*)(L + RING_OFF)); }
        if (vcu >= 128) { const int i = 255 - vcu, rb = i >> 3, h = i & 7;
            chain_wait(ctl, 1, rb, 128u);
            const sba::Tensors T{SV(SR_Q, 1024), SV(SR_K, 1024), SV(SR_V, 1024), SV(SR_YSB, 1024), cache_k, cache_v};
            sba::sb_unit<true>(rb, h, 0, T, (SB_LAS char*)(L + RING_OFF)); }
    }
    SEAM(vcu >= 128);
    if (vcu >= 128 && wave == 0) chain_post_wave(ctl, 2, (255 - vcu) >> 3);
#pragma unroll 1
    for (int pass_ = 0; pass_ < 2; ++pass_) { OPQ(); if ((pass_ == 1) == late_) {
        { const int rb = srb, col0 = scb * 64;
            chain_wait(ctl, 2, rb, 12u);
            const f32x4 va = sk::tile(SV(SR_Y, 1024), WEFF, PW, (size_t)MP + rb * 32, col0, (SK_LAS char*)(L + RING_OFF));
            const f32x4 vb = sk::tile(SV(SR_YSB, 1024), WSB, SBW, (size_t)MP + rb * 32, col0, (SK_LAS char*)(L + RING_OFF));
            int t_raw_ = threadIdx.x; asm volatile("" : "+v"(t_raw_)); const int t = t_raw_, r = MP + rb * 32 + (t >> 4), c = col0 + (t & 15) * 4;
            const f32x4 ga = pg8::up_u8x4(*(const GAS unsigned*)((const unsigned char*)SV(SR_G, 2048) + (size_t)r * 2048 + c)), gb = pg8::up_u8x4(*(const GAS unsigned*)((const unsigned char*)SV(SR_G, 2048) + (size_t)r * 2048 + 1024 + c));
            st8_wt(SV(SR_MG, 2048) + (size_t)r * 1024 + c, sk::pk4(ga * va + gb * vb));
        }
    } else {
        pg8::Gemm g{PV(AR_Y, 1024), WEFF, MP, DM, PW, PV(AR_YSB, 1024), WSB}; pg8::PairOrder S; S.init(MP, DM, G, bx); pg8::EpiMerge E{PV(AR_G, 2048), PV(AR_MG, 2048)};
        pg8::gemm_phase<pg8::EpiMerge, pg8::PairOrder, true, true, PostHook>(L + RING_OFF, g, S, E, PostHook{ctl, 3, srb, !late_});
    } }
    SEAM(late_); LATE_POST(3);
#pragma unroll 1
    for (int pass_ = 0; pass_ < 2; ++pass_) { OPQ(); if ((pass_ == 1) == late_) {
        { const int rb = srb, col0 = scb * 64;
            chain_wait(ctl, 3, rb, 128u);
            const f32x4 v = sk::tile(SV(SR_MG, 2048), WOUT, DM, (size_t)MP + rb * 32, col0, (SK_LAS char*)(L + RING_OFF));
            int t_raw_ = threadIdx.x; asm volatile("" : "+v"(t_raw_)); const int t = t_raw_, rs = rb * 32 + (t >> 4), r = MP + rs, c = col0 + (t & 15) * 4;
            const f32x4 x1 = *(const GAS f32x4*)(x_s + (size_t)rs * DM + c) + v; st8_wt(XB + (size_t)r * DM + c, sk::pk4(x1));
            st8_wt(SV(SR_XN1, 2048) + (size_t)r * DM + c, sk::pk4(x1 * *(const GAS f32x4*)(g_mlp + c)));
            const float ss = sk::sum16(pg8::dot4(x1)); if ((t & 15) == 0) stf_wt(SSQ1 + (size_t)r * 16 + (col0 >> 6), ss);
        }
    } else {
        pg8::Gemm g{PV(AR_MG, 2048), WOUT, MP, DM, DM}; pg8::StaticOrder S; S.init(MP, DM, G, bx); pg8::EpiResid<true> E{x_p, XB, XN, g_mlp, SSQ1};
        pg8::gemm_phase<pg8::EpiResid<true>, pg8::StaticOrder, true, true, PostHook>(L + RING_OFF, g, S, E, PostHook{ctl, 4, srb, !late_});
    } }
    SEAM(late_); LATE_POST(4);
#pragma unroll 1
    for (int pass_ = 0; pass_ < 2; ++pass_) { OPQ(); if ((pass_ == 1) == late_) {
        { const int rb = srb, col0 = scb * 256; f32x4 vv[2][2];
            chain_wait(ctl, 4, rb, 128u);
            sk::tile4(SV(SR_XN1, 2048), WUP, DM, (size_t)MP + rb * 32, col0, (SK_LAS char*)(L + RING_OFF), vv);
            int t_raw_ = threadIdx.x; asm volatile("" : "+v"(t_raw_)); const int t = t_raw_, r = MP + rb * 32 + (t >> 4); const float rs_ = sk::rstd16(SSQ1, r, t);
#pragma unroll
            for (int h = 0; h < 2; ++h)
#pragma unroll
                for (int q = 0; q < 2; ++q) { const int c = col0 + 128 * h + 64 * q + (t & 15) * 4; const f32x4 a = __builtin_elementwise_max(vv[h][q] * rs_, (f32x4){0.f, 0.f, 0.f, 0.f});
                    st8_wt(SV(SR_H, 8192) + (size_t)r * DFF + c, sk::pk4(a * a)); }
        }
    } else {
        pg8::Gemm g{XN, WUP, MP, DFF, DM}; pg8::StaticOrder S; S.init(MP, DFF, G, bx); pg8::EpiUp E{SSQ1, PV(AR_H, 8192)};
        pg8::gemm_phase<pg8::EpiUp, pg8::StaticOrder, true, true, PostHook>(L + RING_OFF, g, S, E, PostHook{ctl, 5, srb, !late_});
    } }
    SEAM(late_); LATE_POST(5);
#pragma unroll 1
    for (int pass_ = 0; pass_ < 2; ++pass_) { OPQ(); if ((pass_ == 1) == late_) {
        { const int rb = srb, col0 = scb * 64;
            chain_wait(ctl, 5, rb, 128u);
            const f32x4 v = sk::tile(SV(SR_H, 8192), WDOWN, DFF, (size_t)MP + rb * 32, col0, (SK_LAS char*)(L + RING_OFF));
            int t_raw_ = threadIdx.x; asm volatile("" : "+v"(t_raw_)); const int t = t_raw_, r = MP + rb * 32 + (t >> 4), c = col0 + (t & 15) * 4;
            const f32x4 x2 = sk::up4(*(const GAS unsigned long long*)(XB + (size_t)r * DM + c)) + v; st8_wt(XB + (size_t)r * DM + c, sk::pk4(x2));
            st8_wt(SV(SR_XN2, 2048) + (size_t)r * DM + c, sk::pk4(x2 * *(const GAS f32x4*)(g_ple + c)));
            const float ss = sk::sum16(pg8::dot4(x2)); if ((t & 15) == 0) stf_wt(SSQ2 + (size_t)r * 16 + (col0 >> 6), ss);
        }
    } else {
        pg8::Gemm g{PV(AR_H, 8192), WDOWN, MP, DM, DFF}; pg8::StaticOrder S; S.init(MP, DM, G, bx); pg8::EpiResid<false> E{nullptr, XB, XN, g_ple, SSQ2};
        pg8::gemm_phase<pg8::EpiResid<false>, pg8::StaticOrder, true, true, PostHook>(L + RING_OFF, g, S, E, PostHook{ctl, 6, srb, !late_});
    } }
    SEAM(late_); LATE_POST(6);
#pragma unroll 1
    for (int pass_ = 0; pass_ < 2; ++pass_) { OPQ(); if ((pass_ == 1) == late_) {
        { const int rb = srb, col0 = scb * 64;
            chain_wait(ctl, 6, rb, 128u);
            const f32x4 vp = sk::tile(PB, WPP, PLE, (size_t)MP + rb * 32, col0, (SK_LAS char*)(L + RING_OFF));
            const f32x4 vg = sk::tile(SV(SR_XN2, 2048), WPG, DM, (size_t)MP + rb * 32, col0, (SK_LAS char*)(L + RING_OFF));
            int t_raw_ = threadIdx.x; asm volatile("" : "+v"(t_raw_)); const int t = t_raw_, r = MP + rb * 32 + (t >> 4), c = col0 + (t & 15) * 4;
            const float rs_ = sk::rstd16(SSQ2, r, t);
            const f32x4 x3 = sk::up4(*(const GAS unsigned long long*)(XB + (size_t)r * DM + c)) + pg8::sigm4(vg * rs_) * vp;
            const float ss = sk::sum16(pg8::dot4(x3)); if ((t & 15) == 0) __hip_atomic_store(SSQ3 + (size_t)r * 16 + (col0 >> 6), ss, __ATOMIC_RELAXED, __HIP_MEMORY_SCOPE_AGENT);
            asm volatile("s_waitcnt vmcnt(0)" ::: "memory");
            unsigned* cw = (unsigned*)(ctl + CW_FINS + 64 * rb);
            if ((t & 63) == 0) __hip_atomic_fetch_add(cw, 1u, __ATOMIC_RELAXED, __HIP_MEMORY_SCOPE_AGENT);
            { unsigned spins = 0; while ((unsigned)__builtin_amdgcn_readfirstlane(__hip_atomic_load(cw, __ATOMIC_RELAXED, __HIP_MEMORY_SCOPE_AGENT)) < 128u) { __builtin_amdgcn_s_sleep(2); if (++spins > (1u << 16)) break; } }
            const float r3 = __builtin_amdgcn_rsqf(sk::sum16(__hip_atomic_load(SSQ3 + (size_t)r * 16 + (t & 15), __ATOMIC_RELAXED, __HIP_MEMORY_SCOPE_AGENT)) * (1.0f / 1024.0f) + EPS);
            *(GAS f32x4*)(Yo + (size_t)r * DM + c) = x3 * r3 * *(const GAS f32x4*)(g_final + c);
        }
    } else {
        { pg8::Gemm g{PB, WPP, MP, DM, PLE}; pg8::StaticOrder S; S.init(MP, DM, G, bx); pg8::EpiPP E{PV(AR_PP, 2048)};
          pg8::gemm_phase<pg8::EpiPP, pg8::StaticOrder, true, true>(L + RING_OFF, g, S, E); }
        { pg8::Gemm g{XN, WPG, MP, DM, DM}; pg8::StaticOrder S; S.init(MP, DM, G, bx); pg8::EpiPleFinal E{SSQ2, PV(AR_PP, 2048), XB, Yo, SSQ3, g_final, (unsigned*)(ctl + CW_FIN)};
          pg8::gemm_phase<pg8::EpiPleFinal, pg8::StaticOrder, true, true>(L + RING_OFF, g, S, E); }
    } }
#undef SEAM
#undef LATE_POST
#undef PV
#undef SV
#undef OPQ
#undef FRESH_TID
}

extern "C" void kernel_launch(void* const* d_in, const int* in_sizes, int n_in, void* d_out, int out_size, void* d_ws, size_t ws_size, hipStream_t stream) {
    static int grid = 0;
    if (grid == 0) {
        if (n_in != 22 || out_size != (int)O_END || ws_size < WS_END) { fprintf(stderr, "kernel_launch: unexpected sizes: n_in %d out %d ws %zu\n", n_in, out_size, ws_size); grid = -1; return; }
        int dev = 0, cus = 0, per_cu = 0;
        if (hipGetDevice(&dev) != hipSuccess || hipDeviceGetAttribute(&cus, hipDeviceAttributeMultiprocessorCount, dev) != hipSuccess) { grid = -1; return; }
        if (hipFuncSetAttribute((const void*)mega_fwd, hipFuncAttributeMaxDynamicSharedMemorySize, LDS_BYTES) != hipSuccess) { fprintf(stderr, "kernel_launch: hipFuncSetAttribute failed\n"); grid = -1; return; }
        if (hipOccupancyMaxActiveBlocksPerMultiprocessor(&per_cu, (const void*)mega_fwd, NWAVES * 64, LDS_BYTES) != hipSuccess || per_cu < 1) { fprintf(stderr, "kernel_launch: occupancy query says %d\n", per_cu); (void)hipGetLastError(); }
        if (cus != 256) { fprintf(stderr, "kernel_launch: built for a 256-CU device (one workgroup per CU, 8 groups of 32); found %d CUs\n", cus); grid = -1; return; }
        grid = cus;
    }
    if (grid < 0) return;
    (void)hipMemsetAsync((char*)d_ws + WS_CTL, 0, CTL_ZERO_BYTES, stream);
    Args a{};
    for (int i = 0; i < 22; ++i) a.in[i] = (const float*)d_in[i];
    a.out = (float*)d_out; a.ws = (unsigned char*)d_ws;
    hipLaunchKernelGGL(mega_fwd, dim3(grid), dim3(NWAVES * 64), LDS_BYTES, stream, a);
}
```

```cpp
#include <hip/hip_runtime.h>
#include <hip/hip_bf16.h>
#include <cstdio>
#include <cstdint>
#include <cmath>
namespace cfg {
constexpr int DM = 1024, NB = 8, SEQ = 2048, DB = 16, DS = 32, PAST = 1024, PW = 512, SBW = 512, HD = 64, NH = 8, DFF = 4096, PLE = 256, INW = 4096;
constexpr int MP = NB * SEQ, MS = DB * DS, MT = MP + MS;
constexpr float EPS = 1e-6f;
constexpr float QSCALE = 0.125f * 1.4426950408889634f;
}
namespace pg8 {
#define PG8_LAS __attribute__((address_space(3)))
typedef unsigned short bf16_t;
typedef short bf16x8 __attribute__((ext_vector_type(8)));
typedef float f32x4 __attribute__((ext_vector_type(4)));
typedef unsigned u32x4 __attribute__((ext_vector_type(4)));
constexpr int BM = 256, BK = 64, HALF = 128, HTB = HALF * BK * 2  , STAGE_BYTES = 8 * HTB, NXCD = 8, WGM = 8;

__host__ __device__ __forceinline__ int lds_byte(int r, int c) { const int st = (r >> 4) * 2 + (c >> 5), rr = r & 15, cc = c & 31, ob = rr * 64 + cc * 2; return st * 1024 + (ob ^ (((ob >> 9) & 1) << 5)); }
__host__ __device__ __forceinline__ void stage_rc(int b, int& R, int& C) { const int st = b / 1024, sb = b % 1024, swz = sb ^ (((sb >> 9) & 1) << 5); R = (st >> 1) * 16 + swz / 64; C = (st & 1) * 32 + (swz % 64) / 2; }
__host__ __device__ __forceinline__ int perm32(int rho) { const int n = rho >> 4, i = rho & 15; return 8 * (i >> 2) + 4 * n + (i & 3); }

struct Unit { int pm, pn, seg; };
struct Gemm { const bf16_t* A; const bf16_t* Bt; int M, N, K; const bf16_t* A1 = nullptr; const bf16_t* Bt1 = nullptr; };

struct StaticOrder {
    int nM, nN, nwg, G, c;
    __host__ __device__ void init(int M, int N, int G_, int c_) { nM = M / BM; nN = N / BM; nwg = nM * nN; G = G_; c = c_; }
    __host__ __device__ bool next(int i, Unit& u) const {
        const long L = (long)i * G + c; if (L >= nwg) return false;
        int wgid = (int)L; { const int q = nwg / NXCD, r = nwg % NXCD, xcd = wgid % NXCD, off = wgid / NXCD; wgid = (xcd < r ? xcd * (q + 1) : r * (q + 1) + (xcd - r) * q) + off; }
        const int nig = WGM * nN, gid = wgid / nig, fm = gid * WGM, gsz = (nM - fm) < WGM ? (nM - fm) : WGM;
        u.pm = fm + ((wgid % nig) % gsz); u.pn = (wgid % nig) / gsz; u.seg = 0; return true;
    }
    __device__ __forceinline__ void a_ready(const Unit&) const {}
    __device__ __forceinline__ void done(const Unit&) const {}
};
struct RotOrder : StaticOrder {
    int rot, cnt;
    __host__ __device__ void init(int M, int N, int G_, int c_, int rot_) { StaticOrder::init(M, N, G_, c_); cnt = (nwg % G_ == 0) ? nwg / G_ : 0; rot = rot_; }
    __host__ __device__ bool next(int i, Unit& u) const { if (cnt == 0) return StaticOrder::next(i, u); if (i >= cnt) return false; return StaticOrder::next((i + rot) % cnt, u); }
};
struct PairOrder : StaticOrder {
    __host__ __device__ bool next(int i, Unit& u) const { if (!StaticOrder::next(i >> 1, u)) return false; u.seg = i & 1; return true; }
};
typedef float f32x2v_t __attribute__((ext_vector_type(2))); typedef __bf16 bf16x2v_t __attribute__((ext_vector_type(2)));
__device__ __forceinline__ unsigned cvt_pk_bf16(float lo, float hi) { f32x2v_t v = {lo, hi}; bf16x2v_t b = __builtin_convertvector(v, bf16x2v_t); return __builtin_bit_cast(unsigned, b); }
typedef float f32x2 __attribute__((ext_vector_type(2)));
__device__ __forceinline__ float bf_lo(unsigned w) { return __uint_as_float(w << 16); }
__device__ __forceinline__ float bf_hi(unsigned w) { return __uint_as_float(w & 0xffff0000u); }
__device__ __forceinline__ u32x4 pack8(f32x4 a, f32x4 b) { u32x4 w; w.x = cvt_pk_bf16(a[0], a[1]); w.y = cvt_pk_bf16(a[2], a[3]); w.z = cvt_pk_bf16(b[0], b[1]); w.w = cvt_pk_bf16(b[2], b[3]); return w; }
__device__ __forceinline__ void unpack8(u32x4 w, f32x4& a, f32x4& b) { a = (f32x4){bf_lo(w.x), bf_hi(w.x), bf_lo(w.y), bf_hi(w.y)}; b = (f32x4){bf_lo(w.z), bf_hi(w.z), bf_lo(w.w), bf_hi(w.w)}; }
__device__ __forceinline__ float sigm(float x) { return __builtin_amdgcn_rcpf(1.f + __builtin_amdgcn_exp2f(-1.4426950408889634f * x)); }
__device__ __forceinline__ f32x4 sigm4(f32x4 x) { return (f32x4){sigm(x[0]), sigm(x[1]), sigm(x[2]), sigm(x[3])}; }
__device__ __forceinline__ float dot4(f32x4 a) { return (a[0] * a[0] + a[1] * a[1]) + (a[2] * a[2] + a[3] * a[3]); }
#ifndef DBG_LDAUX
#define DBG_LDAUX 16
#endif
__device__ __forceinline__ u32x4 ld16_sc1(const void* base, size_t byte_off) {
    const __amdgpu_buffer_rsrc_t rs = __builtin_amdgcn_make_buffer_rsrc((void*)base, (short)0, 0x7fffffff, 0x00020000);
    return __builtin_bit_cast(u32x4, __builtin_amdgcn_raw_buffer_load_b128(rs, (unsigned)byte_off, 0, DBG_LDAUX));
}
__device__ __forceinline__ unsigned pk_u8x4(f32x4 g) { unsigned w = 0u; w = __builtin_amdgcn_cvt_pk_u8_f32(g[0] * 255.0f, 0, w); w = __builtin_amdgcn_cvt_pk_u8_f32(g[1] * 255.0f, 1, w); w = __builtin_amdgcn_cvt_pk_u8_f32(g[2] * 255.0f, 2, w); w = __builtin_amdgcn_cvt_pk_u8_f32(g[3] * 255.0f, 3, w); return w; }
__device__ __forceinline__ f32x4 up_u8x4(unsigned w) { return (f32x4){(float)(w & 0xffu), (float)((w >> 8) & 0xffu), (float)((w >> 16) & 0xffu), (float)(w >> 24)} * (1.0f / 255.0f); }
typedef unsigned u32x2 __attribute__((ext_vector_type(2)));
template <int AUX> __device__ __forceinline__ void st16_aux(void* base, size_t byte_off, u32x4 v) {
    if constexpr (AUX == 0) { *(u32x4*)((char*)base + byte_off) = v; }
    else { const __amdgpu_buffer_rsrc_t rs = __builtin_amdgcn_make_buffer_rsrc(base, (short)0, 0x7fffffff, 0x00020000); __builtin_amdgcn_raw_buffer_store_b128(v, rs, (unsigned)byte_off, 0, AUX); }
}
#ifndef DBG_AUXHS
#define DBG_AUXHS 0
#endif
__device__ __forceinline__ float row_rstd(const float* SSQ, int r, int fq) {
    const f32x4 p = *(const f32x4*)(SSQ + (size_t)r * 16 + 4 * fq); float s = (p[0] + p[1]) + (p[2] + p[3]);
    s += __shfl_xor(s, 16); s += __shfl_xor(s, 32);
    return __builtin_amdgcn_rsqf(s * (1.0f / 1024.0f) + cfg::EPS);
}
#define PG8_ROWS(...) _Pragma("unroll") for (int ai = 0; ai < 2; ++ai) _Pragma("unroll") for (int m = 0; m < 4; ++m) { const int r = u.pm * BM + ai * HALF + wr * 64 + m * 16 + fr; __VA_ARGS__; if (m == 3) asm volatile("" ::: "memory"); }
#define PG8_ROWS_NF(...) _Pragma("unroll") for (int ai = 0; ai < 2; ++ai) _Pragma("unroll") for (int m = 0; m < 4; ++m) { const int r = u.pm * BM + ai * HALF + wr * 64 + m * 16 + fr; __VA_ARGS__; }
#define EPI_ALL(...) _Pragma("unroll") for (int ai = 0; ai < 2; ++ai) _Pragma("unroll") for (int m = 0; m < 4; ++m) { const int r = u.pm * BM + ai * HALF + wr * 64 + m * 16 + fr; _Pragma("unroll") for (int bj = 0; bj < 2; ++bj) { const int c = ct + bj * HALF + wc * 32 + 8 * fq; __VA_ARGS__; } }
#define EPI_HALF(...) _Pragma("unroll") for (int m = 0; m < 4; ++m) { const int r = u.pm * BM + ai * HALF + wr * 64 + m * 16 + fr; _Pragma("unroll") for (int bj = 0; bj < 2; ++bj) { const int c = ct + bj * HALF + wc * 32 + 8 * fq; __VA_ARGS__; } }
#define EPI_HALF_ROWS(...) _Pragma("unroll") for (int m = 0; m < 4; ++m) { const int r = u.pm * BM + ai * HALF + wr * 64 + m * 16 + fr; __VA_ARGS__; }
#define EPI_LOADS_DONE() asm volatile("" ::: "memory")
#ifndef EPI_NOFENCE
#define EPI_NOFENCE 1
#endif
#if EPI_NOFENCE
#define EPI_ROWS_LD PG8_ROWS_NF
#else
#define EPI_ROWS_LD PG8_ROWS
#endif
#define PG8_COLS(...) _Pragma("unroll") for (int bj = 0; bj < 2; ++bj) { const int c = ct + bj * HALF + wc * 32 + 8 * fq; const f32x4 v0 = acc[ai][bj][m][0], v1 = acc[ai][bj][m][1]; __VA_ARGS__; }

struct EpiIn {
    static constexpr bool PERM = true, AFTER_DRAIN = false;
    bf16_t *U, *Q, *K, *V, *G; const float* b_gate; float *k_p, *v_p, *k_s, *v_s, *pool_p, *pool_s;
    __device__ __forceinline__ void operator()(const f32x4 (&acc)[2][2][4][2], const Unit& u, int wr, int wc, int fr, int fq) const {
        const int pn = u.pn;
        if (pn >= 8) {
            const int ct = (pn - 8) * BM; f32x4 bv[2][2];
#pragma unroll
            for (int bj = 0; bj < 2; ++bj) { const int c = ct + bj * HALF + wc * 32 + 8 * fq; bv[bj][0] = *(const f32x4*)(b_gate + c); bv[bj][1] = *(const f32x4*)(b_gate + c + 4); }
            PG8_ROWS(PG8_COLS(*(u32x2*)((unsigned char*)G + (size_t)r * 2048 + c) = (u32x2){pk_u8x4(sigm4(v0 + bv[bj][0])), pk_u8x4(sigm4(v1 + bv[bj][1]))}))
        } else if (pn >= 4) {
            const bool isv = pn >= 6; const int ct = (pn - (isv ? 6 : 4)) * BM; bf16_t* B = isv ? V : K; float* op = isv ? v_p : k_p; float* os = isv ? v_s : k_s;
            PG8_ROWS(float* orow = r < cfg::MP ? op + (size_t)r * 512 : os + (size_t)(r - cfg::MP) * 512;
                     PG8_COLS(*(u32x4*)(B + (size_t)r * 512 + c) = pack8(v0, v1); __builtin_nontemporal_store(v0, (f32x4*)(orow + c)); __builtin_nontemporal_store(v1, (f32x4*)(orow + c + 4))))
        } else if (pn >= 2) {
            const int ct = (pn - 2) * BM;
            PG8_ROWS(PG8_COLS(*(u32x4*)(Q + (size_t)r * 512 + c) = pack8(v0 * cfg::QSCALE, v1 * cfg::QSCALE)))
        } else {
            const int ct = pn * BM;
            PG8_ROWS(float* prow = nullptr;
                     if (r < cfg::MP) { const int t = r & (cfg::SEQ - 1); if (t >= cfg::SEQ - 15) prow = pool_p + ((size_t)(r >> 11) * 15 + (t - (cfg::SEQ - 15))) * 512; }
                     else { const int i = (r - cfg::MP) & 31; if (i >= 17) prow = pool_s + ((size_t)((r - cfg::MP) >> 5) * 15 + (i - 17)) * 512; }
                     PG8_COLS(*(u32x4*)(U + (size_t)r * 512 + c) = pack8(v0, v1); if (prow) { *(f32x4*)(prow + c) = v0; *(f32x4*)(prow + c + 4) = v1; }))
        }
    }
};
struct EpiMerge;
struct EpiMerge0 {
    static constexpr bool PERM = true, AFTER_DRAIN = false;
    const bf16_t* G; bf16_t* MG;
    __device__ __forceinline__ void operator()(const f32x4 (&acc)[2][2][4][2], const Unit& u, int wr, int wc, int fr, int fq) const {
        const int ct = u.pn * BM;
        PG8_ROWS(PG8_COLS(const u32x2 gw = *(const u32x2*)((const unsigned char*)G + (size_t)r * 2048 + c); const f32x4 g0 = up_u8x4(gw.x); const f32x4 g1 = up_u8x4(gw.y); *(u32x4*)(MG + (size_t)r * 1024 + c) = pack8(v0 * g0, v1 * g1)))
    }
};
struct EpiMerge1 {
    static constexpr bool PERM = true, AFTER_DRAIN = false;
    const bf16_t* G; bf16_t* MG;
    __device__ __forceinline__ void operator()(const f32x4 (&acc)[2][2][4][2], const Unit& u, int wr, int wc, int fr, int fq) const {
        const int ct = u.pn * BM;
        PG8_ROWS(PG8_COLS(const u32x2 gw = *(const u32x2*)((const unsigned char*)G + (size_t)r * 2048 + 1024 + c); const u32x4 mw = *(const u32x4*)(MG + (size_t)r * 1024 + c);
                          const f32x4 g0 = up_u8x4(gw.x); const f32x4 g1 = up_u8x4(gw.y); f32x4 m0; f32x4 m1; unpack8(mw, m0, m1); *(u32x4*)(MG + (size_t)r * 1024 + c) = pack8(m0 + v0 * g0, m1 + v1 * g1)))
    }
};
#ifndef MERGE_CARRY
#define MERGE_CARRY 1
#endif
__device__ __forceinline__ f32x4 up_u8x4_floor1(unsigned w) { return (f32x4){(float)__builtin_elementwise_max(w & 0xffu, 1u), (float)__builtin_elementwise_max((w >> 8) & 0xffu, 1u), (float)__builtin_elementwise_max((w >> 16) & 0xffu, 1u), (float)__builtin_elementwise_max(w >> 24, 1u)} * (1.0f / 255.0f); }
__device__ __forceinline__ f32x4 rcp4(f32x4 v) { return (f32x4){__builtin_amdgcn_rcpf(v[0]), __builtin_amdgcn_rcpf(v[1]), __builtin_amdgcn_rcpf(v[2]), __builtin_amdgcn_rcpf(v[3])}; }
struct EpiMerge {
    static constexpr bool PERM = true, AFTER_DRAIN = false, CARRY = MERGE_CARRY != 0;
    const bf16_t* G; bf16_t* MG;
    __device__ __forceinline__ void operator()(f32x4 (&acc)[2][2][4][2], const Unit& u, int wr, int wc, int fr, int fq) const {
#if MERGE_CARRY
        const int ct = u.pn * BM;
        if (u.seg == 0) {
#pragma unroll
            for (int ai = 0; ai < 2; ++ai) { u32x2 gaw[4][2], gbw[4][2];
                EPI_HALF(gaw[m][bj] = *(const u32x2*)((const unsigned char*)G + (size_t)r * 2048 + c); gbw[m][bj] = *(const u32x2*)((const unsigned char*)G + (size_t)r * 2048 + 1024 + c))
                EPI_LOADS_DONE();
                EPI_HALF(const u32x2 ga = gaw[m][bj]; const u32x2 gb = gbw[m][bj]; (void)r; (void)c;
                         acc[ai][bj][m][0] = acc[ai][bj][m][0] * (up_u8x4(ga.x) * rcp4(up_u8x4_floor1(gb.x))); acc[ai][bj][m][1] = acc[ai][bj][m][1] * (up_u8x4(ga.y) * rcp4(up_u8x4_floor1(gb.y)))) }
        } else {
#pragma unroll
            for (int ai = 0; ai < 2; ++ai) { u32x2 gbw[4][2];
                EPI_HALF(gbw[m][bj] = *(const u32x2*)((const unsigned char*)G + (size_t)r * 2048 + 1024 + c))
                EPI_LOADS_DONE();
                EPI_HALF(const u32x2 gb = gbw[m][bj];
                         *(u32x4*)(MG + (size_t)r * 1024 + c) = pack8(acc[ai][bj][m][0] * up_u8x4_floor1(gb.x), acc[ai][bj][m][1] * up_u8x4_floor1(gb.y))) }
        }
#else
        if (u.seg == 0) { const EpiMerge0 E0{G, MG}; E0(acc, u, wr, wc, fr, fq); } else { const EpiMerge1 E1{G, MG}; E1(acc, u, wr, wc, fr, fq); }
#endif
    }
};
#ifndef FOLD_G
#define FOLD_G 1
#endif
#ifndef RES_FROM_XN
#define RES_FROM_XN 1
#endif
#if FOLD_G
#define EPI_XG_STORE (void)0
#else
#define EPI_XG_STORE *(u32x4*)(XG + (size_t)r * 1024 + c) = pack8(a * gv[bj][0], b * gv[bj][1])
#endif
template <bool F32RES>
struct EpiResid {
    static constexpr bool PERM = true, AFTER_DRAIN = false;
    const float* res_p; bf16_t* X; bf16_t* XG; const float* gvec; float* SSQ; const bf16_t* XN0 = nullptr; const float* RS0 = nullptr;
    __device__ __forceinline__ void operator()(const f32x4 (&acc)[2][2][4][2], const Unit& u, int wr, int wc, int fr, int fq) const {
        const int ct = u.pn * BM;
#if !FOLD_G
        f32x4 gv[2][2];
#pragma unroll
        for (int bj = 0; bj < 2; ++bj) { const int c = ct + bj * HALF + wc * 32 + 8 * fq; gv[bj][0] = *(const f32x4*)(gvec + c); gv[bj][1] = *(const f32x4*)(gvec + c + 4); }
#endif
#if RES_FROM_XN
        const bf16_t* src = F32RES ? XN0 : X;
#pragma unroll
        for (int ai = 0; ai < 2; ++ai) { u32x4 xw[4][2]; float irv[4];
            EPI_HALF(xw[m][bj] = F32RES ? __builtin_nontemporal_load((const u32x4*)(src + (size_t)r * 1024 + c)) : *(const u32x4*)(src + (size_t)r * 1024 + c); if (bj == 0) irv[m] = F32RES ? RS0[r] : 1.0f)
            EPI_LOADS_DONE();
            EPI_HALF_ROWS(float s = 0.f; const float ir = irv[m];
                _Pragma("unroll") for (int bj = 0; bj < 2; ++bj) { const int c = ct + bj * HALF + wc * 32 + 8 * fq; f32x4 a; f32x4 b; unpack8(xw[m][bj], a, b); if (F32RES) { a *= ir; b *= ir; }
                    a += acc[ai][bj][m][0]; b += acc[ai][bj][m][1]; *(u32x4*)(X + (size_t)r * 1024 + c) = pack8(a, b); s += dot4(a) + dot4(b);
                    EPI_XG_STORE; }
                s += __shfl_xor(s, 16); s += __shfl_xor(s, 32); if (fq == 0) SSQ[(size_t)r * 16 + u.pn * 4 + wc] = s) }
#else
        PG8_ROWS(float s = 0.f;
                 PG8_COLS(f32x4 a; f32x4 b;
                          if (F32RES) { a = __builtin_nontemporal_load((const f32x4*)(res_p + (size_t)r * 1024 + c)); b = __builtin_nontemporal_load((const f32x4*)(res_p + (size_t)r * 1024 + c + 4)); }
                          else { const u32x4 xw = *(const u32x4*)(X + (size_t)r * 1024 + c); unpack8(xw, a, b); }
                          a += v0; b += v1; *(u32x4*)(X + (size_t)r * 1024 + c) = pack8(a, b); s += dot4(a) + dot4(b);
                          EPI_XG_STORE)
                 s += __shfl_xor(s, 16); s += __shfl_xor(s, 32); if (fq == 0) SSQ[(size_t)r * 16 + u.pn * 4 + wc] = s)
#endif
    }
};
struct EpiUp {
    static constexpr bool PERM = true, AFTER_DRAIN = false;
    const float* SSQ; bf16_t* H;
    __device__ __forceinline__ void operator()(const f32x4 (&acc)[2][2][4][2], const Unit& u, int wr, int wc, int fr, int fq) const {
        const int ct = u.pn * BM; float rsv[2][4];
#pragma unroll
        for (int ai = 0; ai < 2; ++ai)
#pragma unroll
            for (int m = 0; m < 4; ++m) rsv[ai][m] = row_rstd(SSQ, u.pm * BM + ai * HALF + wr * 64 + m * 16 + fr, fq);
        PG8_ROWS(const float rs = rsv[ai][m];
                 PG8_COLS(f32x4 a = v0 * rs; f32x4 b = v1 * rs; a = __builtin_elementwise_max(a, (f32x4){0.f, 0.f, 0.f, 0.f}); b = __builtin_elementwise_max(b, (f32x4){0.f, 0.f, 0.f, 0.f});
                          st16_aux<DBG_AUXHS>(H, ((size_t)r * 4096 + c) * 2, pack8(a * a, b * b))))
    }
};
struct EpiNull {
    static constexpr bool PERM = true, AFTER_DRAIN = false;
    float* sink;
    __device__ __forceinline__ void operator()(const f32x4 (&acc)[2][2][4][2], const Unit& u, int wr, int wc, int fr, int fq) const {
        float s = 0.f;
#pragma unroll
        for (int ai = 0; ai < 2; ++ai)
#pragma unroll
            for (int bj = 0; bj < 2; ++bj)
#pragma unroll
                for (int m = 0; m < 4; ++m)
#pragma unroll
                    for (int n = 0; n < 2; ++n) s += acc[ai][bj][m][n][0] + acc[ai][bj][m][n][3];
        if (s == 1.2345e33f) sink[0] = s;
    }
};
struct EpiPP {
    static constexpr bool PERM = true, AFTER_DRAIN = false;
    bf16_t* PP;
    __device__ __forceinline__ void operator()(const f32x4 (&acc)[2][2][4][2], const Unit& u, int wr, int wc, int fr, int fq) const {
        const int ct = u.pn * BM;
        PG8_ROWS(PG8_COLS(*(u32x4*)(PP + (size_t)r * 1024 + c) = pack8(v0, v1)))
    }
};
struct EpiGate8 {
    static constexpr bool PERM = true, AFTER_DRAIN = false;
    const float* SSQ; unsigned char* S8;
    __device__ __forceinline__ void operator()(const f32x4 (&acc)[2][2][4][2], const Unit& u, int wr, int wc, int fr, int fq) const {
        const int ct = u.pn * BM; float rsv[2][4];
#pragma unroll
        for (int ai = 0; ai < 2; ++ai)
#pragma unroll
            for (int m = 0; m < 4; ++m) rsv[ai][m] = row_rstd(SSQ, u.pm * BM + ai * HALF + wr * 64 + m * 16 + fr, fq);
        PG8_ROWS(const float rs = rsv[ai][m];
                 PG8_COLS(*(u32x2*)(S8 + (size_t)r * 1024 + c) = (u32x2){pk_u8x4(sigm4(v0 * rs)), pk_u8x4(sigm4(v1 * rs))}))
    }
};
struct EpiPleFinal2 {
    static constexpr bool PERM = true, AFTER_DRAIN = false;
    const unsigned char* S8; const bf16_t* X; float* Y; float* SSQo; const float* gfin; unsigned* cnt;
    __device__ __forceinline__ void operator()(f32x4 (&acc)[2][2][4][2], const Unit& u, int wr, int wc, int fr, int fq) const {
        const int ct = u.pn * BM;
#pragma unroll
        for (int ai = 0; ai < 2; ++ai) {
            u32x2 sw[4][2]; u32x4 xw[4][2];
#pragma unroll
            for (int m = 0; m < 4; ++m) { const int r = u.pm * BM + ai * HALF + wr * 64 + m * 16 + fr;
#pragma unroll
                for (int bj = 0; bj < 2; ++bj) { const int c = ct + bj * HALF + wc * 32 + 8 * fq; sw[m][bj] = *(const u32x2*)(S8 + (size_t)r * 1024 + c); xw[m][bj] = *(const u32x4*)(X + (size_t)r * 1024 + c); } }
            EPI_LOADS_DONE();
#pragma unroll
            for (int m = 0; m < 4; ++m) { const int r = u.pm * BM + ai * HALF + wr * 64 + m * 16 + fr; float s = 0.f;
#pragma unroll
                for (int bj = 0; bj < 2; ++bj) { f32x4 a; f32x4 b; unpack8(xw[m][bj], a, b); a += up_u8x4(sw[m][bj].x) * acc[ai][bj][m][0]; b += up_u8x4(sw[m][bj].y) * acc[ai][bj][m][1];
                    acc[ai][bj][m][0] = a; acc[ai][bj][m][1] = b; s += dot4(a) + dot4(b); }
                s += __shfl_xor(s, 16); s += __shfl_xor(s, 32);
                if (fq == 0) __hip_atomic_store(SSQo + (size_t)r * 16 + u.pn * 4 + wc, s, __ATOMIC_RELAXED, __HIP_MEMORY_SCOPE_AGENT); }
        }
        asm volatile("s_waitcnt vmcnt(0)" ::: "memory");
        unsigned* cw = cnt + 64 * (2 * u.pm + wr);
        if (fr == 0 && fq == 0) __hip_atomic_fetch_add(cw, 1u, __ATOMIC_RELAXED, __HIP_MEMORY_SCOPE_AGENT);
        { unsigned spins = 0;
          while ((unsigned)__builtin_amdgcn_readfirstlane(__hip_atomic_load(cw, __ATOMIC_RELAXED, __HIP_MEMORY_SCOPE_AGENT)) < 16u) { __builtin_amdgcn_s_sleep(2); if (++spins > (1u << 16)) break; } }
        f32x4 gv[2][2];
#pragma unroll
        for (int bj = 0; bj < 2; ++bj) { const int c = ct + bj * HALF + wc * 32 + 8 * fq; gv[bj][0] = *(const f32x4*)(gfin + c); gv[bj][1] = *(const f32x4*)(gfin + c + 4); }
        f32x4 pqv[2][4];
#pragma unroll
        for (int ai = 0; ai < 2; ++ai)
#pragma unroll
            for (int m = 0; m < 4; ++m) { const int r = u.pm * BM + ai * HALF + wr * 64 + m * 16 + fr; pqv[ai][m] = __builtin_bit_cast(f32x4, ld16_sc1(SSQo, ((size_t)r * 16 + 4 * fq) * 4)); }
        EPI_LOADS_DONE();
        PG8_ROWS_NF(const f32x4 pq = pqv[ai][m]; float t = (pq[0] + pq[1]) + (pq[2] + pq[3]); t += __shfl_xor(t, 16); t += __shfl_xor(t, 32);
                 const float r3 = __builtin_amdgcn_rsqf(t * (1.0f / 1024.0f) + cfg::EPS);
                 PG8_COLS(__builtin_nontemporal_store(v0 * r3 * gv[bj][0], (f32x4*)(Y + (size_t)r * 1024 + c)); __builtin_nontemporal_store(v1 * r3 * gv[bj][1], (f32x4*)(Y + (size_t)r * 1024 + c + 4))))
    }
};
struct EpiPleFinal {
    static constexpr bool PERM = true, AFTER_DRAIN = false;
    const float* SSQ; const bf16_t* PP; const bf16_t* X; float* Y; float* SSQo; const float* gfin; unsigned* cnt;
    __device__ __forceinline__ void operator()(f32x4 (&acc)[2][2][4][2], const Unit& u, int wr, int wc, int fr, int fq) const {
        const int ct = u.pn * BM; float rsv[2][4];
#pragma unroll
        for (int ai = 0; ai < 2; ++ai)
#pragma unroll
            for (int m = 0; m < 4; ++m) rsv[ai][m] = row_rstd(SSQ, u.pm * BM + ai * HALF + wr * 64 + m * 16 + fr, fq);
        PG8_ROWS(const float rs = rsv[ai][m]; float s = 0.f;
                 PG8_COLS(const u32x4 pw = *(const u32x4*)(PP + (size_t)r * 1024 + c); f32x4 p0; f32x4 p1; unpack8(pw, p0, p1);
                          const u32x4 xw = *(const u32x4*)(X + (size_t)r * 1024 + c); f32x4 a; f32x4 b; unpack8(xw, a, b); a += sigm4(v0 * rs) * p0; b += sigm4(v1 * rs) * p1;
                          acc[ai][bj][m][0] = a; acc[ai][bj][m][1] = b; s += dot4(a) + dot4(b))
                 s += __shfl_xor(s, 16); s += __shfl_xor(s, 32);
                 if (fq == 0) __hip_atomic_store(SSQo + (size_t)r * 16 + u.pn * 4 + wc, s, __ATOMIC_RELAXED, __HIP_MEMORY_SCOPE_AGENT))
        asm volatile("s_waitcnt vmcnt(0)" ::: "memory");
        unsigned* cw = cnt + 64 * (2 * u.pm + wr);
        if (fr == 0 && fq == 0) __hip_atomic_fetch_add(cw, 1u, __ATOMIC_RELAXED, __HIP_MEMORY_SCOPE_AGENT);
        { unsigned spins = 0;
          while ((unsigned)__builtin_amdgcn_readfirstlane(__hip_atomic_load(cw, __ATOMIC_RELAXED, __HIP_MEMORY_SCOPE_AGENT)) < 16u) { __builtin_amdgcn_s_sleep(2); if (++spins > (1u << 16)) break; } }
        f32x4 gv[2][2];
#pragma unroll
        for (int bj = 0; bj < 2; ++bj) { const int c = ct + bj * HALF + wc * 32 + 8 * fq; gv[bj][0] = *(const f32x4*)(gfin + c); gv[bj][1] = *(const f32x4*)(gfin + c + 4); }
        PG8_ROWS(const f32x4 pq = __builtin_bit_cast(f32x4, ld16_sc1(SSQo, ((size_t)r * 16 + 4 * fq) * 4)); float t = (pq[0] + pq[1]) + (pq[2] + pq[3]); t += __shfl_xor(t, 16); t += __shfl_xor(t, 32);
                 const float r3 = __builtin_amdgcn_rsqf(t * (1.0f / 1024.0f) + cfg::EPS);
                 PG8_COLS(__builtin_nontemporal_store(v0 * r3 * gv[bj][0], (f32x4*)(Y + (size_t)r * 1024 + c)); __builtin_nontemporal_store(v1 * r3 * gv[bj][1], (f32x4*)(Y + (size_t)r * 1024 + c + 4))))
    }
};
template <class E, class = void> struct epi_carry { static constexpr bool value = false; };
template <class E> struct epi_carry<E, decltype((void)E::CARRY)> { static constexpr bool value = E::CARRY; };
struct NoHook { __device__ __forceinline__ void operator()(int) const {} };
template <class Epi, class Sched, bool ALIGN_EPI = false, bool SP2 = false, class Hook = NoHook, int AUXA = 0>
__device__ __forceinline__ void gemm_phase(PG8_LAS unsigned char* lds, const Gemm g, const Sched& S, const Epi& E, const Hook& H = Hook()) {
    int tid = threadIdx.x; asm volatile("" : "+v"(tid));
    const int wid = __builtin_amdgcn_readfirstlane(tid >> 6), lane = tid & 63, wr = wid >> 2, wc = wid & 3, fr = lane & 15, fq = lane >> 4;
    int K = g.K; asm volatile("" : "+s"(K)); const int nt = K / BK;
    unsigned voffA[2], voffB[2];
#pragma unroll
    for (int i = 0; i < 2; ++i) { int R, C; stage_rc(tid * 16 + i * 8192, R, C); const int Rb = Epi::PERM ? ((R & ~31) + perm32(R & 31)) : R;
        voffA[i] = (unsigned)(R * K + C) * 2u; voffB[i] = (unsigned)(Rb * K + C) * 2u; }
    const size_t kstep = (size_t)(BK * 2);
    const size_t hstep = (size_t)HALF * K * 2;
    const size_t tstep = 2 * hstep;
    const size_t bhs = hstep;
    const unsigned ldsw = (unsigned)wid * 1024u;
    const int aoff = lds_byte(wr * 64 + fr, fq * 8), boff = lds_byte(wc * 32 + fr, fq * 8);
#define PG8_SA(b, h) (((b) * 2 + (h)) * HTB)
#define PG8_SB(b, h) ((4 + (b) * 2 + (h)) * HTB)
#define PG8_STAGE_X(bufoff, gbase, voff, AUX) do { _Pragma("unroll") for (int _i = 0; _i < 2; ++_i) \
        __builtin_amdgcn_global_load_lds((const unsigned*)((const char*)(gbase) + (voff)[_i]), (PG8_LAS unsigned*)(lds + (bufoff) + ldsw + _i * 8192), 16, 0, AUX); } while (0)
#define PG8_LDA(dst, b, h) do { _Pragma("unroll") for (int m = 0; m < 4; ++m) _Pragma("unroll") for (int k = 0; k < 2; ++k) dst[m][k] = *(const PG8_LAS bf16x8*)(lds + PG8_SA(b, h) + aoff + m * 2048 + k * 1024); } while (0)
#define PG8_LDB(dst, b, h) do { _Pragma("unroll") for (int n = 0; n < 2; ++n) _Pragma("unroll") for (int k = 0; k < 2; ++k) dst[n][k] = *(const PG8_LAS bf16x8*)(lds + PG8_SB(b, h) + boff + n * 2048 + k * 1024); } while (0)
#define PG8_MMA(ai, bj, At, Bt) do { __builtin_amdgcn_s_setprio(1); _Pragma("unroll") for (int m = 0; m < 4; ++m) _Pragma("unroll") for (int n = 0; n < 2; ++n) _Pragma("unroll") for (int k = 0; k < 2; ++k) \
        acc[ai][bj][m][n] = __builtin_amdgcn_mfma_f32_16x16x32_bf16(Bt[n][k], At[m][k], acc[ai][bj][m][n], 0, 0, 0); __builtin_amdgcn_s_setprio(0); } while (0)
#ifdef DRAIN_ALL
#define PG8_WAIT_V(n) asm volatile("s_waitcnt vmcnt(0)" ::: "memory")
#else
#define PG8_WAIT_V(n) asm volatile("s_waitcnt vmcnt(" #n ")" ::: "memory")
#endif
#define PG8_WAIT_L(n) asm volatile("s_waitcnt lgkmcnt(" #n ")" ::: "memory")
#define PG8_BAR __builtin_amdgcn_s_barrier()
#define PG8_SCHED __builtin_amdgcn_sched_barrier(0)
    Unit cur, nxt; int ui = 0;
    if (!S.next(0, cur)) return;
    f32x4 acc[2][2][4][2];
#pragma unroll
    for (int a = 0; a < 2; ++a)
#pragma unroll
        for (int b = 0; b < 2; ++b)
#pragma unroll
            for (int m = 0; m < 4; ++m)
#pragma unroll
                for (int n = 0; n < 2; ++n) acc[a][b][m][n] = (f32x4){0.f, 0.f, 0.f, 0.f};
    bf16x8 At[4][2], B0[2][2], B1[2][2];
    const char* cA = (const char*)(cur.seg ? g.A1 : g.A) + (size_t)cur.pm * tstep; const char* cB = (const char*)(cur.seg ? g.Bt1 : g.Bt) + (size_t)cur.pn * tstep;
    S.a_ready(cur);
    if constexpr (SP2) {
        PG8_STAGE_X(PG8_SB(0, 0), cB, voffB, 0); PG8_STAGE_X(PG8_SB(0, 1), cB + bhs, voffB, 0); PG8_STAGE_X(PG8_SA(0, 0), cA, voffA, AUXA); PG8_STAGE_X(PG8_SA(0, 1), cA + hstep, voffA, AUXA);
        if (wr == 1) PG8_BAR;
        PG8_WAIT_V(2); PG8_BAR;
        PG8_STAGE_X(PG8_SB(1, 0), cB + kstep, voffB, 0); PG8_STAGE_X(PG8_SA(1, 0), cA + kstep, voffA, AUXA); PG8_STAGE_X(PG8_SB(1, 1), cB + bhs + kstep, voffB, 0);
        PG8_WAIT_V(6); PG8_BAR;
    } else {
        PG8_STAGE_X(PG8_SB(0, 0), cB, voffB, 0); PG8_STAGE_X(PG8_SA(0, 0), cA, voffA, AUXA); PG8_STAGE_X(PG8_SB(0, 1), cB + bhs, voffB, 0); PG8_STAGE_X(PG8_SA(0, 1), cA + hstep, voffA, AUXA);
        if (wr == 1) PG8_BAR;
        PG8_WAIT_V(4); PG8_BAR;
        PG8_STAGE_X(PG8_SB(1, 0), cB + kstep, voffB, 0); PG8_STAGE_X(PG8_SA(1, 0), cA + kstep, voffA, AUXA); PG8_STAGE_X(PG8_SB(1, 1), cB + bhs + kstep, voffB, 0);
        PG8_WAIT_V(6); PG8_BAR;
    }
    for (;;) {
        const bool has_next = S.next(ui + 1, nxt);
        const char* nA = has_next ? (const char*)(nxt.seg ? g.A1 : g.A) + (size_t)nxt.pm * tstep : cA; const char* nB = has_next ? (const char*)(nxt.seg ? g.Bt1 : g.Bt) + (size_t)nxt.pn * tstep : cB;
        for (int t = 0; t < nt; t += 2) {
            const bool last = (t == nt - 2);
            const char* a1 = cA + (size_t)(t + 1) * kstep;
            const char* a2 = last ? nA : cA + (size_t)(t + 2) * kstep; const char* b2 = last ? nB : cB + (size_t)(t + 2) * kstep;
            const char* a3 = a2 + kstep; const char* b3 = b2 + kstep;
            if (last && has_next) S.a_ready(nxt);
            if constexpr (SP2) {
            PG8_LDB(B0, 0, 0); PG8_LDB(B1, 0, 1); PG8_SCHED; PG8_LDA(At, 0, 0); PG8_STAGE_X(PG8_SA(1, 1), a1 + hstep, voffA, AUXA);
            PG8_WAIT_V(8); PG8_WAIT_L(0); PG8_BAR; PG8_MMA(0, 0, At, B0); PG8_MMA(0, 1, At, B1); PG8_BAR; PG8_SCHED;
            PG8_LDA(At, 0, 1); PG8_STAGE_X(PG8_SB(0, 0), b2, voffB, 0); PG8_STAGE_X(PG8_SB(0, 1), b2 + bhs, voffB, 0); PG8_STAGE_X(PG8_SA(0, 0), a2, voffA, AUXA);
            PG8_WAIT_V(8); PG8_WAIT_L(0); PG8_BAR; PG8_MMA(1, 0, At, B0); PG8_MMA(1, 1, At, B1); PG8_BAR; PG8_SCHED;
            PG8_LDB(B0, 1, 0); PG8_LDB(B1, 1, 1); PG8_SCHED; PG8_LDA(At, 1, 0); PG8_STAGE_X(PG8_SA(0, 1), a2 + hstep, voffA, AUXA);
            PG8_WAIT_V(8); PG8_WAIT_L(0); PG8_BAR; PG8_MMA(0, 0, At, B0); PG8_MMA(0, 1, At, B1); PG8_BAR; PG8_SCHED;
            PG8_LDA(At, 1, 1); PG8_STAGE_X(PG8_SB(1, 0), b3, voffB, 0); PG8_STAGE_X(PG8_SB(1, 1), b3 + bhs, voffB, 0); PG8_STAGE_X(PG8_SA(1, 0), a3, voffA, AUXA);
            PG8_WAIT_V(8); PG8_WAIT_L(0); PG8_BAR; PG8_MMA(1, 0, At, B0); PG8_MMA(1, 1, At, B1); PG8_BAR; PG8_SCHED;
            } else {
            PG8_LDB(B0, 0, 0); PG8_SCHED; PG8_LDA(At, 0, 0); PG8_STAGE_X(PG8_SA(1, 1), a1 + hstep, voffA, AUXA);
            PG8_WAIT_L(8); PG8_BAR; PG8_WAIT_L(0); PG8_MMA(0, 0, At, B0); PG8_BAR; PG8_SCHED;
            PG8_LDB(B1, 0, 1); PG8_STAGE_X(PG8_SB(0, 0), b2, voffB, 0);
            PG8_BAR; PG8_WAIT_L(0); PG8_MMA(0, 1, At, B1); PG8_BAR;
            PG8_LDA(At, 0, 1); PG8_STAGE_X(PG8_SA(0, 0), a2, voffA, AUXA);
            PG8_BAR; PG8_WAIT_L(0); PG8_MMA(1, 0, At, B0); PG8_BAR; PG8_SCHED;
            PG8_STAGE_X(PG8_SB(0, 1), b2 + bhs, voffB, 0);
            PG8_WAIT_V(6); PG8_BAR; PG8_MMA(1, 1, At, B1); PG8_BAR;
            PG8_LDB(B0, 1, 0); PG8_SCHED; PG8_LDA(At, 1, 0); PG8_STAGE_X(PG8_SA(0, 1), a2 + hstep, voffA, AUXA);
            PG8_WAIT_L(8); PG8_BAR; PG8_WAIT_L(0); PG8_MMA(0, 0, At, B0); PG8_BAR; PG8_SCHED;
            PG8_LDB(B1, 1, 1); PG8_STAGE_X(PG8_SB(1, 0), b3, voffB, 0);
            PG8_BAR; PG8_WAIT_L(0); PG8_MMA(0, 1, At, B1); PG8_BAR;
            PG8_LDA(At, 1, 1); PG8_STAGE_X(PG8_SA(1, 0), a3, voffA, AUXA);
            PG8_BAR; PG8_WAIT_L(0); PG8_MMA(1, 0, At, B0); PG8_BAR; PG8_SCHED;
            PG8_STAGE_X(PG8_SB(1, 1), b3 + bhs, voffB, 0);
            PG8_WAIT_V(6); PG8_BAR; PG8_MMA(1, 1, At, B1); PG8_BAR;
            }
        }
        if constexpr (ALIGN_EPI) { if (wr == 0) PG8_BAR; }
        if constexpr (!Epi::AFTER_DRAIN) { int t_ = threadIdx.x; asm volatile("" : "+v"(t_)); const int l_ = t_ & 63; E(acc, cur, wr, wc, l_ & 15, l_ >> 4); S.done(cur); H(ui); }
        if (!has_next) break;
        if (!(epi_carry<Epi>::value && cur.seg == 0)) {
#pragma unroll
        for (int a = 0; a < 2; ++a)
#pragma unroll
            for (int b = 0; b < 2; ++b)
#pragma unroll
                for (int m = 0; m < 4; ++m)
#pragma unroll
                    for (int n = 0; n < 2; ++n) acc[a][b][m][n] = (f32x4){0.f, 0.f, 0.f, 0.f};
        }
        cur = nxt; cA = nA; cB = nB; ++ui;
        if constexpr (ALIGN_EPI) { if (wr == 1) PG8_BAR; }
    }
    PG8_WAIT_V(0);
    if constexpr (!ALIGN_EPI) { if (wr == 0) PG8_BAR; }
    PG8_BAR;
    if constexpr (Epi::AFTER_DRAIN) { E.fused(acc, cur, wr, wc, fr, fq, lds, wid, lane); S.done(cur); }
#undef PG8_SA
#undef PG8_SB
#undef PG8_STAGE_X
#undef PG8_LDA
#undef PG8_LDB
#undef PG8_MMA
#undef PG8_WAIT_V
#undef PG8_WAIT_L
#undef PG8_BAR
#undef PG8_SCHED
}
}
namespace sba {
typedef short bf16x8 __attribute__((ext_vector_type(8)));
typedef short s16x4 __attribute__((ext_vector_type(4)));
typedef float f32x16 __attribute__((ext_vector_type(16)));
typedef float f32x4 __attribute__((ext_vector_type(4)));
typedef unsigned u32x4 __attribute__((ext_vector_type(4)));
typedef unsigned short bf16_t;
#define SB_LAS __attribute__((address_space(3)))
constexpr int PITCH = 512, HSLOT = 16384  , SLOTB = 4 * HSLOT, LDS_BYTES = 2 * SLOTB;
constexpr float THR2 = 48.0f, NEGBIG = -1.0e30f;
typedef float f32x2_t __attribute__((ext_vector_type(2))); typedef __bf16 bf16x2_t __attribute__((ext_vector_type(2)));
__device__ __forceinline__ unsigned cvtpk(float lo, float hi) { f32x2_t v = {lo, hi}; bf16x2_t b = __builtin_convertvector(v, bf16x2_t); return __builtin_bit_cast(unsigned, b); }
__device__ __forceinline__ bf16x8 pack8f(float a0, float a1, float a2, float a3, float a4, float a5, float a6, float a7) {
    u32x4 w; w.x = cvtpk(a0, a1); w.y = cvtpk(a2, a3); w.z = cvtpk(a4, a5); w.w = cvtpk(a6, a7); return __builtin_bit_cast(bf16x8, w); }
typedef short v4i16_t __attribute__((ext_vector_type(4)));
__device__ __forceinline__ s16x4 vtr(const SB_LAS char* p) { return __builtin_bit_cast(s16x4, __builtin_amdgcn_ds_read_tr16_b64_v4i16((SB_LAS v4i16_t*)p)); }
__device__ __forceinline__ int crow(int r, int hi) { return (r & 3) + 8 * (r >> 2) + 4 * hi; }

template <int SUB>
__device__ __forceinline__ void sub_front(const SB_LAS char* Kslot, bool mask, int kq, const bf16x8 (&qr)[4], f32x16& w, bf16x8 (&spb)[2], int r32, int hi) {
    const SB_LAS char* kb = Kslot + hi * 1024 + r32 * 16 + SUB * 512;
    f32x16 p = {};
#pragma unroll
    for (int d0 = 0; d0 < 4; ++d0) { const bf16x8 kf = *(const SB_LAS bf16x8*)(kb + d0 * 2048); p = __builtin_amdgcn_mfma_f32_32x32x16_bf16(kf, qr[d0], p, 0, 0, 0); }
    float sp[16];
#pragma unroll
    for (int r = 0; r < 16; ++r) {
        float x = p[r];
        if (mask && (kq + 32 * SUB + (r & 3) + 8 * (r >> 2) >= 0)) x = NEGBIG;
        const float t = __builtin_amdgcn_exp2f(-__builtin_fabsf(x));
        const float l = __builtin_amdgcn_logf(1.0f + t);
        sp[r] = __builtin_fmaxf(x, 0.f) + l; w[r] = __builtin_fminf(x, 0.f) - l;
    }
    spb[0] = pack8f(sp[0], sp[1], sp[2], sp[3], sp[4], sp[5], sp[6], sp[7]);
    spb[1] = pack8f(sp[8], sp[9], sp[10], sp[11], sp[12], sp[13], sp[14], sp[15]);
}
template <int SUB>
__device__ __forceinline__ void sub_back(const SB_LAS char* vp, const f32x16& w, const f32x16& sx, f32x16 (&o)[2]) {
    float pr[16];
#pragma unroll
    for (int r = 0; r < 16; ++r) pr[r] = __builtin_amdgcn_exp2f(w[r] - sx[r]);
    bf16x8 pa[2];
    pa[0] = pack8f(pr[0], pr[1], pr[2], pr[3], pr[4], pr[5], pr[6], pr[7]);
    pa[1] = pack8f(pr[8], pr[9], pr[10], pr[11], pr[12], pr[13], pr[14], pr[15]);
#pragma unroll
    for (int d0 = 0; d0 < 2; ++d0)
#pragma unroll
        for (int s = 0; s < 2; ++s) { const int ks = 2 * SUB + s;
            const s16x4 lo = vtr(vp + d0 * 4096 + ks * 1024), hi4 = vtr(vp + d0 * 4096 + ks * 1024 + 512);
            const bf16x8 vf = (bf16x8){lo[0], lo[1], lo[2], lo[3], hi4[0], hi4[1], hi4[2], hi4[3]};
            o[d0] = __builtin_amdgcn_mfma_f32_32x32x16_bf16(pa[s], vf, o[d0], 0, 0, 0); }
}
__device__ __forceinline__ void sb_tile(const SB_LAS char* slot, bool mask, bool skip1, int kq, const bf16x8 (&qr)[4], f32x16& Rb, f32x16 (&o)[2], const bf16x8 (&Um)[2], const bf16x8 Jm, int r32, int hi, int lane) {
    const SB_LAS char* vp = slot + 8192 + ((lane >> 4) & 1) * 32 + (lane & 3) * 8 + (4 * hi + ((lane & 15) >> 2)) * 64;
    f32x16 w1, w0; bf16x8 sb1[2], sb0[2];
    f32x16 t1 = Rb;
    if (!skip1) {
    sub_front<1>(slot, mask, kq, qr, w1, sb1, r32, hi);
    f32x16 a1 = __builtin_amdgcn_mfma_f32_32x32x16_bf16(Um[0], sb1[0], Rb, 0, 0, 0); a1 = __builtin_amdgcn_mfma_f32_32x32x16_bf16(Um[1], sb1[1], a1, 0, 0, 0);
    t1 = __builtin_amdgcn_mfma_f32_32x32x16_bf16(Jm, sb1[0], Rb, 0, 0, 0); t1 = __builtin_amdgcn_mfma_f32_32x32x16_bf16(Jm, sb1[1], t1, 0, 0, 0);
    sub_back<1>(vp, w1, a1, o);
    }
    sub_front<0>(slot, mask, kq, qr, w0, sb0, r32, hi);
    f32x16 a0 = __builtin_amdgcn_mfma_f32_32x32x16_bf16(Um[0], sb0[0], t1, 0, 0, 0); a0 = __builtin_amdgcn_mfma_f32_32x32x16_bf16(Um[1], sb0[1], a0, 0, 0, 0);
    f32x16 rn = __builtin_amdgcn_mfma_f32_32x32x16_bf16(Jm, sb0[0], t1, 0, 0, 0); rn = __builtin_amdgcn_mfma_f32_32x32x16_bf16(Jm, sb0[1], rn, 0, 0, 0);
    sub_back<0>(vp, w0, a0, o);
    Rb = rn;
}
struct Tensors { const bf16_t* Q; const bf16_t* K; const bf16_t* V; bf16_t* O; const float* ck; const float* cv; };

template <bool SAMPLE>
__device__ __forceinline__ void sb_unit(int b, int hg, int q64, const Tensors& T, SB_LAS char* lds, volatile SB_LAS unsigned* flags) {
    int tid = threadIdx.x; asm volatile("" : "+v"(tid)); const int lane = tid & 63, r32 = lane & 31, hi = lane >> 5; const int wid = __builtin_amdgcn_readfirstlane(tid >> 6);
    const size_t rowbase = SAMPLE ? (size_t)cfg::MP + (size_t)b * 32 : (size_t)b * cfg::SEQ; const int q0 = SAMPLE ? 0 : q64 * 64;
    const int jd = SAMPLE ? 16 : q64;
    const bool worker = SAMPLE ? (wid < 4) : true;
    const int hs = SAMPLE ? (wid & 3) : (wid >> 1), head = 4 * hg + hs;
    const int wq = SAMPLE ? 0 : (wid & 1);
    const int qpos = (SAMPLE ? cfg::PAST : q0 + 32 * wq) + r32;
    bf16x8 Um[2], Jm;
#pragma unroll
    for (int s = 0; s < 2; ++s)
#pragma unroll
        for (int jj = 0; jj < 8; ++jj) Um[s][jj] = (16 * s + 8 * (jj >> 2) + 4 * hi + (jj & 3) > r32) ? (short)0x3F80 : (short)0;
#pragma unroll
    for (int jj = 0; jj < 8; ++jj) Jm[jj] = (short)0x3F80;
    bf16x8 qr[4];
    { const bf16_t* Qw = T.Q + (rowbase + q0 + 32 * wq + r32) * PITCH + head * 64 + hi * 8;
#pragma unroll
      for (int d0 = 0; d0 < 4; ++d0) qr[d0] = *(const bf16x8*)(Qw + d0 * 16); }
    f32x16 Rb = {}, o[2]; o[0] = f32x16{}; o[1] = f32x16{};
    bool done = false;
    u32x4 kreg[4], vreg[4];
    const int vkey = 16 * (wid & 3) + (lane >> 2), vcol = (wid >> 2) * 32 + (lane & 3) * 8;
#define SB_LOAD(j) do { \
        if (!SAMPLE) {   \
            const char* kb_ = (const char*)(T.K + (rowbase + (size_t)(64 * (j))) * PITCH + hg * 256 + wid * 8); const char* vb_ = (const char*)(T.V + (rowbase + (size_t)(64 * (j))) * PITCH + hg * 256); \
            _Pragma("unroll") for (int s4 = 0; s4 < 4; ++s4) { kreg[s4] = *(const u32x4*)(kb_ + (unsigned)(lane * (PITCH * 2) + s4 * 128)); vreg[s4] = *(const u32x4*)(vb_ + (unsigned)(vkey * (PITCH * 2) + vcol * 2 + s4 * 128)); } } \
        else if ((j) == 16) { const int kr_ = lane < 31 ? lane : 31, vr_ = vkey < 31 ? vkey : 31; \
            _Pragma("unroll") for (int s4 = 0; s4 < 4; ++s4) { \
            kreg[s4] = *(const u32x4*)((const char*)(T.K + rowbase * PITCH + hg * 256 + wid * 8) + (unsigned)(kr_ * (PITCH * 2) + s4 * 128)); vreg[s4] = *(const u32x4*)((const char*)(T.V + rowbase * PITCH + hg * 256) + (unsigned)(vr_ * (PITCH * 2) + vcol * 2 + s4 * 128)); } } \
        else { _Pragma("unroll") for (int s4 = 0; s4 < 4; ++s4) { \
            const float* kp_ = (const float*)((const char*)(T.ck + ((size_t)b * cfg::PAST + 64 * (j)) * PITCH + hg * 256 + wid * 8) + (unsigned)(lane * (PITCH * 4) + s4 * 256)); const float* vp_ = (const float*)((const char*)(T.cv + ((size_t)b * cfg::PAST + 64 * (j)) * PITCH + hg * 256) + (unsigned)(vkey * (PITCH * 4) + vcol * 4 + s4 * 256)); \
            const f32x4 k0_ = *(const f32x4*)kp_, k1_ = *(const f32x4*)(kp_ + 4), v0_ = *(const f32x4*)vp_, v1_ = *(const f32x4*)(vp_ + 4); \
            kreg[s4] = (u32x4){cvtpk(k0_[0], k0_[1]), cvtpk(k0_[2], k0_[3]), cvtpk(k1_[0], k1_[1]), cvtpk(k1_[2], k1_[3])}; vreg[s4] = (u32x4){cvtpk(v0_[0], v0_[1]), cvtpk(v0_[2], v0_[3]), cvtpk(v1_[0], v1_[1]), cvtpk(v1_[2], v1_[3])}; } } } while (0)
    SB_LOAD(jd);
    for (int j = jd; j >= 0; --j) {
        SB_LAS char* slot = lds + (j & 1) * SLOTB;
#pragma unroll
        for (int s4 = 0; s4 < 4; ++s4) { *(SB_LAS u32x4*)(slot + s4 * HSLOT + wid * 1024 + lane * 16) = kreg[s4]; *(SB_LAS u32x4*)(slot + s4 * HSLOT + 8192 + wid * 1024 + lane * 16) = vreg[s4]; }
        __syncthreads();
        if (j != jd) { const volatile SB_LAS unsigned* f = flags + ((j + 1) & 1) * 8; unsigned all = 1u;
#pragma unroll
            for (int w8 = 0; w8 < 8; ++w8) all &= f[w8];
            if (all) break; }
        if (j > 0) SB_LOAD(j - 1);
        if (worker && !done) {
            const int key0 = (SAMPLE && j == 16) ? cfg::PAST : 64 * j;
            sb_tile(slot + hs * HSLOT, j == jd, (j == jd) && (SAMPLE || wq == 0), key0 + 4 * hi - qpos, qr, Rb, o, Um, Jm, r32, hi, lane);
            done = __all(Rb[0] > THR2) != 0;
        }
        if (lane == 0) flags[(j & 1) * 8 + wid] = (done || !worker) ? 1u : 0u;
    }
#undef SB_LOAD
    __syncthreads();
    if (worker) {
        SB_LAS bf16_t* stg = (SB_LAS bf16_t*)lds + wid * 2048;
#pragma unroll
        for (int r = 0; r < 16; ++r) { const int orow = crow(r, hi);
#pragma unroll
            for (int d0 = 0; d0 < 2; ++d0) stg[orow * 64 + d0 * 32 + r32] = (bf16_t)(cvtpk(o[d0][r], 0.f) & 0xffffu); }
        asm volatile("s_waitcnt lgkmcnt(0)" ::: "memory");
        bf16_t* Ow = T.O + (rowbase + q0 + 32 * wq) * PITCH + head * 64;
        if (SAMPLE) asm volatile("s_waitcnt vmcnt(0)" ::: "memory");
#pragma unroll
        for (int i = 0; i < 4; ++i) { const int row = i * 8 + (lane >> 3), ch = lane & 7; const u32x4 v = *(const SB_LAS u32x4*)(stg + row * 64 + ch * 8);
            if (SAMPLE) { unsigned long long* po = (unsigned long long*)(Ow + (size_t)row * PITCH + ch * 8);
                __hip_atomic_store(po, (unsigned long long)v.x | ((unsigned long long)v.y << 32), __ATOMIC_RELAXED, __HIP_MEMORY_SCOPE_AGENT); __hip_atomic_store(po + 1, (unsigned long long)v.z | ((unsigned long long)v.w << 32), __ATOMIC_RELAXED, __HIP_MEMORY_SCOPE_AGENT); }
            else *(u32x4*)(Ow + (size_t)row * PITCH + ch * 8) = v; }
    }
    if (SAMPLE) { if (!worker) asm volatile("s_waitcnt vmcnt(0)" ::: "memory");
                  asm volatile("s_waitcnt lgkmcnt(0)" ::: "memory"); __builtin_amdgcn_s_barrier(); }
    else __syncthreads();
}
}
namespace sk {
typedef short bf16x8 __attribute__((ext_vector_type(8)));
typedef float f32x16 __attribute__((ext_vector_type(16)));
typedef float f32x4 __attribute__((ext_vector_type(4)));
typedef unsigned short bf16_t;
#define SK_LAS __attribute__((address_space(3)))
constexpr int PLD = 36;
constexpr int LDS_BYTES = 8 * 2 * 32 * PLD * 4;
__device__ __forceinline__ f32x4 tile(const bf16_t* A, const bf16_t* Bt, int K, size_t arow0, int col0, SK_LAS char* lds) {
    int tid = threadIdx.x; asm volatile("" : "+v"(tid)); const int lane = tid & 63, r32 = lane & 31, hi = lane >> 5; const int wid = __builtin_amdgcn_readfirstlane(tid >> 6);
    const int nsplit = (K >= 512) ? 8 : (K >> 6), ks = K / nsplit;
    const bf16_t* ap = A + (arow0 + r32) * K + wid * ks + hi * 32;
    const bf16_t* bp0 = Bt + (size_t)(col0 + r32) * K + wid * ks + hi * 32; const bf16_t* bp1 = bp0 + (size_t)32 * K;
    f32x16 acc0 = {}, acc1 = {};
#pragma unroll 2
    for (int s = 0; s < ((wid < nsplit) ? ks : 0); s += 64) {
        bf16x8 a[4], b0[4], b1[4];
#pragma unroll
        for (int j = 0; j < 4; ++j) { a[j] = *(const bf16x8*)(ap + s + 8 * j); b0[j] = *(const bf16x8*)(bp0 + s + 8 * j); b1[j] = *(const bf16x8*)(bp1 + s + 8 * j); }
#pragma unroll
        for (int j = 0; j < 4; ++j) {
            acc0 = __builtin_amdgcn_mfma_f32_32x32x16_bf16(b0[j], a[j], acc0, 0, 0, 0);
            acc1 = __builtin_amdgcn_mfma_f32_32x32x16_bf16(b1[j], a[j], acc1, 0, 0, 0); }
    }
    SK_LAS float* P0 = (SK_LAS float*)lds + ((wid * 2 + 0) * 32 + r32) * PLD + 4 * hi; SK_LAS float* P1 = P0 + 32 * PLD;
#pragma unroll
    for (int g = 0; g < 4; ++g) { *(SK_LAS f32x4*)(P0 + 8 * g) = (f32x4){acc0[4 * g], acc0[4 * g + 1], acc0[4 * g + 2], acc0[4 * g + 3]};
                                  *(SK_LAS f32x4*)(P1 + 8 * g) = (f32x4){acc1[4 * g], acc1[4 * g + 1], acc1[4 * g + 2], acc1[4 * g + 3]}; }
    __syncthreads();
    const int row = tid >> 4, c = (tid & 15) * 4, cb = c >> 5, cc = c & 31;
    f32x4 s = {0.f, 0.f, 0.f, 0.f};
#pragma unroll
    for (int w = 0; w < 8; ++w) s += *(const SK_LAS f32x4*)((SK_LAS float*)lds + ((w * 2 + cb) * 32 + row) * PLD + cc);
    __syncthreads();
    return s;
}
__device__ __forceinline__ void tile4(const bf16_t* A, const bf16_t* Bt, int K, size_t arow0, int col0, SK_LAS char* lds, f32x4 (&out)[2][2]) {
    int tid = threadIdx.x; asm volatile("" : "+v"(tid)); const int lane = tid & 63, r32 = lane & 31, hi = lane >> 5; const int wid = __builtin_amdgcn_readfirstlane(tid >> 6);
    const int half = wid >> 2, kq = wid & 3, ks = K >> 2;
    const bf16_t* ap = A + (arow0 + r32) * K + kq * ks + hi * 32;
    const bf16_t* bp = Bt + (size_t)(col0 + half * 128 + r32) * K + kq * ks + hi * 32;
    f32x16 acc[4]; acc[0] = f32x16{}; acc[1] = f32x16{}; acc[2] = f32x16{}; acc[3] = f32x16{};
#pragma unroll 1
    for (int s = 0; s < ks; s += 64) {
        bf16x8 a[4], b[4][4];
#pragma unroll
        for (int e = 0; e < 4; ++e) { a[e] = *(const bf16x8*)(ap + s + 8 * e);
#pragma unroll
            for (int j = 0; j < 4; ++j) b[j][e] = *(const bf16x8*)(bp + (size_t)(32 * j) * K + s + 8 * e); }
#pragma unroll
        for (int e = 0; e < 4; ++e)
#pragma unroll
            for (int j = 0; j < 4; ++j) acc[j] = __builtin_amdgcn_mfma_f32_32x32x16_bf16(b[j][e], a[e], acc[j], 0, 0, 0);
    }
    const int row = tid >> 4, cc = (tid & 15) * 4;
#pragma unroll
    for (int q = 0; q < 2; ++q) {
        SK_LAS float* P0 = (SK_LAS float*)lds + ((wid * 2 + 0) * 32 + r32) * PLD + 4 * hi; SK_LAS float* P1 = P0 + 32 * PLD;
#pragma unroll
        for (int g = 0; g < 4; ++g) { *(SK_LAS f32x4*)(P0 + 8 * g) = (f32x4){acc[2 * q][4 * g], acc[2 * q][4 * g + 1], acc[2 * q][4 * g + 2], acc[2 * q][4 * g + 3]};
                                      *(SK_LAS f32x4*)(P1 + 8 * g) = (f32x4){acc[2 * q + 1][4 * g], acc[2 * q + 1][4 * g + 1], acc[2 * q + 1][4 * g + 2], acc[2 * q + 1][4 * g + 3]}; }
        __syncthreads();
#pragma unroll
        for (int h = 0; h < 2; ++h) { f32x4 sum = {0.f, 0.f, 0.f, 0.f};
#pragma unroll
            for (int w = 0; w < 4; ++w) sum += *(const SK_LAS f32x4*)((SK_LAS float*)lds + (((h * 4 + w) * 2 + (cc >> 5)) * 32 + row) * PLD + (cc & 31));
            out[h][q] = sum; }
        __syncthreads();
    }
}
__device__ __forceinline__ f32x16 wtile(const bf16_t* A, const bf16_t* Bt, int K, size_t arow0, int colw, int lane) {
    const int r32 = lane & 31, hi = lane >> 5;
    const bf16_t* ap = A + (arow0 + r32) * K + hi * 32; const bf16_t* bp = Bt + (size_t)(colw + r32) * K + hi * 32;
    f32x16 acc = {};
#pragma unroll 4
    for (int s = 0; s < K; s += 64) {
        bf16x8 a[4], b[4];
#pragma unroll
        for (int e = 0; e < 4; ++e) { a[e] = *(const bf16x8*)(ap + s + 8 * e); b[e] = *(const bf16x8*)(bp + s + 8 * e); }
#pragma unroll
        for (int e = 0; e < 4; ++e) acc = __builtin_amdgcn_mfma_f32_32x32x16_bf16(b[e], a[e], acc, 0, 0, 0);
    }
    return acc;
}
__device__ __forceinline__ float sum16(float v) { v += __shfl_xor(v, 1); v += __shfl_xor(v, 2); v += __shfl_xor(v, 4); v += __shfl_xor(v, 8); return v; }
__device__ __forceinline__ float rstd16(const float* SSQ, int r, int t) { return __builtin_amdgcn_rsqf(sum16(__hip_atomic_load(SSQ + (size_t)r * 16 + (t & 15), __ATOMIC_RELAXED, __HIP_MEMORY_SCOPE_AGENT)) * (1.0f / 1024.0f) + cfg::EPS); }
__device__ __forceinline__ float rstd_row(const float* SSQ, int r) { const f32x4* p = (const f32x4*)(SSQ + (size_t)r * 16); const f32x4 a = p[0], b = p[1], c = p[2], d = p[3];
    const float s = ((a[0] + a[1]) + (a[2] + a[3])) + ((b[0] + b[1]) + (b[2] + b[3])) + ((c[0] + c[1]) + (c[2] + c[3])) + ((d[0] + d[1]) + (d[2] + d[3])); return __builtin_amdgcn_rsqf(s * (1.0f / 1024.0f) + cfg::EPS); }
__device__ __forceinline__ unsigned long long pk4(f32x4 v) { return (unsigned long long)pg8::cvt_pk_bf16(v[0], v[1]) | ((unsigned long long)pg8::cvt_pk_bf16(v[2], v[3]) << 32); }
__device__ __forceinline__ f32x4 up4(unsigned long long w) { const unsigned lo = (unsigned)w, hi = (unsigned)(w >> 32); return (f32x4){pg8::bf_lo(lo), pg8::bf_hi(lo), pg8::bf_lo(hi), pg8::bf_hi(hi)}; }
}
#define GAS __attribute__((address_space(1)))
#define LAS __attribute__((address_space(3)))
typedef unsigned short bf16;
typedef unsigned v4u __attribute__((ext_vector_type(4)));
typedef float f32x4 __attribute__((ext_vector_type(4)));
typedef short bf16x8 __attribute__((ext_vector_type(8)));
typedef GAS unsigned gu32;
typedef GAS unsigned long long gu64;
#define RLX_AGENT __ATOMIC_RELAXED, __HIP_MEMORY_SCOPE_AGENT
#define LDS_WAIT() asm volatile("s_waitcnt lgkmcnt(0)" ::: "memory")
#define VM_WAIT() asm volatile("s_waitcnt vmcnt(0)" ::: "memory")
__device__ __forceinline__ unsigned long long rt() { return __builtin_amdgcn_s_memrealtime(); }
__device__ __forceinline__ unsigned f2bf(float f) { unsigned u = __builtin_bit_cast(unsigned, f); return (u + 0x7fffu + ((u >> 16) & 1u)) >> 16; }
__device__ __forceinline__ unsigned pk2(float lo, float hi) { return f2bf(lo) | (f2bf(hi) << 16); }
#define XB_TMO      128
#define XB_XCNT(j)  (256  + 64 * (j))
#define XB_XSUB(j)  (1280 + 64 * (j))
#define XB_XGEN(j)  (2304 + 64 * (j))
#define XB_TOP      3328
#define XB_TOPGEN   3392
#define XCD_BAR_WORDS 3456
#define XB_SPIN_CAP (1u << 18)

__device__ __forceinline__ unsigned xb_ld(unsigned* p)              { return __hip_atomic_load(p, __ATOMIC_RELAXED, __HIP_MEMORY_SCOPE_AGENT); }
__device__ __forceinline__ unsigned xb_add(unsigned* p, unsigned v) { return __hip_atomic_fetch_add(p, v, __ATOMIC_RELAXED, __HIP_MEMORY_SCOPE_AGENT); }
__device__ __forceinline__ unsigned xb_xcc_id() { return (unsigned)__builtin_amdgcn_s_getreg((3 << 11) | 20) & 0xFu; }
#define XB_SPIN(cond, bar) do { unsigned _sp = 0; while (cond) { __builtin_amdgcn_s_sleep(1); \
    if ((++_sp & 255u) == 0u) { if (xb_ld(&(bar)[XB_TMO])) break; if (_sp > XB_SPIN_CAP) { atomicAdd(&(bar)[XB_TMO], 1u); break; } } } } while (0)

struct XcdBarrier {
    unsigned* bar; unsigned x;
    volatile LAS unsigned* st;
};

__device__ __forceinline__ XcdBarrier xcd_barrier_post(unsigned* bar, volatile LAS unsigned* st) {
    XcdBarrier b; b.bar = bar; b.x = xb_xcc_id(); b.st = st;
    if (threadIdx.x == 0) (void)xb_add(&bar[XB_XCNT(b.x)], 1u);
    return b;
}
__device__ __forceinline__ void xcd_barrier_complete(unsigned* bar, unsigned x, unsigned& nloc, unsigned& nx) {
    const unsigned G = gridDim.x * gridDim.y * gridDim.z;
    unsigned sum, cnt, mine, sp = 0u;
    for (;;) {
        sum = 0u; cnt = 0u; mine = 0u;
#pragma unroll
        for (unsigned j = 0; j < 16; ++j) { const unsigned c = xb_ld(&bar[XB_XCNT(j)]); sum += c; cnt += (c > 0u) ? 1u : 0u; mine = (j == x) ? c : mine; }
        if (sum == G) break;
        __builtin_amdgcn_s_sleep(1);
        if ((++sp & 255u) == 0u) { if (xb_ld(&bar[XB_TMO])) break; if (sp > XB_SPIN_CAP) { atomicAdd(&bar[XB_TMO], 1u); break; } }
    }
    nloc = mine > 0u ? mine : 1u; nx = cnt > 0u ? cnt : 1u;
}

__device__ __forceinline__ void xcd_barrier(const XcdBarrier& b) {
    asm volatile("s_waitcnt vmcnt(0)" ::: "memory");
    __syncthreads();
    if (threadIdx.x == 0) {
        unsigned* bar = b.bar;
        __builtin_amdgcn_s_waitcnt(0);
        unsigned nloc = b.st[0], nx = b.st[1];
        if (nloc == 0u) { xcd_barrier_complete(bar, b.x, nloc, nx); b.st[0] = nloc; b.st[1] = nx; }
        const unsigned old = xb_add(&bar[XB_XSUB(b.x)], 1u);
        const unsigned gen = old / nloc;
        if (old + 1u == (gen + 1u) * nloc) {
            __builtin_amdgcn_fence(__ATOMIC_RELEASE, "agent");
            asm volatile("s_waitcnt vmcnt(0)" ::: "memory");
            const unsigned og = xb_add(&bar[XB_TOP], 1u);
            const unsigned tg = og / nx;
            if (og + 1u == (tg + 1u) * nx) xb_add(&bar[XB_TOPGEN], 1u);
            else XB_SPIN(xb_ld(&bar[XB_TOPGEN]) == tg, bar);
            __builtin_amdgcn_fence(__ATOMIC_ACQUIRE, "agent");
            xb_add(&bar[XB_XGEN(b.x)], 1u);
            asm volatile("s_waitcnt vmcnt(0)" ::: "memory");
        } else {
            XB_SPIN(xb_ld(&bar[XB_XGEN(b.x)]) == gen, bar);
            __builtin_amdgcn_fence(__ATOMIC_ACQUIRE, "agent");
            asm volatile("s_waitcnt vmcnt(0)" ::: "memory");
        }
    }
    __syncthreads();
}
__device__ __forceinline__ float wave_sum(float v) {
#pragma unroll
    for (int o = 1; o < 64; o <<= 1) v += __shfl_xor(v, o);
    return v;
}
__device__ __forceinline__ void p0_transpose_item(const float* W, int K, int N, bf16* WT, int row_off, LAS float* scr, int item, int lane) {
    const int nblk = N / 32, kb = item / nblk, nb = item % nblk, k0 = 64 * kb, n0 = 32 * nb;
    float tv[32];
#pragma unroll
    for (int i = 0; i < 32; ++i) { const int kk = 2 * i + (lane >> 5); tv[i] = __builtin_nontemporal_load(W + (size_t)(k0 + kk) * N + n0 + (lane & 31)); }
#pragma unroll
    for (int i = 0; i < 32; ++i) { const int kk = 2 * i + (lane >> 5); scr[kk * 33 + (lane & 31)] = tv[i]; }
    LDS_WAIT(); asm volatile("" ::: "memory");
    const int c = lane & 7;
#pragma unroll
    for (int j = 0; j < 4; ++j) { const int n = (lane >> 3) + 8 * j; const LAS float* s = scr + (8 * c) * 33 + n;
        v4u o; o.x = pk2(s[0 * 33], s[1 * 33]); o.y = pk2(s[2 * 33], s[3 * 33]); o.z = pk2(s[4 * 33], s[5 * 33]); o.w = pk2(s[6 * 33], s[7 * 33]);
        *(GAS v4u*)(WT + (size_t)(row_off + n0 + n) * K + k0 + 8 * c) = o; }
    LDS_WAIT(); asm volatile("" ::: "memory");
}

struct P0T { const float* W; bf16* WT; int K, N, item; const float* gk; };
__device__ __forceinline__ void p0_t_load(const P0T& t, int lane, float (&tv)[32]) {
    const int nblk = t.N / 32, kb = t.item / nblk, nb = t.item % nblk, k0 = 64 * kb, n0 = 32 * nb;
#pragma unroll
    for (int i = 0; i < 32; ++i) { const int kk = 2 * i + (lane >> 5); tv[i] = __builtin_nontemporal_load(t.W + (size_t)(k0 + kk) * t.N + n0 + (lane & 31)); }
}
__device__ __forceinline__ void p0_t_finish(const P0T& t, LAS float* scr, int lane, const float (&tv)[32]) {
    const int nblk = t.N / 32, kb = t.item / nblk, nb = t.item % nblk, k0 = 64 * kb, n0 = 32 * nb;
#pragma unroll
    for (int i = 0; i < 32; ++i) { const int kk = 2 * i + (lane >> 5); scr[kk * 33 + (lane & 31)] = tv[i]; }
    LDS_WAIT(); asm volatile("" ::: "memory");
    const int c = lane & 7;
    f32x4 g0 = {1.f, 1.f, 1.f, 1.f}, g1 = g0;
    if (t.gk) { g0 = *(const GAS f32x4*)(t.gk + k0 + 8 * c); g1 = *(const GAS f32x4*)(t.gk + k0 + 8 * c + 4); }
#pragma unroll
    for (int j = 0; j < 4; ++j) { const int n = (lane >> 3) + 8 * j; const LAS float* s = scr + (8 * c) * 33 + n;
        v4u o; o.x = pk2(s[0 * 33] * g0.x, s[1 * 33] * g0.y); o.y = pk2(s[2 * 33] * g0.z, s[3 * 33] * g0.w); o.z = pk2(s[4 * 33] * g1.x, s[5 * 33] * g1.y); o.w = pk2(s[6 * 33] * g1.z, s[7 * 33] * g1.w);
        *(GAS v4u*)(t.WT + (size_t)(n0 + n) * t.K + k0 + 8 * c) = o; }
    LDS_WAIT(); asm volatile("" ::: "memory");
}
constexpr int NWAVES = 8;
#ifndef GROUP_BAR
#define GROUP_BAR 1
#endif
using namespace cfg;
constexpr size_t MiB = 1u << 20;
constexpr size_t WS_CTL = 0, CTL_ZERO_BYTES = MiB / 4;
constexpr size_t WS_WIN = 2 * MiB, WS_WEFF = 10 * MiB, WS_WSB = 11 * MiB, WS_WOUT = 12 * MiB, WS_WUP = 14 * MiB, WS_WDOWN = 22 * MiB, WS_WPG = 30 * MiB, WS_WPP = 32 * MiB;
constexpr size_t WS_SSQ1 = 33 * MiB, WS_SSQ2 = 35 * MiB, WS_SSQ3 = 37 * MiB, WS_RS0 = 39 * MiB  ;
constexpr size_t WS_PB = 40 * MiB;
constexpr size_t WS_XN = 49 * MiB;
constexpr size_t WS_BIG = 82 * MiB;
constexpr int NRG = 2048;
constexpr size_t ARK = (size_t)NRG * 1024;
constexpr size_t AR_U = 0, AR_Q = ARK, AR_K = 2 * ARK, AR_V = 3 * ARK, AR_G = 4 * ARK  , AR_Y = 6 * ARK, AR_YSB = 7 * ARK, ARENA = 8 * ARK;
constexpr size_t AR_MG = 0;
constexpr size_t AR_H = 0;
constexpr size_t AR_PP = 0;
constexpr size_t WS_X = WS_BIG + 8 * ARENA;
constexpr size_t WS_S = WS_X + 33 * MiB;
constexpr size_t SR_U = 0, SR_Q = 512 * 1024, SR_K = 2 * 512 * 1024, SR_V = 3 * 512 * 1024, SR_G = 4 * 512 * 1024  , SR_Y = 6 * 512 * 1024, SR_YSB = 7 * 512 * 1024,
                 SR_MG = 8 * 512 * 1024  , SR_H = 10 * 512 * 1024  , SR_XN1 = 18 * 512 * 1024  , SR_XN2 = 20 * 512 * 1024  , SR_END = 22 * 512 * 1024;
constexpr size_t WS_END = WS_S + SR_END;
static_assert((size_t)MT * 1024 * 2 == 33 * MiB && (size_t)MT * 16 * 4 <= 2 * MiB && (size_t)MT * 256 * 2 <= 9 * MiB && WS_END <= 256 * MiB && ARENA % 16 == 0, "d_ws map");
constexpr int CW_BAR = 4096, CW_FIN = 8192  , CW_FINS = 16384  , CW_XCC = 20480  , CW_GRP = 24576  , CW_SC = 28672  ;
static_assert((CW_SC + 64 * 16 * 7) * 4 <= (int)CTL_ZERO_BYTES, "control words inside the memset region");
constexpr size_t O_Y = 0, O_KP = 17301504, O_VP = 25690112, O_POOLP = 34078720, O_KS = 34140160, O_VS = 34402304, O_POOLS = 34664448, O_END = 34787328;
constexpr int RING_OFF = 0, RING_BYTES = 131072, LDSCTL_OFF = RING_BYTES, MISC_OFF = LDSCTL_OFF + 320, LDS_BYTES = 147456;
static_assert(sk::LDS_BYTES <= RING_BYTES && sba::LDS_BYTES <= RING_BYTES, "phase scratch fits the ring region");

struct Args { const float* in[22]; float* out; unsigned char* ws; };

__device__ __forceinline__ unsigned char* effp(unsigned char* ws, size_t aoff, int pitchB, int g) { return ws + WS_BIG + (size_t)g * ARENA + aoff - (size_t)(2048 * g) * (size_t)pitchB; }
__device__ __forceinline__ unsigned char* effs(unsigned char* ws, size_t soff, int pitchB) { return ws + WS_S + soff - (size_t)MP * (size_t)pitchB; }
__device__ __forceinline__ void st8_wt(void* p, unsigned long long v) { __hip_atomic_store((unsigned long long*)p, v, __ATOMIC_RELAXED, __HIP_MEMORY_SCOPE_AGENT); }
__device__ __forceinline__ void st4_wt(void* p, unsigned v) { __hip_atomic_store((unsigned*)p, v, __ATOMIC_RELAXED, __HIP_MEMORY_SCOPE_AGENT); }
__device__ __forceinline__ void stf_wt(float* p, float v) { __hip_atomic_store(p, v, __ATOMIC_RELAXED, __HIP_MEMORY_SCOPE_AGENT); }
#ifndef P0_TN
#define P0_TN 2
#endif
#ifndef P0_RN
#define P0_RN 4
#endif
#ifndef PLE_GATE_FIRST
#define PLE_GATE_FIRST 1
#endif
#ifndef GRP_L2_ATOMICS
#define GRP_L2_ATOMICS 1
#endif
#ifndef CHAIN_FENCE
#define CHAIN_FENCE 0
#endif
__device__ __forceinline__ void chain_post_wave(gu32* ctl, int s, int rb) {
    asm volatile("s_waitcnt vmcnt(0)" ::: "memory");
    if ((threadIdx.x & 63) == 0) __hip_atomic_fetch_add((unsigned*)(ctl + CW_SC + 64 * (16 * s + rb)), 1u, __ATOMIC_RELAXED, __HIP_MEMORY_SCOPE_AGENT);
}
struct PostHook { gu32* ctl; int s, rb; bool on;
    __device__ __forceinline__ void operator()(int ui) const { if (on && ui == 0) chain_post_wave(ctl, s, rb); } };
__device__ __forceinline__ void chain_wait_wave(gu32* ctl, int s, int rb, unsigned target) {
    unsigned spins = 0;
    while ((unsigned)__builtin_amdgcn_readfirstlane(__hip_atomic_load((unsigned*)(ctl + CW_SC + 64 * (16 * s + rb)), __ATOMIC_RELAXED, __HIP_MEMORY_SCOPE_AGENT)) < target) { __builtin_amdgcn_s_sleep(2); if (++spins > (1u << 18)) break; }
    if (CHAIN_FENCE) { __builtin_amdgcn_fence(__ATOMIC_ACQUIRE, "agent"); asm volatile("s_waitcnt vmcnt(0)" ::: "memory"); }
}
__device__ __forceinline__ void chain_wait(gu32* ctl, int s, int rb, unsigned target) {
    if (threadIdx.x < 64) chain_wait_wave(ctl, s, rb, target);
    __syncthreads();
}

template <int NR>
__device__ __forceinline__ void rms_rows_to_bf16(const float* const (&xrow)[NR], const f32x4 (&gg)[4], bf16* const (&orow)[NR], float* const (&rms_out)[NR], int lane) {
    f32x4 v[NR][4]; float s[NR];
#pragma unroll
    for (int i = 0; i < NR; ++i) { const GAS f32x4* xr = (const GAS f32x4*)(xrow[i] ? xrow[i] : xrow[0]) + lane;
#pragma unroll
        for (int j = 0; j < 4; ++j) v[i][j] = __builtin_nontemporal_load(xr + 64 * j); }
#pragma unroll
    for (int i = 0; i < NR; ++i) { s[i] = 0.f;
#pragma unroll
        for (int j = 0; j < 4; ++j) s[i] += (v[i][j].x * v[i][j].x + v[i][j].y * v[i][j].y) + (v[i][j].z * v[i][j].z + v[i][j].w * v[i][j].w); }
#pragma unroll
    for (int o = 1; o < 64; o <<= 1)
#pragma unroll
        for (int i = 0; i < NR; ++i) s[i] += __shfl_xor(s[i], o);
#pragma unroll
    for (int i = 0; i < NR; ++i) { const float rms = sqrtf(s[i] * (1.f / DM) + EPS), rs = 1.f / rms;
        if (xrow[i] && rms_out[i] && lane == 0) *rms_out[i] = rms;
        if (xrow[i]) { GAS unsigned long long* o0 = (GAS unsigned long long*)orow[i] + lane;
#pragma unroll
            for (int j = 0; j < 4; ++j) o0[64 * j] = (unsigned long long)pk2(v[i][j].x * rs * gg[j].x, v[i][j].y * rs * gg[j].y) | ((unsigned long long)pk2(v[i][j].z * rs * gg[j].z, v[i][j].w * rs * gg[j].w) << 32); } }
}
__device__ __forceinline__ void weff_item(const float* wgrp, const float* scale, const float* wpu, bf16* WT, int item, int lane) {
    const int nb = item & 15, cb = (item >> 4) & 15, g = item >> 8, n = nb * 64 + lane;
    float wg[8][2];
#pragma unroll
    for (int cc = 0; cc < 8; ++cc)
#pragma unroll
        for (int hh = 0; hh < 2; ++hh) wg[cc][hh] = wgrp[((size_t)(g * 128 + cb * 8 + cc)) * 128 + lane + 64 * hh] * scale[g * 128 + lane + 64 * hh];
    float acc[8];
#pragma unroll
    for (int cc = 0; cc < 8; ++cc) acc[cc] = 0.f;
#pragma unroll
    for (int hh = 0; hh < 2; ++hh)
#pragma unroll
        for (int q = 0; q < 2; ++q) { float wv[32];
#pragma unroll
            for (int d2 = 0; d2 < 32; ++d2) wv[d2] = wpu[(size_t)(g * 128 + hh * 64 + q * 32 + d2) * 1024 + n];
#pragma unroll
            for (int d2 = 0; d2 < 32; ++d2)
#pragma unroll
                for (int cc = 0; cc < 8; ++cc) acc[cc] = fmaf(__builtin_bit_cast(float, __builtin_amdgcn_readlane(__builtin_bit_cast(int, wg[cc][hh]), q * 32 + d2)), wv[d2], acc[cc]);
            asm volatile("" ::: "memory"); }
    v4u o; o.x = pk2(acc[0], acc[1]); o.y = pk2(acc[2], acc[3]); o.z = pk2(acc[4], acc[5]); o.w = pk2(acc[6], acc[7]);
    *(GAS v4u*)(WT + (size_t)n * 512 + g * 128 + cb * 8) = o;
}
template <int W, int R, bool WT>
__device__ __forceinline__ void pool_run(const bf16* Ub, const float* state_pool, bf16* Yb, int r0, int c, bool sample, int t0, int b_) {
    v4u rw[R - 1 + W];
#pragma unroll
    for (int k = 0; k < W - 1; ++k) { const int pos = t0 + k - (W - 1);
        if (pos >= 0) rw[k] = *(const GAS v4u*)(Ub + (size_t)(r0 - (W - 1) + k) * 512 + c);
        else if (sample) { const float* sp = state_pool + ((size_t)b_ * 15 + 15 + pos) * 512 + c; const f32x4 a = *(const GAS f32x4*)sp, b = *(const GAS f32x4*)(sp + 4); rw[k] = pg8::pack8(a, b); }
        else rw[k] = (v4u){0u, 0u, 0u, 0u}; }
#pragma unroll
    for (int k = W - 1; k < R - 1 + W; ++k) rw[k] = *(const GAS v4u*)(Ub + (size_t)(r0 - (W - 1) + k) * 512 + c);
    f32x4 s0 = {0.f, 0.f, 0.f, 0.f}, s1 = {0.f, 0.f, 0.f, 0.f};
#pragma unroll
    for (int k = 0; k < W - 1; ++k) { f32x4 a, b; pg8::unpack8(rw[k], a, b); s0 += a; s1 += b; }
#pragma unroll
    for (int i = 0; i < R; ++i) { f32x4 a, b, u0, u1; pg8::unpack8(rw[W - 1 + i], u0, u1); s0 += u0; s1 += u1;
        const int cnt = sample ? W : ((t0 + i + 1 < W) ? t0 + i + 1 : W); const float ic = 1.0f / (float)cnt;
        { const v4u yv = pg8::pack8(s0 * ic - u0, s1 * ic - u1);
          if (WT) { st8_wt(Yb + (size_t)(r0 + i) * 512 + c, (unsigned long long)yv.x | ((unsigned long long)yv.y << 32)); st8_wt(Yb + (size_t)(r0 + i) * 512 + c + 4, (unsigned long long)yv.z | ((unsigned long long)yv.w << 32)); }
          else *(GAS v4u*)(Yb + (size_t)(r0 + i) * 512 + c) = yv; }
        pg8::unpack8(rw[i], a, b); s0 -= a; s1 -= b; }
}
template <bool WT>
__device__ __forceinline__ void pool_item(int cg, const bf16* Ub, const float* state_pool, bf16* Yb, int r0, int c, bool sample, int t0, int b_) {
    if (cg == 0) pool_run<2, 16, WT>(Ub, state_pool, Yb, r0, c, sample, t0, b_); else if (cg == 1) pool_run<4, 16, WT>(Ub, state_pool, Yb, r0, c, sample, t0, b_); else if (cg == 2) pool_run<8, 16, WT>(Ub, state_pool, Yb, r0, c, sample, t0, b_);
    else { pool_run<16, 8, WT>(Ub, state_pool, Yb, r0, c, sample, t0, b_); asm volatile("" ::: "memory"); pool_run<16, 8, WT>(Ub, state_pool, Yb, r0 + 8, c, sample, t0 + 8, b_); }
}

__device__ __forceinline__ unsigned l2_add_ret(unsigned* p, unsigned v) {
    unsigned r;
    asm volatile("global_atomic_add %0, %1, %2, off sc0\n\ts_waitcnt vmcnt(0)" : "=&v"(r) : "v"(p), "v"(v) : "memory");
    return r;
}
__device__ __forceinline__ void grp_barrier(unsigned* cnt, unsigned members, volatile LAS unsigned* round_word, bool raw) {
    if (raw) { asm volatile("s_waitcnt lgkmcnt(0)" ::: "memory"); __builtin_amdgcn_s_barrier(); }
    else { asm volatile("s_waitcnt vmcnt(0)" ::: "memory");
           __syncthreads(); }
    if (threadIdx.x == 0) {
        const unsigned round = round_word[0] + 1u; round_word[0] = round;
#if GRP_L2_ATOMICS
        __hip_atomic_fetch_add(cnt, 1u, __ATOMIC_RELAXED, __HIP_MEMORY_SCOPE_WORKGROUP);
        unsigned spins = 0;
        const unsigned base = round_word[1];
        while (l2_add_ret(cnt, 0u) - base < members * round) { __builtin_amdgcn_s_sleep(1); if (++spins > (1u << 20)) break; }
#else
        __hip_atomic_fetch_add(cnt, 1u, __ATOMIC_RELAXED, __HIP_MEMORY_SCOPE_AGENT);
        unsigned spins = 0;
        while (__hip_atomic_load(cnt, __ATOMIC_RELAXED, __HIP_MEMORY_SCOPE_AGENT) < members * round) { __builtin_amdgcn_s_sleep(1); if (++spins > (1u << 20)) break; }
#endif
        __builtin_amdgcn_fence(__ATOMIC_ACQUIRE, "agent");
        asm volatile("s_waitcnt vmcnt(0)" ::: "memory");
    }
    __syncthreads();
}

__global__ void __launch_bounds__(NWAVES * 64, 2) mega_fwd(Args args) {
    extern __shared__ __attribute__((aligned(16))) unsigned char lds[];
    LAS unsigned char* L = (LAS unsigned char*)lds;
    volatile LAS unsigned* MISC = (volatile LAS unsigned*)(L + MISC_OFF);
    const int wave = __builtin_amdgcn_readfirstlane(threadIdx.x >> 6);
#define FRESH_TID() int tid = threadIdx.x; asm volatile("" : "+v"(tid)); const int lane = tid & 63; (void)lane
    const int G = gridDim.x, bx = blockIdx.x, vcu = (bx % 8) * (G / 8) + bx / 8;
    const int grp = vcu >> 5, gi = vcu & 31;
    unsigned char* ws = args.ws;
    gu32* ctl = (gu32*)(ws + WS_CTL);
    const float* x_p = args.in[0]; const float* x_s = args.in[1]; const float* cache_k = args.in[2]; const float* cache_v = args.in[3]; const float* state_pool = args.in[4];
    const float* p_p = args.in[5]; const float* p_s = args.in[6]; const float* g_mix = args.in[7]; const float* w_in = args.in[8]; const float* b_gate = args.in[9]; const float* w_grp = args.in[10];
    const float* pool_scale = args.in[11]; const float* w_pool_up = args.in[12]; const float* w_sb_up = args.in[13]; const float* w_out = args.in[14]; const float* g_mlp = args.in[15];
    const float* w_up = args.in[16]; const float* w_down = args.in[17]; const float* g_ple = args.in[18]; const float* w_ple_gate = args.in[19]; const float* w_ple_proj = args.in[20]; const float* g_final = args.in[21];
    float* out = args.out; float* Yo = out + O_Y;
    bf16 *WIN = (bf16*)(ws + WS_WIN), *WEFF = (bf16*)(ws + WS_WEFF), *WSB = (bf16*)(ws + WS_WSB), *WOUT = (bf16*)(ws + WS_WOUT), *WUP = (bf16*)(ws + WS_WUP), *WDOWN = (bf16*)(ws + WS_WDOWN), *WPG = (bf16*)(ws + WS_WPG), *WPP = (bf16*)(ws + WS_WPP);
    float *SSQ1 = (float*)(ws + WS_SSQ1), *SSQ2 = (float*)(ws + WS_SSQ2), *SSQ3 = (float*)(ws + WS_SSQ3), *RS0 = (float*)(ws + WS_RS0);
    bf16 *PB = (bf16*)(ws + WS_PB), *XN = (bf16*)(ws + WS_XN), *XB = (bf16*)(ws + WS_X);
    const int srb = vcu & 15, scb = vcu >> 4;
#define PV(aoff, pitchB) ((bf16*)effp(ws, aoff, pitchB, g_))
#define SV(soff, pitchB) ((bf16*)effs(ws, soff, pitchB))
#define OPQ() int g_ = grp, r_ = srb; asm volatile("" : "+s"(g_), "+s"(r_))

    for (int i = threadIdx.x; i < (LDS_BYTES - LDSCTL_OFF) / 4; i += NWAVES * 64) ((LAS unsigned*)(L + LDSCTL_OFF))[i] = 0u;
    __syncthreads();
    if (GRP_L2_ATOMICS && threadIdx.x == 0) MISC[13] = l2_add_ret((unsigned*)(ctl + CW_GRP + 64 * grp), 0u);
    XcdBarrier bar = xcd_barrier_post((unsigned*)(ctl + CW_BAR), MISC + 8);
    if (threadIdx.x == 0) __hip_atomic_fetch_add((unsigned*)(ctl + CW_XCC + 16 * grp + (int)(bar.x & 15u)), 1u, __ATOMIC_RELAXED, __HIP_MEMORY_SCOPE_AGENT);
    const int gw = vcu * NWAVES + wave, NGW = G * NWAVES;
    const bool late_ = (vcu & 1) != 0;

    {
        FRESH_TID();
        LAS float* scr = (LAS float*)(L + RING_OFF + wave * 16384);
        constexpr int I_IN = (DM / 64) * (INW / 32), I_SB = (SBW / 64) * (DM / 32), I_OUT = (DM / 64) * (DM / 32), I_UP = (DM / 64) * (DFF / 32), I_DOWN = (DFF / 64) * (DM / 32), I_PG = I_OUT, I_PP = (PLE / 64) * (DM / 32), I_EFF = 4 * 16 * 16;
        constexpr int NITEMS = I_IN + I_SB + I_OUT + I_UP + I_DOWN + I_PG + I_PP + I_EFF;
        for (int it = gw; it < I_EFF; it += NGW) weff_item(w_grp, pool_scale, w_pool_up, WEFF, it, lane);
        constexpr int NT = NITEMS - I_EFF;
        auto decode = [&](int r) -> P0T {
            if (r < I_IN) return P0T{w_in, WIN, DM, INW, r, FOLD_G ? g_mix : nullptr}; r -= I_IN;
            if (r < I_SB) return P0T{w_sb_up, WSB, SBW, DM, r, nullptr}; r -= I_SB;
            if (r < I_OUT) return P0T{w_out, WOUT, DM, DM, r, nullptr}; r -= I_OUT;
            if (r < I_UP) return P0T{w_up, WUP, DM, DFF, r, FOLD_G ? g_mlp : nullptr}; r -= I_UP;
            if (r < I_DOWN) return P0T{w_down, WDOWN, DFF, DM, r, nullptr}; r -= I_DOWN;
            if (r < I_PG) return P0T{w_ple_gate, WPG, DM, DM, r, FOLD_G ? g_ple : nullptr}; r -= I_PG;
            return P0T{w_ple_proj, WPP, PLE, DM, r, nullptr}; };
#pragma unroll 1
        for (int it = NGW - 1 - gw; it < NT; it += P0_TN * NGW) {
            P0T tt[P0_TN]; float tv[P0_TN][32];
#pragma unroll
            for (int i = 0; i < P0_TN; ++i) { const int iti = it + i * NGW; tt[i] = decode(iti < NT ? iti : it); if (iti >= NT) tt[i].item = -1; }
#pragma unroll
            for (int i = 0; i < P0_TN; ++i) if (tt[i].item >= 0) p0_t_load(tt[i], lane, tv[i]);
#pragma unroll
            for (int i = 0; i < P0_TN; ++i) if (tt[i].item >= 0) p0_t_finish(tt[i], scr, lane, tv[i]);
        }
        f32x4 gg[4];
#pragma unroll
        for (int j = 0; j < 4; ++j) gg[j] = FOLD_G ? (f32x4){1.f, 1.f, 1.f, 1.f} : *((const GAS f32x4*)g_mix + lane + 64 * j);
#pragma unroll 1
        for (int m = gw; m < MT; m += P0_RN * NGW) {
            const float* xr[P0_RN]; bf16* orow[P0_RN]; const float* pr[P0_RN]; f32x4 pv[P0_RN]; float* ro[P0_RN];
#pragma unroll
            for (int i = 0; i < P0_RN; ++i) { const int mi = m + i * NGW; const bool ok = mi < MT;
                xr[i] = !ok ? nullptr : (mi < MP ? x_p + (size_t)mi * DM : x_s + (size_t)(mi - MP) * DM);
                pr[i] = !ok ? p_p : (mi < MP ? p_p + (size_t)mi * PLE : p_s + (size_t)(mi - MP) * PLE);
                orow[i] = XN + (size_t)(ok ? mi : m) * DM; ro[i] = (ok && mi < MP) ? RS0 + mi : nullptr; }
#pragma unroll
            for (int i = 0; i < P0_RN; ++i) pv[i] = __builtin_nontemporal_load((const GAS f32x4*)pr[i] + lane);
            rms_rows_to_bf16<P0_RN>(xr, gg, orow, ro, lane);
#pragma unroll
            for (int i = 0; i < P0_RN; ++i) if (xr[i]) *((GAS unsigned long long*)(PB + (size_t)(m + i * NGW) * PLE) + lane) = (unsigned long long)pk2(pv[i].x, pv[i].y) | ((unsigned long long)pk2(pv[i].z, pv[i].w) << 32);
        }
    }
    xcd_barrier(bar);
    bool fast = false;
    if (GROUP_BAR) {
        bool okg = false;
        if (threadIdx.x < 128) okg = __hip_atomic_load((unsigned*)(ctl + CW_XCC + (int)threadIdx.x), __ATOMIC_RELAXED, __HIP_MEMORY_SCOPE_AGENT) == 32u;
        const unsigned long long bm = __ballot(okg);
        if ((threadIdx.x & 63) == 0 && wave < 2) MISC[16 + wave] = (unsigned)__builtin_popcountll(bm);
        __syncthreads();
        fast = (MISC[16] + MISC[17] == 8u) && (G == 256);
    }
    unsigned* gcnt = (unsigned*)(ctl + CW_GRP + 64 * grp);
#define SEAM(RAW) do { if (fast) grp_barrier(gcnt, 32u, MISC + 12, (RAW)); else xcd_barrier(bar); } while (0)
#define DRAIN_PLAIN() asm volatile("s_waitcnt vmcnt(0)" ::: "memory")
#define LATE_POST(S) do { if (late_) chain_post_wave(ctl, (S), srb); } while (0)

#pragma unroll 1
    for (int pass_ = 0; pass_ < 2; ++pass_) { OPQ(); if ((pass_ == 1) == late_) {
        { const int col0 = scb * 256; f32x4 vv[2][2];
            sk::tile4(XN, WIN, DM, (size_t)MP + srb * 32, col0, (SK_LAS char*)(L + RING_OFF), vv);
            DRAIN_PLAIN();
            int t_raw_ = threadIdx.x; asm volatile("" : "+v"(t_raw_)); const int t = t_raw_, rs = srb * 32 + (t >> 4), r = MP + rs;
#pragma unroll
            for (int h = 0; h < 2; ++h)
#pragma unroll
                for (int q = 0; q < 2; ++q) { const f32x4 v = vv[h][q]; const int c = col0 + 128 * h + 64 * q + (t & 15) * 4;
            if (c < 512) { st8_wt(SV(SR_U, 1024) + (size_t)r * 512 + c, sk::pk4(v)); const int i = rs & 31; if (i >= 17) *(GAS f32x4*)(out + O_POOLS + ((size_t)(rs >> 5) * 15 + (i - 17)) * 512 + c) = v; }
            else if (c < 1024) st8_wt(SV(SR_Q, 1024) + (size_t)r * 512 + c - 512, sk::pk4(v * QSCALE));
            else if (c < 1536) { st8_wt(SV(SR_K, 1024) + (size_t)r * 512 + c - 1024, sk::pk4(v)); *(GAS f32x4*)(out + O_KS + (size_t)rs * 512 + c - 1024) = v; }
            else if (c < 2048) { st8_wt(SV(SR_V, 1024) + (size_t)r * 512 + c - 1536, sk::pk4(v)); *(GAS f32x4*)(out + O_VS + (size_t)rs * 512 + c - 1536) = v; }
            else { const f32x4 bg = *(const GAS f32x4*)(b_gate + c - 2048); st4_wt((unsigned char*)SV(SR_G, 2048) + (size_t)r * 2048 + c - 2048, pg8::pk_u8x4(pg8::sigm4(v + bg))); } }
        }
    } else {
        pg8::Gemm g{XN, WIN, MP, INW, DM}; pg8::StaticOrder S; S.init(MP, INW, G, bx);
        pg8::EpiIn E{PV(AR_U, 1024), PV(AR_Q, 1024), PV(AR_K, 1024), PV(AR_V, 1024), PV(AR_G, 2048), b_gate, out + O_KP, out + O_VP, out + O_KS, out + O_VS, out + O_POOLP, out + O_POOLS};
        pg8::gemm_phase<pg8::EpiIn, pg8::StaticOrder, true, true, PostHook>(L + RING_OFF, g, S, E, PostHook{ctl, 1, srb, !late_});
    } }
    SEAM(late_); LATE_POST(1);
    {
        FRESH_TID(); OPQ();
        const bool host_ = (gi & 7) == 7; const int rho_ = gi - (gi >> 3);
        if (!host_ && (wave < 4 || (wave == 5 && rho_ < 16))) { const int wi = wave < 4 ? wave * 28 + rho_ : 112 + rho_, cg = wi & 3, k = lane >> 4, lrow = ((wi >> 2) * 4 + k) * 16;
            const bf16* ub = (const bf16*)(effp(ws, AR_U, 1024, g_) + (size_t)g_ * 2048 * 1024); bf16* yb = (bf16*)(effp(ws, AR_Y, 1024, g_) + (size_t)g_ * 2048 * 1024);
            pool_item<false>(cg, ub, state_pool, yb, lrow, cg * 128 + (lane & 15) * 8, false, lrow & (SEQ - 1), 0); }
        if (wave == 4 && (vcu & 7) == 0) { const int si = vcu >> 3, cg = si & 3, run4 = si >> 2, k = lane >> 4, rs = (run4 * 4 + k) * 16;
            chain_wait_wave(ctl, 1, 2 * run4, 128u); chain_wait_wave(ctl, 1, 2 * run4 + 1, 128u);
            pool_item<true>(cg, SV(SR_U, 1024), state_pool, SV(SR_Y, 1024), MP + rs, cg * 128 + (lane & 15) * 8, true, rs & 31, rs >> 5);
            asm volatile("s_waitcnt vmcnt(0)" ::: "memory");
            if (lane == 0) { __hip_atomic_fetch_add((unsigned*)(ctl + CW_SC + 64 * (16 * 2 + 2 * run4)), 1u, __ATOMIC_RELAXED, __HIP_MEMORY_SCOPE_AGENT); __hip_atomic_fetch_add((unsigned*)(ctl + CW_SC + 64 * (16 * 2 + 2 * run4 + 1)), 1u, __ATOMIC_RELAXED, __HIP_MEMORY_SCOPE_AGENT); } }
        volatile LAS unsigned* sbflags = (volatile LAS unsigned*)(L + LDSCTL_OFF + 1024);
        { const sba::Tensors T{PV(AR_Q, 1024), PV(AR_K, 1024), PV(AR_V, 1024), PV(AR_YSB, 1024), cache_k, cache_v}; const int hg = gi & 1, s = gi >> 1;
#pragma unroll 1
          for (int k = 0; k < 2; ++k) sba::sb_unit<false>(grp, hg, (k & 1) ? 31 - s : s, T, (SB_LAS char*)(L + RING_OFF), sbflags); }
        if ((vcu & 7) == 7) { const int rb = vcu >> 4, hg = (vcu >> 3) & 1;
            chain_wait(ctl, 1, rb, 128u);
            const sba::Tensors T{SV(SR_Q, 1024), SV(SR_K, 1024), SV(SR_V, 1024), SV(SR_YSB, 1024), cache_k, cache_v};
            sba::sb_unit<true>(rb, hg, 0, T, (SB_LAS char*)(L + RING_OFF), sbflags); }
    }
    SEAM((vcu & 7) == 7);
    if ((vcu & 7) == 7 && wave < 4) chain_post_wave(ctl, 2, vcu >> 4);
#pragma unroll 1
    for (int pass_ = 0; pass_ < 2; ++pass_) { OPQ(); if ((pass_ == 1) == late_) {
        { const int rb = srb, col0 = scb * 64;
            chain_wait(ctl, 2, rb, 12u);
            unsigned gaw, gbw;
            { int te_ = threadIdx.x; asm volatile("" : "+v"(te_)); const size_t go = (size_t)(MP + rb * 32 + (te_ >> 4)) * 2048 + col0 + (te_ & 15) * 4; gaw = *(const GAS unsigned*)((const unsigned char*)SV(SR_G, 2048) + go); gbw = *(const GAS unsigned*)((const unsigned char*)SV(SR_G, 2048) + go + 1024); }
            const f32x4 va = sk::tile(SV(SR_Y, 1024), WEFF, PW, (size_t)MP + rb * 32, col0, (SK_LAS char*)(L + RING_OFF));
            const f32x4 vb = sk::tile(SV(SR_YSB, 1024), WSB, SBW, (size_t)MP + rb * 32, col0, (SK_LAS char*)(L + RING_OFF));
            int t_raw_ = threadIdx.x; asm volatile("" : "+v"(t_raw_)); const int t = t_raw_, r = MP + rb * 32 + (t >> 4), c = col0 + (t & 15) * 4;
            const f32x4 ga = pg8::up_u8x4(gaw), gb = pg8::up_u8x4(gbw);
            DRAIN_PLAIN();
            st8_wt(SV(SR_MG, 2048) + (size_t)r * 1024 + c, sk::pk4(ga * va + gb * vb));
        }
    } else {
        pg8::Gemm g{PV(AR_Y, 1024), WEFF, MP, DM, PW, PV(AR_YSB, 1024), WSB}; pg8::PairOrder S; S.init(MP, DM, G, bx); pg8::EpiMerge E{PV(AR_G, 2048), PV(AR_MG, 2048)};
        pg8::gemm_phase<pg8::EpiMerge, pg8::PairOrder, true, true, PostHook>(L + RING_OFF, g, S, E, PostHook{ctl, 3, srb, !late_});
    } }
    SEAM(late_); LATE_POST(3);
#pragma unroll 1
    for (int pass_ = 0; pass_ < 2; ++pass_) { OPQ(); if ((pass_ == 1) == late_) {
        { const int rb = srb, col0 = scb * 64;
            chain_wait(ctl, 3, rb, 128u);
            f32x4 xe;
            { int te_ = threadIdx.x; asm volatile("" : "+v"(te_)); xe = *(const GAS f32x4*)(x_s + (size_t)(rb * 32 + (te_ >> 4)) * DM + col0 + (te_ & 15) * 4); }
            const f32x4 v = sk::tile(SV(SR_MG, 2048), WOUT, DM, (size_t)MP + rb * 32, col0, (SK_LAS char*)(L + RING_OFF));
            int t_raw_ = threadIdx.x; asm volatile("" : "+v"(t_raw_)); const int t = t_raw_, rs = rb * 32 + (t >> 4), r = MP + rs, c = col0 + (t & 15) * 4;
            DRAIN_PLAIN();
            const f32x4 x1 = xe + v; st8_wt(XB + (size_t)r * DM + c, sk::pk4(x1));
            st8_wt(SV(SR_XN1, 2048) + (size_t)r * DM + c, sk::pk4(FOLD_G ? x1 : x1 * *(const GAS f32x4*)(g_mlp + c)));
            const float ss = sk::sum16(pg8::dot4(x1)); if ((t & 15) == 0) stf_wt(SSQ1 + (size_t)r * 16 + (col0 >> 6), ss);
        }
    } else {
        pg8::Gemm g{PV(AR_MG, 2048), WOUT, MP, DM, DM}; pg8::StaticOrder S; S.init(MP, DM, G, bx); pg8::EpiResid<true> E{x_p, XB, XN, g_mlp, SSQ1, XN, RS0};
        pg8::gemm_phase<pg8::EpiResid<true>, pg8::StaticOrder, true, true, PostHook>(L + RING_OFF, g, S, E, PostHook{ctl, 4, srb, !late_});
    } }
    SEAM(late_); LATE_POST(4);
#pragma unroll 1
    for (int pass_ = 0; pass_ < 2; ++pass_) { OPQ(); if ((pass_ == 1) == late_) {
        { const int rb = srb, col0 = scb * 256; f32x4 vv[2][2];
            chain_wait(ctl, 4, rb, 128u);
            float rs_;
            { int te_ = threadIdx.x; asm volatile("" : "+v"(te_)); rs_ = sk::rstd16(SSQ1, MP + rb * 32 + (te_ >> 4), te_); }
            sk::tile4(SV(SR_XN1, 2048), WUP, DM, (size_t)MP + rb * 32, col0, (SK_LAS char*)(L + RING_OFF), vv);
            DRAIN_PLAIN();
            int t_raw_ = threadIdx.x; asm volatile("" : "+v"(t_raw_)); const int t = t_raw_, r = MP + rb * 32 + (t >> 4);
#pragma unroll
            for (int h = 0; h < 2; ++h)
#pragma unroll
                for (int q = 0; q < 2; ++q) { const int c = col0 + 128 * h + 64 * q + (t & 15) * 4; const f32x4 a = __builtin_elementwise_max(vv[h][q] * rs_, (f32x4){0.f, 0.f, 0.f, 0.f});
                    st8_wt(SV(SR_H, 8192) + (size_t)r * DFF + c, sk::pk4(a * a)); }
        }
    } else {
        pg8::Gemm g{FOLD_G ? XB : XN, WUP, MP, DFF, DM}; pg8::StaticOrder S; S.init(MP, DFF, G, bx); pg8::EpiUp E{SSQ1, PV(AR_H, 8192)};
        pg8::gemm_phase<pg8::EpiUp, pg8::StaticOrder, true, true, PostHook>(L + RING_OFF, g, S, E, PostHook{ctl, 5, srb, !late_});
    } }
    SEAM(late_); LATE_POST(5);
#pragma unroll 1
    for (int pass_ = 0; pass_ < 2; ++pass_) { OPQ(); if ((pass_ == 1) == late_) {
        { const int rb = srb, col0 = scb * 64;
            chain_wait(ctl, 5, rb, 128u);
            unsigned long long xw_;
            { int te_ = threadIdx.x; asm volatile("" : "+v"(te_)); xw_ = *(const GAS unsigned long long*)(XB + (size_t)(MP + rb * 32 + (te_ >> 4)) * DM + col0 + (te_ & 15) * 4); }
            const f32x4 v = sk::tile(SV(SR_H, 8192), WDOWN, DFF, (size_t)MP + rb * 32, col0, (SK_LAS char*)(L + RING_OFF));
            int t_raw_ = threadIdx.x; asm volatile("" : "+v"(t_raw_)); const int t = t_raw_, r = MP + rb * 32 + (t >> 4), c = col0 + (t & 15) * 4;
            DRAIN_PLAIN();
            const f32x4 x2 = sk::up4(xw_) + v; st8_wt(XB + (size_t)r * DM + c, sk::pk4(x2));
            st8_wt(SV(SR_XN2, 2048) + (size_t)r * DM + c, sk::pk4(FOLD_G ? x2 : x2 * *(const GAS f32x4*)(g_ple + c)));
            const float ss = sk::sum16(pg8::dot4(x2)); if ((t & 15) == 0) stf_wt(SSQ2 + (size_t)r * 16 + (col0 >> 6), ss);
        }
    } else {
        pg8::Gemm g{PV(AR_H, 8192), WDOWN, MP, DM, DFF}; pg8::StaticOrder S; S.init(MP, DM, G, bx); pg8::EpiResid<false> E{nullptr, XB, XN, g_ple, SSQ2};
        pg8::gemm_phase<pg8::EpiResid<false>, pg8::StaticOrder, true, true, PostHook>(L + RING_OFF, g, S, E, PostHook{ctl, 6, srb, !late_});
    } }
    SEAM(late_); LATE_POST(6);
#pragma unroll 1
    for (int pass_ = 0; pass_ < 2; ++pass_) { OPQ(); if ((pass_ == 1) == late_) {
        { const int rb = srb, col0 = scb * 64;
            chain_wait(ctl, 6, rb, 128u);
            float rs_; unsigned long long xw_;
            { int te_ = threadIdx.x; asm volatile("" : "+v"(te_)); rs_ = sk::rstd16(SSQ2, MP + rb * 32 + (te_ >> 4), te_); xw_ = *(const GAS unsigned long long*)(XB + (size_t)(MP + rb * 32 + (te_ >> 4)) * DM + col0 + (te_ & 15) * 4); }
            const f32x4 vp = sk::tile(PB, WPP, PLE, (size_t)MP + rb * 32, col0, (SK_LAS char*)(L + RING_OFF));
            const f32x4 vg = sk::tile(SV(SR_XN2, 2048), WPG, DM, (size_t)MP + rb * 32, col0, (SK_LAS char*)(L + RING_OFF));
            int t_raw_ = threadIdx.x; asm volatile("" : "+v"(t_raw_)); const int t = t_raw_, r = MP + rb * 32 + (t >> 4), c = col0 + (t & 15) * 4;
            const f32x4 x3 = sk::up4(xw_) + pg8::sigm4(vg * rs_) * vp;
            const float ss = sk::sum16(pg8::dot4(x3)); if ((t & 15) == 0) __hip_atomic_store(SSQ3 + (size_t)r * 16 + (col0 >> 6), ss, __ATOMIC_RELAXED, __HIP_MEMORY_SCOPE_AGENT);
            asm volatile("s_waitcnt vmcnt(0)" ::: "memory");
            unsigned* cw = (unsigned*)(ctl + CW_FINS + 64 * rb);
            if ((t & 63) == 0) __hip_atomic_fetch_add(cw, 1u, __ATOMIC_RELAXED, __HIP_MEMORY_SCOPE_AGENT);
            { unsigned spins = 0; while ((unsigned)__builtin_amdgcn_readfirstlane(__hip_atomic_load(cw, __ATOMIC_RELAXED, __HIP_MEMORY_SCOPE_AGENT)) < 128u) { __builtin_amdgcn_s_sleep(2); if (++spins > (1u << 16)) break; } }
            const float r3 = __builtin_amdgcn_rsqf(sk::sum16(__hip_atomic_load(SSQ3 + (size_t)r * 16 + (t & 15), __ATOMIC_RELAXED, __HIP_MEMORY_SCOPE_AGENT)) * (1.0f / 1024.0f) + EPS);
            *(GAS f32x4*)(Yo + (size_t)r * DM + c) = x3 * r3 * *(const GAS f32x4*)(g_final + c);
        }
    } else {
#if PLE_GATE_FIRST
        { pg8::Gemm g{FOLD_G ? XB : XN, WPG, MP, DM, DM}; pg8::StaticOrder S; S.init(MP, DM, G, bx); pg8::EpiGate8 E{SSQ2, (unsigned char*)PV(AR_PP, 1024)};
          pg8::gemm_phase<pg8::EpiGate8, pg8::StaticOrder, true, true>(L + RING_OFF, g, S, E); }
        { pg8::Gemm g{PB, WPP, MP, DM, PLE}; pg8::StaticOrder S; S.init(MP, DM, G, bx); pg8::EpiPleFinal2 E{(const unsigned char*)PV(AR_PP, 1024), XB, Yo, SSQ3, g_final, (unsigned*)(ctl + CW_FIN)};
          pg8::gemm_phase<pg8::EpiPleFinal2, pg8::StaticOrder, true, true>(L + RING_OFF, g, S, E); }
#else
        { pg8::Gemm g{PB, WPP, MP, DM, PLE}; pg8::StaticOrder S; S.init(MP, DM, G, bx); pg8::EpiPP E{PV(AR_PP, 2048)};
          pg8::gemm_phase<pg8::EpiPP, pg8::StaticOrder, true, true>(L + RING_OFF, g, S, E); }
        { pg8::Gemm g{FOLD_G ? XB : XN, WPG, MP, DM, DM}; pg8::StaticOrder S; S.init(MP, DM, G, bx); pg8::EpiPleFinal E{SSQ2, PV(AR_PP, 2048), XB, Yo, SSQ3, g_final, (unsigned*)(ctl + CW_FIN)};
          pg8::gemm_phase<pg8::EpiPleFinal, pg8::StaticOrder, true, true>(L + RING_OFF, g, S, E); }
#endif
    } }
#undef SEAM
#undef LATE_POST
#undef DRAIN_PLAIN
#undef PV
#undef SV
#undef OPQ
#undef FRESH_TID
}

extern "C" void kernel_launch(void* const* d_in, const int* in_sizes, int n_in, void* d_out, int out_size, void* d_ws, size_t ws_size, hipStream_t stream) {
    static int grid = 0;
    if (grid == 0) {
        if (n_in != 22 || out_size != (int)O_END || ws_size < WS_END) { fprintf(stderr, "kernel_launch: unexpected sizes: n_in %d out %d ws %zu\n", n_in, out_size, ws_size); grid = -1; return; }
        int dev = 0, cus = 0, per_cu = 0;
        if (hipGetDevice(&dev) != hipSuccess || hipDeviceGetAttribute(&cus, hipDeviceAttributeMultiprocessorCount, dev) != hipSuccess) { grid = -1; return; }
        if (hipFuncSetAttribute((const void*)mega_fwd, hipFuncAttributeMaxDynamicSharedMemorySize, LDS_BYTES) != hipSuccess) { fprintf(stderr, "kernel_launch: hipFuncSetAttribute failed\n"); grid = -1; return; }
        if (hipOccupancyMaxActiveBlocksPerMultiprocessor(&per_cu, (const void*)mega_fwd, NWAVES * 64, LDS_BYTES) != hipSuccess || per_cu < 1) { fprintf(stderr, "kernel_launch: occupancy query says %d\n", per_cu); (void)hipGetLastError(); }
        if (cus != 256) { fprintf(stderr, "kernel_launch: built for a 256-CU device (one workgroup per CU, 8 groups of 32); found %d CUs\n", cus); grid = -1; return; }
        grid = cus;
    }
    if (grid < 0) return;
    (void)hipMemsetAsync((char*)d_ws + WS_CTL, 0, CTL_ZERO_BYTES, stream);
    Args a{};
    for (int i = 0; i < 22; ++i) a.in[i] = (const float*)d_in[i];
    a.out = (float*)d_out; a.ws = (unsigned char*)d_ws;
    hipLaunchKernelGGL(mega_fwd, dim3(grid), dim3(NWAVES * 64), LDS_BYTES, stream, a);
}
```

```cpp
#include <hip/hip_runtime.h>
#include <hip/hip_bf16.h>
#include <cstdio>
#include <cstdint>
#include <cmath>
namespace cfg {
constexpr int DM = 1024, NB = 8, SEQ = 2048, DB = 16, DS = 32, PAST = 1024, PW = 512, SBW = 512, HD = 64, NH = 8, DFF = 4096, PLE = 256, INW = 4096;
constexpr int MP = NB * SEQ, MS = DB * DS, MT = MP + MS;
constexpr float EPS = 1e-6f;
constexpr float QSCALE = 0.125f * 1.4426950408889634f;
}
namespace pg8 {
#define PG8_LAS __attribute__((address_space(3)))
typedef unsigned short bf16_t;
typedef short bf16x8 __attribute__((ext_vector_type(8)));
typedef float f32x4 __attribute__((ext_vector_type(4)));
typedef unsigned u32x4 __attribute__((ext_vector_type(4)));
constexpr int BM = 256, BK = 64, HALF = 128, HTB = HALF * BK * 2  , STAGE_BYTES = 8 * HTB, NXCD = 8, WGM = 8;

__host__ __device__ __forceinline__ int lds_byte(int r, int c) { const int st = (r >> 4) * 2 + (c >> 5), rr = r & 15, cc = c & 31, ob = rr * 64 + cc * 2; return st * 1024 + (ob ^ (((ob >> 9) & 1) << 5)); }
__host__ __device__ __forceinline__ void stage_rc(int b, int& R, int& C) { const int st = b / 1024, sb = b % 1024, swz = sb ^ (((sb >> 9) & 1) << 5); R = (st >> 1) * 16 + swz / 64; C = (st & 1) * 32 + (swz % 64) / 2; }
__host__ __device__ __forceinline__ int perm32(int rho) { const int n = rho >> 4, i = rho & 15; return 8 * (i >> 2) + 4 * n + (i & 3); }

struct Unit { int pm, pn, seg; };
struct Gemm { const bf16_t* A; const bf16_t* Bt; int M, N, K; const bf16_t* A1 = nullptr; const bf16_t* Bt1 = nullptr; };

struct StaticOrder {
    int nM, nN, nwg, G, c;
    __host__ __device__ void init(int M, int N, int G_, int c_) { nM = M / BM; nN = N / BM; nwg = nM * nN; G = G_; c = c_; }
    __host__ __device__ bool next(int i, Unit& u) const {
        const long L = (long)i * G + c; if (L >= nwg) return false;
        int wgid = (int)L; { const int q = nwg / NXCD, r = nwg % NXCD, xcd = wgid % NXCD, off = wgid / NXCD; wgid = (xcd < r ? xcd * (q + 1) : r * (q + 1) + (xcd - r) * q) + off; }
        const int nig = WGM * nN, gid = wgid / nig, fm = gid * WGM, gsz = (nM - fm) < WGM ? (nM - fm) : WGM;
        u.pm = fm + ((wgid % nig) % gsz); u.pn = (wgid % nig) / gsz; u.seg = 0; return true;
    }
    __device__ __forceinline__ void a_ready(const Unit&) const {}
    __device__ __forceinline__ void done(const Unit&) const {}
};
struct RotOrder : StaticOrder {
    int rot, cnt;
    __host__ __device__ void init(int M, int N, int G_, int c_, int rot_) { StaticOrder::init(M, N, G_, c_); cnt = (nwg % G_ == 0) ? nwg / G_ : 0; rot = rot_; }
    __host__ __device__ bool next(int i, Unit& u) const { if (cnt == 0) return StaticOrder::next(i, u); if (i >= cnt) return false; return StaticOrder::next((i + rot) % cnt, u); }
};
struct PairOrder : StaticOrder {
    __host__ __device__ bool next(int i, Unit& u) const { if (!StaticOrder::next(i >> 1, u)) return false; u.seg = i & 1; return true; }
};
typedef float f32x2v_t __attribute__((ext_vector_type(2))); typedef __bf16 bf16x2v_t __attribute__((ext_vector_type(2)));
__device__ __forceinline__ unsigned cvt_pk_bf16(float lo, float hi) { f32x2v_t v = {lo, hi}; bf16x2v_t b = __builtin_convertvector(v, bf16x2v_t); return __builtin_bit_cast(unsigned, b); }
typedef float f32x2 __attribute__((ext_vector_type(2)));
__device__ __forceinline__ float bf_lo(unsigned w) { return __uint_as_float(w << 16); }
__device__ __forceinline__ float bf_hi(unsigned w) { return __uint_as_float(w & 0xffff0000u); }
__device__ __forceinline__ u32x4 pack8(f32x4 a, f32x4 b) { u32x4 w; w.x = cvt_pk_bf16(a[0], a[1]); w.y = cvt_pk_bf16(a[2], a[3]); w.z = cvt_pk_bf16(b[0], b[1]); w.w = cvt_pk_bf16(b[2], b[3]); return w; }
__device__ __forceinline__ void unpack8(u32x4 w, f32x4& a, f32x4& b) { a = (f32x4){bf_lo(w.x), bf_hi(w.x), bf_lo(w.y), bf_hi(w.y)}; b = (f32x4){bf_lo(w.z), bf_hi(w.z), bf_lo(w.w), bf_hi(w.w)}; }
__device__ __forceinline__ float sigm(float x) { return __builtin_amdgcn_rcpf(1.f + __builtin_amdgcn_exp2f(-1.4426950408889634f * x)); }
__device__ __forceinline__ f32x4 sigm4(f32x4 x) { return (f32x4){sigm(x[0]), sigm(x[1]), sigm(x[2]), sigm(x[3])}; }
__device__ __forceinline__ float dot4(f32x4 a) { return (a[0] * a[0] + a[1] * a[1]) + (a[2] * a[2] + a[3] * a[3]); }
#ifndef DBG_LDAUX
#define DBG_LDAUX 16
#endif
__device__ __forceinline__ u32x4 ld16_sc1(const void* base, size_t byte_off) {
    const __amdgpu_buffer_rsrc_t rs = __builtin_amdgcn_make_buffer_rsrc((void*)base, (short)0, 0x7fffffff, 0x00020000);
    return __builtin_bit_cast(u32x4, __builtin_amdgcn_raw_buffer_load_b128(rs, (unsigned)byte_off, 0, DBG_LDAUX));
}
__device__ __forceinline__ unsigned pk_u8x4(f32x4 g) { unsigned w = 0u; w = __builtin_amdgcn_cvt_pk_u8_f32(g[0] * 255.0f, 0, w); w = __builtin_amdgcn_cvt_pk_u8_f32(g[1] * 255.0f, 1, w); w = __builtin_amdgcn_cvt_pk_u8_f32(g[2] * 255.0f, 2, w); w = __builtin_amdgcn_cvt_pk_u8_f32(g[3] * 255.0f, 3, w); return w; }
__device__ __forceinline__ f32x4 up_u8x4(unsigned w) { return (f32x4){(float)(w & 0xffu), (float)((w >> 8) & 0xffu), (float)((w >> 16) & 0xffu), (float)(w >> 24)} * (1.0f / 255.0f); }
typedef unsigned u32x2 __attribute__((ext_vector_type(2)));
template <int AUX> __device__ __forceinline__ void st16_aux(void* base, size_t byte_off, u32x4 v) {
    if constexpr (AUX == 0) { *(u32x4*)((char*)base + byte_off) = v; }
    else { const __amdgpu_buffer_rsrc_t rs = __builtin_amdgcn_make_buffer_rsrc(base, (short)0, 0x7fffffff, 0x00020000); __builtin_amdgcn_raw_buffer_store_b128(v, rs, (unsigned)byte_off, 0, AUX); }
}
#ifndef DBG_AUXHS
#define DBG_AUXHS 0
#endif
__device__ __forceinline__ float row_rstd(const float* SSQ, int r, int fq) {
    const f32x4 p = *(const f32x4*)(SSQ + (size_t)r * 16 + 4 * fq); float s = (p[0] + p[1]) + (p[2] + p[3]);
    s += __shfl_xor(s, 16); s += __shfl_xor(s, 32);
    return __builtin_amdgcn_rsqf(s * (1.0f / 1024.0f) + cfg::EPS);
}
#define PG8_ROWS(...) _Pragma("unroll") for (int ai = 0; ai < 2; ++ai) _Pragma("unroll") for (int m = 0; m < 4; ++m) { const int r = u.pm * BM + ai * HALF + wr * 64 + m * 16 + fr; __VA_ARGS__; if (m == 3) asm volatile("" ::: "memory"); }
#define PG8_ROWS_NF(...) _Pragma("unroll") for (int ai = 0; ai < 2; ++ai) _Pragma("unroll") for (int m = 0; m < 4; ++m) { const int r = u.pm * BM + ai * HALF + wr * 64 + m * 16 + fr; __VA_ARGS__; }
#ifndef EPI_NOFENCE
#define EPI_NOFENCE 1
#endif
#if EPI_NOFENCE
#define EPI_ROWS_LD PG8_ROWS_NF
#else
#define EPI_ROWS_LD PG8_ROWS
#endif
#define PG8_COLS(...) _Pragma("unroll") for (int bj = 0; bj < 2; ++bj) { const int c = ct + bj * HALF + wc * 32 + 8 * fq; const f32x4 v0 = acc[ai][bj][m][0], v1 = acc[ai][bj][m][1]; __VA_ARGS__; }

struct EpiIn {
    static constexpr bool PERM = true, AFTER_DRAIN = false;
    bf16_t *U, *Q, *K, *V, *G; const float* b_gate; float *k_p, *v_p, *k_s, *v_s, *pool_p, *pool_s;
    __device__ __forceinline__ void operator()(const f32x4 (&acc)[2][2][4][2], const Unit& u, int wr, int wc, int fr, int fq) const {
        const int pn = u.pn;
        if (pn >= 8) {
            const int ct = (pn - 8) * BM; f32x4 bv[2][2];
#pragma unroll
            for (int bj = 0; bj < 2; ++bj) { const int c = ct + bj * HALF + wc * 32 + 8 * fq; bv[bj][0] = *(const f32x4*)(b_gate + c); bv[bj][1] = *(const f32x4*)(b_gate + c + 4); }
            PG8_ROWS(PG8_COLS(*(u32x2*)((unsigned char*)G + (size_t)r * 2048 + c) = (u32x2){pk_u8x4(sigm4(v0 + bv[bj][0])), pk_u8x4(sigm4(v1 + bv[bj][1]))}))
        } else if (pn >= 4) {
            const bool isv = pn >= 6; const int ct = (pn - (isv ? 6 : 4)) * BM; bf16_t* B = isv ? V : K; float* op = isv ? v_p : k_p; float* os = isv ? v_s : k_s;
            PG8_ROWS(float* orow = r < cfg::MP ? op + (size_t)r * 512 : os + (size_t)(r - cfg::MP) * 512;
                     PG8_COLS(*(u32x4*)(B + (size_t)r * 512 + c) = pack8(v0, v1); __builtin_nontemporal_store(v0, (f32x4*)(orow + c)); __builtin_nontemporal_store(v1, (f32x4*)(orow + c + 4))))
        } else if (pn >= 2) {
            const int ct = (pn - 2) * BM;
            PG8_ROWS(PG8_COLS(*(u32x4*)(Q + (size_t)r * 512 + c) = pack8(v0 * cfg::QSCALE, v1 * cfg::QSCALE)))
        } else {
            const int ct = pn * BM;
            PG8_ROWS(float* prow = nullptr;
                     if (r < cfg::MP) { const int t = r & (cfg::SEQ - 1); if (t >= cfg::SEQ - 15) prow = pool_p + ((size_t)(r >> 11) * 15 + (t - (cfg::SEQ - 15))) * 512; }
                     else { const int i = (r - cfg::MP) & 31; if (i >= 17) prow = pool_s + ((size_t)((r - cfg::MP) >> 5) * 15 + (i - 17)) * 512; }
                     PG8_COLS(*(u32x4*)(U + (size_t)r * 512 + c) = pack8(v0, v1); if (prow) { *(f32x4*)(prow + c) = v0; *(f32x4*)(prow + c + 4) = v1; }))
        }
    }
};
struct EpiMerge;
struct EpiMerge0 {
    static constexpr bool PERM = true, AFTER_DRAIN = false;
    const bf16_t* G; bf16_t* MG;
    __device__ __forceinline__ void operator()(const f32x4 (&acc)[2][2][4][2], const Unit& u, int wr, int wc, int fr, int fq) const {
        const int ct = u.pn * BM;
        PG8_ROWS(PG8_COLS(const u32x2 gw = *(const u32x2*)((const unsigned char*)G + (size_t)r * 2048 + c); const f32x4 g0 = up_u8x4(gw.x); const f32x4 g1 = up_u8x4(gw.y); *(u32x4*)(MG + (size_t)r * 1024 + c) = pack8(v0 * g0, v1 * g1)))
    }
};
struct EpiMerge1 {
    static constexpr bool PERM = true, AFTER_DRAIN = false;
    const bf16_t* G; bf16_t* MG;
    __device__ __forceinline__ void operator()(const f32x4 (&acc)[2][2][4][2], const Unit& u, int wr, int wc, int fr, int fq) const {
        const int ct = u.pn * BM;
        PG8_ROWS(PG8_COLS(const u32x2 gw = *(const u32x2*)((const unsigned char*)G + (size_t)r * 2048 + 1024 + c); const u32x4 mw = *(const u32x4*)(MG + (size_t)r * 1024 + c);
                          const f32x4 g0 = up_u8x4(gw.x); const f32x4 g1 = up_u8x4(gw.y); f32x4 m0; f32x4 m1; unpack8(mw, m0, m1); *(u32x4*)(MG + (size_t)r * 1024 + c) = pack8(m0 + v0 * g0, m1 + v1 * g1)))
    }
};
#ifndef MERGE_CARRY
#define MERGE_CARRY 1
#endif
__device__ __forceinline__ f32x4 up_u8x4_floor1(unsigned w) { return (f32x4){(float)__builtin_elementwise_max(w & 0xffu, 1u), (float)__builtin_elementwise_max((w >> 8) & 0xffu, 1u), (float)__builtin_elementwise_max((w >> 16) & 0xffu, 1u), (float)__builtin_elementwise_max(w >> 24, 1u)} * (1.0f / 255.0f); }
__device__ __forceinline__ f32x4 rcp4(f32x4 v) { return (f32x4){__builtin_amdgcn_rcpf(v[0]), __builtin_amdgcn_rcpf(v[1]), __builtin_amdgcn_rcpf(v[2]), __builtin_amdgcn_rcpf(v[3])}; }
struct EpiMerge {
    static constexpr bool PERM = true, AFTER_DRAIN = false, CARRY = MERGE_CARRY != 0;
    const bf16_t* G; bf16_t* MG;
    __device__ __forceinline__ void operator()(f32x4 (&acc)[2][2][4][2], const Unit& u, int wr, int wc, int fr, int fq) const {
#if MERGE_CARRY
        const int ct = u.pn * BM;
        if (u.seg == 0) {
            EPI_ROWS_LD(PG8_COLS(const u32x2 ga = *(const u32x2*)((const unsigned char*)G + (size_t)r * 2048 + c); const u32x2 gb = *(const u32x2*)((const unsigned char*)G + (size_t)r * 2048 + 1024 + c);
                              acc[ai][bj][m][0] = v0 * (up_u8x4(ga.x) * rcp4(up_u8x4_floor1(gb.x))); acc[ai][bj][m][1] = v1 * (up_u8x4(ga.y) * rcp4(up_u8x4_floor1(gb.y)))))
        } else {
            EPI_ROWS_LD(PG8_COLS(const u32x2 gb = *(const u32x2*)((const unsigned char*)G + (size_t)r * 2048 + 1024 + c);
                              *(u32x4*)(MG + (size_t)r * 1024 + c) = pack8(v0 * up_u8x4_floor1(gb.x), v1 * up_u8x4_floor1(gb.y))))
        }
#else
        if (u.seg == 0) { const EpiMerge0 E0{G, MG}; E0(acc, u, wr, wc, fr, fq); } else { const EpiMerge1 E1{G, MG}; E1(acc, u, wr, wc, fr, fq); }
#endif
    }
};
#ifndef FOLD_G
#define FOLD_G 1
#endif
#ifndef RES_FROM_XN
#define RES_FROM_XN 1
#endif
#if FOLD_G
#define EPI_XG_STORE (void)0
#else
#define EPI_XG_STORE *(u32x4*)(XG + (size_t)r * 1024 + c) = pack8(a * gv[bj][0], b * gv[bj][1])
#endif
template <bool F32RES>
struct EpiResid {
    static constexpr bool PERM = true, AFTER_DRAIN = false;
    const float* res_p; bf16_t* X; bf16_t* XG; const float* gvec; float* SSQ; const bf16_t* XN0 = nullptr; const float* RS0 = nullptr;
    __device__ __forceinline__ void operator()(const f32x4 (&acc)[2][2][4][2], const Unit& u, int wr, int wc, int fr, int fq) const {
        const int ct = u.pn * BM;
#if !FOLD_G
        f32x4 gv[2][2];
#pragma unroll
        for (int bj = 0; bj < 2; ++bj) { const int c = ct + bj * HALF + wc * 32 + 8 * fq; gv[bj][0] = *(const f32x4*)(gvec + c); gv[bj][1] = *(const f32x4*)(gvec + c + 4); }
#endif
        EPI_ROWS_LD(float s = 0.f; float ir = 0.f; if (F32RES && RES_FROM_XN) ir = RS0[r];
                 PG8_COLS(f32x4 a; f32x4 b;
                          if (F32RES && RES_FROM_XN) { const u32x4 xw = __builtin_nontemporal_load((const u32x4*)(XN0 + (size_t)r * 1024 + c)); unpack8(xw, a, b); a *= ir; b *= ir; }
                          else if (F32RES) { a = __builtin_nontemporal_load((const f32x4*)(res_p + (size_t)r * 1024 + c)); b = __builtin_nontemporal_load((const f32x4*)(res_p + (size_t)r * 1024 + c + 4)); }
                          else { const u32x4 xw = *(const u32x4*)(X + (size_t)r * 1024 + c); unpack8(xw, a, b); }
                          a += v0; b += v1; *(u32x4*)(X + (size_t)r * 1024 + c) = pack8(a, b); s += dot4(a) + dot4(b);
                          EPI_XG_STORE)
                 s += __shfl_xor(s, 16); s += __shfl_xor(s, 32); if (fq == 0) SSQ[(size_t)r * 16 + u.pn * 4 + wc] = s)
    }
};
struct EpiUp {
    static constexpr bool PERM = true, AFTER_DRAIN = false;
    const float* SSQ; bf16_t* H;
    __device__ __forceinline__ void operator()(const f32x4 (&acc)[2][2][4][2], const Unit& u, int wr, int wc, int fr, int fq) const {
        const int ct = u.pn * BM; float rsv[2][4];
#pragma unroll
        for (int ai = 0; ai < 2; ++ai)
#pragma unroll
            for (int m = 0; m < 4; ++m) rsv[ai][m] = row_rstd(SSQ, u.pm * BM + ai * HALF + wr * 64 + m * 16 + fr, fq);
        PG8_ROWS(const float rs = rsv[ai][m];
                 PG8_COLS(f32x4 a = v0 * rs; f32x4 b = v1 * rs; a = __builtin_elementwise_max(a, (f32x4){0.f, 0.f, 0.f, 0.f}); b = __builtin_elementwise_max(b, (f32x4){0.f, 0.f, 0.f, 0.f});
                          st16_aux<DBG_AUXHS>(H, ((size_t)r * 4096 + c) * 2, pack8(a * a, b * b))))
    }
};
struct EpiNull {
    static constexpr bool PERM = true, AFTER_DRAIN = false;
    float* sink;
    __device__ __forceinline__ void operator()(const f32x4 (&acc)[2][2][4][2], const Unit& u, int wr, int wc, int fr, int fq) const {
        float s = 0.f;
#pragma unroll
        for (int ai = 0; ai < 2; ++ai)
#pragma unroll
            for (int bj = 0; bj < 2; ++bj)
#pragma unroll
                for (int m = 0; m < 4; ++m)
#pragma unroll
                    for (int n = 0; n < 2; ++n) s += acc[ai][bj][m][n][0] + acc[ai][bj][m][n][3];
        if (s == 1.2345e33f) sink[0] = s;
    }
};
struct EpiPP {
    static constexpr bool PERM = true, AFTER_DRAIN = false;
    bf16_t* PP;
    __device__ __forceinline__ void operator()(const f32x4 (&acc)[2][2][4][2], const Unit& u, int wr, int wc, int fr, int fq) const {
        const int ct = u.pn * BM;
        PG8_ROWS(PG8_COLS(*(u32x4*)(PP + (size_t)r * 1024 + c) = pack8(v0, v1)))
    }
};
struct EpiGate8 {
    static constexpr bool PERM = true, AFTER_DRAIN = false;
    const float* SSQ; unsigned char* S8;
    __device__ __forceinline__ void operator()(const f32x4 (&acc)[2][2][4][2], const Unit& u, int wr, int wc, int fr, int fq) const {
        const int ct = u.pn * BM; float rsv[2][4];
#pragma unroll
        for (int ai = 0; ai < 2; ++ai)
#pragma unroll
            for (int m = 0; m < 4; ++m) rsv[ai][m] = row_rstd(SSQ, u.pm * BM + ai * HALF + wr * 64 + m * 16 + fr, fq);
        PG8_ROWS(const float rs = rsv[ai][m];
                 PG8_COLS(*(u32x2*)(S8 + (size_t)r * 1024 + c) = (u32x2){pk_u8x4(sigm4(v0 * rs)), pk_u8x4(sigm4(v1 * rs))}))
    }
};
struct EpiPleFinal2 {
    static constexpr bool PERM = true, AFTER_DRAIN = false;
    const unsigned char* S8; const bf16_t* X; float* Y; float* SSQo; const float* gfin; unsigned* cnt;
    __device__ __forceinline__ void operator()(f32x4 (&acc)[2][2][4][2], const Unit& u, int wr, int wc, int fr, int fq) const {
        const int ct = u.pn * BM;
        EPI_ROWS_LD(float s = 0.f;
                 PG8_COLS(const u32x2 sw = *(const u32x2*)(S8 + (size_t)r * 1024 + c);
                          const u32x4 xw = *(const u32x4*)(X + (size_t)r * 1024 + c); f32x4 a; f32x4 b; unpack8(xw, a, b); a += up_u8x4(sw.x) * v0; b += up_u8x4(sw.y) * v1;
                          acc[ai][bj][m][0] = a; acc[ai][bj][m][1] = b; s += dot4(a) + dot4(b))
                 s += __shfl_xor(s, 16); s += __shfl_xor(s, 32);
                 if (fq == 0) __hip_atomic_store(SSQo + (size_t)r * 16 + u.pn * 4 + wc, s, __ATOMIC_RELAXED, __HIP_MEMORY_SCOPE_AGENT))
        asm volatile("s_waitcnt vmcnt(0)" ::: "memory");
        unsigned* cw = cnt + 64 * (2 * u.pm + wr);
        if (fr == 0 && fq == 0) __hip_atomic_fetch_add(cw, 1u, __ATOMIC_RELAXED, __HIP_MEMORY_SCOPE_AGENT);
        { unsigned spins = 0;
          while ((unsigned)__builtin_amdgcn_readfirstlane(__hip_atomic_load(cw, __ATOMIC_RELAXED, __HIP_MEMORY_SCOPE_AGENT)) < 16u) { __builtin_amdgcn_s_sleep(2); if (++spins > (1u << 16)) break; } }
        f32x4 gv[2][2];
#pragma unroll
        for (int bj = 0; bj < 2; ++bj) { const int c = ct + bj * HALF + wc * 32 + 8 * fq; gv[bj][0] = *(const f32x4*)(gfin + c); gv[bj][1] = *(const f32x4*)(gfin + c + 4); }
        PG8_ROWS(const f32x4 pq = __builtin_bit_cast(f32x4, ld16_sc1(SSQo, ((size_t)r * 16 + 4 * fq) * 4)); float t = (pq[0] + pq[1]) + (pq[2] + pq[3]); t += __shfl_xor(t, 16); t += __shfl_xor(t, 32);
                 const float r3 = __builtin_amdgcn_rsqf(t * (1.0f / 1024.0f) + cfg::EPS);
                 PG8_COLS(__builtin_nontemporal_store(v0 * r3 * gv[bj][0], (f32x4*)(Y + (size_t)r * 1024 + c)); __builtin_nontemporal_store(v1 * r3 * gv[bj][1], (f32x4*)(Y + (size_t)r * 1024 + c + 4))))
    }
};
struct EpiPleFinal {
    static constexpr bool PERM = true, AFTER_DRAIN = false;
    const float* SSQ; const bf16_t* PP; const bf16_t* X; float* Y; float* SSQo; const float* gfin; unsigned* cnt;
    __device__ __forceinline__ void operator()(f32x4 (&acc)[2][2][4][2], const Unit& u, int wr, int wc, int fr, int fq) const {
        const int ct = u.pn * BM; float rsv[2][4];
#pragma unroll
        for (int ai = 0; ai < 2; ++ai)
#pragma unroll
            for (int m = 0; m < 4; ++m) rsv[ai][m] = row_rstd(SSQ, u.pm * BM + ai * HALF + wr * 64 + m * 16 + fr, fq);
        PG8_ROWS(const float rs = rsv[ai][m]; float s = 0.f;
                 PG8_COLS(const u32x4 pw = *(const u32x4*)(PP + (size_t)r * 1024 + c); f32x4 p0; f32x4 p1; unpack8(pw, p0, p1);
                          const u32x4 xw = *(const u32x4*)(X + (size_t)r * 1024 + c); f32x4 a; f32x4 b; unpack8(xw, a, b); a += sigm4(v0 * rs) * p0; b += sigm4(v1 * rs) * p1;
                          acc[ai][bj][m][0] = a; acc[ai][bj][m][1] = b; s += dot4(a) + dot4(b))
                 s += __shfl_xor(s, 16); s += __shfl_xor(s, 32);
                 if (fq == 0) __hip_atomic_store(SSQo + (size_t)r * 16 + u.pn * 4 + wc, s, __ATOMIC_RELAXED, __HIP_MEMORY_SCOPE_AGENT))
        asm volatile("s_waitcnt vmcnt(0)" ::: "memory");
        unsigned* cw = cnt + 64 * (2 * u.pm + wr);
        if (fr == 0 && fq == 0) __hip_atomic_fetch_add(cw, 1u, __ATOMIC_RELAXED, __HIP_MEMORY_SCOPE_AGENT);
        { unsigned spins = 0;
          while ((unsigned)__builtin_amdgcn_readfirstlane(__hip_atomic_load(cw, __ATOMIC_RELAXED, __HIP_MEMORY_SCOPE_AGENT)) < 16u) { __builtin_amdgcn_s_sleep(2); if (++spins > (1u << 16)) break; } }
        f32x4 gv[2][2];
#pragma unroll
        for (int bj = 0; bj < 2; ++bj) { const int c = ct + bj * HALF + wc * 32 + 8 * fq; gv[bj][0] = *(const f32x4*)(gfin + c); gv[bj][1] = *(const f32x4*)(gfin + c + 4); }
        PG8_ROWS(const f32x4 pq = __builtin_bit_cast(f32x4, ld16_sc1(SSQo, ((size_t)r * 16 + 4 * fq) * 4)); float t = (pq[0] + pq[1]) + (pq[2] + pq[3]); t += __shfl_xor(t, 16); t += __shfl_xor(t, 32);
                 const float r3 = __builtin_amdgcn_rsqf(t * (1.0f / 1024.0f) + cfg::EPS);
                 PG8_COLS(__builtin_nontemporal_store(v0 * r3 * gv[bj][0], (f32x4*)(Y + (size_t)r * 1024 + c)); __builtin_nontemporal_store(v1 * r3 * gv[bj][1], (f32x4*)(Y + (size_t)r * 1024 + c + 4))))
    }
};
template <class E, class = void> struct epi_carry { static constexpr bool value = false; };
template <class E> struct epi_carry<E, decltype((void)E::CARRY)> { static constexpr bool value = E::CARRY; };
struct NoHook { __device__ __forceinline__ void operator()(int) const {} };
template <class Epi, class Sched, bool ALIGN_EPI = false, bool SP2 = false, class Hook = NoHook, int AUXA = 0>
__device__ __forceinline__ void gemm_phase(PG8_LAS unsigned char* lds, const Gemm g, const Sched& S, const Epi& E, const Hook& H = Hook()) {
    int tid = threadIdx.x; asm volatile("" : "+v"(tid));
    const int wid = __builtin_amdgcn_readfirstlane(tid >> 6), lane = tid & 63, wr = wid >> 2, wc = wid & 3, fr = lane & 15, fq = lane >> 4;
    int K = g.K; asm volatile("" : "+s"(K)); const int nt = K / BK;
    unsigned voffA[2], voffB[2];
#pragma unroll
    for (int i = 0; i < 2; ++i) { int R, C; stage_rc(tid * 16 + i * 8192, R, C); const int Rb = Epi::PERM ? ((R & ~31) + perm32(R & 31)) : R;
        voffA[i] = (unsigned)(R * K + C) * 2u; voffB[i] = (unsigned)(Rb * K + C) * 2u; }
    const size_t kstep = (size_t)(BK * 2);
    const size_t hstep = (size_t)HALF * K * 2;
    const size_t tstep = 2 * hstep;
    const size_t bhs = hstep;
    const unsigned ldsw = (unsigned)wid * 1024u;
    const int aoff = lds_byte(wr * 64 + fr, fq * 8), boff = lds_byte(wc * 32 + fr, fq * 8);
#define PG8_SA(b, h) (((b) * 2 + (h)) * HTB)
#define PG8_SB(b, h) ((4 + (b) * 2 + (h)) * HTB)
#define PG8_STAGE_X(bufoff, gbase, voff, AUX) do { _Pragma("unroll") for (int _i = 0; _i < 2; ++_i) \
        __builtin_amdgcn_global_load_lds((const unsigned*)((const char*)(gbase) + (voff)[_i]), (PG8_LAS unsigned*)(lds + (bufoff) + ldsw + _i * 8192), 16, 0, AUX); } while (0)
#define PG8_LDA(dst, b, h) do { _Pragma("unroll") for (int m = 0; m < 4; ++m) _Pragma("unroll") for (int k = 0; k < 2; ++k) dst[m][k] = *(const PG8_LAS bf16x8*)(lds + PG8_SA(b, h) + aoff + m * 2048 + k * 1024); } while (0)
#define PG8_LDB(dst, b, h) do { _Pragma("unroll") for (int n = 0; n < 2; ++n) _Pragma("unroll") for (int k = 0; k < 2; ++k) dst[n][k] = *(const PG8_LAS bf16x8*)(lds + PG8_SB(b, h) + boff + n * 2048 + k * 1024); } while (0)
#define PG8_MMA(ai, bj, At, Bt) do { __builtin_amdgcn_s_setprio(1); _Pragma("unroll") for (int m = 0; m < 4; ++m) _Pragma("unroll") for (int n = 0; n < 2; ++n) _Pragma("unroll") for (int k = 0; k < 2; ++k) \
        acc[ai][bj][m][n] = __builtin_amdgcn_mfma_f32_16x16x32_bf16(Bt[n][k], At[m][k], acc[ai][bj][m][n], 0, 0, 0); __builtin_amdgcn_s_setprio(0); } while (0)
#ifdef DRAIN_ALL
#define PG8_WAIT_V(n) asm volatile("s_waitcnt vmcnt(0)" ::: "memory")
#else
#define PG8_WAIT_V(n) asm volatile("s_waitcnt vmcnt(" #n ")" ::: "memory")
#endif
#define PG8_WAIT_L(n) asm volatile("s_waitcnt lgkmcnt(" #n ")" ::: "memory")
#define PG8_BAR __builtin_amdgcn_s_barrier()
#define PG8_SCHED __builtin_amdgcn_sched_barrier(0)
    Unit cur, nxt; int ui = 0;
    if (!S.next(0, cur)) return;
    f32x4 acc[2][2][4][2];
#pragma unroll
    for (int a = 0; a < 2; ++a)
#pragma unroll
        for (int b = 0; b < 2; ++b)
#pragma unroll
            for (int m = 0; m < 4; ++m)
#pragma unroll
                for (int n = 0; n < 2; ++n) acc[a][b][m][n] = (f32x4){0.f, 0.f, 0.f, 0.f};
    bf16x8 At[4][2], B0[2][2], B1[2][2];
    const char* cA = (const char*)(cur.seg ? g.A1 : g.A) + (size_t)cur.pm * tstep; const char* cB = (const char*)(cur.seg ? g.Bt1 : g.Bt) + (size_t)cur.pn * tstep;
    S.a_ready(cur);
    if constexpr (SP2) {
        PG8_STAGE_X(PG8_SB(0, 0), cB, voffB, 0); PG8_STAGE_X(PG8_SB(0, 1), cB + bhs, voffB, 0); PG8_STAGE_X(PG8_SA(0, 0), cA, voffA, AUXA); PG8_STAGE_X(PG8_SA(0, 1), cA + hstep, voffA, AUXA);
        if (wr == 1) PG8_BAR;
        PG8_WAIT_V(2); PG8_BAR;
        PG8_STAGE_X(PG8_SB(1, 0), cB + kstep, voffB, 0); PG8_STAGE_X(PG8_SA(1, 0), cA + kstep, voffA, AUXA); PG8_STAGE_X(PG8_SB(1, 1), cB + bhs + kstep, voffB, 0);
        PG8_WAIT_V(6); PG8_BAR;
    } else {
        PG8_STAGE_X(PG8_SB(0, 0), cB, voffB, 0); PG8_STAGE_X(PG8_SA(0, 0), cA, voffA, AUXA); PG8_STAGE_X(PG8_SB(0, 1), cB + bhs, voffB, 0); PG8_STAGE_X(PG8_SA(0, 1), cA + hstep, voffA, AUXA);
        if (wr == 1) PG8_BAR;
        PG8_WAIT_V(4); PG8_BAR;
        PG8_STAGE_X(PG8_SB(1, 0), cB + kstep, voffB, 0); PG8_STAGE_X(PG8_SA(1, 0), cA + kstep, voffA, AUXA); PG8_STAGE_X(PG8_SB(1, 1), cB + bhs + kstep, voffB, 0);
        PG8_WAIT_V(6); PG8_BAR;
    }
    for (;;) {
        const bool has_next = S.next(ui + 1, nxt);
        const char* nA = has_next ? (const char*)(nxt.seg ? g.A1 : g.A) + (size_t)nxt.pm * tstep : cA; const char* nB = has_next ? (const char*)(nxt.seg ? g.Bt1 : g.Bt) + (size_t)nxt.pn * tstep : cB;
        for (int t = 0; t < nt; t += 2) {
            const bool last = (t == nt - 2);
            const char* a1 = cA + (size_t)(t + 1) * kstep;
            const char* a2 = last ? nA : cA + (size_t)(t + 2) * kstep; const char* b2 = last ? nB : cB + (size_t)(t + 2) * kstep;
            const char* a3 = a2 + kstep; const char* b3 = b2 + kstep;
            if (last && has_next) S.a_ready(nxt);
            if constexpr (SP2) {
            PG8_LDB(B0, 0, 0); PG8_LDB(B1, 0, 1); PG8_SCHED; PG8_LDA(At, 0, 0); PG8_STAGE_X(PG8_SA(1, 1), a1 + hstep, voffA, AUXA);
            PG8_WAIT_V(8); PG8_WAIT_L(0); PG8_BAR; PG8_MMA(0, 0, At, B0); PG8_MMA(0, 1, At, B1); PG8_BAR; PG8_SCHED;
            PG8_LDA(At, 0, 1); PG8_STAGE_X(PG8_SB(0, 0), b2, voffB, 0); PG8_STAGE_X(PG8_SB(0, 1), b2 + bhs, voffB, 0); PG8_STAGE_X(PG8_SA(0, 0), a2, voffA, AUXA);
            PG8_WAIT_V(8); PG8_WAIT_L(0); PG8_BAR; PG8_MMA(1, 0, At, B0); PG8_MMA(1, 1, At, B1); PG8_BAR; PG8_SCHED;
            PG8_LDB(B0, 1, 0); PG8_LDB(B1, 1, 1); PG8_SCHED; PG8_LDA(At, 1, 0); PG8_STAGE_X(PG8_SA(0, 1), a2 + hstep, voffA, AUXA);
            PG8_WAIT_V(8); PG8_WAIT_L(0); PG8_BAR; PG8_MMA(0, 0, At, B0); PG8_MMA(0, 1, At, B1); PG8_BAR; PG8_SCHED;
            PG8_LDA(At, 1, 1); PG8_STAGE_X(PG8_SB(1, 0), b3, voffB, 0); PG8_STAGE_X(PG8_SB(1, 1), b3 + bhs, voffB, 0); PG8_STAGE_X(PG8_SA(1, 0), a3, voffA, AUXA);
            PG8_WAIT_V(8); PG8_WAIT_L(0); PG8_BAR; PG8_MMA(1, 0, At, B0); PG8_MMA(1, 1, At, B1); PG8_BAR; PG8_SCHED;
            } else {
            PG8_LDB(B0, 0, 0); PG8_SCHED; PG8_LDA(At, 0, 0); PG8_STAGE_X(PG8_SA(1, 1), a1 + hstep, voffA, AUXA);
            PG8_WAIT_L(8); PG8_BAR; PG8_WAIT_L(0); PG8_MMA(0, 0, At, B0); PG8_BAR; PG8_SCHED;
            PG8_LDB(B1, 0, 1); PG8_STAGE_X(PG8_SB(0, 0), b2, voffB, 0);
            PG8_BAR; PG8_WAIT_L(0); PG8_MMA(0, 1, At, B1); PG8_BAR;
            PG8_LDA(At, 0, 1); PG8_STAGE_X(PG8_SA(0, 0), a2, voffA, AUXA);
            PG8_BAR; PG8_WAIT_L(0); PG8_MMA(1, 0, At, B0); PG8_BAR; PG8_SCHED;
            PG8_STAGE_X(PG8_SB(0, 1), b2 + bhs, voffB, 0);
            PG8_WAIT_V(6); PG8_BAR; PG8_MMA(1, 1, At, B1); PG8_BAR;
            PG8_LDB(B0, 1, 0); PG8_SCHED; PG8_LDA(At, 1, 0); PG8_STAGE_X(PG8_SA(0, 1), a2 + hstep, voffA, AUXA);
            PG8_WAIT_L(8); PG8_BAR; PG8_WAIT_L(0); PG8_MMA(0, 0, At, B0); PG8_BAR; PG8_SCHED;
            PG8_LDB(B1, 1, 1); PG8_STAGE_X(PG8_SB(1, 0), b3, voffB, 0);
            PG8_BAR; PG8_WAIT_L(0); PG8_MMA(0, 1, At, B1); PG8_BAR;
            PG8_LDA(At, 1, 1); PG8_STAGE_X(PG8_SA(1, 0), a3, voffA, AUXA);
            PG8_BAR; PG8_WAIT_L(0); PG8_MMA(1, 0, At, B0); PG8_BAR; PG8_SCHED;
            PG8_STAGE_X(PG8_SB(1, 1), b3 + bhs, voffB, 0);
            PG8_WAIT_V(6); PG8_BAR; PG8_MMA(1, 1, At, B1); PG8_BAR;
            }
        }
        if constexpr (ALIGN_EPI) { if (wr == 0) PG8_BAR; }
        if constexpr (!Epi::AFTER_DRAIN) { int t_ = threadIdx.x; asm volatile("" : "+v"(t_)); const int l_ = t_ & 63; E(acc, cur, wr, wc, l_ & 15, l_ >> 4); S.done(cur); H(ui); }
        if (!has_next) break;
        if (!(epi_carry<Epi>::value && cur.seg == 0)) {
#pragma unroll
        for (int a = 0; a < 2; ++a)
#pragma unroll
            for (int b = 0; b < 2; ++b)
#pragma unroll
                for (int m = 0; m < 4; ++m)
#pragma unroll
                    for (int n = 0; n < 2; ++n) acc[a][b][m][n] = (f32x4){0.f, 0.f, 0.f, 0.f};
        }
        cur = nxt; cA = nA; cB = nB; ++ui;
        if constexpr (ALIGN_EPI) { if (wr == 1) PG8_BAR; }
    }
    PG8_WAIT_V(0);
    if constexpr (!ALIGN_EPI) { if (wr == 0) PG8_BAR; }
    PG8_BAR;
    if constexpr (Epi::AFTER_DRAIN) { E.fused(acc, cur, wr, wc, fr, fq, lds, wid, lane); S.done(cur); }
#undef PG8_SA
#undef PG8_SB
#undef PG8_STAGE_X
#undef PG8_LDA
#undef PG8_LDB
#undef PG8_MMA
#undef PG8_WAIT_V
#undef PG8_WAIT_L
#undef PG8_BAR
#undef PG8_SCHED
}
}
namespace sba {
typedef short bf16x8 __attribute__((ext_vector_type(8)));
typedef short s16x4 __attribute__((ext_vector_type(4)));
typedef float f32x16 __attribute__((ext_vector_type(16)));
typedef float f32x4 __attribute__((ext_vector_type(4)));
typedef unsigned u32x4 __attribute__((ext_vector_type(4)));
typedef unsigned short bf16_t;
#define SB_LAS __attribute__((address_space(3)))
constexpr int PITCH = 512, HSLOT = 16384  , SLOTB = 4 * HSLOT, LDS_BYTES = 2 * SLOTB;
constexpr float THR2 = 48.0f, NEGBIG = -1.0e30f;
typedef float f32x2_t __attribute__((ext_vector_type(2))); typedef __bf16 bf16x2_t __attribute__((ext_vector_type(2)));
__device__ __forceinline__ unsigned cvtpk(float lo, float hi) { f32x2_t v = {lo, hi}; bf16x2_t b = __builtin_convertvector(v, bf16x2_t); return __builtin_bit_cast(unsigned, b); }
__device__ __forceinline__ bf16x8 pack8f(float a0, float a1, float a2, float a3, float a4, float a5, float a6, float a7) {
    u32x4 w; w.x = cvtpk(a0, a1); w.y = cvtpk(a2, a3); w.z = cvtpk(a4, a5); w.w = cvtpk(a6, a7); return __builtin_bit_cast(bf16x8, w); }
typedef short v4i16_t __attribute__((ext_vector_type(4)));
__device__ __forceinline__ s16x4 vtr(const SB_LAS char* p) { return __builtin_bit_cast(s16x4, __builtin_amdgcn_ds_read_tr16_b64_v4i16((SB_LAS v4i16_t*)p)); }
__device__ __forceinline__ int crow(int r, int hi) { return (r & 3) + 8 * (r >> 2) + 4 * hi; }

template <int SUB>
__device__ __forceinline__ void sub_front(const SB_LAS char* Kslot, bool mask, int kq, const bf16x8 (&qr)[4], f32x16& w, bf16x8 (&spb)[2], int r32, int hi) {
    const SB_LAS char* kb = Kslot + hi * 1024 + r32 * 16 + SUB * 512;
    f32x16 p = {};
#pragma unroll
    for (int d0 = 0; d0 < 4; ++d0) { const bf16x8 kf = *(const SB_LAS bf16x8*)(kb + d0 * 2048); p = __builtin_amdgcn_mfma_f32_32x32x16_bf16(kf, qr[d0], p, 0, 0, 0); }
    float sp[16];
#pragma unroll
    for (int r = 0; r < 16; ++r) {
        float x = p[r];
        if (mask && (kq + 32 * SUB + (r & 3) + 8 * (r >> 2) >= 0)) x = NEGBIG;
        const float t = __builtin_amdgcn_exp2f(-__builtin_fabsf(x));
        const float l = __builtin_amdgcn_logf(1.0f + t);
        sp[r] = __builtin_fmaxf(x, 0.f) + l; w[r] = __builtin_fminf(x, 0.f) - l;
    }
    spb[0] = pack8f(sp[0], sp[1], sp[2], sp[3], sp[4], sp[5], sp[6], sp[7]);
    spb[1] = pack8f(sp[8], sp[9], sp[10], sp[11], sp[12], sp[13], sp[14], sp[15]);
}
template <int SUB>
__device__ __forceinline__ void sub_back(const SB_LAS char* vp, const f32x16& w, const f32x16& sx, f32x16 (&o)[2]) {
    float pr[16];
#pragma unroll
    for (int r = 0; r < 16; ++r) pr[r] = __builtin_amdgcn_exp2f(w[r] - sx[r]);
    bf16x8 pa[2];
    pa[0] = pack8f(pr[0], pr[1], pr[2], pr[3], pr[4], pr[5], pr[6], pr[7]);
    pa[1] = pack8f(pr[8], pr[9], pr[10], pr[11], pr[12], pr[13], pr[14], pr[15]);
#pragma unroll
    for (int d0 = 0; d0 < 2; ++d0)
#pragma unroll
        for (int s = 0; s < 2; ++s) { const int ks = 2 * SUB + s;
            const s16x4 lo = vtr(vp + d0 * 4096 + ks * 1024), hi4 = vtr(vp + d0 * 4096 + ks * 1024 + 512);
            const bf16x8 vf = (bf16x8){lo[0], lo[1], lo[2], lo[3], hi4[0], hi4[1], hi4[2], hi4[3]};
            o[d0] = __builtin_amdgcn_mfma_f32_32x32x16_bf16(pa[s], vf, o[d0], 0, 0, 0); }
}
__device__ __forceinline__ void sb_tile(const SB_LAS char* slot, bool mask, bool skip1, int kq, const bf16x8 (&qr)[4], f32x16& Rb, f32x16 (&o)[2], const bf16x8 (&Um)[2], const bf16x8 Jm, int r32, int hi, int lane) {
    const SB_LAS char* vp = slot + 8192 + ((lane >> 4) & 1) * 32 + (lane & 3) * 8 + (4 * hi + ((lane & 15) >> 2)) * 64;
    f32x16 w1, w0; bf16x8 sb1[2], sb0[2];
    f32x16 t1 = Rb;
    if (!skip1) {
    sub_front<1>(slot, mask, kq, qr, w1, sb1, r32, hi);
    f32x16 a1 = __builtin_amdgcn_mfma_f32_32x32x16_bf16(Um[0], sb1[0], Rb, 0, 0, 0); a1 = __builtin_amdgcn_mfma_f32_32x32x16_bf16(Um[1], sb1[1], a1, 0, 0, 0);
    t1 = __builtin_amdgcn_mfma_f32_32x32x16_bf16(Jm, sb1[0], Rb, 0, 0, 0); t1 = __builtin_amdgcn_mfma_f32_32x32x16_bf16(Jm, sb1[1], t1, 0, 0, 0);
    sub_back<1>(vp, w1, a1, o);
    }
    sub_front<0>(slot, mask, kq, qr, w0, sb0, r32, hi);
    f32x16 a0 = __builtin_amdgcn_mfma_f32_32x32x16_bf16(Um[0], sb0[0], t1, 0, 0, 0); a0 = __builtin_amdgcn_mfma_f32_32x32x16_bf16(Um[1], sb0[1], a0, 0, 0, 0);
    f32x16 rn = __builtin_amdgcn_mfma_f32_32x32x16_bf16(Jm, sb0[0], t1, 0, 0, 0); rn = __builtin_amdgcn_mfma_f32_32x32x16_bf16(Jm, sb0[1], rn, 0, 0, 0);
    sub_back<0>(vp, w0, a0, o);
    Rb = rn;
}
struct Tensors { const bf16_t* Q; const bf16_t* K; const bf16_t* V; bf16_t* O; const float* ck; const float* cv; };

template <bool SAMPLE>
__device__ __forceinline__ void sb_unit(int b, int hg, int q64, const Tensors& T, SB_LAS char* lds, volatile SB_LAS unsigned* flags) {
    int tid = threadIdx.x; asm volatile("" : "+v"(tid)); const int lane = tid & 63, r32 = lane & 31, hi = lane >> 5; const int wid = __builtin_amdgcn_readfirstlane(tid >> 6);
    const size_t rowbase = SAMPLE ? (size_t)cfg::MP + (size_t)b * 32 : (size_t)b * cfg::SEQ; const int q0 = SAMPLE ? 0 : q64 * 64;
    const int jd = SAMPLE ? 16 : q64;
    const bool worker = SAMPLE ? (wid < 4) : true;
    const int hs = SAMPLE ? (wid & 3) : (wid >> 1), head = 4 * hg + hs;
    const int wq = SAMPLE ? 0 : (wid & 1);
    const int qpos = (SAMPLE ? cfg::PAST : q0 + 32 * wq) + r32;
    bf16x8 Um[2], Jm;
#pragma unroll
    for (int s = 0; s < 2; ++s)
#pragma unroll
        for (int jj = 0; jj < 8; ++jj) Um[s][jj] = (16 * s + 8 * (jj >> 2) + 4 * hi + (jj & 3) > r32) ? (short)0x3F80 : (short)0;
#pragma unroll
    for (int jj = 0; jj < 8; ++jj) Jm[jj] = (short)0x3F80;
    bf16x8 qr[4];
    { const bf16_t* Qw = T.Q + (rowbase + q0 + 32 * wq + r32) * PITCH + head * 64 + hi * 8;
#pragma unroll
      for (int d0 = 0; d0 < 4; ++d0) qr[d0] = *(const bf16x8*)(Qw + d0 * 16); }
    f32x16 Rb = {}, o[2]; o[0] = f32x16{}; o[1] = f32x16{};
    bool done = false;
    u32x4 kreg[4], vreg[4];
    const int vkey = 16 * (wid & 3) + (lane >> 2), vcol = (wid >> 2) * 32 + (lane & 3) * 8;
#define SB_LOAD(j) do { \
        if (!SAMPLE) {   \
            const char* kb_ = (const char*)(T.K + (rowbase + (size_t)(64 * (j))) * PITCH + hg * 256 + wid * 8); const char* vb_ = (const char*)(T.V + (rowbase + (size_t)(64 * (j))) * PITCH + hg * 256); \
            _Pragma("unroll") for (int s4 = 0; s4 < 4; ++s4) { kreg[s4] = *(const u32x4*)(kb_ + (unsigned)(lane * (PITCH * 2) + s4 * 128)); vreg[s4] = *(const u32x4*)(vb_ + (unsigned)(vkey * (PITCH * 2) + vcol * 2 + s4 * 128)); } } \
        else if ((j) == 16) { const int kr_ = lane < 31 ? lane : 31, vr_ = vkey < 31 ? vkey : 31; \
            _Pragma("unroll") for (int s4 = 0; s4 < 4; ++s4) { \
            kreg[s4] = *(const u32x4*)((const char*)(T.K + rowbase * PITCH + hg * 256 + wid * 8) + (unsigned)(kr_ * (PITCH * 2) + s4 * 128)); vreg[s4] = *(const u32x4*)((const char*)(T.V + rowbase * PITCH + hg * 256) + (unsigned)(vr_ * (PITCH * 2) + vcol * 2 + s4 * 128)); } } \
        else { _Pragma("unroll") for (int s4 = 0; s4 < 4; ++s4) { \
            const float* kp_ = (const float*)((const char*)(T.ck + ((size_t)b * cfg::PAST + 64 * (j)) * PITCH + hg * 256 + wid * 8) + (unsigned)(lane * (PITCH * 4) + s4 * 256)); const float* vp_ = (const float*)((const char*)(T.cv + ((size_t)b * cfg::PAST + 64 * (j)) * PITCH + hg * 256) + (unsigned)(vkey * (PITCH * 4) + vcol * 4 + s4 * 256)); \
            const f32x4 k0_ = *(const f32x4*)kp_, k1_ = *(const f32x4*)(kp_ + 4), v0_ = *(const f32x4*)vp_, v1_ = *(const f32x4*)(vp_ + 4); \
            kreg[s4] = (u32x4){cvtpk(k0_[0], k0_[1]), cvtpk(k0_[2], k0_[3]), cvtpk(k1_[0], k1_[1]), cvtpk(k1_[2], k1_[3])}; vreg[s4] = (u32x4){cvtpk(v0_[0], v0_[1]), cvtpk(v0_[2], v0_[3]), cvtpk(v1_[0], v1_[1]), cvtpk(v1_[2], v1_[3])}; } } } while (0)
    SB_LOAD(jd);
    for (int j = jd; j >= 0; --j) {
        SB_LAS char* slot = lds + (j & 1) * SLOTB;
#pragma unroll
        for (int s4 = 0; s4 < 4; ++s4) { *(SB_LAS u32x4*)(slot + s4 * HSLOT + wid * 1024 + lane * 16) = kreg[s4]; *(SB_LAS u32x4*)(slot + s4 * HSLOT + 8192 + wid * 1024 + lane * 16) = vreg[s4]; }
        __syncthreads();
        if (j != jd) { const volatile SB_LAS unsigned* f = flags + ((j + 1) & 1) * 8; unsigned all = 1u;
#pragma unroll
            for (int w8 = 0; w8 < 8; ++w8) all &= f[w8];
            if (all) break; }
        if (j > 0) SB_LOAD(j - 1);
        if (worker && !done) {
            const int key0 = (SAMPLE && j == 16) ? cfg::PAST : 64 * j;
            sb_tile(slot + hs * HSLOT, j == jd, (j == jd) && (SAMPLE || wq == 0), key0 + 4 * hi - qpos, qr, Rb, o, Um, Jm, r32, hi, lane);
            done = __all(Rb[0] > THR2) != 0;
        }
        if (lane == 0) flags[(j & 1) * 8 + wid] = (done || !worker) ? 1u : 0u;
    }
#undef SB_LOAD
    __syncthreads();
    if (worker) {
        SB_LAS bf16_t* stg = (SB_LAS bf16_t*)lds + wid * 2048;
#pragma unroll
        for (int r = 0; r < 16; ++r) { const int orow = crow(r, hi);
#pragma unroll
            for (int d0 = 0; d0 < 2; ++d0) stg[orow * 64 + d0 * 32 + r32] = (bf16_t)(cvtpk(o[d0][r], 0.f) & 0xffffu); }
        asm volatile("s_waitcnt lgkmcnt(0)" ::: "memory");
        bf16_t* Ow = T.O + (rowbase + q0 + 32 * wq) * PITCH + head * 64;
        if (SAMPLE) asm volatile("s_waitcnt vmcnt(0)" ::: "memory");
#pragma unroll
        for (int i = 0; i < 4; ++i) { const int row = i * 8 + (lane >> 3), ch = lane & 7; const u32x4 v = *(const SB_LAS u32x4*)(stg + row * 64 + ch * 8);
            if (SAMPLE) { unsigned long long* po = (unsigned long long*)(Ow + (size_t)row * PITCH + ch * 8);
                __hip_atomic_store(po, (unsigned long long)v.x | ((unsigned long long)v.y << 32), __ATOMIC_RELAXED, __HIP_MEMORY_SCOPE_AGENT); __hip_atomic_store(po + 1, (unsigned long long)v.z | ((unsigned long long)v.w << 32), __ATOMIC_RELAXED, __HIP_MEMORY_SCOPE_AGENT); }
            else *(u32x4*)(Ow + (size_t)row * PITCH + ch * 8) = v; }
    }
    if (SAMPLE) { if (!worker) asm volatile("s_waitcnt vmcnt(0)" ::: "memory");
                  asm volatile("s_waitcnt lgkmcnt(0)" ::: "memory"); __builtin_amdgcn_s_barrier(); }
    else __syncthreads();
}
}
namespace sk {
typedef short bf16x8 __attribute__((ext_vector_type(8)));
typedef float f32x16 __attribute__((ext_vector_type(16)));
typedef float f32x4 __attribute__((ext_vector_type(4)));
typedef unsigned short bf16_t;
#define SK_LAS __attribute__((address_space(3)))
constexpr int PLD = 36;
constexpr int LDS_BYTES = 8 * 2 * 32 * PLD * 4;
__device__ __forceinline__ f32x4 tile(const bf16_t* A, const bf16_t* Bt, int K, size_t arow0, int col0, SK_LAS char* lds) {
    int tid = threadIdx.x; asm volatile("" : "+v"(tid)); const int lane = tid & 63, r32 = lane & 31, hi = lane >> 5; const int wid = __builtin_amdgcn_readfirstlane(tid >> 6);
    const int nsplit = (K >= 512) ? 8 : (K >> 6), ks = K / nsplit;
    const bf16_t* ap = A + (arow0 + r32) * K + wid * ks + hi * 32;
    const bf16_t* bp0 = Bt + (size_t)(col0 + r32) * K + wid * ks + hi * 32; const bf16_t* bp1 = bp0 + (size_t)32 * K;
    f32x16 acc0 = {}, acc1 = {};
#pragma unroll 2
    for (int s = 0; s < ((wid < nsplit) ? ks : 0); s += 64) {
        bf16x8 a[4], b0[4], b1[4];
#pragma unroll
        for (int j = 0; j < 4; ++j) { a[j] = *(const bf16x8*)(ap + s + 8 * j); b0[j] = *(const bf16x8*)(bp0 + s + 8 * j); b1[j] = *(const bf16x8*)(bp1 + s + 8 * j); }
#pragma unroll
        for (int j = 0; j < 4; ++j) {
            acc0 = __builtin_amdgcn_mfma_f32_32x32x16_bf16(b0[j], a[j], acc0, 0, 0, 0);
            acc1 = __builtin_amdgcn_mfma_f32_32x32x16_bf16(b1[j], a[j], acc1, 0, 0, 0); }
    }
    SK_LAS float* P0 = (SK_LAS float*)lds + ((wid * 2 + 0) * 32 + r32) * PLD + 4 * hi; SK_LAS float* P1 = P0 + 32 * PLD;
#pragma unroll
    for (int g = 0; g < 4; ++g) { *(SK_LAS f32x4*)(P0 + 8 * g) = (f32x4){acc0[4 * g], acc0[4 * g + 1], acc0[4 * g + 2], acc0[4 * g + 3]};
                                  *(SK_LAS f32x4*)(P1 + 8 * g) = (f32x4){acc1[4 * g], acc1[4 * g + 1], acc1[4 * g + 2], acc1[4 * g + 3]}; }
    __syncthreads();
    const int row = tid >> 4, c = (tid & 15) * 4, cb = c >> 5, cc = c & 31;
    f32x4 s = {0.f, 0.f, 0.f, 0.f};
#pragma unroll
    for (int w = 0; w < 8; ++w) s += *(const SK_LAS f32x4*)((SK_LAS float*)lds + ((w * 2 + cb) * 32 + row) * PLD + cc);
    __syncthreads();
    return s;
}
__device__ __forceinline__ void tile4(const bf16_t* A, const bf16_t* Bt, int K, size_t arow0, int col0, SK_LAS char* lds, f32x4 (&out)[2][2]) {
    int tid = threadIdx.x; asm volatile("" : "+v"(tid)); const int lane = tid & 63, r32 = lane & 31, hi = lane >> 5; const int wid = __builtin_amdgcn_readfirstlane(tid >> 6);
    const int half = wid >> 2, kq = wid & 3, ks = K >> 2;
    const bf16_t* ap = A + (arow0 + r32) * K + kq * ks + hi * 32;
    const bf16_t* bp = Bt + (size_t)(col0 + half * 128 + r32) * K + kq * ks + hi * 32;
    f32x16 acc[4]; acc[0] = f32x16{}; acc[1] = f32x16{}; acc[2] = f32x16{}; acc[3] = f32x16{};
#pragma unroll 1
    for (int s = 0; s < ks; s += 64) {
        bf16x8 a[4], b[4][4];
#pragma unroll
        for (int e = 0; e < 4; ++e) { a[e] = *(const bf16x8*)(ap + s + 8 * e);
#pragma unroll
            for (int j = 0; j < 4; ++j) b[j][e] = *(const bf16x8*)(bp + (size_t)(32 * j) * K + s + 8 * e); }
#pragma unroll
        for (int e = 0; e < 4; ++e)
#pragma unroll
            for (int j = 0; j < 4; ++j) acc[j] = __builtin_amdgcn_mfma_f32_32x32x16_bf16(b[j][e], a[e], acc[j], 0, 0, 0);
    }
    const int row = tid >> 4, cc = (tid & 15) * 4;
#pragma unroll
    for (int q = 0; q < 2; ++q) {
        SK_LAS float* P0 = (SK_LAS float*)lds + ((wid * 2 + 0) * 32 + r32) * PLD + 4 * hi; SK_LAS float* P1 = P0 + 32 * PLD;
#pragma unroll
        for (int g = 0; g < 4; ++g) { *(SK_LAS f32x4*)(P0 + 8 * g) = (f32x4){acc[2 * q][4 * g], acc[2 * q][4 * g + 1], acc[2 * q][4 * g + 2], acc[2 * q][4 * g + 3]};
                                      *(SK_LAS f32x4*)(P1 + 8 * g) = (f32x4){acc[2 * q + 1][4 * g], acc[2 * q + 1][4 * g + 1], acc[2 * q + 1][4 * g + 2], acc[2 * q + 1][4 * g + 3]}; }
        __syncthreads();
#pragma unroll
        for (int h = 0; h < 2; ++h) { f32x4 sum = {0.f, 0.f, 0.f, 0.f};
#pragma unroll
            for (int w = 0; w < 4; ++w) sum += *(const SK_LAS f32x4*)((SK_LAS float*)lds + (((h * 4 + w) * 2 + (cc >> 5)) * 32 + row) * PLD + (cc & 31));
            out[h][q] = sum; }
        __syncthreads();
    }
}
__device__ __forceinline__ f32x16 wtile(const bf16_t* A, const bf16_t* Bt, int K, size_t arow0, int colw, int lane) {
    const int r32 = lane & 31, hi = lane >> 5;
    const bf16_t* ap = A + (arow0 + r32) * K + hi * 32; const bf16_t* bp = Bt + (size_t)(colw + r32) * K + hi * 32;
    f32x16 acc = {};
#pragma unroll 4
    for (int s = 0; s < K; s += 64) {
        bf16x8 a[4], b[4];
#pragma unroll
        for (int e = 0; e < 4; ++e) { a[e] = *(const bf16x8*)(ap + s + 8 * e); b[e] = *(const bf16x8*)(bp + s + 8 * e); }
#pragma unroll
        for (int e = 0; e < 4; ++e) acc = __builtin_amdgcn_mfma_f32_32x32x16_bf16(b[e], a[e], acc, 0, 0, 0);
    }
    return acc;
}
__device__ __forceinline__ float sum16(float v) { v += __shfl_xor(v, 1); v += __shfl_xor(v, 2); v += __shfl_xor(v, 4); v += __shfl_xor(v, 8); return v; }
__device__ __forceinline__ float rstd16(const float* SSQ, int r, int t) { return __builtin_amdgcn_rsqf(sum16(__hip_atomic_load(SSQ + (size_t)r * 16 + (t & 15), __ATOMIC_RELAXED, __HIP_MEMORY_SCOPE_AGENT)) * (1.0f / 1024.0f) + cfg::EPS); }
__device__ __forceinline__ float rstd_row(const float* SSQ, int r) { const f32x4* p = (const f32x4*)(SSQ + (size_t)r * 16); const f32x4 a = p[0], b = p[1], c = p[2], d = p[3];
    const float s = ((a[0] + a[1]) + (a[2] + a[3])) + ((b[0] + b[1]) + (b[2] + b[3])) + ((c[0] + c[1]) + (c[2] + c[3])) + ((d[0] + d[1]) + (d[2] + d[3])); return __builtin_amdgcn_rsqf(s * (1.0f / 1024.0f) + cfg::EPS); }
__device__ __forceinline__ unsigned long long pk4(f32x4 v) { return (unsigned long long)pg8::cvt_pk_bf16(v[0], v[1]) | ((unsigned long long)pg8::cvt_pk_bf16(v[2], v[3]) << 32); }
__device__ __forceinline__ f32x4 up4(unsigned long long w) { const unsigned lo = (unsigned)w, hi = (unsigned)(w >> 32); return (f32x4){pg8::bf_lo(lo), pg8::bf_hi(lo), pg8::bf_lo(hi), pg8::bf_hi(hi)}; }
}
#define GAS __attribute__((address_space(1)))
#define LAS __attribute__((address_space(3)))
typedef unsigned short bf16;
typedef unsigned v4u __attribute__((ext_vector_type(4)));
typedef float f32x4 __attribute__((ext_vector_type(4)));
typedef short bf16x8 __attribute__((ext_vector_type(8)));
typedef GAS unsigned gu32;
typedef GAS unsigned long long gu64;
#define RLX_AGENT __ATOMIC_RELAXED, __HIP_MEMORY_SCOPE_AGENT
#define LDS_WAIT() asm volatile("s_waitcnt lgkmcnt(0)" ::: "memory")
#define VM_WAIT() asm volatile("s_waitcnt vmcnt(0)" ::: "memory")
__device__ __forceinline__ unsigned long long rt() { return __builtin_amdgcn_s_memrealtime(); }
__device__ __forceinline__ unsigned f2bf(float f) { unsigned u = __builtin_bit_cast(unsigned, f); return (u + 0x7fffu + ((u >> 16) & 1u)) >> 16; }
__device__ __forceinline__ unsigned pk2(float lo, float hi) { return f2bf(lo) | (f2bf(hi) << 16); }
#define XB_TMO      128
#define XB_XCNT(j)  (256  + 64 * (j))
#define XB_XSUB(j)  (1280 + 64 * (j))
#define XB_XGEN(j)  (2304 + 64 * (j))
#define XB_TOP      3328
#define XB_TOPGEN   3392
#define XCD_BAR_WORDS 3456
#define XB_SPIN_CAP (1u << 18)

__device__ __forceinline__ unsigned xb_ld(unsigned* p)              { return __hip_atomic_load(p, __ATOMIC_RELAXED, __HIP_MEMORY_SCOPE_AGENT); }
__device__ __forceinline__ unsigned xb_add(unsigned* p, unsigned v) { return __hip_atomic_fetch_add(p, v, __ATOMIC_RELAXED, __HIP_MEMORY_SCOPE_AGENT); }
__device__ __forceinline__ unsigned xb_xcc_id() { return (unsigned)__builtin_amdgcn_s_getreg((3 << 11) | 20) & 0xFu; }
#define XB_SPIN(cond, bar) do { unsigned _sp = 0; while (cond) { __builtin_amdgcn_s_sleep(1); \
    if ((++_sp & 255u) == 0u) { if (xb_ld(&(bar)[XB_TMO])) break; if (_sp > XB_SPIN_CAP) { atomicAdd(&(bar)[XB_TMO], 1u); break; } } } } while (0)

struct XcdBarrier {
    unsigned* bar; unsigned x;
    volatile LAS unsigned* st;
};

__device__ __forceinline__ XcdBarrier xcd_barrier_post(unsigned* bar, volatile LAS unsigned* st) {
    XcdBarrier b; b.bar = bar; b.x = xb_xcc_id(); b.st = st;
    if (threadIdx.x == 0) (void)xb_add(&bar[XB_XCNT(b.x)], 1u);
    return b;
}
__device__ __forceinline__ void xcd_barrier_complete(unsigned* bar, unsigned x, unsigned& nloc, unsigned& nx) {
    const unsigned G = gridDim.x * gridDim.y * gridDim.z;
    unsigned sum, cnt, mine, sp = 0u;
    for (;;) {
        sum = 0u; cnt = 0u; mine = 0u;
#pragma unroll
        for (unsigned j = 0; j < 16; ++j) { const unsigned c = xb_ld(&bar[XB_XCNT(j)]); sum += c; cnt += (c > 0u) ? 1u : 0u; mine = (j == x) ? c : mine; }
        if (sum == G) break;
        __builtin_amdgcn_s_sleep(1);
        if ((++sp & 255u) == 0u) { if (xb_ld(&bar[XB_TMO])) break; if (sp > XB_SPIN_CAP) { atomicAdd(&bar[XB_TMO], 1u); break; } }
    }
    nloc = mine > 0u ? mine : 1u; nx = cnt > 0u ? cnt : 1u;
}

__device__ __forceinline__ void xcd_barrier(const XcdBarrier& b) {
    asm volatile("s_waitcnt vmcnt(0)" ::: "memory");
    __syncthreads();
    if (threadIdx.x == 0) {
        unsigned* bar = b.bar;
        __builtin_amdgcn_s_waitcnt(0);
        unsigned nloc = b.st[0], nx = b.st[1];
        if (nloc == 0u) { xcd_barrier_complete(bar, b.x, nloc, nx); b.st[0] = nloc; b.st[1] = nx; }
        const unsigned old = xb_add(&bar[XB_XSUB(b.x)], 1u);
        const unsigned gen = old / nloc;
        if (old + 1u == (gen + 1u) * nloc) {
            __builtin_amdgcn_fence(__ATOMIC_RELEASE, "agent");
            asm volatile("s_waitcnt vmcnt(0)" ::: "memory");
            const unsigned og = xb_add(&bar[XB_TOP], 1u);
            const unsigned tg = og / nx;
            if (og + 1u == (tg + 1u) * nx) xb_add(&bar[XB_TOPGEN], 1u);
            else XB_SPIN(xb_ld(&bar[XB_TOPGEN]) == tg, bar);
            __builtin_amdgcn_fence(__ATOMIC_ACQUIRE, "agent");
            xb_add(&bar[XB_XGEN(b.x)], 1u);
            asm volatile("s_waitcnt vmcnt(0)" ::: "memory");
        } else {
            XB_SPIN(xb_ld(&bar[XB_XGEN(b.x)]) == gen, bar);
            __builtin_amdgcn_fence(__ATOMIC_ACQUIRE, "agent");
            asm volatile("s_waitcnt vmcnt(0)" ::: "memory");
        }
    }
    __syncthreads();
}
__device__ __forceinline__ float wave_sum(float v) {
#pragma unroll
    for (int o = 1; o < 64; o <<= 1) v += __shfl_xor(v, o);
    return v;
}
__device__ __forceinline__ void p0_transpose_item(const float* W, int K, int N, bf16* WT, int row_off, LAS float* scr, int item, int lane) {
    const int nblk = N / 32, kb = item / nblk, nb = item % nblk, k0 = 64 * kb, n0 = 32 * nb;
    float tv[32];
#pragma unroll
    for (int i = 0; i < 32; ++i) { const int kk = 2 * i + (lane >> 5); tv[i] = __builtin_nontemporal_load(W + (size_t)(k0 + kk) * N + n0 + (lane & 31)); }
#pragma unroll
    for (int i = 0; i < 32; ++i) { const int kk = 2 * i + (lane >> 5); scr[kk * 33 + (lane & 31)] = tv[i]; }
    LDS_WAIT(); asm volatile("" ::: "memory");
    const int c = lane & 7;
#pragma unroll
    for (int j = 0; j < 4; ++j) { const int n = (lane >> 3) + 8 * j; const LAS float* s = scr + (8 * c) * 33 + n;
        v4u o; o.x = pk2(s[0 * 33], s[1 * 33]); o.y = pk2(s[2 * 33], s[3 * 33]); o.z = pk2(s[4 * 33], s[5 * 33]); o.w = pk2(s[6 * 33], s[7 * 33]);
        *(GAS v4u*)(WT + (size_t)(row_off + n0 + n) * K + k0 + 8 * c) = o; }
    LDS_WAIT(); asm volatile("" ::: "memory");
}

struct P0T { const float* W; bf16* WT; int K, N, item; const float* gk; };
__device__ __forceinline__ void p0_t_load(const P0T& t, int lane, float (&tv)[32]) {
    const int nblk = t.N / 32, kb = t.item / nblk, nb = t.item % nblk, k0 = 64 * kb, n0 = 32 * nb;
#pragma unroll
    for (int i = 0; i < 32; ++i) { const int kk = 2 * i + (lane >> 5); tv[i] = __builtin_nontemporal_load(t.W + (size_t)(k0 + kk) * t.N + n0 + (lane & 31)); }
}
__device__ __forceinline__ void p0_t_finish(const P0T& t, LAS float* scr, int lane, const float (&tv)[32]) {
    const int nblk = t.N / 32, kb = t.item / nblk, nb = t.item % nblk, k0 = 64 * kb, n0 = 32 * nb;
#pragma unroll
    for (int i = 0; i < 32; ++i) { const int kk = 2 * i + (lane >> 5); scr[kk * 33 + (lane & 31)] = tv[i]; }
    LDS_WAIT(); asm volatile("" ::: "memory");
    const int c = lane & 7;
    f32x4 g0 = {1.f, 1.f, 1.f, 1.f}, g1 = g0;
    if (t.gk) { g0 = *(const GAS f32x4*)(t.gk + k0 + 8 * c); g1 = *(const GAS f32x4*)(t.gk + k0 + 8 * c + 4); }
#pragma unroll
    for (int j = 0; j < 4; ++j) { const int n = (lane >> 3) + 8 * j; const LAS float* s = scr + (8 * c) * 33 + n;
        v4u o; o.x = pk2(s[0 * 33] * g0.x, s[1 * 33] * g0.y); o.y = pk2(s[2 * 33] * g0.z, s[3 * 33] * g0.w); o.z = pk2(s[4 * 33] * g1.x, s[5 * 33] * g1.y); o.w = pk2(s[6 * 33] * g1.z, s[7 * 33] * g1.w);
        *(GAS v4u*)(t.WT + (size_t)(n0 + n) * t.K + k0 + 8 * c) = o; }
    LDS_WAIT(); asm volatile("" ::: "memory");
}
constexpr int NWAVES = 8;
#ifndef GROUP_BAR
#define GROUP_BAR 1
#endif
using namespace cfg;
constexpr size_t MiB = 1u << 20;
constexpr size_t WS_CTL = 0, CTL_ZERO_BYTES = MiB / 4;
constexpr size_t WS_WIN = 2 * MiB, WS_WEFF = 10 * MiB, WS_WSB = 11 * MiB, WS_WOUT = 12 * MiB, WS_WUP = 14 * MiB, WS_WDOWN = 22 * MiB, WS_WPG = 30 * MiB, WS_WPP = 32 * MiB;
constexpr size_t WS_SSQ1 = 33 * MiB, WS_SSQ2 = 35 * MiB, WS_SSQ3 = 37 * MiB, WS_RS0 = 39 * MiB  ;
constexpr size_t WS_PB = 40 * MiB;
constexpr size_t WS_XN = 49 * MiB;
constexpr size_t WS_BIG = 82 * MiB;
constexpr int NRG = 2048;
constexpr size_t ARK = (size_t)NRG * 1024;
constexpr size_t AR_U = 0, AR_Q = ARK, AR_K = 2 * ARK, AR_V = 3 * ARK, AR_G = 4 * ARK  , AR_Y = 6 * ARK, AR_YSB = 7 * ARK, ARENA = 8 * ARK;
constexpr size_t AR_MG = 0;
constexpr size_t AR_H = 0;
constexpr size_t AR_PP = 0;
constexpr size_t WS_X = WS_BIG + 8 * ARENA;
constexpr size_t WS_S = WS_X + 33 * MiB;
constexpr size_t SR_U = 0, SR_Q = 512 * 1024, SR_K = 2 * 512 * 1024, SR_V = 3 * 512 * 1024, SR_G = 4 * 512 * 1024  , SR_Y = 6 * 512 * 1024, SR_YSB = 7 * 512 * 1024,
                 SR_MG = 8 * 512 * 1024  , SR_H = 10 * 512 * 1024  , SR_XN1 = 18 * 512 * 1024  , SR_XN2 = 20 * 512 * 1024  , SR_END = 22 * 512 * 1024;
constexpr size_t WS_END = WS_S + SR_END;
static_assert((size_t)MT * 1024 * 2 == 33 * MiB && (size_t)MT * 16 * 4 <= 2 * MiB && (size_t)MT * 256 * 2 <= 9 * MiB && WS_END <= 256 * MiB && ARENA % 16 == 0, "d_ws map");
constexpr int CW_BAR = 4096, CW_FIN = 8192  , CW_FINS = 16384  , CW_XCC = 20480  , CW_GRP = 24576  , CW_SC = 28672  ;
static_assert((CW_SC + 64 * 16 * 7) * 4 <= (int)CTL_ZERO_BYTES, "control words inside the memset region");
constexpr size_t O_Y = 0, O_KP = 17301504, O_VP = 25690112, O_POOLP = 34078720, O_KS = 34140160, O_VS = 34402304, O_POOLS = 34664448, O_END = 34787328;
constexpr int RING_OFF = 0, RING_BYTES = 131072, LDSCTL_OFF = RING_BYTES, MISC_OFF = LDSCTL_OFF + 320, LDS_BYTES = 147456;
static_assert(sk::LDS_BYTES <= RING_BYTES && sba::LDS_BYTES <= RING_BYTES, "phase scratch fits the ring region");

struct Args { const float* in[22]; float* out; unsigned char* ws; };

__device__ __forceinline__ unsigned char* effp(unsigned char* ws, size_t aoff, int pitchB, int g) { return ws + WS_BIG + (size_t)g * ARENA + aoff - (size_t)(2048 * g) * (size_t)pitchB; }
__device__ __forceinline__ unsigned char* effs(unsigned char* ws, size_t soff, int pitchB) { return ws + WS_S + soff - (size_t)MP * (size_t)pitchB; }
__device__ __forceinline__ void st8_wt(void* p, unsigned long long v) { __hip_atomic_store((unsigned long long*)p, v, __ATOMIC_RELAXED, __HIP_MEMORY_SCOPE_AGENT); }
__device__ __forceinline__ void st4_wt(void* p, unsigned v) { __hip_atomic_store((unsigned*)p, v, __ATOMIC_RELAXED, __HIP_MEMORY_SCOPE_AGENT); }
__device__ __forceinline__ void stf_wt(float* p, float v) { __hip_atomic_store(p, v, __ATOMIC_RELAXED, __HIP_MEMORY_SCOPE_AGENT); }
#ifndef P0_TN
#define P0_TN 2
#endif
#ifndef P0_RN
#define P0_RN 4
#endif
#ifndef PLE_GATE_FIRST
#define PLE_GATE_FIRST 1
#endif
#ifndef GRP_L2_ATOMICS
#define GRP_L2_ATOMICS 1
#endif
#ifndef CHAIN_FENCE
#define CHAIN_FENCE 0
#endif
__device__ __forceinline__ void chain_post_wave(gu32* ctl, int s, int rb) {
    asm volatile("s_waitcnt vmcnt(0)" ::: "memory");
    if ((threadIdx.x & 63) == 0) __hip_atomic_fetch_add((unsigned*)(ctl + CW_SC + 64 * (16 * s + rb)), 1u, __ATOMIC_RELAXED, __HIP_MEMORY_SCOPE_AGENT);
}
struct PostHook { gu32* ctl; int s, rb; bool on;
    __device__ __forceinline__ void operator()(int ui) const { if (on && ui == 0) chain_post_wave(ctl, s, rb); } };
__device__ __forceinline__ void chain_wait_wave(gu32* ctl, int s, int rb, unsigned target) {
    unsigned spins = 0;
    while ((unsigned)__builtin_amdgcn_readfirstlane(__hip_atomic_load((unsigned*)(ctl + CW_SC + 64 * (16 * s + rb)), __ATOMIC_RELAXED, __HIP_MEMORY_SCOPE_AGENT)) < target) { __builtin_amdgcn_s_sleep(2); if (++spins > (1u << 18)) break; }
    if (CHAIN_FENCE) { __builtin_amdgcn_fence(__ATOMIC_ACQUIRE, "agent"); asm volatile("s_waitcnt vmcnt(0)" ::: "memory"); }
}
__device__ __forceinline__ void chain_wait(gu32* ctl, int s, int rb, unsigned target) {
    if (threadIdx.x < 64) chain_wait_wave(ctl, s, rb, target);
    __syncthreads();
}

template <int NR>
__device__ __forceinline__ void rms_rows_to_bf16(const float* const (&xrow)[NR], const f32x4 (&gg)[4], bf16* const (&orow)[NR], float* const (&rms_out)[NR], int lane) {
    f32x4 v[NR][4]; float s[NR];
#pragma unroll
    for (int i = 0; i < NR; ++i) { const GAS f32x4* xr = (const GAS f32x4*)(xrow[i] ? xrow[i] : xrow[0]) + lane;
#pragma unroll
        for (int j = 0; j < 4; ++j) v[i][j] = __builtin_nontemporal_load(xr + 64 * j); }
#pragma unroll
    for (int i = 0; i < NR; ++i) { s[i] = 0.f;
#pragma unroll
        for (int j = 0; j < 4; ++j) s[i] += (v[i][j].x * v[i][j].x + v[i][j].y * v[i][j].y) + (v[i][j].z * v[i][j].z + v[i][j].w * v[i][j].w); }
#pragma unroll
    for (int o = 1; o < 64; o <<= 1)
#pragma unroll
        for (int i = 0; i < NR; ++i) s[i] += __shfl_xor(s[i], o);
#pragma unroll
    for (int i = 0; i < NR; ++i) { const float rms = sqrtf(s[i] * (1.f / DM) + EPS), rs = 1.f / rms;
        if (xrow[i] && rms_out[i] && lane == 0) *rms_out[i] = rms;
        if (xrow[i]) { GAS unsigned long long* o0 = (GAS unsigned long long*)orow[i] + lane;
#pragma unroll
            for (int j = 0; j < 4; ++j) o0[64 * j] = (unsigned long long)pk2(v[i][j].x * rs * gg[j].x, v[i][j].y * rs * gg[j].y) | ((unsigned long long)pk2(v[i][j].z * rs * gg[j].z, v[i][j].w * rs * gg[j].w) << 32); } }
}
__device__ __forceinline__ void weff_item(const float* wgrp, const float* scale, const float* wpu, bf16* WT, int item, int lane) {
    const int nb = item & 15, cb = (item >> 4) & 15, g = item >> 8, n = nb * 64 + lane;
    float wg[8][2];
#pragma unroll
    for (int cc = 0; cc < 8; ++cc)
#pragma unroll
        for (int hh = 0; hh < 2; ++hh) wg[cc][hh] = wgrp[((size_t)(g * 128 + cb * 8 + cc)) * 128 + lane + 64 * hh] * scale[g * 128 + lane + 64 * hh];
    float acc[8];
#pragma unroll
    for (int cc = 0; cc < 8; ++cc) acc[cc] = 0.f;
#pragma unroll
    for (int hh = 0; hh < 2; ++hh)
#pragma unroll
        for (int q = 0; q < 2; ++q) { float wv[32];
#pragma unroll
            for (int d2 = 0; d2 < 32; ++d2) wv[d2] = wpu[(size_t)(g * 128 + hh * 64 + q * 32 + d2) * 1024 + n];
#pragma unroll
            for (int d2 = 0; d2 < 32; ++d2)
#pragma unroll
                for (int cc = 0; cc < 8; ++cc) acc[cc] = fmaf(__builtin_bit_cast(float, __builtin_amdgcn_readlane(__builtin_bit_cast(int, wg[cc][hh]), q * 32 + d2)), wv[d2], acc[cc]);
            asm volatile("" ::: "memory"); }
    v4u o; o.x = pk2(acc[0], acc[1]); o.y = pk2(acc[2], acc[3]); o.z = pk2(acc[4], acc[5]); o.w = pk2(acc[6], acc[7]);
    *(GAS v4u*)(WT + (size_t)n * 512 + g * 128 + cb * 8) = o;
}
template <int W, int R, bool WT>
__device__ __forceinline__ void pool_run(const bf16* Ub, const float* state_pool, bf16* Yb, int r0, int c, bool sample, int t0, int b_) {
    v4u rw[R - 1 + W];
#pragma unroll
    for (int k = 0; k < W - 1; ++k) { const int pos = t0 + k - (W - 1);
        if (pos >= 0) rw[k] = *(const GAS v4u*)(Ub + (size_t)(r0 - (W - 1) + k) * 512 + c);
        else if (sample) { const float* sp = state_pool + ((size_t)b_ * 15 + 15 + pos) * 512 + c; const f32x4 a = *(const GAS f32x4*)sp, b = *(const GAS f32x4*)(sp + 4); rw[k] = pg8::pack8(a, b); }
        else rw[k] = (v4u){0u, 0u, 0u, 0u}; }
#pragma unroll
    for (int k = W - 1; k < R - 1 + W; ++k) rw[k] = *(const GAS v4u*)(Ub + (size_t)(r0 - (W - 1) + k) * 512 + c);
    f32x4 s0 = {0.f, 0.f, 0.f, 0.f}, s1 = {0.f, 0.f, 0.f, 0.f};
#pragma unroll
    for (int k = 0; k < W - 1; ++k) { f32x4 a, b; pg8::unpack8(rw[k], a, b); s0 += a; s1 += b; }
#pragma unroll
    for (int i = 0; i < R; ++i) { f32x4 a, b, u0, u1; pg8::unpack8(rw[W - 1 + i], u0, u1); s0 += u0; s1 += u1;
        const int cnt = sample ? W : ((t0 + i + 1 < W) ? t0 + i + 1 : W); const float ic = 1.0f / (float)cnt;
        { const v4u yv = pg8::pack8(s0 * ic - u0, s1 * ic - u1);
          if (WT) { st8_wt(Yb + (size_t)(r0 + i) * 512 + c, (unsigned long long)yv.x | ((unsigned long long)yv.y << 32)); st8_wt(Yb + (size_t)(r0 + i) * 512 + c + 4, (unsigned long long)yv.z | ((unsigned long long)yv.w << 32)); }
          else *(GAS v4u*)(Yb + (size_t)(r0 + i) * 512 + c) = yv; }
        pg8::unpack8(rw[i], a, b); s0 -= a; s1 -= b; }
}
template <bool WT>
__device__ __forceinline__ void pool_item(int cg, const bf16* Ub, const float* state_pool, bf16* Yb, int r0, int c, bool sample, int t0, int b_) {
    if (cg == 0) pool_run<2, 16, WT>(Ub, state_pool, Yb, r0, c, sample, t0, b_); else if (cg == 1) pool_run<4, 16, WT>(Ub, state_pool, Yb, r0, c, sample, t0, b_); else if (cg == 2) pool_run<8, 16, WT>(Ub, state_pool, Yb, r0, c, sample, t0, b_);
    else { pool_run<16, 8, WT>(Ub, state_pool, Yb, r0, c, sample, t0, b_); asm volatile("" ::: "memory"); pool_run<16, 8, WT>(Ub, state_pool, Yb, r0 + 8, c, sample, t0 + 8, b_); }
}

__device__ __forceinline__ unsigned l2_add_ret(unsigned* p, unsigned v) {
    unsigned r;
    asm volatile("global_atomic_add %0, %1, %2, off sc0\n\ts_waitcnt vmcnt(0)" : "=&v"(r) : "v"(p), "v"(v) : "memory");
    return r;
}
__device__ __forceinline__ void grp_barrier(unsigned* cnt, unsigned members, volatile LAS unsigned* round_word, bool raw) {
    if (raw) { asm volatile("s_waitcnt lgkmcnt(0)" ::: "memory"); __builtin_amdgcn_s_barrier(); }
    else { asm volatile("s_waitcnt vmcnt(0)" ::: "memory");
           __syncthreads(); }
    if (threadIdx.x == 0) {
        const unsigned round = round_word[0] + 1u; round_word[0] = round;
#if GRP_L2_ATOMICS
        __hip_atomic_fetch_add(cnt, 1u, __ATOMIC_RELAXED, __HIP_MEMORY_SCOPE_WORKGROUP);
        unsigned spins = 0;
        const unsigned base = round_word[1];
        while (l2_add_ret(cnt, 0u) - base < members * round) { __builtin_amdgcn_s_sleep(1); if (++spins > (1u << 20)) break; }
#else
        __hip_atomic_fetch_add(cnt, 1u, __ATOMIC_RELAXED, __HIP_MEMORY_SCOPE_AGENT);
        unsigned spins = 0;
        while (__hip_atomic_load(cnt, __ATOMIC_RELAXED, __HIP_MEMORY_SCOPE_AGENT) < members * round) { __builtin_amdgcn_s_sleep(1); if (++spins > (1u << 20)) break; }
#endif
        __builtin_amdgcn_fence(__ATOMIC_ACQUIRE, "agent");
        asm volatile("s_waitcnt vmcnt(0)" ::: "memory");
    }
    __syncthreads();
}

__global__ void __launch_bounds__(NWAVES * 64, 2) mega_fwd(Args args) {
    extern __shared__ __attribute__((aligned(16))) unsigned char lds[];
    LAS unsigned char* L = (LAS unsigned char*)lds;
    volatile LAS unsigned* MISC = (volatile LAS unsigned*)(L + MISC_OFF);
    const int wave = __builtin_amdgcn_readfirstlane(threadIdx.x >> 6);
#define FRESH_TID() int tid = threadIdx.x; asm volatile("" : "+v"(tid)); const int lane = tid & 63; (void)lane
    const int G = gridDim.x, bx = blockIdx.x, vcu = (bx % 8) * (G / 8) + bx / 8;
    const int grp = vcu >> 5, gi = vcu & 31;
    unsigned char* ws = args.ws;
    gu32* ctl = (gu32*)(ws + WS_CTL);
    const float* x_p = args.in[0]; const float* x_s = args.in[1]; const float* cache_k = args.in[2]; const float* cache_v = args.in[3]; const float* state_pool = args.in[4];
    const float* p_p = args.in[5]; const float* p_s = args.in[6]; const float* g_mix = args.in[7]; const float* w_in = args.in[8]; const float* b_gate = args.in[9]; const float* w_grp = args.in[10];
    const float* pool_scale = args.in[11]; const float* w_pool_up = args.in[12]; const float* w_sb_up = args.in[13]; const float* w_out = args.in[14]; const float* g_mlp = args.in[15];
    const float* w_up = args.in[16]; const float* w_down = args.in[17]; const float* g_ple = args.in[18]; const float* w_ple_gate = args.in[19]; const float* w_ple_proj = args.in[20]; const float* g_final = args.in[21];
    float* out = args.out; float* Yo = out + O_Y;
    bf16 *WIN = (bf16*)(ws + WS_WIN), *WEFF = (bf16*)(ws + WS_WEFF), *WSB = (bf16*)(ws + WS_WSB), *WOUT = (bf16*)(ws + WS_WOUT), *WUP = (bf16*)(ws + WS_WUP), *WDOWN = (bf16*)(ws + WS_WDOWN), *WPG = (bf16*)(ws + WS_WPG), *WPP = (bf16*)(ws + WS_WPP);
    float *SSQ1 = (float*)(ws + WS_SSQ1), *SSQ2 = (float*)(ws + WS_SSQ2), *SSQ3 = (float*)(ws + WS_SSQ3), *RS0 = (float*)(ws + WS_RS0);
    bf16 *PB = (bf16*)(ws + WS_PB), *XN = (bf16*)(ws + WS_XN), *XB = (bf16*)(ws + WS_X);
    const int srb = vcu & 15, scb = vcu >> 4;
#define PV(aoff, pitchB) ((bf16*)effp(ws, aoff, pitchB, g_))
#define SV(soff, pitchB) ((bf16*)effs(ws, soff, pitchB))
#define OPQ() int g_ = grp, r_ = srb; asm volatile("" : "+s"(g_), "+s"(r_))

    for (int i = threadIdx.x; i < (LDS_BYTES - LDSCTL_OFF) / 4; i += NWAVES * 64) ((LAS unsigned*)(L + LDSCTL_OFF))[i] = 0u;
    __syncthreads();
    if (GRP_L2_ATOMICS && threadIdx.x == 0) MISC[13] = l2_add_ret((unsigned*)(ctl + CW_GRP + 64 * grp), 0u);
    XcdBarrier bar = xcd_barrier_post((unsigned*)(ctl + CW_BAR), MISC + 8);
    if (threadIdx.x == 0) __hip_atomic_fetch_add((unsigned*)(ctl + CW_XCC + 16 * grp + (int)(bar.x & 15u)), 1u, __ATOMIC_RELAXED, __HIP_MEMORY_SCOPE_AGENT);
    const int gw = vcu * NWAVES + wave, NGW = G * NWAVES;
    const bool late_ = (vcu & 1) != 0;

    {
        FRESH_TID();
        LAS float* scr = (LAS float*)(L + RING_OFF + wave * 16384);
        constexpr int I_IN = (DM / 64) * (INW / 32), I_SB = (SBW / 64) * (DM / 32), I_OUT = (DM / 64) * (DM / 32), I_UP = (DM / 64) * (DFF / 32), I_DOWN = (DFF / 64) * (DM / 32), I_PG = I_OUT, I_PP = (PLE / 64) * (DM / 32), I_EFF = 4 * 16 * 16;
        constexpr int NITEMS = I_IN + I_SB + I_OUT + I_UP + I_DOWN + I_PG + I_PP + I_EFF;
        for (int it = gw; it < I_EFF; it += NGW) weff_item(w_grp, pool_scale, w_pool_up, WEFF, it, lane);
        constexpr int NT = NITEMS - I_EFF;
        auto decode = [&](int r) -> P0T {
            if (r < I_IN) return P0T{w_in, WIN, DM, INW, r, FOLD_G ? g_mix : nullptr}; r -= I_IN;
            if (r < I_SB) return P0T{w_sb_up, WSB, SBW, DM, r, nullptr}; r -= I_SB;
            if (r < I_OUT) return P0T{w_out, WOUT, DM, DM, r, nullptr}; r -= I_OUT;
            if (r < I_UP) return P0T{w_up, WUP, DM, DFF, r, FOLD_G ? g_mlp : nullptr}; r -= I_UP;
            if (r < I_DOWN) return P0T{w_down, WDOWN, DFF, DM, r, nullptr}; r -= I_DOWN;
            if (r < I_PG) return P0T{w_ple_gate, WPG, DM, DM, r, FOLD_G ? g_ple : nullptr}; r -= I_PG;
            return P0T{w_ple_proj, WPP, PLE, DM, r, nullptr}; };
#pragma unroll 1
        for (int it = NGW - 1 - gw; it < NT; it += P0_TN * NGW) {
            P0T tt[P0_TN]; float tv[P0_TN][32];
#pragma unroll
            for (int i = 0; i < P0_TN; ++i) { const int iti = it + i * NGW; tt[i] = decode(iti < NT ? iti : it); if (iti >= NT) tt[i].item = -1; }
#pragma unroll
            for (int i = 0; i < P0_TN; ++i) if (tt[i].item >= 0) p0_t_load(tt[i], lane, tv[i]);
#pragma unroll
            for (int i = 0; i < P0_TN; ++i) if (tt[i].item >= 0) p0_t_finish(tt[i], scr, lane, tv[i]);
        }
        f32x4 gg[4];
#pragma unroll
        for (int j = 0; j < 4; ++j) gg[j] = FOLD_G ? (f32x4){1.f, 1.f, 1.f, 1.f} : *((const GAS f32x4*)g_mix + lane + 64 * j);
#pragma unroll 1
        for (int m = gw; m < MT; m += P0_RN * NGW) {
            const float* xr[P0_RN]; bf16* orow[P0_RN]; const float* pr[P0_RN]; f32x4 pv[P0_RN]; float* ro[P0_RN];
#pragma unroll
            for (int i = 0; i < P0_RN; ++i) { const int mi = m + i * NGW; const bool ok = mi < MT;
                xr[i] = !ok ? nullptr : (mi < MP ? x_p + (size_t)mi * DM : x_s + (size_t)(mi - MP) * DM);
                pr[i] = !ok ? p_p : (mi < MP ? p_p + (size_t)mi * PLE : p_s + (size_t)(mi - MP) * PLE);
                orow[i] = XN + (size_t)(ok ? mi : m) * DM; ro[i] = (ok && mi < MP) ? RS0 + mi : nullptr; }
#pragma unroll
            for (int i = 0; i < P0_RN; ++i) pv[i] = __builtin_nontemporal_load((const GAS f32x4*)pr[i] + lane);
            rms_rows_to_bf16<P0_RN>(xr, gg, orow, ro, lane);
#pragma unroll
            for (int i = 0; i < P0_RN; ++i) if (xr[i]) *((GAS unsigned long long*)(PB + (size_t)(m + i * NGW) * PLE) + lane) = (unsigned long long)pk2(pv[i].x, pv[i].y) | ((unsigned long long)pk2(pv[i].z, pv[i].w) << 32);
        }
    }
    xcd_barrier(bar);
    bool fast = false;
    if (GROUP_BAR) {
        bool okg = false;
        if (threadIdx.x < 128) okg = __hip_atomic_load((unsigned*)(ctl + CW_XCC + (int)threadIdx.x), __ATOMIC_RELAXED, __HIP_MEMORY_SCOPE_AGENT) == 32u;
        const unsigned long long bm = __ballot(okg);
        if ((threadIdx.x & 63) == 0 && wave < 2) MISC[16 + wave] = (unsigned)__builtin_popcountll(bm);
        __syncthreads();
        fast = (MISC[16] + MISC[17] == 8u) && (G == 256);
    }
    unsigned* gcnt = (unsigned*)(ctl + CW_GRP + 64 * grp);
#define SEAM(RAW) do { if (fast) grp_barrier(gcnt, 32u, MISC + 12, (RAW)); else xcd_barrier(bar); } while (0)
#define DRAIN_PLAIN() asm volatile("s_waitcnt vmcnt(0)" ::: "memory")
#define LATE_POST(S) do { if (late_) chain_post_wave(ctl, (S), srb); } while (0)

#pragma unroll 1
    for (int pass_ = 0; pass_ < 2; ++pass_) { OPQ(); if ((pass_ == 1) == late_) {
        { const int col0 = scb * 256; f32x4 vv[2][2];
            sk::tile4(XN, WIN, DM, (size_t)MP + srb * 32, col0, (SK_LAS char*)(L + RING_OFF), vv);
            DRAIN_PLAIN();
            int t_raw_ = threadIdx.x; asm volatile("" : "+v"(t_raw_)); const int t = t_raw_, rs = srb * 32 + (t >> 4), r = MP + rs;
#pragma unroll
            for (int h = 0; h < 2; ++h)
#pragma unroll
                for (int q = 0; q < 2; ++q) { const f32x4 v = vv[h][q]; const int c = col0 + 128 * h + 64 * q + (t & 15) * 4;
            if (c < 512) { st8_wt(SV(SR_U, 1024) + (size_t)r * 512 + c, sk::pk4(v)); const int i = rs & 31; if (i >= 17) *(GAS f32x4*)(out + O_POOLS + ((size_t)(rs >> 5) * 15 + (i - 17)) * 512 + c) = v; }
            else if (c < 1024) st8_wt(SV(SR_Q, 1024) + (size_t)r * 512 + c - 512, sk::pk4(v * QSCALE));
            else if (c < 1536) { st8_wt(SV(SR_K, 1024) + (size_t)r * 512 + c - 1024, sk::pk4(v)); *(GAS f32x4*)(out + O_KS + (size_t)rs * 512 + c - 1024) = v; }
            else if (c < 2048) { st8_wt(SV(SR_V, 1024) + (size_t)r * 512 + c - 1536, sk::pk4(v)); *(GAS f32x4*)(out + O_VS + (size_t)rs * 512 + c - 1536) = v; }
            else { const f32x4 bg = *(const GAS f32x4*)(b_gate + c - 2048); st4_wt((unsigned char*)SV(SR_G, 2048) + (size_t)r * 2048 + c - 2048, pg8::pk_u8x4(pg8::sigm4(v + bg))); } }
        }
    } else {
        pg8::Gemm g{XN, WIN, MP, INW, DM}; pg8::StaticOrder S; S.init(MP, INW, G, bx);
        pg8::EpiIn E{PV(AR_U, 1024), PV(AR_Q, 1024), PV(AR_K, 1024), PV(AR_V, 1024), PV(AR_G, 2048), b_gate, out + O_KP, out + O_VP, out + O_KS, out + O_VS, out + O_POOLP, out + O_POOLS};
        pg8::gemm_phase<pg8::EpiIn, pg8::StaticOrder, true, true, PostHook>(L + RING_OFF, g, S, E, PostHook{ctl, 1, srb, !late_});
    } }
    SEAM(late_); LATE_POST(1);
    {
        FRESH_TID(); OPQ();
        const bool host_ = (gi & 7) == 7; const int rho_ = gi - (gi >> 3);
        if (!host_ && (wave < 4 || (wave == 5 && rho_ < 16))) { const int wi = wave < 4 ? wave * 28 + rho_ : 112 + rho_, cg = wi & 3, k = lane >> 4, lrow = ((wi >> 2) * 4 + k) * 16;
            const bf16* ub = (const bf16*)(effp(ws, AR_U, 1024, g_) + (size_t)g_ * 2048 * 1024); bf16* yb = (bf16*)(effp(ws, AR_Y, 1024, g_) + (size_t)g_ * 2048 * 1024);
            pool_item<false>(cg, ub, state_pool, yb, lrow, cg * 128 + (lane & 15) * 8, false, lrow & (SEQ - 1), 0); }
        if (wave == 4 && (vcu & 7) == 0) { const int si = vcu >> 3, cg = si & 3, run4 = si >> 2, k = lane >> 4, rs = (run4 * 4 + k) * 16;
            chain_wait_wave(ctl, 1, 2 * run4, 128u); chain_wait_wave(ctl, 1, 2 * run4 + 1, 128u);
            pool_item<true>(cg, SV(SR_U, 1024), state_pool, SV(SR_Y, 1024), MP + rs, cg * 128 + (lane & 15) * 8, true, rs & 31, rs >> 5);
            asm volatile("s_waitcnt vmcnt(0)" ::: "memory");
            if (lane == 0) { __hip_atomic_fetch_add((unsigned*)(ctl + CW_SC + 64 * (16 * 2 + 2 * run4)), 1u, __ATOMIC_RELAXED, __HIP_MEMORY_SCOPE_AGENT); __hip_atomic_fetch_add((unsigned*)(ctl + CW_SC + 64 * (16 * 2 + 2 * run4 + 1)), 1u, __ATOMIC_RELAXED, __HIP_MEMORY_SCOPE_AGENT); } }
        volatile LAS unsigned* sbflags = (volatile LAS unsigned*)(L + LDSCTL_OFF + 1024);
        { const sba::Tensors T{PV(AR_Q, 1024), PV(AR_K, 1024), PV(AR_V, 1024), PV(AR_YSB, 1024), cache_k, cache_v}; const int hg = gi & 1, s = gi >> 1;
#pragma unroll 1
          for (int k = 0; k < 2; ++k) sba::sb_unit<false>(grp, hg, (k & 1) ? 31 - s : s, T, (SB_LAS char*)(L + RING_OFF), sbflags); }
        if ((vcu & 7) == 7) { const int rb = vcu >> 4, hg = (vcu >> 3) & 1;
            chain_wait(ctl, 1, rb, 128u);
            const sba::Tensors T{SV(SR_Q, 1024), SV(SR_K, 1024), SV(SR_V, 1024), SV(SR_YSB, 1024), cache_k, cache_v};
            sba::sb_unit<true>(rb, hg, 0, T, (SB_LAS char*)(L + RING_OFF), sbflags); }
    }
    SEAM((vcu & 7) == 7);
    if ((vcu & 7) == 7 && wave < 4) chain_post_wave(ctl, 2, vcu >> 4);
#pragma unroll 1
    for (int pass_ = 0; pass_ < 2; ++pass_) { OPQ(); if ((pass_ == 1) == late_) {
        { const int rb = srb, col0 = scb * 64;
            chain_wait(ctl, 2, rb, 12u);
            unsigned gaw, gbw;
            { int te_ = threadIdx.x; asm volatile("" : "+v"(te_)); const size_t go = (size_t)(MP + rb * 32 + (te_ >> 4)) * 2048 + col0 + (te_ & 15) * 4; gaw = *(const GAS unsigned*)((const unsigned char*)SV(SR_G, 2048) + go); gbw = *(const GAS unsigned*)((const unsigned char*)SV(SR_G, 2048) + go + 1024); }
            const f32x4 va = sk::tile(SV(SR_Y, 1024), WEFF, PW, (size_t)MP + rb * 32, col0, (SK_LAS char*)(L + RING_OFF));
            const f32x4 vb = sk::tile(SV(SR_YSB, 1024), WSB, SBW, (size_t)MP + rb * 32, col0, (SK_LAS char*)(L + RING_OFF));
            int t_raw_ = threadIdx.x; asm volatile("" : "+v"(t_raw_)); const int t = t_raw_, r = MP + rb * 32 + (t >> 4), c = col0 + (t & 15) * 4;
            const f32x4 ga = pg8::up_u8x4(gaw), gb = pg8::up_u8x4(gbw);
            DRAIN_PLAIN();
            st8_wt(SV(SR_MG, 2048) + (size_t)r * 1024 + c, sk::pk4(ga * va + gb * vb));
        }
    } else {
        pg8::Gemm g{PV(AR_Y, 1024), WEFF, MP, DM, PW, PV(AR_YSB, 1024), WSB}; pg8::PairOrder S; S.init(MP, DM, G, bx); pg8::EpiMerge E{PV(AR_G, 2048), PV(AR_MG, 2048)};
        pg8::gemm_phase<pg8::EpiMerge, pg8::PairOrder, true, true, PostHook>(L + RING_OFF, g, S, E, PostHook{ctl, 3, srb, !late_});
    } }
    SEAM(late_); LATE_POST(3);
#pragma unroll 1
    for (int pass_ = 0; pass_ < 2; ++pass_) { OPQ(); if ((pass_ == 1) == late_) {
        { const int rb = srb, col0 = scb * 64;
            chain_wait(ctl, 3, rb, 128u);
            f32x4 xe;
            { int te_ = threadIdx.x; asm volatile("" : "+v"(te_)); xe = *(const GAS f32x4*)(x_s + (size_t)(rb * 32 + (te_ >> 4)) * DM + col0 + (te_ & 15) * 4); }
            const f32x4 v = sk::tile(SV(SR_MG, 2048), WOUT, DM, (size_t)MP + rb * 32, col0, (SK_LAS char*)(L + RING_OFF));
            int t_raw_ = threadIdx.x; asm volatile("" : "+v"(t_raw_)); const int t = t_raw_, rs = rb * 32 + (t >> 4), r = MP + rs, c = col0 + (t & 15) * 4;
            DRAIN_PLAIN();
            const f32x4 x1 = xe + v; st8_wt(XB + (size_t)r * DM + c, sk::pk4(x1));
            st8_wt(SV(SR_XN1, 2048) + (size_t)r * DM + c, sk::pk4(FOLD_G ? x1 : x1 * *(const GAS f32x4*)(g_mlp + c)));
            const float ss = sk::sum16(pg8::dot4(x1)); if ((t & 15) == 0) stf_wt(SSQ1 + (size_t)r * 16 + (col0 >> 6), ss);
        }
    } else {
        pg8::Gemm g{PV(AR_MG, 2048), WOUT, MP, DM, DM}; pg8::StaticOrder S; S.init(MP, DM, G, bx); pg8::EpiResid<true> E{x_p, XB, XN, g_mlp, SSQ1, XN, RS0};
        pg8::gemm_phase<pg8::EpiResid<true>, pg8::StaticOrder, true, true, PostHook>(L + RING_OFF, g, S, E, PostHook{ctl, 4, srb, !late_});
    } }
    SEAM(late_); LATE_POST(4);
#pragma unroll 1
    for (int pass_ = 0; pass_ < 2; ++pass_) { OPQ(); if ((pass_ == 1) == late_) {
        { const int rb = srb, col0 = scb * 256; f32x4 vv[2][2];
            chain_wait(ctl, 4, rb, 128u);
            float rs_;
            { int te_ = threadIdx.x; asm volatile("" : "+v"(te_)); rs_ = sk::rstd16(SSQ1, MP + rb * 32 + (te_ >> 4), te_); }
            sk::tile4(SV(SR_XN1, 2048), WUP, DM, (size_t)MP + rb * 32, col0, (SK_LAS char*)(L + RING_OFF), vv);
            DRAIN_PLAIN();
            int t_raw_ = threadIdx.x; asm volatile("" : "+v"(t_raw_)); const int t = t_raw_, r = MP + rb * 32 + (t >> 4);
#pragma unroll
            for (int h = 0; h < 2; ++h)
#pragma unroll
                for (int q = 0; q < 2; ++q) { const int c = col0 + 128 * h + 64 * q + (t & 15) * 4; const f32x4 a = __builtin_elementwise_max(vv[h][q] * rs_, (f32x4){0.f, 0.f, 0.f, 0.f});
                    st8_wt(SV(SR_H, 8192) + (size_t)r * DFF + c, sk::pk4(a * a)); }
        }
    } else {
        pg8::Gemm g{FOLD_G ? XB : XN, WUP, MP, DFF, DM}; pg8::StaticOrder S; S.init(MP, DFF, G, bx); pg8::EpiUp E{SSQ1, PV(AR_H, 8192)};
        pg8::gemm_phase<pg8::EpiUp, pg8::StaticOrder, true, true, PostHook>(L + RING_OFF, g, S, E, PostHook{ctl, 5, srb, !late_});
    } }
    SEAM(late_); LATE_POST(5);
#pragma unroll 1
    for (int pass_ = 0; pass_ < 2; ++pass_) { OPQ(); if ((pass_ == 1) == late_) {
        { const int rb = srb, col0 = scb * 64;
            chain_wait(ctl, 5, rb, 128u);
            unsigned long long xw_;
            { int te_ = threadIdx.x; asm volatile("" : "+v"(te_)); xw_ = *(const GAS unsigned long long*)(XB + (size_t)(MP + rb * 32 + (te_ >> 4)) * DM + col0 + (te_ & 15) * 4); }
            const f32x4 v = sk::tile(SV(SR_H, 8192), WDOWN, DFF, (size_t)MP + rb * 32, col0, (SK_LAS char*)(L + RING_OFF));
            int t_raw_ = threadIdx.x; asm volatile("" : "+v"(t_raw_)); const int t = t_raw_, r = MP + rb * 32 + (t >> 4), c = col0 + (t & 15) * 4;
            DRAIN_PLAIN();
            const f32x4 x2 = sk::up4(xw_) + v; st8_wt(XB + (size_t)r * DM + c, sk::pk4(x2));
            st8_wt(SV(SR_XN2, 2048) + (size_t)r * DM + c, sk::pk4(FOLD_G ? x2 : x2 * *(const GAS f32x4*)(g_ple + c)));
            const float ss = sk::sum16(pg8::dot4(x2)); if ((t & 15) == 0) stf_wt(SSQ2 + (size_t)r * 16 + (col0 >> 6), ss);
        }
    } else {
        pg8::Gemm g{PV(AR_H, 8192), WDOWN, MP, DM, DFF}; pg8::StaticOrder S; S.init(MP, DM, G, bx); pg8::EpiResid<false> E{nullptr, XB, XN, g_ple, SSQ2};
        pg8::gemm_phase<pg8::EpiResid<false>, pg8::StaticOrder, true, true, PostHook>(L + RING_OFF, g, S, E, PostHook{ctl, 6, srb, !late_});
    } }
    SEAM(late_); LATE_POST(6);
#pragma unroll 1
    for (int pass_ = 0; pass_ < 2; ++pass_) { OPQ(); if ((pass_ == 1) == late_) {
        { const int rb = srb, col0 = scb * 64;
            chain_wait(ctl, 6, rb, 128u);
            float rs_; unsigned long long xw_;
            { int te_ = threadIdx.x; asm volatile("" : "+v"(te_)); rs_ = sk::rstd16(SSQ2, MP + rb * 32 + (te_ >> 4), te_); xw_ = *(const GAS unsigned long long*)(XB + (size_t)(MP + rb * 32 + (te_ >> 4)) * DM + col0 + (te_ & 15) * 4); }
            const f32x4 vp = sk::tile(PB, WPP, PLE, (size_t)MP + rb * 32, col0, (SK_LAS char*)(L + RING_OFF));
            const f32x4 vg = sk::tile(SV(SR_XN2, 2048), WPG, DM, (size_t)MP + rb * 32, col0, (SK_LAS char*)(L + RING_OFF));
            int t_raw_ = threadIdx.x; asm volatile("" : "+v"(t_raw_)); const int t = t_raw_, r = MP + rb * 32 + (t >> 4), c = col0 + (t & 15) * 4;
            const f32x4 x3 = sk::up4(xw_) + pg8::sigm4(vg * rs_) * vp;
            const float ss = sk::sum16(pg8::dot4(x3)); if ((t & 15) == 0) __hip_atomic_store(SSQ3 + (size_t)r * 16 + (col0 >> 6), ss, __ATOMIC_RELAXED, __HIP_MEMORY_SCOPE_AGENT);
            asm volatile("s_waitcnt vmcnt(0)" ::: "memory");
            unsigned* cw = (unsigned*)(ctl + CW_FINS + 64 * rb);
            if ((t & 63) == 0) __hip_atomic_fetch_add(cw, 1u, __ATOMIC_RELAXED, __HIP_MEMORY_SCOPE_AGENT);
            { unsigned spins = 0; while ((unsigned)__builtin_amdgcn_readfirstlane(__hip_atomic_load(cw, __ATOMIC_RELAXED, __HIP_MEMORY_SCOPE_AGENT)) < 128u) { __builtin_amdgcn_s_sleep(2); if (++spins > (1u << 16)) break; } }
            const float r3 = __builtin_amdgcn_rsqf(sk::sum16(__hip_atomic_load(SSQ3 + (size_t)r * 16 + (t & 15), __ATOMIC_RELAXED, __HIP_MEMORY_SCOPE_AGENT)) * (1.0f / 1024.0f) + EPS);
            *(GAS f32x4*)(Yo + (size_t)r * DM + c) = x3 * r3 * *(const GAS f32x4*)(g_final + c);
        }
    } else {
#if PLE_GATE_FIRST
        { pg8::Gemm g{FOLD_G ? XB : XN, WPG, MP, DM, DM}; pg8::StaticOrder S; S.init(MP, DM, G, bx); pg8::EpiGate8 E{SSQ2, (unsigned char*)PV(AR_PP, 1024)};
          pg8::gemm_phase<pg8::EpiGate8, pg8::StaticOrder, true, true>(L + RING_OFF, g, S, E); }
        { pg8::Gemm g{PB, WPP, MP, DM, PLE}; pg8::StaticOrder S; S.init(MP, DM, G, bx); pg8::EpiPleFinal2 E{(const unsigned char*)PV(AR_PP, 1024), XB, Yo, SSQ3, g_final, (unsigned*)(ctl + CW_FIN)};
          pg8::gemm_phase<pg8::EpiPleFinal2, pg8::StaticOrder, true, true>(L + RING_OFF, g, S, E); }
#else
        { pg8::Gemm g{PB, WPP, MP, DM, PLE}; pg8::StaticOrder S; S.init(MP, DM, G, bx); pg8::EpiPP E{PV(AR_PP, 2048)};
          pg8::gemm_phase<pg8::EpiPP, pg8::StaticOrder, true, true>(L + RING_OFF, g, S, E); }
        { pg8::Gemm g{FOLD_G ? XB : XN, WPG, MP, DM, DM}; pg8::StaticOrder S; S.init(MP, DM, G, bx); pg8::EpiPleFinal E{SSQ2, PV(AR_PP, 2048), XB, Yo, SSQ3, g_final, (unsigned*)(ctl + CW_FIN)};
          pg8::gemm_phase<pg8::EpiPleFinal, pg8::StaticOrder, true, true>(L + RING_OFF, g, S, E); }
#endif
    } }
#undef SEAM
#undef LATE_POST
#undef DRAIN_PLAIN
#undef PV
#undef SV
#undef OPQ
#undef FRESH_TID
}

extern "C" void kernel_launch(void* const* d_in, const int* in_sizes, int n_in, void* d_out, int out_size, void* d_ws, size_t ws_size, hipStream_t stream) {
    static int grid = 0;
    if (grid == 0) {
        if (n_in != 22 || out_size != (int)O_END || ws_size < WS_END) { fprintf(stderr, "kernel_launch: unexpected sizes: n_in %d out %d ws %zu\n", n_in, out_size, ws_size); grid = -1; return; }
        int dev = 0, cus = 0, per_cu = 0;
        if (hipGetDevice(&dev) != hipSuccess || hipDeviceGetAttribute(&cus, hipDeviceAttributeMultiprocessorCount, dev) != hipSuccess) { grid = -1; return; }
        if (hipFuncSetAttribute((const void*)mega_fwd, hipFuncAttributeMaxDynamicSharedMemorySize, LDS_BYTES) != hipSuccess) { fprintf(stderr, "kernel_launch: hipFuncSetAttribute failed\n"); grid = -1; return; }
        if (hipOccupancyMaxActiveBlocksPerMultiprocessor(&per_cu, (const void*)mega_fwd, NWAVES * 64, LDS_BYTES) != hipSuccess || per_cu < 1) { fprintf(stderr, "kernel_launch: occupancy query says %d\n", per_cu); (void)hipGetLastError(); }
        if (cus != 256) { fprintf(stderr, "kernel_launch: built for a 256-CU device (one workgroup per CU, 8 groups of 32); found %d CUs\n", cus); grid = -1; return; }
        grid = cus;
    }
    if (grid < 0) return;
    (void)hipMemsetAsync((char*)d_ws + WS_CTL, 0, CTL_ZERO_BYTES, stream);
    Args a{};
    for (int i = 0; i < 22; ++i) a.in[i] = (const float*)d_in[i];
    a.out = (float*)d_out; a.ws = (unsigned char*)d_ws;
    hipLaunchKernelGGL(mega_fwd, dim3(grid), dim3(NWAVES * 64), LDS_BYTES, stream, a);
}
```

```cpp
#include <hip/hip_runtime.h>
#include <hip/hip_bf16.h>
#include <cstdio>
#include <cstdint>
#include <cmath>
namespace cfg {
constexpr int DM = 1024, NB = 8, SEQ = 2048, DB = 16, DS = 32, PAST = 1024, PW = 512, SBW = 512, HD = 64, NH = 8, DFF = 4096, PLE = 256, INW = 4096;
constexpr int MP = NB * SEQ, MS = DB * DS, MT = MP + MS;
constexpr float EPS = 1e-6f;
constexpr float QSCALE = 0.125f * 1.4426950408889634f;
}
namespace pg8 {
#define PG8_LAS __attribute__((address_space(3)))
typedef unsigned short bf16_t;
typedef short bf16x8 __attribute__((ext_vector_type(8)));
typedef float f32x4 __attribute__((ext_vector_type(4)));
typedef unsigned u32x4 __attribute__((ext_vector_type(4)));
constexpr int BM = 256, BK = 64, HALF = 128, HTB = HALF * BK * 2  , STAGE_BYTES = 8 * HTB, NXCD = 8, WGM = 8;

__host__ __device__ __forceinline__ int lds_byte(int r, int c) { const int st = (r >> 4) * 2 + (c >> 5), rr = r & 15, cc = c & 31, ob = rr * 64 + cc * 2; return st * 1024 + (ob ^ (((ob >> 9) & 1) << 5)); }
__host__ __device__ __forceinline__ void stage_rc(int b, int& R, int& C) { const int st = b / 1024, sb = b % 1024, swz = sb ^ (((sb >> 9) & 1) << 5); R = (st >> 1) * 16 + swz / 64; C = (st & 1) * 32 + (swz % 64) / 2; }
__host__ __device__ __forceinline__ int perm32(int rho) { const int n = rho >> 4, i = rho & 15; return 8 * (i >> 2) + 4 * n + (i & 3); }

struct Unit { int pm, pn, seg; };
struct Gemm { const bf16_t* A; const bf16_t* Bt; int M, N, K; const bf16_t* A1 = nullptr; const bf16_t* Bt1 = nullptr; };

struct StaticOrder {
    int nM, nN, nwg, G, c;
    __host__ __device__ void init(int M, int N, int G_, int c_) { nM = M / BM; nN = N / BM; nwg = nM * nN; G = G_; c = c_; }
    __host__ __device__ bool next(int i, Unit& u) const {
        const long L = (long)i * G + c; if (L >= nwg) return false;
        int wgid = (int)L; { const int q = nwg / NXCD, r = nwg % NXCD, xcd = wgid % NXCD, off = wgid / NXCD; wgid = (xcd < r ? xcd * (q + 1) : r * (q + 1) + (xcd - r) * q) + off; }
        const int nig = WGM * nN, gid = wgid / nig, fm = gid * WGM, gsz = (nM - fm) < WGM ? (nM - fm) : WGM;
        u.pm = fm + ((wgid % nig) % gsz); u.pn = (wgid % nig) / gsz; u.seg = 0; return true;
    }
    __device__ __forceinline__ void a_ready(const Unit&) const {}
    __device__ __forceinline__ void done(const Unit&) const {}
};
struct RotOrder : StaticOrder {
    int rot, cnt;
    __host__ __device__ void init(int M, int N, int G_, int c_, int rot_) { StaticOrder::init(M, N, G_, c_); cnt = (nwg % G_ == 0) ? nwg / G_ : 0; rot = rot_; }
    __host__ __device__ bool next(int i, Unit& u) const { if (cnt == 0) return StaticOrder::next(i, u); if (i >= cnt) return false; return StaticOrder::next((i + rot) % cnt, u); }
};
struct PairOrder : StaticOrder {
    __host__ __device__ bool next(int i, Unit& u) const { if (!StaticOrder::next(i >> 1, u)) return false; u.seg = i & 1; return true; }
};
typedef float f32x2v_t __attribute__((ext_vector_type(2))); typedef __bf16 bf16x2v_t __attribute__((ext_vector_type(2)));
__device__ __forceinline__ unsigned cvt_pk_bf16(float lo, float hi) { f32x2v_t v = {lo, hi}; bf16x2v_t b = __builtin_convertvector(v, bf16x2v_t); return __builtin_bit_cast(unsigned, b); }
typedef float f32x2 __attribute__((ext_vector_type(2)));
__device__ __forceinline__ float bf_lo(unsigned w) { return __uint_as_float(w << 16); }
__device__ __forceinline__ float bf_hi(unsigned w) { return __uint_as_float(w & 0xffff0000u); }
__device__ __forceinline__ u32x4 pack8(f32x4 a, f32x4 b) { u32x4 w; w.x = cvt_pk_bf16(a[0], a[1]); w.y = cvt_pk_bf16(a[2], a[3]); w.z = cvt_pk_bf16(b[0], b[1]); w.w = cvt_pk_bf16(b[2], b[3]); return w; }
__device__ __forceinline__ void unpack8(u32x4 w, f32x4& a, f32x4& b) { a = (f32x4){bf_lo(w.x), bf_hi(w.x), bf_lo(w.y), bf_hi(w.y)}; b = (f32x4){bf_lo(w.z), bf_hi(w.z), bf_lo(w.w), bf_hi(w.w)}; }
__device__ __forceinline__ float sigm(float x) { return __builtin_amdgcn_rcpf(1.f + __builtin_amdgcn_exp2f(-1.4426950408889634f * x)); }
__device__ __forceinline__ f32x4 sigm4(f32x4 x) { return (f32x4){sigm(x[0]), sigm(x[1]), sigm(x[2]), sigm(x[3])}; }
__device__ __forceinline__ float dot4(f32x4 a) { return (a[0] * a[0] + a[1] * a[1]) + (a[2] * a[2] + a[3] * a[3]); }
#ifndef DBG_LDAUX
#define DBG_LDAUX 16
#endif
__device__ __forceinline__ u32x4 ld16_sc1(const void* base, size_t byte_off) {
    const __amdgpu_buffer_rsrc_t rs = __builtin_amdgcn_make_buffer_rsrc((void*)base, (short)0, 0x7fffffff, 0x00020000);
    return __builtin_bit_cast(u32x4, __builtin_amdgcn_raw_buffer_load_b128(rs, (unsigned)byte_off, 0, DBG_LDAUX));
}
__device__ __forceinline__ unsigned pk_u8x4(f32x4 g) { unsigned w = 0u; w = __builtin_amdgcn_cvt_pk_u8_f32(g[0] * 255.0f, 0, w); w = __builtin_amdgcn_cvt_pk_u8_f32(g[1] * 255.0f, 1, w); w = __builtin_amdgcn_cvt_pk_u8_f32(g[2] * 255.0f, 2, w); w = __builtin_amdgcn_cvt_pk_u8_f32(g[3] * 255.0f, 3, w); return w; }
__device__ __forceinline__ f32x4 up_u8x4(unsigned w) { return (f32x4){(float)(w & 0xffu), (float)((w >> 8) & 0xffu), (float)((w >> 16) & 0xffu), (float)(w >> 24)} * (1.0f / 255.0f); }
typedef unsigned u32x2 __attribute__((ext_vector_type(2)));
template <int AUX> __device__ __forceinline__ void st16_aux(void* base, size_t byte_off, u32x4 v) {
    if constexpr (AUX == 0) { *(u32x4*)((char*)base + byte_off) = v; }
    else { const __amdgpu_buffer_rsrc_t rs = __builtin_amdgcn_make_buffer_rsrc(base, (short)0, 0x7fffffff, 0x00020000); __builtin_amdgcn_raw_buffer_store_b128(v, rs, (unsigned)byte_off, 0, AUX); }
}
#ifndef DBG_AUXHS
#define DBG_AUXHS 0
#endif
__device__ __forceinline__ float row_rstd(const float* SSQ, int r, int fq) {
    const f32x4 p = *(const f32x4*)(SSQ + (size_t)r * 16 + 4 * fq); float s = (p[0] + p[1]) + (p[2] + p[3]);
    s += __shfl_xor(s, 16); s += __shfl_xor(s, 32);
    return __builtin_amdgcn_rsqf(s * (1.0f / 1024.0f) + cfg::EPS);
}
#define PG8_ROWS(...) _Pragma("unroll") for (int ai = 0; ai < 2; ++ai) _Pragma("unroll") for (int m = 0; m < 4; ++m) { const int r = u.pm * BM + ai * HALF + wr * 64 + m * 16 + fr; __VA_ARGS__; if (m == 3) asm volatile("" ::: "memory"); }
#define PG8_ROWS_NF(...) _Pragma("unroll") for (int ai = 0; ai < 2; ++ai) _Pragma("unroll") for (int m = 0; m < 4; ++m) { const int r = u.pm * BM + ai * HALF + wr * 64 + m * 16 + fr; __VA_ARGS__; }
#ifndef EPI_NOFENCE
#define EPI_NOFENCE 1
#endif
#if EPI_NOFENCE
#define EPI_ROWS_LD PG8_ROWS_NF
#else
#define EPI_ROWS_LD PG8_ROWS
#endif
#define PG8_COLS(...) _Pragma("unroll") for (int bj = 0; bj < 2; ++bj) { const int c = ct + bj * HALF + wc * 32 + 8 * fq; const f32x4 v0 = acc[ai][bj][m][0], v1 = acc[ai][bj][m][1]; __VA_ARGS__; }

struct EpiIn {
    static constexpr bool PERM = true, AFTER_DRAIN = false;
    bf16_t *U, *Q, *K, *V, *G; const float* b_gate; float *k_p, *v_p, *k_s, *v_s, *pool_p, *pool_s;
    __device__ __forceinline__ void operator()(const f32x4 (&acc)[2][2][4][2], const Unit& u, int wr, int wc, int fr, int fq) const {
        const int pn = u.pn;
        if (pn >= 8) {
            const int ct = (pn - 8) * BM; f32x4 bv[2][2];
#pragma unroll
            for (int bj = 0; bj < 2; ++bj) { const int c = ct + bj * HALF + wc * 32 + 8 * fq; bv[bj][0] = *(const f32x4*)(b_gate + c); bv[bj][1] = *(const f32x4*)(b_gate + c + 4); }
            PG8_ROWS(PG8_COLS(*(u32x2*)((unsigned char*)G + (size_t)r * 2048 + c) = (u32x2){pk_u8x4(sigm4(v0 + bv[bj][0])), pk_u8x4(sigm4(v1 + bv[bj][1]))}))
        } else if (pn >= 4) {
            const bool isv = pn >= 6; const int ct = (pn - (isv ? 6 : 4)) * BM; bf16_t* B = isv ? V : K; float* op = isv ? v_p : k_p; float* os = isv ? v_s : k_s;
            PG8_ROWS(float* orow = r < cfg::MP ? op + (size_t)r * 512 : os + (size_t)(r - cfg::MP) * 512;
                     PG8_COLS(*(u32x4*)(B + (size_t)r * 512 + c) = pack8(v0, v1); __builtin_nontemporal_store(v0, (f32x4*)(orow + c)); __builtin_nontemporal_store(v1, (f32x4*)(orow + c + 4))))
        } else if (pn >= 2) {
            const int ct = (pn - 2) * BM;
            PG8_ROWS(PG8_COLS(*(u32x4*)(Q + (size_t)r * 512 + c) = pack8(v0 * cfg::QSCALE, v1 * cfg::QSCALE)))
        } else {
            const int ct = pn * BM;
            PG8_ROWS(float* prow = nullptr;
                     if (r < cfg::MP) { const int t = r & (cfg::SEQ - 1); if (t >= cfg::SEQ - 15) prow = pool_p + ((size_t)(r >> 11) * 15 + (t - (cfg::SEQ - 15))) * 512; }
                     else { const int i = (r - cfg::MP) & 31; if (i >= 17) prow = pool_s + ((size_t)((r - cfg::MP) >> 5) * 15 + (i - 17)) * 512; }
                     PG8_COLS(*(u32x4*)(U + (size_t)r * 512 + c) = pack8(v0, v1); if (prow) { *(f32x4*)(prow + c) = v0; *(f32x4*)(prow + c + 4) = v1; }))
        }
    }
};
struct EpiMerge;
struct EpiMerge0 {
    static constexpr bool PERM = true, AFTER_DRAIN = false;
    const bf16_t* G; bf16_t* MG;
    __device__ __forceinline__ void operator()(const f32x4 (&acc)[2][2][4][2], const Unit& u, int wr, int wc, int fr, int fq) const {
        const int ct = u.pn * BM;
        PG8_ROWS(PG8_COLS(const u32x2 gw = *(const u32x2*)((const unsigned char*)G + (size_t)r * 2048 + c); const f32x4 g0 = up_u8x4(gw.x); const f32x4 g1 = up_u8x4(gw.y); *(u32x4*)(MG + (size_t)r * 1024 + c) = pack8(v0 * g0, v1 * g1)))
    }
};
struct EpiMerge1 {
    static constexpr bool PERM = true, AFTER_DRAIN = false;
    const bf16_t* G; bf16_t* MG;
    __device__ __forceinline__ void operator()(const f32x4 (&acc)[2][2][4][2], const Unit& u, int wr, int wc, int fr, int fq) const {
        const int ct = u.pn * BM;
        PG8_ROWS(PG8_COLS(const u32x2 gw = *(const u32x2*)((const unsigned char*)G + (size_t)r * 2048 + 1024 + c); const u32x4 mw = *(const u32x4*)(MG + (size_t)r * 1024 + c);
                          const f32x4 g0 = up_u8x4(gw.x); const f32x4 g1 = up_u8x4(gw.y); f32x4 m0; f32x4 m1; unpack8(mw, m0, m1); *(u32x4*)(MG + (size_t)r * 1024 + c) = pack8(m0 + v0 * g0, m1 + v1 * g1)))
    }
};
#ifndef MERGE_CARRY
#define MERGE_CARRY 1
#endif
__device__ __forceinline__ f32x4 up_u8x4_floor1(unsigned w) { return (f32x4){(float)__builtin_elementwise_max(w & 0xffu, 1u), (float)__builtin_elementwise_max((w >> 8) & 0xffu, 1u), (float)__builtin_elementwise_max((w >> 16) & 0xffu, 1u), (float)__builtin_elementwise_max(w >> 24, 1u)} * (1.0f / 255.0f); }
__device__ __forceinline__ f32x4 rcp4(f32x4 v) { return (f32x4){__builtin_amdgcn_rcpf(v[0]), __builtin_amdgcn_rcpf(v[1]), __builtin_amdgcn_rcpf(v[2]), __builtin_amdgcn_rcpf(v[3])}; }
struct EpiMerge {
    static constexpr bool PERM = true, AFTER_DRAIN = false, CARRY = MERGE_CARRY != 0;
    const bf16_t* G; bf16_t* MG;
    __device__ __forceinline__ void operator()(f32x4 (&acc)[2][2][4][2], const Unit& u, int wr, int wc, int fr, int fq) const {
#if MERGE_CARRY
        const int ct = u.pn * BM;
        if (u.seg == 0) {
            EPI_ROWS_LD(PG8_COLS(const u32x2 ga = *(const u32x2*)((const unsigned char*)G + (size_t)r * 2048 + c); const u32x2 gb = *(const u32x2*)((const unsigned char*)G + (size_t)r * 2048 + 1024 + c);
                              acc[ai][bj][m][0] = v0 * (up_u8x4(ga.x) * rcp4(up_u8x4_floor1(gb.x))); acc[ai][bj][m][1] = v1 * (up_u8x4(ga.y) * rcp4(up_u8x4_floor1(gb.y)))))
        } else {
            EPI_ROWS_LD(PG8_COLS(const u32x2 gb = *(const u32x2*)((const unsigned char*)G + (size_t)r * 2048 + 1024 + c);
                              *(u32x4*)(MG + (size_t)r * 1024 + c) = pack8(v0 * up_u8x4_floor1(gb.x), v1 * up_u8x4_floor1(gb.y))))
        }
#else
        if (u.seg == 0) { const EpiMerge0 E0{G, MG}; E0(acc, u, wr, wc, fr, fq); } else { const EpiMerge1 E1{G, MG}; E1(acc, u, wr, wc, fr, fq); }
#endif
    }
};
#ifndef FOLD_G
#define FOLD_G 1
#endif
#ifndef RES_FROM_XN
#define RES_FROM_XN 1
#endif
#if FOLD_G
#define EPI_XG_STORE (void)0
#else
#define EPI_XG_STORE *(u32x4*)(XG + (size_t)r * 1024 + c) = pack8(a * gv[bj][0], b * gv[bj][1])
#endif
template <bool F32RES>
struct EpiResid {
    static constexpr bool PERM = true, AFTER_DRAIN = false;
    const float* res_p; bf16_t* X; bf16_t* XG; const float* gvec; float* SSQ; const bf16_t* XN0 = nullptr; const float* RS0 = nullptr;
    __device__ __forceinline__ void operator()(const f32x4 (&acc)[2][2][4][2], const Unit& u, int wr, int wc, int fr, int fq) const {
        const int ct = u.pn * BM;
#if !FOLD_G
        f32x4 gv[2][2];
#pragma unroll
        for (int bj = 0; bj < 2; ++bj) { const int c = ct + bj * HALF + wc * 32 + 8 * fq; gv[bj][0] = *(const f32x4*)(gvec + c); gv[bj][1] = *(const f32x4*)(gvec + c + 4); }
#endif
        EPI_ROWS_LD(float s = 0.f; float ir = 0.f; if (F32RES && RES_FROM_XN) ir = RS0[r];
                 PG8_COLS(f32x4 a; f32x4 b;
                          if (F32RES && RES_FROM_XN) { const u32x4 xw = __builtin_nontemporal_load((const u32x4*)(XN0 + (size_t)r * 1024 + c)); unpack8(xw, a, b); a *= ir; b *= ir; }
                          else if (F32RES) { a = __builtin_nontemporal_load((const f32x4*)(res_p + (size_t)r * 1024 + c)); b = __builtin_nontemporal_load((const f32x4*)(res_p + (size_t)r * 1024 + c + 4)); }
                          else { const u32x4 xw = *(const u32x4*)(X + (size_t)r * 1024 + c); unpack8(xw, a, b); }
                          a += v0; b += v1; *(u32x4*)(X + (size_t)r * 1024 + c) = pack8(a, b); s += dot4(a) + dot4(b);
                          EPI_XG_STORE)
                 s += __shfl_xor(s, 16); s += __shfl_xor(s, 32); if (fq == 0) SSQ[(size_t)r * 16 + u.pn * 4 + wc] = s)
    }
};
struct EpiUp {
    static constexpr bool PERM = true, AFTER_DRAIN = false;
    const float* SSQ; bf16_t* H;
    __device__ __forceinline__ void operator()(const f32x4 (&acc)[2][2][4][2], const Unit& u, int wr, int wc, int fr, int fq) const {
        const int ct = u.pn * BM; float rsv[2][4];
#pragma unroll
        for (int ai = 0; ai < 2; ++ai)
#pragma unroll
            for (int m = 0; m < 4; ++m) rsv[ai][m] = row_rstd(SSQ, u.pm * BM + ai * HALF + wr * 64 + m * 16 + fr, fq);
        PG8_ROWS(const float rs = rsv[ai][m];
                 PG8_COLS(f32x4 a = v0 * rs; f32x4 b = v1 * rs; a = __builtin_elementwise_max(a, (f32x4){0.f, 0.f, 0.f, 0.f}); b = __builtin_elementwise_max(b, (f32x4){0.f, 0.f, 0.f, 0.f});
                          st16_aux<DBG_AUXHS>(H, ((size_t)r * 4096 + c) * 2, pack8(a * a, b * b))))
    }
};
struct EpiNull {
    static constexpr bool PERM = true, AFTER_DRAIN = false;
    float* sink;
    __device__ __forceinline__ void operator()(const f32x4 (&acc)[2][2][4][2], const Unit& u, int wr, int wc, int fr, int fq) const {
        float s = 0.f;
#pragma unroll
        for (int ai = 0; ai < 2; ++ai)
#pragma unroll
            for (int bj = 0; bj < 2; ++bj)
#pragma unroll
                for (int m = 0; m < 4; ++m)
#pragma unroll
                    for (int n = 0; n < 2; ++n) s += acc[ai][bj][m][n][0] + acc[ai][bj][m][n][3];
        if (s == 1.2345e33f) sink[0] = s;
    }
};
struct EpiPP {
    static constexpr bool PERM = true, AFTER_DRAIN = false;
    bf16_t* PP;
    __device__ __forceinline__ void operator()(const f32x4 (&acc)[2][2][4][2], const Unit& u, int wr, int wc, int fr, int fq) const {
        const int ct = u.pn * BM;
        PG8_ROWS(PG8_COLS(*(u32x4*)(PP + (size_t)r * 1024 + c) = pack8(v0, v1)))
    }
};
struct EpiGate8 {
    static constexpr bool PERM = true, AFTER_DRAIN = false;
    const float* SSQ; unsigned char* S8;
    __device__ __forceinline__ void operator()(const f32x4 (&acc)[2][2][4][2], const Unit& u, int wr, int wc, int fr, int fq) const {
        const int ct = u.pn * BM; float rsv[2][4];
#pragma unroll
        for (int ai = 0; ai < 2; ++ai)
#pragma unroll
            for (int m = 0; m < 4; ++m) rsv[ai][m] = row_rstd(SSQ, u.pm * BM + ai * HALF + wr * 64 + m * 16 + fr, fq);
        PG8_ROWS(const float rs = rsv[ai][m];
                 PG8_COLS(*(u32x2*)(S8 + (size_t)r * 1024 + c) = (u32x2){pk_u8x4(sigm4(v0 * rs)), pk_u8x4(sigm4(v1 * rs))}))
    }
};
struct EpiPleFinal2 {
    static constexpr bool PERM = true, AFTER_DRAIN = false;
    const unsigned char* S8; const bf16_t* X; float* Y; float* SSQo; const float* gfin; unsigned* cnt;
    __device__ __forceinline__ void operator()(f32x4 (&acc)[2][2][4][2], const Unit& u, int wr, int wc, int fr, int fq) const {
        const int ct = u.pn * BM;
        EPI_ROWS_LD(float s = 0.f;
                 PG8_COLS(const u32x2 sw = *(const u32x2*)(S8 + (size_t)r * 1024 + c);
                          const u32x4 xw = *(const u32x4*)(X + (size_t)r * 1024 + c); f32x4 a; f32x4 b; unpack8(xw, a, b); a += up_u8x4(sw.x) * v0; b += up_u8x4(sw.y) * v1;
                          acc[ai][bj][m][0] = a; acc[ai][bj][m][1] = b; s += dot4(a) + dot4(b))
                 s += __shfl_xor(s, 16); s += __shfl_xor(s, 32);
                 if (fq == 0) __hip_atomic_store(SSQo + (size_t)r * 16 + u.pn * 4 + wc, s, __ATOMIC_RELAXED, __HIP_MEMORY_SCOPE_AGENT))
        asm volatile("s_waitcnt vmcnt(0)" ::: "memory");
        unsigned* cw = cnt + 64 * (2 * u.pm + wr);
        if (fr == 0 && fq == 0) __hip_atomic_fetch_add(cw, 1u, __ATOMIC_RELAXED, __HIP_MEMORY_SCOPE_AGENT);
        { unsigned spins = 0;
          while ((unsigned)__builtin_amdgcn_readfirstlane(__hip_atomic_load(cw, __ATOMIC_RELAXED, __HIP_MEMORY_SCOPE_AGENT)) < 16u) { __builtin_amdgcn_s_sleep(2); if (++spins > (1u << 16)) break; } }
        f32x4 gv[2][2];
#pragma unroll
        for (int bj = 0; bj < 2; ++bj) { const int c = ct + bj * HALF + wc * 32 + 8 * fq; gv[bj][0] = *(const f32x4*)(gfin + c); gv[bj][1] = *(const f32x4*)(gfin + c + 4); }
        PG8_ROWS(const f32x4 pq = __builtin_bit_cast(f32x4, ld16_sc1(SSQo, ((size_t)r * 16 + 4 * fq) * 4)); float t = (pq[0] + pq[1]) + (pq[2] + pq[3]); t += __shfl_xor(t, 16); t += __shfl_xor(t, 32);
                 const float r3 = __builtin_amdgcn_rsqf(t * (1.0f / 1024.0f) + cfg::EPS);
                 PG8_COLS(__builtin_nontemporal_store(v0 * r3 * gv[bj][0], (f32x4*)(Y + (size_t)r * 1024 + c)); __builtin_nontemporal_store(v1 * r3 * gv[bj][1], (f32x4*)(Y + (size_t)r * 1024 + c + 4))))
    }
};
struct EpiPleFinal {
    static constexpr bool PERM = true, AFTER_DRAIN = false;
    const float* SSQ; const bf16_t* PP; const bf16_t* X; float* Y; float* SSQo; const float* gfin; unsigned* cnt;
    __device__ __forceinline__ void operator()(f32x4 (&acc)[2][2][4][2], const Unit& u, int wr, int wc, int fr, int fq) const {
        const int ct = u.pn * BM; float rsv[2][4];
#pragma unroll
        for (int ai = 0; ai < 2; ++ai)
#pragma unroll
            for (int m = 0; m < 4; ++m) rsv[ai][m] = row_rstd(SSQ, u.pm * BM + ai * HALF + wr * 64 + m * 16 + fr, fq);
        PG8_ROWS(const float rs = rsv[ai][m]; float s = 0.f;
                 PG8_COLS(const u32x4 pw = *(const u32x4*)(PP + (size_t)r * 1024 + c); f32x4 p0; f32x4 p1; unpack8(pw, p0, p1);
                          const u32x4 xw = *(const u32x4*)(X + (size_t)r * 1024 + c); f32x4 a; f32x4 b; unpack8(xw, a, b); a += sigm4(v0 * rs) * p0; b += sigm4(v1 * rs) * p1;
                          acc[ai][bj][m][0] = a; acc[ai][bj][m][1] = b; s += dot4(a) + dot4(b))
                 s += __shfl_xor(s, 16); s += __shfl_xor(s, 32);
                 if (fq == 0) __hip_atomic_store(SSQo + (size_t)r * 16 + u.pn * 4 + wc, s, __ATOMIC_RELAXED, __HIP_MEMORY_SCOPE_AGENT))
        asm volatile("s_waitcnt vmcnt(0)" ::: "memory");
        unsigned* cw = cnt + 64 * (2 * u.pm + wr);
        if (fr == 0 && fq == 0) __hip_atomic_fetch_add(cw, 1u, __ATOMIC_RELAXED, __HIP_MEMORY_SCOPE_AGENT);
        { unsigned spins = 0;
          while ((unsigned)__builtin_amdgcn_readfirstlane(__hip_atomic_load(cw, __ATOMIC_RELAXED, __HIP_MEMORY_SCOPE_AGENT)) < 16u) { __builtin_amdgcn_s_sleep(2); if (++spins > (1u << 16)) break; } }
        f32x4 gv[2][2];
#pragma unroll
        for (int bj = 0; bj < 2; ++bj) { const int c = ct + bj * HALF + wc * 32 + 8 * fq; gv[bj][0] = *(const f32x4*)(gfin + c); gv[bj][1] = *(const f32x4*)(gfin + c + 4); }
        PG8_ROWS(const f32x4 pq = __builtin_bit_cast(f32x4, ld16_sc1(SSQo, ((size_t)r * 16 + 4 * fq) * 4)); float t = (pq[0] + pq[1]) + (pq[2] + pq[3]); t += __shfl_xor(t, 16); t += __shfl_xor(t, 32);
                 const float r3 = __builtin_amdgcn_rsqf(t * (1.0f / 1024.0f) + cfg::EPS);
                 PG8_COLS(__builtin_nontemporal_store(v0 * r3 * gv[bj][0], (f32x4*)(Y + (size_t)r * 1024 + c)); __builtin_nontemporal_store(v1 * r3 * gv[bj][1], (f32x4*)(Y + (size_t)r * 1024 + c + 4))))
    }
};
template <class E, class = void> struct epi_carry { static constexpr bool value = false; };
template <class E> struct epi_carry<E, decltype((void)E::CARRY)> { static constexpr bool value = E::CARRY; };
struct NoHook { __device__ __forceinline__ void operator()(int) const {} };
template <class Epi, class Sched, bool ALIGN_EPI = false, bool SP2 = false, class Hook = NoHook, int AUXA = 0>
__device__ __forceinline__ void gemm_phase(PG8_LAS unsigned char* lds, const Gemm g, const Sched& S, const Epi& E, const Hook& H = Hook()) {
    int tid = threadIdx.x; asm volatile("" : "+v"(tid));
    const int wid = __builtin_amdgcn_readfirstlane(tid >> 6), lane = tid & 63, wr = wid >> 2, wc = wid & 3, fr = lane & 15, fq = lane >> 4;
    int K = g.K; asm volatile("" : "+s"(K)); const int nt = K / BK;
    unsigned voffA[2], voffB[2];
#pragma unroll
    for (int i = 0; i < 2; ++i) { int R, C; stage_rc(tid * 16 + i * 8192, R, C); const int Rb = Epi::PERM ? ((R & ~31) + perm32(R & 31)) : R;
        voffA[i] = (unsigned)(R * K + C) * 2u; voffB[i] = (unsigned)(Rb * K + C) * 2u; }
    const size_t kstep = (size_t)(BK * 2);
    const size_t hstep = (size_t)HALF * K * 2;
    const size_t tstep = 2 * hstep;
    const size_t bhs = hstep;
    const unsigned ldsw = (unsigned)wid * 1024u;
    const int aoff = lds_byte(wr * 64 + fr, fq * 8), boff = lds_byte(wc * 32 + fr, fq * 8);
#define PG8_SA(b, h) (((b) * 2 + (h)) * HTB)
#define PG8_SB(b, h) ((4 + (b) * 2 + (h)) * HTB)
#define PG8_STAGE_X(bufoff, gbase, voff, AUX) do { _Pragma("unroll") for (int _i = 0; _i < 2; ++_i) \
        __builtin_amdgcn_global_load_lds((const unsigned*)((const char*)(gbase) + (voff)[_i]), (PG8_LAS unsigned*)(lds + (bufoff) + ldsw + _i * 8192), 16, 0, AUX); } while (0)
#define PG8_LDA(dst, b, h) do { _Pragma("unroll") for (int m = 0; m < 4; ++m) _Pragma("unroll") for (int k = 0; k < 2; ++k) dst[m][k] = *(const PG8_LAS bf16x8*)(lds + PG8_SA(b, h) + aoff + m * 2048 + k * 1024); } while (0)
#define PG8_LDB(dst, b, h) do { _Pragma("unroll") for (int n = 0; n < 2; ++n) _Pragma("unroll") for (int k = 0; k < 2; ++k) dst[n][k] = *(const PG8_LAS bf16x8*)(lds + PG8_SB(b, h) + boff + n * 2048 + k * 1024); } while (0)
#define PG8_MMA(ai, bj, At, Bt) do { __builtin_amdgcn_s_setprio(1); _Pragma("unroll") for (int m = 0; m < 4; ++m) _Pragma("unroll") for (int n = 0; n < 2; ++n) _Pragma("unroll") for (int k = 0; k < 2; ++k) \
        acc[ai][bj][m][n] = __builtin_amdgcn_mfma_f32_16x16x32_bf16(Bt[n][k], At[m][k], acc[ai][bj][m][n], 0, 0, 0); __builtin_amdgcn_s_setprio(0); } while (0)
#ifdef DRAIN_ALL
#define PG8_WAIT_V(n) asm volatile("s_waitcnt vmcnt(0)" ::: "memory")
#else
#define PG8_WAIT_V(n) asm volatile("s_waitcnt vmcnt(" #n ")" ::: "memory")
#endif
#define PG8_WAIT_L(n) asm volatile("s_waitcnt lgkmcnt(" #n ")" ::: "memory")
#define PG8_BAR __builtin_amdgcn_s_barrier()
#define PG8_SCHED __builtin_amdgcn_sched_barrier(0)
    Unit cur, nxt; int ui = 0;
    if (!S.next(0, cur)) return;
    f32x4 acc[2][2][4][2];
#pragma unroll
    for (int a = 0; a < 2; ++a)
#pragma unroll
        for (int b = 0; b < 2; ++b)
#pragma unroll
            for (int m = 0; m < 4; ++m)
#pragma unroll
                for (int n = 0; n < 2; ++n) acc[a][b][m][n] = (f32x4){0.f, 0.f, 0.f, 0.f};
    bf16x8 At[4][2], B0[2][2], B1[2][2];
    const char* cA = (const char*)(cur.seg ? g.A1 : g.A) + (size_t)cur.pm * tstep; const char* cB = (const char*)(cur.seg ? g.Bt1 : g.Bt) + (size_t)cur.pn * tstep;
    S.a_ready(cur);
    if constexpr (SP2) {
        PG8_STAGE_X(PG8_SB(0, 0), cB, voffB, 0); PG8_STAGE_X(PG8_SB(0, 1), cB + bhs, voffB, 0); PG8_STAGE_X(PG8_SA(0, 0), cA, voffA, AUXA); PG8_STAGE_X(PG8_SA(0, 1), cA + hstep, voffA, AUXA);
        if (wr == 1) PG8_BAR;
        PG8_WAIT_V(2); PG8_BAR;
        PG8_STAGE_X(PG8_SB(1, 0), cB + kstep, voffB, 0); PG8_STAGE_X(PG8_SA(1, 0), cA + kstep, voffA, AUXA); PG8_STAGE_X(PG8_SB(1, 1), cB + bhs + kstep, voffB, 0);
        PG8_WAIT_V(6); PG8_BAR;
    } else {
        PG8_STAGE_X(PG8_SB(0, 0), cB, voffB, 0); PG8_STAGE_X(PG8_SA(0, 0), cA, voffA, AUXA); PG8_STAGE_X(PG8_SB(0, 1), cB + bhs, voffB, 0); PG8_STAGE_X(PG8_SA(0, 1), cA + hstep, voffA, AUXA);
        if (wr == 1) PG8_BAR;
        PG8_WAIT_V(4); PG8_BAR;
        PG8_STAGE_X(PG8_SB(1, 0), cB + kstep, voffB, 0); PG8_STAGE_X(PG8_SA(1, 0), cA + kstep, voffA, AUXA); PG8_STAGE_X(PG8_SB(1, 1), cB + bhs + kstep, voffB, 0);
        PG8_WAIT_V(6); PG8_BAR;
    }
    for (;;) {
        const bool has_next = S.next(ui + 1, nxt);
        const char* nA = has_next ? (const char*)(nxt.seg ? g.A1 : g.A) + (size_t)nxt.pm * tstep : cA; const char* nB = has_next ? (const char*)(nxt.seg ? g.Bt1 : g.Bt) + (size_t)nxt.pn * tstep : cB;
        for (int t = 0; t < nt; t += 2) {
            const bool last = (t == nt - 2);
            const char* a1 = cA + (size_t)(t + 1) * kstep;
            const char* a2 = last ? nA : cA + (size_t)(t + 2) * kstep; const char* b2 = last ? nB : cB + (size_t)(t + 2) * kstep;
            const char* a3 = a2 + kstep; const char* b3 = b2 + kstep;
            if (last && has_next) S.a_ready(nxt);
            if constexpr (SP2) {
            PG8_LDB(B0, 0, 0); PG8_LDB(B1, 0, 1); PG8_SCHED; PG8_LDA(At, 0, 0); PG8_STAGE_X(PG8_SA(1, 1), a1 + hstep, voffA, AUXA);
            PG8_WAIT_V(8); PG8_WAIT_L(0); PG8_BAR; PG8_MMA(0, 0, At, B0); PG8_MMA(0, 1, At, B1); PG8_BAR; PG8_SCHED;
            PG8_LDA(At, 0, 1); PG8_STAGE_X(PG8_SB(0, 0), b2, voffB, 0); PG8_STAGE_X(PG8_SB(0, 1), b2 + bhs, voffB, 0); PG8_STAGE_X(PG8_SA(0, 0), a2, voffA, AUXA);
            PG8_WAIT_V(8); PG8_WAIT_L(0); PG8_BAR; PG8_MMA(1, 0, At, B0); PG8_MMA(1, 1, At, B1); PG8_BAR; PG8_SCHED;
            PG8_LDB(B0, 1, 0); PG8_LDB(B1, 1, 1); PG8_SCHED; PG8_LDA(At, 1, 0); PG8_STAGE_X(PG8_SA(0, 1), a2 + hstep, voffA, AUXA);
            PG8_WAIT_V(8); PG8_WAIT_L(0); PG8_BAR; PG8_MMA(0, 0, At, B0); PG8_MMA(0, 1, At, B1); PG8_BAR; PG8_SCHED;
            PG8_LDA(At, 1, 1); PG8_STAGE_X(PG8_SB(1, 0), b3, voffB, 0); PG8_STAGE_X(PG8_SB(1, 1), b3 + bhs, voffB, 0); PG8_STAGE_X(PG8_SA(1, 0), a3, voffA, AUXA);
            PG8_WAIT_V(8); PG8_WAIT_L(0); PG8_BAR; PG8_MMA(1, 0, At, B0); PG8_MMA(1, 1, At, B1); PG8_BAR; PG8_SCHED;
            } else {
            PG8_LDB(B0, 0, 0); PG8_SCHED; PG8_LDA(At, 0, 0); PG8_STAGE_X(PG8_SA(1, 1), a1 + hstep, voffA, AUXA);
            PG8_WAIT_L(8); PG8_BAR; PG8_WAIT_L(0); PG8_MMA(0, 0, At, B0); PG8_BAR; PG8_SCHED;
            PG8_LDB(B1, 0, 1); PG8_STAGE_X(PG8_SB(0, 0), b2, voffB, 0);
            PG8_BAR; PG8_WAIT_L(0); PG8_MMA(0, 1, At, B1); PG8_BAR;
            PG8_LDA(At, 0, 1); PG8_STAGE_X(PG8_SA(0, 0), a2, voffA, AUXA);
            PG8_BAR; PG8_WAIT_L(0); PG8_MMA(1, 0, At, B0); PG8_BAR; PG8_SCHED;
            PG8_STAGE_X(PG8_SB(0, 1), b2 + bhs, voffB, 0);
            PG8_WAIT_V(6); PG8_BAR; PG8_MMA(1, 1, At, B1); PG8_BAR;
            PG8_LDB(B0, 1, 0); PG8_SCHED; PG8_LDA(At, 1, 0); PG8_STAGE_X(PG8_SA(0, 1), a2 + hstep, voffA, AUXA);
            PG8_WAIT_L(8); PG8_BAR; PG8_WAIT_L(0); PG8_MMA(0, 0, At, B0); PG8_BAR; PG8_SCHED;
            PG8_LDB(B1, 1, 1); PG8_STAGE_X(PG8_SB(1, 0), b3, voffB, 0);
            PG8_BAR; PG8_WAIT_L(0); PG8_MMA(0, 1, At, B1); PG8_BAR;
            PG8_LDA(At, 1, 1); PG8_STAGE_X(PG8_SA(1, 0), a3, voffA, AUXA);
            PG8_BAR; PG8_WAIT_L(0); PG8_MMA(1, 0, At, B0); PG8_BAR; PG8_SCHED;
            PG8_STAGE_X(PG8_SB(1, 1), b3 + bhs, voffB, 0);
            PG8_WAIT_V(6); PG8_BAR; PG8_MMA(1, 1, At, B1); PG8_BAR;
            }
        }
        if constexpr (ALIGN_EPI) { if (wr == 0) PG8_BAR; }
        if constexpr (!Epi::AFTER_DRAIN) { int t_ = threadIdx.x; asm volatile("" : "+v"(t_)); const int l_ = t_ & 63; E(acc, cur, wr, wc, l_ & 15, l_ >> 4); S.done(cur); H(ui); }
        if (!has_next) break;
        if (!(epi_carry<Epi>::value && cur.seg == 0)) {
#pragma unroll
        for (int a = 0; a < 2; ++a)
#pragma unroll
            for (int b = 0; b < 2; ++b)
#pragma unroll
                for (int m = 0; m < 4; ++m)
#pragma unroll
                    for (int n = 0; n < 2; ++n) acc[a][b][m][n] = (f32x4){0.f, 0.f, 0.f, 0.f};
        }
        cur = nxt; cA = nA; cB = nB; ++ui;
        if constexpr (ALIGN_EPI) { if (wr == 1) PG8_BAR; }
    }
    PG8_WAIT_V(0);
    if constexpr (!ALIGN_EPI) { if (wr == 0) PG8_BAR; }
    PG8_BAR;
    if constexpr (Epi::AFTER_DRAIN) { E.fused(acc, cur, wr, wc, fr, fq, lds, wid, lane); S.done(cur); }
#undef PG8_SA
#undef PG8_SB
#undef PG8_STAGE_X
#undef PG8_LDA
#undef PG8_LDB
#undef PG8_MMA
#undef PG8_WAIT_V
#undef PG8_WAIT_L
#undef PG8_BAR
#undef PG8_SCHED
}
}
namespace sba {
typedef short bf16x8 __attribute__((ext_vector_type(8)));
typedef short s16x4 __attribute__((ext_vector_type(4)));
typedef float f32x16 __attribute__((ext_vector_type(16)));
typedef float f32x4 __attribute__((ext_vector_type(4)));
typedef unsigned u32x4 __attribute__((ext_vector_type(4)));
typedef unsigned short bf16_t;
#define SB_LAS __attribute__((address_space(3)))
constexpr int PITCH = 512, HSLOT = 16384  , SLOTB = 4 * HSLOT, LDS_BYTES = 2 * SLOTB;
constexpr float THR2 = 48.0f, NEGBIG = -1.0e30f;
typedef float f32x2_t __attribute__((ext_vector_type(2))); typedef __bf16 bf16x2_t __attribute__((ext_vector_type(2)));
__device__ __forceinline__ unsigned cvtpk(float lo, float hi) { f32x2_t v = {lo, hi}; bf16x2_t b = __builtin_convertvector(v, bf16x2_t); return __builtin_bit_cast(unsigned, b); }
__device__ __forceinline__ bf16x8 pack8f(float a0, float a1, float a2, float a3, float a4, float a5, float a6, float a7) {
    u32x4 w; w.x = cvtpk(a0, a1); w.y = cvtpk(a2, a3); w.z = cvtpk(a4, a5); w.w = cvtpk(a6, a7); return __builtin_bit_cast(bf16x8, w); }
typedef short v4i16_t __attribute__((ext_vector_type(4)));
__device__ __forceinline__ s16x4 vtr(const SB_LAS char* p) { return __builtin_bit_cast(s16x4, __builtin_amdgcn_ds_read_tr16_b64_v4i16((SB_LAS v4i16_t*)p)); }
__device__ __forceinline__ int crow(int r, int hi) { return (r & 3) + 8 * (r >> 2) + 4 * hi; }

template <int SUB>
__device__ __forceinline__ void sub_front(const SB_LAS char* Kslot, bool mask, int kq, const bf16x8 (&qr)[4], f32x16& w, bf16x8 (&spb)[2], int r32, int hi) {
    const SB_LAS char* kb = Kslot + hi * 1024 + r32 * 16 + SUB * 512;
    f32x16 p = {};
#pragma unroll
    for (int d0 = 0; d0 < 4; ++d0) { const bf16x8 kf = *(const SB_LAS bf16x8*)(kb + d0 * 2048); p = __builtin_amdgcn_mfma_f32_32x32x16_bf16(kf, qr[d0], p, 0, 0, 0); }
    float sp[16];
#pragma unroll
    for (int r = 0; r < 16; ++r) {
        float x = p[r];
        if (mask && (kq + 32 * SUB + (r & 3) + 8 * (r >> 2) >= 0)) x = NEGBIG;
        const float t = __builtin_amdgcn_exp2f(-__builtin_fabsf(x));
        const float l = __builtin_amdgcn_logf(1.0f + t);
        sp[r] = __builtin_fmaxf(x, 0.f) + l; w[r] = __builtin_fminf(x, 0.f) - l;
    }
    spb[0] = pack8f(sp[0], sp[1], sp[2], sp[3], sp[4], sp[5], sp[6], sp[7]);
    spb[1] = pack8f(sp[8], sp[9], sp[10], sp[11], sp[12], sp[13], sp[14], sp[15]);
}
template <int SUB>
__device__ __forceinline__ void sub_back(const SB_LAS char* vp, const f32x16& w, const f32x16& sx, f32x16 (&o)[2]) {
    float pr[16];
#pragma unroll
    for (int r = 0; r < 16; ++r) pr[r] = __builtin_amdgcn_exp2f(w[r] - sx[r]);
    bf16x8 pa[2];
    pa[0] = pack8f(pr[0], pr[1], pr[2], pr[3], pr[4], pr[5], pr[6], pr[7]);
    pa[1] = pack8f(pr[8], pr[9], pr[10], pr[11], pr[12], pr[13], pr[14], pr[15]);
#pragma unroll
    for (int d0 = 0; d0 < 2; ++d0)
#pragma unroll
        for (int s = 0; s < 2; ++s) { const int ks = 2 * SUB + s;
            const s16x4 lo = vtr(vp + d0 * 4096 + ks * 1024), hi4 = vtr(vp + d0 * 4096 + ks * 1024 + 512);
            const bf16x8 vf = (bf16x8){lo[0], lo[1], lo[2], lo[3], hi4[0], hi4[1], hi4[2], hi4[3]};
            o[d0] = __builtin_amdgcn_mfma_f32_32x32x16_bf16(pa[s], vf, o[d0], 0, 0, 0); }
}
__device__ __forceinline__ void sb_tile(const SB_LAS char* slot, bool mask, bool skip1, int kq, const bf16x8 (&qr)[4], f32x16& Rb, f32x16 (&o)[2], const bf16x8 (&Um)[2], const bf16x8 Jm, int r32, int hi, int lane) {
    const SB_LAS char* vp = slot + 8192 + ((lane >> 4) & 1) * 32 + (lane & 3) * 8 + (4 * hi + ((lane & 15) >> 2)) * 64;
    f32x16 w1, w0; bf16x8 sb1[2], sb0[2];
    f32x16 t1 = Rb;
    if (!skip1) {
    sub_front<1>(slot, mask, kq, qr, w1, sb1, r32, hi);
    f32x16 a1 = __builtin_amdgcn_mfma_f32_32x32x16_bf16(Um[0], sb1[0], Rb, 0, 0, 0); a1 = __builtin_amdgcn_mfma_f32_32x32x16_bf16(Um[1], sb1[1], a1, 0, 0, 0);
    t1 = __builtin_amdgcn_mfma_f32_32x32x16_bf16(Jm, sb1[0], Rb, 0, 0, 0); t1 = __builtin_amdgcn_mfma_f32_32x32x16_bf16(Jm, sb1[1], t1, 0, 0, 0);
    sub_back<1>(vp, w1, a1, o);
    }
    sub_front<0>(slot, mask, kq, qr, w0, sb0, r32, hi);
    f32x16 a0 = __builtin_amdgcn_mfma_f32_32x32x16_bf16(Um[0], sb0[0], t1, 0, 0, 0); a0 = __builtin_amdgcn_mfma_f32_32x32x16_bf16(Um[1], sb0[1], a0, 0, 0, 0);
    f32x16 rn = __builtin_amdgcn_mfma_f32_32x32x16_bf16(Jm, sb0[0], t1, 0, 0, 0); rn = __builtin_amdgcn_mfma_f32_32x32x16_bf16(Jm, sb0[1], rn, 0, 0, 0);
    sub_back<0>(vp, w0, a0, o);
    Rb = rn;
}
struct Tensors { const bf16_t* Q; const bf16_t* K; const bf16_t* V; bf16_t* O; const float* ck; const float* cv; };

template <bool SAMPLE>
__device__ __forceinline__ void sb_unit(int b, int hg, int q64, const Tensors& T, SB_LAS char* lds, volatile SB_LAS unsigned* flags) {
    int tid = threadIdx.x; asm volatile("" : "+v"(tid)); const int lane = tid & 63, r32 = lane & 31, hi = lane >> 5; const int wid = __builtin_amdgcn_readfirstlane(tid >> 6);
    const size_t rowbase = SAMPLE ? (size_t)cfg::MP + (size_t)b * 32 : (size_t)b * cfg::SEQ; const int q0 = SAMPLE ? 0 : q64 * 64;
    const int jd = SAMPLE ? 16 : q64;
    const bool worker = SAMPLE ? (wid < 4) : true;
    const int hs = SAMPLE ? (wid & 3) : (wid >> 1), head = 4 * hg + hs;
    const int wq = SAMPLE ? 0 : (wid & 1);
    const int qpos = (SAMPLE ? cfg::PAST : q0 + 32 * wq) + r32;
    bf16x8 Um[2], Jm;
#pragma unroll
    for (int s = 0; s < 2; ++s)
#pragma unroll
        for (int jj = 0; jj < 8; ++jj) Um[s][jj] = (16 * s + 8 * (jj >> 2) + 4 * hi + (jj & 3) > r32) ? (short)0x3F80 : (short)0;
#pragma unroll
    for (int jj = 0; jj < 8; ++jj) Jm[jj] = (short)0x3F80;
    bf16x8 qr[4];
    { const bf16_t* Qw = T.Q + (rowbase + q0 + 32 * wq + r32) * PITCH + head * 64 + hi * 8;
#pragma unroll
      for (int d0 = 0; d0 < 4; ++d0) qr[d0] = *(const bf16x8*)(Qw + d0 * 16); }
    f32x16 Rb = {}, o[2]; o[0] = f32x16{}; o[1] = f32x16{};
    bool done = false;
    u32x4 kreg[4], vreg[4];
    const int vkey = 16 * (wid & 3) + (lane >> 2), vcol = (wid >> 2) * 32 + (lane & 3) * 8;
#define SB_LOAD(j) do { \
        if (!SAMPLE) {   \
            const char* kb_ = (const char*)(T.K + (rowbase + (size_t)(64 * (j))) * PITCH + hg * 256 + wid * 8); const char* vb_ = (const char*)(T.V + (rowbase + (size_t)(64 * (j))) * PITCH + hg * 256); \
            _Pragma("unroll") for (int s4 = 0; s4 < 4; ++s4) { kreg[s4] = *(const u32x4*)(kb_ + (unsigned)(lane * (PITCH * 2) + s4 * 128)); vreg[s4] = *(const u32x4*)(vb_ + (unsigned)(vkey * (PITCH * 2) + vcol * 2 + s4 * 128)); } } \
        else if ((j) == 16) { const int kr_ = lane < 31 ? lane : 31, vr_ = vkey < 31 ? vkey : 31; \
            _Pragma("unroll") for (int s4 = 0; s4 < 4; ++s4) { \
            kreg[s4] = *(const u32x4*)((const char*)(T.K + rowbase * PITCH + hg * 256 + wid * 8) + (unsigned)(kr_ * (PITCH * 2) + s4 * 128)); vreg[s4] = *(const u32x4*)((const char*)(T.V + rowbase * PITCH + hg * 256) + (unsigned)(vr_ * (PITCH * 2) + vcol * 2 + s4 * 128)); } } \
        else { _Pragma("unroll") for (int s4 = 0; s4 < 4; ++s4) { \
            const float* kp_ = (const float*)((const char*)(T.ck + ((size_t)b * cfg::PAST + 64 * (j)) * PITCH + hg * 256 + wid * 8) + (unsigned)(lane * (PITCH * 4) + s4 * 256)); const float* vp_ = (const float*)((const char*)(T.cv + ((size_t)b * cfg::PAST + 64 * (j)) * PITCH + hg * 256) + (unsigned)(vkey * (PITCH * 4) + vcol * 4 + s4 * 256)); \
            const f32x4 k0_ = *(const f32x4*)kp_, k1_ = *(const f32x4*)(kp_ + 4), v0_ = *(const f32x4*)vp_, v1_ = *(const f32x4*)(vp_ + 4); \
            kreg[s4] = (u32x4){cvtpk(k0_[0], k0_[1]), cvtpk(k0_[2], k0_[3]), cvtpk(k1_[0], k1_[1]), cvtpk(k1_[2], k1_[3])}; vreg[s4] = (u32x4){cvtpk(v0_[0], v0_[1]), cvtpk(v0_[2], v0_[3]), cvtpk(v1_[0], v1_[1]), cvtpk(v1_[2], v1_[3])}; } } } while (0)
    SB_LOAD(jd);
    for (int j = jd; j >= 0; --j) {
        SB_LAS char* slot = lds + (j & 1) * SLOTB;
#pragma unroll
        for (int s4 = 0; s4 < 4; ++s4) { *(SB_LAS u32x4*)(slot + s4 * HSLOT + wid * 1024 + lane * 16) = kreg[s4]; *(SB_LAS u32x4*)(slot + s4 * HSLOT + 8192 + wid * 1024 + lane * 16) = vreg[s4]; }
        __syncthreads();
        if (j != jd) { const volatile SB_LAS unsigned* f = flags + ((j + 1) & 1) * 8; unsigned all = 1u;
#pragma unroll
            for (int w8 = 0; w8 < 8; ++w8) all &= f[w8];
            if (all) break; }
        if (j > 0) SB_LOAD(j - 1);
        if (worker && !done) {
            const int key0 = (SAMPLE && j == 16) ? cfg::PAST : 64 * j;
            sb_tile(slot + hs * HSLOT, j == jd, (j == jd) && (SAMPLE || wq == 0), key0 + 4 * hi - qpos, qr, Rb, o, Um, Jm, r32, hi, lane);
            done = __all(Rb[0] > THR2) != 0;
        }
        if (lane == 0) flags[(j & 1) * 8 + wid] = (done || !worker) ? 1u : 0u;
    }
#undef SB_LOAD
    __syncthreads();
    if (worker) {
        SB_LAS bf16_t* stg = (SB_LAS bf16_t*)lds + wid * 2048;
#pragma unroll
        for (int r = 0; r < 16; ++r) { const int orow = crow(r, hi);
#pragma unroll
            for (int d0 = 0; d0 < 2; ++d0) stg[orow * 64 + d0 * 32 + r32] = (bf16_t)(cvtpk(o[d0][r], 0.f) & 0xffffu); }
        asm volatile("s_waitcnt lgkmcnt(0)" ::: "memory");
        bf16_t* Ow = T.O + (rowbase + q0 + 32 * wq) * PITCH + head * 64;
        if (SAMPLE) asm volatile("s_waitcnt vmcnt(0)" ::: "memory");
#pragma unroll
        for (int i = 0; i < 4; ++i) { const int row = i * 8 + (lane >> 3), ch = lane & 7; const u32x4 v = *(const SB_LAS u32x4*)(stg + row * 64 + ch * 8);
            if (SAMPLE) { unsigned long long* po = (unsigned long long*)(Ow + (size_t)row * PITCH + ch * 8);
                __hip_atomic_store(po, (unsigned long long)v.x | ((unsigned long long)v.y << 32), __ATOMIC_RELAXED, __HIP_MEMORY_SCOPE_AGENT); __hip_atomic_store(po + 1, (unsigned long long)v.z | ((unsigned long long)v.w << 32), __ATOMIC_RELAXED, __HIP_MEMORY_SCOPE_AGENT); }
            else *(u32x4*)(Ow + (size_t)row * PITCH + ch * 8) = v; }
    }
    if (SAMPLE) { if (!worker) asm volatile("s_waitcnt vmcnt(0)" ::: "memory");
                  asm volatile("s_waitcnt lgkmcnt(0)" ::: "memory"); __builtin_amdgcn_s_barrier(); }
    else __syncthreads();
}
}
namespace sk {
typedef short bf16x8 __attribute__((ext_vector_type(8)));
typedef float f32x16 __attribute__((ext_vector_type(16)));
typedef float f32x4 __attribute__((ext_vector_type(4)));
typedef unsigned short bf16_t;
#define SK_LAS __attribute__((address_space(3)))
constexpr int PLD = 36;
constexpr int LDS_BYTES = 8 * 2 * 32 * PLD * 4;
__device__ __forceinline__ f32x4 tile(const bf16_t* A, const bf16_t* Bt, int K, size_t arow0, int col0, SK_LAS char* lds) {
    int tid = threadIdx.x; asm volatile("" : "+v"(tid)); const int lane = tid & 63, r32 = lane & 31, hi = lane >> 5; const int wid = __builtin_amdgcn_readfirstlane(tid >> 6);
    const int nsplit = (K >= 512) ? 8 : (K >> 6), ks = K / nsplit;
    const bf16_t* ap = A + (arow0 + r32) * K + wid * ks + hi * 32;
    const bf16_t* bp0 = Bt + (size_t)(col0 + r32) * K + wid * ks + hi * 32; const bf16_t* bp1 = bp0 + (size_t)32 * K;
    f32x16 acc0 = {}, acc1 = {};
#pragma unroll 2
    for (int s = 0; s < ((wid < nsplit) ? ks : 0); s += 64) {
        bf16x8 a[4], b0[4], b1[4];
#pragma unroll
        for (int j = 0; j < 4; ++j) { a[j] = *(const bf16x8*)(ap + s + 8 * j); b0[j] = *(const bf16x8*)(bp0 + s + 8 * j); b1[j] = *(const bf16x8*)(bp1 + s + 8 * j); }
#pragma unroll
        for (int j = 0; j < 4; ++j) {
            acc0 = __builtin_amdgcn_mfma_f32_32x32x16_bf16(b0[j], a[j], acc0, 0, 0, 0);
            acc1 = __builtin_amdgcn_mfma_f32_32x32x16_bf16(b1[j], a[j], acc1, 0, 0, 0); }
    }
    SK_LAS float* P0 = (SK_LAS float*)lds + ((wid * 2 + 0) * 32 + r32) * PLD + 4 * hi; SK_LAS float* P1 = P0 + 32 * PLD;
#pragma unroll
    for (int g = 0; g < 4; ++g) { *(SK_LAS f32x4*)(P0 + 8 * g) = (f32x4){acc0[4 * g], acc0[4 * g + 1], acc0[4 * g + 2], acc0[4 * g + 3]};
                                  *(SK_LAS f32x4*)(P1 + 8 * g) = (f32x4){acc1[4 * g], acc1[4 * g + 1], acc1[4 * g + 2], acc1[4 * g + 3]}; }
    __syncthreads();
    const int row = tid >> 4, c = (tid & 15) * 4, cb = c >> 5, cc = c & 31;
    f32x4 s = {0.f, 0.f, 0.f, 0.f};
#pragma unroll
    for (int w = 0; w < 8; ++w) s += *(const SK_LAS f32x4*)((SK_LAS float*)lds + ((w * 2 + cb) * 32 + row) * PLD + cc);
    __syncthreads();
    return s;
}
__device__ __forceinline__ void tile4(const bf16_t* A, const bf16_t* Bt, int K, size_t arow0, int col0, SK_LAS char* lds, f32x4 (&out)[2][2]) {
    int tid = threadIdx.x; asm volatile("" : "+v"(tid)); const int lane = tid & 63, r32 = lane & 31, hi = lane >> 5; const int wid = __builtin_amdgcn_readfirstlane(tid >> 6);
    const int half = wid >> 2, kq = wid & 3, ks = K >> 2;
    const bf16_t* ap = A + (arow0 + r32) * K + kq * ks + hi * 32;
    const bf16_t* bp = Bt + (size_t)(col0 + half * 128 + r32) * K + kq * ks + hi * 32;
    f32x16 acc[4]; acc[0] = f32x16{}; acc[1] = f32x16{}; acc[2] = f32x16{}; acc[3] = f32x16{};
#pragma unroll 1
    for (int s = 0; s < ks; s += 64) {
        bf16x8 a[4], b[4][4];
#pragma unroll
        for (int e = 0; e < 4; ++e) { a[e] = *(const bf16x8*)(ap + s + 8 * e);
#pragma unroll
            for (int j = 0; j < 4; ++j) b[j][e] = *(const bf16x8*)(bp + (size_t)(32 * j) * K + s + 8 * e); }
#pragma unroll
        for (int e = 0; e < 4; ++e)
#pragma unroll
            for (int j = 0; j < 4; ++j) acc[j] = __builtin_amdgcn_mfma_f32_32x32x16_bf16(b[j][e], a[e], acc[j], 0, 0, 0);
    }
    const int row = tid >> 4, cc = (tid & 15) * 4;
#pragma unroll
    for (int q = 0; q < 2; ++q) {
        SK_LAS float* P0 = (SK_LAS float*)lds + ((wid * 2 + 0) * 32 + r32) * PLD + 4 * hi; SK_LAS float* P1 = P0 + 32 * PLD;
#pragma unroll
        for (int g = 0; g < 4; ++g) { *(SK_LAS f32x4*)(P0 + 8 * g) = (f32x4){acc[2 * q][4 * g], acc[2 * q][4 * g + 1], acc[2 * q][4 * g + 2], acc[2 * q][4 * g + 3]};
                                      *(SK_LAS f32x4*)(P1 + 8 * g) = (f32x4){acc[2 * q + 1][4 * g], acc[2 * q + 1][4 * g + 1], acc[2 * q + 1][4 * g + 2], acc[2 * q + 1][4 * g + 3]}; }
        __syncthreads();
#pragma unroll
        for (int h = 0; h < 2; ++h) { f32x4 sum = {0.f, 0.f, 0.f, 0.f};
#pragma unroll
            for (int w = 0; w < 4; ++w) sum += *(const SK_LAS f32x4*)((SK_LAS float*)lds + (((h * 4 + w) * 2 + (cc >> 5)) * 32 + row) * PLD + (cc & 31));
            out[h][q] = sum; }
        __syncthreads();
    }
}
__device__ __forceinline__ f32x16 wtile(const bf16_t* A, const bf16_t* Bt, int K, size_t arow0, int colw, int lane) {
    const int r32 = lane & 31, hi = lane >> 5;
    const bf16_t* ap = A + (arow0 + r32) * K + hi * 32; const bf16_t* bp = Bt + (size_t)(colw + r32) * K + hi * 32;
    f32x16 acc = {};
#pragma unroll 4
    for (int s = 0; s < K; s += 64) {
        bf16x8 a[4], b[4];
#pragma unroll
        for (int e = 0; e < 4; ++e) { a[e] = *(const bf16x8*)(ap + s + 8 * e); b[e] = *(const bf16x8*)(bp + s + 8 * e); }
#pragma unroll
        for (int e = 0; e < 4; ++e) acc = __builtin_amdgcn_mfma_f32_32x32x16_bf16(b[e], a[e], acc, 0, 0, 0);
    }
    return acc;
}
__device__ __forceinline__ float sum16(float v) { v += __shfl_xor(v, 1); v += __shfl_xor(v, 2); v += __shfl_xor(v, 4); v += __shfl_xor(v, 8); return v; }
__device__ __forceinline__ float rstd16(const float* SSQ, int r, int t) { return __builtin_amdgcn_rsqf(sum16(__hip_atomic_load(SSQ + (size_t)r * 16 + (t & 15), __ATOMIC_RELAXED, __HIP_MEMORY_SCOPE_AGENT)) * (1.0f / 1024.0f) + cfg::EPS); }
__device__ __forceinline__ float rstd_row(const float* SSQ, int r) { const f32x4* p = (const f32x4*)(SSQ + (size_t)r * 16); const f32x4 a = p[0], b = p[1], c = p[2], d = p[3];
    const float s = ((a[0] + a[1]) + (a[2] + a[3])) + ((b[0] + b[1]) + (b[2] + b[3])) + ((c[0] + c[1]) + (c[2] + c[3])) + ((d[0] + d[1]) + (d[2] + d[3])); return __builtin_amdgcn_rsqf(s * (1.0f / 1024.0f) + cfg::EPS); }
__device__ __forceinline__ unsigned long long pk4(f32x4 v) { return (unsigned long long)pg8::cvt_pk_bf16(v[0], v[1]) | ((unsigned long long)pg8::cvt_pk_bf16(v[2], v[3]) << 32); }
__device__ __forceinline__ f32x4 up4(unsigned long long w) { const unsigned lo = (unsigned)w, hi = (unsigned)(w >> 32); return (f32x4){pg8::bf_lo(lo), pg8::bf_hi(lo), pg8::bf_lo(hi), pg8::bf_hi(hi)}; }
}
#define GAS __attribute__((address_space(1)))
#define LAS __attribute__((address_space(3)))
typedef unsigned short bf16;
typedef unsigned v4u __attribute__((ext_vector_type(4)));
typedef float f32x4 __attribute__((ext_vector_type(4)));
typedef short bf16x8 __attribute__((ext_vector_type(8)));
typedef GAS unsigned gu32;
typedef GAS unsigned long long gu64;
#define RLX_AGENT __ATOMIC_RELAXED, __HIP_MEMORY_SCOPE_AGENT
#define LDS_WAIT() asm volatile("s_waitcnt lgkmcnt(0)" ::: "memory")
#define VM_WAIT() asm volatile("s_waitcnt vmcnt(0)" ::: "memory")
__device__ __forceinline__ unsigned long long rt() { return __builtin_amdgcn_s_memrealtime(); }
__device__ __forceinline__ unsigned f2bf(float f) { unsigned u = __builtin_bit_cast(unsigned, f); return (u + 0x7fffu + ((u >> 16) & 1u)) >> 16; }
__device__ __forceinline__ unsigned pk2(float lo, float hi) { return f2bf(lo) | (f2bf(hi) << 16); }
#define XB_TMO      128
#define XB_XCNT(j)  (256  + 64 * (j))
#define XB_XSUB(j)  (1280 + 64 * (j))
#define XB_XGEN(j)  (2304 + 64 * (j))
#define XB_TOP      3328
#define XB_TOPGEN   3392
#define XCD_BAR_WORDS 3456
#define XB_SPIN_CAP (1u << 18)

__device__ __forceinline__ unsigned xb_ld(unsigned* p)              { return __hip_atomic_load(p, __ATOMIC_RELAXED, __HIP_MEMORY_SCOPE_AGENT); }
__device__ __forceinline__ unsigned xb_add(unsigned* p, unsigned v) { return __hip_atomic_fetch_add(p, v, __ATOMIC_RELAXED, __HIP_MEMORY_SCOPE_AGENT); }
__device__ __forceinline__ unsigned xb_xcc_id() { return (unsigned)__builtin_amdgcn_s_getreg((3 << 11) | 20) & 0xFu; }
#define XB_SPIN(cond, bar) do { unsigned _sp = 0; while (cond) { __builtin_amdgcn_s_sleep(1); \
    if ((++_sp & 255u) == 0u) { if (xb_ld(&(bar)[XB_TMO])) break; if (_sp > XB_SPIN_CAP) { atomicAdd(&(bar)[XB_TMO], 1u); break; } } } } while (0)

struct XcdBarrier {
    unsigned* bar; unsigned x;
    volatile LAS unsigned* st;
};

__device__ __forceinline__ XcdBarrier xcd_barrier_post(unsigned* bar, volatile LAS unsigned* st) {
    XcdBarrier b; b.bar = bar; b.x = xb_xcc_id(); b.st = st;
    if (threadIdx.x == 0) (void)xb_add(&bar[XB_XCNT(b.x)], 1u);
    return b;
}
__device__ __forceinline__ void xcd_barrier_complete(unsigned* bar, unsigned x, unsigned& nloc, unsigned& nx) {
    const unsigned G = gridDim.x * gridDim.y * gridDim.z;
    unsigned sum, cnt, mine, sp = 0u;
    for (;;) {
        sum = 0u; cnt = 0u; mine = 0u;
#pragma unroll
        for (unsigned j = 0; j < 16; ++j) { const unsigned c = xb_ld(&bar[XB_XCNT(j)]); sum += c; cnt += (c > 0u) ? 1u : 0u; mine = (j == x) ? c : mine; }
        if (sum == G) break;
        __builtin_amdgcn_s_sleep(1);
        if ((++sp & 255u) == 0u) { if (xb_ld(&bar[XB_TMO])) break; if (sp > XB_SPIN_CAP) { atomicAdd(&bar[XB_TMO], 1u); break; } }
    }
    nloc = mine > 0u ? mine : 1u; nx = cnt > 0u ? cnt : 1u;
}

__device__ __forceinline__ void xcd_barrier(const XcdBarrier& b) {
    asm volatile("s_waitcnt vmcnt(0)" ::: "memory");
    __syncthreads();
    if (threadIdx.x == 0) {
        unsigned* bar = b.bar;
        __builtin_amdgcn_s_waitcnt(0);
        unsigned nloc = b.st[0], nx = b.st[1];
        if (nloc == 0u) { xcd_barrier_complete(bar, b.x, nloc, nx); b.st[0] = nloc; b.st[1] = nx; }
        const unsigned old = xb_add(&bar[XB_XSUB(b.x)], 1u);
        const unsigned gen = old / nloc;
        if (old + 1u == (gen + 1u) * nloc) {
            __builtin_amdgcn_fence(__ATOMIC_RELEASE, "agent");
            asm volatile("s_waitcnt vmcnt(0)" ::: "memory");
            const unsigned og = xb_add(&bar[XB_TOP], 1u);
            const unsigned tg = og / nx;
            if (og + 1u == (tg + 1u) * nx) xb_add(&bar[XB_TOPGEN], 1u);
            else XB_SPIN(xb_ld(&bar[XB_TOPGEN]) == tg, bar);
            __builtin_amdgcn_fence(__ATOMIC_ACQUIRE, "agent");
            xb_add(&bar[XB_XGEN(b.x)], 1u);
            asm volatile("s_waitcnt vmcnt(0)" ::: "memory");
        } else {
            XB_SPIN(xb_ld(&bar[XB_XGEN(b.x)]) == gen, bar);
            __builtin_amdgcn_fence(__ATOMIC_ACQUIRE, "agent");
            asm volatile("s_waitcnt vmcnt(0)" ::: "memory");
        }
    }
    __syncthreads();
}
__device__ __forceinline__ float wave_sum(float v) {
#pragma unroll
    for (int o = 1; o < 64; o <<= 1) v += __shfl_xor(v, o);
    return v;
}
__device__ __forceinline__ void p0_transpose_item(const float* W, int K, int N, bf16* WT, int row_off, LAS float* scr, int item, int lane) {
    const int nblk = N / 32, kb = item / nblk, nb = item % nblk, k0 = 64 * kb, n0 = 32 * nb;
    float tv[32];
#pragma unroll
    for (int i = 0; i < 32; ++i) { const int kk = 2 * i + (lane >> 5); tv[i] = __builtin_nontemporal_load(W + (size_t)(k0 + kk) * N + n0 + (lane & 31)); }
#pragma unroll
    for (int i = 0; i < 32; ++i) { const int kk = 2 * i + (lane >> 5); scr[kk * 33 + (lane & 31)] = tv[i]; }
    LDS_WAIT(); asm volatile("" ::: "memory");
    const int c = lane & 7;
#pragma unroll
    for (int j = 0; j < 4; ++j) { const int n = (lane >> 3) + 8 * j; const LAS float* s = scr + (8 * c) * 33 + n;
        v4u o; o.x = pk2(s[0 * 33], s[1 * 33]); o.y = pk2(s[2 * 33], s[3 * 33]); o.z = pk2(s[4 * 33], s[5 * 33]); o.w = pk2(s[6 * 33], s[7 * 33]);
        *(GAS v4u*)(WT + (size_t)(row_off + n0 + n) * K + k0 + 8 * c) = o; }
    LDS_WAIT(); asm volatile("" ::: "memory");
}

struct P0T { const float* W; bf16* WT; int K, N, item; const float* gk; };
__device__ __forceinline__ void p0_t_load(const P0T& t, int lane, float (&tv)[32]) {
    const int nblk = t.N / 32, kb = t.item / nblk, nb = t.item % nblk, k0 = 64 * kb, n0 = 32 * nb;
#pragma unroll
    for (int i = 0; i < 32; ++i) { const int kk = 2 * i + (lane >> 5); tv[i] = __builtin_nontemporal_load(t.W + (size_t)(k0 + kk) * t.N + n0 + (lane & 31)); }
}
__device__ __forceinline__ void p0_t_finish(const P0T& t, LAS float* scr, int lane, const float (&tv)[32]) {
    const int nblk = t.N / 32, kb = t.item / nblk, nb = t.item % nblk, k0 = 64 * kb, n0 = 32 * nb;
#pragma unroll
    for (int i = 0; i < 32; ++i) { const int kk = 2 * i + (lane >> 5); scr[kk * 33 + (lane & 31)] = tv[i]; }
    LDS_WAIT(); asm volatile("" ::: "memory");
    const int c = lane & 7;
    f32x4 g0 = {1.f, 1.f, 1.f, 1.f}, g1 = g0;
    if (t.gk) { g0 = *(const GAS f32x4*)(t.gk + k0 + 8 * c); g1 = *(const GAS f32x4*)(t.gk + k0 + 8 * c + 4); }
#pragma unroll
    for (int j = 0; j < 4; ++j) { const int n = (lane >> 3) + 8 * j; const LAS float* s = scr + (8 * c) * 33 + n;
        v4u o; o.x = pk2(s[0 * 33] * g0.x, s[1 * 33] * g0.y); o.y = pk2(s[2 * 33] * g0.z, s[3 * 33] * g0.w); o.z = pk2(s[4 * 33] * g1.x, s[5 * 33] * g1.y); o.w = pk2(s[6 * 33] * g1.z, s[7 * 33] * g1.w);
        *(GAS v4u*)(t.WT + (size_t)(n0 + n) * t.K + k0 + 8 * c) = o; }
    LDS_WAIT(); asm volatile("" ::: "memory");
}
constexpr int NWAVES = 8;
#ifndef GROUP_BAR
#define GROUP_BAR 1
#endif
using namespace cfg;
constexpr size_t MiB = 1u << 20;
constexpr size_t WS_CTL = 0, CTL_ZERO_BYTES = MiB / 4;
constexpr size_t WS_WIN = 2 * MiB, WS_WEFF = 10 * MiB, WS_WSB = 11 * MiB, WS_WOUT = 12 * MiB, WS_WUP = 14 * MiB, WS_WDOWN = 22 * MiB, WS_WPG = 30 * MiB, WS_WPP = 32 * MiB;
constexpr size_t WS_SSQ1 = 33 * MiB, WS_SSQ2 = 35 * MiB, WS_SSQ3 = 37 * MiB, WS_RS0 = 39 * MiB  ;
constexpr size_t WS_PB = 40 * MiB;
constexpr size_t WS_XN = 49 * MiB;
constexpr size_t WS_BIG = 82 * MiB;
constexpr int NRG = 2048;
constexpr size_t ARK = (size_t)NRG * 1024;
constexpr size_t AR_U = 0, AR_Q = ARK, AR_K = 2 * ARK, AR_V = 3 * ARK, AR_G = 4 * ARK  , AR_Y = 6 * ARK, AR_YSB = 7 * ARK, ARENA = 8 * ARK;
constexpr size_t AR_MG = 0;
constexpr size_t AR_H = 0;
constexpr size_t AR_PP = 0;
constexpr size_t WS_X = WS_BIG + 8 * ARENA;
constexpr size_t WS_S = WS_X + 33 * MiB;
constexpr size_t SR_U = 0, SR_Q = 512 * 1024, SR_K = 2 * 512 * 1024, SR_V = 3 * 512 * 1024, SR_G = 4 * 512 * 1024  , SR_Y = 6 * 512 * 1024, SR_YSB = 7 * 512 * 1024,
                 SR_MG = 8 * 512 * 1024  , SR_H = 10 * 512 * 1024  , SR_XN1 = 18 * 512 * 1024  , SR_XN2 = 20 * 512 * 1024  , SR_END = 22 * 512 * 1024;
constexpr size_t WS_END = WS_S + SR_END;
static_assert((size_t)MT * 1024 * 2 == 33 * MiB && (size_t)MT * 16 * 4 <= 2 * MiB && (size_t)MT * 256 * 2 <= 9 * MiB && WS_END <= 256 * MiB && ARENA % 16 == 0, "d_ws map");
constexpr int CW_BAR = 4096, CW_FIN = 8192  , CW_FINS = 16384  , CW_XCC = 20480  , CW_GRP = 24576  , CW_SC = 28672  , CW_PNL = 36864  ;
static_assert((CW_SC + 64 * 16 * 7) <= CW_PNL && (CW_PNL + 64 * 64) * 4 <= (int)CTL_ZERO_BYTES, "control words inside the memset region");
constexpr size_t O_Y = 0, O_KP = 17301504, O_VP = 25690112, O_POOLP = 34078720, O_KS = 34140160, O_VS = 34402304, O_POOLS = 34664448, O_END = 34787328;
constexpr int RING_OFF = 0, RING_BYTES = 131072, LDSCTL_OFF = RING_BYTES, MISC_OFF = LDSCTL_OFF + 320, LDS_BYTES = 147456;
static_assert(sk::LDS_BYTES <= RING_BYTES && sba::LDS_BYTES <= RING_BYTES, "phase scratch fits the ring region");

struct Args { const float* in[22]; float* out; unsigned char* ws; };

__device__ __forceinline__ unsigned char* effp(unsigned char* ws, size_t aoff, int pitchB, int g) { return ws + WS_BIG + (size_t)g * ARENA + aoff - (size_t)(2048 * g) * (size_t)pitchB; }
__device__ __forceinline__ unsigned char* effs(unsigned char* ws, size_t soff, int pitchB) { return ws + WS_S + soff - (size_t)MP * (size_t)pitchB; }
__device__ __forceinline__ void st8_wt(void* p, unsigned long long v) { __hip_atomic_store((unsigned long long*)p, v, __ATOMIC_RELAXED, __HIP_MEMORY_SCOPE_AGENT); }
__device__ __forceinline__ void st4_wt(void* p, unsigned v) { __hip_atomic_store((unsigned*)p, v, __ATOMIC_RELAXED, __HIP_MEMORY_SCOPE_AGENT); }
__device__ __forceinline__ void stf_wt(float* p, float v) { __hip_atomic_store(p, v, __ATOMIC_RELAXED, __HIP_MEMORY_SCOPE_AGENT); }
#ifndef P0_TN
#define P0_TN 2
#endif
#ifndef P0_RN
#define P0_RN 4
#endif
#ifndef PANEL_BAR
#define PANEL_BAR 1
#endif
#ifndef PLE_GATE_FIRST
#define PLE_GATE_FIRST 1
#endif
#ifndef GRP_L2_ATOMICS
#define GRP_L2_ATOMICS 1
#endif
#ifndef CHAIN_FENCE
#define CHAIN_FENCE 0
#endif
__device__ __forceinline__ void chain_post_wave(gu32* ctl, int s, int rb) {
    asm volatile("s_waitcnt vmcnt(0)" ::: "memory");
    if ((threadIdx.x & 63) == 0) __hip_atomic_fetch_add((unsigned*)(ctl + CW_SC + 64 * (16 * s + rb)), 1u, __ATOMIC_RELAXED, __HIP_MEMORY_SCOPE_AGENT);
}
struct PostHook { gu32* ctl; int s, rb; bool on;
    __device__ __forceinline__ void operator()(int ui) const { if (on && ui == 0) chain_post_wave(ctl, s, rb); } };
__device__ __forceinline__ void chain_wait_wave(gu32* ctl, int s, int rb, unsigned target) {
    unsigned spins = 0;
    while ((unsigned)__builtin_amdgcn_readfirstlane(__hip_atomic_load((unsigned*)(ctl + CW_SC + 64 * (16 * s + rb)), __ATOMIC_RELAXED, __HIP_MEMORY_SCOPE_AGENT)) < target) { __builtin_amdgcn_s_sleep(2); if (++spins > (1u << 18)) break; }
    if (CHAIN_FENCE) { __builtin_amdgcn_fence(__ATOMIC_ACQUIRE, "agent"); asm volatile("s_waitcnt vmcnt(0)" ::: "memory"); }
}
__device__ __forceinline__ void chain_wait(gu32* ctl, int s, int rb, unsigned target) {
    if (threadIdx.x < 64) chain_wait_wave(ctl, s, rb, target);
    __syncthreads();
}

template <int NR>
__device__ __forceinline__ void rms_rows_to_bf16(const float* const (&xrow)[NR], const f32x4 (&gg)[4], bf16* const (&orow)[NR], float* const (&rms_out)[NR], int lane) {
    f32x4 v[NR][4]; float s[NR];
#pragma unroll
    for (int i = 0; i < NR; ++i) { const GAS f32x4* xr = (const GAS f32x4*)(xrow[i] ? xrow[i] : xrow[0]) + lane;
#pragma unroll
        for (int j = 0; j < 4; ++j) v[i][j] = __builtin_nontemporal_load(xr + 64 * j); }
#pragma unroll
    for (int i = 0; i < NR; ++i) { s[i] = 0.f;
#pragma unroll
        for (int j = 0; j < 4; ++j) s[i] += (v[i][j].x * v[i][j].x + v[i][j].y * v[i][j].y) + (v[i][j].z * v[i][j].z + v[i][j].w * v[i][j].w); }
#pragma unroll
    for (int o = 1; o < 64; o <<= 1)
#pragma unroll
        for (int i = 0; i < NR; ++i) s[i] += __shfl_xor(s[i], o);
#pragma unroll
    for (int i = 0; i < NR; ++i) { const float rms = sqrtf(s[i] * (1.f / DM) + EPS), rs = 1.f / rms;
        if (xrow[i] && rms_out[i] && lane == 0) *rms_out[i] = rms;
        if (xrow[i]) { GAS unsigned long long* o0 = (GAS unsigned long long*)orow[i] + lane;
#pragma unroll
            for (int j = 0; j < 4; ++j) o0[64 * j] = (unsigned long long)pk2(v[i][j].x * rs * gg[j].x, v[i][j].y * rs * gg[j].y) | ((unsigned long long)pk2(v[i][j].z * rs * gg[j].z, v[i][j].w * rs * gg[j].w) << 32); } }
}
__device__ __forceinline__ void weff_item(const float* wgrp, const float* scale, const float* wpu, bf16* WT, int item, int lane) {
    const int nb = item & 15, cb = (item >> 4) & 15, g = item >> 8, n = nb * 64 + lane;
    float wg[8][2];
#pragma unroll
    for (int cc = 0; cc < 8; ++cc)
#pragma unroll
        for (int hh = 0; hh < 2; ++hh) wg[cc][hh] = wgrp[((size_t)(g * 128 + cb * 8 + cc)) * 128 + lane + 64 * hh] * scale[g * 128 + lane + 64 * hh];
    float acc[8];
#pragma unroll
    for (int cc = 0; cc < 8; ++cc) acc[cc] = 0.f;
#pragma unroll
    for (int hh = 0; hh < 2; ++hh)
#pragma unroll
        for (int q = 0; q < 2; ++q) { float wv[32];
#pragma unroll
            for (int d2 = 0; d2 < 32; ++d2) wv[d2] = wpu[(size_t)(g * 128 + hh * 64 + q * 32 + d2) * 1024 + n];
#pragma unroll
            for (int d2 = 0; d2 < 32; ++d2)
#pragma unroll
                for (int cc = 0; cc < 8; ++cc) acc[cc] = fmaf(__builtin_bit_cast(float, __builtin_amdgcn_readlane(__builtin_bit_cast(int, wg[cc][hh]), q * 32 + d2)), wv[d2], acc[cc]);
            asm volatile("" ::: "memory"); }
    v4u o; o.x = pk2(acc[0], acc[1]); o.y = pk2(acc[2], acc[3]); o.z = pk2(acc[4], acc[5]); o.w = pk2(acc[6], acc[7]);
    *(GAS v4u*)(WT + (size_t)n * 512 + g * 128 + cb * 8) = o;
}
template <int W, int R, bool WT>
__device__ __forceinline__ void pool_run(const bf16* Ub, const float* state_pool, bf16* Yb, int r0, int c, bool sample, int t0, int b_) {
    v4u rw[R - 1 + W];
#pragma unroll
    for (int k = 0; k < W - 1; ++k) { const int pos = t0 + k - (W - 1);
        if (pos >= 0) rw[k] = *(const GAS v4u*)(Ub + (size_t)(r0 - (W - 1) + k) * 512 + c);
        else if (sample) { const float* sp = state_pool + ((size_t)b_ * 15 + 15 + pos) * 512 + c; const f32x4 a = *(const GAS f32x4*)sp, b = *(const GAS f32x4*)(sp + 4); rw[k] = pg8::pack8(a, b); }
        else rw[k] = (v4u){0u, 0u, 0u, 0u}; }
#pragma unroll
    for (int k = W - 1; k < R - 1 + W; ++k) rw[k] = *(const GAS v4u*)(Ub + (size_t)(r0 - (W - 1) + k) * 512 + c);
    f32x4 s0 = {0.f, 0.f, 0.f, 0.f}, s1 = {0.f, 0.f, 0.f, 0.f};
#pragma unroll
    for (int k = 0; k < W - 1; ++k) { f32x4 a, b; pg8::unpack8(rw[k], a, b); s0 += a; s1 += b; }
#pragma unroll
    for (int i = 0; i < R; ++i) { f32x4 a, b, u0, u1; pg8::unpack8(rw[W - 1 + i], u0, u1); s0 += u0; s1 += u1;
        const int cnt = sample ? W : ((t0 + i + 1 < W) ? t0 + i + 1 : W); const float ic = 1.0f / (float)cnt;
        { const v4u yv = pg8::pack8(s0 * ic - u0, s1 * ic - u1);
          if (WT) { st8_wt(Yb + (size_t)(r0 + i) * 512 + c, (unsigned long long)yv.x | ((unsigned long long)yv.y << 32)); st8_wt(Yb + (size_t)(r0 + i) * 512 + c + 4, (unsigned long long)yv.z | ((unsigned long long)yv.w << 32)); }
          else *(GAS v4u*)(Yb + (size_t)(r0 + i) * 512 + c) = yv; }
        pg8::unpack8(rw[i], a, b); s0 -= a; s1 -= b; }
}
template <bool WT>
__device__ __forceinline__ void pool_item(int cg, const bf16* Ub, const float* state_pool, bf16* Yb, int r0, int c, bool sample, int t0, int b_) {
    if (cg == 0) pool_run<2, 16, WT>(Ub, state_pool, Yb, r0, c, sample, t0, b_); else if (cg == 1) pool_run<4, 16, WT>(Ub, state_pool, Yb, r0, c, sample, t0, b_); else if (cg == 2) pool_run<8, 16, WT>(Ub, state_pool, Yb, r0, c, sample, t0, b_);
    else { pool_run<16, 8, WT>(Ub, state_pool, Yb, r0, c, sample, t0, b_); asm volatile("" ::: "memory"); pool_run<16, 8, WT>(Ub, state_pool, Yb, r0 + 8, c, sample, t0 + 8, b_); }
}

__device__ __forceinline__ unsigned l2_add_ret(unsigned* p, unsigned v) {
    unsigned r;
    asm volatile("global_atomic_add %0, %1, %2, off sc0\n\ts_waitcnt vmcnt(0)" : "=&v"(r) : "v"(p), "v"(v) : "memory");
    return r;
}
__device__ __forceinline__ void grp_barrier(unsigned* cnt, unsigned members, volatile LAS unsigned* round_word, bool raw) {
    if (raw) { asm volatile("s_waitcnt lgkmcnt(0)" ::: "memory"); __builtin_amdgcn_s_barrier(); }
    else { asm volatile("s_waitcnt vmcnt(0)" ::: "memory");
           __syncthreads(); }
    if (threadIdx.x == 0) {
        const unsigned round = round_word[0] + 1u; round_word[0] = round;
#if GRP_L2_ATOMICS
        __hip_atomic_fetch_add(cnt, 1u, __ATOMIC_RELAXED, __HIP_MEMORY_SCOPE_WORKGROUP);
        unsigned spins = 0;
        const unsigned base = round_word[1];
        while (l2_add_ret(cnt, 0u) - base < members * round) { __builtin_amdgcn_s_sleep(1); if (++spins > (1u << 20)) break; }
#else
        __hip_atomic_fetch_add(cnt, 1u, __ATOMIC_RELAXED, __HIP_MEMORY_SCOPE_AGENT);
        unsigned spins = 0;
        while (__hip_atomic_load(cnt, __ATOMIC_RELAXED, __HIP_MEMORY_SCOPE_AGENT) < members * round) { __builtin_amdgcn_s_sleep(1); if (++spins > (1u << 20)) break; }
#endif
        __builtin_amdgcn_fence(__ATOMIC_ACQUIRE, "agent");
        asm volatile("s_waitcnt vmcnt(0)" ::: "memory");
    }
    __syncthreads();
}

__global__ void __launch_bounds__(NWAVES * 64, 2) mega_fwd(Args args) {
    extern __shared__ __attribute__((aligned(16))) unsigned char lds[];
    LAS unsigned char* L = (LAS unsigned char*)lds;
    volatile LAS unsigned* MISC = (volatile LAS unsigned*)(L + MISC_OFF);
    const int wave = __builtin_amdgcn_readfirstlane(threadIdx.x >> 6);
#define FRESH_TID() int tid = threadIdx.x; asm volatile("" : "+v"(tid)); const int lane = tid & 63; (void)lane
    const int G = gridDim.x, bx = blockIdx.x, vcu = (bx % 8) * (G / 8) + bx / 8;
    const int grp = vcu >> 5, gi = vcu & 31;
    unsigned char* ws = args.ws;
    gu32* ctl = (gu32*)(ws + WS_CTL);
    const float* x_p = args.in[0]; const float* x_s = args.in[1]; const float* cache_k = args.in[2]; const float* cache_v = args.in[3]; const float* state_pool = args.in[4];
    const float* p_p = args.in[5]; const float* p_s = args.in[6]; const float* g_mix = args.in[7]; const float* w_in = args.in[8]; const float* b_gate = args.in[9]; const float* w_grp = args.in[10];
    const float* pool_scale = args.in[11]; const float* w_pool_up = args.in[12]; const float* w_sb_up = args.in[13]; const float* w_out = args.in[14]; const float* g_mlp = args.in[15];
    const float* w_up = args.in[16]; const float* w_down = args.in[17]; const float* g_ple = args.in[18]; const float* w_ple_gate = args.in[19]; const float* w_ple_proj = args.in[20]; const float* g_final = args.in[21];
    float* out = args.out; float* Yo = out + O_Y;
    bf16 *WIN = (bf16*)(ws + WS_WIN), *WEFF = (bf16*)(ws + WS_WEFF), *WSB = (bf16*)(ws + WS_WSB), *WOUT = (bf16*)(ws + WS_WOUT), *WUP = (bf16*)(ws + WS_WUP), *WDOWN = (bf16*)(ws + WS_WDOWN), *WPG = (bf16*)(ws + WS_WPG), *WPP = (bf16*)(ws + WS_WPP);
    float *SSQ1 = (float*)(ws + WS_SSQ1), *SSQ2 = (float*)(ws + WS_SSQ2), *SSQ3 = (float*)(ws + WS_SSQ3), *RS0 = (float*)(ws + WS_RS0);
    bf16 *PB = (bf16*)(ws + WS_PB), *XN = (bf16*)(ws + WS_XN), *XB = (bf16*)(ws + WS_X);
    const int srb = vcu & 15, scb = vcu >> 4;
#define PV(aoff, pitchB) ((bf16*)effp(ws, aoff, pitchB, g_))
#define SV(soff, pitchB) ((bf16*)effs(ws, soff, pitchB))
#define OPQ() int g_ = grp, r_ = srb; asm volatile("" : "+s"(g_), "+s"(r_))

    for (int i = threadIdx.x; i < (LDS_BYTES - LDSCTL_OFF) / 4; i += NWAVES * 64) ((LAS unsigned*)(L + LDSCTL_OFF))[i] = 0u;
    __syncthreads();
    if (GRP_L2_ATOMICS && threadIdx.x == 0) { MISC[21] = l2_add_ret((unsigned*)(ctl + CW_PNL + 64 * (8 * grp + (gi & 7))), 0u); }
    if (GRP_L2_ATOMICS && threadIdx.x == 0) MISC[13] = l2_add_ret((unsigned*)(ctl + CW_GRP + 64 * grp), 0u);
    XcdBarrier bar = xcd_barrier_post((unsigned*)(ctl + CW_BAR), MISC + 8);
    if (threadIdx.x == 0) __hip_atomic_fetch_add((unsigned*)(ctl + CW_XCC + 16 * grp + (int)(bar.x & 15u)), 1u, __ATOMIC_RELAXED, __HIP_MEMORY_SCOPE_AGENT);
    const int gw = vcu * NWAVES + wave, NGW = G * NWAVES;
    const bool late_ = (vcu & 1) != 0;

    {
        FRESH_TID();
        LAS float* scr = (LAS float*)(L + RING_OFF + wave * 16384);
        constexpr int I_IN = (DM / 64) * (INW / 32), I_SB = (SBW / 64) * (DM / 32), I_OUT = (DM / 64) * (DM / 32), I_UP = (DM / 64) * (DFF / 32), I_DOWN = (DFF / 64) * (DM / 32), I_PG = I_OUT, I_PP = (PLE / 64) * (DM / 32), I_EFF = 4 * 16 * 16;
        constexpr int NITEMS = I_IN + I_SB + I_OUT + I_UP + I_DOWN + I_PG + I_PP + I_EFF;
        for (int it = gw; it < I_EFF; it += NGW) weff_item(w_grp, pool_scale, w_pool_up, WEFF, it, lane);
        constexpr int NT = NITEMS - I_EFF;
        auto decode = [&](int r) -> P0T {
            if (r < I_IN) return P0T{w_in, WIN, DM, INW, r, FOLD_G ? g_mix : nullptr}; r -= I_IN;
            if (r < I_SB) return P0T{w_sb_up, WSB, SBW, DM, r, nullptr}; r -= I_SB;
            if (r < I_OUT) return P0T{w_out, WOUT, DM, DM, r, nullptr}; r -= I_OUT;
            if (r < I_UP) return P0T{w_up, WUP, DM, DFF, r, FOLD_G ? g_mlp : nullptr}; r -= I_UP;
            if (r < I_DOWN) return P0T{w_down, WDOWN, DFF, DM, r, nullptr}; r -= I_DOWN;
            if (r < I_PG) return P0T{w_ple_gate, WPG, DM, DM, r, FOLD_G ? g_ple : nullptr}; r -= I_PG;
            return P0T{w_ple_proj, WPP, PLE, DM, r, nullptr}; };
#pragma unroll 1
        for (int it = NGW - 1 - gw; it < NT; it += P0_TN * NGW) {
            P0T tt[P0_TN]; float tv[P0_TN][32];
#pragma unroll
            for (int i = 0; i < P0_TN; ++i) { const int iti = it + i * NGW; tt[i] = decode(iti < NT ? iti : it); if (iti >= NT) tt[i].item = -1; }
#pragma unroll
            for (int i = 0; i < P0_TN; ++i) if (tt[i].item >= 0) p0_t_load(tt[i], lane, tv[i]);
#pragma unroll
            for (int i = 0; i < P0_TN; ++i) if (tt[i].item >= 0) p0_t_finish(tt[i], scr, lane, tv[i]);
        }
        f32x4 gg[4];
#pragma unroll
        for (int j = 0; j < 4; ++j) gg[j] = FOLD_G ? (f32x4){1.f, 1.f, 1.f, 1.f} : *((const GAS f32x4*)g_mix + lane + 64 * j);
#pragma unroll 1
        for (int m = gw; m < MT; m += P0_RN * NGW) {
            const float* xr[P0_RN]; bf16* orow[P0_RN]; const float* pr[P0_RN]; f32x4 pv[P0_RN]; float* ro[P0_RN];
#pragma unroll
            for (int i = 0; i < P0_RN; ++i) { const int mi = m + i * NGW; const bool ok = mi < MT;
                xr[i] = !ok ? nullptr : (mi < MP ? x_p + (size_t)mi * DM : x_s + (size_t)(mi - MP) * DM);
                pr[i] = !ok ? p_p : (mi < MP ? p_p + (size_t)mi * PLE : p_s + (size_t)(mi - MP) * PLE);
                orow[i] = XN + (size_t)(ok ? mi : m) * DM; ro[i] = (ok && mi < MP) ? RS0 + mi : nullptr; }
#pragma unroll
            for (int i = 0; i < P0_RN; ++i) pv[i] = __builtin_nontemporal_load((const GAS f32x4*)pr[i] + lane);
            rms_rows_to_bf16<P0_RN>(xr, gg, orow, ro, lane);
#pragma unroll
            for (int i = 0; i < P0_RN; ++i) if (xr[i]) *((GAS unsigned long long*)(PB + (size_t)(m + i * NGW) * PLE) + lane) = (unsigned long long)pk2(pv[i].x, pv[i].y) | ((unsigned long long)pk2(pv[i].z, pv[i].w) << 32);
        }
    }
    xcd_barrier(bar);
    bool fast = false;
    if (GROUP_BAR) {
        bool okg = false;
        if (threadIdx.x < 128) okg = __hip_atomic_load((unsigned*)(ctl + CW_XCC + (int)threadIdx.x), __ATOMIC_RELAXED, __HIP_MEMORY_SCOPE_AGENT) == 32u;
        const unsigned long long bm = __ballot(okg);
        if ((threadIdx.x & 63) == 0 && wave < 2) MISC[16 + wave] = (unsigned)__builtin_popcountll(bm);
        __syncthreads();
        fast = (MISC[16] + MISC[17] == 8u) && (G == 256);
    }
    unsigned* gcnt = (unsigned*)(ctl + CW_GRP + 64 * grp);
#define SEAM(RAW) do { if (fast) grp_barrier(gcnt, 32u, MISC + 12, (RAW)); else xcd_barrier(bar); } while (0)
    unsigned* pcnt = (unsigned*)(ctl + CW_PNL + 64 * (8 * grp + (gi & 7)));
#define PSEAM(RAW) do { if (fast && PANEL_BAR) grp_barrier(pcnt, 4u, MISC + 20, (RAW)); else SEAM(RAW); } while (0)
#define DRAIN_PLAIN() asm volatile("s_waitcnt vmcnt(0)" ::: "memory")
#define LATE_POST(S) do { if (late_) chain_post_wave(ctl, (S), srb); } while (0)

#pragma unroll 1
    for (int pass_ = 0; pass_ < 2; ++pass_) { OPQ(); if ((pass_ == 1) == late_) {
        { const int col0 = scb * 256; f32x4 vv[2][2];
            sk::tile4(XN, WIN, DM, (size_t)MP + srb * 32, col0, (SK_LAS char*)(L + RING_OFF), vv);
            DRAIN_PLAIN();
            int t_raw_ = threadIdx.x; asm volatile("" : "+v"(t_raw_)); const int t = t_raw_, rs = srb * 32 + (t >> 4), r = MP + rs;
#pragma unroll
            for (int h = 0; h < 2; ++h)
#pragma unroll
                for (int q = 0; q < 2; ++q) { const f32x4 v = vv[h][q]; const int c = col0 + 128 * h + 64 * q + (t & 15) * 4;
            if (c < 512) { st8_wt(SV(SR_U, 1024) + (size_t)r * 512 + c, sk::pk4(v)); const int i = rs & 31; if (i >= 17) *(GAS f32x4*)(out + O_POOLS + ((size_t)(rs >> 5) * 15 + (i - 17)) * 512 + c) = v; }
            else if (c < 1024) st8_wt(SV(SR_Q, 1024) + (size_t)r * 512 + c - 512, sk::pk4(v * QSCALE));
            else if (c < 1536) { st8_wt(SV(SR_K, 1024) + (size_t)r * 512 + c - 1024, sk::pk4(v)); *(GAS f32x4*)(out + O_KS + (size_t)rs * 512 + c - 1024) = v; }
            else if (c < 2048) { st8_wt(SV(SR_V, 1024) + (size_t)r * 512 + c - 1536, sk::pk4(v)); *(GAS f32x4*)(out + O_VS + (size_t)rs * 512 + c - 1536) = v; }
            else { const f32x4 bg = *(const GAS f32x4*)(b_gate + c - 2048); st4_wt((unsigned char*)SV(SR_G, 2048) + (size_t)r * 2048 + c - 2048, pg8::pk_u8x4(pg8::sigm4(v + bg))); } }
        }
    } else {
        pg8::Gemm g{XN, WIN, MP, INW, DM}; pg8::StaticOrder S; S.init(MP, INW, G, bx);
        pg8::EpiIn E{PV(AR_U, 1024), PV(AR_Q, 1024), PV(AR_K, 1024), PV(AR_V, 1024), PV(AR_G, 2048), b_gate, out + O_KP, out + O_VP, out + O_KS, out + O_VS, out + O_POOLP, out + O_POOLS};
        pg8::gemm_phase<pg8::EpiIn, pg8::StaticOrder, true, true, PostHook>(L + RING_OFF, g, S, E, PostHook{ctl, 1, srb, !late_});
    } }
    SEAM(late_); LATE_POST(1);
    {
        FRESH_TID(); OPQ();
        const bool host_ = (gi & 7) == 7; const int rho_ = gi - (gi >> 3);
        if (!host_ && (wave < 4 || (wave == 5 && rho_ < 16))) { const int wi = wave < 4 ? wave * 28 + rho_ : 112 + rho_, cg = wi & 3, k = lane >> 4, lrow = ((wi >> 2) * 4 + k) * 16;
            const bf16* ub = (const bf16*)(effp(ws, AR_U, 1024, g_) + (size_t)g_ * 2048 * 1024); bf16* yb = (bf16*)(effp(ws, AR_Y, 1024, g_) + (size_t)g_ * 2048 * 1024);
            pool_item<false>(cg, ub, state_pool, yb, lrow, cg * 128 + (lane & 15) * 8, false, lrow & (SEQ - 1), 0); }
        if (wave == 4 && (vcu & 7) == 0) { const int si = vcu >> 3, cg = si & 3, run4 = si >> 2, k = lane >> 4, rs = (run4 * 4 + k) * 16;
            chain_wait_wave(ctl, 1, 2 * run4, 128u); chain_wait_wave(ctl, 1, 2 * run4 + 1, 128u);
            pool_item<true>(cg, SV(SR_U, 1024), state_pool, SV(SR_Y, 1024), MP + rs, cg * 128 + (lane & 15) * 8, true, rs & 31, rs >> 5);
            asm volatile("s_waitcnt vmcnt(0)" ::: "memory");
            if (lane == 0) { __hip_atomic_fetch_add((unsigned*)(ctl + CW_SC + 64 * (16 * 2 + 2 * run4)), 1u, __ATOMIC_RELAXED, __HIP_MEMORY_SCOPE_AGENT); __hip_atomic_fetch_add((unsigned*)(ctl + CW_SC + 64 * (16 * 2 + 2 * run4 + 1)), 1u, __ATOMIC_RELAXED, __HIP_MEMORY_SCOPE_AGENT); } }
        volatile LAS unsigned* sbflags = (volatile LAS unsigned*)(L + LDSCTL_OFF + 1024);
        { const sba::Tensors T{PV(AR_Q, 1024), PV(AR_K, 1024), PV(AR_V, 1024), PV(AR_YSB, 1024), cache_k, cache_v}; const int hg = gi & 1, s = gi >> 1;
#pragma unroll 1
          for (int k = 0; k < 2; ++k) sba::sb_unit<false>(grp, hg, (k & 1) ? 31 - s : s, T, (SB_LAS char*)(L + RING_OFF), sbflags); }
        if ((vcu & 7) == 7) { const int rb = vcu >> 4, hg = (vcu >> 3) & 1;
            chain_wait(ctl, 1, rb, 128u);
            const sba::Tensors T{SV(SR_Q, 1024), SV(SR_K, 1024), SV(SR_V, 1024), SV(SR_YSB, 1024), cache_k, cache_v};
            sba::sb_unit<true>(rb, hg, 0, T, (SB_LAS char*)(L + RING_OFF), sbflags); }
    }
    SEAM((vcu & 7) == 7);
    if ((vcu & 7) == 7 && wave < 4) chain_post_wave(ctl, 2, vcu >> 4);
#pragma unroll 1
    for (int pass_ = 0; pass_ < 2; ++pass_) { OPQ(); if ((pass_ == 1) == late_) {
        { const int rb = srb, col0 = scb * 64;
            chain_wait(ctl, 2, rb, 12u);
            unsigned gaw, gbw;
            { int te_ = threadIdx.x; asm volatile("" : "+v"(te_)); const size_t go = (size_t)(MP + rb * 32 + (te_ >> 4)) * 2048 + col0 + (te_ & 15) * 4; gaw = *(const GAS unsigned*)((const unsigned char*)SV(SR_G, 2048) + go); gbw = *(const GAS unsigned*)((const unsigned char*)SV(SR_G, 2048) + go + 1024); }
            const f32x4 va = sk::tile(SV(SR_Y, 1024), WEFF, PW, (size_t)MP + rb * 32, col0, (SK_LAS char*)(L + RING_OFF));
            const f32x4 vb = sk::tile(SV(SR_YSB, 1024), WSB, SBW, (size_t)MP + rb * 32, col0, (SK_LAS char*)(L + RING_OFF));
            int t_raw_ = threadIdx.x; asm volatile("" : "+v"(t_raw_)); const int t = t_raw_, r = MP + rb * 32 + (t >> 4), c = col0 + (t & 15) * 4;
            const f32x4 ga = pg8::up_u8x4(gaw), gb = pg8::up_u8x4(gbw);
            DRAIN_PLAIN();
            st8_wt(SV(SR_MG, 2048) + (size_t)r * 1024 + c, sk::pk4(ga * va + gb * vb));
        }
    } else {
        pg8::Gemm g{PV(AR_Y, 1024), WEFF, MP, DM, PW, PV(AR_YSB, 1024), WSB}; pg8::PairOrder S; S.init(MP, DM, G, bx); pg8::EpiMerge E{PV(AR_G, 2048), PV(AR_MG, 2048)};
        pg8::gemm_phase<pg8::EpiMerge, pg8::PairOrder, true, true, PostHook>(L + RING_OFF, g, S, E, PostHook{ctl, 3, srb, !late_});
    } }
    PSEAM(late_); LATE_POST(3);
#pragma unroll 1
    for (int pass_ = 0; pass_ < 2; ++pass_) { OPQ(); if ((pass_ == 1) == late_) {
        { const int rb = srb, col0 = scb * 64;
            chain_wait(ctl, 3, rb, 128u);
            f32x4 xe;
            { int te_ = threadIdx.x; asm volatile("" : "+v"(te_)); xe = *(const GAS f32x4*)(x_s + (size_t)(rb * 32 + (te_ >> 4)) * DM + col0 + (te_ & 15) * 4); }
            const f32x4 v = sk::tile(SV(SR_MG, 2048), WOUT, DM, (size_t)MP + rb * 32, col0, (SK_LAS char*)(L + RING_OFF));
            int t_raw_ = threadIdx.x; asm volatile("" : "+v"(t_raw_)); const int t = t_raw_, rs = rb * 32 + (t >> 4), r = MP + rs, c = col0 + (t & 15) * 4;
            DRAIN_PLAIN();
            const f32x4 x1 = xe + v; st8_wt(XB + (size_t)r * DM + c, sk::pk4(x1));
            st8_wt(SV(SR_XN1, 2048) + (size_t)r * DM + c, sk::pk4(FOLD_G ? x1 : x1 * *(const GAS f32x4*)(g_mlp + c)));
            const float ss = sk::sum16(pg8::dot4(x1)); if ((t & 15) == 0) stf_wt(SSQ1 + (size_t)r * 16 + (col0 >> 6), ss);
        }
    } else {
        pg8::Gemm g{PV(AR_MG, 2048), WOUT, MP, DM, DM}; pg8::StaticOrder S; S.init(MP, DM, G, bx); pg8::EpiResid<true> E{x_p, XB, XN, g_mlp, SSQ1, XN, RS0};
        pg8::gemm_phase<pg8::EpiResid<true>, pg8::StaticOrder, true, true, PostHook>(L + RING_OFF, g, S, E, PostHook{ctl, 4, srb, !late_});
    } }
    SEAM(late_); LATE_POST(4);
#pragma unroll 1
    for (int pass_ = 0; pass_ < 2; ++pass_) { OPQ(); if ((pass_ == 1) == late_) {
        { const int rb = srb, col0 = scb * 256; f32x4 vv[2][2];
            chain_wait(ctl, 4, rb, 128u);
            float rs_;
            { int te_ = threadIdx.x; asm volatile("" : "+v"(te_)); rs_ = sk::rstd16(SSQ1, MP + rb * 32 + (te_ >> 4), te_); }
            sk::tile4(SV(SR_XN1, 2048), WUP, DM, (size_t)MP + rb * 32, col0, (SK_LAS char*)(L + RING_OFF), vv);
            DRAIN_PLAIN();
            int t_raw_ = threadIdx.x; asm volatile("" : "+v"(t_raw_)); const int t = t_raw_, r = MP + rb * 32 + (t >> 4);
#pragma unroll
            for (int h = 0; h < 2; ++h)
#pragma unroll
                for (int q = 0; q < 2; ++q) { const int c = col0 + 128 * h + 64 * q + (t & 15) * 4; const f32x4 a = __builtin_elementwise_max(vv[h][q] * rs_, (f32x4){0.f, 0.f, 0.f, 0.f});
                    st8_wt(SV(SR_H, 8192) + (size_t)r * DFF + c, sk::pk4(a * a)); }
        }
    } else {
        pg8::Gemm g{FOLD_G ? XB : XN, WUP, MP, DFF, DM}; pg8::StaticOrder S; S.init(MP, DFF, G, bx); pg8::EpiUp E{SSQ1, PV(AR_H, 8192)};
        pg8::gemm_phase<pg8::EpiUp, pg8::StaticOrder, true, true, PostHook>(L + RING_OFF, g, S, E, PostHook{ctl, 5, srb, !late_});
    } }
    PSEAM(late_); LATE_POST(5);
#pragma unroll 1
    for (int pass_ = 0; pass_ < 2; ++pass_) { OPQ(); if ((pass_ == 1) == late_) {
        { const int rb = srb, col0 = scb * 64;
            chain_wait(ctl, 5, rb, 128u);
            unsigned long long xw_;
            { int te_ = threadIdx.x; asm volatile("" : "+v"(te_)); xw_ = *(const GAS unsigned long long*)(XB + (size_t)(MP + rb * 32 + (te_ >> 4)) * DM + col0 + (te_ & 15) * 4); }
            const f32x4 v = sk::tile(SV(SR_H, 8192), WDOWN, DFF, (size_t)MP + rb * 32, col0, (SK_LAS char*)(L + RING_OFF));
            int t_raw_ = threadIdx.x; asm volatile("" : "+v"(t_raw_)); const int t = t_raw_, r = MP + rb * 32 + (t >> 4), c = col0 + (t & 15) * 4;
            DRAIN_PLAIN();
            const f32x4 x2 = sk::up4(xw_) + v; st8_wt(XB + (size_t)r * DM + c, sk::pk4(x2));
            st8_wt(SV(SR_XN2, 2048) + (size_t)r * DM + c, sk::pk4(FOLD_G ? x2 : x2 * *(const GAS f32x4*)(g_ple + c)));
            const float ss = sk::sum16(pg8::dot4(x2)); if ((t & 15) == 0) stf_wt(SSQ2 + (size_t)r * 16 + (col0 >> 6), ss);
        }
    } else {
        pg8::Gemm g{PV(AR_H, 8192), WDOWN, MP, DM, DFF}; pg8::StaticOrder S; S.init(MP, DM, G, bx); pg8::EpiResid<false> E{nullptr, XB, XN, g_ple, SSQ2};
        pg8::gemm_phase<pg8::EpiResid<false>, pg8::StaticOrder, true, true, PostHook>(L + RING_OFF, g, S, E, PostHook{ctl, 6, srb, !late_});
    } }
    PSEAM(late_); LATE_POST(6);
#pragma unroll 1
    for (int pass_ = 0; pass_ < 2; ++pass_) { OPQ(); if ((pass_ == 1) == late_) {
        { const int rb = srb, col0 = scb * 64;
            chain_wait(ctl, 6, rb, 128u);
            float rs_; unsigned long long xw_;
            { int te_ = threadIdx.x; asm volatile("" : "+v"(te_)); rs_ = sk::rstd16(SSQ2, MP + rb * 32 + (te_ >> 4), te_); xw_ = *(const GAS unsigned long long*)(XB + (size_t)(MP + rb * 32 + (te_ >> 4)) * DM + col0 + (te_ & 15) * 4); }
            const f32x4 vp = sk::tile(PB, WPP, PLE, (size_t)MP + rb * 32, col0, (SK_LAS char*)(L + RING_OFF));
            const f32x4 vg = sk::tile(SV(SR_XN2, 2048), WPG, DM, (size_t)MP + rb * 32, col0, (SK_LAS char*)(L + RING_OFF));
            int t_raw_ = threadIdx.x; asm volatile("" : "+v"(t_raw_)); const int t = t_raw_, r = MP + rb * 32 + (t >> 4), c = col0 + (t & 15) * 4;
            const f32x4 x3 = sk::up4(xw_) + pg8::sigm4(vg * rs_) * vp;
            const float ss = sk::sum16(pg8::dot4(x3)); if ((t & 15) == 0) __hip_atomic_store(SSQ3 + (size_t)r * 16 + (col0 >> 6), ss, __ATOMIC_RELAXED, __HIP_MEMORY_SCOPE_AGENT);
            asm volatile("s_waitcnt vmcnt(0)" ::: "memory");
            unsigned* cw = (unsigned*)(ctl + CW_FINS + 64 * rb);
            if ((t & 63) == 0) __hip_atomic_fetch_add(cw, 1u, __ATOMIC_RELAXED, __HIP_MEMORY_SCOPE_AGENT);
            { unsigned spins = 0; while ((unsigned)__builtin_amdgcn_readfirstlane(__hip_atomic_load(cw, __ATOMIC_RELAXED, __HIP_MEMORY_SCOPE_AGENT)) < 128u) { __builtin_amdgcn_s_sleep(2); if (++spins > (1u << 16)) break; } }
            const float r3 = __builtin_amdgcn_rsqf(sk::sum16(__hip_atomic_load(SSQ3 + (size_t)r * 16 + (t & 15), __ATOMIC_RELAXED, __HIP_MEMORY_SCOPE_AGENT)) * (1.0f / 1024.0f) + EPS);
            *(GAS f32x4*)(Yo + (size_t)r * DM + c) = x3 * r3 * *(const GAS f32x4*)(g_final + c);
        }
    } else {
#if PLE_GATE_FIRST
        { pg8::Gemm g{FOLD_G ? XB : XN, WPG, MP, DM, DM}; pg8::StaticOrder S; S.init(MP, DM, G, bx); pg8::EpiGate8 E{SSQ2, (unsigned char*)XN};
          pg8::gemm_phase<pg8::EpiGate8, pg8::StaticOrder, true, true>(L + RING_OFF, g, S, E); }
        { pg8::Gemm g{PB, WPP, MP, DM, PLE}; pg8::StaticOrder S; S.init(MP, DM, G, bx); pg8::EpiPleFinal2 E{(const unsigned char*)XN, XB, Yo, SSQ3, g_final, (unsigned*)(ctl + CW_FIN)};
          pg8::gemm_phase<pg8::EpiPleFinal2, pg8::StaticOrder, true, true>(L + RING_OFF, g, S, E); }
#else
        { pg8::Gemm g{PB, WPP, MP, DM, PLE}; pg8::StaticOrder S; S.init(MP, DM, G, bx); pg8::EpiPP E{PV(AR_PP, 2048)};
          pg8::gemm_phase<pg8::EpiPP, pg8::StaticOrder, true, true>(L + RING_OFF, g, S, E); }
        { pg8::Gemm g{FOLD_G ? XB : XN, WPG, MP, DM, DM}; pg8::StaticOrder S; S.init(MP, DM, G, bx); pg8::EpiPleFinal E{SSQ2, PV(AR_PP, 2048), XB, Yo, SSQ3, g_final, (unsigned*)(ctl + CW_FIN)};
          pg8::gemm_phase<pg8::EpiPleFinal, pg8::StaticOrder, true, true>(L + RING_OFF, g, S, E); }
#endif
    } }
#undef SEAM
#undef PSEAM
#undef LATE_POST
#undef DRAIN_PLAIN
#undef PV
#undef SV
#undef OPQ
#undef FRESH_TID
}

extern "C" void kernel_launch(void* const* d_in, const int* in_sizes, int n_in, void* d_out, int out_size, void* d_ws, size_t ws_size, hipStream_t stream) {
    static int grid = 0;
    if (grid == 0) {
        if (n_in != 22 || out_size != (int)O_END || ws_size < WS_END) { fprintf(stderr, "kernel_launch: unexpected sizes: n_in %d out %d ws %zu\n", n_in, out_size, ws_size); grid = -1; return; }
        int dev = 0, cus = 0, per_cu = 0;
        if (hipGetDevice(&dev) != hipSuccess || hipDeviceGetAttribute(&cus, hipDeviceAttributeMultiprocessorCount, dev) != hipSuccess) { grid = -1; return; }
        if (hipFuncSetAttribute((const void*)mega_fwd, hipFuncAttributeMaxDynamicSharedMemorySize, LDS_BYTES) != hipSuccess) { fprintf(stderr, "kernel_launch: hipFuncSetAttribute failed\n"); grid = -1; return; }
        if (hipOccupancyMaxActiveBlocksPerMultiprocessor(&per_cu, (const void*)mega_fwd, NWAVES * 64, LDS_BYTES) != hipSuccess || per_cu < 1) { fprintf(stderr, "kernel_launch: occupancy query says %d\n", per_cu); (void)hipGetLastError(); }
        if (cus != 256) { fprintf(stderr, "kernel_launch: built for a 256-CU device (one workgroup per CU, 8 groups of 32); found %d CUs\n", cus); grid = -1; return; }
        grid = cus;
    }
    if (grid < 0) return;
    (void)hipMemsetAsync((char*)d_ws + WS_CTL, 0, CTL_ZERO_BYTES, stream);
    Args a{};
    for (int i = 0; i < 22; ++i) a.in[i] = (const float*)d_in[i];
    a.out = (float*)d_out; a.ws = (unsigned char*)d_ws;
    hipLaunchKernelGGL(mega_fwd, dim3(grid), dim3(NWAVES * 64), LDS_BYTES, stream, a);
}
```
